# Optimizing an MI355X kernel written in HIP

```python
import math
import jax, jax.numpy as jnp
from jax import lax
import numpy as np

D_MODEL = 1024
BATCH = 8
SEQ = 4096
DEPTH = 1

MIX_WIDTH = D_MODEL
HEAD_DIM = 64
SWA_Q_HEADS = 8
SWA_KV_HEADS = 2
SWA_GROUP = SWA_Q_HEADS // SWA_KV_HEADS
WINDOW = 128
BLOCK = 128
DIFF_HEADS = 4
DIFF_VDIM = 2 * HEAD_DIM
Q_BLOCK = 128
SWA_Q_COLS = SWA_Q_HEADS * HEAD_DIM
SWA_KV_COLS = SWA_KV_HEADS * HEAD_DIM
DIFF_QK_COLS = DIFF_HEADS * 2 * HEAD_DIM
DIFF_V_COLS = DIFF_HEADS * DIFF_VDIM
IN_COLS = SWA_Q_COLS + 2 * SWA_KV_COLS + 2 * DIFF_QK_COLS + DIFF_V_COLS
SWA_OUT = SWA_Q_HEADS * HEAD_DIM
DIFF_OUT = DIFF_HEADS * DIFF_VDIM
MEM_LEN = 256
CROSS_HEADS = 4
CROSS_HEAD_DIM = D_MODEL // CROSS_HEADS
D_FF = 4 * D_MODEL
ROPE_THETA = 10000.0
NORM_EPS = 1e-5

kernel_name = "hymba_swa_sink_diffattn_xattn_sqrelu"


def rms_norm(x, g, eps=NORM_EPS):
    xf = x.astype(jnp.float32)
    y = xf * lax.rsqrt(jnp.mean(xf * xf, axis=-1, keepdims=True) + eps)
    return (y * g.astype(jnp.float32)).astype(x.dtype)


def rope_tables(positions, dim):
    inv_freq = ROPE_THETA ** (-jnp.arange(0, dim, 2, dtype=jnp.float32) / dim)
    ang = positions.astype(jnp.float32)[..., None] * inv_freq
    return jnp.cos(ang), jnp.sin(ang)


def apply_rope(x, cos, sin):
    shp = cos.shape[:2] + (1,) * (x.ndim - 3) + cos.shape[-1:]
    c = cos.reshape(shp).astype(x.dtype)
    s = sin.reshape(shp).astype(x.dtype)
    x1, x2 = jnp.split(x, 2, axis=-1)
    return jnp.concatenate([x1 * c - x2 * s, x2 * c + x1 * s], axis=-1)


def sliding_window_sink_attention(q, k, v, sinks):
    Bn, S = q.shape[0], q.shape[1]
    nb = S // BLOCK
    scale = HEAD_DIM ** -0.5
    qb = q.reshape(Bn, nb, BLOCK, SWA_KV_HEADS, SWA_GROUP, HEAD_DIM)
    kb = k.reshape(Bn, nb, BLOCK, SWA_KV_HEADS, HEAD_DIM)
    vb = v.reshape(Bn, nb, BLOCK, SWA_KV_HEADS, HEAD_DIM)
    pad = ((0, 0), (1, 0), (0, 0), (0, 0), (0, 0))
    kw = jnp.concatenate([jnp.pad(kb, pad)[:, :-1], kb], axis=2)
    vw = jnp.concatenate([jnp.pad(vb, pad)[:, :-1], vb], axis=2)
    s = jnp.einsum('bnqhgd,bnkhd->bnhgqk', qb, kw).astype(jnp.float32) * scale
    qi = jnp.arange(BLOCK)[:, None]
    kj = jnp.arange(2 * BLOCK)[None, :]
    rel = qi + BLOCK - kj
    band = (rel >= 0) & (rel < WINDOW)
    exists = (jnp.arange(nb)[:, None, None] * BLOCK + kj[None]) >= BLOCK
    valid = band[None] & exists
    s = jnp.where(valid[None, :, None, None], s, -jnp.inf)
    sink = sinks.astype(jnp.float32).reshape(SWA_KV_HEADS, SWA_GROUP)[None, None, :, :, None, None]
    m = jnp.maximum(jnp.max(s, axis=-1, keepdims=True), sink)
    e = jnp.exp(s - m)
    p = e / (jnp.sum(e, axis=-1, keepdims=True) + jnp.exp(sink - m))
    o = jnp.einsum('bnhgqk,bnkhd->bnqhgd', p.astype(v.dtype), vw)
    return o.reshape(Bn, S, SWA_OUT)


def differential_attention(q, k, v, lam):
    Bn, S = q.shape[0], q.shape[1]
    nb = S // Q_BLOCK
    scale = HEAD_DIM ** -0.5
    qb = q.reshape(Bn, nb, Q_BLOCK, DIFF_HEADS, 2, HEAD_DIM).swapaxes(0, 1)
    starts = jnp.arange(nb) * Q_BLOCK
    kpos = jnp.arange(S)

    def one_block(args):
        qblk, start = args
        s = jnp.einsum('bqhcd,bkhcd->bhcqk', qblk, k).astype(jnp.float32) * scale
        mask = kpos[None, :] <= (start + jnp.arange(Q_BLOCK))[:, None]
        s = jnp.where(mask, s, -jnp.inf)
        p = jax.nn.softmax(s, axis=-1)
        a = p[:, :, 0] - lam * p[:, :, 1]
        return jnp.einsum('bhqk,bkhe->bqhe', a.astype(v.dtype), v)

    o = lax.map(one_block, (qb, starts))
    return o.swapaxes(0, 1).reshape(Bn, S, DIFF_HEADS, DIFF_VDIM)


def cross_attention(h, m, w_q, w_kv, w_o):
    Bn, S = h.shape[0], h.shape[1]
    q = (h @ w_q).reshape(Bn, S, CROSS_HEADS, CROSS_HEAD_DIM)
    kv = (m @ w_kv).reshape(Bn, m.shape[1], 2, CROSS_HEADS, CROSS_HEAD_DIM)
    k, v = kv[:, :, 0], kv[:, :, 1]
    s = jnp.einsum('bshd,bmhd->bhsm', q, k).astype(jnp.float32) * CROSS_HEAD_DIM ** -0.5
    p = jax.nn.softmax(s, axis=-1)
    o = jnp.einsum('bhsm,bmhd->bshd', p.astype(v.dtype), v).reshape(Bn, S, D_MODEL)
    return o @ w_o


def setup_inputs(seed: int = 0) -> dict:
    key = jax.random.key(seed)
    ks = jax.random.split(key, 24)
    f32 = jnp.float32
    L = DEPTH

    def w(k, shape, fan_in):
        return jax.random.normal(k, shape, f32) * fan_in ** -0.5

    def gain(k, shape):
        return 1.0 + 0.02 * jax.random.normal(k, shape, f32)

    x = jax.random.normal(ks[0], (BATCH, SEQ, D_MODEL), f32)
    mem = jax.random.normal(ks[1], (BATCH, MEM_LEN, D_MODEL), f32)
    positions = (jnp.arange(SEQ, dtype=jnp.int32)[None, :]
                 + jax.random.randint(ks[2], (BATCH, 1), 0, 1024, dtype=jnp.int32))
    return {
        "x": x,
        "mem": mem,
        "positions": positions,
        "g_mix": gain(ks[3], (L, D_MODEL)),
        "w_in": w(ks[4], (L, D_MODEL, IN_COLS), D_MODEL),
        "sinks": 0.5 * jax.random.normal(ks[5], (L, SWA_Q_HEADS), f32),
        "lambda_q1": 0.1 * jax.random.normal(ks[6], (L, HEAD_DIM), f32),
        "lambda_k1": 0.1 * jax.random.normal(ks[7], (L, HEAD_DIM), f32),
        "lambda_q2": 0.1 * jax.random.normal(ks[8], (L, HEAD_DIM), f32),
        "lambda_k2": 0.1 * jax.random.normal(ks[9], (L, HEAD_DIM), f32),
        "g_diff": gain(ks[10], (L, DIFF_VDIM)),
        "w_out": w(ks[11], (L, MIX_WIDTH, D_MODEL), MIX_WIDTH),
        "g_cross": gain(ks[12], (L, D_MODEL)),
        "g_mem": gain(ks[13], (L, D_MODEL)),
        "w_cq": w(ks[14], (L, D_MODEL, D_MODEL), D_MODEL),
        "w_ckv": w(ks[15], (L, D_MODEL, 2 * D_MODEL), D_MODEL),
        "w_co": w(ks[16], (L, D_MODEL, D_MODEL), D_MODEL),
        "g_mlp": gain(ks[17], (L, D_MODEL)),
        "w_up": w(ks[18], (L, D_MODEL, D_FF), D_MODEL),
        "w_down": w(ks[19], (L, D_FF, D_MODEL), D_FF),
        "g_final": gain(ks[20], (D_MODEL,)),
    }


def reference(x, mem, positions, g_mix, w_in, sinks, lambda_q1, lambda_k1, lambda_q2, lambda_k2,
              g_diff, w_out, g_cross, g_mem, w_cq, w_ckv, w_co, g_mlp, w_up, w_down, g_final):
    Bn, S = x.shape[0], x.shape[1]
    cos, sin = rope_tables(positions, HEAD_DIM)
    splits = np.cumsum([SWA_Q_COLS, SWA_KV_COLS, SWA_KV_COLS, DIFF_QK_COLS, DIFF_QK_COLS])
    for l in range(DEPTH):
        h = rms_norm(x, g_mix[l])
        proj = h @ w_in[l]
        qa, ka, va, qd, kd, vd = jnp.split(proj, splits, axis=-1)
        qa = apply_rope(qa.reshape(Bn, S, SWA_KV_HEADS, SWA_GROUP, HEAD_DIM), cos, sin)
        ka = apply_rope(ka.reshape(Bn, S, SWA_KV_HEADS, HEAD_DIM), cos, sin)
        va = va.reshape(Bn, S, SWA_KV_HEADS, HEAD_DIM)
        out_a = sliding_window_sink_attention(qa, ka, va, sinks[l])

        lam_init = 0.8 - 0.6 * math.exp(-0.3 * l)
        lam = (jnp.exp(jnp.sum(lambda_q1[l].astype(jnp.float32) * lambda_k1[l].astype(jnp.float32)))
               - jnp.exp(jnp.sum(lambda_q2[l].astype(jnp.float32) * lambda_k2[l].astype(jnp.float32)))
               + lam_init)
        qd = apply_rope(qd.reshape(Bn, S, DIFF_HEADS, 2, HEAD_DIM), cos, sin)
        kd = apply_rope(kd.reshape(Bn, S, DIFF_HEADS, 2, HEAD_DIM), cos, sin)
        vd = vd.reshape(Bn, S, DIFF_HEADS, DIFF_VDIM)
        od = differential_attention(qd, kd, vd, lam)
        out_b = (rms_norm(od, g_diff[l]) * (1.0 - lam_init)).reshape(Bn, S, DIFF_OUT)

        x = x + jnp.concatenate([out_a, out_b], axis=-1) @ w_out[l]

        x = x + cross_attention(rms_norm(x, g_cross[l]), rms_norm(mem, g_mem[l]),
                                w_cq[l], w_ckv[l], w_co[l])

        u = rms_norm(x, g_mlp[l]) @ w_up[l]
        x = x + jnp.square(jax.nn.relu(u)) @ w_down[l]
    return rms_norm(x, g_final)
```

```cpp
#include <hip/hip_runtime.h>
#include <hip/hip_cooperative_groups.h>
#include <cstdio>
#include <cstdint>
namespace cg = cooperative_groups;

#ifndef MK_ONE_LAUNCH
#define MK_ONE_LAUNCH 1
#endif

#define LAS __attribute__((address_space(3)))
typedef unsigned short bf16;
typedef short bf16x8 __attribute__((ext_vector_type(8)));
typedef float f32x4 __attribute__((ext_vector_type(4)));
typedef unsigned u32x4 __attribute__((ext_vector_type(4)));
typedef unsigned u32x2 __attribute__((ext_vector_type(2)));

constexpr int BATCH = 8, SEQ = 4096, M = BATCH * SEQ, DM = 1024, NP = 2304, MEML = 256, MM = BATCH * MEML, FF = 4096;
constexpr int NWAVES = 8, NTHR = NWAVES * 64;
constexpr float EPS = 1e-5f;
constexpr float LOG2E = 1.4426950408889634f;
constexpr float C2 = 0.125f * LOG2E;
constexpr float CQ = 0.0625f * LOG2E;
constexpr int C_QA = 0, C_KA = 512, C_VA = 640, C_QD = 768, C_KD = 1280, C_VD = 1792;

constexpr size_t MiB = 1u << 20;
constexpr size_t WS_CTL = 0;
constexpr size_t WS_WIN = 2 * MiB;
constexpr size_t WS_WOUT = WS_WIN + (size_t)NP * DM * 2;
constexpr size_t WS_WCQ = WS_WOUT + 2 * MiB;
constexpr size_t WS_WCKV = WS_WCQ + 2 * MiB;
constexpr size_t WS_WCO = WS_WCKV + 4 * MiB;
constexpr size_t WS_WUP = WS_WCO + 2 * MiB;
constexpr size_t WS_WDOWN = WS_WUP + 8 * MiB;
constexpr size_t WS_ROPE = 34 * MiB;
constexpr size_t WS_KVM = 42 * MiB;
constexpr size_t WS_MEMN = 50 * MiB;
constexpr size_t WS_SS1 = 54 * MiB, WS_SS2 = 56 * MiB;
constexpr size_t WS_XN = 64 * MiB;
constexpr size_t WS_ODIFF = 128 * MiB;
constexpr size_t WS_PROJ = 256 * MiB;
constexpr size_t WS_ATT = 400 * MiB;
constexpr size_t WS_QC = 256 * MiB;
constexpr size_t WS_OC = 320 * MiB;
constexpr size_t WS_ACT = 256 * MiB;
constexpr size_t WS_END = 512 * MiB;
static_assert(WS_WDOWN + 8 * MiB <= WS_ROPE, "weights fit");

struct Params {
    const float *x, *mem; const int* pos;
    const float *g_mix, *w_in, *sinks, *lq1, *lk1, *lq2, *lk2, *g_diff, *w_out, *g_cross, *g_mem, *w_cq, *w_ckv, *w_co, *g_mlp, *w_up, *w_down, *g_final;
    float* out; unsigned char* ws; int ph_lo, ph_hi;
};

__device__ __forceinline__ unsigned f2bf(float f) { unsigned u = __builtin_bit_cast(unsigned, f); return (u + 0x7fffu + ((u >> 16) & 1u)) >> 16; }
__device__ __forceinline__ unsigned pk2(float lo, float hi) { return f2bf(lo) | (f2bf(hi) << 16); }
__device__ __forceinline__ float bf2f(unsigned h) { return __builtin_bit_cast(float, h << 16); }
__device__ __forceinline__ float bflo(unsigned w) { return __builtin_bit_cast(float, w << 16); }
__device__ __forceinline__ float bfhi(unsigned w) { return __builtin_bit_cast(float, w & 0xffff0000u); }
__device__ __forceinline__ float wave_sum(float v) {
#pragma unroll
    for (int o = 1; o < 64; o <<= 1) v += __shfl_xor(v, o);
    return v;
}
__device__ __forceinline__ float wave_max(float v) {
#pragma unroll
    for (int o = 1; o < 64; o <<= 1) v = fmaxf(v, __shfl_xor(v, o));
    return v;
}
__host__ __device__ __forceinline__ bool col_roped(int n) { return n < C_VA || (n >= C_QD && n < C_VD); }
__host__ __device__ __forceinline__ int phys_of_logical(int nl) {
    if (!col_roped(nl)) return nl;
    const int g = nl & ~63, j = nl & 63; return g + ((j & 31) << 1) + (j >> 5);
}
__device__ __forceinline__ float calc_lambda(const Params& p) {
    float a = 0.f, b = 0.f;
    for (int i = 0; i < 64; ++i) { a += p.lq1[i] * p.lk1[i]; b += p.lq2[i] * p.lk2[i]; }
    return __expf(a) - __expf(b) + 0.2f;
}

__device__ const double INV_FREQ[32] = {
    1.0, 0.7498942093324559, 0.5623413251903491, 0.4216965034285822,
    0.31622776601683794, 0.23713737056616552, 0.1778279410038923, 0.1333521432163324,
    0.1, 0.07498942093324558, 0.05623413251903491, 0.042169650342858224,
    0.03162277660168379, 0.023713737056616554, 0.01778279410038923, 0.01333521432163324,
    0.01, 0.007498942093324558, 0.005623413251903491, 0.004216965034285823,
    0.0031622776601683794, 0.0023713737056616554, 0.0017782794100389228, 0.001333521432163324,
    0.001, 0.0007498942093324559, 0.0005623413251903491, 0.00042169650342858224,
    0.00031622776601683794, 0.00023713737056616554, 0.00017782794100389227, 0.0001333521432163324};

__device__ __forceinline__ void sincos_d(double a, float& c, float& s) {
    const double kd = rint(a * 0.63661977236758134308);
    const int k = (int)kd;
    double r = fma(-kd, 1.57079632679489655800e+00, a); r = fma(-kd, 6.12323399573676603587e-17, r);
    const double r2 = r * r;
    const double sp = r * (1.0 + r2 * (-1.0 / 6.0 + r2 * (1.0 / 120.0 + r2 * (-1.0 / 5040.0 + r2 * (1.0 / 362880.0 + r2 * (-1.0 / 39916800.0 + r2 * (1.0 / 6227020800.0)))))));
    const double cp = 1.0 + r2 * (-0.5 + r2 * (1.0 / 24.0 + r2 * (-1.0 / 720.0 + r2 * (1.0 / 40320.0 + r2 * (-1.0 / 3628800.0 + r2 * (1.0 / 479001600.0 + r2 * (-1.0 / 87178291200.0)))))));
    const int q = k & 3;
    const double ss = (q == 0) ? sp : (q == 1) ? cp : (q == 2) ? -sp : -cp;
    const double cc = (q == 0) ? cp : (q == 1) ? -sp : (q == 2) ? -cp : sp;
    c = (float)cc; s = (float)ss;
}

__device__ __forceinline__ void transpose_item(const float* W, int K, int N, const float* g, bool perm, bf16* WT, LAS float* scr, int item, int lane) {
    const int nblk = N / 32, kb = item / nblk, nb = item % nblk, k0 = 64 * kb, n0 = 32 * nb;
#pragma unroll 8
    for (int i = 0; i < 32; ++i) { const int kk = 2 * i + (lane >> 5); const float gs = g ? g[k0 + kk] : 1.f; scr[kk * 33 + (lane & 31)] = gs * W[(size_t)(k0 + kk) * N + n0 + (lane & 31)]; }
    asm volatile("s_waitcnt lgkmcnt(0)" ::: "memory");
    const int c = lane & 7;
#pragma unroll
    for (int j = 0; j < 4; ++j) { const int n = (lane >> 3) + 8 * j; const LAS float* s = scr + (8 * c) * 33 + n;
        u32x4 o; o.x = pk2(s[0 * 33], s[1 * 33]); o.y = pk2(s[2 * 33], s[3 * 33]); o.z = pk2(s[4 * 33], s[5 * 33]); o.w = pk2(s[6 * 33], s[7 * 33]);
        const int nl = n0 + n, np = perm ? phys_of_logical(nl) : nl;
        *(u32x4*)(WT + (size_t)np * K + k0 + 8 * c) = o; }
    asm volatile("s_waitcnt lgkmcnt(0)" ::: "memory");
}
__device__ __forceinline__ void rms_row_to_bf16(const float* xrow, const float* g, bf16* orow, int lane) {
    const f32x4* xr = (const f32x4*)xrow + lane;
    f32x4 v[4]; float s = 0.f;
#pragma unroll
    for (int j = 0; j < 4; ++j) { v[j] = xr[64 * j]; s += (v[j].x * v[j].x + v[j].y * v[j].y) + (v[j].z * v[j].z + v[j].w * v[j].w); }
    const float rstd = 1.0f / sqrtf(wave_sum(s) * (1.f / DM) + EPS);
    u32x2* o8 = (u32x2*)orow + lane;
#pragma unroll
    for (int j = 0; j < 4; ++j) {
        f32x4 gg = (f32x4){1.f, 1.f, 1.f, 1.f}; if (g) gg = ((const f32x4*)g)[lane + 64 * j];
        u32x2 w; w.x = pk2(v[j].x * rstd * gg.x, v[j].y * rstd * gg.y); w.y = pk2(v[j].z * rstd * gg.z, v[j].w * rstd * gg.w); o8[64 * j] = w; }
}
__device__ __forceinline__ void p0_prologue(const Params& p, LAS unsigned char* lds, int bid, int nblk, int tid) {
    const int wave = tid >> 6, lane = tid & 63;
    LAS float* scr = (LAS float*)(lds + wave * 8704);
    const int gw = bid * NWAVES + wave, NGW = nblk * NWAVES;
    unsigned char* ws = p.ws;
    constexpr int I_IN = (DM / 64) * (NP / 32), I_SQ = (DM / 64) * (DM / 32), I_KV = (DM / 64) * (2048 / 32), I_UP = (DM / 64) * (FF / 32), I_DN = (FF / 64) * (DM / 32);
    constexpr int NITEMS = I_IN + 3 * I_SQ + I_KV + I_UP + I_DN;
    for (int it = gw; it < NITEMS; it += NGW) {
        int r = it;
        if (r < I_IN) { transpose_item(p.w_in, DM, NP, p.g_mix, true, (bf16*)(ws + WS_WIN), scr, r, lane); continue; } r -= I_IN;
        if (r < I_SQ) { transpose_item(p.w_out, DM, DM, nullptr, false, (bf16*)(ws + WS_WOUT), scr, r, lane); continue; } r -= I_SQ;
        if (r < I_SQ) { transpose_item(p.w_cq, DM, DM, p.g_cross, false, (bf16*)(ws + WS_WCQ), scr, r, lane); continue; } r -= I_SQ;
        if (r < I_KV) { transpose_item(p.w_ckv, DM, 2048, nullptr, false, (bf16*)(ws + WS_WCKV), scr, r, lane); continue; } r -= I_KV;
        if (r < I_SQ) { transpose_item(p.w_co, DM, DM, nullptr, false, (bf16*)(ws + WS_WCO), scr, r, lane); continue; } r -= I_SQ;
        if (r < I_UP) { transpose_item(p.w_up, DM, FF, p.g_mlp, false, (bf16*)(ws + WS_WUP), scr, r, lane); continue; } r -= I_UP;
        transpose_item(p.w_down, FF, DM, nullptr, false, (bf16*)(ws + WS_WDOWN), scr, r, lane);
    }
    for (int m = gw; m < M; m += NGW) rms_row_to_bf16(p.x + (size_t)m * DM, nullptr, (bf16*)(ws + WS_XN) + (size_t)m * DM, lane);
    for (int m = gw; m < MM; m += NGW) rms_row_to_bf16(p.mem + (size_t)m * DM, p.g_mem, (bf16*)(ws + WS_MEMN) + (size_t)m * DM, lane);
    float2* rope = (float2*)(ws + WS_ROPE);
    for (int i = bid * NTHR + tid; i < M * 32; i += nblk * NTHR) {
        const int row = i >> 5, d = i & 31; float c, s; sincos_d((double)p.pos[row] * INV_FREQ[d], c, s); rope[i] = make_float2(c, s); }
}

template <class Epi>
__device__ __forceinline__ void gemm_naive(const bf16* A, const bf16* Bt, int Mr, int N, int K, const Epi& epi, int gw, int ngw, int lane) {
    const int tn = N / 32, nt = (Mr / 32) * tn, fr = lane & 15, fq = lane >> 4;
    for (int it = gw; it < nt; it += ngw) {
        const int r0 = (it / tn) * 32, c0 = (it % tn) * 32;
        f32x4 acc[2][2];
#pragma unroll
        for (int i = 0; i < 2; ++i)
#pragma unroll
            for (int j = 0; j < 2; ++j) acc[i][j] = (f32x4){0.f, 0.f, 0.f, 0.f};
        const bf16* a0 = A + (size_t)(r0 + fr) * K + fq * 8; const bf16* a1 = a0 + (size_t)16 * K;
        const bf16* b0 = Bt + (size_t)(c0 + fr) * K + fq * 8; const bf16* b1 = b0 + (size_t)16 * K;
        for (int k = 0; k < K; k += 32) {
            const bf16x8 fa0 = *(const bf16x8*)(a0 + k), fa1 = *(const bf16x8*)(a1 + k), fb0 = *(const bf16x8*)(b0 + k), fb1 = *(const bf16x8*)(b1 + k);
            acc[0][0] = __builtin_amdgcn_mfma_f32_16x16x32_bf16(fa0, fb0, acc[0][0], 0, 0, 0);
            acc[0][1] = __builtin_amdgcn_mfma_f32_16x16x32_bf16(fa0, fb1, acc[0][1], 0, 0, 0);
            acc[1][0] = __builtin_amdgcn_mfma_f32_16x16x32_bf16(fa1, fb0, acc[1][0], 0, 0, 0);
            acc[1][1] = __builtin_amdgcn_mfma_f32_16x16x32_bf16(fa1, fb1, acc[1][1], 0, 0, 0);
        }
#pragma unroll
        for (int mi = 0; mi < 2; ++mi)
#pragma unroll
            for (int ni = 0; ni < 2; ++ni)
#pragma unroll
                for (int j = 0; j < 4; ++j) { const float v = acc[mi][ni][j]; const float pr = __shfl_xor(v, 1); epi(r0 + mi * 16 + fq * 4 + j, c0 + ni * 16 + fr, v, pr); }
    }
}
struct NEpiProj {
    bf16* proj; const float2* rope;
    __device__ __forceinline__ void operator()(int row, int col, float v, float pr) const {
        float o = v;
        if (col_roped(col)) { const float2 cs = rope[row * 32 + ((col & 63) >> 1)]; o = (col & 1) ? (v * cs.x + pr * cs.y) : (v * cs.x - pr * cs.y); }
        if (col < C_KA || (col >= C_QD && col < C_KD)) o *= C2;
        proj[(size_t)row * NP + col] = (bf16)f2bf(o);
    }
};
struct NEpiStore { bf16* o; int ld; __device__ __forceinline__ void operator()(int row, int col, float v, float) const { o[(size_t)row * ld + col] = (bf16)f2bf(v); } };
struct NEpiRes {
    const float* xi; float* xo; bf16* xb;
    __device__ __forceinline__ void operator()(int row, int col, float v, float) const { const size_t i = (size_t)row * DM + col; const float r = xi[i] + v; xo[i] = r; if (xb) xb[i] = (bf16)f2bf(r); }
};
__device__ __forceinline__ float rstd_from_ss(const float* ss, int row) {
    const f32x4* s4 = (const f32x4*)(ss + (size_t)row * 16); float t = 0.f;
#pragma unroll
    for (int i = 0; i < 4; ++i) { const f32x4 v = s4[i]; t += (v.x + v.y) + (v.z + v.w); }
    return 1.0f / sqrtf(t * (1.f / DM) + EPS);
}
struct NEpiCq { bf16* o; const float* ss; __device__ __forceinline__ void operator()(int row, int col, float v, float) const { o[(size_t)row * DM + col] = (bf16)f2bf(v * rstd_from_ss(ss, row) * CQ); } };
struct NEpiUp { bf16* o; const float* ss; __device__ __forceinline__ void operator()(int row, int col, float v, float) const { const float u = fmaxf(v * rstd_from_ss(ss, row), 0.f); o[(size_t)row * FF + col] = (bf16)f2bf(u * u); } };

__device__ __forceinline__ void rowstat_naive(const float* X, float* ss, int gw, int ngw, int lane) {
    for (int m = gw; m < M; m += ngw) {
        const f32x4* xr = (const f32x4*)(X + (size_t)m * DM) + lane; float s = 0.f;
#pragma unroll
        for (int j = 0; j < 4; ++j) { const f32x4 v = xr[64 * j]; s += (v.x * v.x + v.y * v.y) + (v.z * v.z + v.w * v.w); }
        s = wave_sum(s);
        if (lane < 16) ss[(size_t)m * 16 + lane] = (lane == 0) ? s : 0.f;
    }
}
__device__ __forceinline__ void final_norm(float* X, const float* g, int gw, int ngw, int lane) {
    for (int m = gw; m < M; m += ngw) {
        f32x4* xr = (f32x4*)(X + (size_t)m * DM) + lane; f32x4 v[4]; float s = 0.f;
#pragma unroll
        for (int j = 0; j < 4; ++j) { v[j] = xr[64 * j]; s += (v[j].x * v[j].x + v[j].y * v[j].y) + (v[j].z * v[j].z + v[j].w * v[j].w); }
        const float rstd = 1.0f / sqrtf(wave_sum(s) * (1.f / DM) + EPS);
#pragma unroll
        for (int j = 0; j < 4; ++j) { const f32x4 gg = ((const f32x4*)g)[lane + 64 * j]; xr[64 * j] = v[j] * rstd * gg; }
    }
}

__device__ __forceinline__ void swa_naive(const Params& p, int bid, int nblk, int tid) {
    const bf16* proj = (const bf16*)(p.ws + WS_PROJ); bf16* att = (bf16*)(p.ws + WS_ATT);
    for (int base = bid * NTHR; base < M * 8; base += nblk * NTHR) {
        const int idx = base + tid, hq = idx >> 15, row = idx & (M - 1), t = row & (SEQ - 1), kvh = hq >> 2;
        float q[64], o[64];
        { const u32x4* q4 = (const u32x4*)(proj + (size_t)row * NP + C_QA + hq * 64);
#pragma unroll
          for (int i = 0; i < 8; ++i) { const u32x4 w = q4[i]; q[8 * i] = bflo(w.x); q[8 * i + 1] = bfhi(w.x); q[8 * i + 2] = bflo(w.y); q[8 * i + 3] = bfhi(w.y); q[8 * i + 4] = bflo(w.z); q[8 * i + 5] = bfhi(w.z); q[8 * i + 6] = bflo(w.w); q[8 * i + 7] = bfhi(w.w); } }
#pragma unroll
        for (int d = 0; d < 64; ++d) o[d] = 0.f;
        float m = p.sinks[hq] * LOG2E, l = 1.f;
        const int nk = (t < 127 ? t : 127) + 1;
        for (int j = 0; j < nk; ++j) {
            const size_t kr = (size_t)(row - j) * NP;
            const u32x4* k4 = (const u32x4*)(proj + kr + C_KA + kvh * 64); const u32x4* v4 = (const u32x4*)(proj + kr + C_VA + kvh * 64);
            float s = 0.f;
#pragma unroll
            for (int i = 0; i < 8; ++i) { const u32x4 w = k4[i]; s += q[8 * i] * bflo(w.x) + q[8 * i + 1] * bfhi(w.x) + q[8 * i + 2] * bflo(w.y) + q[8 * i + 3] * bfhi(w.y) + q[8 * i + 4] * bflo(w.z) + q[8 * i + 5] * bfhi(w.z) + q[8 * i + 6] * bflo(w.w) + q[8 * i + 7] * bfhi(w.w); }
            const float mn = fmaxf(m, s), a = exp2f(m - mn), pp = exp2f(s - mn); l = l * a + pp; m = mn;
#pragma unroll
            for (int i = 0; i < 8; ++i) { const u32x4 w = v4[i];
                o[8 * i] = o[8 * i] * a + pp * bflo(w.x); o[8 * i + 1] = o[8 * i + 1] * a + pp * bfhi(w.x); o[8 * i + 2] = o[8 * i + 2] * a + pp * bflo(w.y); o[8 * i + 3] = o[8 * i + 3] * a + pp * bfhi(w.y);
                o[8 * i + 4] = o[8 * i + 4] * a + pp * bflo(w.z); o[8 * i + 5] = o[8 * i + 5] * a + pp * bfhi(w.z); o[8 * i + 6] = o[8 * i + 6] * a + pp * bflo(w.w); o[8 * i + 7] = o[8 * i + 7] * a + pp * bfhi(w.w); }
        }
        const float rl = 1.f / l;
        u32x4* o4 = (u32x4*)(att + (size_t)row * DM + hq * 64);
#pragma unroll
        for (int i = 0; i < 8; ++i) { u32x4 w; w.x = pk2(o[8 * i] * rl, o[8 * i + 1] * rl); w.y = pk2(o[8 * i + 2] * rl, o[8 * i + 3] * rl); w.z = pk2(o[8 * i + 4] * rl, o[8 * i + 5] * rl); w.w = pk2(o[8 * i + 6] * rl, o[8 * i + 7] * rl); o4[i] = w; }
    }
}
__device__ __forceinline__ void diff_naive(const Params& p, int bid, int nblk, int tid) {
    const bf16* proj = (const bf16*)(p.ws + WS_PROJ); float* od = (float*)(p.ws + WS_ODIFF);
    for (int base = bid * NTHR; base < M * 16; base += nblk * NTHR) {
        const int idx = base + tid, sel = __builtin_amdgcn_readfirstlane(idx >> 15), row = idx & (M - 1), t = row & (SEQ - 1);
        const int hc = sel >> 1, half = sel & 1, h = hc >> 1, c = hc & 1;
        const int b = __builtin_amdgcn_readfirstlane(row >> 12);
        const int tmax = __builtin_amdgcn_readfirstlane((row | 63) & (SEQ - 1));
        float q[64], o[64];
        { const u32x4* q4 = (const u32x4*)(proj + (size_t)row * NP + C_QD + hc * 64);
#pragma unroll
          for (int i = 0; i < 8; ++i) { const u32x4 w = q4[i]; q[8 * i] = bflo(w.x); q[8 * i + 1] = bfhi(w.x); q[8 * i + 2] = bflo(w.y); q[8 * i + 3] = bfhi(w.y); q[8 * i + 4] = bflo(w.z); q[8 * i + 5] = bfhi(w.z); q[8 * i + 6] = bflo(w.w); q[8 * i + 7] = bfhi(w.w); } }
#pragma unroll
        for (int d = 0; d < 64; ++d) o[d] = 0.f;
        float m = -1e30f, l = 0.f;
        for (int kt = 0; kt <= tmax; ++kt) {
            const size_t kr = (size_t)(b * SEQ + kt) * NP;
            const u32x4* k4 = (const u32x4*)(proj + kr + C_KD + hc * 64); const u32x4* v4 = (const u32x4*)(proj + kr + C_VD + h * 128 + half * 64);
            float s = 0.f;
#pragma unroll
            for (int i = 0; i < 8; ++i) { const u32x4 w = k4[i]; s += q[8 * i] * bflo(w.x) + q[8 * i + 1] * bfhi(w.x) + q[8 * i + 2] * bflo(w.y) + q[8 * i + 3] * bfhi(w.y) + q[8 * i + 4] * bflo(w.z) + q[8 * i + 5] * bfhi(w.z) + q[8 * i + 6] * bflo(w.w) + q[8 * i + 7] * bfhi(w.w); }
            if (kt > t) s = -1e30f;
            const float mn = fmaxf(m, s), a = exp2f(m - mn), pp = (kt > t) ? 0.f : exp2f(s - mn); l = l * a + pp; m = mn;
#pragma unroll
            for (int i = 0; i < 8; ++i) { const u32x4 w = v4[i];
                o[8 * i] = o[8 * i] * a + pp * bflo(w.x); o[8 * i + 1] = o[8 * i + 1] * a + pp * bfhi(w.x); o[8 * i + 2] = o[8 * i + 2] * a + pp * bflo(w.y); o[8 * i + 3] = o[8 * i + 3] * a + pp * bfhi(w.y);
                o[8 * i + 4] = o[8 * i + 4] * a + pp * bflo(w.z); o[8 * i + 5] = o[8 * i + 5] * a + pp * bfhi(w.z); o[8 * i + 6] = o[8 * i + 6] * a + pp * bflo(w.w); o[8 * i + 7] = o[8 * i + 7] * a + pp * bfhi(w.w); }
        }
        const float rl = 1.f / l;
        f32x4* o4 = (f32x4*)(od + ((size_t)c * M + row) * 512 + h * 128 + half * 64);
#pragma unroll
        for (int i = 0; i < 16; ++i) o4[i] = (f32x4){o[4 * i] * rl, o[4 * i + 1] * rl, o[4 * i + 2] * rl, o[4 * i + 3] * rl};
    }
}
__device__ __forceinline__ void diff_combine_naive(const Params& p, int gw, int ngw, int lane) {
    const float* od = (const float*)(p.ws + WS_ODIFF); bf16* att = (bf16*)(p.ws + WS_ATT);
    const float lam = calc_lambda(p);
    for (int m = gw; m < M; m += ngw) {
#pragma unroll
        for (int h = 0; h < 4; ++h) {
            const float2 a = *(const float2*)(od + (size_t)m * 512 + h * 128 + 2 * lane), b = *(const float2*)(od + ((size_t)M + m) * 512 + h * 128 + 2 * lane);
            const float v0 = a.x - lam * b.x, v1 = a.y - lam * b.y;
            const float rstd = 1.0f / sqrtf(wave_sum(v0 * v0 + v1 * v1) * (1.f / 128.f) + EPS);
            const float2 g = *(const float2*)(p.g_diff + 2 * lane);
            *(unsigned*)(att + (size_t)m * DM + 512 + h * 128 + 2 * lane) = pk2(v0 * rstd * g.x * 0.8f, v1 * rstd * g.y * 0.8f);
        }
    }
}
__device__ __forceinline__ void cross_naive(const Params& p, LAS unsigned char* lds, int bid, int nblk, int tid) {
    const bf16* qc = (const bf16*)(p.ws + WS_QC); const bf16* kvm = (const bf16*)(p.ws + WS_KVM); bf16* oc = (bf16*)(p.ws + WS_OC);
    const int sub = tid >> 8, tm = tid & 255, w4 = (tid >> 6) & 3, lane = tid & 63;
    LAS float* qs = (LAS float*)lds + sub * 256; LAS float* ps = (LAS float*)lds + 512 + sub * 256; LAS float* red = (LAS float*)lds + 1024 + sub * 8;
    for (int i2 = bid; i2 < M * 2; i2 += nblk) {
        const int item = i2 * 2 + sub, row = item >> 2, head = item & 3, b = row >> 12;
        qs[tm] = bf2f(qc[(size_t)row * DM + head * 256 + tm]);
        __syncthreads();
        const u32x4* k4 = (const u32x4*)(kvm + (size_t)(b * MEML + tm) * 2048 + head * 256);
        float s = 0.f;
        for (int i = 0; i < 32; ++i) { const u32x4 w = k4[i]; const LAS float* qq = qs + 8 * i;
            s += qq[0] * bflo(w.x) + qq[1] * bfhi(w.x) + qq[2] * bflo(w.y) + qq[3] * bfhi(w.y) + qq[4] * bflo(w.z) + qq[5] * bfhi(w.z) + qq[6] * bflo(w.w) + qq[7] * bfhi(w.w); }
        float mx = wave_max(s); if (lane == 0) red[w4] = mx;
        __syncthreads();
        mx = fmaxf(fmaxf(red[0], red[1]), fmaxf(red[2], red[3]));
        const float e = exp2f(s - mx); ps[tm] = e;
        float sm = wave_sum(e); if (lane == 0) red[4 + w4] = sm;
        __syncthreads();
        sm = (red[4] + red[5]) + (red[6] + red[7]);
        const bf16* vp = kvm + (size_t)(b * MEML) * 2048 + 1024 + head * 256 + tm;
        float o = 0.f;
        for (int mm = 0; mm < MEML; ++mm) o += ps[mm] * bf2f(vp[(size_t)mm * 2048]);
        oc[(size_t)row * DM + head * 256 + tm] = (bf16)f2bf(o / sm);
        __syncthreads();
    }
}

constexpr int N_PHASES = 13;
__global__ void __launch_bounds__(NTHR) fwd_kernel(Params p) {
    __shared__ __attribute__((aligned(16))) unsigned char lds_raw[NWAVES * 8704];
    LAS unsigned char* lds = (LAS unsigned char*)lds_raw;
    cg::grid_group grid = cg::this_grid();
    const int tid = threadIdx.x, wave = tid >> 6, lane = tid & 63, bid = blockIdx.x, nblk = gridDim.x;
    const int gw = bid * NWAVES + wave, ngw = nblk * NWAVES;
    unsigned char* ws = p.ws;
    const int lo = p.ph_lo, hi = p.ph_hi;
#define IN(k) (lo <= (k) && (k) < hi)
#define SEAM(k) do { if (IN(k) && IN((k) + 1)) grid.sync(); } while (0)
    if (IN(0)) { p0_prologue(p, lds, bid, nblk, tid); } SEAM(0);
    if (IN(1)) {
        { NEpiProj e{(bf16*)(ws + WS_PROJ), (const float2*)(ws + WS_ROPE)}; gemm_naive((const bf16*)(ws + WS_XN), (const bf16*)(ws + WS_WIN), M, NP, DM, e, gw, ngw, lane); }
        { NEpiStore e{(bf16*)(ws + WS_KVM), 2048}; gemm_naive((const bf16*)(ws + WS_MEMN), (const bf16*)(ws + WS_WCKV), MM, 2048, DM, e, gw, ngw, lane); }
    } SEAM(1);
    if (IN(2)) { swa_naive(p, bid, nblk, tid); diff_naive(p, bid, nblk, tid); } SEAM(2);
    if (IN(3)) { diff_combine_naive(p, gw, ngw, lane); } SEAM(3);
    if (IN(4)) { NEpiRes e{p.x, p.out, (bf16*)(ws + WS_XN)}; gemm_naive((const bf16*)(ws + WS_ATT), (const bf16*)(ws + WS_WOUT), M, DM, DM, e, gw, ngw, lane); } SEAM(4);
    if (IN(5)) { rowstat_naive(p.out, (float*)(ws + WS_SS1), gw, ngw, lane); } SEAM(5);
    if (IN(6)) { NEpiCq e{(bf16*)(ws + WS_QC), (const float*)(ws + WS_SS1)}; gemm_naive((const bf16*)(ws + WS_XN), (const bf16*)(ws + WS_WCQ), M, DM, DM, e, gw, ngw, lane); } SEAM(6);
    if (IN(7)) { cross_naive(p, lds, bid, nblk, tid); } SEAM(7);
    if (IN(8)) { NEpiRes e{p.out, p.out, (bf16*)(ws + WS_XN)}; gemm_naive((const bf16*)(ws + WS_OC), (const bf16*)(ws + WS_WCO), M, DM, DM, e, gw, ngw, lane); } SEAM(8);
    if (IN(9)) { rowstat_naive(p.out, (float*)(ws + WS_SS2), gw, ngw, lane); } SEAM(9);
    if (IN(10)) { NEpiUp e{(bf16*)(ws + WS_ACT), (const float*)(ws + WS_SS2)}; gemm_naive((const bf16*)(ws + WS_XN), (const bf16*)(ws + WS_WUP), M, FF, DM, e, gw, ngw, lane); } SEAM(10);
    if (IN(11)) { NEpiRes e{p.out, p.out, nullptr}; gemm_naive((const bf16*)(ws + WS_ACT), (const bf16*)(ws + WS_WDOWN), M, DM, FF, e, gw, ngw, lane); } SEAM(11);
    if (IN(12)) { final_norm(p.out, p.g_final, gw, ngw, lane); }
#undef IN
#undef SEAM
}

extern "C" void kernel_launch(void* const* d_in, const int* in_sizes, int n_in, void* d_out, int out_size, void* d_ws, size_t ws_size, hipStream_t stream) {
    static int grid = 0;
    if (grid == 0) {
        if (n_in != 21 || out_size != M * DM || ws_size < WS_END) { fprintf(stderr, "kernel_launch: unexpected shapes (n_in %d out %d ws %zu)\n", n_in, out_size, ws_size); grid = -1; return; }
        int dev = 0, cus = 0, per_cu = 0;
        hipGetDevice(&dev); hipDeviceGetAttribute(&cus, hipDeviceAttributeMultiprocessorCount, dev);
        hipOccupancyMaxActiveBlocksPerMultiprocessor(&per_cu, (const void*)fwd_kernel, NTHR, 0);
        if (per_cu < 1) per_cu = 1;
        grid = cus * (per_cu > 2 ? 2 : per_cu);
    }
    if (grid < 0) return;
    Params p{};
    p.x = (const float*)d_in[0]; p.mem = (const float*)d_in[1]; p.pos = (const int*)d_in[2]; p.g_mix = (const float*)d_in[3]; p.w_in = (const float*)d_in[4];
    p.sinks = (const float*)d_in[5]; p.lq1 = (const float*)d_in[6]; p.lk1 = (const float*)d_in[7]; p.lq2 = (const float*)d_in[8]; p.lk2 = (const float*)d_in[9];
    p.g_diff = (const float*)d_in[10]; p.w_out = (const float*)d_in[11]; p.g_cross = (const float*)d_in[12]; p.g_mem = (const float*)d_in[13]; p.w_cq = (const float*)d_in[14];
    p.w_ckv = (const float*)d_in[15]; p.w_co = (const float*)d_in[16]; p.g_mlp = (const float*)d_in[17]; p.w_up = (const float*)d_in[18]; p.w_down = (const float*)d_in[19]; p.g_final = (const float*)d_in[20];
    p.out = (float*)d_out; p.ws = (unsigned char*)d_ws;
#if MK_ONE_LAUNCH
    p.ph_lo = 0; p.ph_hi = N_PHASES;
    void* args[] = {&p};
    hipError_t e = hipLaunchCooperativeKernel((const void*)fwd_kernel, dim3(grid), dim3(NTHR), args, 0, stream);
    if (e != hipSuccess) fprintf(stderr, "cooperative launch failed: %s (grid %d)\n", hipGetErrorString(e), grid);
#else
    for (int k = 0; k < N_PHASES; ++k) { p.ph_lo = k; p.ph_hi = k + 1; hipLaunchKernelGGL(fwd_kernel, dim3(grid), dim3(NTHR), 0, stream, p); }
#endif
}
```

```cpp
#include <hip/hip_runtime.h>
#include <hip/hip_cooperative_groups.h>
#include <cstdio>
#include <cstdint>
namespace cg = cooperative_groups;

#ifndef MK_ONE_LAUNCH
#define MK_ONE_LAUNCH 1
#endif
#ifndef FA_VARIANT
#endif

#define LAS __attribute__((address_space(3)))
typedef unsigned short bf16;
typedef short bf16x8 __attribute__((ext_vector_type(8)));
typedef float f32x4 __attribute__((ext_vector_type(4)));
typedef unsigned u32x4 __attribute__((ext_vector_type(4)));
typedef unsigned u32x2 __attribute__((ext_vector_type(2)));

constexpr int BATCH = 8, SEQ = 4096, M = BATCH * SEQ, DM = 1024, NP = 2304, MEML = 256, MM = BATCH * MEML, FF = 4096;
constexpr int NWAVES = 8, NTHR = NWAVES * 64;
constexpr float EPS = 1e-5f;
constexpr float LOG2E = 1.4426950408889634f;
constexpr float C2 = 0.125f * LOG2E;
constexpr float CQ = 0.0625f * LOG2E;
constexpr int C_QA = 0, C_KA = 512, C_VA = 640, C_QD = 768, C_KD = 1280, C_VD = 1792;

constexpr size_t MiB = 1u << 20;
constexpr size_t WS_CTL = 0;
constexpr size_t WS_WIN = 2 * MiB;
constexpr size_t WS_WOUT = WS_WIN + (size_t)NP * DM * 2;
constexpr size_t WS_WCQ = WS_WOUT + 2 * MiB;
constexpr size_t WS_WCKV = WS_WCQ + 2 * MiB;
constexpr size_t WS_WCO = WS_WCKV + 4 * MiB;
constexpr size_t WS_WUP = WS_WCO + 2 * MiB;
constexpr size_t WS_WDOWN = WS_WUP + 8 * MiB;
constexpr size_t WS_ROPE = 34 * MiB;
constexpr size_t WS_KVM = 42 * MiB;
constexpr size_t WS_MEMN = 50 * MiB;
constexpr size_t WS_SS1 = 54 * MiB, WS_SS2 = 56 * MiB;
constexpr size_t WS_XN = 64 * MiB;
constexpr size_t WS_ODIFF = 128 * MiB;
constexpr size_t WS_PROJ = 256 * MiB;
constexpr size_t WS_ATT = 400 * MiB;
constexpr size_t WS_QC = 256 * MiB;
constexpr size_t WS_OC = 320 * MiB;
constexpr size_t WS_ACT = 256 * MiB;
constexpr size_t WS_END = 512 * MiB;
static_assert(WS_WDOWN + 8 * MiB <= WS_ROPE, "weights fit");

struct Params {
    const float *x, *mem; const int* pos;
    const float *g_mix, *w_in, *sinks, *lq1, *lk1, *lq2, *lk2, *g_diff, *w_out, *g_cross, *g_mem, *w_cq, *w_ckv, *w_co, *g_mlp, *w_up, *w_down, *g_final;
    float* out; unsigned char* ws; int ph_lo, ph_hi;
};

__device__ __forceinline__ unsigned f2bf(float f) { unsigned u = __builtin_bit_cast(unsigned, f); return (u + 0x7fffu + ((u >> 16) & 1u)) >> 16; }
__device__ __forceinline__ unsigned pk2(float lo, float hi) { return f2bf(lo) | (f2bf(hi) << 16); }
__device__ __forceinline__ float bf2f(unsigned h) { return __builtin_bit_cast(float, h << 16); }
__device__ __forceinline__ float bflo(unsigned w) { return __builtin_bit_cast(float, w << 16); }
__device__ __forceinline__ float bfhi(unsigned w) { return __builtin_bit_cast(float, w & 0xffff0000u); }
__device__ __forceinline__ float wave_sum(float v) {
#pragma unroll
    for (int o = 1; o < 64; o <<= 1) v += __shfl_xor(v, o);
    return v;
}
__device__ __forceinline__ float wave_max(float v) {
#pragma unroll
    for (int o = 1; o < 64; o <<= 1) v = fmaxf(v, __shfl_xor(v, o));
    return v;
}
__host__ __device__ __forceinline__ bool col_roped(int n) { return n < C_VA || (n >= C_QD && n < C_VD); }
__host__ __device__ __forceinline__ int phys_of_logical(int nl) {
    if (!col_roped(nl)) return nl;
    const int g = nl & ~63, j = nl & 63; return g + ((j & 31) << 1) + (j >> 5);
}
__device__ __forceinline__ float calc_lambda(const Params& p) {
    float a = 0.f, b = 0.f;
    for (int i = 0; i < 64; ++i) { a += p.lq1[i] * p.lk1[i]; b += p.lq2[i] * p.lk2[i]; }
    return __expf(a) - __expf(b) + 0.2f;
}

__device__ const double INV_FREQ[32] = {
    1.0, 0.7498942093324559, 0.5623413251903491, 0.4216965034285822,
    0.31622776601683794, 0.23713737056616552, 0.1778279410038923, 0.1333521432163324,
    0.1, 0.07498942093324558, 0.05623413251903491, 0.042169650342858224,
    0.03162277660168379, 0.023713737056616554, 0.01778279410038923, 0.01333521432163324,
    0.01, 0.007498942093324558, 0.005623413251903491, 0.004216965034285823,
    0.0031622776601683794, 0.0023713737056616554, 0.0017782794100389228, 0.001333521432163324,
    0.001, 0.0007498942093324559, 0.0005623413251903491, 0.00042169650342858224,
    0.00031622776601683794, 0.00023713737056616554, 0.00017782794100389227, 0.0001333521432163324};

__device__ __forceinline__ void sincos_d(double a, float& c, float& s) {
    const double kd = rint(a * 0.63661977236758134308);
    const int k = (int)kd;
    double r = fma(-kd, 1.57079632679489655800e+00, a); r = fma(-kd, 6.12323399573676603587e-17, r);
    const double r2 = r * r;
    const double sp = r * (1.0 + r2 * (-1.0 / 6.0 + r2 * (1.0 / 120.0 + r2 * (-1.0 / 5040.0 + r2 * (1.0 / 362880.0 + r2 * (-1.0 / 39916800.0 + r2 * (1.0 / 6227020800.0)))))));
    const double cp = 1.0 + r2 * (-0.5 + r2 * (1.0 / 24.0 + r2 * (-1.0 / 720.0 + r2 * (1.0 / 40320.0 + r2 * (-1.0 / 3628800.0 + r2 * (1.0 / 479001600.0 + r2 * (-1.0 / 87178291200.0)))))));
    const int q = k & 3;
    const double ss = (q == 0) ? sp : (q == 1) ? cp : (q == 2) ? -sp : -cp;
    const double cc = (q == 0) ? cp : (q == 1) ? -sp : (q == 2) ? -cp : sp;
    c = (float)cc; s = (float)ss;
}

__device__ __forceinline__ void transpose_item(const float* W, int K, int N, const float* g, bool perm, bf16* WT, LAS float* scr, int item, int lane) {
    const int nblk = N / 32, kb = item / nblk, nb = item % nblk, k0 = 64 * kb, n0 = 32 * nb;
#pragma unroll 8
    for (int i = 0; i < 32; ++i) { const int kk = 2 * i + (lane >> 5); const float gs = g ? g[k0 + kk] : 1.f; scr[kk * 33 + (lane & 31)] = gs * W[(size_t)(k0 + kk) * N + n0 + (lane & 31)]; }
    asm volatile("s_waitcnt lgkmcnt(0)" ::: "memory");
    const int c = lane & 7;
#pragma unroll
    for (int j = 0; j < 4; ++j) { const int n = (lane >> 3) + 8 * j; const LAS float* s = scr + (8 * c) * 33 + n;
        u32x4 o; o.x = pk2(s[0 * 33], s[1 * 33]); o.y = pk2(s[2 * 33], s[3 * 33]); o.z = pk2(s[4 * 33], s[5 * 33]); o.w = pk2(s[6 * 33], s[7 * 33]);
        const int nl = n0 + n, np = perm ? phys_of_logical(nl) : nl;
        *(u32x4*)(WT + (size_t)np * K + k0 + 8 * c) = o; }
    asm volatile("s_waitcnt lgkmcnt(0)" ::: "memory");
}
__device__ __forceinline__ void rms_row_to_bf16(const float* xrow, const float* g, bf16* orow, int lane) {
    const f32x4* xr = (const f32x4*)xrow + lane;
    f32x4 v[4]; float s = 0.f;
#pragma unroll
    for (int j = 0; j < 4; ++j) { v[j] = xr[64 * j]; s += (v[j].x * v[j].x + v[j].y * v[j].y) + (v[j].z * v[j].z + v[j].w * v[j].w); }
    const float rstd = 1.0f / sqrtf(wave_sum(s) * (1.f / DM) + EPS);
    u32x2* o8 = (u32x2*)orow + lane;
#pragma unroll
    for (int j = 0; j < 4; ++j) {
        f32x4 gg = (f32x4){1.f, 1.f, 1.f, 1.f}; if (g) gg = ((const f32x4*)g)[lane + 64 * j];
        u32x2 w; w.x = pk2(v[j].x * rstd * gg.x, v[j].y * rstd * gg.y); w.y = pk2(v[j].z * rstd * gg.z, v[j].w * rstd * gg.w); o8[64 * j] = w; }
}
__device__ __forceinline__ void p0_prologue(const Params& p, LAS unsigned char* lds, int bid, int nblk, int tid) {
    const int wave = tid >> 6, lane = tid & 63;
    LAS float* scr = (LAS float*)(lds + wave * 8704);
    const int gw = bid * NWAVES + wave, NGW = nblk * NWAVES;
    unsigned char* ws = p.ws;
    constexpr int I_IN = (DM / 64) * (NP / 32), I_SQ = (DM / 64) * (DM / 32), I_KV = (DM / 64) * (2048 / 32), I_UP = (DM / 64) * (FF / 32), I_DN = (FF / 64) * (DM / 32);
    constexpr int NITEMS = I_IN + 3 * I_SQ + I_KV + I_UP + I_DN;
    for (int it = gw; it < NITEMS; it += NGW) {
        int r = it;
        if (r < I_IN) { transpose_item(p.w_in, DM, NP, p.g_mix, true, (bf16*)(ws + WS_WIN), scr, r, lane); continue; } r -= I_IN;
        if (r < I_SQ) { transpose_item(p.w_out, DM, DM, nullptr, false, (bf16*)(ws + WS_WOUT), scr, r, lane); continue; } r -= I_SQ;
        if (r < I_SQ) { transpose_item(p.w_cq, DM, DM, p.g_cross, false, (bf16*)(ws + WS_WCQ), scr, r, lane); continue; } r -= I_SQ;
        if (r < I_KV) { transpose_item(p.w_ckv, DM, 2048, nullptr, false, (bf16*)(ws + WS_WCKV), scr, r, lane); continue; } r -= I_KV;
        if (r < I_SQ) { transpose_item(p.w_co, DM, DM, nullptr, false, (bf16*)(ws + WS_WCO), scr, r, lane); continue; } r -= I_SQ;
        if (r < I_UP) { transpose_item(p.w_up, DM, FF, p.g_mlp, false, (bf16*)(ws + WS_WUP), scr, r, lane); continue; } r -= I_UP;
        transpose_item(p.w_down, FF, DM, nullptr, false, (bf16*)(ws + WS_WDOWN), scr, r, lane);
    }
    for (int m = gw; m < M; m += NGW) rms_row_to_bf16(p.x + (size_t)m * DM, nullptr, (bf16*)(ws + WS_XN) + (size_t)m * DM, lane);
    for (int m = gw; m < MM; m += NGW) rms_row_to_bf16(p.mem + (size_t)m * DM, p.g_mem, (bf16*)(ws + WS_MEMN) + (size_t)m * DM, lane);
    float2* rope = (float2*)(ws + WS_ROPE);
    for (int i = bid * NTHR + tid; i < M * 32; i += nblk * NTHR) {
        const int row = i >> 5, d = i & 31; float c, s; sincos_d((double)p.pos[row] * INV_FREQ[d], c, s); rope[i] = make_float2(c, s); }
}

namespace pg8 {
#define PG8_LAS __attribute__((address_space(3)))
typedef unsigned short bf16_t;
typedef short bf16x8 __attribute__((ext_vector_type(8)));
typedef float f32x4 __attribute__((ext_vector_type(4)));
typedef unsigned u32x4 __attribute__((ext_vector_type(4)));
typedef unsigned u32x2 __attribute__((ext_vector_type(2)));
constexpr int BM = 256, BK = 64, HALF = 128, HTB = HALF * BK * 2  , STAGE_BYTES = 8 * HTB, NXCD = 8, WGM = 8;

__host__ __device__ __forceinline__ int lds_byte(int r, int c) { const int st = (r >> 4) * 2 + (c >> 5), rr = r & 15, cc = c & 31, ob = rr * 64 + cc * 2; return st * 1024 + (ob ^ (((ob >> 9) & 1) << 5)); }
__host__ __device__ __forceinline__ void stage_rc(int b, int& R, int& C) { const int st = b / 1024, sb = b % 1024, swz = sb ^ (((sb >> 9) & 1) << 5); R = (st >> 1) * 16 + swz / 64; C = (st & 1) * 32 + (swz % 64) / 2; }
__host__ __device__ __forceinline__ int perm32(int rho) { const int n = rho >> 4, i = rho & 15; return 8 * (i >> 2) + 4 * n + (i & 3); }

struct Unit { int pm, pn, alt; };
struct Gemm { const bf16_t* A; const bf16_t* Bt; const bf16_t* A2; const bf16_t* Bt2; int K; };

struct StaticOrder {
    int nM, nN, nwg, G, c;
    __host__ __device__ void init(int M_, int N_, int G_, int c_) { nM = M_ / BM; nN = N_ / BM; nwg = nM * nN; G = G_; c = c_; }
    __host__ __device__ bool map(long L, Unit& u) const {
        if (L >= nwg) return false;
        int wgid = (int)L; { const int q = nwg / NXCD, r = nwg % NXCD, xcd = wgid % NXCD, off = wgid / NXCD; wgid = (xcd < r ? xcd * (q + 1) : r * (q + 1) + (xcd - r) * q) + off; }
        const int nig = WGM * nN, gid = wgid / nig, fm = gid * WGM, gsz = (nM - fm) < WGM ? (nM - fm) : WGM;
        u.pm = fm + ((wgid % nig) % gsz); u.pn = (wgid % nig) / gsz; u.alt = 0; return true;
    }
    __host__ __device__ bool next(int i, Unit& u) const { return map((long)i * G + c, u); }
    __device__ __forceinline__ void a_ready(const Unit&) const {}
    __device__ __forceinline__ void done(const Unit&) const {}
};
struct TwoOrder : StaticOrder {
    int n2M, n2N;
    __host__ __device__ bool next(int i, Unit& u) const {
        const long L = (long)i * G + c;
        if (L < nwg) return map(L, u);
        const int r = (int)(L - nwg); if (r >= n2M * n2N) return false;
        u.pm = r % n2M; u.pn = r / n2M; u.alt = 1; return true;
    }
};
__device__ __forceinline__ unsigned cvt_pk_bf16(float lo, float hi) { unsigned r; asm volatile("v_cvt_pk_bf16_f32 %0, %1, %2" : "=v"(r) : "v"(lo), "v"(hi)); return r; }

__device__ __forceinline__ float rstd_ss(const float* ss, int row) {
    const f32x4* s4 = (const f32x4*)(ss + (size_t)row * 16); float t = 0.f;
#pragma unroll
    for (int i = 0; i < 4; ++i) { const f32x4 v = s4[i]; t += (v.x + v.y) + (v.z + v.w); }
    return 1.0f / sqrtf(t * (1.f / DM) + EPS);
}
struct EpiProj {
    static constexpr bool PERM = true, AFTER_DRAIN = false;
    bf16_t* proj; bf16_t* kvm; const float* rope;
    __device__ __forceinline__ void operator()(const f32x4 (&acc)[2][2][4][2], const Unit& u, int wr, int wc, int fr, int fq) const {
        const int row0 = u.pm * BM + wr * 64 + fr, col0 = u.pn * BM + wc * 32 + 8 * fq;
        if (u.alt) {
#pragma unroll
            for (int ai = 0; ai < 2; ++ai)
#pragma unroll
                for (int m = 0; m < 4; ++m) { bf16_t* rowp = kvm + (size_t)(row0 + ai * HALF + m * 16) * 2048 + col0;
#pragma unroll
                    for (int bj = 0; bj < 2; ++bj) { const f32x4 v0 = acc[ai][bj][m][0], v1 = acc[ai][bj][m][1];
                        u32x4 w; w.x = cvt_pk_bf16(v0[0], v0[1]); w.y = cvt_pk_bf16(v0[2], v0[3]); w.z = cvt_pk_bf16(v1[0], v1[1]); w.w = cvt_pk_bf16(v1[2], v1[3]);
                        *(u32x4*)(rowp + bj * HALF) = w; } }
            return;
        }
        const int d0 = ((wc & 1) * 32 + 8 * fq) >> 1;
#pragma unroll
        for (int ai = 0; ai < 2; ++ai)
#pragma unroll
            for (int m = 0; m < 4; ++m) { const int row = row0 + ai * HALF + m * 16;
                const f32x4 cs0 = *(const f32x4*)(rope + (size_t)row * 64 + 2 * d0), cs1 = *(const f32x4*)(rope + (size_t)row * 64 + 2 * d0 + 4);
#pragma unroll
                for (int bj = 0; bj < 2; ++bj) { const int cb = u.pn * BM + bj * HALF;
                    const bool roped = col_roped(cb); const float sc = (cb < C_KA || (cb >= C_QD && cb < C_KD)) ? C2 : 1.f;
                    f32x4 v0 = acc[ai][bj][m][0], v1 = acc[ai][bj][m][1];
                    if (roped) {
                        const f32x4 a = v0, b = v1;
                        v0[0] = a[0] * cs0[0] - a[1] * cs0[1]; v0[1] = a[1] * cs0[0] + a[0] * cs0[1];
                        v0[2] = a[2] * cs0[2] - a[3] * cs0[3]; v0[3] = a[3] * cs0[2] + a[2] * cs0[3];
                        v1[0] = b[0] * cs1[0] - b[1] * cs1[1]; v1[1] = b[1] * cs1[0] + b[0] * cs1[1];
                        v1[2] = b[2] * cs1[2] - b[3] * cs1[3]; v1[3] = b[3] * cs1[2] + b[2] * cs1[3];
                    }
                    v0 = v0 * sc; v1 = v1 * sc;
                    u32x4 w; w.x = cvt_pk_bf16(v0[0], v0[1]); w.y = cvt_pk_bf16(v0[2], v0[3]); w.z = cvt_pk_bf16(v1[0], v1[1]); w.w = cvt_pk_bf16(v1[2], v1[3]);
                    *(u32x4*)(proj + (size_t)row * NP + col0 + bj * HALF) = w; } }
    }
};
struct EpiRes {
    static constexpr bool PERM = false, AFTER_DRAIN = false;
    const float* xi; float* xo; bf16_t* xb; float* ss;
    __device__ __forceinline__ void operator()(const f32x4 (&acc)[2][2][4][2], const Unit& u, int wr, int wc, int fr, int fq) const {
        const int row0 = u.pm * BM + wr * 64 + fr, col0 = u.pn * BM + wc * 32 + 4 * fq;
#pragma unroll
        for (int ai = 0; ai < 2; ++ai)
#pragma unroll
            for (int m = 0; m < 4; ++m) { const int row = row0 + ai * HALF + m * 16; const size_t off = (size_t)row * DM + col0; float q = 0.f;
#pragma unroll
                for (int bj = 0; bj < 2; ++bj)
#pragma unroll
                    for (int n = 0; n < 2; ++n) { const size_t c = off + bj * HALF + n * 16; const f32x4 r = *(const f32x4*)(xi + c) + acc[ai][bj][m][n];
                        *(f32x4*)(xo + c) = r; q += (r[0] * r[0] + r[1] * r[1]) + (r[2] * r[2] + r[3] * r[3]);
                        if (xb) { u32x2 w; w.x = cvt_pk_bf16(r[0], r[1]); w.y = cvt_pk_bf16(r[2], r[3]); *(u32x2*)(xb + c) = w; } }
                q += __shfl_xor(q, 16); q += __shfl_xor(q, 32);
                if (fq == 0) ss[(size_t)row * 16 + u.pn * 4 + wc] = q;
                if (m & 1) asm volatile("" ::: "memory"); }
    }
};
template <int ACT> struct EpiScaleBf16 {
    static constexpr bool PERM = true, AFTER_DRAIN = false;
    bf16_t* O; int ldc; const float* ss; float mul;
    __device__ __forceinline__ void operator()(const f32x4 (&acc)[2][2][4][2], const Unit& u, int wr, int wc, int fr, int fq) const {
        const int row0 = u.pm * BM + wr * 64 + fr, col0 = u.pn * BM + wc * 32 + 8 * fq;
#pragma unroll
        for (int ai = 0; ai < 2; ++ai)
#pragma unroll
            for (int m = 0; m < 4; ++m) { const int row = row0 + ai * HALF + m * 16; const float rs = rstd_ss(ss, row) * mul; bf16_t* rowp = O + (size_t)row * ldc + col0;
#pragma unroll
                for (int bj = 0; bj < 2; ++bj) { f32x4 v0 = acc[ai][bj][m][0] * rs, v1 = acc[ai][bj][m][1] * rs;
                    if (ACT == 1) {
#pragma unroll
                        for (int e = 0; e < 4; ++e) { const float a = fmaxf(v0[e], 0.f), b = fmaxf(v1[e], 0.f); v0[e] = a * a; v1[e] = b * b; } }
                    u32x4 w; w.x = cvt_pk_bf16(v0[0], v0[1]); w.y = cvt_pk_bf16(v0[2], v0[3]); w.z = cvt_pk_bf16(v1[0], v1[1]); w.w = cvt_pk_bf16(v1[2], v1[3]);
                    *(u32x4*)(rowp + bj * HALF) = w; } }
    }
};

template <class Epi, class Sched, bool ALIGN_EPI = false, bool SP2 = false>
__device__ __forceinline__ void gemm_phase(PG8_LAS unsigned char* lds, const Gemm g, const Sched& S, const Epi& E) {
    const int tid = threadIdx.x, wid = __builtin_amdgcn_readfirstlane(tid >> 6), lane = tid & 63, wr = wid >> 2, wc = wid & 3, fr = lane & 15, fq = lane >> 4;
    const int K = g.K, nt = K / BK;
    unsigned voffA[2], voffB[2];
#pragma unroll
    for (int i = 0; i < 2; ++i) { int R, C; stage_rc(tid * 16 + i * 8192, R, C); const int Rb = Epi::PERM ? ((R & ~31) + perm32(R & 31)) : R;
        voffA[i] = (unsigned)(R * K + C) * 2u; voffB[i] = (unsigned)(Rb * K + C) * 2u; }
    const size_t kstep = (size_t)(BK * 2);
    const size_t hstep = (size_t)HALF * K * 2;
    const size_t tstep = 2 * hstep;
    const unsigned ldsw = (unsigned)wid * 1024u;
    const int aoff = lds_byte(wr * 64 + fr, fq * 8), boff = lds_byte(wc * 32 + fr, fq * 8);
#define PG8_SA(b, h) (((b) * 2 + (h)) * HTB)
#define PG8_SB(b, h) ((4 + (b) * 2 + (h)) * HTB)
#define PG8_STAGE(bufoff, gbase, voff) do { _Pragma("unroll") for (int _i = 0; _i < 2; ++_i) \
        __builtin_amdgcn_global_load_lds((const unsigned*)((const char*)(gbase) + (voff)[_i]), (PG8_LAS unsigned*)(lds + (bufoff) + ldsw + _i * 8192), 16, 0, 0); } while (0)
#define PG8_LDA(dst, b, h) do { _Pragma("unroll") for (int m = 0; m < 4; ++m) _Pragma("unroll") for (int k = 0; k < 2; ++k) dst[m][k] = *(const PG8_LAS bf16x8*)(lds + PG8_SA(b, h) + aoff + m * 2048 + k * 1024); } while (0)
#define PG8_LDB(dst, b, h) do { _Pragma("unroll") for (int n = 0; n < 2; ++n) _Pragma("unroll") for (int k = 0; k < 2; ++k) dst[n][k] = *(const PG8_LAS bf16x8*)(lds + PG8_SB(b, h) + boff + n * 2048 + k * 1024); } while (0)
#define PG8_MMA(ai, bj, At, Bt) do { __builtin_amdgcn_s_setprio(1); _Pragma("unroll") for (int m = 0; m < 4; ++m) _Pragma("unroll") for (int n = 0; n < 2; ++n) _Pragma("unroll") for (int k = 0; k < 2; ++k) \
        acc[ai][bj][m][n] = __builtin_amdgcn_mfma_f32_16x16x32_bf16(Bt[n][k], At[m][k], acc[ai][bj][m][n], 0, 0, 0); __builtin_amdgcn_s_setprio(0); } while (0)
#define PG8_WAIT_V(n) asm volatile("s_waitcnt vmcnt(" #n ")" ::: "memory")
#define PG8_WAIT_L(n) asm volatile("s_waitcnt lgkmcnt(" #n ")" ::: "memory")
#define PG8_BAR __builtin_amdgcn_s_barrier()
#define PG8_SCHED __builtin_amdgcn_sched_barrier(0)
    Unit cur, nxt; int ui = 0;
    if (!S.next(0, cur)) return;
    f32x4 acc[2][2][4][2];
#pragma unroll
    for (int a = 0; a < 2; ++a)
#pragma unroll
        for (int b = 0; b < 2; ++b)
#pragma unroll
            for (int m = 0; m < 4; ++m)
#pragma unroll
                for (int n = 0; n < 2; ++n) acc[a][b][m][n] = (f32x4){0.f, 0.f, 0.f, 0.f};
    bf16x8 At[4][2], B0[2][2], B1[2][2];
    const char* cA = (const char*)(cur.alt ? g.A2 : g.A) + (size_t)cur.pm * tstep; const char* cB = (const char*)(cur.alt ? g.Bt2 : g.Bt) + (size_t)cur.pn * tstep;
    S.a_ready(cur);
    if constexpr (SP2) {
        PG8_STAGE(PG8_SB(0, 0), cB, voffB); PG8_STAGE(PG8_SB(0, 1), cB + hstep, voffB); PG8_STAGE(PG8_SA(0, 0), cA, voffA); PG8_STAGE(PG8_SA(0, 1), cA + hstep, voffA);
        if (wr == 1) PG8_BAR;
        PG8_WAIT_V(2); PG8_BAR;
        PG8_STAGE(PG8_SB(1, 0), cB + kstep, voffB); PG8_STAGE(PG8_SA(1, 0), cA + kstep, voffA); PG8_STAGE(PG8_SB(1, 1), cB + hstep + kstep, voffB);
        PG8_WAIT_V(6); PG8_BAR;
    } else {
        PG8_STAGE(PG8_SB(0, 0), cB, voffB); PG8_STAGE(PG8_SA(0, 0), cA, voffA); PG8_STAGE(PG8_SB(0, 1), cB + hstep, voffB); PG8_STAGE(PG8_SA(0, 1), cA + hstep, voffA);
        if (wr == 1) PG8_BAR;
        PG8_WAIT_V(4); PG8_BAR;
        PG8_STAGE(PG8_SB(1, 0), cB + kstep, voffB); PG8_STAGE(PG8_SA(1, 0), cA + kstep, voffA); PG8_STAGE(PG8_SB(1, 1), cB + hstep + kstep, voffB);
        PG8_WAIT_V(6); PG8_BAR;
    }
    for (;;) {
        const bool has_next = S.next(ui + 1, nxt);
        const char* nA = has_next ? (const char*)(nxt.alt ? g.A2 : g.A) + (size_t)nxt.pm * tstep : cA; const char* nB = has_next ? (const char*)(nxt.alt ? g.Bt2 : g.Bt) + (size_t)nxt.pn * tstep : cB;
        for (int t = 0; t < nt; t += 2) {
            const bool last = (t == nt - 2);
            const char* a1 = cA + (size_t)(t + 1) * kstep;
            const char* a2 = last ? nA : cA + (size_t)(t + 2) * kstep; const char* b2 = last ? nB : cB + (size_t)(t + 2) * kstep;
            const char* a3 = a2 + kstep; const char* b3 = b2 + kstep;
            if (last && has_next) S.a_ready(nxt);
            if constexpr (SP2) {
            PG8_LDB(B0, 0, 0); PG8_LDB(B1, 0, 1); PG8_SCHED; PG8_LDA(At, 0, 0); PG8_STAGE(PG8_SA(1, 1), a1 + hstep, voffA);
            PG8_WAIT_V(8); PG8_WAIT_L(0); PG8_BAR; PG8_MMA(0, 0, At, B0); PG8_MMA(0, 1, At, B1); PG8_BAR; PG8_SCHED;
            PG8_LDA(At, 0, 1); PG8_STAGE(PG8_SB(0, 0), b2, voffB); PG8_STAGE(PG8_SB(0, 1), b2 + hstep, voffB); PG8_STAGE(PG8_SA(0, 0), a2, voffA);
            PG8_WAIT_V(8); PG8_WAIT_L(0); PG8_BAR; PG8_MMA(1, 0, At, B0); PG8_MMA(1, 1, At, B1); PG8_BAR; PG8_SCHED;
            PG8_LDB(B0, 1, 0); PG8_LDB(B1, 1, 1); PG8_SCHED; PG8_LDA(At, 1, 0); PG8_STAGE(PG8_SA(0, 1), a2 + hstep, voffA);
            PG8_WAIT_V(8); PG8_WAIT_L(0); PG8_BAR; PG8_MMA(0, 0, At, B0); PG8_MMA(0, 1, At, B1); PG8_BAR; PG8_SCHED;
            PG8_LDA(At, 1, 1); PG8_STAGE(PG8_SB(1, 0), b3, voffB); PG8_STAGE(PG8_SB(1, 1), b3 + hstep, voffB); PG8_STAGE(PG8_SA(1, 0), a3, voffA);
            PG8_WAIT_V(8); PG8_WAIT_L(0); PG8_BAR; PG8_MMA(1, 0, At, B0); PG8_MMA(1, 1, At, B1); PG8_BAR; PG8_SCHED;
            } else {
            PG8_LDB(B0, 0, 0); PG8_SCHED; PG8_LDA(At, 0, 0); PG8_STAGE(PG8_SA(1, 1), a1 + hstep, voffA);
            PG8_WAIT_L(8); PG8_BAR; PG8_WAIT_L(0); PG8_MMA(0, 0, At, B0); PG8_BAR; PG8_SCHED;
            PG8_LDB(B1, 0, 1); PG8_STAGE(PG8_SB(0, 0), b2, voffB);
            PG8_BAR; PG8_WAIT_L(0); PG8_MMA(0, 1, At, B1); PG8_BAR;
            PG8_LDA(At, 0, 1); PG8_STAGE(PG8_SA(0, 0), a2, voffA);
            PG8_BAR; PG8_WAIT_L(0); PG8_MMA(1, 0, At, B0); PG8_BAR; PG8_SCHED;
            PG8_STAGE(PG8_SB(0, 1), b2 + hstep, voffB);
            PG8_WAIT_V(6); PG8_BAR; PG8_MMA(1, 1, At, B1); PG8_BAR;
            PG8_LDB(B0, 1, 0); PG8_SCHED; PG8_LDA(At, 1, 0); PG8_STAGE(PG8_SA(0, 1), a2 + hstep, voffA);
            PG8_WAIT_L(8); PG8_BAR; PG8_WAIT_L(0); PG8_MMA(0, 0, At, B0); PG8_BAR; PG8_SCHED;
            PG8_LDB(B1, 1, 1); PG8_STAGE(PG8_SB(1, 0), b3, voffB);
            PG8_BAR; PG8_WAIT_L(0); PG8_MMA(0, 1, At, B1); PG8_BAR;
            PG8_LDA(At, 1, 1); PG8_STAGE(PG8_SA(1, 0), a3, voffA);
            PG8_BAR; PG8_WAIT_L(0); PG8_MMA(1, 0, At, B0); PG8_BAR; PG8_SCHED;
            PG8_STAGE(PG8_SB(1, 1), b3 + hstep, voffB);
            PG8_WAIT_V(6); PG8_BAR; PG8_MMA(1, 1, At, B1); PG8_BAR;
            }
        }
        if constexpr (ALIGN_EPI) { if (wr == 0) PG8_BAR; }
        if constexpr (!Epi::AFTER_DRAIN) { E(acc, cur, wr, wc, fr, fq); S.done(cur); }
        if (!has_next) break;
#pragma unroll
        for (int a = 0; a < 2; ++a)
#pragma unroll
            for (int b = 0; b < 2; ++b)
#pragma unroll
                for (int m = 0; m < 4; ++m)
#pragma unroll
                    for (int n = 0; n < 2; ++n) acc[a][b][m][n] = (f32x4){0.f, 0.f, 0.f, 0.f};
        cur = nxt; cA = nA; cB = nB; ++ui;
        if constexpr (ALIGN_EPI) { if (wr == 1) PG8_BAR; }
    }
    PG8_WAIT_V(0);
    if constexpr (!ALIGN_EPI) { if (wr == 0) PG8_BAR; }
    PG8_BAR;
    if constexpr (Epi::AFTER_DRAIN) { E.fused(acc, cur, wr, wc, fr, fq, lds, wid, lane); S.done(cur); }
#undef PG8_SA
#undef PG8_SB
#undef PG8_STAGE
#undef PG8_LDA
#undef PG8_LDB
#undef PG8_MMA
#undef PG8_WAIT_V
#undef PG8_WAIT_L
#undef PG8_BAR
#undef PG8_SCHED
}
}
__device__ __forceinline__ void swa_naive(const Params& p, int bid, int nblk, int tid) {
    const bf16* proj = (const bf16*)(p.ws + WS_PROJ); bf16* att = (bf16*)(p.ws + WS_ATT);
    for (int base = bid * NTHR; base < M * 8; base += nblk * NTHR) {
        const int idx = base + tid, hq = idx >> 15, row = idx & (M - 1), t = row & (SEQ - 1), kvh = hq >> 2;
        float q[64], o[64];
        { const u32x4* q4 = (const u32x4*)(proj + (size_t)row * NP + C_QA + hq * 64);
#pragma unroll
          for (int i = 0; i < 8; ++i) { const u32x4 w = q4[i]; q[8 * i] = bflo(w.x); q[8 * i + 1] = bfhi(w.x); q[8 * i + 2] = bflo(w.y); q[8 * i + 3] = bfhi(w.y); q[8 * i + 4] = bflo(w.z); q[8 * i + 5] = bfhi(w.z); q[8 * i + 6] = bflo(w.w); q[8 * i + 7] = bfhi(w.w); } }
#pragma unroll
        for (int d = 0; d < 64; ++d) o[d] = 0.f;
        float m = p.sinks[hq] * LOG2E, l = 1.f;
        const int nk = (t < 127 ? t : 127) + 1;
        for (int j = 0; j < nk; ++j) {
            const size_t kr = (size_t)(row - j) * NP;
            const u32x4* k4 = (const u32x4*)(proj + kr + C_KA + kvh * 64); const u32x4* v4 = (const u32x4*)(proj + kr + C_VA + kvh * 64);
            float s = 0.f;
#pragma unroll
            for (int i = 0; i < 8; ++i) { const u32x4 w = k4[i]; s += q[8 * i] * bflo(w.x) + q[8 * i + 1] * bfhi(w.x) + q[8 * i + 2] * bflo(w.y) + q[8 * i + 3] * bfhi(w.y) + q[8 * i + 4] * bflo(w.z) + q[8 * i + 5] * bfhi(w.z) + q[8 * i + 6] * bflo(w.w) + q[8 * i + 7] * bfhi(w.w); }
            const float mn = fmaxf(m, s), a = exp2f(m - mn), pp = exp2f(s - mn); l = l * a + pp; m = mn;
#pragma unroll
            for (int i = 0; i < 8; ++i) { const u32x4 w = v4[i];
                o[8 * i] = o[8 * i] * a + pp * bflo(w.x); o[8 * i + 1] = o[8 * i + 1] * a + pp * bfhi(w.x); o[8 * i + 2] = o[8 * i + 2] * a + pp * bflo(w.y); o[8 * i + 3] = o[8 * i + 3] * a + pp * bfhi(w.y);
                o[8 * i + 4] = o[8 * i + 4] * a + pp * bflo(w.z); o[8 * i + 5] = o[8 * i + 5] * a + pp * bfhi(w.z); o[8 * i + 6] = o[8 * i + 6] * a + pp * bflo(w.w); o[8 * i + 7] = o[8 * i + 7] * a + pp * bfhi(w.w); }
        }
        const float rl = 1.f / l;
        u32x4* o4 = (u32x4*)(att + (size_t)row * DM + hq * 64);
#pragma unroll
        for (int i = 0; i < 8; ++i) { u32x4 w; w.x = pk2(o[8 * i] * rl, o[8 * i + 1] * rl); w.y = pk2(o[8 * i + 2] * rl, o[8 * i + 3] * rl); w.z = pk2(o[8 * i + 4] * rl, o[8 * i + 5] * rl); w.w = pk2(o[8 * i + 6] * rl, o[8 * i + 7] * rl); o4[i] = w; }
    }
}
__device__ __forceinline__ void diff_naive(const Params& p, int bid, int nblk, int tid) {
    const bf16* proj = (const bf16*)(p.ws + WS_PROJ); float* od = (float*)(p.ws + WS_ODIFF);
    for (int base = bid * NTHR; base < M * 16; base += nblk * NTHR) {
        const int idx = base + tid, sel = __builtin_amdgcn_readfirstlane(idx >> 15), row = idx & (M - 1), t = row & (SEQ - 1);
        const int hc = sel >> 1, half = sel & 1, h = hc >> 1, c = hc & 1;
        const int b = __builtin_amdgcn_readfirstlane(row >> 12);
        const int tmax = __builtin_amdgcn_readfirstlane((row | 63) & (SEQ - 1));
        float q[64], o[64];
        { const u32x4* q4 = (const u32x4*)(proj + (size_t)row * NP + C_QD + hc * 64);
#pragma unroll
          for (int i = 0; i < 8; ++i) { const u32x4 w = q4[i]; q[8 * i] = bflo(w.x); q[8 * i + 1] = bfhi(w.x); q[8 * i + 2] = bflo(w.y); q[8 * i + 3] = bfhi(w.y); q[8 * i + 4] = bflo(w.z); q[8 * i + 5] = bfhi(w.z); q[8 * i + 6] = bflo(w.w); q[8 * i + 7] = bfhi(w.w); } }
#pragma unroll
        for (int d = 0; d < 64; ++d) o[d] = 0.f;
        float m = -1e30f, l = 0.f;
        for (int kt = 0; kt <= tmax; ++kt) {
            const size_t kr = (size_t)(b * SEQ + kt) * NP;
            const u32x4* k4 = (const u32x4*)(proj + kr + C_KD + hc * 64); const u32x4* v4 = (const u32x4*)(proj + kr + C_VD + h * 128 + half * 64);
            float s = 0.f;
#pragma unroll
            for (int i = 0; i < 8; ++i) { const u32x4 w = k4[i]; s += q[8 * i] * bflo(w.x) + q[8 * i + 1] * bfhi(w.x) + q[8 * i + 2] * bflo(w.y) + q[8 * i + 3] * bfhi(w.y) + q[8 * i + 4] * bflo(w.z) + q[8 * i + 5] * bfhi(w.z) + q[8 * i + 6] * bflo(w.w) + q[8 * i + 7] * bfhi(w.w); }
            if (kt > t) s = -1e30f;
            const float mn = fmaxf(m, s), a = exp2f(m - mn), pp = (kt > t) ? 0.f : exp2f(s - mn); l = l * a + pp; m = mn;
#pragma unroll
            for (int i = 0; i < 8; ++i) { const u32x4 w = v4[i];
                o[8 * i] = o[8 * i] * a + pp * bflo(w.x); o[8 * i + 1] = o[8 * i + 1] * a + pp * bfhi(w.x); o[8 * i + 2] = o[8 * i + 2] * a + pp * bflo(w.y); o[8 * i + 3] = o[8 * i + 3] * a + pp * bfhi(w.y);
                o[8 * i + 4] = o[8 * i + 4] * a + pp * bflo(w.z); o[8 * i + 5] = o[8 * i + 5] * a + pp * bfhi(w.z); o[8 * i + 6] = o[8 * i + 6] * a + pp * bflo(w.w); o[8 * i + 7] = o[8 * i + 7] * a + pp * bfhi(w.w); }
        }
        const float rl = 1.f / l;
        f32x4* o4 = (f32x4*)(od + ((size_t)c * M + row) * 512 + h * 128 + half * 64);
#pragma unroll
        for (int i = 0; i < 16; ++i) o4[i] = (f32x4){o[4 * i] * rl, o[4 * i + 1] * rl, o[4 * i + 2] * rl, o[4 * i + 3] * rl};
    }
}
__device__ __forceinline__ void diff_combine_naive(const Params& p, int gw, int ngw, int lane) {
    const float* od = (const float*)(p.ws + WS_ODIFF); bf16* att = (bf16*)(p.ws + WS_ATT);
    const float lam = calc_lambda(p);
    for (int m = gw; m < M; m += ngw) {
#pragma unroll
        for (int h = 0; h < 4; ++h) {
            const float2 a = *(const float2*)(od + (size_t)m * 512 + h * 128 + 2 * lane), b = *(const float2*)(od + ((size_t)M + m) * 512 + h * 128 + 2 * lane);
            const float v0 = a.x - lam * b.x, v1 = a.y - lam * b.y;
            const float rstd = 1.0f / sqrtf(wave_sum(v0 * v0 + v1 * v1) * (1.f / 128.f) + EPS);
            const float2 g = *(const float2*)(p.g_diff + 2 * lane);
            *(unsigned*)(att + (size_t)m * DM + 512 + h * 128 + 2 * lane) = pk2(v0 * rstd * g.x * 0.8f, v1 * rstd * g.y * 0.8f);
        }
    }
}
__device__ __forceinline__ void cross_naive(const Params& p, LAS unsigned char* lds, int bid, int nblk, int tid) {
    const bf16* qc = (const bf16*)(p.ws + WS_QC); const bf16* kvm = (const bf16*)(p.ws + WS_KVM); bf16* oc = (bf16*)(p.ws + WS_OC);
    const int sub = tid >> 8, tm = tid & 255, w4 = (tid >> 6) & 3, lane = tid & 63;
    LAS float* qs = (LAS float*)lds + sub * 256; LAS float* ps = (LAS float*)lds + 512 + sub * 256; LAS float* red = (LAS float*)lds + 1024 + sub * 8;
    for (int i2 = bid; i2 < M * 2; i2 += nblk) {
        const int item = i2 * 2 + sub, row = item >> 2, head = item & 3, b = row >> 12;
        qs[tm] = bf2f(qc[(size_t)row * DM + head * 256 + tm]);
        __syncthreads();
        const u32x4* k4 = (const u32x4*)(kvm + (size_t)(b * MEML + tm) * 2048 + head * 256);
        float s = 0.f;
        for (int i = 0; i < 32; ++i) { const u32x4 w = k4[i]; const LAS float* qq = qs + 8 * i;
            s += qq[0] * bflo(w.x) + qq[1] * bfhi(w.x) + qq[2] * bflo(w.y) + qq[3] * bfhi(w.y) + qq[4] * bflo(w.z) + qq[5] * bfhi(w.z) + qq[6] * bflo(w.w) + qq[7] * bfhi(w.w); }
        float mx = wave_max(s); if (lane == 0) red[w4] = mx;
        __syncthreads();
        mx = fmaxf(fmaxf(red[0], red[1]), fmaxf(red[2], red[3]));
        const float e = exp2f(s - mx); ps[tm] = e;
        float sm = wave_sum(e); if (lane == 0) red[4 + w4] = sm;
        __syncthreads();
        sm = (red[4] + red[5]) + (red[6] + red[7]);
        const bf16* vp = kvm + (size_t)(b * MEML) * 2048 + 1024 + head * 256 + tm;
        float o = 0.f;
        for (int mm = 0; mm < MEML; ++mm) o += ps[mm] * bf2f(vp[(size_t)mm * 2048]);
        oc[(size_t)row * DM + head * 256 + tm] = (bf16)f2bf(o / sm);
        __syncthreads();
    }
}

namespace fa {
typedef short bf16x8 __attribute__((ext_vector_type(8)));
typedef short s16x4 __attribute__((ext_vector_type(4)));
typedef float f32x16 __attribute__((ext_vector_type(16)));
typedef float f32x4 __attribute__((ext_vector_type(4)));
typedef unsigned u32x4 __attribute__((ext_vector_type(4)));
constexpr int NW = 8, QBLK = 32, KVBLK = 64;
constexpr float THR = 8.f;
#define FA_SBAR() __builtin_amdgcn_sched_barrier(0)
#define FA_VMW() asm volatile("s_waitcnt vmcnt(0)" ::: "memory")
__device__ __forceinline__ int crow(int r, int hi) { return (r & 3) + 8 * (r >> 2) + 4 * hi; }
__device__ __forceinline__ unsigned cvtpk(float lo, float hi) { unsigned r; asm volatile("v_cvt_pk_bf16_f32 %0, %1, %2" : "=v"(r) : "v"(lo), "v"(hi)); return r; }

template <int NDQ> __device__ __forceinline__ int kswz(int row, int c) {
    if (NDQ == 4) return row * 128 + ((c ^ ((row >> 1) & 7)) << 4);
    else return row * (NDQ * 32) + ((c ^ (row & 15)) << 4);
}
template <int NDVT> __device__ __forceinline__ int v_st(int k, int c) { const int kk = (k & ~0xC) | ((k & 4) << 1) | ((k & 8) >> 1); return ((kk >> 3) * NDVT + (c >> 5)) * 512 + ((kk & 7) * 32 + (c & 31)) * 2; }
__device__ __forceinline__ int v_rd_base(int lane) { return ((lane & 3) << 3) | (((lane >> 2) & 3) << 6) | (((lane >> 4) & 1) << 5) | (((lane >> 5) & 1) << 8); }

__device__ __forceinline__ void mask_tile(f32x16& p0, f32x16& p1, int dq, unsigned W) {
    const float NEG = -__builtin_inff();
#pragma unroll
    for (int r = 0; r < 16; ++r) { const int c = (r & 3) + 8 * (r >> 2);
        if ((unsigned)(dq - c) >= W) p0[r] = NEG;
        if ((unsigned)(dq - c - 32) >= W) p1[r] = NEG; }
}
__device__ __forceinline__ void partialSM(f32x16& p0, f32x16& p1, float& m_reg, float& alpha) {
    float pmax = p0[0];
#pragma unroll
    for (int r = 1; r < 16; ++r) pmax = fmaxf(pmax, p0[r]);
#pragma unroll
    for (int r = 0; r < 16; ++r) pmax = fmaxf(pmax, p1[r]);
    { auto rr = __builtin_amdgcn_permlane32_swap(__float_as_uint(pmax), __float_as_uint(pmax), false, false); pmax = fmaxf(__uint_as_float(rr[0]), __uint_as_float(rr[1])); }
    float mn;
    if (__builtin_expect(__all((pmax - m_reg) <= THR), 1)) { mn = m_reg; alpha = 1.f; }
    else { mn = fmaxf(m_reg, pmax); alpha = __builtin_amdgcn_exp2f(m_reg - mn); m_reg = mn; }
#pragma unroll
    for (int r = 0; r < 16; ++r) p0[r] = p0[r] - mn;
#pragma unroll
    for (int r = 0; r < 16; ++r) p1[r] = p1[r] - mn;
#pragma unroll
    for (int r = 0; r < 16; ++r) p0[r] = __builtin_amdgcn_exp2f(p0[r]);
}
__device__ __forceinline__ void finishSM(f32x16& p0, f32x16& p1, float alpha, float& l_reg, bf16x8& pa0, bf16x8& pa1, bf16x8& pa2, bf16x8& pa3) {
#pragma unroll
    for (int r = 0; r < 16; ++r) p1[r] = __builtin_amdgcn_exp2f(p1[r]);
    float ps = 0.f;
#pragma unroll
    for (int r = 0; r < 16; ++r) ps += p0[r];
#pragma unroll
    for (int r = 0; r < 16; ++r) ps += p1[r];
    { auto rr = __builtin_amdgcn_permlane32_swap(__float_as_uint(ps), __float_as_uint(ps), false, false); ps = __uint_as_float(rr[0]) + __uint_as_float(rr[1]); }
    l_reg = l_reg * alpha + ps;
#define FA_PK4(P, B_, OUT) do { unsigned a0 = cvtpk(P[B_ + 0], P[B_ + 1]), a1 = cvtpk(P[B_ + 2], P[B_ + 3]); unsigned b0 = cvtpk(P[B_ + 4], P[B_ + 5]), b1 = cvtpk(P[B_ + 6], P[B_ + 7]); \
        auto r0 = __builtin_amdgcn_permlane32_swap(a0, b0, false, false); auto r1 = __builtin_amdgcn_permlane32_swap(a1, b1, false, false); \
        u32x4 w = {r0[0], r1[0], r0[1], r1[1]}; OUT = *reinterpret_cast<bf16x8*>(&w); } while (0)
    FA_PK4(p0, 0, pa0); FA_PK4(p0, 8, pa1); FA_PK4(p1, 0, pa2); FA_PK4(p1, 8, pa3);
#undef FA_PK4
}
template <int NDQ>
__device__ __forceinline__ void qkt(f32x16& p0, f32x16& p1, const char* Kb, int r32, int hi, const bf16x8* qr) {
    p0 = f32x16{}; p1 = f32x16{};
    constexpr int NA = NDQ < 8 ? NDQ : 8;
    const char* kb[NA];
#pragma unroll
    for (int dd = 0; dd < NA; ++dd) kb[dd] = Kb + kswz<NDQ>(r32, 2 * dd + hi);
#pragma unroll
    for (int d0 = 0; d0 < NDQ; ++d0) { const char* a = kb[d0 & (NA - 1)] + (d0 >> 3) * 256;
        const bf16x8 b0 = *reinterpret_cast<const bf16x8*>(a);
        const bf16x8 b1 = *reinterpret_cast<const bf16x8*>(a + 32 * NDQ * 32);
        p0 = __builtin_amdgcn_mfma_f32_32x32x16_bf16(b0, qr[d0], p0, 0, 0, 0);
        p1 = __builtin_amdgcn_mfma_f32_32x32x16_bf16(b1, qr[d0], p1, 0, 0, 0); }
}
template <int NDVT, int NDV>
__device__ __forceinline__ void pv_tile(f32x16* o, int vb, bf16x8 pa0, bf16x8 pa1, bf16x8 pa2, bf16x8 pa3) {
#define FA_TRRD(dst, off) asm volatile("ds_read_b64_tr_b16 %0, %1 offset:%2" : "=&v"(dst) : "v"(vb), "i"(off) : "memory")
#define FA_PV_D0(d0) do { s16x4 l0, l1, l2, l3, h0, h1, h2, h3; constexpr int b_ = (d0) * 512, ks_ = 2 * NDVT * 512, hf_ = NDVT * 512; \
        FA_TRRD(l0, b_); FA_TRRD(h0, b_ + hf_); FA_TRRD(l1, b_ + ks_); FA_TRRD(h1, b_ + ks_ + hf_); FA_TRRD(l2, b_ + 2 * ks_); FA_TRRD(h2, b_ + 2 * ks_ + hf_); FA_TRRD(l3, b_ + 3 * ks_); FA_TRRD(h3, b_ + 3 * ks_ + hf_); \
        asm volatile("s_waitcnt lgkmcnt(0)" ::: "memory"); FA_SBAR(); \
        o[d0] = __builtin_amdgcn_mfma_f32_32x32x16_bf16(pa0, (bf16x8){l0[0], l0[1], l0[2], l0[3], h0[0], h0[1], h0[2], h0[3]}, o[d0], 0, 0, 0); \
        o[d0] = __builtin_amdgcn_mfma_f32_32x32x16_bf16(pa1, (bf16x8){l1[0], l1[1], l1[2], l1[3], h1[0], h1[1], h1[2], h1[3]}, o[d0], 0, 0, 0); \
        o[d0] = __builtin_amdgcn_mfma_f32_32x32x16_bf16(pa2, (bf16x8){l2[0], l2[1], l2[2], l2[3], h2[0], h2[1], h2[2], h2[3]}, o[d0], 0, 0, 0); \
        o[d0] = __builtin_amdgcn_mfma_f32_32x32x16_bf16(pa3, (bf16x8){l3[0], l3[1], l3[2], l3[3], h3[0], h3[1], h3[2], h3[3]}, o[d0], 0, 0, 0); } while (0)
    FA_PV_D0(0); if constexpr (NDV > 1) FA_PV_D0(1); if constexpr (NDV > 2) FA_PV_D0(2); if constexpr (NDV > 3) FA_PV_D0(3);
#undef FA_PV_D0
#undef FA_TRRD
}

template <int NDQ, int NDVT, int NDV>
struct Core {
    static constexpr int KROW = NDQ * 32, SHM_K = 64 * KROW, SHM_V = 64 * NDVT * 64, NKL = NDQ / 4, NVL = NDVT / 2, LDS_NEED = 2 * SHM_V + 2 * SHM_K + NW * 256;
    static_assert(NKL >= 1 && NVL >= 1, "tile too small for 512 staging threads");
    __device__ __forceinline__ static void run(f32x16 (&o)[NDV], float& m_reg, float& l_reg, const bf16* Qw, int ldq, const bf16* Kg, const bf16* Vg, int ldk,
                                               int j_lo, int j_hi, int qlo, int W, char* lds, int vdoff) {
        const int tid = threadIdx.x, wid = __builtin_amdgcn_readfirstlane(tid >> 6), lane = tid & 63, r32 = lane & 31, hi = lane >> 5;
        const int NT = j_hi - j_lo, qm = qlo + r32 - 4 * hi;
        char* V_lds = lds; char* K_lds = lds + 2 * SHM_V;
        float* wsf = (float*)(lds + 2 * SHM_V + 2 * SHM_K) + wid * 64; float* al_l = wsf + 32;
        m_reg = -1e30f; l_reg = 0.f;
#pragma unroll
        for (int d = 0; d < NDV; ++d) o[d] = f32x16{};
        constexpr int KCH = 2 * NDQ, KRS = 512 / KCH, VCH = 4 * NDVT, VRS = 512 / VCH;
        const int krow0 = tid / KCH, kch = tid % KCH, vrow0 = tid / VCH, vcol = (tid % VCH) * 8;
        int kws[NKL], vws[NVL];
#pragma unroll
        for (int i = 0; i < NKL; ++i) kws[i] = kswz<NDQ>(krow0 + i * KRS, kch);
#pragma unroll
        for (int i = 0; i < NVL; ++i) vws[i] = v_st<NDVT>(vrow0 + i * VRS, vcol);
        const bf16* kgp = Kg + (size_t)krow0 * ldk + kch * 8; const bf16* vgp = Vg + (size_t)vrow0 * ldk + vcol;
        bf16x8 sk[NKL], sv[NVL];
        const int vb0 = (int)(uintptr_t)V_lds + v_rd_base(lane) + vdoff * 512;
#define FA_SLOAD(t) do { const size_t ro_ = (size_t)((j_lo + (t)) * KVBLK) * ldk; \
        _Pragma("unroll") for (int i_ = 0; i_ < NVL; ++i_) sv[i_] = *reinterpret_cast<const bf16x8*>(vgp + ro_ + (size_t)(i_ * VRS) * ldk); \
        _Pragma("unroll") for (int i_ = 0; i_ < NKL; ++i_) sk[i_] = *reinterpret_cast<const bf16x8*>(kgp + ro_ + (size_t)(i_ * KRS) * ldk); } while (0)
#define FA_SWRITE(bf) do { _Pragma("unroll") for (int i_ = 0; i_ < NVL; ++i_) *reinterpret_cast<bf16x8*>(V_lds + (bf) * SHM_V + vws[i_]) = sv[i_]; \
        _Pragma("unroll") for (int i_ = 0; i_ < NKL; ++i_) *reinterpret_cast<bf16x8*>(K_lds + (bf) * SHM_K + kws[i_]) = sk[i_]; } while (0)
#define FA_RESC(a) do { if (__any((a) < 1.f)) { if (hi == 0) al_l[r32] = (a); asm volatile("s_waitcnt lgkmcnt(0)" ::: "memory"); \
        _Pragma("unroll") for (int d_ = 0; d_ < NDV; ++d_) _Pragma("unroll") for (int r = 0; r < 16; ++r) o[d_][r] *= al_l[crow(r, hi)]; } } while (0)
#define FA_KBASE(t) ((j_lo + (t)) * KVBLK)
#define FA_MASKT(P0_, P1_, t) do { const int kb_ = FA_KBASE(t); if (kb_ + KVBLK - 1 > qlo || kb_ <= qlo + QBLK - 1 - W) mask_tile(P0_, P1_, qm - kb_, (unsigned)W); } while (0)
        bf16x8 qr[NDQ];
#pragma unroll
        for (int d0 = 0; d0 < NDQ; ++d0) qr[d0] = *reinterpret_cast<const bf16x8*>(Qw + (size_t)r32 * ldq + d0 * 16 + hi * 8);
        FA_SLOAD(0); FA_VMW(); FA_SWRITE(0); FA_SBAR();
        if (NT > 1) FA_SLOAD(1);
        __syncthreads();
        f32x16 pA0, pA1, pB0, pB1; float alA, alB; bf16x8 pa0, pa1, pa2, pa3;
        FA_SBAR(); qkt<NDQ>(pA0, pA1, K_lds, r32, hi, qr);
        FA_MASKT(pA0, pA1, 0); partialSM(pA0, pA1, m_reg, alA);
        if (NT > 1) { FA_VMW(); FA_SWRITE(1); }
        __syncthreads();
#define FA_HALF_STEP(PX0, PX1, alX, PY0, PY1, alY, t, KB, VB, SB) do { \
        FA_SBAR(); qkt<NDQ>(PX0, PX1, K_lds + (KB) * SHM_K, r32, hi, qr); \
        finishSM(PY0, PY1, alY, l_reg, pa0, pa1, pa2, pa3); FA_SBAR(); \
        if ((t) + 1 < NT) { FA_SLOAD((t) + 1); FA_SBAR(); } \
        pv_tile<NDVT, NDV>(o, vb0 + (VB) * SHM_V, pa0, pa1, pa2, pa3); FA_MASKT(PX0, PX1, (t)); partialSM(PX0, PX1, m_reg, alX); \
        __syncthreads(); \
        if ((t) + 1 < NT) { FA_VMW(); FA_SWRITE(SB); } \
        FA_RESC(alX); __syncthreads(); } while (0)
        for (int t = 1; t + 1 < NT; t += 2) {
            FA_HALF_STEP(pB0, pB1, alB, pA0, pA1, alA, t, 1, 0, 0);
            FA_HALF_STEP(pA0, pA1, alA, pB0, pB1, alB, t + 1, 0, 1, 1);
        }
        const bool even = (NT & 1) == 0;
        if (even) { FA_SBAR(); qkt<NDQ>(pB0, pB1, K_lds + SHM_K, r32, hi, qr); FA_SBAR(); }
        finishSM(pA0, pA1, alA, l_reg, pa0, pa1, pa2, pa3); FA_SBAR();
        pv_tile<NDVT, NDV>(o, vb0, pa0, pa1, pa2, pa3);
        if (even) { FA_MASKT(pB0, pB1, NT - 1); partialSM(pB0, pB1, m_reg, alB); FA_RESC(alB);
            finishSM(pB0, pB1, alB, l_reg, pa0, pa1, pa2, pa3); FA_SBAR(); pv_tile<NDVT, NDV>(o, vb0 + SHM_V, pa0, pa1, pa2, pa3); }
        __syncthreads();
#undef FA_SLOAD
#undef FA_SWRITE
#undef FA_RESC
#undef FA_KBASE
#undef FA_MASKT
#undef FA_HALF_STEP
    }
};
}

constexpr size_t WS_STASH = 128 * MiB;
typedef unsigned v4u32 __attribute__((__vector_size__(16)));
__device__ __forceinline__ __amdgpu_buffer_rsrc_t mk_rsrc(const void* ptr) {
    const unsigned long long v = (unsigned long long)ptr; const unsigned lo = __builtin_amdgcn_readfirstlane((unsigned)v), hi = __builtin_amdgcn_readfirstlane((unsigned)(v >> 32));
    return __builtin_amdgcn_make_buffer_rsrc((void*)(((unsigned long long)hi << 32) | lo), 0, 0x40000000, 0x00020000);
}
__device__ __forceinline__ void attn_phase(const Params& p, char* lds, int vcu) {
    using namespace fa;
    const int tid = threadIdx.x, wid = __builtin_amdgcn_readfirstlane(tid >> 6), lane = tid & 63, r32 = lane & 31, hi = lane >> 5;
    const bf16* proj = (const bf16*)(p.ws + WS_PROJ); bf16* att = (bf16*)(p.ws + WS_ATT);
    typedef Core<4, 4, 4> CD; typedef Core<4, 2, 2> CS;
    float* wsf = (float*)(lds + CD::LDS_NEED) + wid * 64;
    const float lam = calc_lambda(p);
    const int ovoff = (4 * hi * DM + r32) * 2;
#ifndef FA_NO_DIFF
    {
        const int bh = vcu >> 3, b = bh >> 2, h = bh & 3, s = vcu & 7;
        u32x4* stash = (u32x4*)(lds + CD::LDS_NEED + NW * 256) + tid;
#pragma nounroll
        for (int pass = 0; pass < 2; ++pass) {
            const int qb = pass ? 15 - s : s;
            const size_t row0 = (size_t)b * SEQ + qb * 256 + wid * 32;
#pragma nounroll
            for (int c = 0; c < 2; ++c) {
                f32x16 o[4]; float m_reg, l_reg;
                CD::run(o, m_reg, l_reg, proj + row0 * NP + C_QD + (2 * h + c) * 64, NP, proj + (size_t)b * SEQ * NP + C_KD + (2 * h + c) * 64, proj + (size_t)b * SEQ * NP + C_VD + h * 128, NP,
                        0, 4 * (qb + 1), qb * 256 + wid * 32, 1 << 30, lds, 0);
                if (hi == 0) wsf[r32] = l_reg;
                asm volatile("s_waitcnt lgkmcnt(0)" ::: "memory");
                if (c == 0) {
#pragma unroll
                    for (int j = 0; j < 2; ++j) { float ri[8];
#pragma unroll
                        for (int e = 0; e < 8; ++e) ri[e] = 1.0f / wsf[crow(8 * j + e, hi)];
#pragma unroll
                        for (int d0 = 0; d0 < 4; ++d0) { u32x4 w; w.x = cvtpk(o[d0][8 * j] * ri[0], o[d0][8 * j + 1] * ri[1]); w.y = cvtpk(o[d0][8 * j + 2] * ri[2], o[d0][8 * j + 3] * ri[3]);
                            w.z = cvtpk(o[d0][8 * j + 4] * ri[4], o[d0][8 * j + 5] * ri[5]); w.w = cvtpk(o[d0][8 * j + 6] * ri[6], o[d0][8 * j + 7] * ri[7]); stash[(d0 * 2 + j) * NTHR] = w; } }
                } else {
                    const __amdgpu_buffer_rsrc_t rso = mk_rsrc(att + row0 * DM + 512 + h * 128);
                    float ssq[16];
#pragma unroll
                    for (int r = 0; r < 16; ++r) ssq[r] = -lam / wsf[crow(r, hi)];
#pragma unroll
                    for (int d0 = 0; d0 < 4; ++d0)
#pragma unroll
                        for (int j = 0; j < 2; ++j) { const u32x4 w = stash[(d0 * 2 + j) * NTHR]; const unsigned ww[4] = {w.x, w.y, w.z, w.w};
#pragma unroll
                            for (int e = 0; e < 8; ++e) { const int r = 8 * j + e; const float a0 = (e & 1) ? __uint_as_float(ww[e >> 1] & 0xffff0000u) : __uint_as_float(ww[e >> 1] << 16);
                                o[d0][r] = a0 + ssq[r] * o[d0][r]; } }
#pragma unroll
                    for (int r = 0; r < 16; ++r) { float q = (o[0][r] * o[0][r] + o[1][r] * o[1][r]) + (o[2][r] * o[2][r] + o[3][r] * o[3][r]);
                        q += __shfl_xor(q, 1); q += __shfl_xor(q, 2); q += __shfl_xor(q, 4); q += __shfl_xor(q, 8); q += __shfl_xor(q, 16);
                        ssq[r] = 0.8f / sqrtf(q * (1.f / 128.f) + EPS); }
#pragma unroll
                    for (int d0 = 0; d0 < 4; ++d0) { const float g = p.g_diff[d0 * 32 + r32];
#pragma unroll
                        for (int r = 0; r < 16; ++r) { const float y = o[d0][r] * ssq[r] * g; const float yn = __shfl_xor(y, 1);
                            if ((r32 & 1) == 0) __builtin_amdgcn_raw_buffer_store_b32(cvtpk(y, yn), rso, ovoff, (((r & 3) + 8 * (r >> 2)) * DM + d0 * 32) * 2, 0); } }
                }
                asm volatile("s_waitcnt lgkmcnt(0)" ::: "memory");
            }
        }
    }
#endif
#ifndef FA_NO_SWA
    for (int i = 0; i < 4; ++i) {
        const int u = vcu * 4 + i, bk = u >> 6, g64 = u & 63, b = bk >> 1, kvh = bk & 1, hq = kvh * 4 + (wid >> 1), sub = wid & 1;
        const size_t row0 = (size_t)b * SEQ + g64 * 64 + sub * 32;
        const __amdgpu_buffer_rsrc_t rso = mk_rsrc(att + row0 * DM + hq * 64);
        f32x16 o[2]; float m_reg, l_reg;
        const bf16* Qw = proj + row0 * NP + C_QA + hq * 64;
        const bf16* Kg = proj + (size_t)b * SEQ * NP + C_KA + kvh * 64;
        const bf16* Vg = proj + (size_t)b * SEQ * NP + C_VA + kvh * 64;
        CS::run(o, m_reg, l_reg, Qw, NP, Kg, Vg, NP, g64 >= 2 ? g64 - 2 : 0, g64 + 1, g64 * 64 + sub * 32, 128, lds, 0);
        const float lt = l_reg + __builtin_amdgcn_exp2f(p.sinks[hq] * LOG2E - m_reg);
        if (hi == 0) wsf[r32] = lt;
        asm volatile("s_waitcnt lgkmcnt(0)" ::: "memory");
#pragma unroll
        for (int r = 0; r < 16; ++r) { const float rl = 1.0f / wsf[crow(r, hi)];
#pragma unroll
            for (int d0 = 0; d0 < 2; ++d0) { const float y = o[d0][r] * rl; const float yn = __shfl_xor(y, 1);
                if ((r32 & 1) == 0) __builtin_amdgcn_raw_buffer_store_b32(cvtpk(y, yn), rso, ovoff, (((r & 3) + 8 * (r >> 2)) * DM + d0 * 32) * 2, 0); } }
        __syncthreads();
    }
#endif
}

namespace fa {
template <int NDQ, int NDVT, int NDV>
struct CoreSeq {
    static constexpr int KROW = NDQ * 32, SHM_K = 64 * KROW, SHM_V = 64 * NDVT * 64, NKL = NDQ / 4, NVL = NDVT / 2, NST = NKL > NVL ? NKL : NVL, LDS_NEED = SHM_V + SHM_K + NW * 256;
    __device__ __forceinline__ static void run(f32x16 (&o)[NDV], float& m_reg, float& l_reg, const bf16* Qw, int ldq, const bf16* Kg, const bf16* Vg, int ldk, int NT, char* lds, int vdoff) {
        const int tid = threadIdx.x, wid = __builtin_amdgcn_readfirstlane(tid >> 6), lane = tid & 63, r32 = lane & 31, hi = lane >> 5;
        char* V_lds = lds; char* K_lds = lds + SHM_V;
        float* al_l = (float*)(lds + SHM_V + SHM_K) + wid * 64 + 32;
        m_reg = -1e30f; l_reg = 0.f;
#pragma unroll
        for (int d = 0; d < NDV; ++d) o[d] = f32x16{};
        constexpr int KCH = 2 * NDQ, KRS = 512 / KCH, VCH = 4 * NDVT, VRS = 512 / VCH;
        const int krow0 = tid / KCH, kch = tid % KCH, vrow0 = tid / VCH, vcol = (tid % VCH) * 8;
        const bf16* kgp = Kg + (size_t)krow0 * ldk + kch * 8; const bf16* vgp = Vg + (size_t)vrow0 * ldk + vcol;
        bf16x8 st[NST];
        const int vb0 = (int)(uintptr_t)V_lds + v_rd_base(lane) + vdoff * 512;
#define FQ_LOADV(t) do { const size_t ro_ = (size_t)((t) * KVBLK) * ldk; _Pragma("unroll") for (int i_ = 0; i_ < NVL; ++i_) st[i_] = *reinterpret_cast<const bf16x8*>(vgp + ro_ + (size_t)(i_ * VRS) * ldk); } while (0)
#define FQ_LOADK(t) do { const size_t ro_ = (size_t)((t) * KVBLK) * ldk; _Pragma("unroll") for (int i_ = 0; i_ < NKL; ++i_) st[i_] = *reinterpret_cast<const bf16x8*>(kgp + ro_ + (size_t)(i_ * KRS) * ldk); } while (0)
#define FQ_WRITEV() do { _Pragma("unroll") for (int i_ = 0; i_ < NVL; ++i_) *reinterpret_cast<bf16x8*>(V_lds + v_st<NDVT>(vrow0 + i_ * VRS, vcol)) = st[i_]; } while (0)
#define FQ_WRITEK() do { _Pragma("unroll") for (int i_ = 0; i_ < NKL; ++i_) *reinterpret_cast<bf16x8*>(K_lds + kswz<NDQ>(krow0 + i_ * KRS, kch)) = st[i_]; } while (0)
        bf16x8 qr[NDQ];
#pragma unroll
        for (int d0 = 0; d0 < NDQ; ++d0) qr[d0] = *reinterpret_cast<const bf16x8*>(Qw + (size_t)r32 * ldq + d0 * 16 + hi * 8);
        FQ_LOADK(0); FA_VMW(); FQ_WRITEK(); FA_SBAR(); FQ_LOADV(0);
        __syncthreads();
        for (int t = 0; t < NT; ++t) {
            f32x16 p0, p1; float al; bf16x8 pa0, pa1, pa2, pa3;
            FA_SBAR(); qkt<NDQ>(p0, p1, K_lds, r32, hi, qr);
            partialSM(p0, p1, m_reg, al);
            if (__any(al < 1.f)) { if (hi == 0) al_l[r32] = al; asm volatile("s_waitcnt lgkmcnt(0)" ::: "memory");
#pragma unroll
                for (int d_ = 0; d_ < NDV; ++d_)
#pragma unroll
                    for (int r = 0; r < 16; ++r) o[d_][r] *= al_l[crow(r, hi)]; }
            finishSM(p0, p1, al, l_reg, pa0, pa1, pa2, pa3); FA_SBAR();
            FA_VMW(); FQ_WRITEV(); FA_SBAR(); if (t + 1 < NT) FQ_LOADK(t + 1);
            __syncthreads();
            pv_tile<NDVT, NDV>(o, vb0, pa0, pa1, pa2, pa3);
            if (t + 1 < NT) { FA_VMW(); FQ_WRITEK(); FA_SBAR(); FQ_LOADV(t + 1); }
            __syncthreads();
        }
#undef FQ_LOADV
#undef FQ_LOADK
#undef FQ_WRITEV
#undef FQ_WRITEK
    }
};
}
__device__ __forceinline__ void cross_phase(const Params& p, char* lds, int vcu) {
    using namespace fa;
    const int tid = threadIdx.x, wid = __builtin_amdgcn_readfirstlane(tid >> 6), lane = tid & 63, r32 = lane & 31, hi = lane >> 5;
    const bf16* qc = (const bf16*)(p.ws + WS_QC); const bf16* kvm = (const bf16*)(p.ws + WS_KVM); bf16* oc = (bf16*)(p.ws + WS_OC);
    typedef CoreSeq<16, 8, 4> CC;
    float* wsf = (float*)(lds + CC::LDS_NEED) + wid * 64;
    const int ovoff = (4 * hi * DM + r32) * 2;
#pragma nounroll
    for (int i = 0; i < 4; ++i) {
        const int u = vcu * 4 + i, bh = u >> 5, rb = u & 31, b = bh >> 2, head = bh & 3, dh = wid >> 2;
        const size_t row0 = (size_t)b * SEQ + rb * 128 + (wid & 3) * 32;
        const __amdgpu_buffer_rsrc_t rso = mk_rsrc(oc + row0 * DM + head * 256 + dh * 128);
        f32x16 o[4]; float m_reg, l_reg;
        CC::run(o, m_reg, l_reg, qc + row0 * DM + head * 256, DM, kvm + (size_t)b * MEML * 2048 + head * 256, kvm + (size_t)b * MEML * 2048 + 1024 + head * 256, 2048, MEML / 64, lds, dh * 4);
        if (hi == 0) wsf[r32] = l_reg;
        asm volatile("s_waitcnt lgkmcnt(0)" ::: "memory");
#pragma unroll
        for (int r = 0; r < 16; ++r) { const float rl = 1.0f / wsf[crow(r, hi)];
#pragma unroll
            for (int d0 = 0; d0 < 4; ++d0) { const float y = o[d0][r] * rl; const float yn = __shfl_xor(y, 1);
                if ((r32 & 1) == 0) __builtin_amdgcn_raw_buffer_store_b32(cvtpk(y, yn), rso, ovoff, (((r & 3) + 8 * (r >> 2)) * DM + d0 * 32) * 2, 0); } }
        asm volatile("s_waitcnt lgkmcnt(0)" ::: "memory");
    }
}
constexpr int LDS_BYTES = 147456;
constexpr size_t WS_SS3 = 58 * MiB;
__device__ __forceinline__ void final_norm_ss(float* X, const float* ss, const float* g, int gw, int ngw, int lane) {
    for (int m = gw; m < M; m += ngw) {
        const float rstd = pg8::rstd_ss(ss, m);
        f32x4* xr = (f32x4*)(X + (size_t)m * DM) + lane;
#pragma unroll
        for (int j = 0; j < 4; ++j) { const f32x4 gg = ((const f32x4*)g)[lane + 64 * j]; xr[64 * j] = xr[64 * j] * rstd * gg; }
    }
}
constexpr int N_PHASES = 10;
__global__ void __launch_bounds__(NTHR, 2) fwd_kernel(Params p) {
    extern __shared__ __attribute__((aligned(16))) unsigned char lds_raw[];
    LAS unsigned char* lds = (LAS unsigned char*)lds_raw;
    cg::grid_group grid = cg::this_grid();
    const int tid = threadIdx.x, wave = __builtin_amdgcn_readfirstlane(tid >> 6), lane = tid & 63, bid = blockIdx.x, nblk = gridDim.x;
    const int gw = bid * NWAVES + wave, ngw = nblk * NWAVES;
    const int vcu = (nblk % 8 == 0) ? (bid % 8) * (nblk / 8) + bid / 8 : bid;
    unsigned char* ws = p.ws;
    const int lo = p.ph_lo, hi = p.ph_hi;
    typedef pg8::bf16_t b16;
#define IN(k) (lo <= (k) && (k) < hi)
#define SEAM(k) do { if (IN(k) && IN((k) + 1)) grid.sync(); } while (0)
    if (IN(0)) { p0_prologue(p, lds, bid, nblk, tid); } SEAM(0);
    if (IN(1)) {
        pg8::Gemm g{(const b16*)(ws + WS_XN), (const b16*)(ws + WS_WIN), (const b16*)(ws + WS_MEMN), (const b16*)(ws + WS_WCKV), DM};
        pg8::TwoOrder S; S.init(M, NP, nblk, bid); S.n2M = MM / 256; S.n2N = 2048 / 256;
        pg8::EpiProj E{(b16*)(ws + WS_PROJ), (b16*)(ws + WS_KVM), (const float*)(ws + WS_ROPE)};
        pg8::gemm_phase<pg8::EpiProj, pg8::TwoOrder, true, true>(lds, g, S, E);
    } SEAM(1);
    if (IN(2)) { attn_phase(p, (char*)lds_raw, vcu);
#ifdef FA_NO_SWA
        swa_naive(p, bid, nblk, tid);
#endif
#ifdef FA_NO_DIFF
        diff_naive(p, bid, nblk, tid); grid.sync(); diff_combine_naive(p, gw, ngw, lane);
#endif
    } SEAM(2);
    if (IN(3)) {
        pg8::Gemm g{(const b16*)(ws + WS_ATT), (const b16*)(ws + WS_WOUT), nullptr, nullptr, DM};
        pg8::StaticOrder S; S.init(M, DM, nblk, bid);
        pg8::EpiRes E{p.x, p.out, (b16*)(ws + WS_XN), (float*)(ws + WS_SS1)};
        pg8::gemm_phase<pg8::EpiRes, pg8::StaticOrder, true, true>(lds, g, S, E);
    } SEAM(3);
    if (IN(4)) {
        pg8::Gemm g{(const b16*)(ws + WS_XN), (const b16*)(ws + WS_WCQ), nullptr, nullptr, DM};
        pg8::StaticOrder S; S.init(M, DM, nblk, bid);
        pg8::EpiScaleBf16<0> E{(b16*)(ws + WS_QC), DM, (const float*)(ws + WS_SS1), CQ};
        pg8::gemm_phase<pg8::EpiScaleBf16<0>, pg8::StaticOrder, true, true>(lds, g, S, E);
    } SEAM(4);
    if (IN(5)) { cross_phase(p, (char*)lds_raw, vcu); } SEAM(5);
    if (IN(6)) {
        pg8::Gemm g{(const b16*)(ws + WS_OC), (const b16*)(ws + WS_WCO), nullptr, nullptr, DM};
        pg8::StaticOrder S; S.init(M, DM, nblk, bid);
        pg8::EpiRes E{p.out, p.out, (b16*)(ws + WS_XN), (float*)(ws + WS_SS2)};
        pg8::gemm_phase<pg8::EpiRes, pg8::StaticOrder, true, true>(lds, g, S, E);
    } SEAM(6);
    if (IN(7)) {
        pg8::Gemm g{(const b16*)(ws + WS_XN), (const b16*)(ws + WS_WUP), nullptr, nullptr, DM};
        pg8::StaticOrder S; S.init(M, FF, nblk, bid);
        pg8::EpiScaleBf16<1> E{(b16*)(ws + WS_ACT), FF, (const float*)(ws + WS_SS2), 1.f};
        pg8::gemm_phase<pg8::EpiScaleBf16<1>, pg8::StaticOrder, true, true>(lds, g, S, E);
    } SEAM(7);
    if (IN(8)) {
        pg8::Gemm g{(const b16*)(ws + WS_ACT), (const b16*)(ws + WS_WDOWN), nullptr, nullptr, FF};
        pg8::StaticOrder S; S.init(M, DM, nblk, bid);
        pg8::EpiRes E{p.out, p.out, nullptr, (float*)(ws + WS_SS3)};
        pg8::gemm_phase<pg8::EpiRes, pg8::StaticOrder, true, true>(lds, g, S, E);
    } SEAM(8);
    if (IN(9)) { final_norm_ss(p.out, (const float*)(ws + WS_SS3), p.g_final, gw, ngw, lane); }
#undef IN
#undef SEAM
}

extern "C" void kernel_launch(void* const* d_in, const int* in_sizes, int n_in, void* d_out, int out_size, void* d_ws, size_t ws_size, hipStream_t stream) {
    static int grid = 0;
    if (grid == 0) {
        if (n_in != 21 || out_size != M * DM || ws_size < WS_END) { fprintf(stderr, "kernel_launch: unexpected shapes (n_in %d out %d ws %zu)\n", n_in, out_size, ws_size); grid = -1; return; }
        int dev = 0, cus = 0, per_cu = 0;
        (void)hipGetDevice(&dev); (void)hipDeviceGetAttribute(&cus, hipDeviceAttributeMultiprocessorCount, dev);
        if (hipFuncSetAttribute((const void*)fwd_kernel, hipFuncAttributeMaxDynamicSharedMemorySize, LDS_BYTES) != hipSuccess) { fprintf(stderr, "kernel_launch: hipFuncSetAttribute failed\n"); grid = -1; return; }
        (void)hipOccupancyMaxActiveBlocksPerMultiprocessor(&per_cu, (const void*)fwd_kernel, NTHR, LDS_BYTES);
        if (per_cu < 1) { fprintf(stderr, "kernel_launch: occupancy query says %d blocks per CU\n", per_cu); per_cu = 1; }
        grid = cus;
    }
    if (grid < 0) return;
    Params p{};
    p.x = (const float*)d_in[0]; p.mem = (const float*)d_in[1]; p.pos = (const int*)d_in[2]; p.g_mix = (const float*)d_in[3]; p.w_in = (const float*)d_in[4];
    p.sinks = (const float*)d_in[5]; p.lq1 = (const float*)d_in[6]; p.lk1 = (const float*)d_in[7]; p.lq2 = (const float*)d_in[8]; p.lk2 = (const float*)d_in[9];
    p.g_diff = (const float*)d_in[10]; p.w_out = (const float*)d_in[11]; p.g_cross = (const float*)d_in[12]; p.g_mem = (const float*)d_in[13]; p.w_cq = (const float*)d_in[14];
    p.w_ckv = (const float*)d_in[15]; p.w_co = (const float*)d_in[16]; p.g_mlp = (const float*)d_in[17]; p.w_up = (const float*)d_in[18]; p.w_down = (const float*)d_in[19]; p.g_final = (const float*)d_in[20];
    p.out = (float*)d_out; p.ws = (unsigned char*)d_ws;
#if MK_ONE_LAUNCH
    p.ph_lo = 0; p.ph_hi = N_PHASES;
    void* args[] = {&p};
    hipError_t e = hipLaunchCooperativeKernel((const void*)fwd_kernel, dim3(grid), dim3(NTHR), args, LDS_BYTES, stream);
    if (e != hipSuccess) fprintf(stderr, "cooperative launch failed: %s (grid %d)\n", hipGetErrorString(e), grid);
#else
    for (int k = 0; k < N_PHASES; ++k) { p.ph_lo = k; p.ph_hi = k + 1; hipLaunchKernelGGL(fwd_kernel, dim3(grid), dim3(NTHR), LDS_BYTES, stream, p); }
#endif
}
```

```cpp
#include <hip/hip_runtime.h>
#include <hip/hip_cooperative_groups.h>
#include <cstdio>
#include <cstdint>
namespace cg = cooperative_groups;

#ifndef MK_ONE_LAUNCH
#define MK_ONE_LAUNCH 1
#endif
#ifndef FA_VARIANT
#endif

#define LAS __attribute__((address_space(3)))
typedef unsigned short bf16;
typedef short bf16x8 __attribute__((ext_vector_type(8)));
typedef float f32x4 __attribute__((ext_vector_type(4)));
typedef unsigned u32x4 __attribute__((ext_vector_type(4)));
typedef unsigned u32x2 __attribute__((ext_vector_type(2)));

constexpr int BATCH = 8, SEQ = 4096, M = BATCH * SEQ, DM = 1024, NP = 2304, MEML = 256, MM = BATCH * MEML, FF = 4096;
constexpr int NWAVES = 8, NTHR = NWAVES * 64;
constexpr float EPS = 1e-5f;
constexpr float LOG2E = 1.4426950408889634f;
constexpr float C2 = 0.125f * LOG2E;
constexpr float CQ = 0.0625f * LOG2E;
constexpr int C_QA = 0, C_KA = 512, C_VA = 640, C_QD = 768, C_KD = 1280, C_VD = 1792;

constexpr size_t MiB = 1u << 20;
constexpr size_t WS_CTL = 0;
constexpr size_t WS_WIN = 2 * MiB;
constexpr size_t WS_WOUT = WS_WIN + (size_t)NP * DM * 2;
constexpr size_t WS_WCQ = WS_WOUT + 2 * MiB;
constexpr size_t WS_WCKV = WS_WCQ + 2 * MiB;
constexpr size_t WS_WCO = WS_WCKV + 4 * MiB;
constexpr size_t WS_WUP = WS_WCO + 2 * MiB;
constexpr size_t WS_WDOWN = WS_WUP + 8 * MiB;
constexpr size_t WS_ROPE = 34 * MiB;
constexpr size_t WS_KVM = 42 * MiB;
constexpr size_t WS_MEMN = 50 * MiB;
constexpr size_t WS_SS1 = 54 * MiB, WS_SS2 = 56 * MiB;
constexpr size_t WS_XN = 64 * MiB;
constexpr size_t WS_ODIFF = 128 * MiB;
constexpr size_t WS_PROJ = 256 * MiB;
constexpr size_t WS_ATT = 400 * MiB;
constexpr size_t WS_QC = 256 * MiB;
constexpr size_t WS_OC = 320 * MiB;
constexpr size_t WS_ACT = 256 * MiB;
constexpr size_t WS_END = 512 * MiB;
static_assert(WS_WDOWN + 8 * MiB <= WS_ROPE, "weights fit");

struct Params {
    const float *x, *mem; const int* pos;
    const float *g_mix, *w_in, *sinks, *lq1, *lk1, *lq2, *lk2, *g_diff, *w_out, *g_cross, *g_mem, *w_cq, *w_ckv, *w_co, *g_mlp, *w_up, *w_down, *g_final;
    float* out; unsigned char* ws; int ph_lo, ph_hi;
};

__device__ __forceinline__ unsigned f2bf(float f) { unsigned u = __builtin_bit_cast(unsigned, f); return (u + 0x7fffu + ((u >> 16) & 1u)) >> 16; }
__device__ __forceinline__ unsigned pk2(float lo, float hi) { return f2bf(lo) | (f2bf(hi) << 16); }
__device__ __forceinline__ float bf2f(unsigned h) { return __builtin_bit_cast(float, h << 16); }
__device__ __forceinline__ float bflo(unsigned w) { return __builtin_bit_cast(float, w << 16); }
__device__ __forceinline__ float bfhi(unsigned w) { return __builtin_bit_cast(float, w & 0xffff0000u); }
__device__ __forceinline__ float wave_sum(float v) {
#pragma unroll
    for (int o = 1; o < 64; o <<= 1) v += __shfl_xor(v, o);
    return v;
}
__device__ __forceinline__ float wave_max(float v) {
#pragma unroll
    for (int o = 1; o < 64; o <<= 1) v = fmaxf(v, __shfl_xor(v, o));
    return v;
}
__host__ __device__ __forceinline__ bool col_roped(int n) { return n < C_VA || (n >= C_QD && n < C_VD); }
__host__ __device__ __forceinline__ int phys_of_logical(int nl) {
    if (!col_roped(nl)) return nl;
    const int g = nl & ~63, j = nl & 63; return g + ((j & 31) << 1) + (j >> 5);
}
__device__ __forceinline__ float calc_lambda(const Params& p) {
    float a = 0.f, b = 0.f;
    for (int i = 0; i < 64; ++i) { a += p.lq1[i] * p.lk1[i]; b += p.lq2[i] * p.lk2[i]; }
    return __expf(a) - __expf(b) + 0.2f;
}

__device__ const double INV_FREQ[32] = {
    1.0, 0.7498942093324559, 0.5623413251903491, 0.4216965034285822,
    0.31622776601683794, 0.23713737056616552, 0.1778279410038923, 0.1333521432163324,
    0.1, 0.07498942093324558, 0.05623413251903491, 0.042169650342858224,
    0.03162277660168379, 0.023713737056616554, 0.01778279410038923, 0.01333521432163324,
    0.01, 0.007498942093324558, 0.005623413251903491, 0.004216965034285823,
    0.0031622776601683794, 0.0023713737056616554, 0.0017782794100389228, 0.001333521432163324,
    0.001, 0.0007498942093324559, 0.0005623413251903491, 0.00042169650342858224,
    0.00031622776601683794, 0.00023713737056616554, 0.00017782794100389227, 0.0001333521432163324};

__device__ __forceinline__ void sincos_d(double a, float& c, float& s) {
    const double kd = rint(a * 0.63661977236758134308);
    const int k = (int)kd;
    double r = fma(-kd, 1.57079632679489655800e+00, a); r = fma(-kd, 6.12323399573676603587e-17, r);
    const double r2 = r * r;
    const double sp = r * (1.0 + r2 * (-1.0 / 6.0 + r2 * (1.0 / 120.0 + r2 * (-1.0 / 5040.0 + r2 * (1.0 / 362880.0 + r2 * (-1.0 / 39916800.0 + r2 * (1.0 / 6227020800.0)))))));
    const double cp = 1.0 + r2 * (-0.5 + r2 * (1.0 / 24.0 + r2 * (-1.0 / 720.0 + r2 * (1.0 / 40320.0 + r2 * (-1.0 / 3628800.0 + r2 * (1.0 / 479001600.0 + r2 * (-1.0 / 87178291200.0)))))));
    const int q = k & 3;
    const double ss = (q == 0) ? sp : (q == 1) ? cp : (q == 2) ? -sp : -cp;
    const double cc = (q == 0) ? cp : (q == 1) ? -sp : (q == 2) ? -cp : sp;
    c = (float)cc; s = (float)ss;
}

__device__ __forceinline__ void transpose_item(const float* W, int K, int N, const float* g, bool perm, bf16* WT, LAS float* scr, int item, int lane) {
    const int nblk = N / 32, kb = item / nblk, nb = item % nblk, k0 = 64 * kb, n0 = 32 * nb;
#pragma unroll 8
    for (int i = 0; i < 32; ++i) { const int kk = 2 * i + (lane >> 5); const float gs = g ? g[k0 + kk] : 1.f; scr[kk * 33 + (lane & 31)] = gs * W[(size_t)(k0 + kk) * N + n0 + (lane & 31)]; }
    asm volatile("s_waitcnt lgkmcnt(0)" ::: "memory");
    const int c = lane & 7;
#pragma unroll
    for (int j = 0; j < 4; ++j) { const int n = (lane >> 3) + 8 * j; const LAS float* s = scr + (8 * c) * 33 + n;
        u32x4 o; o.x = pk2(s[0 * 33], s[1 * 33]); o.y = pk2(s[2 * 33], s[3 * 33]); o.z = pk2(s[4 * 33], s[5 * 33]); o.w = pk2(s[6 * 33], s[7 * 33]);
        const int nl = n0 + n, np = perm ? phys_of_logical(nl) : nl;
        *(u32x4*)(WT + (size_t)np * K + k0 + 8 * c) = o; }
    asm volatile("s_waitcnt lgkmcnt(0)" ::: "memory");
}
__device__ __forceinline__ void rms_row_to_bf16(const float* xrow, const float* g, bf16* orow, int lane) {
    const f32x4* xr = (const f32x4*)xrow + lane;
    f32x4 v[4]; float s = 0.f;
#pragma unroll
    for (int j = 0; j < 4; ++j) { v[j] = xr[64 * j]; s += (v[j].x * v[j].x + v[j].y * v[j].y) + (v[j].z * v[j].z + v[j].w * v[j].w); }
    const float rstd = 1.0f / sqrtf(wave_sum(s) * (1.f / DM) + EPS);
    u32x2* o8 = (u32x2*)orow + lane;
#pragma unroll
    for (int j = 0; j < 4; ++j) {
        f32x4 gg = (f32x4){1.f, 1.f, 1.f, 1.f}; if (g) gg = ((const f32x4*)g)[lane + 64 * j];
        u32x2 w; w.x = pk2(v[j].x * rstd * gg.x, v[j].y * rstd * gg.y); w.y = pk2(v[j].z * rstd * gg.z, v[j].w * rstd * gg.w); o8[64 * j] = w; }
}
__device__ __forceinline__ void p0_prologue(const Params& p, LAS unsigned char* lds, int bid, int nblk, int tid) {
    const int wave = tid >> 6, lane = tid & 63;
    LAS float* scr = (LAS float*)(lds + wave * 8704);
    const int gw = bid * NWAVES + wave, NGW = nblk * NWAVES;
    unsigned char* ws = p.ws;
    constexpr int I_IN = (DM / 64) * (NP / 32), I_SQ = (DM / 64) * (DM / 32), I_KV = (DM / 64) * (2048 / 32), I_UP = (DM / 64) * (FF / 32), I_DN = (FF / 64) * (DM / 32);
    constexpr int NITEMS = I_IN + 3 * I_SQ + I_KV + I_UP + I_DN;
    for (int it = gw; it < NITEMS; it += NGW) {
        int r = it;
        if (r < I_IN) { transpose_item(p.w_in, DM, NP, p.g_mix, true, (bf16*)(ws + WS_WIN), scr, r, lane); continue; } r -= I_IN;
        if (r < I_SQ) { transpose_item(p.w_out, DM, DM, nullptr, false, (bf16*)(ws + WS_WOUT), scr, r, lane); continue; } r -= I_SQ;
        if (r < I_SQ) { transpose_item(p.w_cq, DM, DM, p.g_cross, false, (bf16*)(ws + WS_WCQ), scr, r, lane); continue; } r -= I_SQ;
        if (r < I_KV) { transpose_item(p.w_ckv, DM, 2048, nullptr, false, (bf16*)(ws + WS_WCKV), scr, r, lane); continue; } r -= I_KV;
        if (r < I_SQ) { transpose_item(p.w_co, DM, DM, nullptr, false, (bf16*)(ws + WS_WCO), scr, r, lane); continue; } r -= I_SQ;
        if (r < I_UP) { transpose_item(p.w_up, DM, FF, p.g_mlp, false, (bf16*)(ws + WS_WUP), scr, r, lane); continue; } r -= I_UP;
        transpose_item(p.w_down, FF, DM, nullptr, false, (bf16*)(ws + WS_WDOWN), scr, r, lane);
    }
    for (int m = gw; m < M; m += NGW) rms_row_to_bf16(p.x + (size_t)m * DM, nullptr, (bf16*)(ws + WS_XN) + (size_t)m * DM, lane);
    for (int m = gw; m < MM; m += NGW) rms_row_to_bf16(p.mem + (size_t)m * DM, p.g_mem, (bf16*)(ws + WS_MEMN) + (size_t)m * DM, lane);
    float2* rope = (float2*)(ws + WS_ROPE);
    for (int i = bid * NTHR + tid; i < M * 32; i += nblk * NTHR) {
        const int row = i >> 5, d = i & 31; float c, s; sincos_d((double)p.pos[row] * INV_FREQ[d], c, s); rope[i] = make_float2(c, s); }
}

namespace pg8 {
#define PG8_LAS __attribute__((address_space(3)))
typedef unsigned short bf16_t;
typedef short bf16x8 __attribute__((ext_vector_type(8)));
typedef float f32x4 __attribute__((ext_vector_type(4)));
typedef unsigned u32x4 __attribute__((ext_vector_type(4)));
typedef unsigned u32x2 __attribute__((ext_vector_type(2)));
constexpr int BM = 256, BK = 64, HALF = 128, HTB = HALF * BK * 2  , STAGE_BYTES = 8 * HTB, NXCD = 8, WGM = 8;

__host__ __device__ __forceinline__ int lds_byte(int r, int c) { const int st = (r >> 4) * 2 + (c >> 5), rr = r & 15, cc = c & 31, ob = rr * 64 + cc * 2; return st * 1024 + (ob ^ (((ob >> 9) & 1) << 5)); }
__host__ __device__ __forceinline__ void stage_rc(int b, int& R, int& C) { const int st = b / 1024, sb = b % 1024, swz = sb ^ (((sb >> 9) & 1) << 5); R = (st >> 1) * 16 + swz / 64; C = (st & 1) * 32 + (swz % 64) / 2; }
__host__ __device__ __forceinline__ int perm32(int rho) { const int n = rho >> 4, i = rho & 15; return 8 * (i >> 2) + 4 * n + (i & 3); }

struct Unit { int pm, pn, alt; };
struct Gemm { const bf16_t* A; const bf16_t* Bt; const bf16_t* A2; const bf16_t* Bt2; int K; };

struct StaticOrder {
    int nM, nN, nwg, G, c;
    __host__ __device__ void init(int M_, int N_, int G_, int c_) { nM = M_ / BM; nN = N_ / BM; nwg = nM * nN; G = G_; c = c_; }
    __host__ __device__ bool map(long L, Unit& u) const {
        if (L >= nwg) return false;
        int wgid = (int)L; { const int q = nwg / NXCD, r = nwg % NXCD, xcd = wgid % NXCD, off = wgid / NXCD; wgid = (xcd < r ? xcd * (q + 1) : r * (q + 1) + (xcd - r) * q) + off; }
        const int nig = WGM * nN, gid = wgid / nig, fm = gid * WGM, gsz = (nM - fm) < WGM ? (nM - fm) : WGM;
        u.pm = fm + ((wgid % nig) % gsz); u.pn = (wgid % nig) / gsz; u.alt = 0; return true;
    }
    __host__ __device__ bool next(int i, Unit& u) const { return map((long)i * G + c, u); }
    __device__ __forceinline__ void a_ready(const Unit&) const {}
    __device__ __forceinline__ void done(const Unit&) const {}
};
struct TwoOrder : StaticOrder {
    int n2M, n2N;
    __host__ __device__ bool next(int i, Unit& u) const {
        const long L = (long)i * G + c;
        if (L < nwg) return map(L, u);
        const int r = (int)(L - nwg); if (r >= n2M * n2N) return false;
        u.pm = r % n2M; u.pn = r / n2M; u.alt = 1; return true;
    }
};
__device__ __forceinline__ unsigned cvt_pk_bf16(float lo, float hi) { unsigned r; asm volatile("v_cvt_pk_bf16_f32 %0, %1, %2" : "=v"(r) : "v"(lo), "v"(hi)); return r; }

__device__ __forceinline__ float rstd_ss(const float* ss, int row) {
    const f32x4* s4 = (const f32x4*)(ss + (size_t)row * 16); float t = 0.f;
#pragma unroll
    for (int i = 0; i < 4; ++i) { const f32x4 v = s4[i]; t += (v.x + v.y) + (v.z + v.w); }
    return 1.0f / sqrtf(t * (1.f / DM) + EPS);
}
struct EpiProj {
    static constexpr bool PERM = true, AFTER_DRAIN = false;
    bf16_t* proj; bf16_t* kvm; const float* rope;
    __device__ __forceinline__ void operator()(const f32x4 (&acc)[2][2][4][2], const Unit& u, int wr, int wc, int fr, int fq) const {
        const int row0 = u.pm * BM + wr * 64 + fr, col0 = u.pn * BM + wc * 32 + 8 * fq;
        if (u.alt) {
#pragma unroll
            for (int ai = 0; ai < 2; ++ai)
#pragma unroll
                for (int m = 0; m < 4; ++m) { bf16_t* rowp = kvm + (size_t)(row0 + ai * HALF + m * 16) * 2048 + col0;
#pragma unroll
                    for (int bj = 0; bj < 2; ++bj) { const f32x4 v0 = acc[ai][bj][m][0], v1 = acc[ai][bj][m][1];
                        u32x4 w; w.x = cvt_pk_bf16(v0[0], v0[1]); w.y = cvt_pk_bf16(v0[2], v0[3]); w.z = cvt_pk_bf16(v1[0], v1[1]); w.w = cvt_pk_bf16(v1[2], v1[3]);
                        *(u32x4*)(rowp + bj * HALF) = w; } }
            return;
        }
        const int d0 = ((wc & 1) * 32 + 8 * fq) >> 1;
#pragma unroll
        for (int ai = 0; ai < 2; ++ai)
#pragma unroll
            for (int m = 0; m < 4; ++m) { const int row = row0 + ai * HALF + m * 16;
                const f32x4 cs0 = *(const f32x4*)(rope + (size_t)row * 64 + 2 * d0), cs1 = *(const f32x4*)(rope + (size_t)row * 64 + 2 * d0 + 4);
#pragma unroll
                for (int bj = 0; bj < 2; ++bj) { const int cb = u.pn * BM + bj * HALF;
                    const bool roped = col_roped(cb); const float sc = (cb < C_KA || (cb >= C_QD && cb < C_KD)) ? C2 : 1.f;
                    f32x4 v0 = acc[ai][bj][m][0], v1 = acc[ai][bj][m][1];
                    if (roped) {
                        const f32x4 a = v0, b = v1;
                        v0[0] = a[0] * cs0[0] - a[1] * cs0[1]; v0[1] = a[1] * cs0[0] + a[0] * cs0[1];
                        v0[2] = a[2] * cs0[2] - a[3] * cs0[3]; v0[3] = a[3] * cs0[2] + a[2] * cs0[3];
                        v1[0] = b[0] * cs1[0] - b[1] * cs1[1]; v1[1] = b[1] * cs1[0] + b[0] * cs1[1];
                        v1[2] = b[2] * cs1[2] - b[3] * cs1[3]; v1[3] = b[3] * cs1[2] + b[2] * cs1[3];
                    }
                    v0 = v0 * sc; v1 = v1 * sc;
                    u32x4 w; w.x = cvt_pk_bf16(v0[0], v0[1]); w.y = cvt_pk_bf16(v0[2], v0[3]); w.z = cvt_pk_bf16(v1[0], v1[1]); w.w = cvt_pk_bf16(v1[2], v1[3]);
                    *(u32x4*)(proj + (size_t)row * NP + col0 + bj * HALF) = w; } }
    }
};
struct EpiRes {
    static constexpr bool PERM = false, AFTER_DRAIN = false;
    const float* xi; float* xo; bf16_t* xb; float* ss;
    __device__ __forceinline__ void operator()(const f32x4 (&acc)[2][2][4][2], const Unit& u, int wr, int wc, int fr, int fq) const {
        const int row0 = u.pm * BM + wr * 64 + fr, col0 = u.pn * BM + wc * 32 + 4 * fq;
#pragma unroll
        for (int ai = 0; ai < 2; ++ai)
#pragma unroll
            for (int m = 0; m < 4; ++m) { const int row = row0 + ai * HALF + m * 16; const size_t off = (size_t)row * DM + col0; float q = 0.f;
#pragma unroll
                for (int bj = 0; bj < 2; ++bj)
#pragma unroll
                    for (int n = 0; n < 2; ++n) { const size_t c = off + bj * HALF + n * 16; const f32x4 r = *(const f32x4*)(xi + c) + acc[ai][bj][m][n];
                        *(f32x4*)(xo + c) = r; q += (r[0] * r[0] + r[1] * r[1]) + (r[2] * r[2] + r[3] * r[3]);
                        if (xb) { u32x2 w; w.x = cvt_pk_bf16(r[0], r[1]); w.y = cvt_pk_bf16(r[2], r[3]); *(u32x2*)(xb + c) = w; } }
                q += __shfl_xor(q, 16); q += __shfl_xor(q, 32);
                if (fq == 0) ss[(size_t)row * 16 + u.pn * 4 + wc] = q;
                if (m & 1) asm volatile("" ::: "memory"); }
    }
};
template <bool XF> struct EpiResB {
    static constexpr bool PERM = true, AFTER_DRAIN = false;
    const float* xf; const bf16_t* xb_in; bf16_t* xb_out; float* ss;
    __device__ __forceinline__ void operator()(const f32x4 (&acc)[2][2][4][2], const Unit& u, int wr, int wc, int fr, int fq) const {
        const int row0 = u.pm * BM + wr * 64 + fr, col0 = u.pn * BM + wc * 32 + 8 * fq;
#pragma unroll
        for (int ai = 0; ai < 2; ++ai)
#pragma unroll
            for (int m = 0; m < 4; ++m) { const int row = row0 + ai * HALF + m * 16; const size_t off = (size_t)row * DM + col0; float q = 0.f;
#pragma unroll
                for (int bj = 0; bj < 2; ++bj) { f32x4 r0, r1;
                    if (XF) { r0 = *(const f32x4*)(xf + off + bj * HALF); r1 = *(const f32x4*)(xf + off + bj * HALF + 4); }
                    else { const u32x4 w = *(const u32x4*)(xb_in + off + bj * HALF);
                        r0 = (f32x4){__uint_as_float(w.x << 16), __uint_as_float(w.x & 0xffff0000u), __uint_as_float(w.y << 16), __uint_as_float(w.y & 0xffff0000u)};
                        r1 = (f32x4){__uint_as_float(w.z << 16), __uint_as_float(w.z & 0xffff0000u), __uint_as_float(w.w << 16), __uint_as_float(w.w & 0xffff0000u)}; }
                    r0 = r0 + acc[ai][bj][m][0]; r1 = r1 + acc[ai][bj][m][1];
                    q += ((r0[0] * r0[0] + r0[1] * r0[1]) + (r0[2] * r0[2] + r0[3] * r0[3])) + ((r1[0] * r1[0] + r1[1] * r1[1]) + (r1[2] * r1[2] + r1[3] * r1[3]));
                    u32x4 w; w.x = cvt_pk_bf16(r0[0], r0[1]); w.y = cvt_pk_bf16(r0[2], r0[3]); w.z = cvt_pk_bf16(r1[0], r1[1]); w.w = cvt_pk_bf16(r1[2], r1[3]);
                    *(u32x4*)(xb_out + off + bj * HALF) = w; }
                q += __shfl_xor(q, 16); q += __shfl_xor(q, 32);
                if (fq == 0) ss[(size_t)row * 16 + u.pn * 4 + wc] = q;
                if (m & 1) asm volatile("" ::: "memory"); }
    }
};
struct EpiResF {
    static constexpr bool PERM = false, AFTER_DRAIN = false;
    const bf16_t* xb; float* xo; float* ss;
    __device__ __forceinline__ void operator()(const f32x4 (&acc)[2][2][4][2], const Unit& u, int wr, int wc, int fr, int fq) const {
        const int row0 = u.pm * BM + wr * 64 + fr, col0 = u.pn * BM + wc * 32 + 4 * fq;
#pragma unroll
        for (int ai = 0; ai < 2; ++ai)
#pragma unroll
            for (int m = 0; m < 4; ++m) { const int row = row0 + ai * HALF + m * 16; const size_t off = (size_t)row * DM + col0; float q = 0.f;
#pragma unroll
                for (int bj = 0; bj < 2; ++bj)
#pragma unroll
                    for (int n = 0; n < 2; ++n) { const size_t c = off + bj * HALF + n * 16; const u32x2 w = *(const u32x2*)(xb + c);
                        const f32x4 r = (f32x4){__uint_as_float(w.x << 16), __uint_as_float(w.x & 0xffff0000u), __uint_as_float(w.y << 16), __uint_as_float(w.y & 0xffff0000u)} + acc[ai][bj][m][n];
                        *(f32x4*)(xo + c) = r; q += (r[0] * r[0] + r[1] * r[1]) + (r[2] * r[2] + r[3] * r[3]); }
                q += __shfl_xor(q, 16); q += __shfl_xor(q, 32);
                if (fq == 0) ss[(size_t)row * 16 + u.pn * 4 + wc] = q;
                if (m & 1) asm volatile("" ::: "memory"); }
    }
};
template <int ACT> struct EpiScaleBf16 {
    static constexpr bool PERM = true, AFTER_DRAIN = false;
    bf16_t* O; int ldc; const float* ss; float mul;
    __device__ __forceinline__ void operator()(const f32x4 (&acc)[2][2][4][2], const Unit& u, int wr, int wc, int fr, int fq) const {
        const int row0 = u.pm * BM + wr * 64 + fr, col0 = u.pn * BM + wc * 32 + 8 * fq;
#pragma unroll
        for (int ai = 0; ai < 2; ++ai)
#pragma unroll
            for (int m = 0; m < 4; ++m) { const int row = row0 + ai * HALF + m * 16; const float rs = rstd_ss(ss, row) * mul; bf16_t* rowp = O + (size_t)row * ldc + col0;
#pragma unroll
                for (int bj = 0; bj < 2; ++bj) { f32x4 v0 = acc[ai][bj][m][0] * rs, v1 = acc[ai][bj][m][1] * rs;
                    if (ACT == 1) {
#pragma unroll
                        for (int e = 0; e < 4; ++e) { const float a = fmaxf(v0[e], 0.f), b = fmaxf(v1[e], 0.f); v0[e] = a * a; v1[e] = b * b; } }
                    u32x4 w; w.x = cvt_pk_bf16(v0[0], v0[1]); w.y = cvt_pk_bf16(v0[2], v0[3]); w.z = cvt_pk_bf16(v1[0], v1[1]); w.w = cvt_pk_bf16(v1[2], v1[3]);
                    *(u32x4*)(rowp + bj * HALF) = w; } }
    }
};

template <class Epi, class Sched, bool ALIGN_EPI = false, bool SP2 = false>
__device__ __forceinline__ void gemm_phase(PG8_LAS unsigned char* lds, const Gemm g, const Sched& S, const Epi& E) {
    const int tid = threadIdx.x, wid = __builtin_amdgcn_readfirstlane(tid >> 6), lane = tid & 63, wr = wid >> 2, wc = wid & 3, fr = lane & 15, fq = lane >> 4;
    const int K = g.K, nt = K / BK;
    unsigned voffA[2], voffB[2];
#pragma unroll
    for (int i = 0; i < 2; ++i) { int R, C; stage_rc(tid * 16 + i * 8192, R, C); const int Rb = Epi::PERM ? ((R & ~31) + perm32(R & 31)) : R;
        voffA[i] = (unsigned)(R * K + C) * 2u; voffB[i] = (unsigned)(Rb * K + C) * 2u; }
    const size_t kstep = (size_t)(BK * 2);
    const size_t hstep = (size_t)HALF * K * 2;
    const size_t tstep = 2 * hstep;
    const unsigned ldsw = (unsigned)wid * 1024u;
    const int aoff = lds_byte(wr * 64 + fr, fq * 8), boff = lds_byte(wc * 32 + fr, fq * 8);
#define PG8_SA(b, h) (((b) * 2 + (h)) * HTB)
#define PG8_SB(b, h) ((4 + (b) * 2 + (h)) * HTB)
#define PG8_STAGE(bufoff, gbase, voff) do { _Pragma("unroll") for (int _i = 0; _i < 2; ++_i) \
        __builtin_amdgcn_global_load_lds((const unsigned*)((const char*)(gbase) + (voff)[_i]), (PG8_LAS unsigned*)(lds + (bufoff) + ldsw + _i * 8192), 16, 0, 0); } while (0)
#define PG8_LDA(dst, b, h) do { _Pragma("unroll") for (int m = 0; m < 4; ++m) _Pragma("unroll") for (int k = 0; k < 2; ++k) dst[m][k] = *(const PG8_LAS bf16x8*)(lds + PG8_SA(b, h) + aoff + m * 2048 + k * 1024); } while (0)
#define PG8_LDB(dst, b, h) do { _Pragma("unroll") for (int n = 0; n < 2; ++n) _Pragma("unroll") for (int k = 0; k < 2; ++k) dst[n][k] = *(const PG8_LAS bf16x8*)(lds + PG8_SB(b, h) + boff + n * 2048 + k * 1024); } while (0)
#define PG8_MMA(ai, bj, At, Bt) do { __builtin_amdgcn_s_setprio(1); _Pragma("unroll") for (int m = 0; m < 4; ++m) _Pragma("unroll") for (int n = 0; n < 2; ++n) _Pragma("unroll") for (int k = 0; k < 2; ++k) \
        acc[ai][bj][m][n] = __builtin_amdgcn_mfma_f32_16x16x32_bf16(Bt[n][k], At[m][k], acc[ai][bj][m][n], 0, 0, 0); __builtin_amdgcn_s_setprio(0); } while (0)
#define PG8_WAIT_V(n) asm volatile("s_waitcnt vmcnt(" #n ")" ::: "memory")
#define PG8_WAIT_L(n) asm volatile("s_waitcnt lgkmcnt(" #n ")" ::: "memory")
#define PG8_BAR __builtin_amdgcn_s_barrier()
#define PG8_SCHED __builtin_amdgcn_sched_barrier(0)
    Unit cur, nxt; int ui = 0;
    if (!S.next(0, cur)) return;
    f32x4 acc[2][2][4][2];
#pragma unroll
    for (int a = 0; a < 2; ++a)
#pragma unroll
        for (int b = 0; b < 2; ++b)
#pragma unroll
            for (int m = 0; m < 4; ++m)
#pragma unroll
                for (int n = 0; n < 2; ++n) acc[a][b][m][n] = (f32x4){0.f, 0.f, 0.f, 0.f};
    bf16x8 At[4][2], B0[2][2], B1[2][2];
    const char* cA = (const char*)(cur.alt ? g.A2 : g.A) + (size_t)cur.pm * tstep; const char* cB = (const char*)(cur.alt ? g.Bt2 : g.Bt) + (size_t)cur.pn * tstep;
    S.a_ready(cur);
    if constexpr (SP2) {
        PG8_STAGE(PG8_SB(0, 0), cB, voffB); PG8_STAGE(PG8_SB(0, 1), cB + hstep, voffB); PG8_STAGE(PG8_SA(0, 0), cA, voffA); PG8_STAGE(PG8_SA(0, 1), cA + hstep, voffA);
        if (wr == 1) PG8_BAR;
        PG8_WAIT_V(2); PG8_BAR;
        PG8_STAGE(PG8_SB(1, 0), cB + kstep, voffB); PG8_STAGE(PG8_SA(1, 0), cA + kstep, voffA); PG8_STAGE(PG8_SB(1, 1), cB + hstep + kstep, voffB);
        PG8_WAIT_V(6); PG8_BAR;
    } else {
        PG8_STAGE(PG8_SB(0, 0), cB, voffB); PG8_STAGE(PG8_SA(0, 0), cA, voffA); PG8_STAGE(PG8_SB(0, 1), cB + hstep, voffB); PG8_STAGE(PG8_SA(0, 1), cA + hstep, voffA);
        if (wr == 1) PG8_BAR;
        PG8_WAIT_V(4); PG8_BAR;
        PG8_STAGE(PG8_SB(1, 0), cB + kstep, voffB); PG8_STAGE(PG8_SA(1, 0), cA + kstep, voffA); PG8_STAGE(PG8_SB(1, 1), cB + hstep + kstep, voffB);
        PG8_WAIT_V(6); PG8_BAR;
    }
    for (;;) {
        const bool has_next = S.next(ui + 1, nxt);
        const char* nA = has_next ? (const char*)(nxt.alt ? g.A2 : g.A) + (size_t)nxt.pm * tstep : cA; const char* nB = has_next ? (const char*)(nxt.alt ? g.Bt2 : g.Bt) + (size_t)nxt.pn * tstep : cB;
        for (int t = 0; t < nt; t += 2) {
            const bool last = (t == nt - 2);
            const char* a1 = cA + (size_t)(t + 1) * kstep;
            const char* a2 = last ? nA : cA + (size_t)(t + 2) * kstep; const char* b2 = last ? nB : cB + (size_t)(t + 2) * kstep;
            const char* a3 = a2 + kstep; const char* b3 = b2 + kstep;
            if (last && has_next) S.a_ready(nxt);
            if constexpr (SP2) {
            PG8_LDB(B0, 0, 0); PG8_LDB(B1, 0, 1); PG8_SCHED; PG8_LDA(At, 0, 0); PG8_STAGE(PG8_SA(1, 1), a1 + hstep, voffA);
            PG8_WAIT_V(8); PG8_WAIT_L(0); PG8_BAR; PG8_MMA(0, 0, At, B0); PG8_MMA(0, 1, At, B1); PG8_BAR; PG8_SCHED;
            PG8_LDA(At, 0, 1); PG8_STAGE(PG8_SB(0, 0), b2, voffB); PG8_STAGE(PG8_SB(0, 1), b2 + hstep, voffB); PG8_STAGE(PG8_SA(0, 0), a2, voffA);
            PG8_WAIT_V(8); PG8_WAIT_L(0); PG8_BAR; PG8_MMA(1, 0, At, B0); PG8_MMA(1, 1, At, B1); PG8_BAR; PG8_SCHED;
            PG8_LDB(B0, 1, 0); PG8_LDB(B1, 1, 1); PG8_SCHED; PG8_LDA(At, 1, 0); PG8_STAGE(PG8_SA(0, 1), a2 + hstep, voffA);
            PG8_WAIT_V(8); PG8_WAIT_L(0); PG8_BAR; PG8_MMA(0, 0, At, B0); PG8_MMA(0, 1, At, B1); PG8_BAR; PG8_SCHED;
            PG8_LDA(At, 1, 1); PG8_STAGE(PG8_SB(1, 0), b3, voffB); PG8_STAGE(PG8_SB(1, 1), b3 + hstep, voffB); PG8_STAGE(PG8_SA(1, 0), a3, voffA);
            PG8_WAIT_V(8); PG8_WAIT_L(0); PG8_BAR; PG8_MMA(1, 0, At, B0); PG8_MMA(1, 1, At, B1); PG8_BAR; PG8_SCHED;
            } else {
            PG8_LDB(B0, 0, 0); PG8_SCHED; PG8_LDA(At, 0, 0); PG8_STAGE(PG8_SA(1, 1), a1 + hstep, voffA);
            PG8_WAIT_L(8); PG8_BAR; PG8_WAIT_L(0); PG8_MMA(0, 0, At, B0); PG8_BAR; PG8_SCHED;
            PG8_LDB(B1, 0, 1); PG8_STAGE(PG8_SB(0, 0), b2, voffB);
            PG8_BAR; PG8_WAIT_L(0); PG8_MMA(0, 1, At, B1); PG8_BAR;
            PG8_LDA(At, 0, 1); PG8_STAGE(PG8_SA(0, 0), a2, voffA);
            PG8_BAR; PG8_WAIT_L(0); PG8_MMA(1, 0, At, B0); PG8_BAR; PG8_SCHED;
            PG8_STAGE(PG8_SB(0, 1), b2 + hstep, voffB);
            PG8_WAIT_V(6); PG8_BAR; PG8_MMA(1, 1, At, B1); PG8_BAR;
            PG8_LDB(B0, 1, 0); PG8_SCHED; PG8_LDA(At, 1, 0); PG8_STAGE(PG8_SA(0, 1), a2 + hstep, voffA);
            PG8_WAIT_L(8); PG8_BAR; PG8_WAIT_L(0); PG8_MMA(0, 0, At, B0); PG8_BAR; PG8_SCHED;
            PG8_LDB(B1, 1, 1); PG8_STAGE(PG8_SB(1, 0), b3, voffB);
            PG8_BAR; PG8_WAIT_L(0); PG8_MMA(0, 1, At, B1); PG8_BAR;
            PG8_LDA(At, 1, 1); PG8_STAGE(PG8_SA(1, 0), a3, voffA);
            PG8_BAR; PG8_WAIT_L(0); PG8_MMA(1, 0, At, B0); PG8_BAR; PG8_SCHED;
            PG8_STAGE(PG8_SB(1, 1), b3 + hstep, voffB);
            PG8_WAIT_V(6); PG8_BAR; PG8_MMA(1, 1, At, B1); PG8_BAR;
            }
        }
        if constexpr (ALIGN_EPI) { if (wr == 0) PG8_BAR; }
        if constexpr (!Epi::AFTER_DRAIN) { E(acc, cur, wr, wc, fr, fq); S.done(cur); }
        if (!has_next) break;
#pragma unroll
        for (int a = 0; a < 2; ++a)
#pragma unroll
            for (int b = 0; b < 2; ++b)
#pragma unroll
                for (int m = 0; m < 4; ++m)
#pragma unroll
                    for (int n = 0; n < 2; ++n) acc[a][b][m][n] = (f32x4){0.f, 0.f, 0.f, 0.f};
        cur = nxt; cA = nA; cB = nB; ++ui;
        if constexpr (ALIGN_EPI) { if (wr == 1) PG8_BAR; }
    }
    PG8_WAIT_V(0);
    if constexpr (!ALIGN_EPI) { if (wr == 0) PG8_BAR; }
    PG8_BAR;
    if constexpr (Epi::AFTER_DRAIN) { E.fused(acc, cur, wr, wc, fr, fq, lds, wid, lane); S.done(cur); }
#undef PG8_SA
#undef PG8_SB
#undef PG8_STAGE
#undef PG8_LDA
#undef PG8_LDB
#undef PG8_MMA
#undef PG8_WAIT_V
#undef PG8_WAIT_L
#undef PG8_BAR
#undef PG8_SCHED
}
}
__device__ __forceinline__ void swa_naive(const Params& p, int bid, int nblk, int tid) {
    const bf16* proj = (const bf16*)(p.ws + WS_PROJ); bf16* att = (bf16*)(p.ws + WS_ATT);
    for (int base = bid * NTHR; base < M * 8; base += nblk * NTHR) {
        const int idx = base + tid, hq = idx >> 15, row = idx & (M - 1), t = row & (SEQ - 1), kvh = hq >> 2;
        float q[64], o[64];
        { const u32x4* q4 = (const u32x4*)(proj + (size_t)row * NP + C_QA + hq * 64);
#pragma unroll
          for (int i = 0; i < 8; ++i) { const u32x4 w = q4[i]; q[8 * i] = bflo(w.x); q[8 * i + 1] = bfhi(w.x); q[8 * i + 2] = bflo(w.y); q[8 * i + 3] = bfhi(w.y); q[8 * i + 4] = bflo(w.z); q[8 * i + 5] = bfhi(w.z); q[8 * i + 6] = bflo(w.w); q[8 * i + 7] = bfhi(w.w); } }
#pragma unroll
        for (int d = 0; d < 64; ++d) o[d] = 0.f;
        float m = p.sinks[hq] * LOG2E, l = 1.f;
        const int nk = (t < 127 ? t : 127) + 1;
        for (int j = 0; j < nk; ++j) {
            const size_t kr = (size_t)(row - j) * NP;
            const u32x4* k4 = (const u32x4*)(proj + kr + C_KA + kvh * 64); const u32x4* v4 = (const u32x4*)(proj + kr + C_VA + kvh * 64);
            float s = 0.f;
#pragma unroll
            for (int i = 0; i < 8; ++i) { const u32x4 w = k4[i]; s += q[8 * i] * bflo(w.x) + q[8 * i + 1] * bfhi(w.x) + q[8 * i + 2] * bflo(w.y) + q[8 * i + 3] * bfhi(w.y) + q[8 * i + 4] * bflo(w.z) + q[8 * i + 5] * bfhi(w.z) + q[8 * i + 6] * bflo(w.w) + q[8 * i + 7] * bfhi(w.w); }
            const float mn = fmaxf(m, s), a = exp2f(m - mn), pp = exp2f(s - mn); l = l * a + pp; m = mn;
#pragma unroll
            for (int i = 0; i < 8; ++i) { const u32x4 w = v4[i];
                o[8 * i] = o[8 * i] * a + pp * bflo(w.x); o[8 * i + 1] = o[8 * i + 1] * a + pp * bfhi(w.x); o[8 * i + 2] = o[8 * i + 2] * a + pp * bflo(w.y); o[8 * i + 3] = o[8 * i + 3] * a + pp * bfhi(w.y);
                o[8 * i + 4] = o[8 * i + 4] * a + pp * bflo(w.z); o[8 * i + 5] = o[8 * i + 5] * a + pp * bfhi(w.z); o[8 * i + 6] = o[8 * i + 6] * a + pp * bflo(w.w); o[8 * i + 7] = o[8 * i + 7] * a + pp * bfhi(w.w); }
        }
        const float rl = 1.f / l;
        u32x4* o4 = (u32x4*)(att + (size_t)row * DM + hq * 64);
#pragma unroll
        for (int i = 0; i < 8; ++i) { u32x4 w; w.x = pk2(o[8 * i] * rl, o[8 * i + 1] * rl); w.y = pk2(o[8 * i + 2] * rl, o[8 * i + 3] * rl); w.z = pk2(o[8 * i + 4] * rl, o[8 * i + 5] * rl); w.w = pk2(o[8 * i + 6] * rl, o[8 * i + 7] * rl); o4[i] = w; }
    }
}
__device__ __forceinline__ void diff_naive(const Params& p, int bid, int nblk, int tid) {
    const bf16* proj = (const bf16*)(p.ws + WS_PROJ); float* od = (float*)(p.ws + WS_ODIFF);
    for (int base = bid * NTHR; base < M * 16; base += nblk * NTHR) {
        const int idx = base + tid, sel = __builtin_amdgcn_readfirstlane(idx >> 15), row = idx & (M - 1), t = row & (SEQ - 1);
        const int hc = sel >> 1, half = sel & 1, h = hc >> 1, c = hc & 1;
        const int b = __builtin_amdgcn_readfirstlane(row >> 12);
        const int tmax = __builtin_amdgcn_readfirstlane((row | 63) & (SEQ - 1));
        float q[64], o[64];
        { const u32x4* q4 = (const u32x4*)(proj + (size_t)row * NP + C_QD + hc * 64);
#pragma unroll
          for (int i = 0; i < 8; ++i) { const u32x4 w = q4[i]; q[8 * i] = bflo(w.x); q[8 * i + 1] = bfhi(w.x); q[8 * i + 2] = bflo(w.y); q[8 * i + 3] = bfhi(w.y); q[8 * i + 4] = bflo(w.z); q[8 * i + 5] = bfhi(w.z); q[8 * i + 6] = bflo(w.w); q[8 * i + 7] = bfhi(w.w); } }
#pragma unroll
        for (int d = 0; d < 64; ++d) o[d] = 0.f;
        float m = -1e30f, l = 0.f;
        for (int kt = 0; kt <= tmax; ++kt) {
            const size_t kr = (size_t)(b * SEQ + kt) * NP;
            const u32x4* k4 = (const u32x4*)(proj + kr + C_KD + hc * 64); const u32x4* v4 = (const u32x4*)(proj + kr + C_VD + h * 128 + half * 64);
            float s = 0.f;
#pragma unroll
            for (int i = 0; i < 8; ++i) { const u32x4 w = k4[i]; s += q[8 * i] * bflo(w.x) + q[8 * i + 1] * bfhi(w.x) + q[8 * i + 2] * bflo(w.y) + q[8 * i + 3] * bfhi(w.y) + q[8 * i + 4] * bflo(w.z) + q[8 * i + 5] * bfhi(w.z) + q[8 * i + 6] * bflo(w.w) + q[8 * i + 7] * bfhi(w.w); }
            if (kt > t) s = -1e30f;
            const float mn = fmaxf(m, s), a = exp2f(m - mn), pp = (kt > t) ? 0.f : exp2f(s - mn); l = l * a + pp; m = mn;
#pragma unroll
            for (int i = 0; i < 8; ++i) { const u32x4 w = v4[i];
                o[8 * i] = o[8 * i] * a + pp * bflo(w.x); o[8 * i + 1] = o[8 * i + 1] * a + pp * bfhi(w.x); o[8 * i + 2] = o[8 * i + 2] * a + pp * bflo(w.y); o[8 * i + 3] = o[8 * i + 3] * a + pp * bfhi(w.y);
                o[8 * i + 4] = o[8 * i + 4] * a + pp * bflo(w.z); o[8 * i + 5] = o[8 * i + 5] * a + pp * bfhi(w.z); o[8 * i + 6] = o[8 * i + 6] * a + pp * bflo(w.w); o[8 * i + 7] = o[8 * i + 7] * a + pp * bfhi(w.w); }
        }
        const float rl = 1.f / l;
        f32x4* o4 = (f32x4*)(od + ((size_t)c * M + row) * 512 + h * 128 + half * 64);
#pragma unroll
        for (int i = 0; i < 16; ++i) o4[i] = (f32x4){o[4 * i] * rl, o[4 * i + 1] * rl, o[4 * i + 2] * rl, o[4 * i + 3] * rl};
    }
}
__device__ __forceinline__ void diff_combine_naive(const Params& p, int gw, int ngw, int lane) {
    const float* od = (const float*)(p.ws + WS_ODIFF); bf16* att = (bf16*)(p.ws + WS_ATT);
    const float lam = calc_lambda(p);
    for (int m = gw; m < M; m += ngw) {
#pragma unroll
        for (int h = 0; h < 4; ++h) {
            const float2 a = *(const float2*)(od + (size_t)m * 512 + h * 128 + 2 * lane), b = *(const float2*)(od + ((size_t)M + m) * 512 + h * 128 + 2 * lane);
            const float v0 = a.x - lam * b.x, v1 = a.y - lam * b.y;
            const float rstd = 1.0f / sqrtf(wave_sum(v0 * v0 + v1 * v1) * (1.f / 128.f) + EPS);
            const float2 g = *(const float2*)(p.g_diff + 2 * lane);
            *(unsigned*)(att + (size_t)m * DM + 512 + h * 128 + 2 * lane) = pk2(v0 * rstd * g.x * 0.8f, v1 * rstd * g.y * 0.8f);
        }
    }
}
__device__ __forceinline__ void cross_naive(const Params& p, LAS unsigned char* lds, int bid, int nblk, int tid) {
    const bf16* qc = (const bf16*)(p.ws + WS_QC); const bf16* kvm = (const bf16*)(p.ws + WS_KVM); bf16* oc = (bf16*)(p.ws + WS_OC);
    const int sub = tid >> 8, tm = tid & 255, w4 = (tid >> 6) & 3, lane = tid & 63;
    LAS float* qs = (LAS float*)lds + sub * 256; LAS float* ps = (LAS float*)lds + 512 + sub * 256; LAS float* red = (LAS float*)lds + 1024 + sub * 8;
    for (int i2 = bid; i2 < M * 2; i2 += nblk) {
        const int item = i2 * 2 + sub, row = item >> 2, head = item & 3, b = row >> 12;
        qs[tm] = bf2f(qc[(size_t)row * DM + head * 256 + tm]);
        __syncthreads();
        const u32x4* k4 = (const u32x4*)(kvm + (size_t)(b * MEML + tm) * 2048 + head * 256);
        float s = 0.f;
        for (int i = 0; i < 32; ++i) { const u32x4 w = k4[i]; const LAS float* qq = qs + 8 * i;
            s += qq[0] * bflo(w.x) + qq[1] * bfhi(w.x) + qq[2] * bflo(w.y) + qq[3] * bfhi(w.y) + qq[4] * bflo(w.z) + qq[5] * bfhi(w.z) + qq[6] * bflo(w.w) + qq[7] * bfhi(w.w); }
        float mx = wave_max(s); if (lane == 0) red[w4] = mx;
        __syncthreads();
        mx = fmaxf(fmaxf(red[0], red[1]), fmaxf(red[2], red[3]));
        const float e = exp2f(s - mx); ps[tm] = e;
        float sm = wave_sum(e); if (lane == 0) red[4 + w4] = sm;
        __syncthreads();
        sm = (red[4] + red[5]) + (red[6] + red[7]);
        const bf16* vp = kvm + (size_t)(b * MEML) * 2048 + 1024 + head * 256 + tm;
        float o = 0.f;
        for (int mm = 0; mm < MEML; ++mm) o += ps[mm] * bf2f(vp[(size_t)mm * 2048]);
        oc[(size_t)row * DM + head * 256 + tm] = (bf16)f2bf(o / sm);
        __syncthreads();
    }
}

namespace fa {
typedef short bf16x8 __attribute__((ext_vector_type(8)));
typedef short s16x4 __attribute__((ext_vector_type(4)));
typedef float f32x16 __attribute__((ext_vector_type(16)));
typedef float f32x4 __attribute__((ext_vector_type(4)));
typedef unsigned u32x4 __attribute__((ext_vector_type(4)));
constexpr int NW = 8, QBLK = 32, KVBLK = 64;
constexpr float THR = 8.f;
#define FA_SBAR() __builtin_amdgcn_sched_barrier(0)
#define FA_VMW() asm volatile("s_waitcnt vmcnt(0)" ::: "memory")
__device__ __forceinline__ int crow(int r, int hi) { return (r & 3) + 8 * (r >> 2) + 4 * hi; }
__device__ __forceinline__ unsigned cvtpk(float lo, float hi) { unsigned r; asm volatile("v_cvt_pk_bf16_f32 %0, %1, %2" : "=v"(r) : "v"(lo), "v"(hi)); return r; }

template <int NDQ> __device__ __forceinline__ int kswz(int row, int c) {
    if (NDQ == 4) return row * 128 + ((c ^ ((row >> 1) & 7)) << 4);
    else return row * (NDQ * 32) + ((c ^ (row & 15)) << 4);
}
template <int NDVT> __device__ __forceinline__ int v_st(int k, int c) { const int kk = (k & ~0xC) | ((k & 4) << 1) | ((k & 8) >> 1); return ((kk >> 3) * NDVT + (c >> 5)) * 512 + ((kk & 7) * 32 + (c & 31)) * 2; }
__device__ __forceinline__ int v_rd_base(int lane) { return ((lane & 3) << 3) | (((lane >> 2) & 3) << 6) | (((lane >> 4) & 1) << 5) | (((lane >> 5) & 1) << 8); }

__device__ __forceinline__ void mask_tile(f32x16& p0, f32x16& p1, int dq, unsigned W) {
    const float NEG = -__builtin_inff();
#pragma unroll
    for (int r = 0; r < 16; ++r) { const int c = (r & 3) + 8 * (r >> 2);
        if ((unsigned)(dq - c) >= W) p0[r] = NEG;
        if ((unsigned)(dq - c - 32) >= W) p1[r] = NEG; }
}
__device__ __forceinline__ void partialSM(f32x16& p0, f32x16& p1, float& m_reg, float& alpha) {
    float pmax = p0[0];
#pragma unroll
    for (int r = 1; r < 16; ++r) pmax = fmaxf(pmax, p0[r]);
#pragma unroll
    for (int r = 0; r < 16; ++r) pmax = fmaxf(pmax, p1[r]);
    { auto rr = __builtin_amdgcn_permlane32_swap(__float_as_uint(pmax), __float_as_uint(pmax), false, false); pmax = fmaxf(__uint_as_float(rr[0]), __uint_as_float(rr[1])); }
    float mn;
    if (__builtin_expect(__all((pmax - m_reg) <= THR), 1)) { mn = m_reg; alpha = 1.f; }
    else { mn = fmaxf(m_reg, pmax); alpha = __builtin_amdgcn_exp2f(m_reg - mn); m_reg = mn; }
#pragma unroll
    for (int r = 0; r < 16; ++r) p0[r] = p0[r] - mn;
#pragma unroll
    for (int r = 0; r < 16; ++r) p1[r] = p1[r] - mn;
#pragma unroll
    for (int r = 0; r < 16; ++r) p0[r] = __builtin_amdgcn_exp2f(p0[r]);
}
__device__ __forceinline__ void finishSM(f32x16& p0, f32x16& p1, float alpha, float& l_reg, bf16x8& pa0, bf16x8& pa1, bf16x8& pa2, bf16x8& pa3) {
#pragma unroll
    for (int r = 0; r < 16; ++r) p1[r] = __builtin_amdgcn_exp2f(p1[r]);
    float ps = 0.f;
#pragma unroll
    for (int r = 0; r < 16; ++r) ps += p0[r];
#pragma unroll
    for (int r = 0; r < 16; ++r) ps += p1[r];
    { auto rr = __builtin_amdgcn_permlane32_swap(__float_as_uint(ps), __float_as_uint(ps), false, false); ps = __uint_as_float(rr[0]) + __uint_as_float(rr[1]); }
    l_reg = l_reg * alpha + ps;
#define FA_PK4(P, B_, OUT) do { unsigned a0 = cvtpk(P[B_ + 0], P[B_ + 1]), a1 = cvtpk(P[B_ + 2], P[B_ + 3]); unsigned b0 = cvtpk(P[B_ + 4], P[B_ + 5]), b1 = cvtpk(P[B_ + 6], P[B_ + 7]); \
        auto r0 = __builtin_amdgcn_permlane32_swap(a0, b0, false, false); auto r1 = __builtin_amdgcn_permlane32_swap(a1, b1, false, false); \
        u32x4 w = {r0[0], r1[0], r0[1], r1[1]}; OUT = *reinterpret_cast<bf16x8*>(&w); } while (0)
    FA_PK4(p0, 0, pa0); FA_PK4(p0, 8, pa1); FA_PK4(p1, 0, pa2); FA_PK4(p1, 8, pa3);
#undef FA_PK4
}
template <int NDQ>
__device__ __forceinline__ void qkt(f32x16& p0, f32x16& p1, const char* Kb, int r32, int hi, const bf16x8* qr) {
    p0 = f32x16{}; p1 = f32x16{};
    constexpr int NA = NDQ < 8 ? NDQ : 8;
    const char* kb[NA];
#pragma unroll
    for (int dd = 0; dd < NA; ++dd) kb[dd] = Kb + kswz<NDQ>(r32, 2 * dd + hi);
#pragma unroll
    for (int d0 = 0; d0 < NDQ; ++d0) { const char* a = kb[d0 & (NA - 1)] + (d0 >> 3) * 256;
        const bf16x8 b0 = *reinterpret_cast<const bf16x8*>(a);
        const bf16x8 b1 = *reinterpret_cast<const bf16x8*>(a + 32 * NDQ * 32);
        p0 = __builtin_amdgcn_mfma_f32_32x32x16_bf16(b0, qr[d0], p0, 0, 0, 0);
        p1 = __builtin_amdgcn_mfma_f32_32x32x16_bf16(b1, qr[d0], p1, 0, 0, 0); }
}
template <int NDVT, int NDV>
__device__ __forceinline__ void pv_tile(f32x16* o, int vb, bf16x8 pa0, bf16x8 pa1, bf16x8 pa2, bf16x8 pa3) {
#define FA_TRRD(dst, off) asm volatile("ds_read_b64_tr_b16 %0, %1 offset:%2" : "=&v"(dst) : "v"(vb), "i"(off) : "memory")
#define FA_PV_D0(d0) do { s16x4 l0, l1, l2, l3, h0, h1, h2, h3; constexpr int b_ = (d0) * 512, ks_ = 2 * NDVT * 512, hf_ = NDVT * 512; \
        FA_TRRD(l0, b_); FA_TRRD(h0, b_ + hf_); FA_TRRD(l1, b_ + ks_); FA_TRRD(h1, b_ + ks_ + hf_); FA_TRRD(l2, b_ + 2 * ks_); FA_TRRD(h2, b_ + 2 * ks_ + hf_); FA_TRRD(l3, b_ + 3 * ks_); FA_TRRD(h3, b_ + 3 * ks_ + hf_); \
        asm volatile("s_waitcnt lgkmcnt(0)" ::: "memory"); FA_SBAR(); \
        o[d0] = __builtin_amdgcn_mfma_f32_32x32x16_bf16(pa0, (bf16x8){l0[0], l0[1], l0[2], l0[3], h0[0], h0[1], h0[2], h0[3]}, o[d0], 0, 0, 0); \
        o[d0] = __builtin_amdgcn_mfma_f32_32x32x16_bf16(pa1, (bf16x8){l1[0], l1[1], l1[2], l1[3], h1[0], h1[1], h1[2], h1[3]}, o[d0], 0, 0, 0); \
        o[d0] = __builtin_amdgcn_mfma_f32_32x32x16_bf16(pa2, (bf16x8){l2[0], l2[1], l2[2], l2[3], h2[0], h2[1], h2[2], h2[3]}, o[d0], 0, 0, 0); \
        o[d0] = __builtin_amdgcn_mfma_f32_32x32x16_bf16(pa3, (bf16x8){l3[0], l3[1], l3[2], l3[3], h3[0], h3[1], h3[2], h3[3]}, o[d0], 0, 0, 0); } while (0)
    FA_PV_D0(0); if constexpr (NDV > 1) FA_PV_D0(1); if constexpr (NDV > 2) FA_PV_D0(2); if constexpr (NDV > 3) FA_PV_D0(3);
#undef FA_PV_D0
#undef FA_TRRD
}

template <int NDQ, int NDVT, int NDV>
struct Core {
    static constexpr int KROW = NDQ * 32, SHM_K = 64 * KROW, SHM_V = 64 * NDVT * 64, NKL = NDQ / 4, NVL = NDVT / 2, LDS_NEED = 2 * SHM_V + 2 * SHM_K + NW * 256;
    static_assert(NKL >= 1 && NVL >= 1, "tile too small for 512 staging threads");
    __device__ __forceinline__ static void run(f32x16 (&o)[NDV], float& m_reg, float& l_reg, const bf16* Qw, int ldq, const bf16* Kg, const bf16* Vg, int ldk,
                                               int j_lo, int j_hi, int qlo, int W, char* lds, int vdoff) {
        const int tid = threadIdx.x, wid = __builtin_amdgcn_readfirstlane(tid >> 6), lane = tid & 63, r32 = lane & 31, hi = lane >> 5;
        const int NT = j_hi - j_lo, qm = qlo + r32 - 4 * hi;
        char* V_lds = lds; char* K_lds = lds + 2 * SHM_V;
        float* wsf = (float*)(lds + 2 * SHM_V + 2 * SHM_K) + wid * 64; float* al_l = wsf + 32;
        m_reg = -1e30f; l_reg = 0.f;
#pragma unroll
        for (int d = 0; d < NDV; ++d) o[d] = f32x16{};
        constexpr int KCH = 2 * NDQ, KRS = 512 / KCH, VCH = 4 * NDVT, VRS = 512 / VCH;
        const int krow0 = tid / KCH, kch = tid % KCH, vrow0 = tid / VCH, vcol = (tid % VCH) * 8;
        int kws[NKL], vws[NVL];
#pragma unroll
        for (int i = 0; i < NKL; ++i) kws[i] = kswz<NDQ>(krow0 + i * KRS, kch);
#pragma unroll
        for (int i = 0; i < NVL; ++i) vws[i] = v_st<NDVT>(vrow0 + i * VRS, vcol);
        const bf16* kgp = Kg + (size_t)krow0 * ldk + kch * 8; const bf16* vgp = Vg + (size_t)vrow0 * ldk + vcol;
        bf16x8 sk[NKL], sv[NVL];
        const int vb0 = (int)(uintptr_t)V_lds + v_rd_base(lane) + vdoff * 512;
#define FA_SLOAD(t) do { const size_t ro_ = (size_t)((j_lo + (t)) * KVBLK) * ldk; \
        _Pragma("unroll") for (int i_ = 0; i_ < NVL; ++i_) sv[i_] = *reinterpret_cast<const bf16x8*>(vgp + ro_ + (size_t)(i_ * VRS) * ldk); \
        _Pragma("unroll") for (int i_ = 0; i_ < NKL; ++i_) sk[i_] = *reinterpret_cast<const bf16x8*>(kgp + ro_ + (size_t)(i_ * KRS) * ldk); } while (0)
#define FA_SWRITE(bf) do { _Pragma("unroll") for (int i_ = 0; i_ < NVL; ++i_) *reinterpret_cast<bf16x8*>(V_lds + (bf) * SHM_V + vws[i_]) = sv[i_]; \
        _Pragma("unroll") for (int i_ = 0; i_ < NKL; ++i_) *reinterpret_cast<bf16x8*>(K_lds + (bf) * SHM_K + kws[i_]) = sk[i_]; } while (0)
#define FA_RESC(a) do { if (__any((a) < 1.f)) { if (hi == 0) al_l[r32] = (a); asm volatile("s_waitcnt lgkmcnt(0)" ::: "memory"); \
        _Pragma("unroll") for (int d_ = 0; d_ < NDV; ++d_) _Pragma("unroll") for (int r = 0; r < 16; ++r) o[d_][r] *= al_l[crow(r, hi)]; } } while (0)
#define FA_KBASE(t) ((j_lo + (t)) * KVBLK)
#define FA_MASKT(P0_, P1_, t) do { const int kb_ = FA_KBASE(t); if (kb_ + KVBLK - 1 > qlo || kb_ <= qlo + QBLK - 1 - W) mask_tile(P0_, P1_, qm - kb_, (unsigned)W); } while (0)
        bf16x8 qr[NDQ];
#pragma unroll
        for (int d0 = 0; d0 < NDQ; ++d0) qr[d0] = *reinterpret_cast<const bf16x8*>(Qw + (size_t)r32 * ldq + d0 * 16 + hi * 8);
        FA_SLOAD(0); FA_VMW(); FA_SWRITE(0); FA_SBAR();
        if (NT > 1) FA_SLOAD(1);
        __syncthreads();
        f32x16 pA0, pA1, pB0, pB1; float alA, alB; bf16x8 pa0, pa1, pa2, pa3;
        FA_SBAR(); qkt<NDQ>(pA0, pA1, K_lds, r32, hi, qr);
        FA_MASKT(pA0, pA1, 0); partialSM(pA0, pA1, m_reg, alA);
        if (NT > 1) { FA_VMW(); FA_SWRITE(1); }
        __syncthreads();
#define FA_HALF_STEP(PX0, PX1, alX, PY0, PY1, alY, t, KB, VB, SB) do { \
        FA_SBAR(); qkt<NDQ>(PX0, PX1, K_lds + (KB) * SHM_K, r32, hi, qr); \
        finishSM(PY0, PY1, alY, l_reg, pa0, pa1, pa2, pa3); FA_SBAR(); \
        if ((t) + 1 < NT) { FA_SLOAD((t) + 1); FA_SBAR(); } \
        pv_tile<NDVT, NDV>(o, vb0 + (VB) * SHM_V, pa0, pa1, pa2, pa3); FA_MASKT(PX0, PX1, (t)); partialSM(PX0, PX1, m_reg, alX); \
        __syncthreads(); \
        if ((t) + 1 < NT) { FA_VMW(); FA_SWRITE(SB); } \
        FA_RESC(alX); __syncthreads(); } while (0)
        for (int t = 1; t + 1 < NT; t += 2) {
            FA_HALF_STEP(pB0, pB1, alB, pA0, pA1, alA, t, 1, 0, 0);
            FA_HALF_STEP(pA0, pA1, alA, pB0, pB1, alB, t + 1, 0, 1, 1);
        }
        const bool even = (NT & 1) == 0;
        if (even) { FA_SBAR(); qkt<NDQ>(pB0, pB1, K_lds + SHM_K, r32, hi, qr); FA_SBAR(); }
        finishSM(pA0, pA1, alA, l_reg, pa0, pa1, pa2, pa3); FA_SBAR();
        pv_tile<NDVT, NDV>(o, vb0, pa0, pa1, pa2, pa3);
        if (even) { FA_MASKT(pB0, pB1, NT - 1); partialSM(pB0, pB1, m_reg, alB); FA_RESC(alB);
            finishSM(pB0, pB1, alB, l_reg, pa0, pa1, pa2, pa3); FA_SBAR(); pv_tile<NDVT, NDV>(o, vb0 + SHM_V, pa0, pa1, pa2, pa3); }
        __syncthreads();
#undef FA_SLOAD
#undef FA_SWRITE
#undef FA_RESC
#undef FA_KBASE
#undef FA_MASKT
#undef FA_HALF_STEP
    }
};
}

constexpr size_t WS_STASH = 128 * MiB;
typedef unsigned v4u32 __attribute__((__vector_size__(16)));
__device__ __forceinline__ __amdgpu_buffer_rsrc_t mk_rsrc(const void* ptr) {
    const unsigned long long v = (unsigned long long)ptr; const unsigned lo = __builtin_amdgcn_readfirstlane((unsigned)v), hi = __builtin_amdgcn_readfirstlane((unsigned)(v >> 32));
    return __builtin_amdgcn_make_buffer_rsrc((void*)(((unsigned long long)hi << 32) | lo), 0, 0x40000000, 0x00020000);
}
__device__ __forceinline__ void attn_phase(const Params& p, char* lds, int vcu0, int nwg) {
    using namespace fa;
    const int tid = threadIdx.x, wid = __builtin_amdgcn_readfirstlane(tid >> 6), lane = tid & 63, r32 = lane & 31, hi = lane >> 5;
    const bf16* proj = (const bf16*)(p.ws + WS_PROJ); bf16* att = (bf16*)(p.ws + WS_ATT);
    typedef Core<4, 4, 4> CD; typedef Core<4, 2, 2> CS;
    float* wsf = (float*)(lds + CD::LDS_NEED) + wid * 64;
    const float lam = calc_lambda(p);
    const int ovoff = (4 * hi * DM + r32) * 2;
#ifndef FA_NO_DIFF
#pragma nounroll
    for (int vcu = vcu0; vcu < 256; vcu += nwg) {
        const int bh = vcu >> 3, b = bh >> 2, h = bh & 3, s = vcu & 7;
        u32x4* stash = (u32x4*)(lds + CD::LDS_NEED + NW * 256) + tid;
#pragma nounroll
        for (int pass = 0; pass < 2; ++pass) {
            const int qb = pass ? 15 - s : s;
            const size_t row0 = (size_t)b * SEQ + qb * 256 + wid * 32;
#pragma nounroll
            for (int c = 0; c < 2; ++c) {
                f32x16 o[4]; float m_reg, l_reg;
                CD::run(o, m_reg, l_reg, proj + row0 * NP + C_QD + (2 * h + c) * 64, NP, proj + (size_t)b * SEQ * NP + C_KD + (2 * h + c) * 64, proj + (size_t)b * SEQ * NP + C_VD + h * 128, NP,
                        0, 4 * (qb + 1), qb * 256 + wid * 32, 1 << 30, lds, 0);
                if (hi == 0) wsf[r32] = l_reg;
                asm volatile("s_waitcnt lgkmcnt(0)" ::: "memory");
                if (c == 0) {
#pragma unroll
                    for (int j = 0; j < 2; ++j) { float ri[8];
#pragma unroll
                        for (int e = 0; e < 8; ++e) ri[e] = 1.0f / wsf[crow(8 * j + e, hi)];
#pragma unroll
                        for (int d0 = 0; d0 < 4; ++d0) { u32x4 w; w.x = cvtpk(o[d0][8 * j] * ri[0], o[d0][8 * j + 1] * ri[1]); w.y = cvtpk(o[d0][8 * j + 2] * ri[2], o[d0][8 * j + 3] * ri[3]);
                            w.z = cvtpk(o[d0][8 * j + 4] * ri[4], o[d0][8 * j + 5] * ri[5]); w.w = cvtpk(o[d0][8 * j + 6] * ri[6], o[d0][8 * j + 7] * ri[7]); stash[(d0 * 2 + j) * NTHR] = w; } }
                } else {
                    const __amdgpu_buffer_rsrc_t rso = mk_rsrc(att + row0 * DM + 512 + h * 128);
                    float ssq[16];
#pragma unroll
                    for (int r = 0; r < 16; ++r) ssq[r] = -lam / wsf[crow(r, hi)];
#pragma unroll
                    for (int d0 = 0; d0 < 4; ++d0)
#pragma unroll
                        for (int j = 0; j < 2; ++j) { const u32x4 w = stash[(d0 * 2 + j) * NTHR]; const unsigned ww[4] = {w.x, w.y, w.z, w.w};
#pragma unroll
                            for (int e = 0; e < 8; ++e) { const int r = 8 * j + e; const float a0 = (e & 1) ? __uint_as_float(ww[e >> 1] & 0xffff0000u) : __uint_as_float(ww[e >> 1] << 16);
                                o[d0][r] = a0 + ssq[r] * o[d0][r]; } }
#pragma unroll
                    for (int r = 0; r < 16; ++r) { float q = (o[0][r] * o[0][r] + o[1][r] * o[1][r]) + (o[2][r] * o[2][r] + o[3][r] * o[3][r]);
                        q += __shfl_xor(q, 1); q += __shfl_xor(q, 2); q += __shfl_xor(q, 4); q += __shfl_xor(q, 8); q += __shfl_xor(q, 16);
                        ssq[r] = 0.8f / sqrtf(q * (1.f / 128.f) + EPS); }
#pragma unroll
                    for (int d0 = 0; d0 < 4; ++d0) { const float g = p.g_diff[d0 * 32 + r32];
#pragma unroll
                        for (int r = 0; r < 16; ++r) { const float y = o[d0][r] * ssq[r] * g; const float yn = __shfl_xor(y, 1);
                            if ((r32 & 1) == 0) __builtin_amdgcn_raw_buffer_store_b32(cvtpk(y, yn), rso, ovoff, (((r & 3) + 8 * (r >> 2)) * DM + d0 * 32) * 2, 0); } }
                }
                asm volatile("s_waitcnt lgkmcnt(0)" ::: "memory");
            }
        }
    }
#endif
#ifndef FA_NO_SWA
#pragma nounroll
    for (int u = vcu0; u < 1024; u += nwg) {
        const int bk = u >> 6, g64 = u & 63, b = bk >> 1, kvh = bk & 1, hq = kvh * 4 + (wid >> 1), sub = wid & 1;
        const size_t row0 = (size_t)b * SEQ + g64 * 64 + sub * 32;
        const __amdgpu_buffer_rsrc_t rso = mk_rsrc(att + row0 * DM + hq * 64);
        f32x16 o[2]; float m_reg, l_reg;
        const bf16* Qw = proj + row0 * NP + C_QA + hq * 64;
        const bf16* Kg = proj + (size_t)b * SEQ * NP + C_KA + kvh * 64;
        const bf16* Vg = proj + (size_t)b * SEQ * NP + C_VA + kvh * 64;
        CS::run(o, m_reg, l_reg, Qw, NP, Kg, Vg, NP, g64 >= 2 ? g64 - 2 : 0, g64 + 1, g64 * 64 + sub * 32, 128, lds, 0);
        const float lt = l_reg + __builtin_amdgcn_exp2f(p.sinks[hq] * LOG2E - m_reg);
        if (hi == 0) wsf[r32] = lt;
        asm volatile("s_waitcnt lgkmcnt(0)" ::: "memory");
#pragma unroll
        for (int r = 0; r < 16; ++r) { const float rl = 1.0f / wsf[crow(r, hi)];
#pragma unroll
            for (int d0 = 0; d0 < 2; ++d0) { const float y = o[d0][r] * rl; const float yn = __shfl_xor(y, 1);
                if ((r32 & 1) == 0) __builtin_amdgcn_raw_buffer_store_b32(cvtpk(y, yn), rso, ovoff, (((r & 3) + 8 * (r >> 2)) * DM + d0 * 32) * 2, 0); } }
        __syncthreads();
    }
#endif
}

namespace fa {
template <int NDQ, int NDVT, int NDV>
struct CoreSeq {
    static constexpr int KROW = NDQ * 32, SHM_K = 64 * KROW, SHM_V = 64 * NDVT * 64, NKL = NDQ / 4, NVL = NDVT / 2, NST = NKL > NVL ? NKL : NVL, LDS_NEED = SHM_V + SHM_K + NW * 256;
    __device__ __forceinline__ static void run(f32x16 (&o)[NDV], float& m_reg, float& l_reg, const bf16* Qw, int ldq, const bf16* Kg, const bf16* Vg, int ldk, int NT, char* lds, int vdoff) {
        const int tid = threadIdx.x, wid = __builtin_amdgcn_readfirstlane(tid >> 6), lane = tid & 63, r32 = lane & 31, hi = lane >> 5;
        char* V_lds = lds; char* K_lds = lds + SHM_V;
        float* al_l = (float*)(lds + SHM_V + SHM_K) + wid * 64 + 32;
        m_reg = -1e30f; l_reg = 0.f;
#pragma unroll
        for (int d = 0; d < NDV; ++d) o[d] = f32x16{};
        constexpr int KCH = 2 * NDQ, KRS = 512 / KCH, VCH = 4 * NDVT, VRS = 512 / VCH;
        const int krow0 = tid / KCH, kch = tid % KCH, vrow0 = tid / VCH, vcol = (tid % VCH) * 8;
        const bf16* kgp = Kg + (size_t)krow0 * ldk + kch * 8; const bf16* vgp = Vg + (size_t)vrow0 * ldk + vcol;
        bf16x8 st[NST];
        const int vb0 = (int)(uintptr_t)V_lds + v_rd_base(lane) + vdoff * 512;
#define FQ_LOADV(t) do { const size_t ro_ = (size_t)((t) * KVBLK) * ldk; _Pragma("unroll") for (int i_ = 0; i_ < NVL; ++i_) st[i_] = *reinterpret_cast<const bf16x8*>(vgp + ro_ + (size_t)(i_ * VRS) * ldk); } while (0)
#define FQ_LOADK(t) do { const size_t ro_ = (size_t)((t) * KVBLK) * ldk; _Pragma("unroll") for (int i_ = 0; i_ < NKL; ++i_) st[i_] = *reinterpret_cast<const bf16x8*>(kgp + ro_ + (size_t)(i_ * KRS) * ldk); } while (0)
#define FQ_WRITEV() do { _Pragma("unroll") for (int i_ = 0; i_ < NVL; ++i_) *reinterpret_cast<bf16x8*>(V_lds + v_st<NDVT>(vrow0 + i_ * VRS, vcol)) = st[i_]; } while (0)
#define FQ_WRITEK() do { _Pragma("unroll") for (int i_ = 0; i_ < NKL; ++i_) *reinterpret_cast<bf16x8*>(K_lds + kswz<NDQ>(krow0 + i_ * KRS, kch)) = st[i_]; } while (0)
        bf16x8 qr[NDQ];
#pragma unroll
        for (int d0 = 0; d0 < NDQ; ++d0) qr[d0] = *reinterpret_cast<const bf16x8*>(Qw + (size_t)r32 * ldq + d0 * 16 + hi * 8);
        FQ_LOADK(0); FA_VMW(); FQ_WRITEK(); FA_SBAR(); FQ_LOADV(0);
        __syncthreads();
        for (int t = 0; t < NT; ++t) {
            f32x16 p0, p1; float al; bf16x8 pa0, pa1, pa2, pa3;
            FA_SBAR(); qkt<NDQ>(p0, p1, K_lds, r32, hi, qr);
            partialSM(p0, p1, m_reg, al);
            if (__any(al < 1.f)) { if (hi == 0) al_l[r32] = al; asm volatile("s_waitcnt lgkmcnt(0)" ::: "memory");
#pragma unroll
                for (int d_ = 0; d_ < NDV; ++d_)
#pragma unroll
                    for (int r = 0; r < 16; ++r) o[d_][r] *= al_l[crow(r, hi)]; }
            finishSM(p0, p1, al, l_reg, pa0, pa1, pa2, pa3); FA_SBAR();
            FA_VMW(); FQ_WRITEV(); FA_SBAR(); if (t + 1 < NT) FQ_LOADK(t + 1);
            __syncthreads();
            pv_tile<NDVT, NDV>(o, vb0, pa0, pa1, pa2, pa3);
            if (t + 1 < NT) { FA_VMW(); FQ_WRITEK(); FA_SBAR(); FQ_LOADV(t + 1); }
            __syncthreads();
        }
#undef FQ_LOADV
#undef FQ_LOADK
#undef FQ_WRITEV
#undef FQ_WRITEK
    }
};
}
__device__ __forceinline__ void cross_phase(const Params& p, char* lds, int vcu0, int nwg) {
    using namespace fa;
    const int tid = threadIdx.x, wid = __builtin_amdgcn_readfirstlane(tid >> 6), lane = tid & 63, r32 = lane & 31, hi = lane >> 5;
    const bf16* qc = (const bf16*)(p.ws + WS_QC); const bf16* kvm = (const bf16*)(p.ws + WS_KVM); bf16* oc = (bf16*)(p.ws + WS_OC);
    typedef CoreSeq<16, 8, 4> CC;
    float* wsf = (float*)(lds + CC::LDS_NEED) + wid * 64;
    const int ovoff = (4 * hi * DM + r32) * 2;
#pragma nounroll
    for (int u = vcu0; u < 1024; u += nwg) {
        const int bh = u >> 5, rb = u & 31, b = bh >> 2, head = bh & 3, dh = wid >> 2;
        const size_t row0 = (size_t)b * SEQ + rb * 128 + (wid & 3) * 32;
        const __amdgpu_buffer_rsrc_t rso = mk_rsrc(oc + row0 * DM + head * 256 + dh * 128);
        f32x16 o[4]; float m_reg, l_reg;
        CC::run(o, m_reg, l_reg, qc + row0 * DM + head * 256, DM, kvm + (size_t)b * MEML * 2048 + head * 256, kvm + (size_t)b * MEML * 2048 + 1024 + head * 256, 2048, MEML / 64, lds, dh * 4);
        if (hi == 0) wsf[r32] = l_reg;
        asm volatile("s_waitcnt lgkmcnt(0)" ::: "memory");
#pragma unroll
        for (int r = 0; r < 16; ++r) { const float rl = 1.0f / wsf[crow(r, hi)];
#pragma unroll
            for (int d0 = 0; d0 < 4; ++d0) { const float y = o[d0][r] * rl; const float yn = __shfl_xor(y, 1);
                if ((r32 & 1) == 0) __builtin_amdgcn_raw_buffer_store_b32(cvtpk(y, yn), rso, ovoff, (((r & 3) + 8 * (r >> 2)) * DM + d0 * 32) * 2, 0); } }
        asm volatile("s_waitcnt lgkmcnt(0)" ::: "memory");
    }
}
#define GAS __attribute__((address_space(1)))
typedef GAS unsigned gu32;
constexpr int CW_BAR = 4096;
constexpr size_t CTL_ZERO_BYTES = 65536;
constexpr int MISC_OFF = 131072 + 320;
#define XB_TMO      128
#define XB_XCNT(j)  (256  + 64 * (j))
#define XB_XSUB(j)  (1280 + 64 * (j))
#define XB_XGEN(j)  (2304 + 64 * (j))
#define XB_TOP      3328
#define XB_TOPGEN   3392
#define XCD_BAR_WORDS 3456
#define XB_SPIN_CAP (1u << 18)

__device__ __forceinline__ unsigned xb_ld(unsigned* p)              { return __hip_atomic_load(p, __ATOMIC_RELAXED, __HIP_MEMORY_SCOPE_AGENT); }
__device__ __forceinline__ unsigned xb_add(unsigned* p, unsigned v) { return __hip_atomic_fetch_add(p, v, __ATOMIC_RELAXED, __HIP_MEMORY_SCOPE_AGENT); }
__device__ __forceinline__ unsigned xb_xcc_id() { return (unsigned)__builtin_amdgcn_s_getreg((3 << 11) | 20) & 0xFu; }
#define XB_SPIN(cond, bar) do { unsigned _sp = 0; while (cond) { __builtin_amdgcn_s_sleep(1); \
    if ((++_sp & 255u) == 0u) { if (xb_ld(&(bar)[XB_TMO])) break; if (_sp > XB_SPIN_CAP) { atomicAdd(&(bar)[XB_TMO], 1u); break; } } } } while (0)

struct XcdBarrier {
    unsigned* bar; unsigned x;
    volatile LAS unsigned* st;
};

__device__ __forceinline__ XcdBarrier xcd_barrier_post(unsigned* bar, volatile LAS unsigned* st) {
    XcdBarrier b; b.bar = bar; b.x = xb_xcc_id(); b.st = st;
    if (threadIdx.x == 0) (void)xb_add(&bar[XB_XCNT(b.x)], 1u);
    return b;
}
__device__ __forceinline__ void xcd_barrier_complete(unsigned* bar, unsigned x, unsigned& nloc, unsigned& nx) {
    const unsigned G = gridDim.x * gridDim.y * gridDim.z;
    unsigned sum, cnt, mine, sp = 0u;
    for (;;) {
        sum = 0u; cnt = 0u; mine = 0u;
#pragma unroll
        for (unsigned j = 0; j < 16; ++j) { const unsigned c = xb_ld(&bar[XB_XCNT(j)]); sum += c; cnt += (c > 0u) ? 1u : 0u; mine = (j == x) ? c : mine; }
        if (sum == G) break;
        __builtin_amdgcn_s_sleep(1);
        if ((++sp & 255u) == 0u) { if (xb_ld(&bar[XB_TMO])) break; if (sp > XB_SPIN_CAP) { atomicAdd(&bar[XB_TMO], 1u); break; } }
    }
    nloc = mine > 0u ? mine : 1u; nx = cnt > 0u ? cnt : 1u;
}

__device__ __forceinline__ void xcd_barrier(const XcdBarrier& b) {
    asm volatile("s_waitcnt vmcnt(0)" ::: "memory");
    __syncthreads();
    if (threadIdx.x == 0) {
        unsigned* bar = b.bar;
        __builtin_amdgcn_s_waitcnt(0);
        unsigned nloc = b.st[0], nx = b.st[1];
        if (nloc == 0u) { xcd_barrier_complete(bar, b.x, nloc, nx); b.st[0] = nloc; b.st[1] = nx; }
        const unsigned old = xb_add(&bar[XB_XSUB(b.x)], 1u);
        const unsigned gen = old / nloc;
        if (old + 1u == (gen + 1u) * nloc) {
            __builtin_amdgcn_fence(__ATOMIC_RELEASE, "agent");
            asm volatile("s_waitcnt vmcnt(0)" ::: "memory");
            const unsigned og = xb_add(&bar[XB_TOP], 1u);
            const unsigned tg = og / nx;
            if (og + 1u == (tg + 1u) * nx) xb_add(&bar[XB_TOPGEN], 1u);
            else XB_SPIN(xb_ld(&bar[XB_TOPGEN]) == tg, bar);
            __builtin_amdgcn_fence(__ATOMIC_ACQUIRE, "agent");
            xb_add(&bar[XB_XGEN(b.x)], 1u);
            asm volatile("s_waitcnt vmcnt(0)" ::: "memory");
        } else {
            XB_SPIN(xb_ld(&bar[XB_XGEN(b.x)]) == gen, bar);
            __builtin_amdgcn_fence(__ATOMIC_ACQUIRE, "agent");
            asm volatile("s_waitcnt vmcnt(0)" ::: "memory");
        }
    }
    __syncthreads();
}

constexpr int LDS_BYTES = 147456;
constexpr size_t WS_SS3 = 58 * MiB;
__device__ __forceinline__ void final_norm_ss(float* X, const float* ss, const float* g, int gw, int ngw, int lane) {
    for (int m = gw; m < M; m += ngw) {
        const float rstd = pg8::rstd_ss(ss, m);
        f32x4* xr = (f32x4*)(X + (size_t)m * DM) + lane;
#pragma unroll
        for (int j = 0; j < 4; ++j) { const f32x4 gg = ((const f32x4*)g)[lane + 64 * j]; xr[64 * j] = xr[64 * j] * rstd * gg; }
    }
}
constexpr int N_PHASES = 10;
__global__ void __launch_bounds__(NTHR, 2) fwd_kernel(Params p) {
    extern __shared__ __attribute__((aligned(16))) unsigned char lds_raw[];
    LAS unsigned char* lds = (LAS unsigned char*)lds_raw;
    for (int u = threadIdx.x; u < 64; u += NTHR) ((LAS unsigned*)(lds + MISC_OFF))[u] = 0u;
    __syncthreads();
    XcdBarrier bar = xcd_barrier_post((unsigned*)(p.ws + WS_CTL) + CW_BAR, (volatile LAS unsigned*)(lds + MISC_OFF) + 8);
    const int tid = threadIdx.x, wave = __builtin_amdgcn_readfirstlane(tid >> 6), lane = tid & 63, bid = blockIdx.x, nblk = gridDim.x;
    const int gw = bid * NWAVES + wave, ngw = nblk * NWAVES;
    const int vcu = (nblk % 8 == 0) ? (bid % 8) * (nblk / 8) + bid / 8 : bid;
    unsigned char* ws = p.ws;
    const int lo = p.ph_lo, hi = p.ph_hi;
    typedef pg8::bf16_t b16;
#define IN(k) (lo <= (k) && (k) < hi)
#define SEAM(k) do { if (IN(k) && IN((k) + 1)) xcd_barrier(bar); } while (0)
#ifndef PROBE_REP
#define PROBE_REP -1
#endif
#define REPS(k) for (int rep_ = 0; rep_ < ((k) == PROBE_REP ? 2 : 1); ++rep_, ((k) == PROBE_REP && rep_ < 2 ? xcd_barrier(bar) : (void)0))
    if (IN(0)) REPS(0) { p0_prologue(p, lds, bid, nblk, tid); } SEAM(0);
    if (IN(1)) REPS(1) {
        pg8::Gemm g{(const b16*)(ws + WS_XN), (const b16*)(ws + WS_WIN), (const b16*)(ws + WS_MEMN), (const b16*)(ws + WS_WCKV), DM};
        pg8::TwoOrder S; S.init(M, NP, nblk, bid); S.n2M = MM / 256; S.n2N = 2048 / 256;
        pg8::EpiProj E{(b16*)(ws + WS_PROJ), (b16*)(ws + WS_KVM), (const float*)(ws + WS_ROPE)};
        pg8::gemm_phase<pg8::EpiProj, pg8::TwoOrder, true, true>(lds, g, S, E);
    } SEAM(1);
    if (IN(2)) REPS(2) { attn_phase(p, (char*)lds_raw, vcu, nblk);
#ifdef FA_NO_SWA
        swa_naive(p, bid, nblk, tid);
#endif
#ifdef FA_NO_DIFF
        diff_naive(p, bid, nblk, tid); xcd_barrier(bar); diff_combine_naive(p, gw, ngw, lane);
#endif
    } SEAM(2);
    if (IN(3)) REPS(3) {
        pg8::Gemm g{(const b16*)(ws + WS_ATT), (const b16*)(ws + WS_WOUT), nullptr, nullptr, DM};
        pg8::StaticOrder S; S.init(M, DM, nblk, bid);
        pg8::EpiResB<true> E{p.x, nullptr, (b16*)(ws + WS_XN), (float*)(ws + WS_SS1)};
        pg8::gemm_phase<pg8::EpiResB<true>, pg8::StaticOrder, true, true>(lds, g, S, E);
    } SEAM(3);
    if (IN(4)) REPS(4) {
        pg8::Gemm g{(const b16*)(ws + WS_XN), (const b16*)(ws + WS_WCQ), nullptr, nullptr, DM};
        pg8::StaticOrder S; S.init(M, DM, nblk, bid);
        pg8::EpiScaleBf16<0> E{(b16*)(ws + WS_QC), DM, (const float*)(ws + WS_SS1), CQ};
        pg8::gemm_phase<pg8::EpiScaleBf16<0>, pg8::StaticOrder, true, true>(lds, g, S, E);
    } SEAM(4);
    if (IN(5)) REPS(5) { cross_phase(p, (char*)lds_raw, vcu, nblk); } SEAM(5);
    if (IN(6)) REPS(6) {
        pg8::Gemm g{(const b16*)(ws + WS_OC), (const b16*)(ws + WS_WCO), nullptr, nullptr, DM};
        pg8::StaticOrder S; S.init(M, DM, nblk, bid);
        pg8::EpiResB<false> E{nullptr, (const b16*)(ws + WS_XN), (b16*)(ws + WS_XN), (float*)(ws + WS_SS2)};
        pg8::gemm_phase<pg8::EpiResB<false>, pg8::StaticOrder, true, true>(lds, g, S, E);
    } SEAM(6);
    if (IN(7)) REPS(7) {
        pg8::Gemm g{(const b16*)(ws + WS_XN), (const b16*)(ws + WS_WUP), nullptr, nullptr, DM};
        pg8::StaticOrder S; S.init(M, FF, nblk, bid);
        pg8::EpiScaleBf16<1> E{(b16*)(ws + WS_ACT), FF, (const float*)(ws + WS_SS2), 1.f};
        pg8::gemm_phase<pg8::EpiScaleBf16<1>, pg8::StaticOrder, true, true>(lds, g, S, E);
    } SEAM(7);
    if (IN(8)) REPS(8) {
        pg8::Gemm g{(const b16*)(ws + WS_ACT), (const b16*)(ws + WS_WDOWN), nullptr, nullptr, FF};
        pg8::StaticOrder S; S.init(M, DM, nblk, bid);
        pg8::EpiResF E{(const b16*)(ws + WS_XN), p.out, (float*)(ws + WS_SS3)};
        pg8::gemm_phase<pg8::EpiResF, pg8::StaticOrder, true, true>(lds, g, S, E);
    } SEAM(8);
    if (IN(9)) REPS(9) { final_norm_ss(p.out, (const float*)(ws + WS_SS3), p.g_final, gw, ngw, lane); }
#undef IN
#undef SEAM
}

extern "C" void kernel_launch(void* const* d_in, const int* in_sizes, int n_in, void* d_out, int out_size, void* d_ws, size_t ws_size, hipStream_t stream) {
    static int grid = 0;
    if (grid == 0) {
        if (n_in != 21 || out_size != M * DM || ws_size < WS_END) { fprintf(stderr, "kernel_launch: unexpected shapes (n_in %d out %d ws %zu)\n", n_in, out_size, ws_size); grid = -1; return; }
        int dev = 0, cus = 0, per_cu = 0;
        (void)hipGetDevice(&dev); (void)hipDeviceGetAttribute(&cus, hipDeviceAttributeMultiprocessorCount, dev);
        if (hipFuncSetAttribute((const void*)fwd_kernel, hipFuncAttributeMaxDynamicSharedMemorySize, LDS_BYTES) != hipSuccess) { fprintf(stderr, "kernel_launch: hipFuncSetAttribute failed\n"); grid = -1; return; }
        (void)hipOccupancyMaxActiveBlocksPerMultiprocessor(&per_cu, (const void*)fwd_kernel, NTHR, LDS_BYTES);
        if (per_cu < 1) { fprintf(stderr, "kernel_launch: occupancy query says %d blocks per CU\n", per_cu); per_cu = 1; }
        grid = cus;
    }
    if (grid < 0) return;
    Params p{};
    p.x = (const float*)d_in[0]; p.mem = (const float*)d_in[1]; p.pos = (const int*)d_in[2]; p.g_mix = (const float*)d_in[3]; p.w_in = (const float*)d_in[4];
    p.sinks = (const float*)d_in[5]; p.lq1 = (const float*)d_in[6]; p.lk1 = (const float*)d_in[7]; p.lq2 = (const float*)d_in[8]; p.lk2 = (const float*)d_in[9];
    p.g_diff = (const float*)d_in[10]; p.w_out = (const float*)d_in[11]; p.g_cross = (const float*)d_in[12]; p.g_mem = (const float*)d_in[13]; p.w_cq = (const float*)d_in[14];
    p.w_ckv = (const float*)d_in[15]; p.w_co = (const float*)d_in[16]; p.g_mlp = (const float*)d_in[17]; p.w_up = (const float*)d_in[18]; p.w_down = (const float*)d_in[19]; p.g_final = (const float*)d_in[20];
    p.out = (float*)d_out; p.ws = (unsigned char*)d_ws;
    if (hipMemsetAsync((char*)d_ws + WS_CTL, 0, CTL_ZERO_BYTES, stream) != hipSuccess) { fprintf(stderr, "kernel_launch: hipMemsetAsync of the control words failed\n"); return; }
    p.ph_lo = 0; p.ph_hi = N_PHASES;
    hipLaunchKernelGGL(fwd_kernel, dim3(grid), dim3(NTHR), LDS_BYTES, stream, p);
}
```

```cpp
#include <hip/hip_runtime.h>
#include <hip/hip_cooperative_groups.h>
#include <cstdio>
#include <cstdint>
namespace cg = cooperative_groups;

#ifndef MK_ONE_LAUNCH
#define MK_ONE_LAUNCH 1
#endif
#ifndef FA_VARIANT
#endif

#define LAS __attribute__((address_space(3)))
typedef unsigned short bf16;
typedef short bf16x8 __attribute__((ext_vector_type(8)));
typedef float f32x4 __attribute__((ext_vector_type(4)));
typedef unsigned u32x4 __attribute__((ext_vector_type(4)));
typedef unsigned u32x2 __attribute__((ext_vector_type(2)));

constexpr int BATCH = 8, SEQ = 4096, M = BATCH * SEQ, DM = 1024, NP = 2304, MEML = 256, MM = BATCH * MEML, FF = 4096;
constexpr int NWAVES = 8, NTHR = NWAVES * 64;
constexpr float EPS = 1e-5f;
constexpr float LOG2E = 1.4426950408889634f;
constexpr float C2 = 0.125f * LOG2E;
constexpr float CQ = 0.0625f * LOG2E;
constexpr int C_QA = 0, C_KA = 512, C_VA = 640, C_QD = 768, C_KD = 1280, C_VD = 1792;

constexpr size_t MiB = 1u << 20;
constexpr size_t WS_CTL = 0;
constexpr size_t WS_WIN = 2 * MiB;
constexpr size_t WS_WOUT = WS_WIN + (size_t)NP * DM * 2;
constexpr size_t WS_WCQ = WS_WOUT + 2 * MiB;
constexpr size_t WS_WCKV = WS_WCQ + 2 * MiB;
constexpr size_t WS_WCO = WS_WCKV + 4 * MiB;
constexpr size_t WS_WUP = WS_WCO + 2 * MiB;
constexpr size_t WS_WDOWN = WS_WUP + 8 * MiB;
constexpr size_t WS_ROPE = 34 * MiB;
constexpr size_t WS_KVM = 42 * MiB;
constexpr size_t WS_MEMN = 50 * MiB;
constexpr size_t WS_SS1 = 54 * MiB, WS_SS2 = 56 * MiB;
constexpr size_t WS_XN = 64 * MiB;
constexpr size_t WS_ODIFF = 128 * MiB;
constexpr size_t WS_PROJ = 256 * MiB;
constexpr size_t WS_ATT = 400 * MiB;
constexpr size_t WS_QC = 256 * MiB;
constexpr size_t WS_OC = 320 * MiB;
constexpr size_t WS_ACT = 256 * MiB;
constexpr size_t WS_END = 512 * MiB;
static_assert(WS_WDOWN + 8 * MiB <= WS_ROPE, "weights fit");

struct Params {
    const float *x, *mem; const int* pos;
    const float *g_mix, *w_in, *sinks, *lq1, *lk1, *lq2, *lk2, *g_diff, *w_out, *g_cross, *g_mem, *w_cq, *w_ckv, *w_co, *g_mlp, *w_up, *w_down, *g_final;
    float* out; unsigned char* ws; int ph_lo, ph_hi;
};

#ifndef PROBE_TS
#define PROBE_TS 0
#endif
#if PROBE_TS
#define TS(p_, i_) do { if (blockIdx.x == 0 && threadIdx.x == 0) ((volatile unsigned long long*)((p_).ws + 1024))[(i_)] = __builtin_amdgcn_s_memrealtime(); } while (0)
#else
#define TS(p_, i_) do { } while (0)
#endif
__device__ __forceinline__ unsigned f2bf(float f) { unsigned u = __builtin_bit_cast(unsigned, f); return (u + 0x7fffu + ((u >> 16) & 1u)) >> 16; }
__device__ __forceinline__ unsigned pk2(float lo, float hi) { return f2bf(lo) | (f2bf(hi) << 16); }
__device__ __forceinline__ float bf2f(unsigned h) { return __builtin_bit_cast(float, h << 16); }
__device__ __forceinline__ float bflo(unsigned w) { return __builtin_bit_cast(float, w << 16); }
__device__ __forceinline__ float bfhi(unsigned w) { return __builtin_bit_cast(float, w & 0xffff0000u); }
__device__ __forceinline__ float wave_sum(float v) {
#pragma unroll
    for (int o = 1; o < 64; o <<= 1) v += __shfl_xor(v, o);
    return v;
}
__device__ __forceinline__ float wave_max(float v) {
#pragma unroll
    for (int o = 1; o < 64; o <<= 1) v = fmaxf(v, __shfl_xor(v, o));
    return v;
}
__host__ __device__ __forceinline__ bool col_roped(int n) { return n < C_VA || (n >= C_QD && n < C_VD); }
__host__ __device__ __forceinline__ int phys_of_logical(int nl) {
    if (!col_roped(nl)) return nl;
    const int g = nl & ~63, j = nl & 63; return g + ((j & 31) << 1) + (j >> 5);
}
__device__ __forceinline__ float calc_lambda(const Params& p) {
    float a = 0.f, b = 0.f;
    for (int i = 0; i < 64; ++i) { a += p.lq1[i] * p.lk1[i]; b += p.lq2[i] * p.lk2[i]; }
    return __expf(a) - __expf(b) + 0.2f;
}

__device__ const double INV_FREQ[32] = {
    1.0, 0.7498942093324559, 0.5623413251903491, 0.4216965034285822,
    0.31622776601683794, 0.23713737056616552, 0.1778279410038923, 0.1333521432163324,
    0.1, 0.07498942093324558, 0.05623413251903491, 0.042169650342858224,
    0.03162277660168379, 0.023713737056616554, 0.01778279410038923, 0.01333521432163324,
    0.01, 0.007498942093324558, 0.005623413251903491, 0.004216965034285823,
    0.0031622776601683794, 0.0023713737056616554, 0.0017782794100389228, 0.001333521432163324,
    0.001, 0.0007498942093324559, 0.0005623413251903491, 0.00042169650342858224,
    0.00031622776601683794, 0.00023713737056616554, 0.00017782794100389227, 0.0001333521432163324};

__device__ __forceinline__ void sincos_d(double a, float& c, float& s) {
    const double kd = rint(a * 0.63661977236758134308);
    const int k = (int)kd;
    double r = fma(-kd, 1.57079632679489655800e+00, a); r = fma(-kd, 6.12323399573676603587e-17, r);
    const double r2 = r * r;
    const double sp = r * (1.0 + r2 * (-1.0 / 6.0 + r2 * (1.0 / 120.0 + r2 * (-1.0 / 5040.0 + r2 * (1.0 / 362880.0 + r2 * (-1.0 / 39916800.0 + r2 * (1.0 / 6227020800.0)))))));
    const double cp = 1.0 + r2 * (-0.5 + r2 * (1.0 / 24.0 + r2 * (-1.0 / 720.0 + r2 * (1.0 / 40320.0 + r2 * (-1.0 / 3628800.0 + r2 * (1.0 / 479001600.0 + r2 * (-1.0 / 87178291200.0)))))));
    const int q = k & 3;
    const double ss = (q == 0) ? sp : (q == 1) ? cp : (q == 2) ? -sp : -cp;
    const double cc = (q == 0) ? cp : (q == 1) ? -sp : (q == 2) ? -cp : sp;
    c = (float)cc; s = (float)ss;
}

template <bool HASG, bool PERMC>
__device__ __forceinline__ void transpose_item(const float* W, int K, int N, const float* g, bf16* WT, LAS float* scr, int item, int lane) {
    const int nblk = N / 32, kb = item / nblk, nb = item % nblk, k0 = 64 * kb, n0 = 32 * nb;
#pragma unroll 16
    for (int i = 0; i < 32; ++i) { const int kk = 2 * i + (lane >> 5); float v = W[(size_t)(k0 + kk) * N + n0 + (lane & 31)]; if (HASG) v *= g[k0 + kk]; scr[kk * 33 + (lane & 31)] = v; }
    asm volatile("s_waitcnt lgkmcnt(0)" ::: "memory");
    const int c = lane & 7;
#pragma unroll
    for (int j = 0; j < 4; ++j) { const int n = (lane >> 3) + 8 * j; const LAS float* s = scr + (8 * c) * 33 + n;
        u32x4 o; o.x = pk2(s[0 * 33], s[1 * 33]); o.y = pk2(s[2 * 33], s[3 * 33]); o.z = pk2(s[4 * 33], s[5 * 33]); o.w = pk2(s[6 * 33], s[7 * 33]);
        const int nl = n0 + n, np = PERMC ? phys_of_logical(nl) : nl;
        *(u32x4*)(WT + (size_t)np * K + k0 + 8 * c) = o; }
    asm volatile("s_waitcnt lgkmcnt(0)" ::: "memory");
}
__device__ __forceinline__ void rms_row_to_bf16(const float* xrow, const float* g, bf16* orow, int lane) {
    const f32x4* xr = (const f32x4*)xrow + lane;
    f32x4 v[4]; float s = 0.f;
#pragma unroll
    for (int j = 0; j < 4; ++j) { v[j] = xr[64 * j]; s += (v[j].x * v[j].x + v[j].y * v[j].y) + (v[j].z * v[j].z + v[j].w * v[j].w); }
    const float rstd = 1.0f / sqrtf(wave_sum(s) * (1.f / DM) + EPS);
    u32x2* o8 = (u32x2*)orow + lane;
#pragma unroll
    for (int j = 0; j < 4; ++j) {
        f32x4 gg = (f32x4){1.f, 1.f, 1.f, 1.f}; if (g) gg = ((const f32x4*)g)[lane + 64 * j];
        u32x2 w; w.x = pk2(v[j].x * rstd * gg.x, v[j].y * rstd * gg.y); w.y = pk2(v[j].z * rstd * gg.z, v[j].w * rstd * gg.w); o8[64 * j] = w; }
}
__device__ __forceinline__ void p0_prologue(const Params& p, LAS unsigned char* lds, int bid, int nblk, int tid) {
    const int wave = tid >> 6, lane = tid & 63;
    LAS float* scr = (LAS float*)(lds + wave * 8704);
    const int gw = bid * NWAVES + wave, NGW = nblk * NWAVES;
    unsigned char* ws = p.ws;
    constexpr int I_IN = (DM / 64) * (NP / 32), I_SQ = (DM / 64) * (DM / 32), I_KV = (DM / 64) * (2048 / 32), I_UP = (DM / 64) * (FF / 32), I_DN = (FF / 64) * (DM / 32);
    constexpr int NITEMS = I_IN + 3 * I_SQ + I_KV + I_UP + I_DN;
#ifndef PROBE_P0
#define PROBE_P0 0
#endif
    for (int rp_ = 0; rp_ < (PROBE_P0 == 1 ? 2 : 1); ++rp_)
    for (int it = gw; it < NITEMS; it += NGW) {
        int r = it;
        if (r < I_IN) { transpose_item<true, true>(p.w_in, DM, NP, p.g_mix, (bf16*)(ws + WS_WIN), scr, r, lane); continue; } r -= I_IN;
        if (r < I_SQ) { transpose_item<false, false>(p.w_out, DM, DM, nullptr, (bf16*)(ws + WS_WOUT), scr, r, lane); continue; } r -= I_SQ;
        if (r < I_SQ) { transpose_item<true, false>(p.w_cq, DM, DM, p.g_cross, (bf16*)(ws + WS_WCQ), scr, r, lane); continue; } r -= I_SQ;
        if (r < I_KV) { transpose_item<false, false>(p.w_ckv, DM, 2048, nullptr, (bf16*)(ws + WS_WCKV), scr, r, lane); continue; } r -= I_KV;
        if (r < I_SQ) { transpose_item<false, false>(p.w_co, DM, DM, nullptr, (bf16*)(ws + WS_WCO), scr, r, lane); continue; } r -= I_SQ;
        if (r < I_UP) { transpose_item<true, false>(p.w_up, DM, FF, p.g_mlp, (bf16*)(ws + WS_WUP), scr, r, lane); continue; } r -= I_UP;
        transpose_item<false, false>(p.w_down, FF, DM, nullptr, (bf16*)(ws + WS_WDOWN), scr, r, lane);
    }
    TS(p, 20);
    for (int rp_ = 0; rp_ < (PROBE_P0 == 2 ? 2 : 1); ++rp_)
    for (int m = gw * 2; m < M; m += NGW * 2) {
        const f32x4* x0 = (const f32x4*)(p.x + (size_t)m * DM) + lane; const f32x4* x1 = x0 + DM / 4;
        f32x4 v0[4], v1[4]; float s0 = 0.f, s1 = 0.f;
#pragma unroll
        for (int j = 0; j < 4; ++j) { v0[j] = x0[64 * j]; v1[j] = x1[64 * j]; }
#pragma unroll
        for (int j = 0; j < 4; ++j) { s0 += (v0[j].x * v0[j].x + v0[j].y * v0[j].y) + (v0[j].z * v0[j].z + v0[j].w * v0[j].w); s1 += (v1[j].x * v1[j].x + v1[j].y * v1[j].y) + (v1[j].z * v1[j].z + v1[j].w * v1[j].w); }
#pragma unroll
        for (int o = 1; o < 64; o <<= 1) { s0 += __shfl_xor(s0, o); s1 += __shfl_xor(s1, o); }
        const float r0 = 1.0f / sqrtf(s0 * (1.f / DM) + EPS), r1 = 1.0f / sqrtf(s1 * (1.f / DM) + EPS);
        u32x2* o0 = (u32x2*)((bf16*)(ws + WS_XN) + (size_t)m * DM) + lane; u32x2* o1 = o0 + DM / 4;
#pragma unroll
        for (int j = 0; j < 4; ++j) { u32x2 w; w.x = pk2(v0[j].x * r0, v0[j].y * r0); w.y = pk2(v0[j].z * r0, v0[j].w * r0); o0[64 * j] = w;
            u32x2 z; z.x = pk2(v1[j].x * r1, v1[j].y * r1); z.y = pk2(v1[j].z * r1, v1[j].w * r1); o1[64 * j] = z; }
    }
    TS(p, 21);
    for (int m = gw; m < MM; m += NGW) rms_row_to_bf16(p.mem + (size_t)m * DM, p.g_mem, (bf16*)(ws + WS_MEMN) + (size_t)m * DM, lane);
    TS(p, 22);
    float2* rope = (float2*)(ws + WS_ROPE);
    for (int rp_ = 0; rp_ < (PROBE_P0 == 3 ? 2 : 1); ++rp_)
    for (int i = bid * NTHR + tid; i < M * 32; i += nblk * NTHR) {
        const int row = i >> 5, d = i & 31; float c, s; sincos_d((double)p.pos[row] * INV_FREQ[d], c, s); rope[i] = make_float2(c, s); }
}

namespace pg8 {
#define PG8_LAS __attribute__((address_space(3)))
typedef unsigned short bf16_t;
typedef short bf16x8 __attribute__((ext_vector_type(8)));
typedef float f32x4 __attribute__((ext_vector_type(4)));
typedef unsigned u32x4 __attribute__((ext_vector_type(4)));
typedef unsigned u32x2 __attribute__((ext_vector_type(2)));
constexpr int BM = 256, BK = 64, HALF = 128, HTB = HALF * BK * 2  , STAGE_BYTES = 8 * HTB, NXCD = 8, WGM = 8;

__host__ __device__ __forceinline__ int lds_byte(int r, int c) { const int st = (r >> 4) * 2 + (c >> 5), rr = r & 15, cc = c & 31, ob = rr * 64 + cc * 2; return st * 1024 + (ob ^ (((ob >> 9) & 1) << 5)); }
__host__ __device__ __forceinline__ void stage_rc(int b, int& R, int& C) { const int st = b / 1024, sb = b % 1024, swz = sb ^ (((sb >> 9) & 1) << 5); R = (st >> 1) * 16 + swz / 64; C = (st & 1) * 32 + (swz % 64) / 2; }
__host__ __device__ __forceinline__ int perm32(int rho) { const int n = rho >> 4, i = rho & 15; return 8 * (i >> 2) + 4 * n + (i & 3); }

struct Unit { int pm, pn, alt; };
struct Gemm { const bf16_t* A; const bf16_t* Bt; const bf16_t* A2; const bf16_t* Bt2; int K; };

struct StaticOrder {
    int nM, nN, nwg, G, c;
    __host__ __device__ void init(int M_, int N_, int G_, int c_) { nM = M_ / BM; nN = N_ / BM; nwg = nM * nN; G = G_; c = c_; }
    __host__ __device__ bool map(long L, Unit& u) const {
        if (L >= nwg) return false;
        int wgid = (int)L; { const int q = nwg / NXCD, r = nwg % NXCD, xcd = wgid % NXCD, off = wgid / NXCD; wgid = (xcd < r ? xcd * (q + 1) : r * (q + 1) + (xcd - r) * q) + off; }
        const int nig = WGM * nN, gid = wgid / nig, fm = gid * WGM, gsz = (nM - fm) < WGM ? (nM - fm) : WGM;
        u.pm = fm + ((wgid % nig) % gsz); u.pn = (wgid % nig) / gsz; u.alt = 0; return true;
    }
    __host__ __device__ bool next(int i, Unit& u) const { return map((long)i * G + c, u); }
    __device__ __forceinline__ void a_ready(const Unit&) const {}
    __device__ __forceinline__ void done(const Unit&) const {}
};
struct TwoOrder : StaticOrder {
    int n2M, n2N;
    __host__ __device__ bool next(int i, Unit& u) const {
        const long L = (long)i * G + c;
        if (L < nwg) return map(L, u);
        const int r = (int)(L - nwg); if (r >= n2M * n2N) return false;
        u.pm = r % n2M; u.pn = r / n2M; u.alt = 1; return true;
    }
};
__device__ __forceinline__ unsigned cvt_pk_bf16(float lo, float hi) { unsigned r; asm volatile("v_cvt_pk_bf16_f32 %0, %1, %2" : "=v"(r) : "v"(lo), "v"(hi)); return r; }

__device__ __forceinline__ float rstd_ss(const float* ss, int row) {
    const f32x4* s4 = (const f32x4*)(ss + (size_t)row * 16); float t = 0.f;
#pragma unroll
    for (int i = 0; i < 4; ++i) { const f32x4 v = s4[i]; t += (v.x + v.y) + (v.z + v.w); }
    return 1.0f / sqrtf(t * (1.f / DM) + EPS);
}
struct EpiProj {
    static constexpr bool PERM = true, AFTER_DRAIN = false;
    bf16_t* proj; bf16_t* kvm; const float* rope;
    __device__ __forceinline__ void operator()(const f32x4 (&acc)[2][2][4][2], const Unit& u, int wr, int wc, int fr, int fq) const {
        const int row0 = u.pm * BM + wr * 64 + fr, col0 = u.pn * BM + wc * 32 + 8 * fq;
        if (u.alt) {
#pragma unroll
            for (int ai = 0; ai < 2; ++ai)
#pragma unroll
                for (int m = 0; m < 4; ++m) { bf16_t* rowp = kvm + (size_t)(row0 + ai * HALF + m * 16) * 2048 + col0;
#pragma unroll
                    for (int bj = 0; bj < 2; ++bj) { const f32x4 v0 = acc[ai][bj][m][0], v1 = acc[ai][bj][m][1];
                        u32x4 w; w.x = cvt_pk_bf16(v0[0], v0[1]); w.y = cvt_pk_bf16(v0[2], v0[3]); w.z = cvt_pk_bf16(v1[0], v1[1]); w.w = cvt_pk_bf16(v1[2], v1[3]);
                        *(u32x4*)(rowp + bj * HALF) = w; } }
            return;
        }
        const int d0 = ((wc & 1) * 32 + 8 * fq) >> 1;
#pragma unroll
        for (int ai = 0; ai < 2; ++ai)
#pragma unroll
            for (int m = 0; m < 4; ++m) { const int row = row0 + ai * HALF + m * 16;
                const f32x4 cs0 = *(const f32x4*)(rope + (size_t)row * 64 + 2 * d0), cs1 = *(const f32x4*)(rope + (size_t)row * 64 + 2 * d0 + 4);
#pragma unroll
                for (int bj = 0; bj < 2; ++bj) { const int cb = u.pn * BM + bj * HALF;
                    const bool roped = col_roped(cb); const float sc = (cb < C_KA || (cb >= C_QD && cb < C_KD)) ? C2 : 1.f;
                    f32x4 v0 = acc[ai][bj][m][0], v1 = acc[ai][bj][m][1];
                    if (roped) {
                        const f32x4 a = v0, b = v1;
                        v0[0] = a[0] * cs0[0] - a[1] * cs0[1]; v0[1] = a[1] * cs0[0] + a[0] * cs0[1];
                        v0[2] = a[2] * cs0[2] - a[3] * cs0[3]; v0[3] = a[3] * cs0[2] + a[2] * cs0[3];
                        v1[0] = b[0] * cs1[0] - b[1] * cs1[1]; v1[1] = b[1] * cs1[0] + b[0] * cs1[1];
                        v1[2] = b[2] * cs1[2] - b[3] * cs1[3]; v1[3] = b[3] * cs1[2] + b[2] * cs1[3];
                    }
                    v0 = v0 * sc; v1 = v1 * sc;
                    u32x4 w; w.x = cvt_pk_bf16(v0[0], v0[1]); w.y = cvt_pk_bf16(v0[2], v0[3]); w.z = cvt_pk_bf16(v1[0], v1[1]); w.w = cvt_pk_bf16(v1[2], v1[3]);
                    *(u32x4*)(proj + (size_t)row * NP + col0 + bj * HALF) = w; } }
    }
};
struct EpiRes {
    static constexpr bool PERM = false, AFTER_DRAIN = false;
    const float* xi; float* xo; bf16_t* xb; float* ss;
    __device__ __forceinline__ void operator()(const f32x4 (&acc)[2][2][4][2], const Unit& u, int wr, int wc, int fr, int fq) const {
        const int row0 = u.pm * BM + wr * 64 + fr, col0 = u.pn * BM + wc * 32 + 4 * fq;
#pragma unroll
        for (int ai = 0; ai < 2; ++ai)
#pragma unroll
            for (int m = 0; m < 4; ++m) { const int row = row0 + ai * HALF + m * 16; const size_t off = (size_t)row * DM + col0; float q = 0.f;
#pragma unroll
                for (int bj = 0; bj < 2; ++bj)
#pragma unroll
                    for (int n = 0; n < 2; ++n) { const size_t c = off + bj * HALF + n * 16; const f32x4 r = *(const f32x4*)(xi + c) + acc[ai][bj][m][n];
                        *(f32x4*)(xo + c) = r; q += (r[0] * r[0] + r[1] * r[1]) + (r[2] * r[2] + r[3] * r[3]);
                        if (xb) { u32x2 w; w.x = cvt_pk_bf16(r[0], r[1]); w.y = cvt_pk_bf16(r[2], r[3]); *(u32x2*)(xb + c) = w; } }
                q += __shfl_xor(q, 16); q += __shfl_xor(q, 32);
                if (fq == 0) ss[(size_t)row * 16 + u.pn * 4 + wc] = q;
                if (m & 1) asm volatile("" ::: "memory"); }
    }
};
template <bool XF> struct EpiResB {
    static constexpr bool PERM = true, AFTER_DRAIN = false;
    const float* xf; const bf16_t* xb_in; bf16_t* xb_out; float* ss;
    __device__ __forceinline__ void operator()(const f32x4 (&acc)[2][2][4][2], const Unit& u, int wr, int wc, int fr, int fq) const {
        const int row0 = u.pm * BM + wr * 64 + fr, col0 = u.pn * BM + wc * 32 + 8 * fq;
#pragma unroll
        for (int ai = 0; ai < 2; ++ai)
#pragma unroll
            for (int m = 0; m < 4; ++m) { const int row = row0 + ai * HALF + m * 16; const size_t off = (size_t)row * DM + col0; float q = 0.f;
#pragma unroll
                for (int bj = 0; bj < 2; ++bj) { f32x4 r0, r1;
                    if (XF) { r0 = *(const f32x4*)(xf + off + bj * HALF); r1 = *(const f32x4*)(xf + off + bj * HALF + 4); }
                    else { const u32x4 w = *(const u32x4*)(xb_in + off + bj * HALF);
                        r0 = (f32x4){__uint_as_float(w.x << 16), __uint_as_float(w.x & 0xffff0000u), __uint_as_float(w.y << 16), __uint_as_float(w.y & 0xffff0000u)};
                        r1 = (f32x4){__uint_as_float(w.z << 16), __uint_as_float(w.z & 0xffff0000u), __uint_as_float(w.w << 16), __uint_as_float(w.w & 0xffff0000u)}; }
                    r0 = r0 + acc[ai][bj][m][0]; r1 = r1 + acc[ai][bj][m][1];
                    q += ((r0[0] * r0[0] + r0[1] * r0[1]) + (r0[2] * r0[2] + r0[3] * r0[3])) + ((r1[0] * r1[0] + r1[1] * r1[1]) + (r1[2] * r1[2] + r1[3] * r1[3]));
                    u32x4 w; w.x = cvt_pk_bf16(r0[0], r0[1]); w.y = cvt_pk_bf16(r0[2], r0[3]); w.z = cvt_pk_bf16(r1[0], r1[1]); w.w = cvt_pk_bf16(r1[2], r1[3]);
                    *(u32x4*)(xb_out + off + bj * HALF) = w; }
                q += __shfl_xor(q, 16); q += __shfl_xor(q, 32);
                if (fq == 0) ss[(size_t)row * 16 + u.pn * 4 + wc] = q;
                if (m & 1) asm volatile("" ::: "memory"); }
    }
};
struct EpiResF {
    static constexpr bool PERM = false, AFTER_DRAIN = false;
    const bf16_t* xb; float* xo; float* ss;
    __device__ __forceinline__ void operator()(const f32x4 (&acc)[2][2][4][2], const Unit& u, int wr, int wc, int fr, int fq) const {
        const int row0 = u.pm * BM + wr * 64 + fr, col0 = u.pn * BM + wc * 32 + 4 * fq;
#pragma unroll
        for (int ai = 0; ai < 2; ++ai)
#pragma unroll
            for (int m = 0; m < 4; ++m) { const int row = row0 + ai * HALF + m * 16; const size_t off = (size_t)row * DM + col0; float q = 0.f;
#pragma unroll
                for (int bj = 0; bj < 2; ++bj)
#pragma unroll
                    for (int n = 0; n < 2; ++n) { const size_t c = off + bj * HALF + n * 16; const u32x2 w = *(const u32x2*)(xb + c);
                        const f32x4 r = (f32x4){__uint_as_float(w.x << 16), __uint_as_float(w.x & 0xffff0000u), __uint_as_float(w.y << 16), __uint_as_float(w.y & 0xffff0000u)} + acc[ai][bj][m][n];
                        *(f32x4*)(xo + c) = r; q += (r[0] * r[0] + r[1] * r[1]) + (r[2] * r[2] + r[3] * r[3]); }
                q += __shfl_xor(q, 16); q += __shfl_xor(q, 32);
                if (fq == 0) ss[(size_t)row * 16 + u.pn * 4 + wc] = q;
                if (m & 1) asm volatile("" ::: "memory"); }
    }
};
struct EpiFinal {
    static constexpr bool PERM = false, AFTER_DRAIN = false;
    const bf16_t* xb; float* out; const float* g; unsigned* xbuf; unsigned* cnt; PG8_LAS unsigned char* tab;
    __device__ __forceinline__ void operator()(f32x4 (&acc)[2][2][4][2], const Unit& u, int wr, int wc, int fr, int fq) const {
        const int tid = threadIdx.x, lane = tid & 63, wid = __builtin_amdgcn_readfirstlane(tid >> 6);
        PG8_LAS float* P = (PG8_LAS float*)tab; PG8_LAS float* S = (PG8_LAS float*)(tab + 4096);
        const int col0 = u.pn * BM + wc * 32 + 4 * fq;
#pragma unroll
        for (int ai = 0; ai < 2; ++ai)
#pragma unroll
            for (int m = 0; m < 4; ++m) { const int rl = ai * HALF + wr * 64 + m * 16 + fr; const size_t off = (size_t)(u.pm * BM + rl) * DM + col0; float q = 0.f;
#pragma unroll
                for (int bj = 0; bj < 2; ++bj)
#pragma unroll
                    for (int n = 0; n < 2; ++n) { const u32x2 w = *(const u32x2*)(xb + off + bj * HALF + n * 16);
                        const f32x4 r = (f32x4){__uint_as_float(w.x << 16), __uint_as_float(w.x & 0xffff0000u), __uint_as_float(w.y << 16), __uint_as_float(w.y & 0xffff0000u)} + acc[ai][bj][m][n];
                        acc[ai][bj][m][n] = r; q += (r[0] * r[0] + r[1] * r[1]) + (r[2] * r[2] + r[3] * r[3]); }
                q += __shfl_xor(q, 16); q += __shfl_xor(q, 32);
                if (fq == 0) P[rl * 4 + wc] = q;
                if (m & 1) asm volatile("" ::: "memory"); }
        asm volatile("s_waitcnt lgkmcnt(0)" ::: "memory"); __builtin_amdgcn_s_barrier(); asm volatile("" ::: "memory");
        unsigned* slot = xbuf + ((size_t)(u.pm * BM + (tid & 255)) * 4);
        if (tid < 256) { const f32x4 a = *(const PG8_LAS f32x4*)(P + tid * 4);
            __hip_atomic_store(slot + u.pn, __float_as_uint((a[0] + a[1]) + (a[2] + a[3])), __ATOMIC_RELAXED, __HIP_MEMORY_SCOPE_AGENT); }
        asm volatile("s_waitcnt vmcnt(0)" ::: "memory");
        if (tid < 256 && lane == 0) __hip_atomic_fetch_add(cnt + 64 * u.pm, 1u, __ATOMIC_RELAXED, __HIP_MEMORY_SCOPE_AGENT);
        if (wid == 0) {
            unsigned sp = 0;
            while ((unsigned)__builtin_amdgcn_readfirstlane(__hip_atomic_load(cnt + 64 * u.pm, __ATOMIC_RELAXED, __HIP_MEMORY_SCOPE_AGENT)) < 16u) { __builtin_amdgcn_s_sleep(2); if (++sp > (1u << 22)) break; }
            __builtin_amdgcn_fence(__ATOMIC_ACQUIRE, "agent");
        }
        asm volatile("s_waitcnt vmcnt(0) lgkmcnt(0)" ::: "memory"); __builtin_amdgcn_s_barrier(); asm volatile("" ::: "memory");
        if (tid < 256) { float t = 0.f;
#pragma unroll
            for (int k = 0; k < 4; ++k) t += __uint_as_float(__hip_atomic_load(slot + k, __ATOMIC_RELAXED, __HIP_MEMORY_SCOPE_AGENT));
            S[tid] = 1.0f / sqrtf(t * (1.f / DM) + EPS); }
        asm volatile("s_waitcnt lgkmcnt(0)" ::: "memory"); __builtin_amdgcn_s_barrier(); asm volatile("" ::: "memory");
        f32x4 gg[2][2];
#pragma unroll
        for (int bj = 0; bj < 2; ++bj)
#pragma unroll
            for (int n = 0; n < 2; ++n) gg[bj][n] = *(const f32x4*)(g + col0 + bj * HALF + n * 16);
#pragma unroll
        for (int ai = 0; ai < 2; ++ai)
#pragma unroll
            for (int m = 0; m < 4; ++m) { const int rl = ai * HALF + wr * 64 + m * 16 + fr; const size_t off = (size_t)(u.pm * BM + rl) * DM + col0; const float rs = S[rl];
#pragma unroll
                for (int bj = 0; bj < 2; ++bj)
#pragma unroll
                    for (int n = 0; n < 2; ++n) *(f32x4*)(out + off + bj * HALF + n * 16) = acc[ai][bj][m][n] * rs * gg[bj][n]; }
    }
};
template <int ACT> struct EpiScaleBf16 {
    static constexpr bool PERM = true, AFTER_DRAIN = false;
    bf16_t* O; int ldc; const float* ss; float mul;
    __device__ __forceinline__ void operator()(const f32x4 (&acc)[2][2][4][2], const Unit& u, int wr, int wc, int fr, int fq) const {
        const int row0 = u.pm * BM + wr * 64 + fr, col0 = u.pn * BM + wc * 32 + 8 * fq;
#pragma unroll
        for (int ai = 0; ai < 2; ++ai)
#pragma unroll
            for (int m = 0; m < 4; ++m) { const int row = row0 + ai * HALF + m * 16; const float rs = rstd_ss(ss, row) * mul; bf16_t* rowp = O + (size_t)row * ldc + col0;
#pragma unroll
                for (int bj = 0; bj < 2; ++bj) { f32x4 v0 = acc[ai][bj][m][0] * rs, v1 = acc[ai][bj][m][1] * rs;
                    if (ACT == 1) {
#pragma unroll
                        for (int e = 0; e < 4; ++e) { const float a = fmaxf(v0[e], 0.f), b = fmaxf(v1[e], 0.f); v0[e] = a * a; v1[e] = b * b; } }
                    u32x4 w; w.x = cvt_pk_bf16(v0[0], v0[1]); w.y = cvt_pk_bf16(v0[2], v0[3]); w.z = cvt_pk_bf16(v1[0], v1[1]); w.w = cvt_pk_bf16(v1[2], v1[3]);
                    *(u32x4*)(rowp + bj * HALF) = w; } }
    }
};

template <class Epi, class Sched, bool ALIGN_EPI = false, bool SP2 = false>
__device__ __forceinline__ void gemm_phase(PG8_LAS unsigned char* lds, const Gemm g, const Sched& S, const Epi& E) {
    const int tid = threadIdx.x, wid = __builtin_amdgcn_readfirstlane(tid >> 6), lane = tid & 63, wr = wid >> 2, wc = wid & 3, fr = lane & 15, fq = lane >> 4;
    const int K = g.K, nt = K / BK;
    unsigned voffA[2], voffB[2];
#pragma unroll
    for (int i = 0; i < 2; ++i) { int R, C; stage_rc(tid * 16 + i * 8192, R, C); const int Rb = Epi::PERM ? ((R & ~31) + perm32(R & 31)) : R;
        voffA[i] = (unsigned)(R * K + C) * 2u; voffB[i] = (unsigned)(Rb * K + C) * 2u; }
    const size_t kstep = (size_t)(BK * 2);
    const size_t hstep = (size_t)HALF * K * 2;
    const size_t tstep = 2 * hstep;
    const unsigned ldsw = (unsigned)wid * 1024u;
    const int aoff = lds_byte(wr * 64 + fr, fq * 8), boff = lds_byte(wc * 32 + fr, fq * 8);
#define PG8_SA(b, h) (((b) * 2 + (h)) * HTB)
#define PG8_SB(b, h) ((4 + (b) * 2 + (h)) * HTB)
#define PG8_STAGE(bufoff, gbase, voff) do { _Pragma("unroll") for (int _i = 0; _i < 2; ++_i) \
        __builtin_amdgcn_global_load_lds((const unsigned*)((const char*)(gbase) + (voff)[_i]), (PG8_LAS unsigned*)(lds + (bufoff) + ldsw + _i * 8192), 16, 0, 0); } while (0)
#define PG8_LDA(dst, b, h) do { _Pragma("unroll") for (int m = 0; m < 4; ++m) _Pragma("unroll") for (int k = 0; k < 2; ++k) dst[m][k] = *(const PG8_LAS bf16x8*)(lds + PG8_SA(b, h) + aoff + m * 2048 + k * 1024); } while (0)
#define PG8_LDB(dst, b, h) do { _Pragma("unroll") for (int n = 0; n < 2; ++n) _Pragma("unroll") for (int k = 0; k < 2; ++k) dst[n][k] = *(const PG8_LAS bf16x8*)(lds + PG8_SB(b, h) + boff + n * 2048 + k * 1024); } while (0)
#define PG8_MMA(ai, bj, At, Bt) do { __builtin_amdgcn_s_setprio(1); _Pragma("unroll") for (int m = 0; m < 4; ++m) _Pragma("unroll") for (int n = 0; n < 2; ++n) _Pragma("unroll") for (int k = 0; k < 2; ++k) \
        acc[ai][bj][m][n] = __builtin_amdgcn_mfma_f32_16x16x32_bf16(Bt[n][k], At[m][k], acc[ai][bj][m][n], 0, 0, 0); __builtin_amdgcn_s_setprio(0); } while (0)
#define PG8_WAIT_V(n) asm volatile("s_waitcnt vmcnt(" #n ")" ::: "memory")
#define PG8_WAIT_L(n) asm volatile("s_waitcnt lgkmcnt(" #n ")" ::: "memory")
#define PG8_BAR __builtin_amdgcn_s_barrier()
#define PG8_SCHED __builtin_amdgcn_sched_barrier(0)
    Unit cur, nxt; int ui = 0;
    if (!S.next(0, cur)) return;
    f32x4 acc[2][2][4][2];
#pragma unroll
    for (int a = 0; a < 2; ++a)
#pragma unroll
        for (int b = 0; b < 2; ++b)
#pragma unroll
            for (int m = 0; m < 4; ++m)
#pragma unroll
                for (int n = 0; n < 2; ++n) acc[a][b][m][n] = (f32x4){0.f, 0.f, 0.f, 0.f};
    bf16x8 At[4][2], B0[2][2], B1[2][2];
    const char* cA = (const char*)(cur.alt ? g.A2 : g.A) + (size_t)cur.pm * tstep; const char* cB = (const char*)(cur.alt ? g.Bt2 : g.Bt) + (size_t)cur.pn * tstep;
    S.a_ready(cur);
    if constexpr (SP2) {
        PG8_STAGE(PG8_SB(0, 0), cB, voffB); PG8_STAGE(PG8_SB(0, 1), cB + hstep, voffB); PG8_STAGE(PG8_SA(0, 0), cA, voffA); PG8_STAGE(PG8_SA(0, 1), cA + hstep, voffA);
        if (wr == 1) PG8_BAR;
        PG8_WAIT_V(2); PG8_BAR;
        PG8_STAGE(PG8_SB(1, 0), cB + kstep, voffB); PG8_STAGE(PG8_SA(1, 0), cA + kstep, voffA); PG8_STAGE(PG8_SB(1, 1), cB + hstep + kstep, voffB);
        PG8_WAIT_V(6); PG8_BAR;
    } else {
        PG8_STAGE(PG8_SB(0, 0), cB, voffB); PG8_STAGE(PG8_SA(0, 0), cA, voffA); PG8_STAGE(PG8_SB(0, 1), cB + hstep, voffB); PG8_STAGE(PG8_SA(0, 1), cA + hstep, voffA);
        if (wr == 1) PG8_BAR;
        PG8_WAIT_V(4); PG8_BAR;
        PG8_STAGE(PG8_SB(1, 0), cB + kstep, voffB); PG8_STAGE(PG8_SA(1, 0), cA + kstep, voffA); PG8_STAGE(PG8_SB(1, 1), cB + hstep + kstep, voffB);
        PG8_WAIT_V(6); PG8_BAR;
    }
    for (;;) {
        const bool has_next = S.next(ui + 1, nxt);
        const char* nA = has_next ? (const char*)(nxt.alt ? g.A2 : g.A) + (size_t)nxt.pm * tstep : cA; const char* nB = has_next ? (const char*)(nxt.alt ? g.Bt2 : g.Bt) + (size_t)nxt.pn * tstep : cB;
        for (int t = 0; t < nt; t += 2) {
            const bool last = (t == nt - 2);
            const char* a1 = cA + (size_t)(t + 1) * kstep;
            const char* a2 = last ? nA : cA + (size_t)(t + 2) * kstep; const char* b2 = last ? nB : cB + (size_t)(t + 2) * kstep;
            const char* a3 = a2 + kstep; const char* b3 = b2 + kstep;
            if (last && has_next) S.a_ready(nxt);
            if constexpr (SP2) {
            PG8_LDB(B0, 0, 0); PG8_LDB(B1, 0, 1); PG8_SCHED; PG8_LDA(At, 0, 0); PG8_STAGE(PG8_SA(1, 1), a1 + hstep, voffA);
            PG8_WAIT_V(8); PG8_WAIT_L(0); PG8_BAR; PG8_MMA(0, 0, At, B0); PG8_MMA(0, 1, At, B1); PG8_BAR; PG8_SCHED;
            PG8_LDA(At, 0, 1); PG8_STAGE(PG8_SB(0, 0), b2, voffB); PG8_STAGE(PG8_SB(0, 1), b2 + hstep, voffB); PG8_STAGE(PG8_SA(0, 0), a2, voffA);
            PG8_WAIT_V(8); PG8_WAIT_L(0); PG8_BAR; PG8_MMA(1, 0, At, B0); PG8_MMA(1, 1, At, B1); PG8_BAR; PG8_SCHED;
            PG8_LDB(B0, 1, 0); PG8_LDB(B1, 1, 1); PG8_SCHED; PG8_LDA(At, 1, 0); PG8_STAGE(PG8_SA(0, 1), a2 + hstep, voffA);
            PG8_WAIT_V(8); PG8_WAIT_L(0); PG8_BAR; PG8_MMA(0, 0, At, B0); PG8_MMA(0, 1, At, B1); PG8_BAR; PG8_SCHED;
            PG8_LDA(At, 1, 1); PG8_STAGE(PG8_SB(1, 0), b3, voffB); PG8_STAGE(PG8_SB(1, 1), b3 + hstep, voffB); PG8_STAGE(PG8_SA(1, 0), a3, voffA);
            PG8_WAIT_V(8); PG8_WAIT_L(0); PG8_BAR; PG8_MMA(1, 0, At, B0); PG8_MMA(1, 1, At, B1); PG8_BAR; PG8_SCHED;
            } else {
            PG8_LDB(B0, 0, 0); PG8_SCHED; PG8_LDA(At, 0, 0); PG8_STAGE(PG8_SA(1, 1), a1 + hstep, voffA);
            PG8_WAIT_L(8); PG8_BAR; PG8_WAIT_L(0); PG8_MMA(0, 0, At, B0); PG8_BAR; PG8_SCHED;
            PG8_LDB(B1, 0, 1); PG8_STAGE(PG8_SB(0, 0), b2, voffB);
            PG8_BAR; PG8_WAIT_L(0); PG8_MMA(0, 1, At, B1); PG8_BAR;
            PG8_LDA(At, 0, 1); PG8_STAGE(PG8_SA(0, 0), a2, voffA);
            PG8_BAR; PG8_WAIT_L(0); PG8_MMA(1, 0, At, B0); PG8_BAR; PG8_SCHED;
            PG8_STAGE(PG8_SB(0, 1), b2 + hstep, voffB);
            PG8_WAIT_V(6); PG8_BAR; PG8_MMA(1, 1, At, B1); PG8_BAR;
            PG8_LDB(B0, 1, 0); PG8_SCHED; PG8_LDA(At, 1, 0); PG8_STAGE(PG8_SA(0, 1), a2 + hstep, voffA);
            PG8_WAIT_L(8); PG8_BAR; PG8_WAIT_L(0); PG8_MMA(0, 0, At, B0); PG8_BAR; PG8_SCHED;
            PG8_LDB(B1, 1, 1); PG8_STAGE(PG8_SB(1, 0), b3, voffB);
            PG8_BAR; PG8_WAIT_L(0); PG8_MMA(0, 1, At, B1); PG8_BAR;
            PG8_LDA(At, 1, 1); PG8_STAGE(PG8_SA(1, 0), a3, voffA);
            PG8_BAR; PG8_WAIT_L(0); PG8_MMA(1, 0, At, B0); PG8_BAR; PG8_SCHED;
            PG8_STAGE(PG8_SB(1, 1), b3 + hstep, voffB);
            PG8_WAIT_V(6); PG8_BAR; PG8_MMA(1, 1, At, B1); PG8_BAR;
            }
        }
        if constexpr (ALIGN_EPI) { if (wr == 0) PG8_BAR; }
        if constexpr (!Epi::AFTER_DRAIN) { E(acc, cur, wr, wc, fr, fq); S.done(cur); }
        if (!has_next) break;
#pragma unroll
        for (int a = 0; a < 2; ++a)
#pragma unroll
            for (int b = 0; b < 2; ++b)
#pragma unroll
                for (int m = 0; m < 4; ++m)
#pragma unroll
                    for (int n = 0; n < 2; ++n) acc[a][b][m][n] = (f32x4){0.f, 0.f, 0.f, 0.f};
        cur = nxt; cA = nA; cB = nB; ++ui;
        if constexpr (ALIGN_EPI) { if (wr == 1) PG8_BAR; }
    }
    PG8_WAIT_V(0);
    if constexpr (!ALIGN_EPI) { if (wr == 0) PG8_BAR; }
    PG8_BAR;
    if constexpr (Epi::AFTER_DRAIN) { E.fused(acc, cur, wr, wc, fr, fq, lds, wid, lane); S.done(cur); }
#undef PG8_SA
#undef PG8_SB
#undef PG8_STAGE
#undef PG8_LDA
#undef PG8_LDB
#undef PG8_MMA
#undef PG8_WAIT_V
#undef PG8_WAIT_L
#undef PG8_BAR
#undef PG8_SCHED
}
}
__device__ __forceinline__ void swa_naive(const Params& p, int bid, int nblk, int tid) {
    const bf16* proj = (const bf16*)(p.ws + WS_PROJ); bf16* att = (bf16*)(p.ws + WS_ATT);
    for (int base = bid * NTHR; base < M * 8; base += nblk * NTHR) {
        const int idx = base + tid, hq = idx >> 15, row = idx & (M - 1), t = row & (SEQ - 1), kvh = hq >> 2;
        float q[64], o[64];
        { const u32x4* q4 = (const u32x4*)(proj + (size_t)row * NP + C_QA + hq * 64);
#pragma unroll
          for (int i = 0; i < 8; ++i) { const u32x4 w = q4[i]; q[8 * i] = bflo(w.x); q[8 * i + 1] = bfhi(w.x); q[8 * i + 2] = bflo(w.y); q[8 * i + 3] = bfhi(w.y); q[8 * i + 4] = bflo(w.z); q[8 * i + 5] = bfhi(w.z); q[8 * i + 6] = bflo(w.w); q[8 * i + 7] = bfhi(w.w); } }
#pragma unroll
        for (int d = 0; d < 64; ++d) o[d] = 0.f;
        float m = p.sinks[hq] * LOG2E, l = 1.f;
        const int nk = (t < 127 ? t : 127) + 1;
        for (int j = 0; j < nk; ++j) {
            const size_t kr = (size_t)(row - j) * NP;
            const u32x4* k4 = (const u32x4*)(proj + kr + C_KA + kvh * 64); const u32x4* v4 = (const u32x4*)(proj + kr + C_VA + kvh * 64);
            float s = 0.f;
#pragma unroll
            for (int i = 0; i < 8; ++i) { const u32x4 w = k4[i]; s += q[8 * i] * bflo(w.x) + q[8 * i + 1] * bfhi(w.x) + q[8 * i + 2] * bflo(w.y) + q[8 * i + 3] * bfhi(w.y) + q[8 * i + 4] * bflo(w.z) + q[8 * i + 5] * bfhi(w.z) + q[8 * i + 6] * bflo(w.w) + q[8 * i + 7] * bfhi(w.w); }
            const float mn = fmaxf(m, s), a = exp2f(m - mn), pp = exp2f(s - mn); l = l * a + pp; m = mn;
#pragma unroll
            for (int i = 0; i < 8; ++i) { const u32x4 w = v4[i];
                o[8 * i] = o[8 * i] * a + pp * bflo(w.x); o[8 * i + 1] = o[8 * i + 1] * a + pp * bfhi(w.x); o[8 * i + 2] = o[8 * i + 2] * a + pp * bflo(w.y); o[8 * i + 3] = o[8 * i + 3] * a + pp * bfhi(w.y);
                o[8 * i + 4] = o[8 * i + 4] * a + pp * bflo(w.z); o[8 * i + 5] = o[8 * i + 5] * a + pp * bfhi(w.z); o[8 * i + 6] = o[8 * i + 6] * a + pp * bflo(w.w); o[8 * i + 7] = o[8 * i + 7] * a + pp * bfhi(w.w); }
        }
        const float rl = 1.f / l;
        u32x4* o4 = (u32x4*)(att + (size_t)row * DM + hq * 64);
#pragma unroll
        for (int i = 0; i < 8; ++i) { u32x4 w; w.x = pk2(o[8 * i] * rl, o[8 * i + 1] * rl); w.y = pk2(o[8 * i + 2] * rl, o[8 * i + 3] * rl); w.z = pk2(o[8 * i + 4] * rl, o[8 * i + 5] * rl); w.w = pk2(o[8 * i + 6] * rl, o[8 * i + 7] * rl); o4[i] = w; }
    }
}
__device__ __forceinline__ void diff_naive(const Params& p, int bid, int nblk, int tid) {
    const bf16* proj = (const bf16*)(p.ws + WS_PROJ); float* od = (float*)(p.ws + WS_ODIFF);
    for (int base = bid * NTHR; base < M * 16; base += nblk * NTHR) {
        const int idx = base + tid, sel = __builtin_amdgcn_readfirstlane(idx >> 15), row = idx & (M - 1), t = row & (SEQ - 1);
        const int hc = sel >> 1, half = sel & 1, h = hc >> 1, c = hc & 1;
        const int b = __builtin_amdgcn_readfirstlane(row >> 12);
        const int tmax = __builtin_amdgcn_readfirstlane((row | 63) & (SEQ - 1));
        float q[64], o[64];
        { const u32x4* q4 = (const u32x4*)(proj + (size_t)row * NP + C_QD + hc * 64);
#pragma unroll
          for (int i = 0; i < 8; ++i) { const u32x4 w = q4[i]; q[8 * i] = bflo(w.x); q[8 * i + 1] = bfhi(w.x); q[8 * i + 2] = bflo(w.y); q[8 * i + 3] = bfhi(w.y); q[8 * i + 4] = bflo(w.z); q[8 * i + 5] = bfhi(w.z); q[8 * i + 6] = bflo(w.w); q[8 * i + 7] = bfhi(w.w); } }
#pragma unroll
        for (int d = 0; d < 64; ++d) o[d] = 0.f;
        float m = -1e30f, l = 0.f;
        for (int kt = 0; kt <= tmax; ++kt) {
            const size_t kr = (size_t)(b * SEQ + kt) * NP;
            const u32x4* k4 = (const u32x4*)(proj + kr + C_KD + hc * 64); const u32x4* v4 = (const u32x4*)(proj + kr + C_VD + h * 128 + half * 64);
            float s = 0.f;
#pragma unroll
            for (int i = 0; i < 8; ++i) { const u32x4 w = k4[i]; s += q[8 * i] * bflo(w.x) + q[8 * i + 1] * bfhi(w.x) + q[8 * i + 2] * bflo(w.y) + q[8 * i + 3] * bfhi(w.y) + q[8 * i + 4] * bflo(w.z) + q[8 * i + 5] * bfhi(w.z) + q[8 * i + 6] * bflo(w.w) + q[8 * i + 7] * bfhi(w.w); }
            if (kt > t) s = -1e30f;
            const float mn = fmaxf(m, s), a = exp2f(m - mn), pp = (kt > t) ? 0.f : exp2f(s - mn); l = l * a + pp; m = mn;
#pragma unroll
            for (int i = 0; i < 8; ++i) { const u32x4 w = v4[i];
                o[8 * i] = o[8 * i] * a + pp * bflo(w.x); o[8 * i + 1] = o[8 * i + 1] * a + pp * bfhi(w.x); o[8 * i + 2] = o[8 * i + 2] * a + pp * bflo(w.y); o[8 * i + 3] = o[8 * i + 3] * a + pp * bfhi(w.y);
                o[8 * i + 4] = o[8 * i + 4] * a + pp * bflo(w.z); o[8 * i + 5] = o[8 * i + 5] * a + pp * bfhi(w.z); o[8 * i + 6] = o[8 * i + 6] * a + pp * bflo(w.w); o[8 * i + 7] = o[8 * i + 7] * a + pp * bfhi(w.w); }
        }
        const float rl = 1.f / l;
        f32x4* o4 = (f32x4*)(od + ((size_t)c * M + row) * 512 + h * 128 + half * 64);
#pragma unroll
        for (int i = 0; i < 16; ++i) o4[i] = (f32x4){o[4 * i] * rl, o[4 * i + 1] * rl, o[4 * i + 2] * rl, o[4 * i + 3] * rl};
    }
}
__device__ __forceinline__ void diff_combine_naive(const Params& p, int gw, int ngw, int lane) {
    const float* od = (const float*)(p.ws + WS_ODIFF); bf16* att = (bf16*)(p.ws + WS_ATT);
    const float lam = calc_lambda(p);
    for (int m = gw; m < M; m += ngw) {
#pragma unroll
        for (int h = 0; h < 4; ++h) {
            const float2 a = *(const float2*)(od + (size_t)m * 512 + h * 128 + 2 * lane), b = *(const float2*)(od + ((size_t)M + m) * 512 + h * 128 + 2 * lane);
            const float v0 = a.x - lam * b.x, v1 = a.y - lam * b.y;
            const float rstd = 1.0f / sqrtf(wave_sum(v0 * v0 + v1 * v1) * (1.f / 128.f) + EPS);
            const float2 g = *(const float2*)(p.g_diff + 2 * lane);
            *(unsigned*)(att + (size_t)m * DM + 512 + h * 128 + 2 * lane) = pk2(v0 * rstd * g.x * 0.8f, v1 * rstd * g.y * 0.8f);
        }
    }
}
__device__ __forceinline__ void cross_naive(const Params& p, LAS unsigned char* lds, int bid, int nblk, int tid) {
    const bf16* qc = (const bf16*)(p.ws + WS_QC); const bf16* kvm = (const bf16*)(p.ws + WS_KVM); bf16* oc = (bf16*)(p.ws + WS_OC);
    const int sub = tid >> 8, tm = tid & 255, w4 = (tid >> 6) & 3, lane = tid & 63;
    LAS float* qs = (LAS float*)lds + sub * 256; LAS float* ps = (LAS float*)lds + 512 + sub * 256; LAS float* red = (LAS float*)lds + 1024 + sub * 8;
    for (int i2 = bid; i2 < M * 2; i2 += nblk) {
        const int item = i2 * 2 + sub, row = item >> 2, head = item & 3, b = row >> 12;
        qs[tm] = bf2f(qc[(size_t)row * DM + head * 256 + tm]);
        __syncthreads();
        const u32x4* k4 = (const u32x4*)(kvm + (size_t)(b * MEML + tm) * 2048 + head * 256);
        float s = 0.f;
        for (int i = 0; i < 32; ++i) { const u32x4 w = k4[i]; const LAS float* qq = qs + 8 * i;
            s += qq[0] * bflo(w.x) + qq[1] * bfhi(w.x) + qq[2] * bflo(w.y) + qq[3] * bfhi(w.y) + qq[4] * bflo(w.z) + qq[5] * bfhi(w.z) + qq[6] * bflo(w.w) + qq[7] * bfhi(w.w); }
        float mx = wave_max(s); if (lane == 0) red[w4] = mx;
        __syncthreads();
        mx = fmaxf(fmaxf(red[0], red[1]), fmaxf(red[2], red[3]));
        const float e = exp2f(s - mx); ps[tm] = e;
        float sm = wave_sum(e); if (lane == 0) red[4 + w4] = sm;
        __syncthreads();
        sm = (red[4] + red[5]) + (red[6] + red[7]);
        const bf16* vp = kvm + (size_t)(b * MEML) * 2048 + 1024 + head * 256 + tm;
        float o = 0.f;
        for (int mm = 0; mm < MEML; ++mm) o += ps[mm] * bf2f(vp[(size_t)mm * 2048]);
        oc[(size_t)row * DM + head * 256 + tm] = (bf16)f2bf(o / sm);
        __syncthreads();
    }
}

#if PROBE_TS
#ifndef PROBE_WAVE
#define PROBE_WAVE 0
#endif
__device__ unsigned char* g_probe_ws;
#endif
namespace fa {
typedef short bf16x8 __attribute__((ext_vector_type(8)));
typedef short s16x4 __attribute__((ext_vector_type(4)));
typedef float f32x16 __attribute__((ext_vector_type(16)));
typedef float f32x4 __attribute__((ext_vector_type(4)));
typedef unsigned u32x4 __attribute__((ext_vector_type(4)));
constexpr int NW = 8, QBLK = 32, KVBLK = 64;
constexpr float THR = 8.f;
#define FA_SBAR() __builtin_amdgcn_sched_barrier(0)
#define FA_VMW() asm volatile("s_waitcnt vmcnt(0)" ::: "memory")
__device__ __forceinline__ int crow(int r, int hi) { return (r & 3) + 8 * (r >> 2) + 4 * hi; }
__device__ __forceinline__ unsigned cvtpk(float lo, float hi) { unsigned r; asm volatile("v_cvt_pk_bf16_f32 %0, %1, %2" : "=v"(r) : "v"(lo), "v"(hi)); return r; }

template <int NDQ> __device__ __forceinline__ int kswz(int row, int c) {
    if (NDQ == 4) return row * 128 + ((c ^ ((row >> 1) & 7)) << 4);
    else return row * (NDQ * 32) + ((c ^ (row & 15)) << 4);
}
template <int NDVT> __device__ __forceinline__ int v_st(int k, int c) { const int kk = (k & ~0xC) | ((k & 4) << 1) | ((k & 8) >> 1); return ((kk >> 3) * NDVT + (c >> 5)) * 512 + ((kk & 7) * 32 + (c & 31)) * 2; }
__device__ __forceinline__ int v_rd_base(int lane) { return ((lane & 3) << 3) | (((lane >> 2) & 3) << 6) | (((lane >> 4) & 1) << 5) | (((lane >> 5) & 1) << 8); }

__device__ __forceinline__ void mask_tile(f32x16& p0, f32x16& p1, int dq, unsigned W) {
    const float NEG = -__builtin_inff();
#pragma unroll
    for (int r = 0; r < 16; ++r) { const int c = (r & 3) + 8 * (r >> 2);
        if ((unsigned)(dq - c) >= W) p0[r] = NEG;
        if ((unsigned)(dq - c - 32) >= W) p1[r] = NEG; }
}
__device__ __forceinline__ void partialSM(f32x16& p0, f32x16& p1, float& m_reg, float& alpha) {
    float pmax = p0[0];
#pragma unroll
    for (int r = 1; r < 16; ++r) pmax = fmaxf(pmax, p0[r]);
#pragma unroll
    for (int r = 0; r < 16; ++r) pmax = fmaxf(pmax, p1[r]);
    { auto rr = __builtin_amdgcn_permlane32_swap(__float_as_uint(pmax), __float_as_uint(pmax), false, false); pmax = fmaxf(__uint_as_float(rr[0]), __uint_as_float(rr[1])); }
    float mn;
    if (__builtin_expect(__all((pmax - m_reg) <= THR), 1)) { mn = m_reg; alpha = 1.f; }
    else { mn = fmaxf(m_reg, pmax); alpha = __builtin_amdgcn_exp2f(m_reg - mn); m_reg = mn; }
#pragma unroll
    for (int r = 0; r < 16; ++r) p0[r] = p0[r] - mn;
#pragma unroll
    for (int r = 0; r < 16; ++r) p1[r] = p1[r] - mn;
#pragma unroll
    for (int r = 0; r < 16; ++r) p0[r] = __builtin_amdgcn_exp2f(p0[r]);
}
__device__ __forceinline__ void finishSM(f32x16& p0, f32x16& p1, float alpha, float& l_reg, bf16x8& pa0, bf16x8& pa1, bf16x8& pa2, bf16x8& pa3) {
#pragma unroll
    for (int r = 0; r < 16; ++r) p1[r] = __builtin_amdgcn_exp2f(p1[r]);
    float ps = 0.f;
#pragma unroll
    for (int r = 0; r < 16; ++r) ps += p0[r];
#pragma unroll
    for (int r = 0; r < 16; ++r) ps += p1[r];
    { auto rr = __builtin_amdgcn_permlane32_swap(__float_as_uint(ps), __float_as_uint(ps), false, false); ps = __uint_as_float(rr[0]) + __uint_as_float(rr[1]); }
    l_reg = l_reg * alpha + ps;
#define FA_PK4(P, B_, OUT) do { unsigned a0 = cvtpk(P[B_ + 0], P[B_ + 1]), a1 = cvtpk(P[B_ + 2], P[B_ + 3]); unsigned b0 = cvtpk(P[B_ + 4], P[B_ + 5]), b1 = cvtpk(P[B_ + 6], P[B_ + 7]); \
        auto r0 = __builtin_amdgcn_permlane32_swap(a0, b0, false, false); auto r1 = __builtin_amdgcn_permlane32_swap(a1, b1, false, false); \
        u32x4 w = {r0[0], r1[0], r0[1], r1[1]}; OUT = *reinterpret_cast<bf16x8*>(&w); } while (0)
    FA_PK4(p0, 0, pa0); FA_PK4(p0, 8, pa1); FA_PK4(p1, 0, pa2); FA_PK4(p1, 8, pa3);
#undef FA_PK4
}
template <int NDQ>
__device__ __forceinline__ void qkt(f32x16& p0, f32x16& p1, const char* Kb, int r32, int hi, const bf16x8* qr) {
    p0 = f32x16{}; p1 = f32x16{};
    constexpr int NA = NDQ < 8 ? NDQ : 8;
    const char* kb[NA];
#pragma unroll
    for (int dd = 0; dd < NA; ++dd) kb[dd] = Kb + kswz<NDQ>(r32, 2 * dd + hi);
#pragma unroll
    for (int d0 = 0; d0 < NDQ; ++d0) { const char* a = kb[d0 & (NA - 1)] + (d0 >> 3) * 256;
        const bf16x8 b0 = *reinterpret_cast<const bf16x8*>(a);
        const bf16x8 b1 = *reinterpret_cast<const bf16x8*>(a + 32 * NDQ * 32);
        p0 = __builtin_amdgcn_mfma_f32_32x32x16_bf16(b0, qr[d0], p0, 0, 0, 0);
        p1 = __builtin_amdgcn_mfma_f32_32x32x16_bf16(b1, qr[d0], p1, 0, 0, 0); }
}
template <int NDVT, int NDV>
__device__ __forceinline__ void pv_tile(f32x16* o, int vb, bf16x8 pa0, bf16x8 pa1, bf16x8 pa2, bf16x8 pa3) {
#define FA_TRRD(dst, off) asm volatile("ds_read_b64_tr_b16 %0, %1 offset:%2" : "=&v"(dst) : "v"(vb), "i"(off) : "memory")
#define FA_PV_D0(d0) do { s16x4 l0, l1, l2, l3, h0, h1, h2, h3; constexpr int b_ = (d0) * 512, ks_ = 2 * NDVT * 512, hf_ = NDVT * 512; \
        FA_TRRD(l0, b_); FA_TRRD(h0, b_ + hf_); FA_TRRD(l1, b_ + ks_); FA_TRRD(h1, b_ + ks_ + hf_); FA_TRRD(l2, b_ + 2 * ks_); FA_TRRD(h2, b_ + 2 * ks_ + hf_); FA_TRRD(l3, b_ + 3 * ks_); FA_TRRD(h3, b_ + 3 * ks_ + hf_); \
        asm volatile("s_waitcnt lgkmcnt(0)" ::: "memory"); FA_SBAR(); \
        o[d0] = __builtin_amdgcn_mfma_f32_32x32x16_bf16(pa0, (bf16x8){l0[0], l0[1], l0[2], l0[3], h0[0], h0[1], h0[2], h0[3]}, o[d0], 0, 0, 0); \
        o[d0] = __builtin_amdgcn_mfma_f32_32x32x16_bf16(pa1, (bf16x8){l1[0], l1[1], l1[2], l1[3], h1[0], h1[1], h1[2], h1[3]}, o[d0], 0, 0, 0); \
        o[d0] = __builtin_amdgcn_mfma_f32_32x32x16_bf16(pa2, (bf16x8){l2[0], l2[1], l2[2], l2[3], h2[0], h2[1], h2[2], h2[3]}, o[d0], 0, 0, 0); \
        o[d0] = __builtin_amdgcn_mfma_f32_32x32x16_bf16(pa3, (bf16x8){l3[0], l3[1], l3[2], l3[3], h3[0], h3[1], h3[2], h3[3]}, o[d0], 0, 0, 0); } while (0)
    FA_PV_D0(0); if constexpr (NDV > 1) FA_PV_D0(1); if constexpr (NDV > 2) FA_PV_D0(2); if constexpr (NDV > 3) FA_PV_D0(3);
#undef FA_PV_D0
#undef FA_TRRD
}

template <int NDQ, int NDVT, int NDV>
struct Core {
    static constexpr int KROW = NDQ * 32, SHM_K = 64 * KROW, SHM_V = 64 * NDVT * 64, NKL = NDQ / 4, NVL = NDVT / 2, LDS_NEED = 2 * SHM_V + 2 * SHM_K + NW * 256;
    static_assert(NKL >= 1 && NVL >= 1, "tile too small for 512 staging threads");
    __device__ __forceinline__ static void run(f32x16 (&o)[NDV], float& m_reg, float& l_reg, const bf16* Qw, int ldq, const bf16* Kg, const bf16* Vg, int ldk,
                                               int j_lo, int j_hi, int qlo, int W, char* lds, int vdoff) {
        int tid = threadIdx.x; asm volatile("" : "+v"(tid));
        const int wid = __builtin_amdgcn_readfirstlane(tid >> 6), lane = tid & 63, r32 = lane & 31, hi = lane >> 5;
        const int NT = j_hi - j_lo, qm = qlo + r32 - 4 * hi;
        char* V_lds = lds; char* K_lds = lds + 2 * SHM_V;
        float* wsf = (float*)(lds + 2 * SHM_V + 2 * SHM_K) + wid * 64; float* al_l = wsf + 32;
        m_reg = -1e30f; l_reg = 0.f;
#pragma unroll
        for (int d = 0; d < NDV; ++d) o[d] = f32x16{};
        constexpr int KCH = 2 * NDQ, KRS = 512 / KCH, VCH = 4 * NDVT, VRS = 512 / VCH;
        const int krow0 = tid / KCH, kch = tid % KCH, vrow0 = tid / VCH, vcol = (tid % VCH) * 8;
        int kws[NKL], vws[NVL];
#pragma unroll
        for (int i = 0; i < NKL; ++i) kws[i] = kswz<NDQ>(krow0 + i * KRS, kch);
#pragma unroll
        for (int i = 0; i < NVL; ++i) vws[i] = v_st<NDVT>(vrow0 + i * VRS, vcol);
        const bf16* kgp = Kg + (size_t)krow0 * ldk + kch * 8; const bf16* vgp = Vg + (size_t)vrow0 * ldk + vcol;
        bf16x8 sk[NKL], sv[NVL];
        const int vb0 = (int)(uintptr_t)V_lds + v_rd_base(lane) + vdoff * 512;
#define FA_SLOAD(t) do { const size_t ro_ = (size_t)((j_lo + (t)) * KVBLK) * ldk; \
        _Pragma("unroll") for (int i_ = 0; i_ < NVL; ++i_) sv[i_] = *reinterpret_cast<const bf16x8*>(vgp + ro_ + (size_t)(i_ * VRS) * ldk); \
        _Pragma("unroll") for (int i_ = 0; i_ < NKL; ++i_) sk[i_] = *reinterpret_cast<const bf16x8*>(kgp + ro_ + (size_t)(i_ * KRS) * ldk); } while (0)
#define FA_SWRITE(bf) do { _Pragma("unroll") for (int i_ = 0; i_ < NVL; ++i_) *reinterpret_cast<bf16x8*>(V_lds + (bf) * SHM_V + vws[i_]) = sv[i_]; \
        _Pragma("unroll") for (int i_ = 0; i_ < NKL; ++i_) *reinterpret_cast<bf16x8*>(K_lds + (bf) * SHM_K + kws[i_]) = sk[i_]; } while (0)
#define FA_RESC(a) do { if (__any((a) < 1.f)) { if (hi == 0) al_l[r32] = (a); asm volatile("s_waitcnt lgkmcnt(0)" ::: "memory"); \
        _Pragma("unroll") for (int d_ = 0; d_ < NDV; ++d_) _Pragma("unroll") for (int r = 0; r < 16; ++r) o[d_][r] *= al_l[crow(r, hi)]; } } while (0)
#define FA_KBASE(t) ((j_lo + (t)) * KVBLK)
#define FA_MASKT(P0_, P1_, t) do { const int kb_ = FA_KBASE(t); if (kb_ + KVBLK - 1 > qlo || kb_ <= qlo + QBLK - 1 - W) mask_tile(P0_, P1_, qm - kb_, (unsigned)W); } while (0)
        bf16x8 qr[NDQ];
#pragma unroll
        for (int d0 = 0; d0 < NDQ; ++d0) qr[d0] = *reinterpret_cast<const bf16x8*>(Qw + (size_t)r32 * ldq + d0 * 16 + hi * 8);
        FA_SLOAD(0); FA_VMW(); FA_SWRITE(0); FA_SBAR();
        if (NT > 1) FA_SLOAD(1);
        __syncthreads();
        f32x16 pA0, pA1, pB0, pB1; float alA, alB; bf16x8 pa0, pa1, pa2, pa3;
        FA_SBAR(); qkt<NDQ>(pA0, pA1, K_lds, r32, hi, qr);
        FA_MASKT(pA0, pA1, 0); partialSM(pA0, pA1, m_reg, alA);
        if (NT > 1) { FA_VMW(); FA_SWRITE(1); }
        __syncthreads();
#define FA_HALF_STEP(PX0, PX1, alX, PY0, PY1, alY, t, KB, VB, SB) do { \
        FA_SBAR(); qkt<NDQ>(PX0, PX1, K_lds + (KB) * SHM_K, r32, hi, qr); \
        finishSM(PY0, PY1, alY, l_reg, pa0, pa1, pa2, pa3); FA_SBAR(); \
        if ((t) + 1 < NT) { FA_SLOAD((t) + 1); FA_SBAR(); } \
        pv_tile<NDVT, NDV>(o, vb0 + (VB) * SHM_V, pa0, pa1, pa2, pa3); FA_MASKT(PX0, PX1, (t)); partialSM(PX0, PX1, m_reg, alX); \
        __syncthreads(); \
        if ((t) + 1 < NT) { FA_VMW(); FA_SWRITE(SB); } \
        FA_RESC(alX); __syncthreads(); } while (0)
        for (int t = 1; t + 1 < NT; t += 2) {
            FA_HALF_STEP(pB0, pB1, alB, pA0, pA1, alA, t, 1, 0, 0);
            FA_HALF_STEP(pA0, pA1, alA, pB0, pB1, alB, t + 1, 0, 1, 1);
        }
        const bool even = (NT & 1) == 0;
        if (even) { FA_SBAR(); qkt<NDQ>(pB0, pB1, K_lds + SHM_K, r32, hi, qr); FA_SBAR(); }
        finishSM(pA0, pA1, alA, l_reg, pa0, pa1, pa2, pa3); FA_SBAR();
        pv_tile<NDVT, NDV>(o, vb0, pa0, pa1, pa2, pa3);
        if (even) { FA_MASKT(pB0, pB1, NT - 1); partialSM(pB0, pB1, m_reg, alB); FA_RESC(alB);
            finishSM(pB0, pB1, alB, l_reg, pa0, pa1, pa2, pa3); FA_SBAR(); pv_tile<NDVT, NDV>(o, vb0 + SHM_V, pa0, pa1, pa2, pa3); }
        __syncthreads();
#undef FA_SLOAD
#undef FA_SWRITE
#undef FA_RESC
#undef FA_KBASE
#undef FA_MASKT
#undef FA_HALF_STEP
    }
};

#define FA_PIN(x) asm volatile("" : "+v"(x))
#define FA_PK4V(P, B_, OUT) do { unsigned a0_ = cvtpk(P[B_ + 0], P[B_ + 1]), a1_ = cvtpk(P[B_ + 2], P[B_ + 3]); unsigned b0_ = cvtpk(P[B_ + 4], P[B_ + 5]), b1_ = cvtpk(P[B_ + 6], P[B_ + 7]); \
        auto r0_ = __builtin_amdgcn_permlane32_swap(a0_, b0_, false, false); auto r1_ = __builtin_amdgcn_permlane32_swap(a1_, b1_, false, false); \
        u32x4 w_ = {r0_[0], r1_[0], r0_[1], r1_[1]}; OUT = *reinterpret_cast<bf16x8*>(&w_); } while (0)
__device__ __forceinline__ void step_qk_fin(f32x16& X0, f32x16& X1, const char* Kb, int r32, int hi, const bf16x8* qr,
                                            f32x16& Y0, f32x16& Y1, float alY, float& l_reg, bf16x8& pa0, bf16x8& pa1, bf16x8& pa2, bf16x8& pa3) {
    const char* k0 = Kb + kswz<4>(r32, hi); const char* k1 = Kb + kswz<4>(r32, 2 + hi); const char* k2 = Kb + kswz<4>(r32, 4 + hi); const char* k3 = Kb + kswz<4>(r32, 6 + hi);
    bf16x8 fa = *reinterpret_cast<const bf16x8*>(k0), fb = *reinterpret_cast<const bf16x8*>(k0 + 4096);
    float ps;
    X0 = __builtin_amdgcn_mfma_f32_32x32x16_bf16(fa, qr[0], f32x16{}, 0, 0, 0); X1 = __builtin_amdgcn_mfma_f32_32x32x16_bf16(fb, qr[0], f32x16{}, 0, 0, 0);
    fa = *reinterpret_cast<const bf16x8*>(k1); fb = *reinterpret_cast<const bf16x8*>(k1 + 4096);
#pragma unroll
    for (int r = 0; r < 4; ++r) Y1[r] = __builtin_amdgcn_exp2f(Y1[r]);
    ps = (Y0[0] + Y0[1]) + (Y0[2] + Y0[3]);
    FA_PK4V(Y0, 0, pa0); FA_PIN(ps); FA_PIN(pa0); FA_PIN(Y1); FA_SBAR();
    X0 = __builtin_amdgcn_mfma_f32_32x32x16_bf16(fa, qr[1], X0, 0, 0, 0); X1 = __builtin_amdgcn_mfma_f32_32x32x16_bf16(fb, qr[1], X1, 0, 0, 0);
    fa = *reinterpret_cast<const bf16x8*>(k2); fb = *reinterpret_cast<const bf16x8*>(k2 + 4096);
#pragma unroll
    for (int r = 4; r < 8; ++r) Y1[r] = __builtin_amdgcn_exp2f(Y1[r]);
    ps += (Y0[4] + Y0[5]) + (Y0[6] + Y0[7]); ps += (Y1[0] + Y1[1]) + (Y1[2] + Y1[3]);
    FA_PK4V(Y0, 8, pa1); FA_PIN(ps); FA_PIN(pa1); FA_PIN(Y1); FA_SBAR();
    X0 = __builtin_amdgcn_mfma_f32_32x32x16_bf16(fa, qr[2], X0, 0, 0, 0); X1 = __builtin_amdgcn_mfma_f32_32x32x16_bf16(fb, qr[2], X1, 0, 0, 0);
    fa = *reinterpret_cast<const bf16x8*>(k3); fb = *reinterpret_cast<const bf16x8*>(k3 + 4096);
#pragma unroll
    for (int r = 8; r < 12; ++r) Y1[r] = __builtin_amdgcn_exp2f(Y1[r]);
    ps += (Y0[8] + Y0[9]) + (Y0[10] + Y0[11]); ps += (Y1[4] + Y1[5]) + (Y1[6] + Y1[7]);
    FA_PK4V(Y1, 0, pa2); FA_PIN(ps); FA_PIN(pa2); FA_PIN(Y1); FA_SBAR();
    X0 = __builtin_amdgcn_mfma_f32_32x32x16_bf16(fa, qr[3], X0, 0, 0, 0); X1 = __builtin_amdgcn_mfma_f32_32x32x16_bf16(fb, qr[3], X1, 0, 0, 0);
#pragma unroll
    for (int r = 12; r < 16; ++r) Y1[r] = __builtin_amdgcn_exp2f(Y1[r]);
    ps += (Y0[12] + Y0[13]) + (Y0[14] + Y0[15]); ps += (Y1[8] + Y1[9]) + (Y1[10] + Y1[11]); ps += (Y1[12] + Y1[13]) + (Y1[14] + Y1[15]);
    { auto rr = __builtin_amdgcn_permlane32_swap(__float_as_uint(ps), __float_as_uint(ps), false, false); ps = __uint_as_float(rr[0]) + __uint_as_float(rr[1]); }
    l_reg = l_reg * alY + ps;
    FA_PK4V(Y1, 8, pa3); FA_PIN(l_reg); FA_PIN(pa3); FA_PIN(X0); FA_PIN(X1); FA_SBAR();
}
__device__ __forceinline__ void step_pv_max(f32x16* o, int vb, bf16x8 pa0, bf16x8 pa1, bf16x8 pa2, bf16x8 pa3, f32x16& X0, f32x16& X1, float& m_reg, float& alpha, bool MASK, int dq, unsigned W) {
#define FA_TRRD(dst, off) asm volatile("ds_read_b64_tr_b16 %0, %1 offset:%2" : "=&v"(dst) : "v"(vb), "i"(off) : "memory")
#define FA_RD2(l, h, d0, ks) do { FA_TRRD(l, (d0) * 512 + (ks) * 4096); FA_TRRD(h, (d0) * 512 + (ks) * 4096 + 2048); } while (0)
#define FA_FRAG(l, h) (bf16x8){l[0], l[1], l[2], l[3], h[0], h[1], h[2], h[3]}
    s16x4 l0, h0, l1, h1, l2, h2, l3, h3;
    FA_RD2(l0, h0, 0, 0); FA_RD2(l1, h1, 0, 1); FA_RD2(l2, h2, 0, 2); FA_RD2(l3, h3, 0, 3);
    if (MASK) mask_tile(X0, X1, dq, W);
    float pmax = fmaxf(fmaxf(X0[0], X0[1]), X1[0]);
#pragma unroll
    for (int r = 2; r < 16; r += 2) pmax = fmaxf(fmaxf(pmax, X0[r]), X0[r + 1]);
#pragma unroll
    for (int r = 1; r < 16; r += 2) pmax = fmaxf(fmaxf(pmax, X1[r]), X1[(r + 1) & 15]);
    { auto rr = __builtin_amdgcn_permlane32_swap(__float_as_uint(pmax), __float_as_uint(pmax), false, false); pmax = fmaxf(__uint_as_float(rr[0]), __uint_as_float(rr[1])); }
    float mn;
    if (__builtin_expect(__all((pmax - m_reg) <= THR), 1)) { mn = m_reg; alpha = 1.f; }
    else { mn = fmaxf(m_reg, pmax); alpha = __builtin_amdgcn_exp2f(m_reg - mn); m_reg = mn; }
    FA_PIN(mn);
#define FA_BLK(d0, NXT, FILL) do { asm volatile("s_waitcnt lgkmcnt(0)" ::: "memory"); FA_SBAR(); \
        o[d0] = __builtin_amdgcn_mfma_f32_32x32x16_bf16(pa0, FA_FRAG(l0, h0), o[d0], 0, 0, 0); if (NXT) FA_RD2(l0, h0, (d0) + 1, 0); \
        o[d0] = __builtin_amdgcn_mfma_f32_32x32x16_bf16(pa1, FA_FRAG(l1, h1), o[d0], 0, 0, 0); if (NXT) FA_RD2(l1, h1, (d0) + 1, 1); \
        o[d0] = __builtin_amdgcn_mfma_f32_32x32x16_bf16(pa2, FA_FRAG(l2, h2), o[d0], 0, 0, 0); if (NXT) FA_RD2(l2, h2, (d0) + 1, 2); \
        o[d0] = __builtin_amdgcn_mfma_f32_32x32x16_bf16(pa3, FA_FRAG(l3, h3), o[d0], 0, 0, 0); if (NXT) FA_RD2(l3, h3, (d0) + 1, 3); \
        FILL; } while (0)
    FA_BLK(0, true,  { _Pragma("unroll") for (int r = 0; r < 16; ++r) X0[r] = X0[r] - mn; FA_PIN(X0); });
    FA_BLK(1, true,  { _Pragma("unroll") for (int r = 0; r < 16; ++r) X1[r] = X1[r] - mn; FA_PIN(X1); });
    FA_BLK(2, true,  { _Pragma("unroll") for (int r = 0; r < 8; ++r) X0[r] = __builtin_amdgcn_exp2f(X0[r]); FA_PIN(X0); });
    FA_BLK(3, false, { _Pragma("unroll") for (int r = 8; r < 16; ++r) X0[r] = __builtin_amdgcn_exp2f(X0[r]); FA_PIN(X0); });
    FA_SBAR();
#undef FA_BLK
#undef FA_RD2
#undef FA_FRAG
#undef FA_TRRD
}

template <int NDQ, int NDVT, int NDV>
struct CoreStag {
    static_assert(NDQ == 4 && NDVT == 4 && NDV == 4, "the interleaved interval bodies are written for d_qk = 64, d_v = 128");
    static constexpr int KROW = NDQ * 32, SHM_K = 64 * KROW, SHM_V = 64 * NDVT * 64, NKL = NDQ / 4, NVL = NDVT / 2, LDS_NEED = 2 * SHM_V + 2 * SHM_K + NW * 256;
    __device__ __forceinline__ static void run(f32x16 (&o)[NDV], float& m_reg, float& l_reg, const bf16* Qw, int ldq, const bf16* Kg, const bf16* Vg, int ldk,
                                               int j_lo, int j_hi, int qlo, int W, char* lds, int vdoff) {
        const int tid = threadIdx.x, wid = __builtin_amdgcn_readfirstlane(tid >> 6), lane = tid & 63, r32 = lane & 31, hi = lane >> 5;
        const bool half1 = wid >= 4;
        const int NT = j_hi - j_lo, qm = qlo + r32 - 4 * hi;
        char* V_lds = lds; char* K_lds = lds + 2 * SHM_V;
        float* al_l = (float*)(lds + 2 * SHM_V + 2 * SHM_K) + wid * 64 + 32;
        m_reg = -1e30f; l_reg = 0.f;
#if PROBE_TS
        unsigned long long tbar_ = 0; const unsigned long long tst_ = __builtin_amdgcn_s_memtime(), trt_ = __builtin_amdgcn_s_memrealtime();
#endif
#pragma unroll
        for (int d = 0; d < NDV; ++d) o[d] = f32x16{};
        constexpr int KCH = 2 * NDQ, KRS = 512 / KCH, VCH = 4 * NDVT, VRS = 512 / VCH;
        const int krow0 = tid / KCH, kch = tid % KCH, vrow0 = tid / VCH, vcol = (tid % VCH) * 8;
        int kws[NKL], vws[NVL];
#pragma unroll
        for (int i = 0; i < NKL; ++i) kws[i] = kswz<NDQ>(krow0 + i * KRS, kch);
#pragma unroll
        for (int i = 0; i < NVL; ++i) vws[i] = v_st<NDVT>(vrow0 + i * VRS, vcol);
        const bf16* kgp = Kg + (size_t)(j_lo * KVBLK + krow0) * ldk + kch * 8; const bf16* vgp = Vg + (size_t)(j_lo * KVBLK + vrow0) * ldk + vcol;
        bf16x8 sk[NKL], sv[NVL];
        const int vb0 = (int)(uintptr_t)V_lds + v_rd_base(lane) + vdoff * 512;
#if PROBE_TS
#define FS_BAR() do { FA_SBAR(); const unsigned long long tb0_ = __builtin_amdgcn_s_memtime(); __syncthreads(); tbar_ += __builtin_amdgcn_s_memtime() - tb0_; FA_SBAR(); } while (0)
#else
#define FS_BAR() do { FA_SBAR(); __syncthreads(); FA_SBAR(); } while (0)
#endif
#define FS_LOADK(t) do { if ((t) < NT) { const size_t ro_ = (size_t)((t) * KVBLK) * ldk; _Pragma("unroll") for (int i_ = 0; i_ < NKL; ++i_) sk[i_] = *reinterpret_cast<const bf16x8*>(kgp + ro_ + (size_t)(i_ * KRS) * ldk); } } while (0)
#define FS_LOADV(t) do { if ((t) < NT) { const size_t ro_ = (size_t)((t) * KVBLK) * ldk; _Pragma("unroll") for (int i_ = 0; i_ < NVL; ++i_) sv[i_] = *reinterpret_cast<const bf16x8*>(vgp + ro_ + (size_t)(i_ * VRS) * ldk); } } while (0)
#define FS_WRITEK(t, bf) do { if ((t) < NT) { _Pragma("unroll") for (int i_ = 0; i_ < NKL; ++i_) *reinterpret_cast<bf16x8*>(K_lds + (bf) * SHM_K + kws[i_]) = sk[i_]; } } while (0)
#define FS_WRITEV(t, bf) do { if ((t) < NT) { _Pragma("unroll") for (int i_ = 0; i_ < NVL; ++i_) *reinterpret_cast<bf16x8*>(V_lds + (bf) * SHM_V + vws[i_]) = sv[i_]; } } while (0)
#define FS_RESC(a) do { if (__any((a) < 1.f)) { if (hi == 0) al_l[r32] = (a); asm volatile("s_waitcnt lgkmcnt(0)" ::: "memory"); \
        _Pragma("unroll") for (int d_ = 0; d_ < NDV; ++d_) _Pragma("unroll") for (int r = 0; r < 16; ++r) o[d_][r] *= al_l[crow(r, hi)]; } } while (0)
#define FS_MASKT(P0_, P1_, t) do { const int kb_ = (j_lo + (t)) * KVBLK; if (kb_ + KVBLK - 1 > qlo || kb_ <= qlo + QBLK - 1 - W) mask_tile(P0_, P1_, qm - kb_, (unsigned)W); } while (0)
        bf16x8 qr[NDQ];
#pragma unroll
        for (int d0 = 0; d0 < NDQ; ++d0) qr[d0] = *reinterpret_cast<const bf16x8*>(Qw + (size_t)r32 * ldq + d0 * 16 + hi * 8);
        FS_LOADK(0); FS_WRITEK(0, 0); FA_SBAR(); FS_LOADK(1); FS_LOADV(0);
        FS_BAR();
        if (half1) { FS_BAR(); }
        f32x16 pA0, pA1, pB0, pB1; float alA = 1.f, alB = 1.f; bf16x8 pa0, pa1, pa2, pa3;
        FS_WRITEK(1, 1); FA_SBAR(); FS_LOADK(2); FA_SBAR();
        qkt<NDQ>(pA0, pA1, K_lds, r32, hi, qr); asm volatile("" : "+v"(pA0), "+v"(pA1));
        FS_BAR();
        FS_WRITEV(0, 0); FA_SBAR(); FS_LOADV(1); FA_SBAR();
        FS_MASKT(pA0, pA1, 0); partialSM(pA0, pA1, m_reg, alA);
        FS_BAR();
#define FS_STEP(PX0, PX1, alX, PY0, PY1, alY, t, KB) do { \
        finishSM(PY0, PY1, alY, l_reg, pa0, pa1, pa2, pa3); FA_SBAR(); \
        FS_WRITEK((t) + 1, (KB) ^ 1); FA_SBAR(); FS_LOADK((t) + 2); FA_SBAR(); \
        qkt<NDQ>(PX0, PX1, K_lds + (KB) * SHM_K, r32, hi, qr); asm volatile("" : "+v"(PX0), "+v"(PX1)); \
        FS_BAR(); \
        pv_tile<NDVT, NDV>(o, vb0 + ((KB) ^ 1) * SHM_V, pa0, pa1, pa2, pa3); \
        FS_WRITEV((t), (KB)); FA_SBAR(); FS_LOADV((t) + 1); FA_SBAR(); \
        FS_MASKT(PX0, PX1, (t)); partialSM(PX0, PX1, m_reg, alX); FS_RESC(alX); \
        FS_BAR(); } while (0)
        int t = 1;
        for (; t + 1 < NT; t += 2) {
            FS_STEP(pB0, pB1, alB, pA0, pA1, alA, t, 1);
            FS_STEP(pA0, pA1, alA, pB0, pB1, alB, t + 1, 0);
        }
        FS_STEP(pB0, pB1, alB, pA0, pA1, alA, t, 1);
        finishSM(pB0, pB1, alB, l_reg, pa0, pa1, pa2, pa3); FA_SBAR();
        FS_BAR();
        pv_tile<NDVT, NDV>(o, vb0 + SHM_V, pa0, pa1, pa2, pa3);
        FS_BAR();
        if (!half1) { FS_BAR(); }
#if PROBE_TS
        if (blockIdx.x == 0 && tid == PROBE_WAVE * 64 && NT == 64) { volatile unsigned long long* ts = (volatile unsigned long long*)(g_probe_ws + 1024);
            ts[30] = 0; ts[31] = tbar_ / 24; ts[32] = (__builtin_amdgcn_s_memtime() - tst_) / 24; ts[33] = __builtin_amdgcn_s_memrealtime() - trt_; }
#endif
#undef FS_BAR
#undef FS_LOADK
#undef FS_LOADV
#undef FS_WRITEK
#undef FS_WRITEV
#undef FS_RESC
#undef FS_MASKT
#undef FS_STEP
    }
};
}

constexpr size_t WS_STASH = 128 * MiB;
typedef unsigned v4u32 __attribute__((__vector_size__(16)));
__device__ __forceinline__ __amdgpu_buffer_rsrc_t mk_rsrc(const void* ptr) {
    const unsigned long long v = (unsigned long long)ptr; const unsigned lo = __builtin_amdgcn_readfirstlane((unsigned)v), hi = __builtin_amdgcn_readfirstlane((unsigned)(v >> 32));
    return __builtin_amdgcn_make_buffer_rsrc((void*)(((unsigned long long)hi << 32) | lo), 0, 0x40000000, 0x00020000);
}
__device__ __forceinline__ void attn_phase(const Params& p, char* lds, int vcu0, int nwg) {
    using namespace fa;
    const int tid = threadIdx.x, wid = __builtin_amdgcn_readfirstlane(tid >> 6), lane = tid & 63, r32 = lane & 31, hi = lane >> 5;
    const bf16* proj = (const bf16*)(p.ws + WS_PROJ); bf16* att = (bf16*)(p.ws + WS_ATT);
    typedef CoreStag<4, 4, 4> CD; typedef Core<4, 2, 2> CS;
    float* wsf = (float*)(lds + CD::LDS_NEED) + wid * 64;
    const float lam = calc_lambda(p);
    const int ovoff = (4 * hi * DM + r32) * 2;
#ifndef PROBE_ATT
#define PROBE_ATT 0
#endif
#ifndef FA_NO_DIFF
    for (int rpa_ = 0; rpa_ < (PROBE_ATT == 1 ? 2 : 1); ++rpa_)
#pragma nounroll
    for (int vcu = vcu0; vcu < 256; vcu += nwg) {
        const int bh = vcu >> 3, b = bh >> 2, h = bh & 3, s = vcu & 7;
        u32x4* stash = (u32x4*)(lds + CD::LDS_NEED + NW * 256) + tid;
#pragma nounroll
        for (int pass = 0; pass < 2; ++pass) {
            const int qb = pass ? 15 - s : s;
            const size_t row0 = (size_t)b * SEQ + qb * 256 + wid * 32;
#pragma nounroll
            for (int c = 0; c < 2; ++c) {
                f32x16 o[4]; float m_reg, l_reg;
                CD::run(o, m_reg, l_reg, proj + row0 * NP + C_QD + (2 * h + c) * 64, NP, proj + (size_t)b * SEQ * NP + C_KD + (2 * h + c) * 64, proj + (size_t)b * SEQ * NP + C_VD + h * 128, NP,
                        0, 4 * (qb + 1), qb * 256 + wid * 32, 1 << 30, lds, 0);
                if (hi == 0) wsf[r32] = l_reg;
                asm volatile("s_waitcnt lgkmcnt(0)" ::: "memory");
                if (c == 0) {
#pragma unroll
                    for (int j = 0; j < 2; ++j) { float ri[8];
#pragma unroll
                        for (int e = 0; e < 8; ++e) ri[e] = 1.0f / wsf[crow(8 * j + e, hi)];
#pragma unroll
                        for (int d0 = 0; d0 < 4; ++d0) { u32x4 w; w.x = cvtpk(o[d0][8 * j] * ri[0], o[d0][8 * j + 1] * ri[1]); w.y = cvtpk(o[d0][8 * j + 2] * ri[2], o[d0][8 * j + 3] * ri[3]);
                            w.z = cvtpk(o[d0][8 * j + 4] * ri[4], o[d0][8 * j + 5] * ri[5]); w.w = cvtpk(o[d0][8 * j + 6] * ri[6], o[d0][8 * j + 7] * ri[7]); stash[(d0 * 2 + j) * NTHR] = w; } }
                } else {
                    const __amdgpu_buffer_rsrc_t rso = mk_rsrc(att + row0 * DM + 512 + h * 128);
                    float ssq[16];
#pragma unroll
                    for (int r = 0; r < 16; ++r) ssq[r] = -lam / wsf[crow(r, hi)];
#pragma unroll
                    for (int d0 = 0; d0 < 4; ++d0)
#pragma unroll
                        for (int j = 0; j < 2; ++j) { const u32x4 w = stash[(d0 * 2 + j) * NTHR]; const unsigned ww[4] = {w.x, w.y, w.z, w.w};
#pragma unroll
                            for (int e = 0; e < 8; ++e) { const int r = 8 * j + e; const float a0 = (e & 1) ? __uint_as_float(ww[e >> 1] & 0xffff0000u) : __uint_as_float(ww[e >> 1] << 16);
                                o[d0][r] = a0 + ssq[r] * o[d0][r]; } }
#pragma unroll
                    for (int r = 0; r < 16; ++r) { float q = (o[0][r] * o[0][r] + o[1][r] * o[1][r]) + (o[2][r] * o[2][r] + o[3][r] * o[3][r]);
                        q += __shfl_xor(q, 1); q += __shfl_xor(q, 2); q += __shfl_xor(q, 4); q += __shfl_xor(q, 8); q += __shfl_xor(q, 16);
                        ssq[r] = 0.8f / sqrtf(q * (1.f / 128.f) + EPS); }
#pragma unroll
                    for (int d0 = 0; d0 < 4; ++d0) { const float g = p.g_diff[d0 * 32 + r32];
#pragma unroll
                        for (int r = 0; r < 16; ++r) { const float y = o[d0][r] * ssq[r] * g; const float yn = __shfl_xor(y, 1);
                            if ((r32 & 1) == 0) __builtin_amdgcn_raw_buffer_store_b32(cvtpk(y, yn), rso, ovoff, (((r & 3) + 8 * (r >> 2)) * DM + d0 * 32) * 2, 0); } }
                }
                asm volatile("s_waitcnt lgkmcnt(0)" ::: "memory");
            }
        }
    }
#endif
#ifndef FA_NO_SWA
    int tid_s = threadIdx.x; asm volatile("" : "+v"(tid_s));
    const int wid_s = __builtin_amdgcn_readfirstlane(tid_s >> 6), r32_s = tid_s & 31, hi_s = (tid_s >> 5) & 1;
    float* wsf_s = (float*)(lds + CD::LDS_NEED) + wid_s * 64; const int ovoff_s = (4 * hi_s * DM + r32_s) * 2;
    for (int rps_ = 0; rps_ < (PROBE_ATT == 2 ? 2 : 1); ++rps_)
#pragma nounroll
    for (int u = vcu0; u < 1024; u += nwg) {
        const int wid = wid_s, r32 = r32_s, hi = hi_s, ovoff = ovoff_s; float* wsf = wsf_s;
        const int bk = u >> 6, g64 = u & 63, b = bk >> 1, kvh = bk & 1, hq = kvh * 4 + (wid >> 1), sub = wid & 1;
        const size_t row0 = (size_t)b * SEQ + g64 * 64 + sub * 32;
        const __amdgpu_buffer_rsrc_t rso = mk_rsrc(att + row0 * DM + hq * 64);
        f32x16 o[2]; float m_reg, l_reg;
        const bf16* Qw = proj + row0 * NP + C_QA + hq * 64;
        const bf16* Kg = proj + (size_t)b * SEQ * NP + C_KA + kvh * 64;
        const bf16* Vg = proj + (size_t)b * SEQ * NP + C_VA + kvh * 64;
        CS::run(o, m_reg, l_reg, Qw, NP, Kg, Vg, NP, g64 >= 2 ? g64 - 2 : 0, g64 + 1, g64 * 64 + sub * 32, 128, lds, 0);
        const float lt = l_reg + __builtin_amdgcn_exp2f(p.sinks[hq] * LOG2E - m_reg);
        if (hi == 0) wsf[r32] = lt;
        asm volatile("s_waitcnt lgkmcnt(0)" ::: "memory");
#pragma unroll
        for (int r = 0; r < 16; ++r) { const float rl = 1.0f / wsf[crow(r, hi)];
#pragma unroll
            for (int d0 = 0; d0 < 2; ++d0) { const float y = o[d0][r] * rl; const float yn = __shfl_xor(y, 1);
                if ((r32 & 1) == 0) __builtin_amdgcn_raw_buffer_store_b32(cvtpk(y, yn), rso, ovoff, (((r & 3) + 8 * (r >> 2)) * DM + d0 * 32) * 2, 0); } }
        __syncthreads();
    }
#endif
}

namespace fa {
template <int NDQ, int NDVT, int NDV>
struct CoreSeqG {
    static constexpr int KROW = NDQ * 32, SHM_K = 64 * KROW, SHM_V = 64 * NDVT * 64, KPW = SHM_K / 8192, VPW = SHM_V / 8192;
    static_assert(NDQ == 16 && NDVT == 8, "piece maps below are written for 512-byte K rows and 8 V column blocks");
    typedef __attribute__((address_space(3))) unsigned char* lptr;
    __device__ __forceinline__ static void run(f32x16 (&o)[NDV], float& m_reg, float& l_reg, const bf16* Qw, int ldq, const bf16* Kg, const bf16* Vg, int ldk, int NT, char* lds, lptr ldsL, int scr_off, int vdoff) {
        const int tid = threadIdx.x, wid = __builtin_amdgcn_readfirstlane(tid >> 6), lane = tid & 63, r32 = lane & 31, hi = lane >> 5;
        char* V_lds = lds; char* K_lds = lds + 2 * SHM_V;
        float* al_l = (float*)(lds + scr_off) + wid * 64 + 32;
        m_reg = -1e30f; l_reg = 0.f;
#pragma unroll
        for (int d = 0; d < NDV; ++d) o[d] = f32x16{};
        int ksrc[KPW], vsrc[VPW];
#pragma unroll
        for (int i = 0; i < KPW; ++i) { const int row = 2 * (wid * KPW + i) + (lane >> 5); ksrc[i] = row * ldk + (((lane & 31) ^ (row & 15)) << 3); }
#pragma unroll
        for (int i = 0; i < VPW; ++i) { const int kk = wid * 8 + ((lane & 31) >> 2), k = (kk & ~0xC) | ((kk & 4) << 1) | ((kk & 8) >> 1); vsrc[i] = k * ldk + (2 * i + (lane >> 5)) * 32 + (lane & 3) * 8; }
#ifndef PROBE_XT
#define PROBE_XT 0
#endif
#define FG_DMA(t, bf) do { const size_t ro_ = (size_t)((PROBE_XT ? ((t) & 3) : (t)) * KVBLK) * ldk; \
        _Pragma("unroll") for (int i_ = 0; i_ < VPW; ++i_) __builtin_amdgcn_global_load_lds((const unsigned*)(Vg + ro_ + vsrc[i_]), (__attribute__((address_space(3))) unsigned*)(ldsL + (bf) * SHM_V + (wid * VPW + i_) * 1024), 16, 0, 0); \
        _Pragma("unroll") for (int i_ = 0; i_ < KPW; ++i_) __builtin_amdgcn_global_load_lds((const unsigned*)(Kg + ro_ + ksrc[i_]), (__attribute__((address_space(3))) unsigned*)(ldsL + 2 * SHM_V + (bf) * SHM_K + (wid * KPW + i_) * 1024), 16, 0, 0); } while (0)
        const int vb0 = (int)(uintptr_t)V_lds + v_rd_base(lane) + vdoff * 512;
        FG_DMA(0, 0);
        bf16x8 qr[NDQ];
#pragma unroll
        for (int d0 = 0; d0 < NDQ; ++d0) qr[d0] = *reinterpret_cast<const bf16x8*>(Qw + (size_t)r32 * ldq + d0 * 16 + hi * 8);
        __syncthreads();
        for (int t = 0; t < NT; ++t) {
            const int bf = t & 1;
            if (t + 1 < NT) FG_DMA(t + 1, bf ^ 1);
            f32x16 p0, p1; float al; bf16x8 pa0, pa1, pa2, pa3;
            FA_SBAR(); qkt<NDQ>(p0, p1, K_lds + bf * SHM_K, r32, hi, qr);
            partialSM(p0, p1, m_reg, al);
            if (__any(al < 1.f)) { if (hi == 0) al_l[r32] = al; asm volatile("s_waitcnt lgkmcnt(0)" ::: "memory");
#pragma unroll
                for (int d_ = 0; d_ < NDV; ++d_)
#pragma unroll
                    for (int r = 0; r < 16; ++r) o[d_][r] *= al_l[crow(r, hi)]; }
            finishSM(p0, p1, al, l_reg, pa0, pa1, pa2, pa3); FA_SBAR();
            pv_tile<NDVT, NDV>(o, vb0 + bf * SHM_V, pa0, pa1, pa2, pa3);
            __syncthreads();
        }
#undef FG_DMA
    }
};
}
__device__ __forceinline__ void cross_phase(const Params& p, char* lds, LAS unsigned char* ldsL, int vcu0, int nwg) {
    using namespace fa;
    const int tid = threadIdx.x, wid = __builtin_amdgcn_readfirstlane(tid >> 6), lane = tid & 63, r32 = lane & 31, hi = lane >> 5;
    const bf16* qc = (const bf16*)(p.ws + WS_QC); const bf16* kvm = (const bf16*)(p.ws + WS_KVM); bf16* oc = (bf16*)(p.ws + WS_OC);
    typedef CoreSeqG<16, 8, 4> CC;
    constexpr int SCR = 131072 + 8192;
    float* wsf = (float*)(lds + SCR + 2048) + wid * 64;
    const int ovoff = (4 * hi * DM + r32) * 2;
#pragma nounroll
    for (int u = vcu0; u < 1024; u += nwg) {
        const int bh = u >> 5, rb = u & 31, b = bh >> 2, head = bh & 3, dh = wid >> 2;
        const size_t row0 = (size_t)b * SEQ + rb * 128 + (wid & 3) * 32;
        const __amdgpu_buffer_rsrc_t rso = mk_rsrc(oc + row0 * DM + head * 256 + dh * 128);
        f32x16 o[4]; float m_reg, l_reg;
        if (u == vcu0) TS(p, 10);
        CC::run(o, m_reg, l_reg, qc + row0 * DM + head * 256, DM, kvm + (size_t)b * MEML * 2048 + head * 256, kvm + (size_t)b * MEML * 2048 + 1024 + head * 256, 2048, (PROBE_XT ? 2 : 1) * (MEML / 64), lds, (CC::lptr)(__attribute__((address_space(3))) void*)ldsL, SCR, dh * 4);
        if (u == vcu0) TS(p, 11);
        if (hi == 0) wsf[r32] = l_reg;
        asm volatile("s_waitcnt lgkmcnt(0)" ::: "memory");
#pragma unroll
        for (int r = 0; r < 16; ++r) { const float rl = 1.0f / wsf[crow(r, hi)];
#pragma unroll
            for (int d0 = 0; d0 < 4; ++d0) { const float y = o[d0][r] * rl; const float yn = __shfl_xor(y, 1);
                if ((r32 & 1) == 0) __builtin_amdgcn_raw_buffer_store_b32(cvtpk(y, yn), rso, ovoff, (((r & 3) + 8 * (r >> 2)) * DM + d0 * 32) * 2, 0); } }
        asm volatile("s_waitcnt vmcnt(0) lgkmcnt(0)" ::: "memory");
        if (u == vcu0) TS(p, 12);
    }
}
#define GAS __attribute__((address_space(1)))
typedef GAS unsigned gu32;
constexpr int CW_BAR = 4096;
constexpr size_t CTL_ZERO_BYTES = 65536;
constexpr int MISC_OFF = 131072 + 320, TAB_OFF = 131072 + 1024;
constexpr int CW_PANEL = 8192;
constexpr size_t WS_XCH = 60 * MiB;
#define XB_TMO      128
#define XB_XCNT(j)  (256  + 64 * (j))
#define XB_XSUB(j)  (1280 + 64 * (j))
#define XB_XGEN(j)  (2304 + 64 * (j))
#define XB_TOP      3328
#define XB_TOPGEN   3392
#define XCD_BAR_WORDS 3456
#define XB_SPIN_CAP (1u << 18)

__device__ __forceinline__ unsigned xb_ld(unsigned* p)              { return __hip_atomic_load(p, __ATOMIC_RELAXED, __HIP_MEMORY_SCOPE_AGENT); }
__device__ __forceinline__ unsigned xb_add(unsigned* p, unsigned v) { return __hip_atomic_fetch_add(p, v, __ATOMIC_RELAXED, __HIP_MEMORY_SCOPE_AGENT); }
__device__ __forceinline__ unsigned xb_xcc_id() { return (unsigned)__builtin_amdgcn_s_getreg((3 << 11) | 20) & 0xFu; }
#define XB_SPIN(cond, bar) do { unsigned _sp = 0; while (cond) { __builtin_amdgcn_s_sleep(1); \
    if ((++_sp & 255u) == 0u) { if (xb_ld(&(bar)[XB_TMO])) break; if (_sp > XB_SPIN_CAP) { atomicAdd(&(bar)[XB_TMO], 1u); break; } } } } while (0)

struct XcdBarrier {
    unsigned* bar; unsigned x;
    volatile LAS unsigned* st;
};

__device__ __forceinline__ XcdBarrier xcd_barrier_post(unsigned* bar, volatile LAS unsigned* st) {
    XcdBarrier b; b.bar = bar; b.x = xb_xcc_id(); b.st = st;
    if (threadIdx.x == 0) (void)xb_add(&bar[XB_XCNT(b.x)], 1u);
    return b;
}
__device__ __forceinline__ void xcd_barrier_complete(unsigned* bar, unsigned x, unsigned& nloc, unsigned& nx) {
    const unsigned G = gridDim.x * gridDim.y * gridDim.z;
    unsigned sum, cnt, mine, sp = 0u;
    for (;;) {
        sum = 0u; cnt = 0u; mine = 0u;
#pragma unroll
        for (unsigned j = 0; j < 16; ++j) { const unsigned c = xb_ld(&bar[XB_XCNT(j)]); sum += c; cnt += (c > 0u) ? 1u : 0u; mine = (j == x) ? c : mine; }
        if (sum == G) break;
        __builtin_amdgcn_s_sleep(1);
        if ((++sp & 255u) == 0u) { if (xb_ld(&bar[XB_TMO])) break; if (sp > XB_SPIN_CAP) { atomicAdd(&bar[XB_TMO], 1u); break; } }
    }
    nloc = mine > 0u ? mine : 1u; nx = cnt > 0u ? cnt : 1u;
}

__device__ __forceinline__ void xcd_barrier(const XcdBarrier& b) {
    asm volatile("s_waitcnt vmcnt(0)" ::: "memory");
    __syncthreads();
    if (threadIdx.x == 0) {
        unsigned* bar = b.bar;
        __builtin_amdgcn_s_waitcnt(0);
        unsigned nloc = b.st[0], nx = b.st[1];
        if (nloc == 0u) { xcd_barrier_complete(bar, b.x, nloc, nx); b.st[0] = nloc; b.st[1] = nx; }
        const unsigned old = xb_add(&bar[XB_XSUB(b.x)], 1u);
        const unsigned gen = old / nloc;
        if (old + 1u == (gen + 1u) * nloc) {
            __builtin_amdgcn_fence(__ATOMIC_RELEASE, "agent");
            asm volatile("s_waitcnt vmcnt(0)" ::: "memory");
            const unsigned og = xb_add(&bar[XB_TOP], 1u);
            const unsigned tg = og / nx;
            if (og + 1u == (tg + 1u) * nx) xb_add(&bar[XB_TOPGEN], 1u);
            else XB_SPIN(xb_ld(&bar[XB_TOPGEN]) == tg, bar);
            __builtin_amdgcn_fence(__ATOMIC_ACQUIRE, "agent");
            xb_add(&bar[XB_XGEN(b.x)], 1u);
            asm volatile("s_waitcnt vmcnt(0)" ::: "memory");
        } else {
            XB_SPIN(xb_ld(&bar[XB_XGEN(b.x)]) == gen, bar);
            __builtin_amdgcn_fence(__ATOMIC_ACQUIRE, "agent");
            asm volatile("s_waitcnt vmcnt(0)" ::: "memory");
        }
    }
    __syncthreads();
}

constexpr int LDS_BYTES = 147456;
constexpr size_t WS_SS3 = 58 * MiB;
__device__ __forceinline__ void final_norm_ss(float* X, const float* ss, const float* g, int gw, int ngw, int lane) {
    for (int m = gw; m < M; m += ngw) {
        const float rstd = pg8::rstd_ss(ss, m);
        f32x4* xr = (f32x4*)(X + (size_t)m * DM) + lane;
#pragma unroll
        for (int j = 0; j < 4; ++j) { const f32x4 gg = ((const f32x4*)g)[lane + 64 * j]; xr[64 * j] = xr[64 * j] * rstd * gg; }
    }
}
constexpr int N_PHASES = 10;
__global__ void __launch_bounds__(NTHR, 2) fwd_kernel(Params p) {
    extern __shared__ __attribute__((aligned(16))) unsigned char lds_raw[];
    LAS unsigned char* lds = (LAS unsigned char*)lds_raw;
    for (int u = threadIdx.x; u < 64; u += NTHR) ((LAS unsigned*)(lds + MISC_OFF))[u] = 0u;
    __syncthreads();
    XcdBarrier bar = xcd_barrier_post((unsigned*)(p.ws + WS_CTL) + CW_BAR, (volatile LAS unsigned*)(lds + MISC_OFF) + 8);
    const int tid = threadIdx.x, wave = __builtin_amdgcn_readfirstlane(tid >> 6), lane = tid & 63, bid = blockIdx.x, nblk = gridDim.x;
    const int gw = bid * NWAVES + wave, ngw = nblk * NWAVES;
    const int vcu = (nblk % 8 == 0) ? (bid % 8) * (nblk / 8) + bid / 8 : bid;
    unsigned char* ws = p.ws;
    const int lo = p.ph_lo, hi = p.ph_hi;
    typedef pg8::bf16_t b16;
    TS(p, 0);
#if PROBE_TS
    if (bid == 0 && tid == 0) g_probe_ws = p.ws;
#endif
#define IN(k) (lo <= (k) && (k) < hi)
#define SEAM(k) do { if (IN(k) && IN((k) + 1) && !((k) == 8 && nblk == 256)) xcd_barrier(bar); TS(p, (k) + 1); } while (0)
#ifndef PROBE_REP
#define PROBE_REP -1
#endif
#define REPS(k) for (int rep_ = 0; rep_ < ((k) == PROBE_REP ? 2 : 1); ++rep_, ((k) == PROBE_REP && rep_ < 2 ? xcd_barrier(bar) : (void)0))
    if (IN(0)) REPS(0) { p0_prologue(p, lds, bid, nblk, tid); TS(p, 23); } SEAM(0);
    if (IN(1)) REPS(1) {
        pg8::Gemm g{(const b16*)(ws + WS_XN), (const b16*)(ws + WS_WIN), (const b16*)(ws + WS_MEMN), (const b16*)(ws + WS_WCKV), DM};
        pg8::TwoOrder S; S.init(M, NP, nblk, bid); S.n2M = MM / 256; S.n2N = 2048 / 256;
        pg8::EpiProj E{(b16*)(ws + WS_PROJ), (b16*)(ws + WS_KVM), (const float*)(ws + WS_ROPE)};
        pg8::gemm_phase<pg8::EpiProj, pg8::TwoOrder, true, true>(lds, g, S, E);
    } SEAM(1);
    if (IN(2)) REPS(2) { attn_phase(p, (char*)lds_raw, vcu, nblk);
#ifdef FA_NO_SWA
        swa_naive(p, bid, nblk, tid);
#endif
#ifdef FA_NO_DIFF
        diff_naive(p, bid, nblk, tid); xcd_barrier(bar); diff_combine_naive(p, gw, ngw, lane);
#endif
    } SEAM(2);
    if (IN(3)) REPS(3) {
        pg8::Gemm g{(const b16*)(ws + WS_ATT), (const b16*)(ws + WS_WOUT), nullptr, nullptr, DM};
        pg8::StaticOrder S; S.init(M, DM, nblk, bid);
        pg8::EpiResB<true> E{p.x, nullptr, (b16*)(ws + WS_XN), (float*)(ws + WS_SS1)};
        pg8::gemm_phase<pg8::EpiResB<true>, pg8::StaticOrder, true, true>(lds, g, S, E);
    } SEAM(3);
    if (IN(4)) REPS(4) {
        pg8::Gemm g{(const b16*)(ws + WS_XN), (const b16*)(ws + WS_WCQ), nullptr, nullptr, DM};
        pg8::StaticOrder S; S.init(M, DM, nblk, bid);
        pg8::EpiScaleBf16<0> E{(b16*)(ws + WS_QC), DM, (const float*)(ws + WS_SS1), CQ};
        pg8::gemm_phase<pg8::EpiScaleBf16<0>, pg8::StaticOrder, true, true>(lds, g, S, E);
    } SEAM(4);
    if (IN(5)) REPS(5) { cross_phase(p, (char*)lds_raw, lds, vcu, nblk); } SEAM(5);
    if (IN(6)) REPS(6) {
        pg8::Gemm g{(const b16*)(ws + WS_OC), (const b16*)(ws + WS_WCO), nullptr, nullptr, DM};
        pg8::StaticOrder S; S.init(M, DM, nblk, bid);
        pg8::EpiResB<false> E{nullptr, (const b16*)(ws + WS_XN), (b16*)(ws + WS_XN), (float*)(ws + WS_SS2)};
        pg8::gemm_phase<pg8::EpiResB<false>, pg8::StaticOrder, true, true>(lds, g, S, E);
    } SEAM(6);
    if (IN(7)) REPS(7) {
        pg8::Gemm g{(const b16*)(ws + WS_XN), (const b16*)(ws + WS_WUP), nullptr, nullptr, DM};
        pg8::StaticOrder S; S.init(M, FF, nblk, bid);
        pg8::EpiScaleBf16<1> E{(b16*)(ws + WS_ACT), FF, (const float*)(ws + WS_SS2), 1.f};
        pg8::gemm_phase<pg8::EpiScaleBf16<1>, pg8::StaticOrder, true, true>(lds, g, S, E);
    } SEAM(7);
    if (IN(8)) REPS(8) {
        pg8::Gemm g{(const b16*)(ws + WS_ACT), (const b16*)(ws + WS_WDOWN), nullptr, nullptr, FF};
        pg8::StaticOrder S; S.init(M, DM, nblk, bid);
        if (nblk == 256) {
            pg8::EpiFinal E{(const b16*)(ws + WS_XN), p.out, p.g_final, (unsigned*)(ws + WS_XCH), (unsigned*)(ws + WS_CTL) + CW_PANEL, lds + TAB_OFF};
            pg8::gemm_phase<pg8::EpiFinal, pg8::StaticOrder, true, true>(lds, g, S, E);
        } else {
            pg8::EpiResF E{(const b16*)(ws + WS_XN), p.out, (float*)(ws + WS_SS3)};
            pg8::gemm_phase<pg8::EpiResF, pg8::StaticOrder, true, true>(lds, g, S, E);
        }
    } SEAM(8);
    if (IN(9) && nblk != 256) REPS(9) { final_norm_ss(p.out, (const float*)(ws + WS_SS3), p.g_final, gw, ngw, lane); }
#if PROBE_TS
    if (bid == 0 && tid == 0) { volatile unsigned long long* ts = (volatile unsigned long long*)(p.ws + 1024); const unsigned long long d = ts[PROBE_TS_B] - ts[PROBE_TS_A], t0 = __builtin_amdgcn_s_memrealtime();
        while (__builtin_amdgcn_s_memrealtime() - t0 < 16ull * d) __builtin_amdgcn_s_sleep(8); }
#endif
#undef IN
#undef SEAM
}

extern "C" void kernel_launch(void* const* d_in, const int* in_sizes, int n_in, void* d_out, int out_size, void* d_ws, size_t ws_size, hipStream_t stream) {
    static int grid = 0;
    if (grid == 0) {
        if (n_in != 21 || out_size != M * DM || ws_size < WS_END) { fprintf(stderr, "kernel_launch: unexpected shapes (n_in %d out %d ws %zu)\n", n_in, out_size, ws_size); grid = -1; return; }
        int dev = 0, cus = 0, per_cu = 0;
        (void)hipGetDevice(&dev); (void)hipDeviceGetAttribute(&cus, hipDeviceAttributeMultiprocessorCount, dev);
        if (hipFuncSetAttribute((const void*)fwd_kernel, hipFuncAttributeMaxDynamicSharedMemorySize, LDS_BYTES) != hipSuccess) { fprintf(stderr, "kernel_launch: hipFuncSetAttribute failed\n"); grid = -1; return; }
        (void)hipOccupancyMaxActiveBlocksPerMultiprocessor(&per_cu, (const void*)fwd_kernel, NTHR, LDS_BYTES);
        if (per_cu < 1) { fprintf(stderr, "kernel_launch: occupancy query says %d blocks per CU\n", per_cu); per_cu = 1; }
        grid = cus;
    }
    if (grid < 0) return;
    Params p{};
    p.x = (const float*)d_in[0]; p.mem = (const float*)d_in[1]; p.pos = (const int*)d_in[2]; p.g_mix = (const float*)d_in[3]; p.w_in = (const float*)d_in[4];
    p.sinks = (const float*)d_in[5]; p.lq1 = (const float*)d_in[6]; p.lk1 = (const float*)d_in[7]; p.lq2 = (const float*)d_in[8]; p.lk2 = (const float*)d_in[9];
    p.g_diff = (const float*)d_in[10]; p.w_out = (const float*)d_in[11]; p.g_cross = (const float*)d_in[12]; p.g_mem = (const float*)d_in[13]; p.w_cq = (const float*)d_in[14];
    p.w_ckv = (const float*)d_in[15]; p.w_co = (const float*)d_in[16]; p.g_mlp = (const float*)d_in[17]; p.w_up = (const float*)d_in[18]; p.w_down = (const float*)d_in[19]; p.g_final = (const float*)d_in[20];
    p.out = (float*)d_out; p.ws = (unsigned char*)d_ws;
    if (hipMemsetAsync((char*)d_ws + WS_CTL, 0, CTL_ZERO_BYTES, stream) != hipSuccess) { fprintf(stderr, "kernel_launch: hipMemsetAsync of the control words failed\n"); return; }
    p.ph_lo = 0; p.ph_hi = N_PHASES;
    hipLaunchKernelGGL(fwd_kernel, dim3(grid), dim3(NTHR), LDS_BYTES, stream, p);
}
```

```cpp
#include <hip/hip_runtime.h>
#include <hip/hip_cooperative_groups.h>
#include <cstdio>
#include <cstdint>
namespace cg = cooperative_groups;

#ifndef MK_ONE_LAUNCH
#define MK_ONE_LAUNCH 1
#endif
#ifndef FA_VARIANT
#endif

#define LAS __attribute__((address_space(3)))
typedef unsigned short bf16;
typedef short bf16x8 __attribute__((ext_vector_type(8)));
typedef float f32x4 __attribute__((ext_vector_type(4)));
typedef unsigned u32x4 __attribute__((ext_vector_type(4)));
typedef unsigned u32x2 __attribute__((ext_vector_type(2)));

constexpr int BATCH = 8, SEQ = 4096, M = BATCH * SEQ, DM = 1024, NP = 2304, MEML = 256, MM = BATCH * MEML, FF = 4096;
constexpr int NWAVES = 8, NTHR = NWAVES * 64;
constexpr float EPS = 1e-5f;
constexpr float LOG2E = 1.4426950408889634f;
constexpr float C2 = 0.125f * LOG2E;
constexpr float CQ = 0.0625f * LOG2E;
constexpr int C_QA = 0, C_KA = 512, C_VA = 640, C_QD = 768, C_KD = 1280, C_VD = 1792;

constexpr size_t MiB = 1u << 20;
constexpr size_t WS_CTL = 0;
constexpr size_t WS_WIN = 2 * MiB;
constexpr size_t WS_WOUT = WS_WIN + (size_t)NP * DM * 2;
constexpr size_t WS_WCQ = WS_WOUT + 2 * MiB;
constexpr size_t WS_WCKV = WS_WCQ + 2 * MiB;
constexpr size_t WS_WCO = WS_WCKV + 4 * MiB;
constexpr size_t WS_WUP = WS_WCO + 2 * MiB;
constexpr size_t WS_WDOWN = WS_WUP + 8 * MiB;
constexpr size_t WS_ROPE = 34 * MiB;
constexpr size_t WS_KVM = 42 * MiB;
constexpr size_t WS_MEMN = 50 * MiB;
constexpr size_t WS_SS1 = 54 * MiB, WS_SS2 = 56 * MiB;
constexpr size_t WS_XN = 64 * MiB;
constexpr size_t WS_ODIFF = 128 * MiB;
constexpr size_t WS_PROJ = 256 * MiB;
constexpr size_t WS_ATT = 400 * MiB;
constexpr size_t WS_QC = 256 * MiB;
constexpr size_t WS_OC = 320 * MiB;
constexpr size_t WS_ACT = 256 * MiB;
constexpr size_t WS_END = 512 * MiB;
static_assert(WS_WDOWN + 8 * MiB <= WS_ROPE, "weights fit");

struct Params {
    const float *x, *mem; const int* pos;
    const float *g_mix, *w_in, *sinks, *lq1, *lk1, *lq2, *lk2, *g_diff, *w_out, *g_cross, *g_mem, *w_cq, *w_ckv, *w_co, *g_mlp, *w_up, *w_down, *g_final;
    float* out; unsigned char* ws; int ph_lo, ph_hi;
};

#ifndef PROBE_TS
#define PROBE_TS 0
#endif
#if PROBE_TS
#define TS(p_, i_) do { if (blockIdx.x == 0 && threadIdx.x == 0) ((volatile unsigned long long*)((p_).ws + 1024))[(i_)] = __builtin_amdgcn_s_memrealtime(); } while (0)
#else
#define TS(p_, i_) do { } while (0)
#endif
__device__ __forceinline__ unsigned f2bf(float f) { unsigned u = __builtin_bit_cast(unsigned, f); return (u + 0x7fffu + ((u >> 16) & 1u)) >> 16; }
__device__ __forceinline__ unsigned pk2(float lo, float hi) { return f2bf(lo) | (f2bf(hi) << 16); }
__device__ __forceinline__ float bf2f(unsigned h) { return __builtin_bit_cast(float, h << 16); }
__device__ __forceinline__ float bflo(unsigned w) { return __builtin_bit_cast(float, w << 16); }
__device__ __forceinline__ float bfhi(unsigned w) { return __builtin_bit_cast(float, w & 0xffff0000u); }
__device__ __forceinline__ float wave_sum(float v) {
#pragma unroll
    for (int o = 1; o < 64; o <<= 1) v += __shfl_xor(v, o);
    return v;
}
__device__ __forceinline__ float wave_max(float v) {
#pragma unroll
    for (int o = 1; o < 64; o <<= 1) v = fmaxf(v, __shfl_xor(v, o));
    return v;
}
__host__ __device__ __forceinline__ bool col_roped(int n) { return n < C_VA || (n >= C_QD && n < C_VD); }
__host__ __device__ __forceinline__ int phys_of_logical(int nl) {
    if (!col_roped(nl)) return nl;
    const int g = nl & ~63, j = nl & 63; return g + ((j & 31) << 1) + (j >> 5);
}
__device__ __forceinline__ float calc_lambda(const Params& p) {
    float a = 0.f, b = 0.f;
    for (int i = 0; i < 64; ++i) { a += p.lq1[i] * p.lk1[i]; b += p.lq2[i] * p.lk2[i]; }
    return __expf(a) - __expf(b) + 0.2f;
}

__device__ const double INV_FREQ[32] = {
    1.0, 0.7498942093324559, 0.5623413251903491, 0.4216965034285822,
    0.31622776601683794, 0.23713737056616552, 0.1778279410038923, 0.1333521432163324,
    0.1, 0.07498942093324558, 0.05623413251903491, 0.042169650342858224,
    0.03162277660168379, 0.023713737056616554, 0.01778279410038923, 0.01333521432163324,
    0.01, 0.007498942093324558, 0.005623413251903491, 0.004216965034285823,
    0.0031622776601683794, 0.0023713737056616554, 0.0017782794100389228, 0.001333521432163324,
    0.001, 0.0007498942093324559, 0.0005623413251903491, 0.00042169650342858224,
    0.00031622776601683794, 0.00023713737056616554, 0.00017782794100389227, 0.0001333521432163324};

__device__ __forceinline__ void sincos_d(double a, float& c, float& s) {
    const double kd = rint(a * 0.63661977236758134308);
    const int k = (int)kd;
    double r = fma(-kd, 1.57079632679489655800e+00, a); r = fma(-kd, 6.12323399573676603587e-17, r);
    const double r2 = r * r;
    const double sp = r * (1.0 + r2 * (-1.0 / 6.0 + r2 * (1.0 / 120.0 + r2 * (-1.0 / 5040.0 + r2 * (1.0 / 362880.0 + r2 * (-1.0 / 39916800.0 + r2 * (1.0 / 6227020800.0)))))));
    const double cp = 1.0 + r2 * (-0.5 + r2 * (1.0 / 24.0 + r2 * (-1.0 / 720.0 + r2 * (1.0 / 40320.0 + r2 * (-1.0 / 3628800.0 + r2 * (1.0 / 479001600.0 + r2 * (-1.0 / 87178291200.0)))))));
    const int q = k & 3;
    const double ss = (q == 0) ? sp : (q == 1) ? cp : (q == 2) ? -sp : -cp;
    const double cc = (q == 0) ? cp : (q == 1) ? -sp : (q == 2) ? -cp : sp;
    c = (float)cc; s = (float)ss;
}

template <bool HASG, bool PERMC>
__device__ __forceinline__ void transpose_item(const float* W, int K, int N, const float* g, bf16* WT, LAS float* scr, int item, int lane) {
    const int nblk = N / 32, kb = item / nblk, nb = item % nblk, k0 = 64 * kb, n0 = 32 * nb;
#pragma unroll 16
    for (int i = 0; i < 32; ++i) { const int kk = 2 * i + (lane >> 5); float v = W[(size_t)(k0 + kk) * N + n0 + (lane & 31)]; if (HASG) v *= g[k0 + kk]; scr[kk * 33 + (lane & 31)] = v; }
    asm volatile("s_waitcnt lgkmcnt(0)" ::: "memory");
    const int c = lane & 7;
#pragma unroll
    for (int j = 0; j < 4; ++j) { const int n = (lane >> 3) + 8 * j; const LAS float* s = scr + (8 * c) * 33 + n;
        u32x4 o; o.x = pk2(s[0 * 33], s[1 * 33]); o.y = pk2(s[2 * 33], s[3 * 33]); o.z = pk2(s[4 * 33], s[5 * 33]); o.w = pk2(s[6 * 33], s[7 * 33]);
        const int nl = n0 + n, np = PERMC ? phys_of_logical(nl) : nl;
        *(u32x4*)(WT + (size_t)np * K + k0 + 8 * c) = o; }
    asm volatile("s_waitcnt lgkmcnt(0)" ::: "memory");
}
__device__ __forceinline__ void rms_row_to_bf16(const float* xrow, const float* g, bf16* orow, int lane) {
    const f32x4* xr = (const f32x4*)xrow + lane;
    f32x4 v[4]; float s = 0.f;
#pragma unroll
    for (int j = 0; j < 4; ++j) { v[j] = xr[64 * j]; s += (v[j].x * v[j].x + v[j].y * v[j].y) + (v[j].z * v[j].z + v[j].w * v[j].w); }
    const float rstd = 1.0f / sqrtf(wave_sum(s) * (1.f / DM) + EPS);
    u32x2* o8 = (u32x2*)orow + lane;
#pragma unroll
    for (int j = 0; j < 4; ++j) {
        f32x4 gg = (f32x4){1.f, 1.f, 1.f, 1.f}; if (g) gg = ((const f32x4*)g)[lane + 64 * j];
        u32x2 w; w.x = pk2(v[j].x * rstd * gg.x, v[j].y * rstd * gg.y); w.y = pk2(v[j].z * rstd * gg.z, v[j].w * rstd * gg.w); o8[64 * j] = w; }
}
__device__ __forceinline__ void p0_prologue(const Params& p, LAS unsigned char* lds, int bid, int nblk, int tid) {
    const int wave = tid >> 6, lane = tid & 63;
    LAS float* scr = (LAS float*)(lds + wave * 8704);
    const int gw = bid * NWAVES + wave, NGW = nblk * NWAVES;
    unsigned char* ws = p.ws;
    constexpr int I_IN = (DM / 64) * (NP / 32), I_SQ = (DM / 64) * (DM / 32), I_KV = (DM / 64) * (2048 / 32), I_UP = (DM / 64) * (FF / 32), I_DN = (FF / 64) * (DM / 32);
    constexpr int NITEMS = I_IN + 3 * I_SQ + I_KV + I_UP + I_DN;
#ifndef PROBE_P0
#define PROBE_P0 0
#endif
    for (int rp_ = 0; rp_ < (PROBE_P0 == 1 ? 2 : 1); ++rp_)
    for (int it = gw; it < NITEMS; it += NGW) {
        int r = it;
        if (r < I_IN) { transpose_item<true, true>(p.w_in, DM, NP, p.g_mix, (bf16*)(ws + WS_WIN), scr, r, lane); continue; } r -= I_IN;
        if (r < I_SQ) { transpose_item<false, false>(p.w_out, DM, DM, nullptr, (bf16*)(ws + WS_WOUT), scr, r, lane); continue; } r -= I_SQ;
        if (r < I_SQ) { transpose_item<true, false>(p.w_cq, DM, DM, p.g_cross, (bf16*)(ws + WS_WCQ), scr, r, lane); continue; } r -= I_SQ;
        if (r < I_KV) { transpose_item<false, false>(p.w_ckv, DM, 2048, nullptr, (bf16*)(ws + WS_WCKV), scr, r, lane); continue; } r -= I_KV;
        if (r < I_SQ) { transpose_item<false, false>(p.w_co, DM, DM, nullptr, (bf16*)(ws + WS_WCO), scr, r, lane); continue; } r -= I_SQ;
        if (r < I_UP) { transpose_item<true, false>(p.w_up, DM, FF, p.g_mlp, (bf16*)(ws + WS_WUP), scr, r, lane); continue; } r -= I_UP;
        transpose_item<false, false>(p.w_down, FF, DM, nullptr, (bf16*)(ws + WS_WDOWN), scr, r, lane);
    }
    TS(p, 20);
    for (int rp_ = 0; rp_ < (PROBE_P0 == 2 ? 2 : 1); ++rp_)
    for (int m = gw * 2; m < M; m += NGW * 2) {
        const f32x4* x0 = (const f32x4*)(p.x + (size_t)m * DM) + lane; const f32x4* x1 = x0 + DM / 4;
        f32x4 v0[4], v1[4]; float s0 = 0.f, s1 = 0.f;
#pragma unroll
        for (int j = 0; j < 4; ++j) { v0[j] = x0[64 * j]; v1[j] = x1[64 * j]; }
#pragma unroll
        for (int j = 0; j < 4; ++j) { s0 += (v0[j].x * v0[j].x + v0[j].y * v0[j].y) + (v0[j].z * v0[j].z + v0[j].w * v0[j].w); s1 += (v1[j].x * v1[j].x + v1[j].y * v1[j].y) + (v1[j].z * v1[j].z + v1[j].w * v1[j].w); }
#pragma unroll
        for (int o = 1; o < 64; o <<= 1) { s0 += __shfl_xor(s0, o); s1 += __shfl_xor(s1, o); }
        const float r0 = 1.0f / sqrtf(s0 * (1.f / DM) + EPS), r1 = 1.0f / sqrtf(s1 * (1.f / DM) + EPS);
        u32x2* o0 = (u32x2*)((bf16*)(ws + WS_XN) + (size_t)m * DM) + lane; u32x2* o1 = o0 + DM / 4;
#pragma unroll
        for (int j = 0; j < 4; ++j) { u32x2 w; w.x = pk2(v0[j].x * r0, v0[j].y * r0); w.y = pk2(v0[j].z * r0, v0[j].w * r0); o0[64 * j] = w;
            u32x2 z; z.x = pk2(v1[j].x * r1, v1[j].y * r1); z.y = pk2(v1[j].z * r1, v1[j].w * r1); o1[64 * j] = z; }
    }
    TS(p, 21);
    for (int m = gw; m < MM; m += NGW) rms_row_to_bf16(p.mem + (size_t)m * DM, p.g_mem, (bf16*)(ws + WS_MEMN) + (size_t)m * DM, lane);
    TS(p, 22);
    float2* rope = (float2*)(ws + WS_ROPE);
    for (int rp_ = 0; rp_ < (PROBE_P0 == 3 ? 2 : 1); ++rp_)
    for (int i = bid * NTHR + tid; i < M * 32; i += nblk * NTHR) {
        const int row = i >> 5, d = i & 31; float c, s; sincos_d((double)p.pos[row] * INV_FREQ[d], c, s); rope[i] = make_float2(c, s); }
}

namespace pg8 {
#define PG8_LAS __attribute__((address_space(3)))
typedef unsigned short bf16_t;
typedef short bf16x8 __attribute__((ext_vector_type(8)));
typedef float f32x4 __attribute__((ext_vector_type(4)));
typedef unsigned u32x4 __attribute__((ext_vector_type(4)));
typedef unsigned u32x2 __attribute__((ext_vector_type(2)));
constexpr int BM = 256, BK = 64, HALF = 128, HTB = HALF * BK * 2  , STAGE_BYTES = 8 * HTB, NXCD = 8, WGM = 8;

__host__ __device__ __forceinline__ int lds_byte(int r, int c) { const int st = (r >> 4) * 2 + (c >> 5), rr = r & 15, cc = c & 31, ob = rr * 64 + cc * 2; return st * 1024 + (ob ^ (((ob >> 9) & 1) << 5)); }
__host__ __device__ __forceinline__ void stage_rc(int b, int& R, int& C) { const int st = b / 1024, sb = b % 1024, swz = sb ^ (((sb >> 9) & 1) << 5); R = (st >> 1) * 16 + swz / 64; C = (st & 1) * 32 + (swz % 64) / 2; }
__host__ __device__ __forceinline__ int perm32(int rho) { const int n = rho >> 4, i = rho & 15; return 8 * (i >> 2) + 4 * n + (i & 3); }

struct Unit { int pm, pn, alt; };
struct Gemm { const bf16_t* A; const bf16_t* Bt; const bf16_t* A2; const bf16_t* Bt2; int K; };

struct StaticOrder {
    int nM, nN, nwg, G, c;
    __host__ __device__ void init(int M_, int N_, int G_, int c_) { nM = M_ / BM; nN = N_ / BM; nwg = nM * nN; G = G_; c = c_; }
    __host__ __device__ bool map(long L, Unit& u) const {
        if (L >= nwg) return false;
        int wgid = (int)L; { const int q = nwg / NXCD, r = nwg % NXCD, xcd = wgid % NXCD, off = wgid / NXCD; wgid = (xcd < r ? xcd * (q + 1) : r * (q + 1) + (xcd - r) * q) + off; }
        const int nig = WGM * nN, gid = wgid / nig, fm = gid * WGM, gsz = (nM - fm) < WGM ? (nM - fm) : WGM;
        u.pm = fm + ((wgid % nig) % gsz); u.pn = (wgid % nig) / gsz; u.alt = 0; return true;
    }
    __host__ __device__ bool next(int i, Unit& u) const { return map((long)i * G + c, u); }
    __device__ __forceinline__ void a_ready(const Unit&) const {}
    __device__ __forceinline__ void done(const Unit&) const {}
};
struct TwoOrder : StaticOrder {
    int n2M, n2N;
    __host__ __device__ bool next(int i, Unit& u) const {
        const long L = (long)i * G + c;
        if (L < nwg) return map(L, u);
        const int r = (int)(L - nwg); if (r >= n2M * n2N) return false;
        u.pm = r % n2M; u.pn = r / n2M; u.alt = 1; return true;
    }
};
__device__ __forceinline__ unsigned cvt_pk_bf16(float lo, float hi) { unsigned r; asm volatile("v_cvt_pk_bf16_f32 %0, %1, %2" : "=v"(r) : "v"(lo), "v"(hi)); return r; }

__device__ __forceinline__ float rstd_ss(const float* ss, int row) {
    const f32x4* s4 = (const f32x4*)(ss + (size_t)row * 16); float t = 0.f;
#pragma unroll
    for (int i = 0; i < 4; ++i) { const f32x4 v = s4[i]; t += (v.x + v.y) + (v.z + v.w); }
    return 1.0f / sqrtf(t * (1.f / DM) + EPS);
}
struct EpiProj {
    static constexpr bool PERM = true, AFTER_DRAIN = false;
    bf16_t* proj; bf16_t* kvm; const float* rope;
    __device__ __forceinline__ void operator()(const f32x4 (&acc)[2][2][4][2], const Unit& u, int wr, int wc, int fr, int fq) const {
        const int row0 = u.pm * BM + wr * 64 + fr, col0 = u.pn * BM + wc * 32 + 8 * fq;
        if (u.alt) {
#pragma unroll
            for (int ai = 0; ai < 2; ++ai)
#pragma unroll
                for (int m = 0; m < 4; ++m) { bf16_t* rowp = kvm + (size_t)(row0 + ai * HALF + m * 16) * 2048 + col0;
#pragma unroll
                    for (int bj = 0; bj < 2; ++bj) { const f32x4 v0 = acc[ai][bj][m][0], v1 = acc[ai][bj][m][1];
                        u32x4 w; w.x = cvt_pk_bf16(v0[0], v0[1]); w.y = cvt_pk_bf16(v0[2], v0[3]); w.z = cvt_pk_bf16(v1[0], v1[1]); w.w = cvt_pk_bf16(v1[2], v1[3]);
                        *(u32x4*)(rowp + bj * HALF) = w; } }
            return;
        }
        const int d0 = ((wc & 1) * 32 + 8 * fq) >> 1;
#pragma unroll
        for (int ai = 0; ai < 2; ++ai) {
            f32x4 csa[4], csb[4];
#pragma unroll
            for (int m = 0; m < 4; ++m) { const size_t ro = (size_t)(row0 + ai * HALF + m * 16) * 64 + 2 * d0; csa[m] = *(const f32x4*)(rope + ro); csb[m] = *(const f32x4*)(rope + ro + 4); }
#pragma unroll
            for (int m = 0; m < 4; ++m) { const int row = row0 + ai * HALF + m * 16;
                const f32x4 cs0 = csa[m], cs1 = csb[m];
#pragma unroll
                for (int bj = 0; bj < 2; ++bj) { const int cb = u.pn * BM + bj * HALF;
                    const bool roped = col_roped(cb); const float sc = (cb < C_KA || (cb >= C_QD && cb < C_KD)) ? C2 : 1.f;
                    f32x4 v0 = acc[ai][bj][m][0], v1 = acc[ai][bj][m][1];
                    if (roped) {
                        const f32x4 a = v0, b = v1;
                        v0[0] = a[0] * cs0[0] - a[1] * cs0[1]; v0[1] = a[1] * cs0[0] + a[0] * cs0[1];
                        v0[2] = a[2] * cs0[2] - a[3] * cs0[3]; v0[3] = a[3] * cs0[2] + a[2] * cs0[3];
                        v1[0] = b[0] * cs1[0] - b[1] * cs1[1]; v1[1] = b[1] * cs1[0] + b[0] * cs1[1];
                        v1[2] = b[2] * cs1[2] - b[3] * cs1[3]; v1[3] = b[3] * cs1[2] + b[2] * cs1[3];
                    }
                    v0 = v0 * sc; v1 = v1 * sc;
                    u32x4 w; w.x = cvt_pk_bf16(v0[0], v0[1]); w.y = cvt_pk_bf16(v0[2], v0[3]); w.z = cvt_pk_bf16(v1[0], v1[1]); w.w = cvt_pk_bf16(v1[2], v1[3]);
                    *(u32x4*)(proj + (size_t)row * NP + col0 + bj * HALF) = w; } }
        }
    }
};
struct EpiRes {
    static constexpr bool PERM = false, AFTER_DRAIN = false;
    const float* xi; float* xo; bf16_t* xb; float* ss;
    __device__ __forceinline__ void operator()(const f32x4 (&acc)[2][2][4][2], const Unit& u, int wr, int wc, int fr, int fq) const {
        const int row0 = u.pm * BM + wr * 64 + fr, col0 = u.pn * BM + wc * 32 + 4 * fq;
#pragma unroll
        for (int ai = 0; ai < 2; ++ai)
#pragma unroll
            for (int m = 0; m < 4; ++m) { const int row = row0 + ai * HALF + m * 16; const size_t off = (size_t)row * DM + col0; float q = 0.f;
#pragma unroll
                for (int bj = 0; bj < 2; ++bj)
#pragma unroll
                    for (int n = 0; n < 2; ++n) { const size_t c = off + bj * HALF + n * 16; const f32x4 r = *(const f32x4*)(xi + c) + acc[ai][bj][m][n];
                        *(f32x4*)(xo + c) = r; q += (r[0] * r[0] + r[1] * r[1]) + (r[2] * r[2] + r[3] * r[3]);
                        if (xb) { u32x2 w; w.x = cvt_pk_bf16(r[0], r[1]); w.y = cvt_pk_bf16(r[2], r[3]); *(u32x2*)(xb + c) = w; } }
                q += __shfl_xor(q, 16); q += __shfl_xor(q, 32);
                if (fq == 0) ss[(size_t)row * 16 + u.pn * 4 + wc] = q;
                if (m & 1) asm volatile("" ::: "memory"); }
    }
};
template <bool XF> struct EpiResB {
    static constexpr bool PERM = true, AFTER_DRAIN = false;
    const float* xf; const bf16_t* xb_in; bf16_t* xb_out; float* ss;
    __device__ __forceinline__ void operator()(const f32x4 (&acc)[2][2][4][2], const Unit& u, int wr, int wc, int fr, int fq) const {
        const int row0 = u.pm * BM + wr * 64 + fr, col0 = u.pn * BM + wc * 32 + 8 * fq;
#pragma unroll
        for (int ai = 0; ai < 2; ++ai) {
            u32x4 pre[4][2];
            if (!XF) {
#pragma unroll
                for (int m = 0; m < 4; ++m)
#pragma unroll
                    for (int bj = 0; bj < 2; ++bj) pre[m][bj] = *(const u32x4*)(xb_in + (size_t)(row0 + ai * HALF + m * 16) * DM + col0 + bj * HALF); }
#pragma unroll
            for (int m = 0; m < 4; ++m) { const int row = row0 + ai * HALF + m * 16; const size_t off = (size_t)row * DM + col0; float q = 0.f;
#pragma unroll
                for (int bj = 0; bj < 2; ++bj) { f32x4 r0, r1;
                    if (XF) { r0 = *(const f32x4*)(xf + off + bj * HALF); r1 = *(const f32x4*)(xf + off + bj * HALF + 4); }
                    else { const u32x4 w = pre[m][bj];
                        r0 = (f32x4){__uint_as_float(w.x << 16), __uint_as_float(w.x & 0xffff0000u), __uint_as_float(w.y << 16), __uint_as_float(w.y & 0xffff0000u)};
                        r1 = (f32x4){__uint_as_float(w.z << 16), __uint_as_float(w.z & 0xffff0000u), __uint_as_float(w.w << 16), __uint_as_float(w.w & 0xffff0000u)}; }
                    r0 = r0 + acc[ai][bj][m][0]; r1 = r1 + acc[ai][bj][m][1];
                    q += ((r0[0] * r0[0] + r0[1] * r0[1]) + (r0[2] * r0[2] + r0[3] * r0[3])) + ((r1[0] * r1[0] + r1[1] * r1[1]) + (r1[2] * r1[2] + r1[3] * r1[3]));
                    u32x4 w; w.x = cvt_pk_bf16(r0[0], r0[1]); w.y = cvt_pk_bf16(r0[2], r0[3]); w.z = cvt_pk_bf16(r1[0], r1[1]); w.w = cvt_pk_bf16(r1[2], r1[3]);
                    *(u32x4*)(xb_out + off + bj * HALF) = w; }
                q += __shfl_xor(q, 16); q += __shfl_xor(q, 32);
                if (fq == 0) ss[(size_t)row * 16 + u.pn * 4 + wc] = q; }
            asm volatile("" ::: "memory");
        }
    }
};
struct EpiResF {
    static constexpr bool PERM = false, AFTER_DRAIN = false;
    const bf16_t* xb; float* xo; float* ss;
    __device__ __forceinline__ void operator()(const f32x4 (&acc)[2][2][4][2], const Unit& u, int wr, int wc, int fr, int fq) const {
        const int row0 = u.pm * BM + wr * 64 + fr, col0 = u.pn * BM + wc * 32 + 4 * fq;
#pragma unroll
        for (int ai = 0; ai < 2; ++ai)
#pragma unroll
            for (int m = 0; m < 4; ++m) { const int row = row0 + ai * HALF + m * 16; const size_t off = (size_t)row * DM + col0; float q = 0.f;
#pragma unroll
                for (int bj = 0; bj < 2; ++bj)
#pragma unroll
                    for (int n = 0; n < 2; ++n) { const size_t c = off + bj * HALF + n * 16; const u32x2 w = *(const u32x2*)(xb + c);
                        const f32x4 r = (f32x4){__uint_as_float(w.x << 16), __uint_as_float(w.x & 0xffff0000u), __uint_as_float(w.y << 16), __uint_as_float(w.y & 0xffff0000u)} + acc[ai][bj][m][n];
                        *(f32x4*)(xo + c) = r; q += (r[0] * r[0] + r[1] * r[1]) + (r[2] * r[2] + r[3] * r[3]); }
                q += __shfl_xor(q, 16); q += __shfl_xor(q, 32);
                if (fq == 0) ss[(size_t)row * 16 + u.pn * 4 + wc] = q;
                if (m & 1) asm volatile("" ::: "memory"); }
    }
};
struct EpiFinal {
    static constexpr bool PERM = false, AFTER_DRAIN = false;
    const bf16_t* xb; float* out; const float* g; unsigned* xbuf; unsigned* cnt; PG8_LAS unsigned char* tab;
    __device__ __forceinline__ void operator()(f32x4 (&acc)[2][2][4][2], const Unit& u, int wr, int wc, int fr, int fq) const {
        const int tid = threadIdx.x, lane = tid & 63, wid = __builtin_amdgcn_readfirstlane(tid >> 6);
        PG8_LAS float* P = (PG8_LAS float*)tab; PG8_LAS float* S = (PG8_LAS float*)(tab + 4096);
        const int col0 = u.pn * BM + wc * 32 + 4 * fq;
#pragma unroll
        for (int ai = 0; ai < 2; ++ai)
#pragma unroll
            for (int m = 0; m < 4; ++m) { const int rl = ai * HALF + wr * 64 + m * 16 + fr; const size_t off = (size_t)(u.pm * BM + rl) * DM + col0; float q = 0.f;
#pragma unroll
                for (int bj = 0; bj < 2; ++bj)
#pragma unroll
                    for (int n = 0; n < 2; ++n) { const u32x2 w = *(const u32x2*)(xb + off + bj * HALF + n * 16);
                        const f32x4 r = (f32x4){__uint_as_float(w.x << 16), __uint_as_float(w.x & 0xffff0000u), __uint_as_float(w.y << 16), __uint_as_float(w.y & 0xffff0000u)} + acc[ai][bj][m][n];
                        acc[ai][bj][m][n] = r; q += (r[0] * r[0] + r[1] * r[1]) + (r[2] * r[2] + r[3] * r[3]); }
                q += __shfl_xor(q, 16); q += __shfl_xor(q, 32);
                if (fq == 0) P[rl * 4 + wc] = q;
                if (m & 1) asm volatile("" ::: "memory"); }
        asm volatile("s_waitcnt lgkmcnt(0)" ::: "memory"); __builtin_amdgcn_s_barrier(); asm volatile("" ::: "memory");
        unsigned* slot = xbuf + ((size_t)(u.pm * BM + (tid & 255)) * 4);
        if (tid < 256) { const f32x4 a = *(const PG8_LAS f32x4*)(P + tid * 4);
            __hip_atomic_store(slot + u.pn, __float_as_uint((a[0] + a[1]) + (a[2] + a[3])), __ATOMIC_RELAXED, __HIP_MEMORY_SCOPE_AGENT); }
        asm volatile("s_waitcnt vmcnt(0)" ::: "memory");
        if (tid < 256 && lane == 0) __hip_atomic_fetch_add(cnt + 64 * u.pm, 1u, __ATOMIC_RELAXED, __HIP_MEMORY_SCOPE_AGENT);
        if (wid == 0) {
            unsigned sp = 0;
            while ((unsigned)__builtin_amdgcn_readfirstlane(__hip_atomic_load(cnt + 64 * u.pm, __ATOMIC_RELAXED, __HIP_MEMORY_SCOPE_AGENT)) < 16u) { __builtin_amdgcn_s_sleep(2); if (++sp > (1u << 22)) break; }
            __builtin_amdgcn_fence(__ATOMIC_ACQUIRE, "agent");
        }
        asm volatile("s_waitcnt vmcnt(0) lgkmcnt(0)" ::: "memory"); __builtin_amdgcn_s_barrier(); asm volatile("" ::: "memory");
        if (tid < 256) { float t = 0.f;
#pragma unroll
            for (int k = 0; k < 4; ++k) t += __uint_as_float(__hip_atomic_load(slot + k, __ATOMIC_RELAXED, __HIP_MEMORY_SCOPE_AGENT));
            S[tid] = 1.0f / sqrtf(t * (1.f / DM) + EPS); }
        asm volatile("s_waitcnt lgkmcnt(0)" ::: "memory"); __builtin_amdgcn_s_barrier(); asm volatile("" ::: "memory");
        f32x4 gg[2][2];
#pragma unroll
        for (int bj = 0; bj < 2; ++bj)
#pragma unroll
            for (int n = 0; n < 2; ++n) gg[bj][n] = *(const f32x4*)(g + col0 + bj * HALF + n * 16);
#pragma unroll
        for (int ai = 0; ai < 2; ++ai)
#pragma unroll
            for (int m = 0; m < 4; ++m) { const int rl = ai * HALF + wr * 64 + m * 16 + fr; const size_t off = (size_t)(u.pm * BM + rl) * DM + col0; const float rs = S[rl];
#pragma unroll
                for (int bj = 0; bj < 2; ++bj)
#pragma unroll
                    for (int n = 0; n < 2; ++n) *(f32x4*)(out + off + bj * HALF + n * 16) = acc[ai][bj][m][n] * rs * gg[bj][n]; }
    }
};
template <int ACT> struct EpiScaleBf16 {
    static constexpr bool PERM = true, AFTER_DRAIN = false;
    bf16_t* O; int ldc; const float* ss; float mul; PG8_LAS unsigned char* tab;
    __device__ __forceinline__ void operator()(const f32x4 (&acc)[2][2][4][2], const Unit& u, int wr, int wc, int fr, int fq) const {
        const int tid = threadIdx.x; PG8_LAS float* S = (PG8_LAS float*)tab;
        if (tid < 256) S[tid] = rstd_ss(ss, u.pm * BM + tid) * mul;
        asm volatile("s_waitcnt lgkmcnt(0)" ::: "memory"); __builtin_amdgcn_s_barrier(); asm volatile("" ::: "memory");
        const int rl0 = wr * 64 + fr, col0 = u.pn * BM + wc * 32 + 8 * fq;
#pragma unroll
        for (int ai = 0; ai < 2; ++ai)
#pragma unroll
            for (int m = 0; m < 4; ++m) { const int rl = rl0 + ai * HALF + m * 16; const float rs = S[rl]; bf16_t* rowp = O + (size_t)(u.pm * BM + rl) * ldc + col0;
#pragma unroll
                for (int bj = 0; bj < 2; ++bj) { f32x4 v0 = acc[ai][bj][m][0] * rs, v1 = acc[ai][bj][m][1] * rs;
                    if (ACT == 1) {
#pragma unroll
                        for (int e = 0; e < 4; ++e) { const float a = fmaxf(v0[e], 0.f), b = fmaxf(v1[e], 0.f); v0[e] = a * a; v1[e] = b * b; } }
                    u32x4 w; w.x = cvt_pk_bf16(v0[0], v0[1]); w.y = cvt_pk_bf16(v0[2], v0[3]); w.z = cvt_pk_bf16(v1[0], v1[1]); w.w = cvt_pk_bf16(v1[2], v1[3]);
                    *(u32x4*)(rowp + bj * HALF) = w; } }
        __builtin_amdgcn_s_barrier();
    }
};

template <class Epi, class Sched, bool ALIGN_EPI = false, bool SP2 = false>
__device__ __forceinline__ void gemm_phase(PG8_LAS unsigned char* lds, const Gemm g, const Sched& S, const Epi& E) {
    const int tid = threadIdx.x, wid = __builtin_amdgcn_readfirstlane(tid >> 6), lane = tid & 63, wr = wid >> 2, wc = wid & 3, fr = lane & 15, fq = lane >> 4;
    const int K = g.K, nt = K / BK;
    unsigned voffA[2], voffB[2];
#pragma unroll
    for (int i = 0; i < 2; ++i) { int R, C; stage_rc(tid * 16 + i * 8192, R, C); const int Rb = Epi::PERM ? ((R & ~31) + perm32(R & 31)) : R;
        voffA[i] = (unsigned)(R * K + C) * 2u; voffB[i] = (unsigned)(Rb * K + C) * 2u; }
    const size_t kstep = (size_t)(BK * 2);
    const size_t hstep = (size_t)HALF * K * 2;
    const size_t tstep = 2 * hstep;
    const unsigned ldsw = (unsigned)wid * 1024u;
    const int aoff = lds_byte(wr * 64 + fr, fq * 8), boff = lds_byte(wc * 32 + fr, fq * 8);
#define PG8_SA(b, h) (((b) * 2 + (h)) * HTB)
#define PG8_SB(b, h) ((4 + (b) * 2 + (h)) * HTB)
#define PG8_STAGE(bufoff, gbase, voff) do { _Pragma("unroll") for (int _i = 0; _i < 2; ++_i) \
        __builtin_amdgcn_global_load_lds((const unsigned*)((const char*)(gbase) + (voff)[_i]), (PG8_LAS unsigned*)(lds + (bufoff) + ldsw + _i * 8192), 16, 0, 0); } while (0)
#define PG8_LDA(dst, b, h) do { _Pragma("unroll") for (int m = 0; m < 4; ++m) _Pragma("unroll") for (int k = 0; k < 2; ++k) dst[m][k] = *(const PG8_LAS bf16x8*)(lds + PG8_SA(b, h) + aoff + m * 2048 + k * 1024); } while (0)
#define PG8_LDB(dst, b, h) do { _Pragma("unroll") for (int n = 0; n < 2; ++n) _Pragma("unroll") for (int k = 0; k < 2; ++k) dst[n][k] = *(const PG8_LAS bf16x8*)(lds + PG8_SB(b, h) + boff + n * 2048 + k * 1024); } while (0)
#define PG8_MMA(ai, bj, At, Bt) do { __builtin_amdgcn_s_setprio(1); _Pragma("unroll") for (int m = 0; m < 4; ++m) _Pragma("unroll") for (int n = 0; n < 2; ++n) _Pragma("unroll") for (int k = 0; k < 2; ++k) \
        acc[ai][bj][m][n] = __builtin_amdgcn_mfma_f32_16x16x32_bf16(Bt[n][k], At[m][k], acc[ai][bj][m][n], 0, 0, 0); __builtin_amdgcn_s_setprio(0); } while (0)
#define PG8_WAIT_V(n) asm volatile("s_waitcnt vmcnt(" #n ")" ::: "memory")
#define PG8_WAIT_L(n) asm volatile("s_waitcnt lgkmcnt(" #n ")" ::: "memory")
#define PG8_BAR __builtin_amdgcn_s_barrier()
#define PG8_SCHED __builtin_amdgcn_sched_barrier(0)
    Unit cur, nxt; int ui = 0;
    if (!S.next(0, cur)) return;
    f32x4 acc[2][2][4][2];
#pragma unroll
    for (int a = 0; a < 2; ++a)
#pragma unroll
        for (int b = 0; b < 2; ++b)
#pragma unroll
            for (int m = 0; m < 4; ++m)
#pragma unroll
                for (int n = 0; n < 2; ++n) acc[a][b][m][n] = (f32x4){0.f, 0.f, 0.f, 0.f};
    bf16x8 At[4][2], B0[2][2], B1[2][2];
    const char* cA = (const char*)(cur.alt ? g.A2 : g.A) + (size_t)cur.pm * tstep; const char* cB = (const char*)(cur.alt ? g.Bt2 : g.Bt) + (size_t)cur.pn * tstep;
    S.a_ready(cur);
    if constexpr (SP2) {
        PG8_STAGE(PG8_SB(0, 0), cB, voffB); PG8_STAGE(PG8_SB(0, 1), cB + hstep, voffB); PG8_STAGE(PG8_SA(0, 0), cA, voffA); PG8_STAGE(PG8_SA(0, 1), cA + hstep, voffA);
        if (wr == 1) PG8_BAR;
        PG8_WAIT_V(2); PG8_BAR;
        PG8_STAGE(PG8_SB(1, 0), cB + kstep, voffB); PG8_STAGE(PG8_SA(1, 0), cA + kstep, voffA); PG8_STAGE(PG8_SB(1, 1), cB + hstep + kstep, voffB);
        PG8_WAIT_V(6); PG8_BAR;
    } else {
        PG8_STAGE(PG8_SB(0, 0), cB, voffB); PG8_STAGE(PG8_SA(0, 0), cA, voffA); PG8_STAGE(PG8_SB(0, 1), cB + hstep, voffB); PG8_STAGE(PG8_SA(0, 1), cA + hstep, voffA);
        if (wr == 1) PG8_BAR;
        PG8_WAIT_V(4); PG8_BAR;
        PG8_STAGE(PG8_SB(1, 0), cB + kstep, voffB); PG8_STAGE(PG8_SA(1, 0), cA + kstep, voffA); PG8_STAGE(PG8_SB(1, 1), cB + hstep + kstep, voffB);
        PG8_WAIT_V(6); PG8_BAR;
    }
    for (;;) {
        const bool has_next = S.next(ui + 1, nxt);
        const char* nA = has_next ? (const char*)(nxt.alt ? g.A2 : g.A) + (size_t)nxt.pm * tstep : cA; const char* nB = has_next ? (const char*)(nxt.alt ? g.Bt2 : g.Bt) + (size_t)nxt.pn * tstep : cB;
        for (int t = 0; t < nt; t += 2) {
            const bool last = (t == nt - 2);
            const char* a1 = cA + (size_t)(t + 1) * kstep;
            const char* a2 = last ? nA : cA + (size_t)(t + 2) * kstep; const char* b2 = last ? nB : cB + (size_t)(t + 2) * kstep;
            const char* a3 = a2 + kstep; const char* b3 = b2 + kstep;
            if (last && has_next) S.a_ready(nxt);
            if constexpr (SP2) {
            PG8_LDB(B0, 0, 0); PG8_LDB(B1, 0, 1); PG8_SCHED; PG8_LDA(At, 0, 0); PG8_STAGE(PG8_SA(1, 1), a1 + hstep, voffA);
            PG8_WAIT_V(8); PG8_WAIT_L(0); PG8_BAR; PG8_MMA(0, 0, At, B0); PG8_MMA(0, 1, At, B1); PG8_BAR; PG8_SCHED;
            PG8_LDA(At, 0, 1); PG8_STAGE(PG8_SB(0, 0), b2, voffB); PG8_STAGE(PG8_SB(0, 1), b2 + hstep, voffB); PG8_STAGE(PG8_SA(0, 0), a2, voffA);
            PG8_WAIT_V(8); PG8_WAIT_L(0); PG8_BAR; PG8_MMA(1, 0, At, B0); PG8_MMA(1, 1, At, B1); PG8_BAR; PG8_SCHED;
            PG8_LDB(B0, 1, 0); PG8_LDB(B1, 1, 1); PG8_SCHED; PG8_LDA(At, 1, 0); PG8_STAGE(PG8_SA(0, 1), a2 + hstep, voffA);
            PG8_WAIT_V(8); PG8_WAIT_L(0); PG8_BAR; PG8_MMA(0, 0, At, B0); PG8_MMA(0, 1, At, B1); PG8_BAR; PG8_SCHED;
            PG8_LDA(At, 1, 1); PG8_STAGE(PG8_SB(1, 0), b3, voffB); PG8_STAGE(PG8_SB(1, 1), b3 + hstep, voffB); PG8_STAGE(PG8_SA(1, 0), a3, voffA);
            PG8_WAIT_V(8); PG8_WAIT_L(0); PG8_BAR; PG8_MMA(1, 0, At, B0); PG8_MMA(1, 1, At, B1); PG8_BAR; PG8_SCHED;
            } else {
            PG8_LDB(B0, 0, 0); PG8_SCHED; PG8_LDA(At, 0, 0); PG8_STAGE(PG8_SA(1, 1), a1 + hstep, voffA);
            PG8_WAIT_L(8); PG8_BAR; PG8_WAIT_L(0); PG8_MMA(0, 0, At, B0); PG8_BAR; PG8_SCHED;
            PG8_LDB(B1, 0, 1); PG8_STAGE(PG8_SB(0, 0), b2, voffB);
            PG8_BAR; PG8_WAIT_L(0); PG8_MMA(0, 1, At, B1); PG8_BAR;
            PG8_LDA(At, 0, 1); PG8_STAGE(PG8_SA(0, 0), a2, voffA);
            PG8_BAR; PG8_WAIT_L(0); PG8_MMA(1, 0, At, B0); PG8_BAR; PG8_SCHED;
            PG8_STAGE(PG8_SB(0, 1), b2 + hstep, voffB);
            PG8_WAIT_V(6); PG8_BAR; PG8_MMA(1, 1, At, B1); PG8_BAR;
            PG8_LDB(B0, 1, 0); PG8_SCHED; PG8_LDA(At, 1, 0); PG8_STAGE(PG8_SA(0, 1), a2 + hstep, voffA);
            PG8_WAIT_L(8); PG8_BAR; PG8_WAIT_L(0); PG8_MMA(0, 0, At, B0); PG8_BAR; PG8_SCHED;
            PG8_LDB(B1, 1, 1); PG8_STAGE(PG8_SB(1, 0), b3, voffB);
            PG8_BAR; PG8_WAIT_L(0); PG8_MMA(0, 1, At, B1); PG8_BAR;
            PG8_LDA(At, 1, 1); PG8_STAGE(PG8_SA(1, 0), a3, voffA);
            PG8_BAR; PG8_WAIT_L(0); PG8_MMA(1, 0, At, B0); PG8_BAR; PG8_SCHED;
            PG8_STAGE(PG8_SB(1, 1), b3 + hstep, voffB);
            PG8_WAIT_V(6); PG8_BAR; PG8_MMA(1, 1, At, B1); PG8_BAR;
            }
        }
        if constexpr (ALIGN_EPI) { if (wr == 0) PG8_BAR; }
        if constexpr (!Epi::AFTER_DRAIN) { E(acc, cur, wr, wc, fr, fq); S.done(cur); }
        if (!has_next) break;
#pragma unroll
        for (int a = 0; a < 2; ++a)
#pragma unroll
            for (int b = 0; b < 2; ++b)
#pragma unroll
                for (int m = 0; m < 4; ++m)
#pragma unroll
                    for (int n = 0; n < 2; ++n) acc[a][b][m][n] = (f32x4){0.f, 0.f, 0.f, 0.f};
        cur = nxt; cA = nA; cB = nB; ++ui;
        if constexpr (ALIGN_EPI) { if (wr == 1) PG8_BAR; }
    }
    PG8_WAIT_V(0);
    if constexpr (!ALIGN_EPI) { if (wr == 0) PG8_BAR; }
    PG8_BAR;
    if constexpr (Epi::AFTER_DRAIN) { E.fused(acc, cur, wr, wc, fr, fq, lds, wid, lane); S.done(cur); }
#undef PG8_SA
#undef PG8_SB
#undef PG8_STAGE
#undef PG8_LDA
#undef PG8_LDB
#undef PG8_MMA
#undef PG8_WAIT_V
#undef PG8_WAIT_L
#undef PG8_BAR
#undef PG8_SCHED
}
}
__device__ __forceinline__ void swa_naive(const Params& p, int bid, int nblk, int tid) {
    const bf16* proj = (const bf16*)(p.ws + WS_PROJ); bf16* att = (bf16*)(p.ws + WS_ATT);
    for (int base = bid * NTHR; base < M * 8; base += nblk * NTHR) {
        const int idx = base + tid, hq = idx >> 15, row = idx & (M - 1), t = row & (SEQ - 1), kvh = hq >> 2;
        float q[64], o[64];
        { const u32x4* q4 = (const u32x4*)(proj + (size_t)row * NP + C_QA + hq * 64);
#pragma unroll
          for (int i = 0; i < 8; ++i) { const u32x4 w = q4[i]; q[8 * i] = bflo(w.x); q[8 * i + 1] = bfhi(w.x); q[8 * i + 2] = bflo(w.y); q[8 * i + 3] = bfhi(w.y); q[8 * i + 4] = bflo(w.z); q[8 * i + 5] = bfhi(w.z); q[8 * i + 6] = bflo(w.w); q[8 * i + 7] = bfhi(w.w); } }
#pragma unroll
        for (int d = 0; d < 64; ++d) o[d] = 0.f;
        float m = p.sinks[hq] * LOG2E, l = 1.f;
        const int nk = (t < 127 ? t : 127) + 1;
        for (int j = 0; j < nk; ++j) {
            const size_t kr = (size_t)(row - j) * NP;
            const u32x4* k4 = (const u32x4*)(proj + kr + C_KA + kvh * 64); const u32x4* v4 = (const u32x4*)(proj + kr + C_VA + kvh * 64);
            float s = 0.f;
#pragma unroll
            for (int i = 0; i < 8; ++i) { const u32x4 w = k4[i]; s += q[8 * i] * bflo(w.x) + q[8 * i + 1] * bfhi(w.x) + q[8 * i + 2] * bflo(w.y) + q[8 * i + 3] * bfhi(w.y) + q[8 * i + 4] * bflo(w.z) + q[8 * i + 5] * bfhi(w.z) + q[8 * i + 6] * bflo(w.w) + q[8 * i + 7] * bfhi(w.w); }
            const float mn = fmaxf(m, s), a = exp2f(m - mn), pp = exp2f(s - mn); l = l * a + pp; m = mn;
#pragma unroll
            for (int i = 0; i < 8; ++i) { const u32x4 w = v4[i];
                o[8 * i] = o[8 * i] * a + pp * bflo(w.x); o[8 * i + 1] = o[8 * i + 1] * a + pp * bfhi(w.x); o[8 * i + 2] = o[8 * i + 2] * a + pp * bflo(w.y); o[8 * i + 3] = o[8 * i + 3] * a + pp * bfhi(w.y);
                o[8 * i + 4] = o[8 * i + 4] * a + pp * bflo(w.z); o[8 * i + 5] = o[8 * i + 5] * a + pp * bfhi(w.z); o[8 * i + 6] = o[8 * i + 6] * a + pp * bflo(w.w); o[8 * i + 7] = o[8 * i + 7] * a + pp * bfhi(w.w); }
        }
        const float rl = 1.f / l;
        u32x4* o4 = (u32x4*)(att + (size_t)row * DM + hq * 64);
#pragma unroll
        for (int i = 0; i < 8; ++i) { u32x4 w; w.x = pk2(o[8 * i] * rl, o[8 * i + 1] * rl); w.y = pk2(o[8 * i + 2] * rl, o[8 * i + 3] * rl); w.z = pk2(o[8 * i + 4] * rl, o[8 * i + 5] * rl); w.w = pk2(o[8 * i + 6] * rl, o[8 * i + 7] * rl); o4[i] = w; }
    }
}
__device__ __forceinline__ void diff_naive(const Params& p, int bid, int nblk, int tid) {
    const bf16* proj = (const bf16*)(p.ws + WS_PROJ); float* od = (float*)(p.ws + WS_ODIFF);
    for (int base = bid * NTHR; base < M * 16; base += nblk * NTHR) {
        const int idx = base + tid, sel = __builtin_amdgcn_readfirstlane(idx >> 15), row = idx & (M - 1), t = row & (SEQ - 1);
        const int hc = sel >> 1, half = sel & 1, h = hc >> 1, c = hc & 1;
        const int b = __builtin_amdgcn_readfirstlane(row >> 12);
        const int tmax = __builtin_amdgcn_readfirstlane((row | 63) & (SEQ - 1));
        float q[64], o[64];
        { const u32x4* q4 = (const u32x4*)(proj + (size_t)row * NP + C_QD + hc * 64);
#pragma unroll
          for (int i = 0; i < 8; ++i) { const u32x4 w = q4[i]; q[8 * i] = bflo(w.x); q[8 * i + 1] = bfhi(w.x); q[8 * i + 2] = bflo(w.y); q[8 * i + 3] = bfhi(w.y); q[8 * i + 4] = bflo(w.z); q[8 * i + 5] = bfhi(w.z); q[8 * i + 6] = bflo(w.w); q[8 * i + 7] = bfhi(w.w); } }
#pragma unroll
        for (int d = 0; d < 64; ++d) o[d] = 0.f;
        float m = -1e30f, l = 0.f;
        for (int kt = 0; kt <= tmax; ++kt) {
            const size_t kr = (size_t)(b * SEQ + kt) * NP;
            const u32x4* k4 = (const u32x4*)(proj + kr + C_KD + hc * 64); const u32x4* v4 = (const u32x4*)(proj + kr + C_VD + h * 128 + half * 64);
            float s = 0.f;
#pragma unroll
            for (int i = 0; i < 8; ++i) { const u32x4 w = k4[i]; s += q[8 * i] * bflo(w.x) + q[8 * i + 1] * bfhi(w.x) + q[8 * i + 2] * bflo(w.y) + q[8 * i + 3] * bfhi(w.y) + q[8 * i + 4] * bflo(w.z) + q[8 * i + 5] * bfhi(w.z) + q[8 * i + 6] * bflo(w.w) + q[8 * i + 7] * bfhi(w.w); }
            if (kt > t) s = -1e30f;
            const float mn = fmaxf(m, s), a = exp2f(m - mn), pp = (kt > t) ? 0.f : exp2f(s - mn); l = l * a + pp; m = mn;
#pragma unroll
            for (int i = 0; i < 8; ++i) { const u32x4 w = v4[i];
                o[8 * i] = o[8 * i] * a + pp * bflo(w.x); o[8 * i + 1] = o[8 * i + 1] * a + pp * bfhi(w.x); o[8 * i + 2] = o[8 * i + 2] * a + pp * bflo(w.y); o[8 * i + 3] = o[8 * i + 3] * a + pp * bfhi(w.y);
                o[8 * i + 4] = o[8 * i + 4] * a + pp * bflo(w.z); o[8 * i + 5] = o[8 * i + 5] * a + pp * bfhi(w.z); o[8 * i + 6] = o[8 * i + 6] * a + pp * bflo(w.w); o[8 * i + 7] = o[8 * i + 7] * a + pp * bfhi(w.w); }
        }
        const float rl = 1.f / l;
        f32x4* o4 = (f32x4*)(od + ((size_t)c * M + row) * 512 + h * 128 + half * 64);
#pragma unroll
        for (int i = 0; i < 16; ++i) o4[i] = (f32x4){o[4 * i] * rl, o[4 * i + 1] * rl, o[4 * i + 2] * rl, o[4 * i + 3] * rl};
    }
}
__device__ __forceinline__ void diff_combine_naive(const Params& p, int gw, int ngw, int lane) {
    const float* od = (const float*)(p.ws + WS_ODIFF); bf16* att = (bf16*)(p.ws + WS_ATT);
    const float lam = calc_lambda(p);
    for (int m = gw; m < M; m += ngw) {
#pragma unroll
        for (int h = 0; h < 4; ++h) {
            const float2 a = *(const float2*)(od + (size_t)m * 512 + h * 128 + 2 * lane), b = *(const float2*)(od + ((size_t)M + m) * 512 + h * 128 + 2 * lane);
            const float v0 = a.x - lam * b.x, v1 = a.y - lam * b.y;
            const float rstd = 1.0f / sqrtf(wave_sum(v0 * v0 + v1 * v1) * (1.f / 128.f) + EPS);
            const float2 g = *(const float2*)(p.g_diff + 2 * lane);
            *(unsigned*)(att + (size_t)m * DM + 512 + h * 128 + 2 * lane) = pk2(v0 * rstd * g.x * 0.8f, v1 * rstd * g.y * 0.8f);
        }
    }
}
__device__ __forceinline__ void cross_naive(const Params& p, LAS unsigned char* lds, int bid, int nblk, int tid) {
    const bf16* qc = (const bf16*)(p.ws + WS_QC); const bf16* kvm = (const bf16*)(p.ws + WS_KVM); bf16* oc = (bf16*)(p.ws + WS_OC);
    const int sub = tid >> 8, tm = tid & 255, w4 = (tid >> 6) & 3, lane = tid & 63;
    LAS float* qs = (LAS float*)lds + sub * 256; LAS float* ps = (LAS float*)lds + 512 + sub * 256; LAS float* red = (LAS float*)lds + 1024 + sub * 8;
    for (int i2 = bid; i2 < M * 2; i2 += nblk) {
        const int item = i2 * 2 + sub, row = item >> 2, head = item & 3, b = row >> 12;
        qs[tm] = bf2f(qc[(size_t)row * DM + head * 256 + tm]);
        __syncthreads();
        const u32x4* k4 = (const u32x4*)(kvm + (size_t)(b * MEML + tm) * 2048 + head * 256);
        float s = 0.f;
        for (int i = 0; i < 32; ++i) { const u32x4 w = k4[i]; const LAS float* qq = qs + 8 * i;
            s += qq[0] * bflo(w.x) + qq[1] * bfhi(w.x) + qq[2] * bflo(w.y) + qq[3] * bfhi(w.y) + qq[4] * bflo(w.z) + qq[5] * bfhi(w.z) + qq[6] * bflo(w.w) + qq[7] * bfhi(w.w); }
        float mx = wave_max(s); if (lane == 0) red[w4] = mx;
        __syncthreads();
        mx = fmaxf(fmaxf(red[0], red[1]), fmaxf(red[2], red[3]));
        const float e = exp2f(s - mx); ps[tm] = e;
        float sm = wave_sum(e); if (lane == 0) red[4 + w4] = sm;
        __syncthreads();
        sm = (red[4] + red[5]) + (red[6] + red[7]);
        const bf16* vp = kvm + (size_t)(b * MEML) * 2048 + 1024 + head * 256 + tm;
        float o = 0.f;
        for (int mm = 0; mm < MEML; ++mm) o += ps[mm] * bf2f(vp[(size_t)mm * 2048]);
        oc[(size_t)row * DM + head * 256 + tm] = (bf16)f2bf(o / sm);
        __syncthreads();
    }
}

#if PROBE_TS
#ifndef PROBE_WAVE
#define PROBE_WAVE 0
#endif
__device__ unsigned char* g_probe_ws;
#endif
namespace fa {
typedef short bf16x8 __attribute__((ext_vector_type(8)));
typedef short s16x4 __attribute__((ext_vector_type(4)));
typedef float f32x16 __attribute__((ext_vector_type(16)));
typedef float f32x4 __attribute__((ext_vector_type(4)));
typedef unsigned u32x4 __attribute__((ext_vector_type(4)));
constexpr int NW = 8, QBLK = 32, KVBLK = 64;
constexpr float THR = 8.f;
#define FA_SBAR() __builtin_amdgcn_sched_barrier(0)
#define FA_VMW() asm volatile("s_waitcnt vmcnt(0)" ::: "memory")
__device__ __forceinline__ int crow(int r, int hi) { return (r & 3) + 8 * (r >> 2) + 4 * hi; }
__device__ __forceinline__ unsigned cvtpk(float lo, float hi) { unsigned r; asm volatile("v_cvt_pk_bf16_f32 %0, %1, %2" : "=v"(r) : "v"(lo), "v"(hi)); return r; }

template <int NDQ> __device__ __forceinline__ int kswz(int row, int c) {
    if (NDQ == 4) return row * 128 + ((c ^ ((row >> 1) & 7)) << 4);
    else return row * (NDQ * 32) + ((c ^ (row & 15)) << 4);
}
template <int NDVT> __device__ __forceinline__ int v_st(int k, int c) { const int kk = (k & ~0xC) | ((k & 4) << 1) | ((k & 8) >> 1); return ((kk >> 3) * NDVT + (c >> 5)) * 512 + ((kk & 7) * 32 + (c & 31)) * 2; }
__device__ __forceinline__ int v_rd_base(int lane) { return ((lane & 3) << 3) | (((lane >> 2) & 3) << 6) | (((lane >> 4) & 1) << 5) | (((lane >> 5) & 1) << 8); }

__device__ __forceinline__ void mask_tile(f32x16& p0, f32x16& p1, int dq, unsigned W) {
    const float NEG = -__builtin_inff();
#pragma unroll
    for (int r = 0; r < 16; ++r) { const int c = (r & 3) + 8 * (r >> 2);
        if ((unsigned)(dq - c) >= W) p0[r] = NEG;
        if ((unsigned)(dq - c - 32) >= W) p1[r] = NEG; }
}
__device__ __forceinline__ void partialSM(f32x16& p0, f32x16& p1, float& m_reg, float& alpha) {
    float pmax = p0[0];
#pragma unroll
    for (int r = 1; r < 16; ++r) pmax = fmaxf(pmax, p0[r]);
#pragma unroll
    for (int r = 0; r < 16; ++r) pmax = fmaxf(pmax, p1[r]);
    { auto rr = __builtin_amdgcn_permlane32_swap(__float_as_uint(pmax), __float_as_uint(pmax), false, false); pmax = fmaxf(__uint_as_float(rr[0]), __uint_as_float(rr[1])); }
    float mn;
    if (__builtin_expect(__all((pmax - m_reg) <= THR), 1)) { mn = m_reg; alpha = 1.f; }
    else { mn = fmaxf(m_reg, pmax); alpha = __builtin_amdgcn_exp2f(m_reg - mn); m_reg = mn; }
#pragma unroll
    for (int r = 0; r < 16; ++r) p0[r] = p0[r] - mn;
#pragma unroll
    for (int r = 0; r < 16; ++r) p1[r] = p1[r] - mn;
#pragma unroll
    for (int r = 0; r < 16; ++r) p0[r] = __builtin_amdgcn_exp2f(p0[r]);
}
__device__ __forceinline__ void finishSM(f32x16& p0, f32x16& p1, float alpha, float& l_reg, bf16x8& pa0, bf16x8& pa1, bf16x8& pa2, bf16x8& pa3) {
#pragma unroll
    for (int r = 0; r < 16; ++r) p1[r] = __builtin_amdgcn_exp2f(p1[r]);
    float ps = 0.f;
#pragma unroll
    for (int r = 0; r < 16; ++r) ps += p0[r];
#pragma unroll
    for (int r = 0; r < 16; ++r) ps += p1[r];
    { auto rr = __builtin_amdgcn_permlane32_swap(__float_as_uint(ps), __float_as_uint(ps), false, false); ps = __uint_as_float(rr[0]) + __uint_as_float(rr[1]); }
    l_reg = l_reg * alpha + ps;
#define FA_PK4(P, B_, OUT) do { unsigned a0 = cvtpk(P[B_ + 0], P[B_ + 1]), a1 = cvtpk(P[B_ + 2], P[B_ + 3]); unsigned b0 = cvtpk(P[B_ + 4], P[B_ + 5]), b1 = cvtpk(P[B_ + 6], P[B_ + 7]); \
        auto r0 = __builtin_amdgcn_permlane32_swap(a0, b0, false, false); auto r1 = __builtin_amdgcn_permlane32_swap(a1, b1, false, false); \
        u32x4 w = {r0[0], r1[0], r0[1], r1[1]}; OUT = *reinterpret_cast<bf16x8*>(&w); } while (0)
    FA_PK4(p0, 0, pa0); FA_PK4(p0, 8, pa1); FA_PK4(p1, 0, pa2); FA_PK4(p1, 8, pa3);
#undef FA_PK4
}
template <int NDQ>
__device__ __forceinline__ void qkt(f32x16& p0, f32x16& p1, const char* Kb, int r32, int hi, const bf16x8* qr) {
    p0 = f32x16{}; p1 = f32x16{};
    constexpr int NA = NDQ < 8 ? NDQ : 8;
    const char* kb[NA];
#pragma unroll
    for (int dd = 0; dd < NA; ++dd) kb[dd] = Kb + kswz<NDQ>(r32, 2 * dd + hi);
#pragma unroll
    for (int d0 = 0; d0 < NDQ; ++d0) { const char* a = kb[d0 & (NA - 1)] + (d0 >> 3) * 256;
        const bf16x8 b0 = *reinterpret_cast<const bf16x8*>(a);
        const bf16x8 b1 = *reinterpret_cast<const bf16x8*>(a + 32 * NDQ * 32);
        p0 = __builtin_amdgcn_mfma_f32_32x32x16_bf16(b0, qr[d0], p0, 0, 0, 0);
        p1 = __builtin_amdgcn_mfma_f32_32x32x16_bf16(b1, qr[d0], p1, 0, 0, 0); }
}
template <int NDVT, int NDV>
__device__ __forceinline__ void pv_tile(f32x16* o, int vb, bf16x8 pa0, bf16x8 pa1, bf16x8 pa2, bf16x8 pa3) {
#define FA_TRRD(dst, off) asm volatile("ds_read_b64_tr_b16 %0, %1 offset:%2" : "=&v"(dst) : "v"(vb), "i"(off) : "memory")
#define FA_PV_D0(d0) do { s16x4 l0, l1, l2, l3, h0, h1, h2, h3; constexpr int b_ = (d0) * 512, ks_ = 2 * NDVT * 512, hf_ = NDVT * 512; \
        FA_TRRD(l0, b_); FA_TRRD(h0, b_ + hf_); FA_TRRD(l1, b_ + ks_); FA_TRRD(h1, b_ + ks_ + hf_); FA_TRRD(l2, b_ + 2 * ks_); FA_TRRD(h2, b_ + 2 * ks_ + hf_); FA_TRRD(l3, b_ + 3 * ks_); FA_TRRD(h3, b_ + 3 * ks_ + hf_); \
        asm volatile("s_waitcnt lgkmcnt(0)" ::: "memory"); FA_SBAR(); \
        o[d0] = __builtin_amdgcn_mfma_f32_32x32x16_bf16(pa0, (bf16x8){l0[0], l0[1], l0[2], l0[3], h0[0], h0[1], h0[2], h0[3]}, o[d0], 0, 0, 0); \
        o[d0] = __builtin_amdgcn_mfma_f32_32x32x16_bf16(pa1, (bf16x8){l1[0], l1[1], l1[2], l1[3], h1[0], h1[1], h1[2], h1[3]}, o[d0], 0, 0, 0); \
        o[d0] = __builtin_amdgcn_mfma_f32_32x32x16_bf16(pa2, (bf16x8){l2[0], l2[1], l2[2], l2[3], h2[0], h2[1], h2[2], h2[3]}, o[d0], 0, 0, 0); \
        o[d0] = __builtin_amdgcn_mfma_f32_32x32x16_bf16(pa3, (bf16x8){l3[0], l3[1], l3[2], l3[3], h3[0], h3[1], h3[2], h3[3]}, o[d0], 0, 0, 0); } while (0)
    FA_PV_D0(0); if constexpr (NDV > 1) FA_PV_D0(1); if constexpr (NDV > 2) FA_PV_D0(2); if constexpr (NDV > 3) FA_PV_D0(3);
#undef FA_PV_D0
#undef FA_TRRD
}

template <int NDQ, int NDVT, int NDV>
struct Core {
    static constexpr int KROW = NDQ * 32, SHM_K = 64 * KROW, SHM_V = 64 * NDVT * 64, NKL = NDQ / 4, NVL = NDVT / 2, LDS_NEED = 2 * SHM_V + 2 * SHM_K + NW * 256;
    static_assert(NKL >= 1 && NVL >= 1, "tile too small for 512 staging threads");
    __device__ __forceinline__ static void run(f32x16 (&o)[NDV], float& m_reg, float& l_reg, const bf16* Qw, int ldq, const bf16* Kg, const bf16* Vg, int ldk,
                                               int j_lo, int j_hi, int qlo, int W, char* lds, int vdoff) {
        int tid = threadIdx.x; asm volatile("" : "+v"(tid));
        const int wid = __builtin_amdgcn_readfirstlane(tid >> 6), lane = tid & 63, r32 = lane & 31, hi = lane >> 5;
        const int NT = j_hi - j_lo, qm = qlo + r32 - 4 * hi;
        char* V_lds = lds; char* K_lds = lds + 2 * SHM_V;
        float* wsf = (float*)(lds + 2 * SHM_V + 2 * SHM_K) + wid * 64; float* al_l = wsf + 32;
        m_reg = -1e30f; l_reg = 0.f;
#pragma unroll
        for (int d = 0; d < NDV; ++d) o[d] = f32x16{};
        constexpr int KCH = 2 * NDQ, KRS = 512 / KCH, VCH = 4 * NDVT, VRS = 512 / VCH;
        const int krow0 = tid / KCH, kch = tid % KCH, vrow0 = tid / VCH, vcol = (tid % VCH) * 8;
        int kws[NKL], vws[NVL];
#pragma unroll
        for (int i = 0; i < NKL; ++i) kws[i] = kswz<NDQ>(krow0 + i * KRS, kch);
#pragma unroll
        for (int i = 0; i < NVL; ++i) vws[i] = v_st<NDVT>(vrow0 + i * VRS, vcol);
        const bf16* kgp = Kg + (size_t)krow0 * ldk + kch * 8; const bf16* vgp = Vg + (size_t)vrow0 * ldk + vcol;
        bf16x8 sk[NKL], sv[NVL];
        const int vb0 = (int)(uintptr_t)V_lds + v_rd_base(lane) + vdoff * 512;
#define FA_SLOAD(t) do { const size_t ro_ = (size_t)((j_lo + (t)) * KVBLK) * ldk; \
        _Pragma("unroll") for (int i_ = 0; i_ < NVL; ++i_) sv[i_] = *reinterpret_cast<const bf16x8*>(vgp + ro_ + (size_t)(i_ * VRS) * ldk); \
        _Pragma("unroll") for (int i_ = 0; i_ < NKL; ++i_) sk[i_] = *reinterpret_cast<const bf16x8*>(kgp + ro_ + (size_t)(i_ * KRS) * ldk); } while (0)
#define FA_SWRITE(bf) do { _Pragma("unroll") for (int i_ = 0; i_ < NVL; ++i_) *reinterpret_cast<bf16x8*>(V_lds + (bf) * SHM_V + vws[i_]) = sv[i_]; \
        _Pragma("unroll") for (int i_ = 0; i_ < NKL; ++i_) *reinterpret_cast<bf16x8*>(K_lds + (bf) * SHM_K + kws[i_]) = sk[i_]; } while (0)
#define FA_RESC(a) do { if (__any((a) < 1.f)) { if (hi == 0) al_l[r32] = (a); asm volatile("s_waitcnt lgkmcnt(0)" ::: "memory"); \
        _Pragma("unroll") for (int d_ = 0; d_ < NDV; ++d_) _Pragma("unroll") for (int r = 0; r < 16; ++r) o[d_][r] *= al_l[crow(r, hi)]; } } while (0)
#define FA_KBASE(t) ((j_lo + (t)) * KVBLK)
#define FA_MASKT(P0_, P1_, t) do { const int kb_ = FA_KBASE(t); if (kb_ + KVBLK - 1 > qlo || kb_ <= qlo + QBLK - 1 - W) mask_tile(P0_, P1_, qm - kb_, (unsigned)W); } while (0)
        bf16x8 qr[NDQ];
#pragma unroll
        for (int d0 = 0; d0 < NDQ; ++d0) qr[d0] = *reinterpret_cast<const bf16x8*>(Qw + (size_t)r32 * ldq + d0 * 16 + hi * 8);
        FA_SLOAD(0); FA_VMW(); FA_SWRITE(0); FA_SBAR();
        if (NT > 1) FA_SLOAD(1);
        __syncthreads();
        f32x16 pA0, pA1, pB0, pB1; float alA, alB; bf16x8 pa0, pa1, pa2, pa3;
        FA_SBAR(); qkt<NDQ>(pA0, pA1, K_lds, r32, hi, qr);
        FA_MASKT(pA0, pA1, 0); partialSM(pA0, pA1, m_reg, alA);
        if (NT > 1) { FA_VMW(); FA_SWRITE(1); }
        __syncthreads();
#define FA_HALF_STEP(PX0, PX1, alX, PY0, PY1, alY, t, KB, VB, SB) do { \
        FA_SBAR(); qkt<NDQ>(PX0, PX1, K_lds + (KB) * SHM_K, r32, hi, qr); \
        finishSM(PY0, PY1, alY, l_reg, pa0, pa1, pa2, pa3); FA_SBAR(); \
        if ((t) + 1 < NT) { FA_SLOAD((t) + 1); FA_SBAR(); } \
        pv_tile<NDVT, NDV>(o, vb0 + (VB) * SHM_V, pa0, pa1, pa2, pa3); FA_MASKT(PX0, PX1, (t)); partialSM(PX0, PX1, m_reg, alX); \
        __syncthreads(); \
        if ((t) + 1 < NT) { FA_VMW(); FA_SWRITE(SB); } \
        FA_RESC(alX); __syncthreads(); } while (0)
        for (int t = 1; t + 1 < NT; t += 2) {
            FA_HALF_STEP(pB0, pB1, alB, pA0, pA1, alA, t, 1, 0, 0);
            FA_HALF_STEP(pA0, pA1, alA, pB0, pB1, alB, t + 1, 0, 1, 1);
        }
        const bool even = (NT & 1) == 0;
        if (even) { FA_SBAR(); qkt<NDQ>(pB0, pB1, K_lds + SHM_K, r32, hi, qr); FA_SBAR(); }
        finishSM(pA0, pA1, alA, l_reg, pa0, pa1, pa2, pa3); FA_SBAR();
        pv_tile<NDVT, NDV>(o, vb0, pa0, pa1, pa2, pa3);
        if (even) { FA_MASKT(pB0, pB1, NT - 1); partialSM(pB0, pB1, m_reg, alB); FA_RESC(alB);
            finishSM(pB0, pB1, alB, l_reg, pa0, pa1, pa2, pa3); FA_SBAR(); pv_tile<NDVT, NDV>(o, vb0 + SHM_V, pa0, pa1, pa2, pa3); }
        __syncthreads();
#undef FA_SLOAD
#undef FA_SWRITE
#undef FA_RESC
#undef FA_KBASE
#undef FA_MASKT
#undef FA_HALF_STEP
    }
};

#define FA_PIN(x) asm volatile("" : "+v"(x))
#define FA_PK4V(P, B_, OUT) do { unsigned a0_ = cvtpk(P[B_ + 0], P[B_ + 1]), a1_ = cvtpk(P[B_ + 2], P[B_ + 3]); unsigned b0_ = cvtpk(P[B_ + 4], P[B_ + 5]), b1_ = cvtpk(P[B_ + 6], P[B_ + 7]); \
        auto r0_ = __builtin_amdgcn_permlane32_swap(a0_, b0_, false, false); auto r1_ = __builtin_amdgcn_permlane32_swap(a1_, b1_, false, false); \
        u32x4 w_ = {r0_[0], r1_[0], r0_[1], r1_[1]}; OUT = *reinterpret_cast<bf16x8*>(&w_); } while (0)
__device__ __forceinline__ void step_qk_fin(f32x16& X0, f32x16& X1, const char* Kb, int r32, int hi, const bf16x8* qr,
                                            f32x16& Y0, f32x16& Y1, float alY, float& l_reg, bf16x8& pa0, bf16x8& pa1, bf16x8& pa2, bf16x8& pa3) {
    const char* k0 = Kb + kswz<4>(r32, hi); const char* k1 = Kb + kswz<4>(r32, 2 + hi); const char* k2 = Kb + kswz<4>(r32, 4 + hi); const char* k3 = Kb + kswz<4>(r32, 6 + hi);
    bf16x8 fa = *reinterpret_cast<const bf16x8*>(k0), fb = *reinterpret_cast<const bf16x8*>(k0 + 4096);
    float ps;
    X0 = __builtin_amdgcn_mfma_f32_32x32x16_bf16(fa, qr[0], f32x16{}, 0, 0, 0); X1 = __builtin_amdgcn_mfma_f32_32x32x16_bf16(fb, qr[0], f32x16{}, 0, 0, 0);
    fa = *reinterpret_cast<const bf16x8*>(k1); fb = *reinterpret_cast<const bf16x8*>(k1 + 4096);
#pragma unroll
    for (int r = 0; r < 4; ++r) Y1[r] = __builtin_amdgcn_exp2f(Y1[r]);
    ps = (Y0[0] + Y0[1]) + (Y0[2] + Y0[3]);
    FA_PK4V(Y0, 0, pa0); FA_PIN(ps); FA_PIN(pa0); FA_PIN(Y1); FA_SBAR();
    X0 = __builtin_amdgcn_mfma_f32_32x32x16_bf16(fa, qr[1], X0, 0, 0, 0); X1 = __builtin_amdgcn_mfma_f32_32x32x16_bf16(fb, qr[1], X1, 0, 0, 0);
    fa = *reinterpret_cast<const bf16x8*>(k2); fb = *reinterpret_cast<const bf16x8*>(k2 + 4096);
#pragma unroll
    for (int r = 4; r < 8; ++r) Y1[r] = __builtin_amdgcn_exp2f(Y1[r]);
    ps += (Y0[4] + Y0[5]) + (Y0[6] + Y0[7]); ps += (Y1[0] + Y1[1]) + (Y1[2] + Y1[3]);
    FA_PK4V(Y0, 8, pa1); FA_PIN(ps); FA_PIN(pa1); FA_PIN(Y1); FA_SBAR();
    X0 = __builtin_amdgcn_mfma_f32_32x32x16_bf16(fa, qr[2], X0, 0, 0, 0); X1 = __builtin_amdgcn_mfma_f32_32x32x16_bf16(fb, qr[2], X1, 0, 0, 0);
    fa = *reinterpret_cast<const bf16x8*>(k3); fb = *reinterpret_cast<const bf16x8*>(k3 + 4096);
#pragma unroll
    for (int r = 8; r < 12; ++r) Y1[r] = __builtin_amdgcn_exp2f(Y1[r]);
    ps += (Y0[8] + Y0[9]) + (Y0[10] + Y0[11]); ps += (Y1[4] + Y1[5]) + (Y1[6] + Y1[7]);
    FA_PK4V(Y1, 0, pa2); FA_PIN(ps); FA_PIN(pa2); FA_PIN(Y1); FA_SBAR();
    X0 = __builtin_amdgcn_mfma_f32_32x32x16_bf16(fa, qr[3], X0, 0, 0, 0); X1 = __builtin_amdgcn_mfma_f32_32x32x16_bf16(fb, qr[3], X1, 0, 0, 0);
#pragma unroll
    for (int r = 12; r < 16; ++r) Y1[r] = __builtin_amdgcn_exp2f(Y1[r]);
    ps += (Y0[12] + Y0[13]) + (Y0[14] + Y0[15]); ps += (Y1[8] + Y1[9]) + (Y1[10] + Y1[11]); ps += (Y1[12] + Y1[13]) + (Y1[14] + Y1[15]);
    { auto rr = __builtin_amdgcn_permlane32_swap(__float_as_uint(ps), __float_as_uint(ps), false, false); ps = __uint_as_float(rr[0]) + __uint_as_float(rr[1]); }
    l_reg = l_reg * alY + ps;
    FA_PK4V(Y1, 8, pa3); FA_PIN(l_reg); FA_PIN(pa3); FA_PIN(X0); FA_PIN(X1); FA_SBAR();
}
__device__ __forceinline__ void step_pv_max(f32x16* o, int vb, bf16x8 pa0, bf16x8 pa1, bf16x8 pa2, bf16x8 pa3, f32x16& X0, f32x16& X1, float& m_reg, float& alpha, bool MASK, int dq, unsigned W) {
#define FA_TRRD(dst, off) asm volatile("ds_read_b64_tr_b16 %0, %1 offset:%2" : "=&v"(dst) : "v"(vb), "i"(off) : "memory")
#define FA_RD2(l, h, d0, ks) do { FA_TRRD(l, (d0) * 512 + (ks) * 4096); FA_TRRD(h, (d0) * 512 + (ks) * 4096 + 2048); } while (0)
#define FA_FRAG(l, h) (bf16x8){l[0], l[1], l[2], l[3], h[0], h[1], h[2], h[3]}
    s16x4 l0, h0, l1, h1, l2, h2, l3, h3;
    FA_RD2(l0, h0, 0, 0); FA_RD2(l1, h1, 0, 1); FA_RD2(l2, h2, 0, 2); FA_RD2(l3, h3, 0, 3);
    if (MASK) mask_tile(X0, X1, dq, W);
    float pmax = fmaxf(fmaxf(X0[0], X0[1]), X1[0]);
#pragma unroll
    for (int r = 2; r < 16; r += 2) pmax = fmaxf(fmaxf(pmax, X0[r]), X0[r + 1]);
#pragma unroll
    for (int r = 1; r < 16; r += 2) pmax = fmaxf(fmaxf(pmax, X1[r]), X1[(r + 1) & 15]);
    { auto rr = __builtin_amdgcn_permlane32_swap(__float_as_uint(pmax), __float_as_uint(pmax), false, false); pmax = fmaxf(__uint_as_float(rr[0]), __uint_as_float(rr[1])); }
    float mn;
    if (__builtin_expect(__all((pmax - m_reg) <= THR), 1)) { mn = m_reg; alpha = 1.f; }
    else { mn = fmaxf(m_reg, pmax); alpha = __builtin_amdgcn_exp2f(m_reg - mn); m_reg = mn; }
    FA_PIN(mn);
#define FA_BLK(d0, NXT, FILL) do { asm volatile("s_waitcnt lgkmcnt(0)" ::: "memory"); FA_SBAR(); \
        o[d0] = __builtin_amdgcn_mfma_f32_32x32x16_bf16(pa0, FA_FRAG(l0, h0), o[d0], 0, 0, 0); if (NXT) FA_RD2(l0, h0, (d0) + 1, 0); \
        o[d0] = __builtin_amdgcn_mfma_f32_32x32x16_bf16(pa1, FA_FRAG(l1, h1), o[d0], 0, 0, 0); if (NXT) FA_RD2(l1, h1, (d0) + 1, 1); \
        o[d0] = __builtin_amdgcn_mfma_f32_32x32x16_bf16(pa2, FA_FRAG(l2, h2), o[d0], 0, 0, 0); if (NXT) FA_RD2(l2, h2, (d0) + 1, 2); \
        o[d0] = __builtin_amdgcn_mfma_f32_32x32x16_bf16(pa3, FA_FRAG(l3, h3), o[d0], 0, 0, 0); if (NXT) FA_RD2(l3, h3, (d0) + 1, 3); \
        FILL; } while (0)
    FA_BLK(0, true,  { _Pragma("unroll") for (int r = 0; r < 16; ++r) X0[r] = X0[r] - mn; FA_PIN(X0); });
    FA_BLK(1, true,  { _Pragma("unroll") for (int r = 0; r < 16; ++r) X1[r] = X1[r] - mn; FA_PIN(X1); });
    FA_BLK(2, true,  { _Pragma("unroll") for (int r = 0; r < 8; ++r) X0[r] = __builtin_amdgcn_exp2f(X0[r]); FA_PIN(X0); });
    FA_BLK(3, false, { _Pragma("unroll") for (int r = 8; r < 16; ++r) X0[r] = __builtin_amdgcn_exp2f(X0[r]); FA_PIN(X0); });
    FA_SBAR();
#undef FA_BLK
#undef FA_RD2
#undef FA_FRAG
#undef FA_TRRD
}

template <int NDQ, int NDVT, int NDV>
struct CoreStag {
    static_assert(NDQ == 4 && NDVT == 4 && NDV == 4, "the interleaved interval bodies are written for d_qk = 64, d_v = 128");
    static constexpr int KROW = NDQ * 32, SHM_K = 64 * KROW, SHM_V = 64 * NDVT * 64, NKL = NDQ / 4, NVL = NDVT / 2, LDS_NEED = 2 * SHM_V + 2 * SHM_K + NW * 256;
    __device__ __forceinline__ static void run(f32x16 (&o)[NDV], float& m_reg, float& l_reg, const bf16* Qw, int ldq, const bf16* Kg, const bf16* Vg, int ldk,
                                               int j_lo, int j_hi, int qlo, int W, char* lds, int vdoff) {
        const int tid = threadIdx.x, wid = __builtin_amdgcn_readfirstlane(tid >> 6), lane = tid & 63, r32 = lane & 31, hi = lane >> 5;
        const bool half1 = wid >= 4;
        const int NT = j_hi - j_lo, qm = qlo + r32 - 4 * hi;
        char* V_lds = lds; char* K_lds = lds + 2 * SHM_V;
        float* al_l = (float*)(lds + 2 * SHM_V + 2 * SHM_K) + wid * 64 + 32;
        m_reg = -1e30f; l_reg = 0.f;
#if PROBE_TS
        unsigned long long tbar_ = 0; const unsigned long long tst_ = __builtin_amdgcn_s_memtime(), trt_ = __builtin_amdgcn_s_memrealtime();
#endif
#pragma unroll
        for (int d = 0; d < NDV; ++d) o[d] = f32x16{};
        constexpr int KCH = 2 * NDQ, KRS = 512 / KCH, VCH = 4 * NDVT, VRS = 512 / VCH;
        const int krow0 = tid / KCH, kch = tid % KCH, vrow0 = tid / VCH, vcol = (tid % VCH) * 8;
        int kws[NKL], vws[NVL];
#pragma unroll
        for (int i = 0; i < NKL; ++i) kws[i] = kswz<NDQ>(krow0 + i * KRS, kch);
#pragma unroll
        for (int i = 0; i < NVL; ++i) vws[i] = v_st<NDVT>(vrow0 + i * VRS, vcol);
        const bf16* kgp = Kg + (size_t)(j_lo * KVBLK + krow0) * ldk + kch * 8; const bf16* vgp = Vg + (size_t)(j_lo * KVBLK + vrow0) * ldk + vcol;
        bf16x8 sk[NKL], sv[NVL];
        const int vb0 = (int)(uintptr_t)V_lds + v_rd_base(lane) + vdoff * 512;
#if PROBE_TS
#define FS_BAR() do { FA_SBAR(); const unsigned long long tb0_ = __builtin_amdgcn_s_memtime(); __syncthreads(); tbar_ += __builtin_amdgcn_s_memtime() - tb0_; FA_SBAR(); } while (0)
#else
#define FS_BAR() do { FA_SBAR(); __syncthreads(); FA_SBAR(); } while (0)
#endif
#define FS_LOADK(t) do { if ((t) < NT) { const size_t ro_ = (size_t)((t) * KVBLK) * ldk; _Pragma("unroll") for (int i_ = 0; i_ < NKL; ++i_) sk[i_] = *reinterpret_cast<const bf16x8*>(kgp + ro_ + (size_t)(i_ * KRS) * ldk); } } while (0)
#define FS_LOADV(t) do { if ((t) < NT) { const size_t ro_ = (size_t)((t) * KVBLK) * ldk; _Pragma("unroll") for (int i_ = 0; i_ < NVL; ++i_) sv[i_] = *reinterpret_cast<const bf16x8*>(vgp + ro_ + (size_t)(i_ * VRS) * ldk); } } while (0)
#define FS_WRITEK(t, bf) do { if ((t) < NT) { _Pragma("unroll") for (int i_ = 0; i_ < NKL; ++i_) *reinterpret_cast<bf16x8*>(K_lds + (bf) * SHM_K + kws[i_]) = sk[i_]; } } while (0)
#define FS_WRITEV(t, bf) do { if ((t) < NT) { _Pragma("unroll") for (int i_ = 0; i_ < NVL; ++i_) *reinterpret_cast<bf16x8*>(V_lds + (bf) * SHM_V + vws[i_]) = sv[i_]; } } while (0)
#define FS_RESC(a) do { if (__any((a) < 1.f)) { if (hi == 0) al_l[r32] = (a); asm volatile("s_waitcnt lgkmcnt(0)" ::: "memory"); \
        _Pragma("unroll") for (int d_ = 0; d_ < NDV; ++d_) _Pragma("unroll") for (int r = 0; r < 16; ++r) o[d_][r] *= al_l[crow(r, hi)]; } } while (0)
#define FS_MASKT(P0_, P1_, t) do { const int kb_ = (j_lo + (t)) * KVBLK; if (kb_ + KVBLK - 1 > qlo || kb_ <= qlo + QBLK - 1 - W) mask_tile(P0_, P1_, qm - kb_, (unsigned)W); } while (0)
        bf16x8 qr[NDQ];
#pragma unroll
        for (int d0 = 0; d0 < NDQ; ++d0) qr[d0] = *reinterpret_cast<const bf16x8*>(Qw + (size_t)r32 * ldq + d0 * 16 + hi * 8);
        FS_LOADK(0); FS_WRITEK(0, 0); FA_SBAR(); FS_LOADK(1); FS_LOADV(0);
        FS_BAR();
        if (half1) { FS_BAR(); }
        f32x16 pA0, pA1, pB0, pB1; float alA = 1.f, alB = 1.f; bf16x8 pa0, pa1, pa2, pa3;
        FS_WRITEK(1, 1); FA_SBAR(); FS_LOADK(2); FA_SBAR();
        qkt<NDQ>(pA0, pA1, K_lds, r32, hi, qr); asm volatile("" : "+v"(pA0), "+v"(pA1));
        FS_BAR();
        FS_WRITEV(0, 0); FA_SBAR(); FS_LOADV(1); FA_SBAR();
        FS_MASKT(pA0, pA1, 0); partialSM(pA0, pA1, m_reg, alA);
        FS_BAR();
#define FS_STEP(PX0, PX1, alX, PY0, PY1, alY, t, KB) do { \
        finishSM(PY0, PY1, alY, l_reg, pa0, pa1, pa2, pa3); FA_SBAR(); \
        FS_WRITEK((t) + 1, (KB) ^ 1); FA_SBAR(); FS_LOADK((t) + 2); FA_SBAR(); \
        qkt<NDQ>(PX0, PX1, K_lds + (KB) * SHM_K, r32, hi, qr); asm volatile("" : "+v"(PX0), "+v"(PX1)); \
        FS_BAR(); \
        pv_tile<NDVT, NDV>(o, vb0 + ((KB) ^ 1) * SHM_V, pa0, pa1, pa2, pa3); \
        FS_WRITEV((t), (KB)); FA_SBAR(); FS_LOADV((t) + 1); FA_SBAR(); \
        FS_MASKT(PX0, PX1, (t)); partialSM(PX0, PX1, m_reg, alX); FS_RESC(alX); \
        FS_BAR(); } while (0)
        int t = 1;
        for (; t + 1 < NT; t += 2) {
            FS_STEP(pB0, pB1, alB, pA0, pA1, alA, t, 1);
            FS_STEP(pA0, pA1, alA, pB0, pB1, alB, t + 1, 0);
        }
        FS_STEP(pB0, pB1, alB, pA0, pA1, alA, t, 1);
        finishSM(pB0, pB1, alB, l_reg, pa0, pa1, pa2, pa3); FA_SBAR();
        FS_BAR();
        pv_tile<NDVT, NDV>(o, vb0 + SHM_V, pa0, pa1, pa2, pa3);
        FS_BAR();
        if (!half1) { FS_BAR(); }
#if PROBE_TS
        if (blockIdx.x == 0 && tid == PROBE_WAVE * 64 && NT == 64) { volatile unsigned long long* ts = (volatile unsigned long long*)(g_probe_ws + 1024);
            ts[30] = 0; ts[31] = tbar_ / 24; ts[32] = (__builtin_amdgcn_s_memtime() - tst_) / 24; ts[33] = __builtin_amdgcn_s_memrealtime() - trt_; }
#endif
#undef FS_BAR
#undef FS_LOADK
#undef FS_LOADV
#undef FS_WRITEK
#undef FS_WRITEV
#undef FS_RESC
#undef FS_MASKT
#undef FS_STEP
    }
};
}

constexpr size_t WS_STASH = 128 * MiB;
typedef unsigned v4u32 __attribute__((__vector_size__(16)));
__device__ __forceinline__ __amdgpu_buffer_rsrc_t mk_rsrc(const void* ptr) {
    const unsigned long long v = (unsigned long long)ptr; const unsigned lo = __builtin_amdgcn_readfirstlane((unsigned)v), hi = __builtin_amdgcn_readfirstlane((unsigned)(v >> 32));
    return __builtin_amdgcn_make_buffer_rsrc((void*)(((unsigned long long)hi << 32) | lo), 0, 0x40000000, 0x00020000);
}
__device__ __forceinline__ void attn_phase(const Params& p, char* lds, int vcu0, int nwg) {
    using namespace fa;
    const int tid = threadIdx.x, wid = __builtin_amdgcn_readfirstlane(tid >> 6), lane = tid & 63, r32 = lane & 31, hi = lane >> 5;
    const bf16* proj = (const bf16*)(p.ws + WS_PROJ); bf16* att = (bf16*)(p.ws + WS_ATT);
    typedef CoreStag<4, 4, 4> CD; typedef Core<4, 2, 2> CS;
    float* wsf = (float*)(lds + CD::LDS_NEED) + wid * 64;
    const float lam = calc_lambda(p);
    const int ovoff = (4 * hi * DM + r32) * 2;
#ifndef PROBE_ATT
#define PROBE_ATT 0
#endif
#ifndef FA_NO_DIFF
    for (int rpa_ = 0; rpa_ < (PROBE_ATT == 1 ? 2 : 1); ++rpa_)
#pragma nounroll
    for (int vcu = vcu0; vcu < 256; vcu += nwg) {
        const int bh = vcu >> 3, b = bh >> 2, h = bh & 3, s = vcu & 7;
        u32x4* stash = (u32x4*)(lds + CD::LDS_NEED + NW * 256) + tid;
#pragma nounroll
        for (int pass = 0; pass < 2; ++pass) {
            const int qb = pass ? 15 - s : s;
            const size_t row0 = (size_t)b * SEQ + qb * 256 + wid * 32;
#pragma nounroll
            for (int c = 0; c < 2; ++c) {
                f32x16 o[4]; float m_reg, l_reg;
                CD::run(o, m_reg, l_reg, proj + row0 * NP + C_QD + (2 * h + c) * 64, NP, proj + (size_t)b * SEQ * NP + C_KD + (2 * h + c) * 64, proj + (size_t)b * SEQ * NP + C_VD + h * 128, NP,
                        0, 4 * (qb + 1), qb * 256 + wid * 32, 1 << 30, lds, 0);
                if (hi == 0) wsf[r32] = l_reg;
                asm volatile("s_waitcnt lgkmcnt(0)" ::: "memory");
                if (c == 0) {
#pragma unroll
                    for (int j = 0; j < 2; ++j) { float ri[8];
#pragma unroll
                        for (int e = 0; e < 8; ++e) ri[e] = 1.0f / wsf[crow(8 * j + e, hi)];
#pragma unroll
                        for (int d0 = 0; d0 < 4; ++d0) { u32x4 w; w.x = cvtpk(o[d0][8 * j] * ri[0], o[d0][8 * j + 1] * ri[1]); w.y = cvtpk(o[d0][8 * j + 2] * ri[2], o[d0][8 * j + 3] * ri[3]);
                            w.z = cvtpk(o[d0][8 * j + 4] * ri[4], o[d0][8 * j + 5] * ri[5]); w.w = cvtpk(o[d0][8 * j + 6] * ri[6], o[d0][8 * j + 7] * ri[7]); stash[(d0 * 2 + j) * NTHR] = w; } }
                } else {
                    const __amdgpu_buffer_rsrc_t rso = mk_rsrc(att + row0 * DM + 512 + h * 128);
                    float ssq[16];
#pragma unroll
                    for (int r = 0; r < 16; ++r) ssq[r] = -lam / wsf[crow(r, hi)];
#pragma unroll
                    for (int d0 = 0; d0 < 4; ++d0)
#pragma unroll
                        for (int j = 0; j < 2; ++j) { const u32x4 w = stash[(d0 * 2 + j) * NTHR]; const unsigned ww[4] = {w.x, w.y, w.z, w.w};
#pragma unroll
                            for (int e = 0; e < 8; ++e) { const int r = 8 * j + e; const float a0 = (e & 1) ? __uint_as_float(ww[e >> 1] & 0xffff0000u) : __uint_as_float(ww[e >> 1] << 16);
                                o[d0][r] = a0 + ssq[r] * o[d0][r]; } }
#pragma unroll
                    for (int r = 0; r < 16; ++r) { float q = (o[0][r] * o[0][r] + o[1][r] * o[1][r]) + (o[2][r] * o[2][r] + o[3][r] * o[3][r]);
                        q += __shfl_xor(q, 1); q += __shfl_xor(q, 2); q += __shfl_xor(q, 4); q += __shfl_xor(q, 8); q += __shfl_xor(q, 16);
                        ssq[r] = 0.8f / sqrtf(q * (1.f / 128.f) + EPS); }
#pragma unroll
                    for (int d0 = 0; d0 < 4; ++d0) { const float g = p.g_diff[d0 * 32 + r32];
#pragma unroll
                        for (int r = 0; r < 16; ++r) { const float y = o[d0][r] * ssq[r] * g; const float yn = __shfl_xor(y, 1);
                            if ((r32 & 1) == 0) __builtin_amdgcn_raw_buffer_store_b32(cvtpk(y, yn), rso, ovoff, (((r & 3) + 8 * (r >> 2)) * DM + d0 * 32) * 2, 0); } }
                }
                asm volatile("s_waitcnt lgkmcnt(0)" ::: "memory");
            }
        }
    }
#endif
#ifndef FA_NO_SWA
    int tid_s = threadIdx.x; asm volatile("" : "+v"(tid_s));
    const int wid_s = __builtin_amdgcn_readfirstlane(tid_s >> 6), r32_s = tid_s & 31, hi_s = (tid_s >> 5) & 1;
    float* wsf_s = (float*)(lds + CD::LDS_NEED) + wid_s * 64; const int ovoff_s = (4 * hi_s * DM + r32_s) * 2;
    for (int rps_ = 0; rps_ < (PROBE_ATT == 2 ? 2 : 1); ++rps_)
#pragma nounroll
    for (int u = vcu0; u < 1024; u += nwg) {
        const int wid = wid_s, r32 = r32_s, hi = hi_s, ovoff = ovoff_s; float* wsf = wsf_s;
        const int bk = u >> 6, g64 = u & 63, b = bk >> 1, kvh = bk & 1, hq = kvh * 4 + (wid >> 1), sub = wid & 1;
        const size_t row0 = (size_t)b * SEQ + g64 * 64 + sub * 32;
        const __amdgpu_buffer_rsrc_t rso = mk_rsrc(att + row0 * DM + hq * 64);
        f32x16 o[2]; float m_reg, l_reg;
        const bf16* Qw = proj + row0 * NP + C_QA + hq * 64;
        const bf16* Kg = proj + (size_t)b * SEQ * NP + C_KA + kvh * 64;
        const bf16* Vg = proj + (size_t)b * SEQ * NP + C_VA + kvh * 64;
        CS::run(o, m_reg, l_reg, Qw, NP, Kg, Vg, NP, g64 >= 2 ? g64 - 2 : 0, g64 + 1, g64 * 64 + sub * 32, 128, lds, 0);
        const float lt = l_reg + __builtin_amdgcn_exp2f(p.sinks[hq] * LOG2E - m_reg);
        if (hi == 0) wsf[r32] = lt;
        asm volatile("s_waitcnt lgkmcnt(0)" ::: "memory");
#pragma unroll
        for (int r = 0; r < 16; ++r) { const float rl = 1.0f / wsf[crow(r, hi)];
#pragma unroll
            for (int d0 = 0; d0 < 2; ++d0) { const float y = o[d0][r] * rl; const float yn = __shfl_xor(y, 1);
                if ((r32 & 1) == 0) __builtin_amdgcn_raw_buffer_store_b32(cvtpk(y, yn), rso, ovoff, (((r & 3) + 8 * (r >> 2)) * DM + d0 * 32) * 2, 0); } }
        __syncthreads();
    }
#endif
}

namespace fa {
template <int NDQ, int NDVT, int NDV>
struct CoreSeqG {
    static constexpr int KROW = NDQ * 32, SHM_K = 64 * KROW, SHM_V = 64 * NDVT * 64, KPW = SHM_K / 8192, VPW = SHM_V / 8192;
    static_assert(NDQ == 16 && NDVT == 8, "piece maps below are written for 512-byte K rows and 8 V column blocks");
    typedef __attribute__((address_space(3))) unsigned char* lptr;
    __device__ __forceinline__ static void run(f32x16 (&o)[NDV], float& m_reg, float& l_reg, const bf16* Qw, int ldq, const bf16* Kg, const bf16* Vg, int ldk, int NT, char* lds, lptr ldsL, int scr_off, int vdoff) {
        const int tid = threadIdx.x, wid = __builtin_amdgcn_readfirstlane(tid >> 6), lane = tid & 63, r32 = lane & 31, hi = lane >> 5;
        char* V_lds = lds; char* K_lds = lds + 2 * SHM_V;
        float* al_l = (float*)(lds + scr_off) + wid * 64 + 32;
        m_reg = -1e30f; l_reg = 0.f;
#pragma unroll
        for (int d = 0; d < NDV; ++d) o[d] = f32x16{};
        int ksrc[KPW], vsrc[VPW];
#pragma unroll
        for (int i = 0; i < KPW; ++i) { const int row = 2 * (wid * KPW + i) + (lane >> 5); ksrc[i] = row * ldk + (((lane & 31) ^ (row & 15)) << 3); }
#pragma unroll
        for (int i = 0; i < VPW; ++i) { const int kk = wid * 8 + ((lane & 31) >> 2), k = (kk & ~0xC) | ((kk & 4) << 1) | ((kk & 8) >> 1); vsrc[i] = k * ldk + (2 * i + (lane >> 5)) * 32 + (lane & 3) * 8; }
#ifndef PROBE_XT
#define PROBE_XT 0
#endif
#define FG_DMA(t, bf) do { const size_t ro_ = (size_t)((PROBE_XT ? ((t) & 3) : (t)) * KVBLK) * ldk; \
        _Pragma("unroll") for (int i_ = 0; i_ < VPW; ++i_) __builtin_amdgcn_global_load_lds((const unsigned*)(Vg + ro_ + vsrc[i_]), (__attribute__((address_space(3))) unsigned*)(ldsL + (bf) * SHM_V + (wid * VPW + i_) * 1024), 16, 0, 0); \
        _Pragma("unroll") for (int i_ = 0; i_ < KPW; ++i_) __builtin_amdgcn_global_load_lds((const unsigned*)(Kg + ro_ + ksrc[i_]), (__attribute__((address_space(3))) unsigned*)(ldsL + 2 * SHM_V + (bf) * SHM_K + (wid * KPW + i_) * 1024), 16, 0, 0); } while (0)
        const int vb0 = (int)(uintptr_t)V_lds + v_rd_base(lane) + vdoff * 512;
        FG_DMA(0, 0);
        bf16x8 qr[NDQ];
#pragma unroll
        for (int d0 = 0; d0 < NDQ; ++d0) qr[d0] = *reinterpret_cast<const bf16x8*>(Qw + (size_t)r32 * ldq + d0 * 16 + hi * 8);
        __syncthreads();
        for (int t = 0; t < NT; ++t) {
            const int bf = t & 1;
            if (t + 1 < NT) FG_DMA(t + 1, bf ^ 1);
            f32x16 p0, p1; float al; bf16x8 pa0, pa1, pa2, pa3;
            FA_SBAR(); qkt<NDQ>(p0, p1, K_lds + bf * SHM_K, r32, hi, qr);
            partialSM(p0, p1, m_reg, al);
            if (__any(al < 1.f)) { if (hi == 0) al_l[r32] = al; asm volatile("s_waitcnt lgkmcnt(0)" ::: "memory");
#pragma unroll
                for (int d_ = 0; d_ < NDV; ++d_)
#pragma unroll
                    for (int r = 0; r < 16; ++r) o[d_][r] *= al_l[crow(r, hi)]; }
            finishSM(p0, p1, al, l_reg, pa0, pa1, pa2, pa3); FA_SBAR();
            pv_tile<NDVT, NDV>(o, vb0 + bf * SHM_V, pa0, pa1, pa2, pa3);
            __syncthreads();
        }
#undef FG_DMA
    }
};
}
__device__ __forceinline__ void cross_phase(const Params& p, char* lds, LAS unsigned char* ldsL, int vcu0, int nwg) {
    using namespace fa;
    const int tid = threadIdx.x, wid = __builtin_amdgcn_readfirstlane(tid >> 6), lane = tid & 63, r32 = lane & 31, hi = lane >> 5;
    const bf16* qc = (const bf16*)(p.ws + WS_QC); const bf16* kvm = (const bf16*)(p.ws + WS_KVM); bf16* oc = (bf16*)(p.ws + WS_OC);
    typedef CoreSeqG<16, 8, 4> CC;
    constexpr int SCR = 131072 + 8192;
    float* wsf = (float*)(lds + SCR + 2048) + wid * 64;
    const int ovoff = (4 * hi * DM + r32) * 2;
#pragma nounroll
    for (int u = vcu0; u < 1024; u += nwg) {
        const int bh = u >> 5, rb = u & 31, b = bh >> 2, head = bh & 3, dh = wid >> 2;
        const size_t row0 = (size_t)b * SEQ + rb * 128 + (wid & 3) * 32;
        const __amdgpu_buffer_rsrc_t rso = mk_rsrc(oc + row0 * DM + head * 256 + dh * 128);
        f32x16 o[4]; float m_reg, l_reg;
        if (u == vcu0) TS(p, 10);
        CC::run(o, m_reg, l_reg, qc + row0 * DM + head * 256, DM, kvm + (size_t)b * MEML * 2048 + head * 256, kvm + (size_t)b * MEML * 2048 + 1024 + head * 256, 2048, (PROBE_XT ? 2 : 1) * (MEML / 64), lds, (CC::lptr)(__attribute__((address_space(3))) void*)ldsL, SCR, dh * 4);
        if (u == vcu0) TS(p, 11);
        if (hi == 0) wsf[r32] = l_reg;
        asm volatile("s_waitcnt lgkmcnt(0)" ::: "memory");
#pragma unroll
        for (int r = 0; r < 16; ++r) { const float rl = 1.0f / wsf[crow(r, hi)];
#pragma unroll
            for (int d0 = 0; d0 < 4; ++d0) { const float y = o[d0][r] * rl; const float yn = __shfl_xor(y, 1);
                if ((r32 & 1) == 0) __builtin_amdgcn_raw_buffer_store_b32(cvtpk(y, yn), rso, ovoff, (((r & 3) + 8 * (r >> 2)) * DM + d0 * 32) * 2, 0); } }
        asm volatile("s_waitcnt vmcnt(0) lgkmcnt(0)" ::: "memory");
        if (u == vcu0) TS(p, 12);
    }
}
#define GAS __attribute__((address_space(1)))
typedef GAS unsigned gu32;
constexpr int CW_BAR = 4096;
constexpr size_t CTL_ZERO_BYTES = 65536;
constexpr int MISC_OFF = 131072 + 320, TAB_OFF = 131072 + 1024;
constexpr int CW_PANEL = 8192;
constexpr size_t WS_XCH = 60 * MiB;
#define XB_TMO      128
#define XB_XCNT(j)  (256  + 64 * (j))
#define XB_XSUB(j)  (1280 + 64 * (j))
#define XB_XGEN(j)  (2304 + 64 * (j))
#define XB_TOP      3328
#define XB_TOPGEN   3392
#define XCD_BAR_WORDS 3456
#define XB_SPIN_CAP (1u << 18)

__device__ __forceinline__ unsigned xb_ld(unsigned* p)              { return __hip_atomic_load(p, __ATOMIC_RELAXED, __HIP_MEMORY_SCOPE_AGENT); }
__device__ __forceinline__ unsigned xb_add(unsigned* p, unsigned v) { return __hip_atomic_fetch_add(p, v, __ATOMIC_RELAXED, __HIP_MEMORY_SCOPE_AGENT); }
__device__ __forceinline__ unsigned xb_xcc_id() { return (unsigned)__builtin_amdgcn_s_getreg((3 << 11) | 20) & 0xFu; }
#define XB_SPIN(cond, bar) do { unsigned _sp = 0; while (cond) { __builtin_amdgcn_s_sleep(1); \
    if ((++_sp & 255u) == 0u) { if (xb_ld(&(bar)[XB_TMO])) break; if (_sp > XB_SPIN_CAP) { atomicAdd(&(bar)[XB_TMO], 1u); break; } } } } while (0)

struct XcdBarrier {
    unsigned* bar; unsigned x;
    volatile LAS unsigned* st;
};

__device__ __forceinline__ XcdBarrier xcd_barrier_post(unsigned* bar, volatile LAS unsigned* st) {
    XcdBarrier b; b.bar = bar; b.x = xb_xcc_id(); b.st = st;
    if (threadIdx.x == 0) (void)xb_add(&bar[XB_XCNT(b.x)], 1u);
    return b;
}
__device__ __forceinline__ void xcd_barrier_complete(unsigned* bar, unsigned x, unsigned& nloc, unsigned& nx) {
    const unsigned G = gridDim.x * gridDim.y * gridDim.z;
    unsigned sum, cnt, mine, sp = 0u;
    for (;;) {
        sum = 0u; cnt = 0u; mine = 0u;
#pragma unroll
        for (unsigned j = 0; j < 16; ++j) { const unsigned c = xb_ld(&bar[XB_XCNT(j)]); sum += c; cnt += (c > 0u) ? 1u : 0u; mine = (j == x) ? c : mine; }
        if (sum == G) break;
        __builtin_amdgcn_s_sleep(1);
        if ((++sp & 255u) == 0u) { if (xb_ld(&bar[XB_TMO])) break; if (sp > XB_SPIN_CAP) { atomicAdd(&bar[XB_TMO], 1u); break; } }
    }
    nloc = mine > 0u ? mine : 1u; nx = cnt > 0u ? cnt : 1u;
}

__device__ __forceinline__ void xcd_barrier(const XcdBarrier& b) {
    asm volatile("s_waitcnt vmcnt(0)" ::: "memory");
    __syncthreads();
    if (threadIdx.x == 0) {
        unsigned* bar = b.bar;
        __builtin_amdgcn_s_waitcnt(0);
        unsigned nloc = b.st[0], nx = b.st[1];
        if (nloc == 0u) { xcd_barrier_complete(bar, b.x, nloc, nx); b.st[0] = nloc; b.st[1] = nx; }
        const unsigned old = xb_add(&bar[XB_XSUB(b.x)], 1u);
        const unsigned gen = old / nloc;
        if (old + 1u == (gen + 1u) * nloc) {
            __builtin_amdgcn_fence(__ATOMIC_RELEASE, "agent");
            asm volatile("s_waitcnt vmcnt(0)" ::: "memory");
            const unsigned og = xb_add(&bar[XB_TOP], 1u);
            const unsigned tg = og / nx;
            if (og + 1u == (tg + 1u) * nx) xb_add(&bar[XB_TOPGEN], 1u);
            else XB_SPIN(xb_ld(&bar[XB_TOPGEN]) == tg, bar);
            __builtin_amdgcn_fence(__ATOMIC_ACQUIRE, "agent");
            xb_add(&bar[XB_XGEN(b.x)], 1u);
            asm volatile("s_waitcnt vmcnt(0)" ::: "memory");
        } else {
            XB_SPIN(xb_ld(&bar[XB_XGEN(b.x)]) == gen, bar);
            __builtin_amdgcn_fence(__ATOMIC_ACQUIRE, "agent");
            asm volatile("s_waitcnt vmcnt(0)" ::: "memory");
        }
    }
    __syncthreads();
}

constexpr int LDS_BYTES = 147456;
constexpr size_t WS_SS3 = 58 * MiB;
__device__ __forceinline__ void final_norm_ss(float* X, const float* ss, const float* g, int gw, int ngw, int lane) {
    for (int m = gw; m < M; m += ngw) {
        const float rstd = pg8::rstd_ss(ss, m);
        f32x4* xr = (f32x4*)(X + (size_t)m * DM) + lane;
#pragma unroll
        for (int j = 0; j < 4; ++j) { const f32x4 gg = ((const f32x4*)g)[lane + 64 * j]; xr[64 * j] = xr[64 * j] * rstd * gg; }
    }
}
constexpr int N_PHASES = 10;
__global__ void __launch_bounds__(NTHR, 2) fwd_kernel(Params p) {
    extern __shared__ __attribute__((aligned(16))) unsigned char lds_raw[];
    LAS unsigned char* lds = (LAS unsigned char*)lds_raw;
    for (int u = threadIdx.x; u < 64; u += NTHR) ((LAS unsigned*)(lds + MISC_OFF))[u] = 0u;
    __syncthreads();
    XcdBarrier bar = xcd_barrier_post((unsigned*)(p.ws + WS_CTL) + CW_BAR, (volatile LAS unsigned*)(lds + MISC_OFF) + 8);
    const int tid = threadIdx.x, wave = __builtin_amdgcn_readfirstlane(tid >> 6), lane = tid & 63, bid = blockIdx.x, nblk = gridDim.x;
    const int gw = bid * NWAVES + wave, ngw = nblk * NWAVES;
    const int vcu = (nblk % 8 == 0) ? (bid % 8) * (nblk / 8) + bid / 8 : bid;
    unsigned char* ws = p.ws;
    const int lo = p.ph_lo, hi = p.ph_hi;
    typedef pg8::bf16_t b16;
    TS(p, 0);
#if PROBE_TS
    if (bid == 0 && tid == 0) g_probe_ws = p.ws;
#endif
#define IN(k) (lo <= (k) && (k) < hi)
#define SEAM(k) do { if (IN(k) && IN((k) + 1) && !((k) == 8 && nblk == 256)) xcd_barrier(bar); TS(p, (k) + 1); } while (0)
#ifndef PROBE_REP
#define PROBE_REP -1
#endif
#define REPS(k) for (int rep_ = 0; rep_ < ((k) == PROBE_REP ? 2 : 1); ++rep_, ((k) == PROBE_REP && rep_ < 2 ? xcd_barrier(bar) : (void)0))
    if (IN(0)) REPS(0) { p0_prologue(p, lds, bid, nblk, tid); TS(p, 23); } SEAM(0);
    if (IN(1)) REPS(1) {
        pg8::Gemm g{(const b16*)(ws + WS_XN), (const b16*)(ws + WS_WIN), (const b16*)(ws + WS_MEMN), (const b16*)(ws + WS_WCKV), DM};
        pg8::TwoOrder S; S.init(M, NP, nblk, bid); S.n2M = MM / 256; S.n2N = 2048 / 256;
        pg8::EpiProj E{(b16*)(ws + WS_PROJ), (b16*)(ws + WS_KVM), (const float*)(ws + WS_ROPE)};
        pg8::gemm_phase<pg8::EpiProj, pg8::TwoOrder, true, true>(lds, g, S, E);
    } SEAM(1);
    if (IN(2)) REPS(2) { attn_phase(p, (char*)lds_raw, vcu, nblk);
#ifdef FA_NO_SWA
        swa_naive(p, bid, nblk, tid);
#endif
#ifdef FA_NO_DIFF
        diff_naive(p, bid, nblk, tid); xcd_barrier(bar); diff_combine_naive(p, gw, ngw, lane);
#endif
    } SEAM(2);
    if (IN(3)) REPS(3) {
        pg8::Gemm g{(const b16*)(ws + WS_ATT), (const b16*)(ws + WS_WOUT), nullptr, nullptr, DM};
        pg8::StaticOrder S; S.init(M, DM, nblk, bid);
        pg8::EpiResB<true> E{p.x, nullptr, (b16*)(ws + WS_XN), (float*)(ws + WS_SS1)};
        pg8::gemm_phase<pg8::EpiResB<true>, pg8::StaticOrder, true, true>(lds, g, S, E);
    } SEAM(3);
    if (IN(4)) REPS(4) {
        pg8::Gemm g{(const b16*)(ws + WS_XN), (const b16*)(ws + WS_WCQ), nullptr, nullptr, DM};
        pg8::StaticOrder S; S.init(M, DM, nblk, bid);
        pg8::EpiScaleBf16<0> E{(b16*)(ws + WS_QC), DM, (const float*)(ws + WS_SS1), CQ, lds + TAB_OFF};
        pg8::gemm_phase<pg8::EpiScaleBf16<0>, pg8::StaticOrder, true, true>(lds, g, S, E);
    } SEAM(4);
    if (IN(5)) REPS(5) { cross_phase(p, (char*)lds_raw, lds, vcu, nblk); } SEAM(5);
    if (IN(6)) REPS(6) {
        pg8::Gemm g{(const b16*)(ws + WS_OC), (const b16*)(ws + WS_WCO), nullptr, nullptr, DM};
        pg8::StaticOrder S; S.init(M, DM, nblk, bid);
        pg8::EpiResB<false> E{nullptr, (const b16*)(ws + WS_XN), (b16*)(ws + WS_XN), (float*)(ws + WS_SS2)};
        pg8::gemm_phase<pg8::EpiResB<false>, pg8::StaticOrder, true, true>(lds, g, S, E);
    } SEAM(6);
    if (IN(7)) REPS(7) {
        pg8::Gemm g{(const b16*)(ws + WS_XN), (const b16*)(ws + WS_WUP), nullptr, nullptr, DM};
        pg8::StaticOrder S; S.init(M, FF, nblk, bid);
        pg8::EpiScaleBf16<1> E{(b16*)(ws + WS_ACT), FF, (const float*)(ws + WS_SS2), 1.f, lds + TAB_OFF};
        pg8::gemm_phase<pg8::EpiScaleBf16<1>, pg8::StaticOrder, true, true>(lds, g, S, E);
    } SEAM(7);
    if (IN(8)) REPS(8) {
        pg8::Gemm g{(const b16*)(ws + WS_ACT), (const b16*)(ws + WS_WDOWN), nullptr, nullptr, FF};
        pg8::StaticOrder S; S.init(M, DM, nblk, bid);
        if (nblk == 256) {
            pg8::EpiFinal E{(const b16*)(ws + WS_XN), p.out, p.g_final, (unsigned*)(ws + WS_XCH), (unsigned*)(ws + WS_CTL) + CW_PANEL, lds + TAB_OFF};
            pg8::gemm_phase<pg8::EpiFinal, pg8::StaticOrder, true, true>(lds, g, S, E);
        } else {
            pg8::EpiResF E{(const b16*)(ws + WS_XN), p.out, (float*)(ws + WS_SS3)};
            pg8::gemm_phase<pg8::EpiResF, pg8::StaticOrder, true, true>(lds, g, S, E);
        }
    } SEAM(8);
    if (IN(9) && nblk != 256) REPS(9) { final_norm_ss(p.out, (const float*)(ws + WS_SS3), p.g_final, gw, ngw, lane); }
#if PROBE_TS
    if (bid == 0 && tid == 0) { volatile unsigned long long* ts = (volatile unsigned long long*)(p.ws + 1024); const unsigned long long d = ts[PROBE_TS_B] - ts[PROBE_TS_A], t0 = __builtin_amdgcn_s_memrealtime();
        while (__builtin_amdgcn_s_memrealtime() - t0 < 16ull * d) __builtin_amdgcn_s_sleep(8); }
#endif
#undef IN
#undef SEAM
}

extern "C" void kernel_launch(void* const* d_in, const int* in_sizes, int n_in, void* d_out, int out_size, void* d_ws, size_t ws_size, hipStream_t stream) {
    static int grid = 0;
    if (grid == 0) {
        if (n_in != 21 || out_size != M * DM || ws_size < WS_END) { fprintf(stderr, "kernel_launch: unexpected shapes (n_in %d out %d ws %zu)\n", n_in, out_size, ws_size); grid = -1; return; }
        int dev = 0, cus = 0, per_cu = 0;
        (void)hipGetDevice(&dev); (void)hipDeviceGetAttribute(&cus, hipDeviceAttributeMultiprocessorCount, dev);
        if (hipFuncSetAttribute((const void*)fwd_kernel, hipFuncAttributeMaxDynamicSharedMemorySize, LDS_BYTES) != hipSuccess) { fprintf(stderr, "kernel_launch: hipFuncSetAttribute failed\n"); grid = -1; return; }
        (void)hipOccupancyMaxActiveBlocksPerMultiprocessor(&per_cu, (const void*)fwd_kernel, NTHR, LDS_BYTES);
        if (per_cu < 1) { fprintf(stderr, "kernel_launch: occupancy query says %d blocks per CU\n", per_cu); per_cu = 1; }
        grid = cus;
    }
    if (grid < 0) return;
    Params p{};
    p.x = (const float*)d_in[0]; p.mem = (const float*)d_in[1]; p.pos = (const int*)d_in[2]; p.g_mix = (const float*)d_in[3]; p.w_in = (const float*)d_in[4];
    p.sinks = (const float*)d_in[5]; p.lq1 = (const float*)d_in[6]; p.lk1 = (const float*)d_in[7]; p.lq2 = (const float*)d_in[8]; p.lk2 = (const float*)d_in[9];
    p.g_diff = (const float*)d_in[10]; p.w_out = (const float*)d_in[11]; p.g_cross = (const float*)d_in[12]; p.g_mem = (const float*)d_in[13]; p.w_cq = (const float*)d_in[14];
    p.w_ckv = (const float*)d_in[15]; p.w_co = (const float*)d_in[16]; p.g_mlp = (const float*)d_in[17]; p.w_up = (const float*)d_in[18]; p.w_down = (const float*)d_in[19]; p.g_final = (const float*)d_in[20];
    p.out = (float*)d_out; p.ws = (unsigned char*)d_ws;
    if (hipMemsetAsync((char*)d_ws + WS_CTL, 0, CTL_ZERO_BYTES, stream) != hipSuccess) { fprintf(stderr, "kernel_launch: hipMemsetAsync of the control words failed\n"); return; }
    p.ph_lo = 0; p.ph_hi = N_PHASES;
    hipLaunchKernelGGL(fwd_kernel, dim3(grid), dim3(NTHR), LDS_BYTES, stream, p);
}
```

```cpp
#include <hip/hip_runtime.h>
#include <cstdio>
#include <cstdint>


#define LAS __attribute__((address_space(3)))
typedef unsigned short bf16;
typedef short bf16x8 __attribute__((ext_vector_type(8)));
typedef float f32x4 __attribute__((ext_vector_type(4)));
typedef unsigned u32x4 __attribute__((ext_vector_type(4)));
typedef unsigned u32x2 __attribute__((ext_vector_type(2)));

constexpr int BATCH = 8, SEQ = 4096, M = BATCH * SEQ, DM = 1024, NP = 2304, MEML = 256, MM = BATCH * MEML, FF = 4096;
constexpr int NWAVES = 8, NTHR = NWAVES * 64;
constexpr float EPS = 1e-5f;
constexpr float LOG2E = 1.4426950408889634f;
constexpr float C2 = 0.125f * LOG2E;
constexpr float CQ = 0.0625f * LOG2E;
constexpr int C_QA = 0, C_KA = 512, C_VA = 640, C_QD = 768, C_KD = 1280, C_VD = 1792;

constexpr size_t MiB = 1u << 20;
constexpr size_t WS_CTL = 0;
constexpr size_t WS_WIN = 2 * MiB;
constexpr size_t WS_WOUT = WS_WIN + (size_t)NP * DM * 2;
constexpr size_t WS_WCQ = WS_WOUT + 2 * MiB;
constexpr size_t WS_WCKV = WS_WCQ + 2 * MiB;
constexpr size_t WS_WCO = WS_WCKV + 4 * MiB;
constexpr size_t WS_WUP = WS_WCO + 2 * MiB;
constexpr size_t WS_WDOWN = WS_WUP + 8 * MiB;
constexpr size_t WS_ROPE = 34 * MiB;
constexpr size_t WS_KVM = 42 * MiB;
constexpr size_t WS_MEMN = 50 * MiB;
constexpr size_t WS_SS1 = 54 * MiB, WS_SS2 = 56 * MiB;
constexpr size_t WS_XN = 64 * MiB;
constexpr size_t WS_PROJ = 256 * MiB;
constexpr size_t WS_ATT = 400 * MiB;
constexpr size_t WS_QC = 256 * MiB;
constexpr size_t WS_OC = 320 * MiB;
constexpr size_t WS_ACT = 256 * MiB;
constexpr size_t WS_END = 512 * MiB;
static_assert(WS_WDOWN + 8 * MiB <= WS_ROPE, "weights fit");

struct Params {
    const float *x, *mem; const int* pos;
    const float *g_mix, *w_in, *sinks, *lq1, *lk1, *lq2, *lk2, *g_diff, *w_out, *g_cross, *g_mem, *w_cq, *w_ckv, *w_co, *g_mlp, *w_up, *w_down, *g_final;
    float* out; unsigned char* ws; int ph_lo, ph_hi;
};

__device__ __forceinline__ unsigned f2bf(float f) { unsigned u = __builtin_bit_cast(unsigned, f); return (u + 0x7fffu + ((u >> 16) & 1u)) >> 16; }
__device__ __forceinline__ unsigned pk2(float lo, float hi) { return f2bf(lo) | (f2bf(hi) << 16); }
__device__ __forceinline__ float bf2f(unsigned h) { return __builtin_bit_cast(float, h << 16); }
__device__ __forceinline__ float bflo(unsigned w) { return __builtin_bit_cast(float, w << 16); }
__device__ __forceinline__ float bfhi(unsigned w) { return __builtin_bit_cast(float, w & 0xffff0000u); }
__device__ __forceinline__ float wave_sum(float v) {
#pragma unroll
    for (int o = 1; o < 64; o <<= 1) v += __shfl_xor(v, o);
    return v;
}
__device__ __forceinline__ float wave_max(float v) {
#pragma unroll
    for (int o = 1; o < 64; o <<= 1) v = fmaxf(v, __shfl_xor(v, o));
    return v;
}
__host__ __device__ __forceinline__ bool col_roped(int n) { return n < C_VA || (n >= C_QD && n < C_VD); }
__host__ __device__ __forceinline__ int phys_of_logical(int nl) {
    if (!col_roped(nl)) return nl;
    const int g = nl & ~63, j = nl & 63; return g + ((j & 31) << 1) + (j >> 5);
}
__device__ __forceinline__ float calc_lambda(const Params& p) {
    float a = 0.f, b = 0.f;
    for (int i = 0; i < 64; ++i) { a += p.lq1[i] * p.lk1[i]; b += p.lq2[i] * p.lk2[i]; }
    return __expf(a) - __expf(b) + 0.2f;
}

__device__ const double INV_FREQ[32] = {
    1.0, 0.7498942093324559, 0.5623413251903491, 0.4216965034285822,
    0.31622776601683794, 0.23713737056616552, 0.1778279410038923, 0.1333521432163324,
    0.1, 0.07498942093324558, 0.05623413251903491, 0.042169650342858224,
    0.03162277660168379, 0.023713737056616554, 0.01778279410038923, 0.01333521432163324,
    0.01, 0.007498942093324558, 0.005623413251903491, 0.004216965034285823,
    0.0031622776601683794, 0.0023713737056616554, 0.0017782794100389228, 0.001333521432163324,
    0.001, 0.0007498942093324559, 0.0005623413251903491, 0.00042169650342858224,
    0.00031622776601683794, 0.00023713737056616554, 0.00017782794100389227, 0.0001333521432163324};

__device__ __forceinline__ void sincos_d(double a, float& c, float& s) {
    const double kd = rint(a * 0.63661977236758134308);
    const int k = (int)kd;
    double r = fma(-kd, 1.57079632679489655800e+00, a); r = fma(-kd, 6.12323399573676603587e-17, r);
    const double r2 = r * r;
    const double sp = r * (1.0 + r2 * (-1.0 / 6.0 + r2 * (1.0 / 120.0 + r2 * (-1.0 / 5040.0 + r2 * (1.0 / 362880.0 + r2 * (-1.0 / 39916800.0 + r2 * (1.0 / 6227020800.0)))))));
    const double cp = 1.0 + r2 * (-0.5 + r2 * (1.0 / 24.0 + r2 * (-1.0 / 720.0 + r2 * (1.0 / 40320.0 + r2 * (-1.0 / 3628800.0 + r2 * (1.0 / 479001600.0 + r2 * (-1.0 / 87178291200.0)))))));
    const int q = k & 3;
    const double ss = (q == 0) ? sp : (q == 1) ? cp : (q == 2) ? -sp : -cp;
    const double cc = (q == 0) ? cp : (q == 1) ? -sp : (q == 2) ? -cp : sp;
    c = (float)cc; s = (float)ss;
}

template <bool HASG, bool PERMC>
__device__ __forceinline__ void transpose_item(const float* W, int K, int N, const float* g, bf16* WT, LAS float* scr, int item, int lane) {
    const int nblk = N / 32, kb = item / nblk, nb = item % nblk, k0 = 64 * kb, n0 = 32 * nb;
#pragma unroll 16
    for (int i = 0; i < 32; ++i) { const int kk = 2 * i + (lane >> 5); float v = W[(size_t)(k0 + kk) * N + n0 + (lane & 31)]; if (HASG) v *= g[k0 + kk]; scr[kk * 33 + (lane & 31)] = v; }
    asm volatile("s_waitcnt lgkmcnt(0)" ::: "memory");
    const int c = lane & 7;
#pragma unroll
    for (int j = 0; j < 4; ++j) { const int n = (lane >> 3) + 8 * j; const LAS float* s = scr + (8 * c) * 33 + n;
        u32x4 o; o.x = pk2(s[0 * 33], s[1 * 33]); o.y = pk2(s[2 * 33], s[3 * 33]); o.z = pk2(s[4 * 33], s[5 * 33]); o.w = pk2(s[6 * 33], s[7 * 33]);
        const int nl = n0 + n, np = PERMC ? phys_of_logical(nl) : nl;
        *(u32x4*)(WT + (size_t)np * K + k0 + 8 * c) = o; }
    asm volatile("s_waitcnt lgkmcnt(0)" ::: "memory");
}
__device__ __forceinline__ void rms_row_to_bf16(const float* xrow, const float* g, bf16* orow, int lane) {
    const f32x4* xr = (const f32x4*)xrow + lane;
    f32x4 v[4]; float s = 0.f;
#pragma unroll
    for (int j = 0; j < 4; ++j) { v[j] = xr[64 * j]; s += (v[j].x * v[j].x + v[j].y * v[j].y) + (v[j].z * v[j].z + v[j].w * v[j].w); }
    const float rstd = 1.0f / sqrtf(wave_sum(s) * (1.f / DM) + EPS);
    u32x2* o8 = (u32x2*)orow + lane;
#pragma unroll
    for (int j = 0; j < 4; ++j) {
        f32x4 gg = (f32x4){1.f, 1.f, 1.f, 1.f}; if (g) gg = ((const f32x4*)g)[lane + 64 * j];
        u32x2 w; w.x = pk2(v[j].x * rstd * gg.x, v[j].y * rstd * gg.y); w.y = pk2(v[j].z * rstd * gg.z, v[j].w * rstd * gg.w); o8[64 * j] = w; }
}
__device__ __forceinline__ void p0_prologue(const Params& p, LAS unsigned char* lds, int bid, int nblk, int tid) {
    const int wave = tid >> 6, lane = tid & 63;
    LAS float* scr = (LAS float*)(lds + wave * 8704);
    const int gw = bid * NWAVES + wave, NGW = nblk * NWAVES;
    unsigned char* ws = p.ws;
    constexpr int I_IN = (DM / 64) * (NP / 32), I_SQ = (DM / 64) * (DM / 32), I_KV = (DM / 64) * (2048 / 32), I_UP = (DM / 64) * (FF / 32), I_DN = (FF / 64) * (DM / 32);
    constexpr int NITEMS = I_IN + 3 * I_SQ + I_KV + I_UP + I_DN;
    for (int it = gw; it < NITEMS; it += NGW) {
        int r = it;
        if (r < I_IN) { transpose_item<true, true>(p.w_in, DM, NP, p.g_mix, (bf16*)(ws + WS_WIN), scr, r, lane); continue; } r -= I_IN;
        if (r < I_SQ) { transpose_item<false, false>(p.w_out, DM, DM, nullptr, (bf16*)(ws + WS_WOUT), scr, r, lane); continue; } r -= I_SQ;
        if (r < I_SQ) { transpose_item<true, false>(p.w_cq, DM, DM, p.g_cross, (bf16*)(ws + WS_WCQ), scr, r, lane); continue; } r -= I_SQ;
        if (r < I_KV) { transpose_item<false, false>(p.w_ckv, DM, 2048, nullptr, (bf16*)(ws + WS_WCKV), scr, r, lane); continue; } r -= I_KV;
        if (r < I_SQ) { transpose_item<false, false>(p.w_co, DM, DM, nullptr, (bf16*)(ws + WS_WCO), scr, r, lane); continue; } r -= I_SQ;
        if (r < I_UP) { transpose_item<true, false>(p.w_up, DM, FF, p.g_mlp, (bf16*)(ws + WS_WUP), scr, r, lane); continue; } r -= I_UP;
        transpose_item<false, false>(p.w_down, FF, DM, nullptr, (bf16*)(ws + WS_WDOWN), scr, r, lane);
    }
    for (int m = gw * 2; m < M; m += NGW * 2) {
        const f32x4* x0 = (const f32x4*)(p.x + (size_t)m * DM) + lane; const f32x4* x1 = x0 + DM / 4;
        f32x4 v0[4], v1[4]; float s0 = 0.f, s1 = 0.f;
#pragma unroll
        for (int j = 0; j < 4; ++j) { v0[j] = x0[64 * j]; v1[j] = x1[64 * j]; }
#pragma unroll
        for (int j = 0; j < 4; ++j) { s0 += (v0[j].x * v0[j].x + v0[j].y * v0[j].y) + (v0[j].z * v0[j].z + v0[j].w * v0[j].w); s1 += (v1[j].x * v1[j].x + v1[j].y * v1[j].y) + (v1[j].z * v1[j].z + v1[j].w * v1[j].w); }
#pragma unroll
        for (int o = 1; o < 64; o <<= 1) { s0 += __shfl_xor(s0, o); s1 += __shfl_xor(s1, o); }
        const float r0 = 1.0f / sqrtf(s0 * (1.f / DM) + EPS), r1 = 1.0f / sqrtf(s1 * (1.f / DM) + EPS);
        u32x2* o0 = (u32x2*)((bf16*)(ws + WS_XN) + (size_t)m * DM) + lane; u32x2* o1 = o0 + DM / 4;
#pragma unroll
        for (int j = 0; j < 4; ++j) { u32x2 w; w.x = pk2(v0[j].x * r0, v0[j].y * r0); w.y = pk2(v0[j].z * r0, v0[j].w * r0); o0[64 * j] = w;
            u32x2 z; z.x = pk2(v1[j].x * r1, v1[j].y * r1); z.y = pk2(v1[j].z * r1, v1[j].w * r1); o1[64 * j] = z; }
    }
    for (int m = gw; m < MM; m += NGW) rms_row_to_bf16(p.mem + (size_t)m * DM, p.g_mem, (bf16*)(ws + WS_MEMN) + (size_t)m * DM, lane);
    float2* rope = (float2*)(ws + WS_ROPE);
    for (int i = bid * NTHR + tid; i < M * 32; i += nblk * NTHR) {
        const int row = i >> 5, d = i & 31; float c, s; sincos_d((double)p.pos[row] * INV_FREQ[d], c, s); rope[i] = make_float2(c, s); }
}

namespace pg8 {
#define PG8_LAS __attribute__((address_space(3)))
typedef unsigned short bf16_t;
typedef short bf16x8 __attribute__((ext_vector_type(8)));
typedef float f32x4 __attribute__((ext_vector_type(4)));
typedef unsigned u32x4 __attribute__((ext_vector_type(4)));
typedef unsigned u32x2 __attribute__((ext_vector_type(2)));
constexpr int BM = 256, BK = 64, HALF = 128, HTB = HALF * BK * 2  , STAGE_BYTES = 8 * HTB, NXCD = 8, WGM = 8;

__host__ __device__ __forceinline__ int lds_byte(int r, int c) { const int st = (r >> 4) * 2 + (c >> 5), rr = r & 15, cc = c & 31, ob = rr * 64 + cc * 2; return st * 1024 + (ob ^ (((ob >> 9) & 1) << 5)); }
__host__ __device__ __forceinline__ void stage_rc(int b, int& R, int& C) { const int st = b / 1024, sb = b % 1024, swz = sb ^ (((sb >> 9) & 1) << 5); R = (st >> 1) * 16 + swz / 64; C = (st & 1) * 32 + (swz % 64) / 2; }
__host__ __device__ __forceinline__ int perm32(int rho) { const int n = rho >> 4, i = rho & 15; return 8 * (i >> 2) + 4 * n + (i & 3); }

struct Unit { int pm, pn, alt; };
struct Gemm { const bf16_t* A; const bf16_t* Bt; const bf16_t* A2; const bf16_t* Bt2; int K; };

struct StaticOrder {
    int nM, nN, nwg, G, c;
    __host__ __device__ void init(int M_, int N_, int G_, int c_) { nM = M_ / BM; nN = N_ / BM; nwg = nM * nN; G = G_; c = c_; }
    __host__ __device__ bool map(long L, Unit& u) const {
        if (L >= nwg) return false;
        int wgid = (int)L; { const int q = nwg / NXCD, r = nwg % NXCD, xcd = wgid % NXCD, off = wgid / NXCD; wgid = (xcd < r ? xcd * (q + 1) : r * (q + 1) + (xcd - r) * q) + off; }
        const int nig = WGM * nN, gid = wgid / nig, fm = gid * WGM, gsz = (nM - fm) < WGM ? (nM - fm) : WGM;
        u.pm = fm + ((wgid % nig) % gsz); u.pn = (wgid % nig) / gsz; u.alt = 0; return true;
    }
    __host__ __device__ bool next(int i, Unit& u) const { return map((long)i * G + c, u); }
    __device__ __forceinline__ void a_ready(const Unit&) const {}
    __device__ __forceinline__ void done(const Unit&) const {}
};
struct TwoOrder : StaticOrder {
    int n2M, n2N;
    __host__ __device__ bool next(int i, Unit& u) const {
        const long L = (long)i * G + c;
        if (L < nwg) return map(L, u);
        const int r = (int)(L - nwg); if (r >= n2M * n2N) return false;
        u.pm = r % n2M; u.pn = r / n2M; u.alt = 1; return true;
    }
};
__device__ __forceinline__ unsigned cvt_pk_bf16(float lo, float hi) { unsigned r; asm volatile("v_cvt_pk_bf16_f32 %0, %1, %2" : "=v"(r) : "v"(lo), "v"(hi)); return r; }

__device__ __forceinline__ float rstd_ss(const float* ss, int row) {
    const f32x4* s4 = (const f32x4*)(ss + (size_t)row * 16); float t = 0.f;
#pragma unroll
    for (int i = 0; i < 4; ++i) { const f32x4 v = s4[i]; t += (v.x + v.y) + (v.z + v.w); }
    return 1.0f / sqrtf(t * (1.f / DM) + EPS);
}
struct EpiProj {
    static constexpr bool PERM = true, AFTER_DRAIN = false;
    bf16_t* proj; bf16_t* kvm; const float* rope;
    __device__ __forceinline__ void operator()(const f32x4 (&acc)[2][2][4][2], const Unit& u, int wr, int wc, int fr, int fq) const {
        const int row0 = u.pm * BM + wr * 64 + fr, col0 = u.pn * BM + wc * 32 + 8 * fq;
        if (u.alt) {
#pragma unroll
            for (int ai = 0; ai < 2; ++ai)
#pragma unroll
                for (int m = 0; m < 4; ++m) { bf16_t* rowp = kvm + (size_t)(row0 + ai * HALF + m * 16) * 2048 + col0;
#pragma unroll
                    for (int bj = 0; bj < 2; ++bj) { const f32x4 v0 = acc[ai][bj][m][0], v1 = acc[ai][bj][m][1];
                        u32x4 w; w.x = cvt_pk_bf16(v0[0], v0[1]); w.y = cvt_pk_bf16(v0[2], v0[3]); w.z = cvt_pk_bf16(v1[0], v1[1]); w.w = cvt_pk_bf16(v1[2], v1[3]);
                        *(u32x4*)(rowp + bj * HALF) = w; } }
            return;
        }
        const int d0 = ((wc & 1) * 32 + 8 * fq) >> 1;
#pragma unroll
        for (int ai = 0; ai < 2; ++ai) {
            f32x4 csa[4], csb[4];
#pragma unroll
            for (int m = 0; m < 4; ++m) { const size_t ro = (size_t)(row0 + ai * HALF + m * 16) * 64 + 2 * d0; csa[m] = *(const f32x4*)(rope + ro); csb[m] = *(const f32x4*)(rope + ro + 4); }
#pragma unroll
            for (int m = 0; m < 4; ++m) { const int row = row0 + ai * HALF + m * 16;
                const f32x4 cs0 = csa[m], cs1 = csb[m];
#pragma unroll
                for (int bj = 0; bj < 2; ++bj) { const int cb = u.pn * BM + bj * HALF;
                    const bool roped = col_roped(cb); const float sc = (cb < C_KA || (cb >= C_QD && cb < C_KD)) ? C2 : 1.f;
                    f32x4 v0 = acc[ai][bj][m][0], v1 = acc[ai][bj][m][1];
                    if (roped) {
                        const f32x4 a = v0, b = v1;
                        v0[0] = a[0] * cs0[0] - a[1] * cs0[1]; v0[1] = a[1] * cs0[0] + a[0] * cs0[1];
                        v0[2] = a[2] * cs0[2] - a[3] * cs0[3]; v0[3] = a[3] * cs0[2] + a[2] * cs0[3];
                        v1[0] = b[0] * cs1[0] - b[1] * cs1[1]; v1[1] = b[1] * cs1[0] + b[0] * cs1[1];
                        v1[2] = b[2] * cs1[2] - b[3] * cs1[3]; v1[3] = b[3] * cs1[2] + b[2] * cs1[3];
                    }
                    v0 = v0 * sc; v1 = v1 * sc;
                    u32x4 w; w.x = cvt_pk_bf16(v0[0], v0[1]); w.y = cvt_pk_bf16(v0[2], v0[3]); w.z = cvt_pk_bf16(v1[0], v1[1]); w.w = cvt_pk_bf16(v1[2], v1[3]);
                    *(u32x4*)(proj + (size_t)row * NP + col0 + bj * HALF) = w; } }
        }
    }
};
struct EpiRes {
    static constexpr bool PERM = false, AFTER_DRAIN = false;
    const float* xi; float* xo; bf16_t* xb; float* ss;
    __device__ __forceinline__ void operator()(const f32x4 (&acc)[2][2][4][2], const Unit& u, int wr, int wc, int fr, int fq) const {
        const int row0 = u.pm * BM + wr * 64 + fr, col0 = u.pn * BM + wc * 32 + 4 * fq;
#pragma unroll
        for (int ai = 0; ai < 2; ++ai)
#pragma unroll
            for (int m = 0; m < 4; ++m) { const int row = row0 + ai * HALF + m * 16; const size_t off = (size_t)row * DM + col0; float q = 0.f;
#pragma unroll
                for (int bj = 0; bj < 2; ++bj)
#pragma unroll
                    for (int n = 0; n < 2; ++n) { const size_t c = off + bj * HALF + n * 16; const f32x4 r = *(const f32x4*)(xi + c) + acc[ai][bj][m][n];
                        *(f32x4*)(xo + c) = r; q += (r[0] * r[0] + r[1] * r[1]) + (r[2] * r[2] + r[3] * r[3]);
                        if (xb) { u32x2 w; w.x = cvt_pk_bf16(r[0], r[1]); w.y = cvt_pk_bf16(r[2], r[3]); *(u32x2*)(xb + c) = w; } }
                q += __shfl_xor(q, 16); q += __shfl_xor(q, 32);
                if (fq == 0) ss[(size_t)row * 16 + u.pn * 4 + wc] = q;
                if (m & 1) asm volatile("" ::: "memory"); }
    }
};
template <bool XF> struct EpiResB {
    static constexpr bool PERM = true, AFTER_DRAIN = false;
    const float* xf; const bf16_t* xb_in; bf16_t* xb_out; float* ss;
    __device__ __forceinline__ void operator()(const f32x4 (&acc)[2][2][4][2], const Unit& u, int wr, int wc, int fr, int fq) const {
        const int row0 = u.pm * BM + wr * 64 + fr, col0 = u.pn * BM + wc * 32 + 8 * fq;
#pragma unroll
        for (int ai = 0; ai < 2; ++ai) {
            u32x4 pre[4][2];
            if (!XF) {
#pragma unroll
                for (int m = 0; m < 4; ++m)
#pragma unroll
                    for (int bj = 0; bj < 2; ++bj) pre[m][bj] = *(const u32x4*)(xb_in + (size_t)(row0 + ai * HALF + m * 16) * DM + col0 + bj * HALF); }
#pragma unroll
            for (int m = 0; m < 4; ++m) { const int row = row0 + ai * HALF + m * 16; const size_t off = (size_t)row * DM + col0; float q = 0.f;
#pragma unroll
                for (int bj = 0; bj < 2; ++bj) { f32x4 r0, r1;
                    if (XF) { r0 = *(const f32x4*)(xf + off + bj * HALF); r1 = *(const f32x4*)(xf + off + bj * HALF + 4); }
                    else { const u32x4 w = pre[m][bj];
                        r0 = (f32x4){__uint_as_float(w.x << 16), __uint_as_float(w.x & 0xffff0000u), __uint_as_float(w.y << 16), __uint_as_float(w.y & 0xffff0000u)};
                        r1 = (f32x4){__uint_as_float(w.z << 16), __uint_as_float(w.z & 0xffff0000u), __uint_as_float(w.w << 16), __uint_as_float(w.w & 0xffff0000u)}; }
                    r0 = r0 + acc[ai][bj][m][0]; r1 = r1 + acc[ai][bj][m][1];
                    q += ((r0[0] * r0[0] + r0[1] * r0[1]) + (r0[2] * r0[2] + r0[3] * r0[3])) + ((r1[0] * r1[0] + r1[1] * r1[1]) + (r1[2] * r1[2] + r1[3] * r1[3]));
                    u32x4 w; w.x = cvt_pk_bf16(r0[0], r0[1]); w.y = cvt_pk_bf16(r0[2], r0[3]); w.z = cvt_pk_bf16(r1[0], r1[1]); w.w = cvt_pk_bf16(r1[2], r1[3]);
                    *(u32x4*)(xb_out + off + bj * HALF) = w; }
                q += __shfl_xor(q, 16); q += __shfl_xor(q, 32);
                if (fq == 0) ss[(size_t)row * 16 + u.pn * 4 + wc] = q; }
            asm volatile("" ::: "memory");
        }
    }
};
struct EpiResF {
    static constexpr bool PERM = false, AFTER_DRAIN = false;
    const bf16_t* xb; float* xo; float* ss;
    __device__ __forceinline__ void operator()(const f32x4 (&acc)[2][2][4][2], const Unit& u, int wr, int wc, int fr, int fq) const {
        const int row0 = u.pm * BM + wr * 64 + fr, col0 = u.pn * BM + wc * 32 + 4 * fq;
#pragma unroll
        for (int ai = 0; ai < 2; ++ai)
#pragma unroll
            for (int m = 0; m < 4; ++m) { const int row = row0 + ai * HALF + m * 16; const size_t off = (size_t)row * DM + col0; float q = 0.f;
#pragma unroll
                for (int bj = 0; bj < 2; ++bj)
#pragma unroll
                    for (int n = 0; n < 2; ++n) { const size_t c = off + bj * HALF + n * 16; const u32x2 w = *(const u32x2*)(xb + c);
                        const f32x4 r = (f32x4){__uint_as_float(w.x << 16), __uint_as_float(w.x & 0xffff0000u), __uint_as_float(w.y << 16), __uint_as_float(w.y & 0xffff0000u)} + acc[ai][bj][m][n];
                        *(f32x4*)(xo + c) = r; q += (r[0] * r[0] + r[1] * r[1]) + (r[2] * r[2] + r[3] * r[3]); }
                q += __shfl_xor(q, 16); q += __shfl_xor(q, 32);
                if (fq == 0) ss[(size_t)row * 16 + u.pn * 4 + wc] = q;
                if (m & 1) asm volatile("" ::: "memory"); }
    }
};
struct EpiFinal {
    static constexpr bool PERM = false, AFTER_DRAIN = false;
    const bf16_t* xb; float* out; const float* g; unsigned* xbuf; unsigned* cnt; PG8_LAS unsigned char* tab;
    __device__ __forceinline__ void operator()(f32x4 (&acc)[2][2][4][2], const Unit& u, int wr, int wc, int fr, int fq) const {
        const int tid = threadIdx.x, lane = tid & 63, wid = __builtin_amdgcn_readfirstlane(tid >> 6);
        PG8_LAS float* P = (PG8_LAS float*)tab; PG8_LAS float* S = (PG8_LAS float*)(tab + 4096);
        const int col0 = u.pn * BM + wc * 32 + 4 * fq;
#pragma unroll
        for (int ai = 0; ai < 2; ++ai)
#pragma unroll
            for (int m = 0; m < 4; ++m) { const int rl = ai * HALF + wr * 64 + m * 16 + fr; const size_t off = (size_t)(u.pm * BM + rl) * DM + col0; float q = 0.f;
#pragma unroll
                for (int bj = 0; bj < 2; ++bj)
#pragma unroll
                    for (int n = 0; n < 2; ++n) { const u32x2 w = *(const u32x2*)(xb + off + bj * HALF + n * 16);
                        const f32x4 r = (f32x4){__uint_as_float(w.x << 16), __uint_as_float(w.x & 0xffff0000u), __uint_as_float(w.y << 16), __uint_as_float(w.y & 0xffff0000u)} + acc[ai][bj][m][n];
                        acc[ai][bj][m][n] = r; q += (r[0] * r[0] + r[1] * r[1]) + (r[2] * r[2] + r[3] * r[3]); }
                q += __shfl_xor(q, 16); q += __shfl_xor(q, 32);
                if (fq == 0) P[rl * 4 + wc] = q;
                if (m & 1) asm volatile("" ::: "memory"); }
        asm volatile("s_waitcnt lgkmcnt(0)" ::: "memory"); __builtin_amdgcn_s_barrier(); asm volatile("" ::: "memory");
        unsigned* slot = xbuf + ((size_t)(u.pm * BM + (tid & 255)) * 4);
        if (tid < 256) { const f32x4 a = *(const PG8_LAS f32x4*)(P + tid * 4);
            __hip_atomic_store(slot + u.pn, __float_as_uint((a[0] + a[1]) + (a[2] + a[3])), __ATOMIC_RELAXED, __HIP_MEMORY_SCOPE_AGENT); }
        asm volatile("s_waitcnt vmcnt(0)" ::: "memory");
        if (tid < 256 && lane == 0) __hip_atomic_fetch_add(cnt + 64 * u.pm, 1u, __ATOMIC_RELAXED, __HIP_MEMORY_SCOPE_AGENT);
        if (wid == 0) {
            unsigned sp = 0;
            while ((unsigned)__builtin_amdgcn_readfirstlane(__hip_atomic_load(cnt + 64 * u.pm, __ATOMIC_RELAXED, __HIP_MEMORY_SCOPE_AGENT)) < 16u) { __builtin_amdgcn_s_sleep(2); if (++sp > (1u << 22)) break; }
            __builtin_amdgcn_fence(__ATOMIC_ACQUIRE, "agent");
        }
        asm volatile("s_waitcnt vmcnt(0) lgkmcnt(0)" ::: "memory"); __builtin_amdgcn_s_barrier(); asm volatile("" ::: "memory");
        if (tid < 256) { float t = 0.f;
#pragma unroll
            for (int k = 0; k < 4; ++k) t += __uint_as_float(__hip_atomic_load(slot + k, __ATOMIC_RELAXED, __HIP_MEMORY_SCOPE_AGENT));
            S[tid] = 1.0f / sqrtf(t * (1.f / DM) + EPS); }
        asm volatile("s_waitcnt lgkmcnt(0)" ::: "memory"); __builtin_amdgcn_s_barrier(); asm volatile("" ::: "memory");
        f32x4 gg[2][2];
#pragma unroll
        for (int bj = 0; bj < 2; ++bj)
#pragma unroll
            for (int n = 0; n < 2; ++n) gg[bj][n] = *(const f32x4*)(g + col0 + bj * HALF + n * 16);
#pragma unroll
        for (int ai = 0; ai < 2; ++ai)
#pragma unroll
            for (int m = 0; m < 4; ++m) { const int rl = ai * HALF + wr * 64 + m * 16 + fr; const size_t off = (size_t)(u.pm * BM + rl) * DM + col0; const float rs = S[rl];
#pragma unroll
                for (int bj = 0; bj < 2; ++bj)
#pragma unroll
                    for (int n = 0; n < 2; ++n) *(f32x4*)(out + off + bj * HALF + n * 16) = acc[ai][bj][m][n] * rs * gg[bj][n]; }
    }
};
template <int ACT> struct EpiScaleBf16 {
    static constexpr bool PERM = true, AFTER_DRAIN = false;
    bf16_t* O; int ldc; const float* ss; float mul; PG8_LAS unsigned char* tab;
    __device__ __forceinline__ void operator()(const f32x4 (&acc)[2][2][4][2], const Unit& u, int wr, int wc, int fr, int fq) const {
        const int tid = threadIdx.x; PG8_LAS float* S = (PG8_LAS float*)tab;
        if (tid < 256) S[tid] = rstd_ss(ss, u.pm * BM + tid) * mul;
        asm volatile("s_waitcnt lgkmcnt(0)" ::: "memory"); __builtin_amdgcn_s_barrier(); asm volatile("" ::: "memory");
        const int rl0 = wr * 64 + fr, col0 = u.pn * BM + wc * 32 + 8 * fq;
#pragma unroll
        for (int ai = 0; ai < 2; ++ai)
#pragma unroll
            for (int m = 0; m < 4; ++m) { const int rl = rl0 + ai * HALF + m * 16; const float rs = S[rl]; bf16_t* rowp = O + (size_t)(u.pm * BM + rl) * ldc + col0;
#pragma unroll
                for (int bj = 0; bj < 2; ++bj) { f32x4 v0 = acc[ai][bj][m][0] * rs, v1 = acc[ai][bj][m][1] * rs;
                    if (ACT == 1) {
#pragma unroll
                        for (int e = 0; e < 4; ++e) { const float a = fmaxf(v0[e], 0.f), b = fmaxf(v1[e], 0.f); v0[e] = a * a; v1[e] = b * b; } }
                    u32x4 w; w.x = cvt_pk_bf16(v0[0], v0[1]); w.y = cvt_pk_bf16(v0[2], v0[3]); w.z = cvt_pk_bf16(v1[0], v1[1]); w.w = cvt_pk_bf16(v1[2], v1[3]);
                    *(u32x4*)(rowp + bj * HALF) = w; } }
        __builtin_amdgcn_s_barrier();
    }
};

template <class Epi, class Sched, bool ALIGN_EPI = false, bool SP2 = false>
__device__ __forceinline__ void gemm_phase(PG8_LAS unsigned char* lds, const Gemm g, const Sched& S, const Epi& E) {
    const int tid = threadIdx.x, wid = __builtin_amdgcn_readfirstlane(tid >> 6), lane = tid & 63, wr = wid >> 2, wc = wid & 3, fr = lane & 15, fq = lane >> 4;
    const int K = g.K, nt = K / BK;
    unsigned voffA[2], voffB[2];
#pragma unroll
    for (int i = 0; i < 2; ++i) { int R, C; stage_rc(tid * 16 + i * 8192, R, C); const int Rb = Epi::PERM ? ((R & ~31) + perm32(R & 31)) : R;
        voffA[i] = (unsigned)(R * K + C) * 2u; voffB[i] = (unsigned)(Rb * K + C) * 2u; }
    const size_t kstep = (size_t)(BK * 2);
    const size_t hstep = (size_t)HALF * K * 2;
    const size_t tstep = 2 * hstep;
    const unsigned ldsw = (unsigned)wid * 1024u;
    const int aoff = lds_byte(wr * 64 + fr, fq * 8), boff = lds_byte(wc * 32 + fr, fq * 8);
#define PG8_SA(b, h) (((b) * 2 + (h)) * HTB)
#define PG8_SB(b, h) ((4 + (b) * 2 + (h)) * HTB)
#define PG8_STAGE(bufoff, gbase, voff) do { _Pragma("unroll") for (int _i = 0; _i < 2; ++_i) \
        __builtin_amdgcn_global_load_lds((const unsigned*)((const char*)(gbase) + (voff)[_i]), (PG8_LAS unsigned*)(lds + (bufoff) + ldsw + _i * 8192), 16, 0, 0); } while (0)
#define PG8_LDA(dst, b, h) do { _Pragma("unroll") for (int m = 0; m < 4; ++m) _Pragma("unroll") for (int k = 0; k < 2; ++k) dst[m][k] = *(const PG8_LAS bf16x8*)(lds + PG8_SA(b, h) + aoff + m * 2048 + k * 1024); } while (0)
#define PG8_LDB(dst, b, h) do { _Pragma("unroll") for (int n = 0; n < 2; ++n) _Pragma("unroll") for (int k = 0; k < 2; ++k) dst[n][k] = *(const PG8_LAS bf16x8*)(lds + PG8_SB(b, h) + boff + n * 2048 + k * 1024); } while (0)
#define PG8_MMA(ai, bj, At, Bt) do { __builtin_amdgcn_s_setprio(1); _Pragma("unroll") for (int m = 0; m < 4; ++m) _Pragma("unroll") for (int n = 0; n < 2; ++n) _Pragma("unroll") for (int k = 0; k < 2; ++k) \
        acc[ai][bj][m][n] = __builtin_amdgcn_mfma_f32_16x16x32_bf16(Bt[n][k], At[m][k], acc[ai][bj][m][n], 0, 0, 0); __builtin_amdgcn_s_setprio(0); } while (0)
#define PG8_WAIT_V(n) asm volatile("s_waitcnt vmcnt(" #n ")" ::: "memory")
#define PG8_WAIT_L(n) asm volatile("s_waitcnt lgkmcnt(" #n ")" ::: "memory")
#define PG8_BAR __builtin_amdgcn_s_barrier()
#define PG8_SCHED __builtin_amdgcn_sched_barrier(0)
    Unit cur, nxt; int ui = 0;
    if (!S.next(0, cur)) return;
    f32x4 acc[2][2][4][2];
#pragma unroll
    for (int a = 0; a < 2; ++a)
#pragma unroll
        for (int b = 0; b < 2; ++b)
#pragma unroll
            for (int m = 0; m < 4; ++m)
#pragma unroll
                for (int n = 0; n < 2; ++n) acc[a][b][m][n] = (f32x4){0.f, 0.f, 0.f, 0.f};
    bf16x8 At[4][2], B0[2][2], B1[2][2];
    const char* cA = (const char*)(cur.alt ? g.A2 : g.A) + (size_t)cur.pm * tstep; const char* cB = (const char*)(cur.alt ? g.Bt2 : g.Bt) + (size_t)cur.pn * tstep;
    S.a_ready(cur);
    if constexpr (SP2) {
        PG8_STAGE(PG8_SB(0, 0), cB, voffB); PG8_STAGE(PG8_SB(0, 1), cB + hstep, voffB); PG8_STAGE(PG8_SA(0, 0), cA, voffA); PG8_STAGE(PG8_SA(0, 1), cA + hstep, voffA);
        if (wr == 1) PG8_BAR;
        PG8_WAIT_V(2); PG8_BAR;
        PG8_STAGE(PG8_SB(1, 0), cB + kstep, voffB); PG8_STAGE(PG8_SA(1, 0), cA + kstep, voffA); PG8_STAGE(PG8_SB(1, 1), cB + hstep + kstep, voffB);
        PG8_WAIT_V(6); PG8_BAR;
    } else {
        PG8_STAGE(PG8_SB(0, 0), cB, voffB); PG8_STAGE(PG8_SA(0, 0), cA, voffA); PG8_STAGE(PG8_SB(0, 1), cB + hstep, voffB); PG8_STAGE(PG8_SA(0, 1), cA + hstep, voffA);
        if (wr == 1) PG8_BAR;
        PG8_WAIT_V(4); PG8_BAR;
        PG8_STAGE(PG8_SB(1, 0), cB + kstep, voffB); PG8_STAGE(PG8_SA(1, 0), cA + kstep, voffA); PG8_STAGE(PG8_SB(1, 1), cB + hstep + kstep, voffB);
        PG8_WAIT_V(6); PG8_BAR;
    }
    for (;;) {
        const bool has_next = S.next(ui + 1, nxt);
        const char* nA = has_next ? (const char*)(nxt.alt ? g.A2 : g.A) + (size_t)nxt.pm * tstep : cA; const char* nB = has_next ? (const char*)(nxt.alt ? g.Bt2 : g.Bt) + (size_t)nxt.pn * tstep : cB;
        for (int t = 0; t < nt; t += 2) {
            const bool last = (t == nt - 2);
            const char* a1 = cA + (size_t)(t + 1) * kstep;
            const char* a2 = last ? nA : cA + (size_t)(t + 2) * kstep; const char* b2 = last ? nB : cB + (size_t)(t + 2) * kstep;
            const char* a3 = a2 + kstep; const char* b3 = b2 + kstep;
            if (last && has_next) S.a_ready(nxt);
            if constexpr (SP2) {
            PG8_LDB(B0, 0, 0); PG8_LDB(B1, 0, 1); PG8_SCHED; PG8_LDA(At, 0, 0); PG8_STAGE(PG8_SA(1, 1), a1 + hstep, voffA);
            PG8_WAIT_V(8); PG8_WAIT_L(0); PG8_BAR; PG8_MMA(0, 0, At, B0); PG8_MMA(0, 1, At, B1); PG8_BAR; PG8_SCHED;
            PG8_LDA(At, 0, 1); PG8_STAGE(PG8_SB(0, 0), b2, voffB); PG8_STAGE(PG8_SB(0, 1), b2 + hstep, voffB); PG8_STAGE(PG8_SA(0, 0), a2, voffA);
            PG8_WAIT_V(8); PG8_WAIT_L(0); PG8_BAR; PG8_MMA(1, 0, At, B0); PG8_MMA(1, 1, At, B1); PG8_BAR; PG8_SCHED;
            PG8_LDB(B0, 1, 0); PG8_LDB(B1, 1, 1); PG8_SCHED; PG8_LDA(At, 1, 0); PG8_STAGE(PG8_SA(0, 1), a2 + hstep, voffA);
            PG8_WAIT_V(8); PG8_WAIT_L(0); PG8_BAR; PG8_MMA(0, 0, At, B0); PG8_MMA(0, 1, At, B1); PG8_BAR; PG8_SCHED;
            PG8_LDA(At, 1, 1); PG8_STAGE(PG8_SB(1, 0), b3, voffB); PG8_STAGE(PG8_SB(1, 1), b3 + hstep, voffB); PG8_STAGE(PG8_SA(1, 0), a3, voffA);
            PG8_WAIT_V(8); PG8_WAIT_L(0); PG8_BAR; PG8_MMA(1, 0, At, B0); PG8_MMA(1, 1, At, B1); PG8_BAR; PG8_SCHED;
            } else {
            PG8_LDB(B0, 0, 0); PG8_SCHED; PG8_LDA(At, 0, 0); PG8_STAGE(PG8_SA(1, 1), a1 + hstep, voffA);
            PG8_WAIT_L(8); PG8_BAR; PG8_WAIT_L(0); PG8_MMA(0, 0, At, B0); PG8_BAR; PG8_SCHED;
            PG8_LDB(B1, 0, 1); PG8_STAGE(PG8_SB(0, 0), b2, voffB);
            PG8_BAR; PG8_WAIT_L(0); PG8_MMA(0, 1, At, B1); PG8_BAR;
            PG8_LDA(At, 0, 1); PG8_STAGE(PG8_SA(0, 0), a2, voffA);
            PG8_BAR; PG8_WAIT_L(0); PG8_MMA(1, 0, At, B0); PG8_BAR; PG8_SCHED;
            PG8_STAGE(PG8_SB(0, 1), b2 + hstep, voffB);
            PG8_WAIT_V(6); PG8_BAR; PG8_MMA(1, 1, At, B1); PG8_BAR;
            PG8_LDB(B0, 1, 0); PG8_SCHED; PG8_LDA(At, 1, 0); PG8_STAGE(PG8_SA(0, 1), a2 + hstep, voffA);
            PG8_WAIT_L(8); PG8_BAR; PG8_WAIT_L(0); PG8_MMA(0, 0, At, B0); PG8_BAR; PG8_SCHED;
            PG8_LDB(B1, 1, 1); PG8_STAGE(PG8_SB(1, 0), b3, voffB);
            PG8_BAR; PG8_WAIT_L(0); PG8_MMA(0, 1, At, B1); PG8_BAR;
            PG8_LDA(At, 1, 1); PG8_STAGE(PG8_SA(1, 0), a3, voffA);
            PG8_BAR; PG8_WAIT_L(0); PG8_MMA(1, 0, At, B0); PG8_BAR; PG8_SCHED;
            PG8_STAGE(PG8_SB(1, 1), b3 + hstep, voffB);
            PG8_WAIT_V(6); PG8_BAR; PG8_MMA(1, 1, At, B1); PG8_BAR;
            }
        }
        if constexpr (ALIGN_EPI) { if (wr == 0) PG8_BAR; }
        if constexpr (!Epi::AFTER_DRAIN) { E(acc, cur, wr, wc, fr, fq); S.done(cur); }
        if (!has_next) break;
#pragma unroll
        for (int a = 0; a < 2; ++a)
#pragma unroll
            for (int b = 0; b < 2; ++b)
#pragma unroll
                for (int m = 0; m < 4; ++m)
#pragma unroll
                    for (int n = 0; n < 2; ++n) acc[a][b][m][n] = (f32x4){0.f, 0.f, 0.f, 0.f};
        cur = nxt; cA = nA; cB = nB; ++ui;
        if constexpr (ALIGN_EPI) { if (wr == 1) PG8_BAR; }
    }
    PG8_WAIT_V(0);
    if constexpr (!ALIGN_EPI) { if (wr == 0) PG8_BAR; }
    PG8_BAR;
    if constexpr (Epi::AFTER_DRAIN) { E.fused(acc, cur, wr, wc, fr, fq, lds, wid, lane); S.done(cur); }
#undef PG8_SA
#undef PG8_SB
#undef PG8_STAGE
#undef PG8_LDA
#undef PG8_LDB
#undef PG8_MMA
#undef PG8_WAIT_V
#undef PG8_WAIT_L
#undef PG8_BAR
#undef PG8_SCHED
}
}
namespace fa {
typedef short bf16x8 __attribute__((ext_vector_type(8)));
typedef short s16x4 __attribute__((ext_vector_type(4)));
typedef float f32x16 __attribute__((ext_vector_type(16)));
typedef float f32x4 __attribute__((ext_vector_type(4)));
typedef unsigned u32x4 __attribute__((ext_vector_type(4)));
constexpr int NW = 8, QBLK = 32, KVBLK = 64;
constexpr float THR = 8.f;
#define FA_SBAR() __builtin_amdgcn_sched_barrier(0)
#define FA_VMW() asm volatile("s_waitcnt vmcnt(0)" ::: "memory")
__device__ __forceinline__ int crow(int r, int hi) { return (r & 3) + 8 * (r >> 2) + 4 * hi; }
__device__ __forceinline__ unsigned cvtpk(float lo, float hi) { unsigned r; asm volatile("v_cvt_pk_bf16_f32 %0, %1, %2" : "=v"(r) : "v"(lo), "v"(hi)); return r; }

template <int NDQ> __device__ __forceinline__ int kswz(int row, int c) {
    if (NDQ == 4) return row * 128 + ((c ^ ((row >> 1) & 7)) << 4);
    else return row * (NDQ * 32) + ((c ^ (row & 15)) << 4);
}
template <int NDVT> __device__ __forceinline__ int v_st(int k, int c) { const int kk = (k & ~0xC) | ((k & 4) << 1) | ((k & 8) >> 1); return ((kk >> 3) * NDVT + (c >> 5)) * 512 + ((kk & 7) * 32 + (c & 31)) * 2; }
__device__ __forceinline__ int v_rd_base(int lane) { return ((lane & 3) << 3) | (((lane >> 2) & 3) << 6) | (((lane >> 4) & 1) << 5) | (((lane >> 5) & 1) << 8); }

__device__ __forceinline__ void mask_tile(f32x16& p0, f32x16& p1, int dq, unsigned W) {
    const float NEG = -__builtin_inff();
#pragma unroll
    for (int r = 0; r < 16; ++r) { const int c = (r & 3) + 8 * (r >> 2);
        if ((unsigned)(dq - c) >= W) p0[r] = NEG;
        if ((unsigned)(dq - c - 32) >= W) p1[r] = NEG; }
}
__device__ __forceinline__ void partialSM(f32x16& p0, f32x16& p1, float& m_reg, float& alpha) {
    float pmax = p0[0];
#pragma unroll
    for (int r = 1; r < 16; ++r) pmax = fmaxf(pmax, p0[r]);
#pragma unroll
    for (int r = 0; r < 16; ++r) pmax = fmaxf(pmax, p1[r]);
    { auto rr = __builtin_amdgcn_permlane32_swap(__float_as_uint(pmax), __float_as_uint(pmax), false, false); pmax = fmaxf(__uint_as_float(rr[0]), __uint_as_float(rr[1])); }
    float mn;
    if (__builtin_expect(__all((pmax - m_reg) <= THR), 1)) { mn = m_reg; alpha = 1.f; }
    else { mn = fmaxf(m_reg, pmax); alpha = __builtin_amdgcn_exp2f(m_reg - mn); m_reg = mn; }
#pragma unroll
    for (int r = 0; r < 16; ++r) p0[r] = p0[r] - mn;
#pragma unroll
    for (int r = 0; r < 16; ++r) p1[r] = p1[r] - mn;
#pragma unroll
    for (int r = 0; r < 16; ++r) p0[r] = __builtin_amdgcn_exp2f(p0[r]);
}
__device__ __forceinline__ void finishSM(f32x16& p0, f32x16& p1, float alpha, float& l_reg, bf16x8& pa0, bf16x8& pa1, bf16x8& pa2, bf16x8& pa3) {
#pragma unroll
    for (int r = 0; r < 16; ++r) p1[r] = __builtin_amdgcn_exp2f(p1[r]);
    float ps = 0.f;
#pragma unroll
    for (int r = 0; r < 16; ++r) ps += p0[r];
#pragma unroll
    for (int r = 0; r < 16; ++r) ps += p1[r];
    { auto rr = __builtin_amdgcn_permlane32_swap(__float_as_uint(ps), __float_as_uint(ps), false, false); ps = __uint_as_float(rr[0]) + __uint_as_float(rr[1]); }
    l_reg = l_reg * alpha + ps;
#define FA_PK4(P, B_, OUT) do { unsigned a0 = cvtpk(P[B_ + 0], P[B_ + 1]), a1 = cvtpk(P[B_ + 2], P[B_ + 3]); unsigned b0 = cvtpk(P[B_ + 4], P[B_ + 5]), b1 = cvtpk(P[B_ + 6], P[B_ + 7]); \
        auto r0 = __builtin_amdgcn_permlane32_swap(a0, b0, false, false); auto r1 = __builtin_amdgcn_permlane32_swap(a1, b1, false, false); \
        u32x4 w = {r0[0], r1[0], r0[1], r1[1]}; OUT = *reinterpret_cast<bf16x8*>(&w); } while (0)
    FA_PK4(p0, 0, pa0); FA_PK4(p0, 8, pa1); FA_PK4(p1, 0, pa2); FA_PK4(p1, 8, pa3);
#undef FA_PK4
}
template <int NDQ>
__device__ __forceinline__ void qkt(f32x16& p0, f32x16& p1, const char* Kb, int r32, int hi, const bf16x8* qr) {
    p0 = f32x16{}; p1 = f32x16{};
    constexpr int NA = NDQ < 8 ? NDQ : 8;
    const char* kb[NA];
#pragma unroll
    for (int dd = 0; dd < NA; ++dd) kb[dd] = Kb + kswz<NDQ>(r32, 2 * dd + hi);
#pragma unroll
    for (int d0 = 0; d0 < NDQ; ++d0) { const char* a = kb[d0 & (NA - 1)] + (d0 >> 3) * 256;
        const bf16x8 b0 = *reinterpret_cast<const bf16x8*>(a);
        const bf16x8 b1 = *reinterpret_cast<const bf16x8*>(a + 32 * NDQ * 32);
        p0 = __builtin_amdgcn_mfma_f32_32x32x16_bf16(b0, qr[d0], p0, 0, 0, 0);
        p1 = __builtin_amdgcn_mfma_f32_32x32x16_bf16(b1, qr[d0], p1, 0, 0, 0); }
}
template <int NDVT, int NDV>
__device__ __forceinline__ void pv_tile(f32x16* o, int vb, bf16x8 pa0, bf16x8 pa1, bf16x8 pa2, bf16x8 pa3) {
#define FA_TRRD(dst, off) asm volatile("ds_read_b64_tr_b16 %0, %1 offset:%2" : "=&v"(dst) : "v"(vb), "i"(off) : "memory")
#define FA_PV_D0(d0) do { s16x4 l0, l1, l2, l3, h0, h1, h2, h3; constexpr int b_ = (d0) * 512, ks_ = 2 * NDVT * 512, hf_ = NDVT * 512; \
        FA_TRRD(l0, b_); FA_TRRD(h0, b_ + hf_); FA_TRRD(l1, b_ + ks_); FA_TRRD(h1, b_ + ks_ + hf_); FA_TRRD(l2, b_ + 2 * ks_); FA_TRRD(h2, b_ + 2 * ks_ + hf_); FA_TRRD(l3, b_ + 3 * ks_); FA_TRRD(h3, b_ + 3 * ks_ + hf_); \
        asm volatile("s_waitcnt lgkmcnt(0)" ::: "memory"); FA_SBAR(); \
        o[d0] = __builtin_amdgcn_mfma_f32_32x32x16_bf16(pa0, (bf16x8){l0[0], l0[1], l0[2], l0[3], h0[0], h0[1], h0[2], h0[3]}, o[d0], 0, 0, 0); \
        o[d0] = __builtin_amdgcn_mfma_f32_32x32x16_bf16(pa1, (bf16x8){l1[0], l1[1], l1[2], l1[3], h1[0], h1[1], h1[2], h1[3]}, o[d0], 0, 0, 0); \
        o[d0] = __builtin_amdgcn_mfma_f32_32x32x16_bf16(pa2, (bf16x8){l2[0], l2[1], l2[2], l2[3], h2[0], h2[1], h2[2], h2[3]}, o[d0], 0, 0, 0); \
        o[d0] = __builtin_amdgcn_mfma_f32_32x32x16_bf16(pa3, (bf16x8){l3[0], l3[1], l3[2], l3[3], h3[0], h3[1], h3[2], h3[3]}, o[d0], 0, 0, 0); } while (0)
    FA_PV_D0(0); if constexpr (NDV > 1) FA_PV_D0(1); if constexpr (NDV > 2) FA_PV_D0(2); if constexpr (NDV > 3) FA_PV_D0(3);
#undef FA_PV_D0
#undef FA_TRRD
}

template <int NDQ, int NDVT, int NDV>
struct Core {
    static constexpr int KROW = NDQ * 32, SHM_K = 64 * KROW, SHM_V = 64 * NDVT * 64, NKL = NDQ / 4, NVL = NDVT / 2, LDS_NEED = 2 * SHM_V + 2 * SHM_K + NW * 256;
    static_assert(NKL >= 1 && NVL >= 1, "tile too small for 512 staging threads");
    __device__ __forceinline__ static void run(f32x16 (&o)[NDV], float& m_reg, float& l_reg, const bf16* Qw, int ldq, const bf16* Kg, const bf16* Vg, int ldk,
                                               int j_lo, int j_hi, int qlo, int W, char* lds, int vdoff) {
        int tid = threadIdx.x; asm volatile("" : "+v"(tid));
        const int wid = __builtin_amdgcn_readfirstlane(tid >> 6), lane = tid & 63, r32 = lane & 31, hi = lane >> 5;
        const int NT = j_hi - j_lo, qm = qlo + r32 - 4 * hi;
        char* V_lds = lds; char* K_lds = lds + 2 * SHM_V;
        float* wsf = (float*)(lds + 2 * SHM_V + 2 * SHM_K) + wid * 64; float* al_l = wsf + 32;
        m_reg = -1e30f; l_reg = 0.f;
#pragma unroll
        for (int d = 0; d < NDV; ++d) o[d] = f32x16{};
        constexpr int KCH = 2 * NDQ, KRS = 512 / KCH, VCH = 4 * NDVT, VRS = 512 / VCH;
        const int krow0 = tid / KCH, kch = tid % KCH, vrow0 = tid / VCH, vcol = (tid % VCH) * 8;
        int kws[NKL], vws[NVL];
#pragma unroll
        for (int i = 0; i < NKL; ++i) kws[i] = kswz<NDQ>(krow0 + i * KRS, kch);
#pragma unroll
        for (int i = 0; i < NVL; ++i) vws[i] = v_st<NDVT>(vrow0 + i * VRS, vcol);
        const bf16* kgp = Kg + (size_t)krow0 * ldk + kch * 8; const bf16* vgp = Vg + (size_t)vrow0 * ldk + vcol;
        bf16x8 sk[NKL], sv[NVL];
        const int vb0 = (int)(uintptr_t)V_lds + v_rd_base(lane) + vdoff * 512;
#define FA_SLOAD(t) do { const size_t ro_ = (size_t)((j_lo + (t)) * KVBLK) * ldk; \
        _Pragma("unroll") for (int i_ = 0; i_ < NVL; ++i_) sv[i_] = *reinterpret_cast<const bf16x8*>(vgp + ro_ + (size_t)(i_ * VRS) * ldk); \
        _Pragma("unroll") for (int i_ = 0; i_ < NKL; ++i_) sk[i_] = *reinterpret_cast<const bf16x8*>(kgp + ro_ + (size_t)(i_ * KRS) * ldk); } while (0)
#define FA_SWRITE(bf) do { _Pragma("unroll") for (int i_ = 0; i_ < NVL; ++i_) *reinterpret_cast<bf16x8*>(V_lds + (bf) * SHM_V + vws[i_]) = sv[i_]; \
        _Pragma("unroll") for (int i_ = 0; i_ < NKL; ++i_) *reinterpret_cast<bf16x8*>(K_lds + (bf) * SHM_K + kws[i_]) = sk[i_]; } while (0)
#define FA_RESC(a) do { if (__any((a) < 1.f)) { if (hi == 0) al_l[r32] = (a); asm volatile("s_waitcnt lgkmcnt(0)" ::: "memory"); \
        _Pragma("unroll") for (int d_ = 0; d_ < NDV; ++d_) _Pragma("unroll") for (int r = 0; r < 16; ++r) o[d_][r] *= al_l[crow(r, hi)]; } } while (0)
#define FA_KBASE(t) ((j_lo + (t)) * KVBLK)
#define FA_MASKT(P0_, P1_, t) do { const int kb_ = FA_KBASE(t); if (kb_ + KVBLK - 1 > qlo || kb_ <= qlo + QBLK - 1 - W) mask_tile(P0_, P1_, qm - kb_, (unsigned)W); } while (0)
        bf16x8 qr[NDQ];
#pragma unroll
        for (int d0 = 0; d0 < NDQ; ++d0) qr[d0] = *reinterpret_cast<const bf16x8*>(Qw + (size_t)r32 * ldq + d0 * 16 + hi * 8);
        FA_SLOAD(0); FA_VMW(); FA_SWRITE(0); FA_SBAR();
        if (NT > 1) FA_SLOAD(1);
        __syncthreads();
        f32x16 pA0, pA1, pB0, pB1; float alA, alB; bf16x8 pa0, pa1, pa2, pa3;
        FA_SBAR(); qkt<NDQ>(pA0, pA1, K_lds, r32, hi, qr);
        FA_MASKT(pA0, pA1, 0); partialSM(pA0, pA1, m_reg, alA);
        if (NT > 1) { FA_VMW(); FA_SWRITE(1); }
        __syncthreads();
#define FA_HALF_STEP(PX0, PX1, alX, PY0, PY1, alY, t, KB, VB, SB) do { \
        FA_SBAR(); qkt<NDQ>(PX0, PX1, K_lds + (KB) * SHM_K, r32, hi, qr); \
        finishSM(PY0, PY1, alY, l_reg, pa0, pa1, pa2, pa3); FA_SBAR(); \
        if ((t) + 1 < NT) { FA_SLOAD((t) + 1); FA_SBAR(); } \
        pv_tile<NDVT, NDV>(o, vb0 + (VB) * SHM_V, pa0, pa1, pa2, pa3); FA_MASKT(PX0, PX1, (t)); partialSM(PX0, PX1, m_reg, alX); \
        __syncthreads(); \
        if ((t) + 1 < NT) { FA_VMW(); FA_SWRITE(SB); } \
        FA_RESC(alX); __syncthreads(); } while (0)
        for (int t = 1; t + 1 < NT; t += 2) {
            FA_HALF_STEP(pB0, pB1, alB, pA0, pA1, alA, t, 1, 0, 0);
            FA_HALF_STEP(pA0, pA1, alA, pB0, pB1, alB, t + 1, 0, 1, 1);
        }
        const bool even = (NT & 1) == 0;
        if (even) { FA_SBAR(); qkt<NDQ>(pB0, pB1, K_lds + SHM_K, r32, hi, qr); FA_SBAR(); }
        finishSM(pA0, pA1, alA, l_reg, pa0, pa1, pa2, pa3); FA_SBAR();
        pv_tile<NDVT, NDV>(o, vb0, pa0, pa1, pa2, pa3);
        if (even) { FA_MASKT(pB0, pB1, NT - 1); partialSM(pB0, pB1, m_reg, alB); FA_RESC(alB);
            finishSM(pB0, pB1, alB, l_reg, pa0, pa1, pa2, pa3); FA_SBAR(); pv_tile<NDVT, NDV>(o, vb0 + SHM_V, pa0, pa1, pa2, pa3); }
        __syncthreads();
#undef FA_SLOAD
#undef FA_SWRITE
#undef FA_RESC
#undef FA_KBASE
#undef FA_MASKT
#undef FA_HALF_STEP
    }
};

#define FA_PIN(x) asm volatile("" : "+v"(x))
#define FA_PK4V(P, B_, OUT) do { unsigned a0_ = cvtpk(P[B_ + 0], P[B_ + 1]), a1_ = cvtpk(P[B_ + 2], P[B_ + 3]); unsigned b0_ = cvtpk(P[B_ + 4], P[B_ + 5]), b1_ = cvtpk(P[B_ + 6], P[B_ + 7]); \
        auto r0_ = __builtin_amdgcn_permlane32_swap(a0_, b0_, false, false); auto r1_ = __builtin_amdgcn_permlane32_swap(a1_, b1_, false, false); \
        u32x4 w_ = {r0_[0], r1_[0], r0_[1], r1_[1]}; OUT = *reinterpret_cast<bf16x8*>(&w_); } while (0)
__device__ __forceinline__ void step_qk_fin(f32x16& X0, f32x16& X1, const char* Kb, int r32, int hi, const bf16x8* qr,
                                            f32x16& Y0, f32x16& Y1, float alY, float& l_reg, bf16x8& pa0, bf16x8& pa1, bf16x8& pa2, bf16x8& pa3) {
    const char* k0 = Kb + kswz<4>(r32, hi); const char* k1 = Kb + kswz<4>(r32, 2 + hi); const char* k2 = Kb + kswz<4>(r32, 4 + hi); const char* k3 = Kb + kswz<4>(r32, 6 + hi);
    bf16x8 fa = *reinterpret_cast<const bf16x8*>(k0), fb = *reinterpret_cast<const bf16x8*>(k0 + 4096);
    float ps;
    X0 = __builtin_amdgcn_mfma_f32_32x32x16_bf16(fa, qr[0], f32x16{}, 0, 0, 0); X1 = __builtin_amdgcn_mfma_f32_32x32x16_bf16(fb, qr[0], f32x16{}, 0, 0, 0);
    fa = *reinterpret_cast<const bf16x8*>(k1); fb = *reinterpret_cast<const bf16x8*>(k1 + 4096);
#pragma unroll
    for (int r = 0; r < 4; ++r) Y1[r] = __builtin_amdgcn_exp2f(Y1[r]);
    ps = (Y0[0] + Y0[1]) + (Y0[2] + Y0[3]);
    FA_PK4V(Y0, 0, pa0); FA_PIN(ps); FA_PIN(pa0); FA_PIN(Y1); FA_SBAR();
    X0 = __builtin_amdgcn_mfma_f32_32x32x16_bf16(fa, qr[1], X0, 0, 0, 0); X1 = __builtin_amdgcn_mfma_f32_32x32x16_bf16(fb, qr[1], X1, 0, 0, 0);
    fa = *reinterpret_cast<const bf16x8*>(k2); fb = *reinterpret_cast<const bf16x8*>(k2 + 4096);
#pragma unroll
    for (int r = 4; r < 8; ++r) Y1[r] = __builtin_amdgcn_exp2f(Y1[r]);
    ps += (Y0[4] + Y0[5]) + (Y0[6] + Y0[7]); ps += (Y1[0] + Y1[1]) + (Y1[2] + Y1[3]);
    FA_PK4V(Y0, 8, pa1); FA_PIN(ps); FA_PIN(pa1); FA_PIN(Y1); FA_SBAR();
    X0 = __builtin_amdgcn_mfma_f32_32x32x16_bf16(fa, qr[2], X0, 0, 0, 0); X1 = __builtin_amdgcn_mfma_f32_32x32x16_bf16(fb, qr[2], X1, 0, 0, 0);
    fa = *reinterpret_cast<const bf16x8*>(k3); fb = *reinterpret_cast<const bf16x8*>(k3 + 4096);
#pragma unroll
    for (int r = 8; r < 12; ++r) Y1[r] = __builtin_amdgcn_exp2f(Y1[r]);
    ps += (Y0[8] + Y0[9]) + (Y0[10] + Y0[11]); ps += (Y1[4] + Y1[5]) + (Y1[6] + Y1[7]);
    FA_PK4V(Y1, 0, pa2); FA_PIN(ps); FA_PIN(pa2); FA_PIN(Y1); FA_SBAR();
    X0 = __builtin_amdgcn_mfma_f32_32x32x16_bf16(fa, qr[3], X0, 0, 0, 0); X1 = __builtin_amdgcn_mfma_f32_32x32x16_bf16(fb, qr[3], X1, 0, 0, 0);
#pragma unroll
    for (int r = 12; r < 16; ++r) Y1[r] = __builtin_amdgcn_exp2f(Y1[r]);
    ps += (Y0[12] + Y0[13]) + (Y0[14] + Y0[15]); ps += (Y1[8] + Y1[9]) + (Y1[10] + Y1[11]); ps += (Y1[12] + Y1[13]) + (Y1[14] + Y1[15]);
    { auto rr = __builtin_amdgcn_permlane32_swap(__float_as_uint(ps), __float_as_uint(ps), false, false); ps = __uint_as_float(rr[0]) + __uint_as_float(rr[1]); }
    l_reg = l_reg * alY + ps;
    FA_PK4V(Y1, 8, pa3); FA_PIN(l_reg); FA_PIN(pa3); FA_PIN(X0); FA_PIN(X1); FA_SBAR();
}
__device__ __forceinline__ void step_pv_max(f32x16* o, int vb, bf16x8 pa0, bf16x8 pa1, bf16x8 pa2, bf16x8 pa3, f32x16& X0, f32x16& X1, float& m_reg, float& alpha, bool MASK, int dq, unsigned W) {
#define FA_TRRD(dst, off) asm volatile("ds_read_b64_tr_b16 %0, %1 offset:%2" : "=&v"(dst) : "v"(vb), "i"(off) : "memory")
#define FA_RD2(l, h, d0, ks) do { FA_TRRD(l, (d0) * 512 + (ks) * 4096); FA_TRRD(h, (d0) * 512 + (ks) * 4096 + 2048); } while (0)
#define FA_FRAG(l, h) (bf16x8){l[0], l[1], l[2], l[3], h[0], h[1], h[2], h[3]}
    s16x4 l0, h0, l1, h1, l2, h2, l3, h3;
    FA_RD2(l0, h0, 0, 0); FA_RD2(l1, h1, 0, 1); FA_RD2(l2, h2, 0, 2); FA_RD2(l3, h3, 0, 3);
    if (MASK) mask_tile(X0, X1, dq, W);
    float pmax = fmaxf(fmaxf(X0[0], X0[1]), X1[0]);
#pragma unroll
    for (int r = 2; r < 16; r += 2) pmax = fmaxf(fmaxf(pmax, X0[r]), X0[r + 1]);
#pragma unroll
    for (int r = 1; r < 16; r += 2) pmax = fmaxf(fmaxf(pmax, X1[r]), X1[(r + 1) & 15]);
    { auto rr = __builtin_amdgcn_permlane32_swap(__float_as_uint(pmax), __float_as_uint(pmax), false, false); pmax = fmaxf(__uint_as_float(rr[0]), __uint_as_float(rr[1])); }
    float mn;
    if (__builtin_expect(__all((pmax - m_reg) <= THR), 1)) { mn = m_reg; alpha = 1.f; }
    else { mn = fmaxf(m_reg, pmax); alpha = __builtin_amdgcn_exp2f(m_reg - mn); m_reg = mn; }
    FA_PIN(mn);
#define FA_BLK(d0, NXT, FILL) do { asm volatile("s_waitcnt lgkmcnt(0)" ::: "memory"); FA_SBAR(); \
        o[d0] = __builtin_amdgcn_mfma_f32_32x32x16_bf16(pa0, FA_FRAG(l0, h0), o[d0], 0, 0, 0); if (NXT) FA_RD2(l0, h0, (d0) + 1, 0); \
        o[d0] = __builtin_amdgcn_mfma_f32_32x32x16_bf16(pa1, FA_FRAG(l1, h1), o[d0], 0, 0, 0); if (NXT) FA_RD2(l1, h1, (d0) + 1, 1); \
        o[d0] = __builtin_amdgcn_mfma_f32_32x32x16_bf16(pa2, FA_FRAG(l2, h2), o[d0], 0, 0, 0); if (NXT) FA_RD2(l2, h2, (d0) + 1, 2); \
        o[d0] = __builtin_amdgcn_mfma_f32_32x32x16_bf16(pa3, FA_FRAG(l3, h3), o[d0], 0, 0, 0); if (NXT) FA_RD2(l3, h3, (d0) + 1, 3); \
        FILL; } while (0)
    FA_BLK(0, true,  { _Pragma("unroll") for (int r = 0; r < 16; ++r) X0[r] = X0[r] - mn; FA_PIN(X0); });
    FA_BLK(1, true,  { _Pragma("unroll") for (int r = 0; r < 16; ++r) X1[r] = X1[r] - mn; FA_PIN(X1); });
    FA_BLK(2, true,  { _Pragma("unroll") for (int r = 0; r < 8; ++r) X0[r] = __builtin_amdgcn_exp2f(X0[r]); FA_PIN(X0); });
    FA_BLK(3, false, { _Pragma("unroll") for (int r = 8; r < 16; ++r) X0[r] = __builtin_amdgcn_exp2f(X0[r]); FA_PIN(X0); });
    FA_SBAR();
#undef FA_BLK
#undef FA_RD2
#undef FA_FRAG
#undef FA_TRRD
}

template <int NDQ, int NDVT, int NDV>
struct CoreStag {
    static_assert(NDQ == 4 && NDVT == 4 && NDV == 4, "the interleaved interval bodies are written for d_qk = 64, d_v = 128");
    static constexpr int KROW = NDQ * 32, SHM_K = 64 * KROW, SHM_V = 64 * NDVT * 64, NKL = NDQ / 4, NVL = NDVT / 2, LDS_NEED = 2 * SHM_V + 2 * SHM_K + NW * 256;
    __device__ __forceinline__ static void run(f32x16 (&o)[NDV], float& m_reg, float& l_reg, const bf16* Qw, int ldq, const bf16* Kg, const bf16* Vg, int ldk,
                                               int j_lo, int j_hi, int qlo, int W, char* lds, int vdoff) {
        const int tid = threadIdx.x, wid = __builtin_amdgcn_readfirstlane(tid >> 6), lane = tid & 63, r32 = lane & 31, hi = lane >> 5;
        const bool half1 = wid >= 4;
        const int NT = j_hi - j_lo, qm = qlo + r32 - 4 * hi;
        char* V_lds = lds; char* K_lds = lds + 2 * SHM_V;
        float* al_l = (float*)(lds + 2 * SHM_V + 2 * SHM_K) + wid * 64 + 32;
        m_reg = -1e30f; l_reg = 0.f;
#pragma unroll
        for (int d = 0; d < NDV; ++d) o[d] = f32x16{};
        constexpr int KCH = 2 * NDQ, KRS = 512 / KCH, VCH = 4 * NDVT, VRS = 512 / VCH;
        const int krow0 = tid / KCH, kch = tid % KCH, vrow0 = tid / VCH, vcol = (tid % VCH) * 8;
        int kws[NKL], vws[NVL];
#pragma unroll
        for (int i = 0; i < NKL; ++i) kws[i] = kswz<NDQ>(krow0 + i * KRS, kch);
#pragma unroll
        for (int i = 0; i < NVL; ++i) vws[i] = v_st<NDVT>(vrow0 + i * VRS, vcol);
        const bf16* kgp = Kg + (size_t)(j_lo * KVBLK + krow0) * ldk + kch * 8; const bf16* vgp = Vg + (size_t)(j_lo * KVBLK + vrow0) * ldk + vcol;
        bf16x8 sk[NKL], sv[NVL];
        const int vb0 = (int)(uintptr_t)V_lds + v_rd_base(lane) + vdoff * 512;
#define FS_BAR() do { FA_SBAR(); __syncthreads(); FA_SBAR(); } while (0)
#define FS_LOADK(t) do { if ((t) < NT) { const size_t ro_ = (size_t)((t) * KVBLK) * ldk; _Pragma("unroll") for (int i_ = 0; i_ < NKL; ++i_) sk[i_] = *reinterpret_cast<const bf16x8*>(kgp + ro_ + (size_t)(i_ * KRS) * ldk); } } while (0)
#define FS_LOADV(t) do { if ((t) < NT) { const size_t ro_ = (size_t)((t) * KVBLK) * ldk; _Pragma("unroll") for (int i_ = 0; i_ < NVL; ++i_) sv[i_] = *reinterpret_cast<const bf16x8*>(vgp + ro_ + (size_t)(i_ * VRS) * ldk); } } while (0)
#define FS_WRITEK(t, bf) do { if ((t) < NT) { _Pragma("unroll") for (int i_ = 0; i_ < NKL; ++i_) *reinterpret_cast<bf16x8*>(K_lds + (bf) * SHM_K + kws[i_]) = sk[i_]; } } while (0)
#define FS_WRITEV(t, bf) do { if ((t) < NT) { _Pragma("unroll") for (int i_ = 0; i_ < NVL; ++i_) *reinterpret_cast<bf16x8*>(V_lds + (bf) * SHM_V + vws[i_]) = sv[i_]; } } while (0)
#define FS_RESC(a) do { if (__any((a) < 1.f)) { if (hi == 0) al_l[r32] = (a); asm volatile("s_waitcnt lgkmcnt(0)" ::: "memory"); \
        _Pragma("unroll") for (int d_ = 0; d_ < NDV; ++d_) _Pragma("unroll") for (int r = 0; r < 16; ++r) o[d_][r] *= al_l[crow(r, hi)]; } } while (0)
#define FS_MASKT(P0_, P1_, t) do { const int kb_ = (j_lo + (t)) * KVBLK; if (kb_ + KVBLK - 1 > qlo || kb_ <= qlo + QBLK - 1 - W) mask_tile(P0_, P1_, qm - kb_, (unsigned)W); } while (0)
        bf16x8 qr[NDQ];
#pragma unroll
        for (int d0 = 0; d0 < NDQ; ++d0) qr[d0] = *reinterpret_cast<const bf16x8*>(Qw + (size_t)r32 * ldq + d0 * 16 + hi * 8);
        FS_LOADK(0); FS_WRITEK(0, 0); FA_SBAR(); FS_LOADK(1); FS_LOADV(0);
        FS_BAR();
        if (half1) { FS_BAR(); }
        f32x16 pA0, pA1, pB0, pB1; float alA = 1.f, alB = 1.f; bf16x8 pa0, pa1, pa2, pa3;
        FS_WRITEK(1, 1); FA_SBAR(); FS_LOADK(2); FA_SBAR();
        qkt<NDQ>(pA0, pA1, K_lds, r32, hi, qr); asm volatile("" : "+v"(pA0), "+v"(pA1));
        FS_BAR();
        FS_WRITEV(0, 0); FA_SBAR(); FS_LOADV(1); FA_SBAR();
        FS_MASKT(pA0, pA1, 0); partialSM(pA0, pA1, m_reg, alA);
        FS_BAR();
#define FS_STEP(PX0, PX1, alX, PY0, PY1, alY, t, KB) do { \
        finishSM(PY0, PY1, alY, l_reg, pa0, pa1, pa2, pa3); FA_SBAR(); \
        FS_WRITEK((t) + 1, (KB) ^ 1); FA_SBAR(); FS_LOADK((t) + 2); FA_SBAR(); \
        qkt<NDQ>(PX0, PX1, K_lds + (KB) * SHM_K, r32, hi, qr); asm volatile("" : "+v"(PX0), "+v"(PX1)); \
        FS_BAR(); \
        pv_tile<NDVT, NDV>(o, vb0 + ((KB) ^ 1) * SHM_V, pa0, pa1, pa2, pa3); \
        FS_WRITEV((t), (KB)); FA_SBAR(); FS_LOADV((t) + 1); FA_SBAR(); \
        FS_MASKT(PX0, PX1, (t)); partialSM(PX0, PX1, m_reg, alX); FS_RESC(alX); \
        FS_BAR(); } while (0)
        int t = 1;
        for (; t + 1 < NT; t += 2) {
            FS_STEP(pB0, pB1, alB, pA0, pA1, alA, t, 1);
            FS_STEP(pA0, pA1, alA, pB0, pB1, alB, t + 1, 0);
        }
        FS_STEP(pB0, pB1, alB, pA0, pA1, alA, t, 1);
        finishSM(pB0, pB1, alB, l_reg, pa0, pa1, pa2, pa3); FA_SBAR();
        FS_BAR();
        pv_tile<NDVT, NDV>(o, vb0 + SHM_V, pa0, pa1, pa2, pa3);
        FS_BAR();
        if (!half1) { FS_BAR(); }
#undef FS_BAR
#undef FS_LOADK
#undef FS_LOADV
#undef FS_WRITEK
#undef FS_WRITEV
#undef FS_RESC
#undef FS_MASKT
#undef FS_STEP
    }
};
}

constexpr size_t WS_STASH = 128 * MiB;
typedef unsigned v4u32 __attribute__((__vector_size__(16)));
__device__ __forceinline__ __amdgpu_buffer_rsrc_t mk_rsrc(const void* ptr) {
    const unsigned long long v = (unsigned long long)ptr; const unsigned lo = __builtin_amdgcn_readfirstlane((unsigned)v), hi = __builtin_amdgcn_readfirstlane((unsigned)(v >> 32));
    return __builtin_amdgcn_make_buffer_rsrc((void*)(((unsigned long long)hi << 32) | lo), 0, 0x40000000, 0x00020000);
}
__device__ __forceinline__ void attn_phase(const Params& p, char* lds, int vcu0, int nwg) {
    using namespace fa;
    const int tid = threadIdx.x, wid = __builtin_amdgcn_readfirstlane(tid >> 6), lane = tid & 63, r32 = lane & 31, hi = lane >> 5;
    const bf16* proj = (const bf16*)(p.ws + WS_PROJ); bf16* att = (bf16*)(p.ws + WS_ATT);
    typedef CoreStag<4, 4, 4> CD; typedef Core<4, 2, 2> CS;
    float* wsf = (float*)(lds + CD::LDS_NEED) + wid * 64;
    const float lam = calc_lambda(p);
    const int ovoff = (4 * hi * DM + r32) * 2;
#pragma nounroll
    for (int vcu = vcu0; vcu < 256; vcu += nwg) {
        const int bh = vcu >> 3, b = bh >> 2, h = bh & 3, s = vcu & 7;
        u32x4* stash = (u32x4*)(lds + CD::LDS_NEED + NW * 256) + tid;
#pragma nounroll
        for (int pass = 0; pass < 2; ++pass) {
            const int qb = pass ? 15 - s : s;
            const size_t row0 = (size_t)b * SEQ + qb * 256 + wid * 32;
#pragma nounroll
            for (int c = 0; c < 2; ++c) {
                f32x16 o[4]; float m_reg, l_reg;
                CD::run(o, m_reg, l_reg, proj + row0 * NP + C_QD + (2 * h + c) * 64, NP, proj + (size_t)b * SEQ * NP + C_KD + (2 * h + c) * 64, proj + (size_t)b * SEQ * NP + C_VD + h * 128, NP,
                        0, 4 * (qb + 1), qb * 256 + wid * 32, 1 << 30, lds, 0);
                if (hi == 0) wsf[r32] = l_reg;
                asm volatile("s_waitcnt lgkmcnt(0)" ::: "memory");
                if (c == 0) {
#pragma unroll
                    for (int j = 0; j < 2; ++j) { float ri[8];
#pragma unroll
                        for (int e = 0; e < 8; ++e) ri[e] = 1.0f / wsf[crow(8 * j + e, hi)];
#pragma unroll
                        for (int d0 = 0; d0 < 4; ++d0) { u32x4 w; w.x = cvtpk(o[d0][8 * j] * ri[0], o[d0][8 * j + 1] * ri[1]); w.y = cvtpk(o[d0][8 * j + 2] * ri[2], o[d0][8 * j + 3] * ri[3]);
                            w.z = cvtpk(o[d0][8 * j + 4] * ri[4], o[d0][8 * j + 5] * ri[5]); w.w = cvtpk(o[d0][8 * j + 6] * ri[6], o[d0][8 * j + 7] * ri[7]); stash[(d0 * 2 + j) * NTHR] = w; } }
                } else {
                    const __amdgpu_buffer_rsrc_t rso = mk_rsrc(att + row0 * DM + 512 + h * 128);
                    float ssq[16];
#pragma unroll
                    for (int r = 0; r < 16; ++r) ssq[r] = -lam / wsf[crow(r, hi)];
#pragma unroll
                    for (int d0 = 0; d0 < 4; ++d0)
#pragma unroll
                        for (int j = 0; j < 2; ++j) { const u32x4 w = stash[(d0 * 2 + j) * NTHR]; const unsigned ww[4] = {w.x, w.y, w.z, w.w};
#pragma unroll
                            for (int e = 0; e < 8; ++e) { const int r = 8 * j + e; const float a0 = (e & 1) ? __uint_as_float(ww[e >> 1] & 0xffff0000u) : __uint_as_float(ww[e >> 1] << 16);
                                o[d0][r] = a0 + ssq[r] * o[d0][r]; } }
#pragma unroll
                    for (int r = 0; r < 16; ++r) { float q = (o[0][r] * o[0][r] + o[1][r] * o[1][r]) + (o[2][r] * o[2][r] + o[3][r] * o[3][r]);
                        q += __shfl_xor(q, 1); q += __shfl_xor(q, 2); q += __shfl_xor(q, 4); q += __shfl_xor(q, 8); q += __shfl_xor(q, 16);
                        ssq[r] = 0.8f / sqrtf(q * (1.f / 128.f) + EPS); }
#pragma unroll
                    for (int d0 = 0; d0 < 4; ++d0) { const float g = p.g_diff[d0 * 32 + r32];
#pragma unroll
                        for (int r = 0; r < 16; ++r) { const float y = o[d0][r] * ssq[r] * g; const float yn = __shfl_xor(y, 1);
                            if ((r32 & 1) == 0) __builtin_amdgcn_raw_buffer_store_b32(cvtpk(y, yn), rso, ovoff, (((r & 3) + 8 * (r >> 2)) * DM + d0 * 32) * 2, 0); } }
                }
                asm volatile("s_waitcnt lgkmcnt(0)" ::: "memory");
            }
        }
    }
    int tid_s = threadIdx.x; asm volatile("" : "+v"(tid_s));
    const int wid_s = __builtin_amdgcn_readfirstlane(tid_s >> 6), r32_s = tid_s & 31, hi_s = (tid_s >> 5) & 1;
    float* wsf_s = (float*)(lds + CD::LDS_NEED) + wid_s * 64; const int ovoff_s = (4 * hi_s * DM + r32_s) * 2;
#pragma nounroll
    for (int u = vcu0; u < 1024; u += nwg) {
        const int wid = wid_s, r32 = r32_s, hi = hi_s, ovoff = ovoff_s; float* wsf = wsf_s;
        const int bk = u >> 6, g64 = u & 63, b = bk >> 1, kvh = bk & 1, hq = kvh * 4 + (wid >> 1), sub = wid & 1;
        const size_t row0 = (size_t)b * SEQ + g64 * 64 + sub * 32;
        const __amdgpu_buffer_rsrc_t rso = mk_rsrc(att + row0 * DM + hq * 64);
        f32x16 o[2]; float m_reg, l_reg;
        const bf16* Qw = proj + row0 * NP + C_QA + hq * 64;
        const bf16* Kg = proj + (size_t)b * SEQ * NP + C_KA + kvh * 64;
        const bf16* Vg = proj + (size_t)b * SEQ * NP + C_VA + kvh * 64;
        CS::run(o, m_reg, l_reg, Qw, NP, Kg, Vg, NP, g64 >= 2 ? g64 - 2 : 0, g64 + 1, g64 * 64 + sub * 32, 128, lds, 0);
        const float lt = l_reg + __builtin_amdgcn_exp2f(p.sinks[hq] * LOG2E - m_reg);
        if (hi == 0) wsf[r32] = lt;
        asm volatile("s_waitcnt lgkmcnt(0)" ::: "memory");
#pragma unroll
        for (int r = 0; r < 16; ++r) { const float rl = 1.0f / wsf[crow(r, hi)];
#pragma unroll
            for (int d0 = 0; d0 < 2; ++d0) { const float y = o[d0][r] * rl; const float yn = __shfl_xor(y, 1);
                if ((r32 & 1) == 0) __builtin_amdgcn_raw_buffer_store_b32(cvtpk(y, yn), rso, ovoff, (((r & 3) + 8 * (r >> 2)) * DM + d0 * 32) * 2, 0); } }
        __syncthreads();
    }
}

namespace fa {
template <int NDQ, int NDVT, int NDV>
struct CoreSeqG {
    static constexpr int KROW = NDQ * 32, SHM_K = 64 * KROW, SHM_V = 64 * NDVT * 64, KPW = SHM_K / 8192, VPW = SHM_V / 8192;
    static_assert(NDQ == 16 && NDVT == 8, "piece maps below are written for 512-byte K rows and 8 V column blocks");
    typedef __attribute__((address_space(3))) unsigned char* lptr;
    __device__ __forceinline__ static void run(f32x16 (&o)[NDV], float& m_reg, float& l_reg, const bf16* Qw, int ldq, const bf16* Kg, const bf16* Vg, int ldk, int NT, char* lds, lptr ldsL, int scr_off, int vdoff) {
        const int tid = threadIdx.x, wid = __builtin_amdgcn_readfirstlane(tid >> 6), lane = tid & 63, r32 = lane & 31, hi = lane >> 5;
        char* V_lds = lds; char* K_lds = lds + 2 * SHM_V;
        float* al_l = (float*)(lds + scr_off) + wid * 64 + 32;
        m_reg = -1e30f; l_reg = 0.f;
#pragma unroll
        for (int d = 0; d < NDV; ++d) o[d] = f32x16{};
        int ksrc[KPW], vsrc[VPW];
#pragma unroll
        for (int i = 0; i < KPW; ++i) { const int row = 2 * (wid * KPW + i) + (lane >> 5); ksrc[i] = row * ldk + (((lane & 31) ^ (row & 15)) << 3); }
#pragma unroll
        for (int i = 0; i < VPW; ++i) { const int kk = wid * 8 + ((lane & 31) >> 2), k = (kk & ~0xC) | ((kk & 4) << 1) | ((kk & 8) >> 1); vsrc[i] = k * ldk + (2 * i + (lane >> 5)) * 32 + (lane & 3) * 8; }
#define FG_DMA(t, bf) do { const size_t ro_ = (size_t)((t) * KVBLK) * ldk; \
        _Pragma("unroll") for (int i_ = 0; i_ < VPW; ++i_) __builtin_amdgcn_global_load_lds((const unsigned*)(Vg + ro_ + vsrc[i_]), (__attribute__((address_space(3))) unsigned*)(ldsL + (bf) * SHM_V + (wid * VPW + i_) * 1024), 16, 0, 0); \
        _Pragma("unroll") for (int i_ = 0; i_ < KPW; ++i_) __builtin_amdgcn_global_load_lds((const unsigned*)(Kg + ro_ + ksrc[i_]), (__attribute__((address_space(3))) unsigned*)(ldsL + 2 * SHM_V + (bf) * SHM_K + (wid * KPW + i_) * 1024), 16, 0, 0); } while (0)
        const int vb0 = (int)(uintptr_t)V_lds + v_rd_base(lane) + vdoff * 512;
        FG_DMA(0, 0);
        bf16x8 qr[NDQ];
#pragma unroll
        for (int d0 = 0; d0 < NDQ; ++d0) qr[d0] = *reinterpret_cast<const bf16x8*>(Qw + (size_t)r32 * ldq + d0 * 16 + hi * 8);
        __syncthreads();
        for (int t = 0; t < NT; ++t) {
            const int bf = t & 1;
            if (t + 1 < NT) FG_DMA(t + 1, bf ^ 1);
            f32x16 p0, p1; float al; bf16x8 pa0, pa1, pa2, pa3;
            FA_SBAR(); qkt<NDQ>(p0, p1, K_lds + bf * SHM_K, r32, hi, qr);
            partialSM(p0, p1, m_reg, al);
            if (__any(al < 1.f)) { if (hi == 0) al_l[r32] = al; asm volatile("s_waitcnt lgkmcnt(0)" ::: "memory");
#pragma unroll
                for (int d_ = 0; d_ < NDV; ++d_)
#pragma unroll
                    for (int r = 0; r < 16; ++r) o[d_][r] *= al_l[crow(r, hi)]; }
            finishSM(p0, p1, al, l_reg, pa0, pa1, pa2, pa3); FA_SBAR();
            pv_tile<NDVT, NDV>(o, vb0 + bf * SHM_V, pa0, pa1, pa2, pa3);
            __syncthreads();
        }
#undef FG_DMA
    }
};
}
__device__ __forceinline__ void cross_phase(const Params& p, char* lds, LAS unsigned char* ldsL, int vcu0, int nwg) {
    using namespace fa;
    const int tid = threadIdx.x, wid = __builtin_amdgcn_readfirstlane(tid >> 6), lane = tid & 63, r32 = lane & 31, hi = lane >> 5;
    const bf16* qc = (const bf16*)(p.ws + WS_QC); const bf16* kvm = (const bf16*)(p.ws + WS_KVM); bf16* oc = (bf16*)(p.ws + WS_OC);
    typedef CoreSeqG<16, 8, 4> CC;
    constexpr int SCR = 131072 + 8192;
    float* wsf = (float*)(lds + SCR + 2048) + wid * 64;
    const int ovoff = (4 * hi * DM + r32) * 2;
#pragma nounroll
    for (int u = vcu0; u < 1024; u += nwg) {
        const int bh = u >> 5, rb = u & 31, b = bh >> 2, head = bh & 3, dh = wid >> 2;
        const size_t row0 = (size_t)b * SEQ + rb * 128 + (wid & 3) * 32;
        const __amdgpu_buffer_rsrc_t rso = mk_rsrc(oc + row0 * DM + head * 256 + dh * 128);
        f32x16 o[4]; float m_reg, l_reg;
        CC::run(o, m_reg, l_reg, qc + row0 * DM + head * 256, DM, kvm + (size_t)b * MEML * 2048 + head * 256, kvm + (size_t)b * MEML * 2048 + 1024 + head * 256, 2048, MEML / 64, lds, (CC::lptr)(__attribute__((address_space(3))) void*)ldsL, SCR, dh * 4);
        if (hi == 0) wsf[r32] = l_reg;
        asm volatile("s_waitcnt lgkmcnt(0)" ::: "memory");
#pragma unroll
        for (int r = 0; r < 16; ++r) { const float rl = 1.0f / wsf[crow(r, hi)];
#pragma unroll
            for (int d0 = 0; d0 < 4; ++d0) { const float y = o[d0][r] * rl; const float yn = __shfl_xor(y, 1);
                if ((r32 & 1) == 0) __builtin_amdgcn_raw_buffer_store_b32(cvtpk(y, yn), rso, ovoff, (((r & 3) + 8 * (r >> 2)) * DM + d0 * 32) * 2, 0); } }
        asm volatile("s_waitcnt lgkmcnt(0)" ::: "memory");
    }
}
#define GAS __attribute__((address_space(1)))
typedef GAS unsigned gu32;
constexpr int CW_BAR = 4096;
constexpr size_t CTL_ZERO_BYTES = 65536;
constexpr int MISC_OFF = 131072 + 320, TAB_OFF = 131072 + 1024;
constexpr int CW_PANEL = 8192;
constexpr size_t WS_XCH = 60 * MiB;
#define XB_TMO      128
#define XB_XCNT(j)  (256  + 64 * (j))
#define XB_XSUB(j)  (1280 + 64 * (j))
#define XB_XGEN(j)  (2304 + 64 * (j))
#define XB_TOP      3328
#define XB_TOPGEN   3392
#define XCD_BAR_WORDS 3456
#define XB_SPIN_CAP (1u << 18)

__device__ __forceinline__ unsigned xb_ld(unsigned* p)              { return __hip_atomic_load(p, __ATOMIC_RELAXED, __HIP_MEMORY_SCOPE_AGENT); }
__device__ __forceinline__ unsigned xb_add(unsigned* p, unsigned v) { return __hip_atomic_fetch_add(p, v, __ATOMIC_RELAXED, __HIP_MEMORY_SCOPE_AGENT); }
__device__ __forceinline__ unsigned xb_xcc_id() { return (unsigned)__builtin_amdgcn_s_getreg((3 << 11) | 20) & 0xFu; }
#define XB_SPIN(cond, bar) do { unsigned _sp = 0; while (cond) { __builtin_amdgcn_s_sleep(1); \
    if ((++_sp & 255u) == 0u) { if (xb_ld(&(bar)[XB_TMO])) break; if (_sp > XB_SPIN_CAP) { atomicAdd(&(bar)[XB_TMO], 1u); break; } } } } while (0)

struct XcdBarrier {
    unsigned* bar; unsigned x;
    volatile LAS unsigned* st;
};

__device__ __forceinline__ XcdBarrier xcd_barrier_post(unsigned* bar, volatile LAS unsigned* st) {
    XcdBarrier b; b.bar = bar; b.x = xb_xcc_id(); b.st = st;
    if (threadIdx.x == 0) (void)xb_add(&bar[XB_XCNT(b.x)], 1u);
    return b;
}
__device__ __forceinline__ void xcd_barrier_complete(unsigned* bar, unsigned x, unsigned& nloc, unsigned& nx) {
    const unsigned G = gridDim.x * gridDim.y * gridDim.z;
    unsigned sum, cnt, mine, sp = 0u;
    for (;;) {
        sum = 0u; cnt = 0u; mine = 0u;
#pragma unroll
        for (unsigned j = 0; j < 16; ++j) { const unsigned c = xb_ld(&bar[XB_XCNT(j)]); sum += c; cnt += (c > 0u) ? 1u : 0u; mine = (j == x) ? c : mine; }
        if (sum == G) break;
        __builtin_amdgcn_s_sleep(1);
        if ((++sp & 255u) == 0u) { if (xb_ld(&bar[XB_TMO])) break; if (sp > XB_SPIN_CAP) { atomicAdd(&bar[XB_TMO], 1u); break; } }
    }
    nloc = mine > 0u ? mine : 1u; nx = cnt > 0u ? cnt : 1u;
}

__device__ __forceinline__ void xcd_barrier(const XcdBarrier& b) {
    asm volatile("s_waitcnt vmcnt(0)" ::: "memory");
    __syncthreads();
    if (threadIdx.x == 0) {
        unsigned* bar = b.bar;
        __builtin_amdgcn_s_waitcnt(0);
        unsigned nloc = b.st[0], nx = b.st[1];
        if (nloc == 0u) { xcd_barrier_complete(bar, b.x, nloc, nx); b.st[0] = nloc; b.st[1] = nx; }
        const unsigned old = xb_add(&bar[XB_XSUB(b.x)], 1u);
        const unsigned gen = old / nloc;
        if (old + 1u == (gen + 1u) * nloc) {
            __builtin_amdgcn_fence(__ATOMIC_RELEASE, "agent");
            asm volatile("s_waitcnt vmcnt(0)" ::: "memory");
            const unsigned og = xb_add(&bar[XB_TOP], 1u);
            const unsigned tg = og / nx;
            if (og + 1u == (tg + 1u) * nx) xb_add(&bar[XB_TOPGEN], 1u);
            else XB_SPIN(xb_ld(&bar[XB_TOPGEN]) == tg, bar);
            __builtin_amdgcn_fence(__ATOMIC_ACQUIRE, "agent");
            xb_add(&bar[XB_XGEN(b.x)], 1u);
            asm volatile("s_waitcnt vmcnt(0)" ::: "memory");
        } else {
            XB_SPIN(xb_ld(&bar[XB_XGEN(b.x)]) == gen, bar);
            __builtin_amdgcn_fence(__ATOMIC_ACQUIRE, "agent");
            asm volatile("s_waitcnt vmcnt(0)" ::: "memory");
        }
    }
    __syncthreads();
}

constexpr int LDS_BYTES = 147456;
constexpr size_t WS_SS3 = 58 * MiB;
__device__ __forceinline__ void final_norm_ss(float* X, const float* ss, const float* g, int gw, int ngw, int lane) {
    for (int m = gw; m < M; m += ngw) {
        const float rstd = pg8::rstd_ss(ss, m);
        f32x4* xr = (f32x4*)(X + (size_t)m * DM) + lane;
#pragma unroll
        for (int j = 0; j < 4; ++j) { const f32x4 gg = ((const f32x4*)g)[lane + 64 * j]; xr[64 * j] = xr[64 * j] * rstd * gg; }
    }
}
constexpr int N_PHASES = 10;
__global__ void __launch_bounds__(NTHR, 2) fwd_kernel(Params p) {
    extern __shared__ __attribute__((aligned(16))) unsigned char lds_raw[];
    LAS unsigned char* lds = (LAS unsigned char*)lds_raw;
    for (int u = threadIdx.x; u < 64; u += NTHR) ((LAS unsigned*)(lds + MISC_OFF))[u] = 0u;
    __syncthreads();
    XcdBarrier bar = xcd_barrier_post((unsigned*)(p.ws + WS_CTL) + CW_BAR, (volatile LAS unsigned*)(lds + MISC_OFF) + 8);
    const int tid = threadIdx.x, wave = __builtin_amdgcn_readfirstlane(tid >> 6), lane = tid & 63, bid = blockIdx.x, nblk = gridDim.x;
    const int gw = bid * NWAVES + wave, ngw = nblk * NWAVES;
    const int vcu = (nblk % 8 == 0) ? (bid % 8) * (nblk / 8) + bid / 8 : bid;
    unsigned char* ws = p.ws;
    const int lo = p.ph_lo, hi = p.ph_hi;
    typedef pg8::bf16_t b16;
#define IN(k) (lo <= (k) && (k) < hi)
#define SEAM(k) do { if (IN(k) && IN((k) + 1) && !((k) == 8 && nblk == 256)) xcd_barrier(bar); } while (0)
    if (IN(0)) { p0_prologue(p, lds, bid, nblk, tid); } SEAM(0);
    if (IN(1)) {
        pg8::Gemm g{(const b16*)(ws + WS_XN), (const b16*)(ws + WS_WIN), (const b16*)(ws + WS_MEMN), (const b16*)(ws + WS_WCKV), DM};
        pg8::TwoOrder S; S.init(M, NP, nblk, bid); S.n2M = MM / 256; S.n2N = 2048 / 256;
        pg8::EpiProj E{(b16*)(ws + WS_PROJ), (b16*)(ws + WS_KVM), (const float*)(ws + WS_ROPE)};
        pg8::gemm_phase<pg8::EpiProj, pg8::TwoOrder, true, true>(lds, g, S, E);
    } SEAM(1);
    if (IN(2)) { attn_phase(p, (char*)lds_raw, vcu, nblk);
    } SEAM(2);
    if (IN(3)) {
        pg8::Gemm g{(const b16*)(ws + WS_ATT), (const b16*)(ws + WS_WOUT), nullptr, nullptr, DM};
        pg8::StaticOrder S; S.init(M, DM, nblk, bid);
        pg8::EpiResB<true> E{p.x, nullptr, (b16*)(ws + WS_XN), (float*)(ws + WS_SS1)};
        pg8::gemm_phase<pg8::EpiResB<true>, pg8::StaticOrder, true, true>(lds, g, S, E);
    } SEAM(3);
    if (IN(4)) {
        pg8::Gemm g{(const b16*)(ws + WS_XN), (const b16*)(ws + WS_WCQ), nullptr, nullptr, DM};
        pg8::StaticOrder S; S.init(M, DM, nblk, bid);
        pg8::EpiScaleBf16<0> E{(b16*)(ws + WS_QC), DM, (const float*)(ws + WS_SS1), CQ, lds + TAB_OFF};
        pg8::gemm_phase<pg8::EpiScaleBf16<0>, pg8::StaticOrder, true, true>(lds, g, S, E);
    } SEAM(4);
    if (IN(5)) { cross_phase(p, (char*)lds_raw, lds, vcu, nblk); } SEAM(5);
    if (IN(6)) {
        pg8::Gemm g{(const b16*)(ws + WS_OC), (const b16*)(ws + WS_WCO), nullptr, nullptr, DM};
        pg8::StaticOrder S; S.init(M, DM, nblk, bid);
        pg8::EpiResB<false> E{nullptr, (const b16*)(ws + WS_XN), (b16*)(ws + WS_XN), (float*)(ws + WS_SS2)};
        pg8::gemm_phase<pg8::EpiResB<false>, pg8::StaticOrder, true, true>(lds, g, S, E);
    } SEAM(6);
    if (IN(7)) {
        pg8::Gemm g{(const b16*)(ws + WS_XN), (const b16*)(ws + WS_WUP), nullptr, nullptr, DM};
        pg8::StaticOrder S; S.init(M, FF, nblk, bid);
        pg8::EpiScaleBf16<1> E{(b16*)(ws + WS_ACT), FF, (const float*)(ws + WS_SS2), 1.f, lds + TAB_OFF};
        pg8::gemm_phase<pg8::EpiScaleBf16<1>, pg8::StaticOrder, true, true>(lds, g, S, E);
    } SEAM(7);
    if (IN(8)) {
        pg8::Gemm g{(const b16*)(ws + WS_ACT), (const b16*)(ws + WS_WDOWN), nullptr, nullptr, FF};
        pg8::StaticOrder S; S.init(M, DM, nblk, bid);
        if (nblk == 256) {
            pg8::EpiFinal E{(const b16*)(ws + WS_XN), p.out, p.g_final, (unsigned*)(ws + WS_XCH), (unsigned*)(ws + WS_CTL) + CW_PANEL, lds + TAB_OFF};
            pg8::gemm_phase<pg8::EpiFinal, pg8::StaticOrder, true, true>(lds, g, S, E);
        } else {
            pg8::EpiResF E{(const b16*)(ws + WS_XN), p.out, (float*)(ws + WS_SS3)};
            pg8::gemm_phase<pg8::EpiResF, pg8::StaticOrder, true, true>(lds, g, S, E);
        }
    } SEAM(8);
    if (IN(9) && nblk != 256) { final_norm_ss(p.out, (const float*)(ws + WS_SS3), p.g_final, gw, ngw, lane); }
#undef IN
#undef SEAM
}

extern "C" void kernel_launch(void* const* d_in, const int* in_sizes, int n_in, void* d_out, int out_size, void* d_ws, size_t ws_size, hipStream_t stream) {
    static int grid = 0;
    if (grid == 0) {
        if (n_in != 21 || out_size != M * DM || ws_size < WS_END) { fprintf(stderr, "kernel_launch: unexpected shapes (n_in %d out %d ws %zu)\n", n_in, out_size, ws_size); grid = -1; return; }
        int dev = 0, cus = 0, per_cu = 0;
        (void)hipGetDevice(&dev); (void)hipDeviceGetAttribute(&cus, hipDeviceAttributeMultiprocessorCount, dev);
        if (hipFuncSetAttribute((const void*)fwd_kernel, hipFuncAttributeMaxDynamicSharedMemorySize, LDS_BYTES) != hipSuccess) { fprintf(stderr, "kernel_launch: hipFuncSetAttribute failed\n"); grid = -1; return; }
        (void)hipOccupancyMaxActiveBlocksPerMultiprocessor(&per_cu, (const void*)fwd_kernel, NTHR, LDS_BYTES);
        if (per_cu < 1) { fprintf(stderr, "kernel_launch: occupancy query says %d blocks per CU\n", per_cu); per_cu = 1; }
        grid = cus;
    }
    if (grid < 0) return;
    Params p{};
    p.x = (const float*)d_in[0]; p.mem = (const float*)d_in[1]; p.pos = (const int*)d_in[2]; p.g_mix = (const float*)d_in[3]; p.w_in = (const float*)d_in[4];
    p.sinks = (const float*)d_in[5]; p.lq1 = (const float*)d_in[6]; p.lk1 = (const float*)d_in[7]; p.lq2 = (const float*)d_in[8]; p.lk2 = (const float*)d_in[9];
    p.g_diff = (const float*)d_in[10]; p.w_out = (const float*)d_in[11]; p.g_cross = (const float*)d_in[12]; p.g_mem = (const float*)d_in[13]; p.w_cq = (const float*)d_in[14];
    p.w_ckv = (const float*)d_in[15]; p.w_co = (const float*)d_in[16]; p.g_mlp = (const float*)d_in[17]; p.w_up = (const float*)d_in[18]; p.w_down = (const float*)d_in[19]; p.g_final = (const float*)d_in[20];
    p.out = (float*)d_out; p.ws = (unsigned char*)d_ws;
    if (hipMemsetAsync((char*)d_ws + WS_CTL, 0, CTL_ZERO_BYTES, stream) != hipSuccess) { fprintf(stderr, "kernel_launch: hipMemsetAsync of the control words failed\n"); return; }
    p.ph_lo = 0; p.ph_hi = N_PHASES;
    hipLaunchKernelGGL(fwd_kernel, dim3(grid), dim3(NTHR), LDS_BYTES, stream, p);
}
```

```cpp
#include <hip/hip_runtime.h>
#include <cstdio>
#include <cstdint>


#define LAS __attribute__((address_space(3)))
typedef unsigned short bf16;
typedef short bf16x8 __attribute__((ext_vector_type(8)));
typedef float f32x4 __attribute__((ext_vector_type(4)));
typedef unsigned u32x4 __attribute__((ext_vector_type(4)));
typedef unsigned u32x2 __attribute__((ext_vector_type(2)));

constexpr int BATCH = 8, SEQ = 4096, M = BATCH * SEQ, DM = 1024, NP = 2304, MEML = 256, MM = BATCH * MEML, FF = 4096;
constexpr int NWAVES = 8, NTHR = NWAVES * 64;
constexpr float EPS = 1e-5f;
constexpr float LOG2E = 1.4426950408889634f;
constexpr float C2 = 0.125f * LOG2E;
constexpr float CQ = 0.0625f * LOG2E;
constexpr int C_QA = 0, C_KA = 512, C_VA = 640, C_QD = 768, C_KD = 1280, C_VD = 1792;

constexpr size_t MiB = 1u << 20;
constexpr size_t WS_CTL = 0;
constexpr size_t WS_WIN = 2 * MiB;
constexpr size_t WS_WOUT = WS_WIN + (size_t)NP * DM * 2;
constexpr size_t WS_WCQ = WS_WOUT + 2 * MiB;
constexpr size_t WS_WCKV = WS_WCQ + 2 * MiB;
constexpr size_t WS_WCO = WS_WCKV + 4 * MiB;
constexpr size_t WS_WUP = WS_WCO + 2 * MiB;
constexpr size_t WS_WDOWN = WS_WUP + 8 * MiB;
constexpr size_t WS_ROPE = 34 * MiB;
constexpr size_t WS_KVM = 42 * MiB;
constexpr size_t WS_MEMN = 50 * MiB;
constexpr size_t WS_SS1 = 54 * MiB, WS_SS2 = 56 * MiB;
constexpr size_t WS_XN = 64 * MiB;
constexpr size_t WS_PROJ = 256 * MiB;
constexpr size_t WS_ATT = 400 * MiB;
constexpr size_t WS_QC = 256 * MiB;
constexpr size_t WS_OC = 320 * MiB;
constexpr size_t WS_ACT = 256 * MiB;
constexpr size_t WS_END = 512 * MiB;
static_assert(WS_WDOWN + 8 * MiB <= WS_ROPE, "weights fit");

struct Params {
    const float *x, *mem; const int* pos;
    const float *g_mix, *w_in, *sinks, *lq1, *lk1, *lq2, *lk2, *g_diff, *w_out, *g_cross, *g_mem, *w_cq, *w_ckv, *w_co, *g_mlp, *w_up, *w_down, *g_final;
    float* out; unsigned char* ws; int ph_lo, ph_hi;
};

__device__ __forceinline__ unsigned f2bf(float f) { unsigned u = __builtin_bit_cast(unsigned, f); return (u + 0x7fffu + ((u >> 16) & 1u)) >> 16; }
__device__ __forceinline__ unsigned pk2(float lo, float hi) { return f2bf(lo) | (f2bf(hi) << 16); }
__device__ __forceinline__ float bf2f(unsigned h) { return __builtin_bit_cast(float, h << 16); }
__device__ __forceinline__ float bflo(unsigned w) { return __builtin_bit_cast(float, w << 16); }
__device__ __forceinline__ float bfhi(unsigned w) { return __builtin_bit_cast(float, w & 0xffff0000u); }
__device__ __forceinline__ float wave_sum(float v) {
#pragma unroll
    for (int o = 1; o < 64; o <<= 1) v += __shfl_xor(v, o);
    return v;
}
__device__ __forceinline__ float wave_max(float v) {
#pragma unroll
    for (int o = 1; o < 64; o <<= 1) v = fmaxf(v, __shfl_xor(v, o));
    return v;
}
__host__ __device__ __forceinline__ bool col_roped(int n) { return n < C_VA || (n >= C_QD && n < C_VD); }
__host__ __device__ __forceinline__ int phys_of_logical(int nl) {
    if (!col_roped(nl)) return nl;
    const int g = nl & ~63, j = nl & 63; return g + ((j & 31) << 1) + (j >> 5);
}
__device__ __forceinline__ float calc_lambda(const Params& p) {
    float a = 0.f, b = 0.f;
    for (int i = 0; i < 64; ++i) { a += p.lq1[i] * p.lk1[i]; b += p.lq2[i] * p.lk2[i]; }
    return __expf(a) - __expf(b) + 0.2f;
}

__device__ const double INV_FREQ[32] = {
    1.0, 0.7498942093324559, 0.5623413251903491, 0.4216965034285822,
    0.31622776601683794, 0.23713737056616552, 0.1778279410038923, 0.1333521432163324,
    0.1, 0.07498942093324558, 0.05623413251903491, 0.042169650342858224,
    0.03162277660168379, 0.023713737056616554, 0.01778279410038923, 0.01333521432163324,
    0.01, 0.007498942093324558, 0.005623413251903491, 0.004216965034285823,
    0.0031622776601683794, 0.0023713737056616554, 0.0017782794100389228, 0.001333521432163324,
    0.001, 0.0007498942093324559, 0.0005623413251903491, 0.00042169650342858224,
    0.00031622776601683794, 0.00023713737056616554, 0.00017782794100389227, 0.0001333521432163324};

__device__ __forceinline__ void sincos_d(double a, float& c, float& s) {
    const double kd = rint(a * 0.63661977236758134308);
    const int k = (int)kd;
    double r = fma(-kd, 1.57079632679489655800e+00, a); r = fma(-kd, 6.12323399573676603587e-17, r);
    const double r2 = r * r;
    const double sp = r * (1.0 + r2 * (-1.0 / 6.0 + r2 * (1.0 / 120.0 + r2 * (-1.0 / 5040.0 + r2 * (1.0 / 362880.0 + r2 * (-1.0 / 39916800.0 + r2 * (1.0 / 6227020800.0)))))));
    const double cp = 1.0 + r2 * (-0.5 + r2 * (1.0 / 24.0 + r2 * (-1.0 / 720.0 + r2 * (1.0 / 40320.0 + r2 * (-1.0 / 3628800.0 + r2 * (1.0 / 479001600.0 + r2 * (-1.0 / 87178291200.0)))))));
    const int q = k & 3;
    const double ss = (q == 0) ? sp : (q == 1) ? cp : (q == 2) ? -sp : -cp;
    const double cc = (q == 0) ? cp : (q == 1) ? -sp : (q == 2) ? -cp : sp;
    c = (float)cc; s = (float)ss;
}

template <bool HASG, bool PERMC>
__device__ __forceinline__ void transpose_item(const float* W, int K, int N, const float* g, bf16* WT, LAS float* scr, int item, int lane) {
    const int nblk = N / 32, kb = item / nblk, nb = item % nblk, k0 = 64 * kb, n0 = 32 * nb;
#pragma unroll 16
    for (int i = 0; i < 32; ++i) { const int kk = 2 * i + (lane >> 5); float v = W[(size_t)(k0 + kk) * N + n0 + (lane & 31)]; if (HASG) v *= g[k0 + kk]; scr[kk * 33 + (lane & 31)] = v; }
    asm volatile("s_waitcnt lgkmcnt(0)" ::: "memory");
    const int c = lane & 7;
#pragma unroll
    for (int j = 0; j < 4; ++j) { const int n = (lane >> 3) + 8 * j; const LAS float* s = scr + (8 * c) * 33 + n;
        u32x4 o; o.x = pk2(s[0 * 33], s[1 * 33]); o.y = pk2(s[2 * 33], s[3 * 33]); o.z = pk2(s[4 * 33], s[5 * 33]); o.w = pk2(s[6 * 33], s[7 * 33]);
        const int nl = n0 + n, np = PERMC ? phys_of_logical(nl) : nl;
        *(u32x4*)(WT + (size_t)np * K + k0 + 8 * c) = o; }
    asm volatile("s_waitcnt lgkmcnt(0)" ::: "memory");
}
__device__ __forceinline__ void rms_row_to_bf16(const float* xrow, const float* g, bf16* orow, int lane) {
    const f32x4* xr = (const f32x4*)xrow + lane;
    f32x4 v[4]; float s = 0.f;
#pragma unroll
    for (int j = 0; j < 4; ++j) { v[j] = xr[64 * j]; s += (v[j].x * v[j].x + v[j].y * v[j].y) + (v[j].z * v[j].z + v[j].w * v[j].w); }
    const float rstd = 1.0f / sqrtf(wave_sum(s) * (1.f / DM) + EPS);
    u32x2* o8 = (u32x2*)orow + lane;
#pragma unroll
    for (int j = 0; j < 4; ++j) {
        f32x4 gg = (f32x4){1.f, 1.f, 1.f, 1.f}; if (g) gg = ((const f32x4*)g)[lane + 64 * j];
        u32x2 w; w.x = pk2(v[j].x * rstd * gg.x, v[j].y * rstd * gg.y); w.y = pk2(v[j].z * rstd * gg.z, v[j].w * rstd * gg.w); o8[64 * j] = w; }
}
__device__ __forceinline__ void p0_prologue(const Params& p, LAS unsigned char* lds, int bid, int nblk, int tid) {
    const int wave = tid >> 6, lane = tid & 63;
    LAS float* scr = (LAS float*)(lds + wave * 8704);
    const int gw = bid * NWAVES + wave, NGW = nblk * NWAVES;
    unsigned char* ws = p.ws;
    constexpr int I_IN = (DM / 64) * (NP / 32), I_SQ = (DM / 64) * (DM / 32), I_KV = (DM / 64) * (2048 / 32), I_UP = (DM / 64) * (FF / 32), I_DN = (FF / 64) * (DM / 32);
    constexpr int NITEMS = I_IN + 3 * I_SQ + I_KV + I_UP + I_DN;
    for (int it = gw; it < NITEMS; it += NGW) {
        int r = it;
        if (r < I_IN) { transpose_item<true, true>(p.w_in, DM, NP, p.g_mix, (bf16*)(ws + WS_WIN), scr, r, lane); continue; } r -= I_IN;
        if (r < I_SQ) { transpose_item<false, false>(p.w_out, DM, DM, nullptr, (bf16*)(ws + WS_WOUT), scr, r, lane); continue; } r -= I_SQ;
        if (r < I_SQ) { transpose_item<true, false>(p.w_cq, DM, DM, p.g_cross, (bf16*)(ws + WS_WCQ), scr, r, lane); continue; } r -= I_SQ;
        if (r < I_KV) { transpose_item<false, false>(p.w_ckv, DM, 2048, nullptr, (bf16*)(ws + WS_WCKV), scr, r, lane); continue; } r -= I_KV;
        if (r < I_SQ) { transpose_item<false, false>(p.w_co, DM, DM, nullptr, (bf16*)(ws + WS_WCO), scr, r, lane); continue; } r -= I_SQ;
        if (r < I_UP) { transpose_item<true, false>(p.w_up, DM, FF, p.g_mlp, (bf16*)(ws + WS_WUP), scr, r, lane); continue; } r -= I_UP;
        transpose_item<false, false>(p.w_down, FF, DM, nullptr, (bf16*)(ws + WS_WDOWN), scr, r, lane);
    }
    for (int m = gw * 2; m < M; m += NGW * 2) {
        const f32x4* x0 = (const f32x4*)(p.x + (size_t)m * DM) + lane; const f32x4* x1 = x0 + DM / 4;
        f32x4 v0[4], v1[4]; float s0 = 0.f, s1 = 0.f;
#pragma unroll
        for (int j = 0; j < 4; ++j) { v0[j] = x0[64 * j]; v1[j] = x1[64 * j]; }
#pragma unroll
        for (int j = 0; j < 4; ++j) { s0 += (v0[j].x * v0[j].x + v0[j].y * v0[j].y) + (v0[j].z * v0[j].z + v0[j].w * v0[j].w); s1 += (v1[j].x * v1[j].x + v1[j].y * v1[j].y) + (v1[j].z * v1[j].z + v1[j].w * v1[j].w); }
#pragma unroll
        for (int o = 1; o < 64; o <<= 1) { s0 += __shfl_xor(s0, o); s1 += __shfl_xor(s1, o); }
        const float r0 = 1.0f / sqrtf(s0 * (1.f / DM) + EPS), r1 = 1.0f / sqrtf(s1 * (1.f / DM) + EPS);
        u32x2* o0 = (u32x2*)((bf16*)(ws + WS_XN) + (size_t)m * DM) + lane; u32x2* o1 = o0 + DM / 4;
#pragma unroll
        for (int j = 0; j < 4; ++j) { u32x2 w; w.x = pk2(v0[j].x * r0, v0[j].y * r0); w.y = pk2(v0[j].z * r0, v0[j].w * r0); o0[64 * j] = w;
            u32x2 z; z.x = pk2(v1[j].x * r1, v1[j].y * r1); z.y = pk2(v1[j].z * r1, v1[j].w * r1); o1[64 * j] = z; }
    }
    for (int m = gw; m < MM; m += NGW) rms_row_to_bf16(p.mem + (size_t)m * DM, p.g_mem, (bf16*)(ws + WS_MEMN) + (size_t)m * DM, lane);
    float2* rope = (float2*)(ws + WS_ROPE);
    for (int i = bid * NTHR + tid; i < M * 32; i += nblk * NTHR) {
        const int row = i >> 5, d = i & 31; float c, s; sincos_d((double)p.pos[row] * INV_FREQ[d], c, s); rope[i] = make_float2(c, s); }
}

namespace pg8 {
#define PG8_LAS __attribute__((address_space(3)))
typedef unsigned short bf16_t;
typedef short bf16x8 __attribute__((ext_vector_type(8)));
typedef float f32x4 __attribute__((ext_vector_type(4)));
typedef unsigned u32x4 __attribute__((ext_vector_type(4)));
typedef unsigned u32x2 __attribute__((ext_vector_type(2)));
constexpr int BM = 256, BK = 64, HALF = 128, HTB = HALF * BK * 2  , STAGE_BYTES = 8 * HTB, NXCD = 8, WGM = 8;

__host__ __device__ __forceinline__ int lds_byte(int r, int c) { const int st = (r >> 4) * 2 + (c >> 5), rr = r & 15, cc = c & 31, ob = rr * 64 + cc * 2; return st * 1024 + (ob ^ (((ob >> 9) & 1) << 5)); }
__host__ __device__ __forceinline__ void stage_rc(int b, int& R, int& C) { const int st = b / 1024, sb = b % 1024, swz = sb ^ (((sb >> 9) & 1) << 5); R = (st >> 1) * 16 + swz / 64; C = (st & 1) * 32 + (swz % 64) / 2; }
__host__ __device__ __forceinline__ int perm32(int rho) { const int n = rho >> 4, i = rho & 15; return 8 * (i >> 2) + 4 * n + (i & 3); }

struct Unit { int pm, pn, alt; };
struct Gemm { const bf16_t* A; const bf16_t* Bt; const bf16_t* A2; const bf16_t* Bt2; int K; };

struct StaticOrder {
    int nM, nN, nwg, G, c;
    __host__ __device__ void init(int M_, int N_, int G_, int c_) { nM = M_ / BM; nN = N_ / BM; nwg = nM * nN; G = G_; c = c_; }
    __host__ __device__ bool map(long L, Unit& u) const {
        if (L >= nwg) return false;
        int wgid = (int)L; { const int q = nwg / NXCD, r = nwg % NXCD, xcd = wgid % NXCD, off = wgid / NXCD; wgid = (xcd < r ? xcd * (q + 1) : r * (q + 1) + (xcd - r) * q) + off; }
        const int nig = WGM * nN, gid = wgid / nig, fm = gid * WGM, gsz = (nM - fm) < WGM ? (nM - fm) : WGM;
        u.pm = fm + ((wgid % nig) % gsz); u.pn = (wgid % nig) / gsz; u.alt = 0; return true;
    }
    __host__ __device__ bool next(int i, Unit& u) const { return map((long)i * G + c, u); }
    __device__ __forceinline__ void a_ready(const Unit&) const {}
    __device__ __forceinline__ void done(const Unit&) const {}
};
struct OneUnit {
    Unit u;
    __device__ __forceinline__ bool next(int i, Unit& o) const { if (i) return false; o = u; return true; }
    __device__ __forceinline__ void a_ready(const Unit&) const {}
    __device__ __forceinline__ void done(const Unit&) const {}
};
struct TwoOrder : StaticOrder {
    int n2M, n2N;
    __host__ __device__ bool next(int i, Unit& u) const {
        const long L = (long)i * G + c;
        if (L < nwg) return map(L, u);
        const int r = (int)(L - nwg); if (r >= n2M * n2N) return false;
        u.pm = r % n2M; u.pn = r / n2M; u.alt = 1; return true;
    }
};
__device__ __forceinline__ unsigned cvt_pk_bf16(float lo, float hi) { unsigned r; asm volatile("v_cvt_pk_bf16_f32 %0, %1, %2" : "=v"(r) : "v"(lo), "v"(hi)); return r; }

__device__ __forceinline__ float rstd_ss(const float* ss, int row) {
    const f32x4* s4 = (const f32x4*)(ss + (size_t)row * 16); float t = 0.f;
#pragma unroll
    for (int i = 0; i < 4; ++i) { const f32x4 v = s4[i]; t += (v.x + v.y) + (v.z + v.w); }
    return 1.0f / sqrtf(t * (1.f / DM) + EPS);
}
struct EpiProj {
    static constexpr bool PERM = true, AFTER_DRAIN = false;
    bf16_t* proj; bf16_t* kvm; const float* rope;
    __device__ __forceinline__ void operator()(const f32x4 (&acc)[2][2][4][2], const Unit& u, int wr, int wc, int fr, int fq) const {
        const int row0 = u.pm * BM + wr * 64 + fr, col0 = u.pn * BM + wc * 32 + 8 * fq;
        if (u.alt) {
#pragma unroll
            for (int ai = 0; ai < 2; ++ai)
#pragma unroll
                for (int m = 0; m < 4; ++m) { bf16_t* rowp = kvm + (size_t)(row0 + ai * HALF + m * 16) * 2048 + col0;
#pragma unroll
                    for (int bj = 0; bj < 2; ++bj) { const f32x4 v0 = acc[ai][bj][m][0], v1 = acc[ai][bj][m][1];
                        u32x4 w; w.x = cvt_pk_bf16(v0[0], v0[1]); w.y = cvt_pk_bf16(v0[2], v0[3]); w.z = cvt_pk_bf16(v1[0], v1[1]); w.w = cvt_pk_bf16(v1[2], v1[3]);
                        *(u32x4*)(rowp + bj * HALF) = w; } }
            return;
        }
        const int d0 = ((wc & 1) * 32 + 8 * fq) >> 1;
#pragma unroll
        for (int ai = 0; ai < 2; ++ai) {
            f32x4 csa[4], csb[4];
#pragma unroll
            for (int m = 0; m < 4; ++m) { const size_t ro = (size_t)(row0 + ai * HALF + m * 16) * 64 + 2 * d0; csa[m] = *(const f32x4*)(rope + ro); csb[m] = *(const f32x4*)(rope + ro + 4); }
#pragma unroll
            for (int m = 0; m < 4; ++m) { const int row = row0 + ai * HALF + m * 16;
                const f32x4 cs0 = csa[m], cs1 = csb[m];
#pragma unroll
                for (int bj = 0; bj < 2; ++bj) { const int cb = u.pn * BM + bj * HALF;
                    const bool roped = col_roped(cb); const float sc = (cb < C_KA || (cb >= C_QD && cb < C_KD)) ? C2 : 1.f;
                    f32x4 v0 = acc[ai][bj][m][0], v1 = acc[ai][bj][m][1];
                    if (roped) {
                        const f32x4 a = v0, b = v1;
                        v0[0] = a[0] * cs0[0] - a[1] * cs0[1]; v0[1] = a[1] * cs0[0] + a[0] * cs0[1];
                        v0[2] = a[2] * cs0[2] - a[3] * cs0[3]; v0[3] = a[3] * cs0[2] + a[2] * cs0[3];
                        v1[0] = b[0] * cs1[0] - b[1] * cs1[1]; v1[1] = b[1] * cs1[0] + b[0] * cs1[1];
                        v1[2] = b[2] * cs1[2] - b[3] * cs1[3]; v1[3] = b[3] * cs1[2] + b[2] * cs1[3];
                    }
                    v0 = v0 * sc; v1 = v1 * sc;
                    u32x4 w; w.x = cvt_pk_bf16(v0[0], v0[1]); w.y = cvt_pk_bf16(v0[2], v0[3]); w.z = cvt_pk_bf16(v1[0], v1[1]); w.w = cvt_pk_bf16(v1[2], v1[3]);
                    *(u32x4*)(proj + (size_t)row * NP + col0 + bj * HALF) = w; } }
        }
    }
};
struct EpiRes {
    static constexpr bool PERM = false, AFTER_DRAIN = false;
    const float* xi; float* xo; bf16_t* xb; float* ss;
    __device__ __forceinline__ void operator()(const f32x4 (&acc)[2][2][4][2], const Unit& u, int wr, int wc, int fr, int fq) const {
        const int row0 = u.pm * BM + wr * 64 + fr, col0 = u.pn * BM + wc * 32 + 4 * fq;
#pragma unroll
        for (int ai = 0; ai < 2; ++ai)
#pragma unroll
            for (int m = 0; m < 4; ++m) { const int row = row0 + ai * HALF + m * 16; const size_t off = (size_t)row * DM + col0; float q = 0.f;
#pragma unroll
                for (int bj = 0; bj < 2; ++bj)
#pragma unroll
                    for (int n = 0; n < 2; ++n) { const size_t c = off + bj * HALF + n * 16; const f32x4 r = *(const f32x4*)(xi + c) + acc[ai][bj][m][n];
                        *(f32x4*)(xo + c) = r; q += (r[0] * r[0] + r[1] * r[1]) + (r[2] * r[2] + r[3] * r[3]);
                        if (xb) { u32x2 w; w.x = cvt_pk_bf16(r[0], r[1]); w.y = cvt_pk_bf16(r[2], r[3]); *(u32x2*)(xb + c) = w; } }
                q += __shfl_xor(q, 16); q += __shfl_xor(q, 32);
                if (fq == 0) ss[(size_t)row * 16 + u.pn * 4 + wc] = q;
                if (m & 1) asm volatile("" ::: "memory"); }
    }
};
template <bool XF> struct EpiResB {
    static constexpr bool PERM = true, AFTER_DRAIN = false;
    const float* xf; const bf16_t* xb_in; bf16_t* xb_out; float* ss;
    __device__ __forceinline__ void operator()(const f32x4 (&acc)[2][2][4][2], const Unit& u, int wr, int wc, int fr, int fq) const {
        const int row0 = u.pm * BM + wr * 64 + fr, col0 = u.pn * BM + wc * 32 + 8 * fq;
#pragma unroll
        for (int ai = 0; ai < 2; ++ai) {
            u32x4 pre[4][2];
            if (!XF) {
#pragma unroll
                for (int m = 0; m < 4; ++m)
#pragma unroll
                    for (int bj = 0; bj < 2; ++bj) pre[m][bj] = *(const u32x4*)(xb_in + (size_t)(row0 + ai * HALF + m * 16) * DM + col0 + bj * HALF); }
#pragma unroll
            for (int m = 0; m < 4; ++m) { const int row = row0 + ai * HALF + m * 16; const size_t off = (size_t)row * DM + col0; float q = 0.f;
#pragma unroll
                for (int bj = 0; bj < 2; ++bj) { f32x4 r0, r1;
                    if (XF) { r0 = *(const f32x4*)(xf + off + bj * HALF); r1 = *(const f32x4*)(xf + off + bj * HALF + 4); }
                    else { const u32x4 w = pre[m][bj];
                        r0 = (f32x4){__uint_as_float(w.x << 16), __uint_as_float(w.x & 0xffff0000u), __uint_as_float(w.y << 16), __uint_as_float(w.y & 0xffff0000u)};
                        r1 = (f32x4){__uint_as_float(w.z << 16), __uint_as_float(w.z & 0xffff0000u), __uint_as_float(w.w << 16), __uint_as_float(w.w & 0xffff0000u)}; }
                    r0 = r0 + acc[ai][bj][m][0]; r1 = r1 + acc[ai][bj][m][1];
                    q += ((r0[0] * r0[0] + r0[1] * r0[1]) + (r0[2] * r0[2] + r0[3] * r0[3])) + ((r1[0] * r1[0] + r1[1] * r1[1]) + (r1[2] * r1[2] + r1[3] * r1[3]));
                    u32x4 w; w.x = cvt_pk_bf16(r0[0], r0[1]); w.y = cvt_pk_bf16(r0[2], r0[3]); w.z = cvt_pk_bf16(r1[0], r1[1]); w.w = cvt_pk_bf16(r1[2], r1[3]);
                    *(u32x4*)(xb_out + off + bj * HALF) = w; }
                q += __shfl_xor(q, 16); q += __shfl_xor(q, 32);
                if (fq == 0) ss[(size_t)row * 16 + u.pn * 4 + wc] = q; }
            asm volatile("" ::: "memory");
        }
    }
};
struct EpiResF {
    static constexpr bool PERM = false, AFTER_DRAIN = false;
    const bf16_t* xb; float* xo; float* ss;
    __device__ __forceinline__ void operator()(const f32x4 (&acc)[2][2][4][2], const Unit& u, int wr, int wc, int fr, int fq) const {
        const int row0 = u.pm * BM + wr * 64 + fr, col0 = u.pn * BM + wc * 32 + 4 * fq;
#pragma unroll
        for (int ai = 0; ai < 2; ++ai)
#pragma unroll
            for (int m = 0; m < 4; ++m) { const int row = row0 + ai * HALF + m * 16; const size_t off = (size_t)row * DM + col0; float q = 0.f;
#pragma unroll
                for (int bj = 0; bj < 2; ++bj)
#pragma unroll
                    for (int n = 0; n < 2; ++n) { const size_t c = off + bj * HALF + n * 16; const u32x2 w = *(const u32x2*)(xb + c);
                        const f32x4 r = (f32x4){__uint_as_float(w.x << 16), __uint_as_float(w.x & 0xffff0000u), __uint_as_float(w.y << 16), __uint_as_float(w.y & 0xffff0000u)} + acc[ai][bj][m][n];
                        *(f32x4*)(xo + c) = r; q += (r[0] * r[0] + r[1] * r[1]) + (r[2] * r[2] + r[3] * r[3]); }
                q += __shfl_xor(q, 16); q += __shfl_xor(q, 32);
                if (fq == 0) ss[(size_t)row * 16 + u.pn * 4 + wc] = q;
                if (m & 1) asm volatile("" ::: "memory"); }
    }
};
struct EpiFinal {
    static constexpr bool PERM = false, AFTER_DRAIN = false;
    const bf16_t* xb; float* out; const float* g; unsigned* xbuf; unsigned* cnt; PG8_LAS unsigned char* tab;
    __device__ __forceinline__ void operator()(f32x4 (&acc)[2][2][4][2], const Unit& u, int wr, int wc, int fr, int fq) const {
        const int tid = threadIdx.x, lane = tid & 63, wid = __builtin_amdgcn_readfirstlane(tid >> 6);
        PG8_LAS float* P = (PG8_LAS float*)tab; PG8_LAS float* S = (PG8_LAS float*)(tab + 4096);
        const int col0 = u.pn * BM + wc * 32 + 4 * fq;
#pragma unroll
        for (int ai = 0; ai < 2; ++ai)
#pragma unroll
            for (int m = 0; m < 4; ++m) { const int rl = ai * HALF + wr * 64 + m * 16 + fr; const size_t off = (size_t)(u.pm * BM + rl) * DM + col0; float q = 0.f;
#pragma unroll
                for (int bj = 0; bj < 2; ++bj)
#pragma unroll
                    for (int n = 0; n < 2; ++n) { const u32x2 w = *(const u32x2*)(xb + off + bj * HALF + n * 16);
                        const f32x4 r = (f32x4){__uint_as_float(w.x << 16), __uint_as_float(w.x & 0xffff0000u), __uint_as_float(w.y << 16), __uint_as_float(w.y & 0xffff0000u)} + acc[ai][bj][m][n];
                        acc[ai][bj][m][n] = r; q += (r[0] * r[0] + r[1] * r[1]) + (r[2] * r[2] + r[3] * r[3]); }
                q += __shfl_xor(q, 16); q += __shfl_xor(q, 32);
                if (fq == 0) P[rl * 4 + wc] = q;
                if (m & 1) asm volatile("" ::: "memory"); }
        asm volatile("s_waitcnt lgkmcnt(0)" ::: "memory"); __builtin_amdgcn_s_barrier(); asm volatile("" ::: "memory");
        unsigned* slot = xbuf + ((size_t)(u.pm * BM + (tid & 255)) * 4);
        if (tid < 256) { const f32x4 a = *(const PG8_LAS f32x4*)(P + tid * 4);
            __hip_atomic_store(slot + u.pn, __float_as_uint((a[0] + a[1]) + (a[2] + a[3])), __ATOMIC_RELAXED, __HIP_MEMORY_SCOPE_AGENT); }
        asm volatile("s_waitcnt vmcnt(0)" ::: "memory");
        if (tid < 256 && lane == 0) __hip_atomic_fetch_add(cnt + 64 * u.pm, 1u, __ATOMIC_RELAXED, __HIP_MEMORY_SCOPE_AGENT);
        if (wid == 0) {
            unsigned sp = 0;
            while ((unsigned)__builtin_amdgcn_readfirstlane(__hip_atomic_load(cnt + 64 * u.pm, __ATOMIC_RELAXED, __HIP_MEMORY_SCOPE_AGENT)) < 16u) { __builtin_amdgcn_s_sleep(2); if (++sp > (1u << 22)) break; }
            __builtin_amdgcn_fence(__ATOMIC_ACQUIRE, "agent");
        }
        asm volatile("s_waitcnt vmcnt(0) lgkmcnt(0)" ::: "memory"); __builtin_amdgcn_s_barrier(); asm volatile("" ::: "memory");
        if (tid < 256) { float t = 0.f;
#pragma unroll
            for (int k = 0; k < 4; ++k) t += __uint_as_float(__hip_atomic_load(slot + k, __ATOMIC_RELAXED, __HIP_MEMORY_SCOPE_AGENT));
            S[tid] = 1.0f / sqrtf(t * (1.f / DM) + EPS); }
        asm volatile("s_waitcnt lgkmcnt(0)" ::: "memory"); __builtin_amdgcn_s_barrier(); asm volatile("" ::: "memory");
        f32x4 gg[2][2];
#pragma unroll
        for (int bj = 0; bj < 2; ++bj)
#pragma unroll
            for (int n = 0; n < 2; ++n) gg[bj][n] = *(const f32x4*)(g + col0 + bj * HALF + n * 16);
#pragma unroll
        for (int ai = 0; ai < 2; ++ai)
#pragma unroll
            for (int m = 0; m < 4; ++m) { const int rl = ai * HALF + wr * 64 + m * 16 + fr; const size_t off = (size_t)(u.pm * BM + rl) * DM + col0; const float rs = S[rl];
#pragma unroll
                for (int bj = 0; bj < 2; ++bj)
#pragma unroll
                    for (int n = 0; n < 2; ++n) *(f32x4*)(out + off + bj * HALF + n * 16) = acc[ai][bj][m][n] * rs * gg[bj][n]; }
    }
};
template <int ACT> struct EpiScaleBf16 {
    static constexpr bool PERM = true, AFTER_DRAIN = false;
    bf16_t* O; int ldc; const float* ss; float mul; PG8_LAS unsigned char* tab;
    __device__ __forceinline__ void operator()(const f32x4 (&acc)[2][2][4][2], const Unit& u, int wr, int wc, int fr, int fq) const {
        const int tid = threadIdx.x; PG8_LAS float* S = (PG8_LAS float*)tab;
        if (tid < 256) S[tid] = rstd_ss(ss, u.pm * BM + tid) * mul;
        asm volatile("s_waitcnt lgkmcnt(0)" ::: "memory"); __builtin_amdgcn_s_barrier(); asm volatile("" ::: "memory");
        const int rl0 = wr * 64 + fr, col0 = u.pn * BM + wc * 32 + 8 * fq;
#pragma unroll
        for (int ai = 0; ai < 2; ++ai)
#pragma unroll
            for (int m = 0; m < 4; ++m) { const int rl = rl0 + ai * HALF + m * 16; const float rs = S[rl]; bf16_t* rowp = O + (size_t)(u.pm * BM + rl) * ldc + col0;
#pragma unroll
                for (int bj = 0; bj < 2; ++bj) { f32x4 v0 = acc[ai][bj][m][0] * rs, v1 = acc[ai][bj][m][1] * rs;
                    if (ACT == 1) {
#pragma unroll
                        for (int e = 0; e < 4; ++e) { const float a = fmaxf(v0[e], 0.f), b = fmaxf(v1[e], 0.f); v0[e] = a * a; v1[e] = b * b; } }
                    u32x4 w; w.x = cvt_pk_bf16(v0[0], v0[1]); w.y = cvt_pk_bf16(v0[2], v0[3]); w.z = cvt_pk_bf16(v1[0], v1[1]); w.w = cvt_pk_bf16(v1[2], v1[3]);
                    *(u32x4*)(rowp + bj * HALF) = w; } }
        __builtin_amdgcn_s_barrier();
    }
};

template <class Epi, class Sched, bool ALIGN_EPI = false, bool SP2 = false>
__device__ __forceinline__ void gemm_phase(PG8_LAS unsigned char* lds, const Gemm g, const Sched& S, const Epi& E) {
    const int tid = threadIdx.x, wid = __builtin_amdgcn_readfirstlane(tid >> 6), lane = tid & 63, wr = wid >> 2, wc = wid & 3, fr = lane & 15, fq = lane >> 4;
    const int K = g.K, nt = K / BK;
    unsigned voffA[2], voffB[2];
#pragma unroll
    for (int i = 0; i < 2; ++i) { int R, C; stage_rc(tid * 16 + i * 8192, R, C); const int Rb = Epi::PERM ? ((R & ~31) + perm32(R & 31)) : R;
        voffA[i] = (unsigned)(R * K + C) * 2u; voffB[i] = (unsigned)(Rb * K + C) * 2u; }
    const size_t kstep = (size_t)(BK * 2);
    const size_t hstep = (size_t)HALF * K * 2;
    const size_t tstep = 2 * hstep;
    const unsigned ldsw = (unsigned)wid * 1024u;
    const int aoff = lds_byte(wr * 64 + fr, fq * 8), boff = lds_byte(wc * 32 + fr, fq * 8);
#define PG8_SA(b, h) (((b) * 2 + (h)) * HTB)
#define PG8_SB(b, h) ((4 + (b) * 2 + (h)) * HTB)
#define PG8_STAGE(bufoff, gbase, voff) do { _Pragma("unroll") for (int _i = 0; _i < 2; ++_i) \
        __builtin_amdgcn_global_load_lds((const unsigned*)((const char*)(gbase) + (voff)[_i]), (PG8_LAS unsigned*)(lds + (bufoff) + ldsw + _i * 8192), 16, 0, 0); } while (0)
#define PG8_LDA(dst, b, h) do { _Pragma("unroll") for (int m = 0; m < 4; ++m) _Pragma("unroll") for (int k = 0; k < 2; ++k) dst[m][k] = *(const PG8_LAS bf16x8*)(lds + PG8_SA(b, h) + aoff + m * 2048 + k * 1024); } while (0)
#define PG8_LDB(dst, b, h) do { _Pragma("unroll") for (int n = 0; n < 2; ++n) _Pragma("unroll") for (int k = 0; k < 2; ++k) dst[n][k] = *(const PG8_LAS bf16x8*)(lds + PG8_SB(b, h) + boff + n * 2048 + k * 1024); } while (0)
#define PG8_MMA(ai, bj, At, Bt) do { __builtin_amdgcn_s_setprio(1); _Pragma("unroll") for (int m = 0; m < 4; ++m) _Pragma("unroll") for (int n = 0; n < 2; ++n) _Pragma("unroll") for (int k = 0; k < 2; ++k) \
        acc[ai][bj][m][n] = __builtin_amdgcn_mfma_f32_16x16x32_bf16(Bt[n][k], At[m][k], acc[ai][bj][m][n], 0, 0, 0); __builtin_amdgcn_s_setprio(0); } while (0)
#define PG8_WAIT_V(n) asm volatile("s_waitcnt vmcnt(" #n ")" ::: "memory")
#define PG8_WAIT_L(n) asm volatile("s_waitcnt lgkmcnt(" #n ")" ::: "memory")
#define PG8_BAR __builtin_amdgcn_s_barrier()
#define PG8_SCHED __builtin_amdgcn_sched_barrier(0)
    Unit cur, nxt; int ui = 0;
    if (!S.next(0, cur)) return;
    f32x4 acc[2][2][4][2];
#pragma unroll
    for (int a = 0; a < 2; ++a)
#pragma unroll
        for (int b = 0; b < 2; ++b)
#pragma unroll
            for (int m = 0; m < 4; ++m)
#pragma unroll
                for (int n = 0; n < 2; ++n) acc[a][b][m][n] = (f32x4){0.f, 0.f, 0.f, 0.f};
    bf16x8 At[4][2], B0[2][2], B1[2][2];
    const char* cA = (const char*)(cur.alt ? g.A2 : g.A) + (size_t)cur.pm * tstep; const char* cB = (const char*)(cur.alt ? g.Bt2 : g.Bt) + (size_t)cur.pn * tstep;
    S.a_ready(cur);
    if constexpr (SP2) {
        PG8_STAGE(PG8_SB(0, 0), cB, voffB); PG8_STAGE(PG8_SB(0, 1), cB + hstep, voffB); PG8_STAGE(PG8_SA(0, 0), cA, voffA); PG8_STAGE(PG8_SA(0, 1), cA + hstep, voffA);
        if (wr == 1) PG8_BAR;
        PG8_WAIT_V(2); PG8_BAR;
        PG8_STAGE(PG8_SB(1, 0), cB + kstep, voffB); PG8_STAGE(PG8_SA(1, 0), cA + kstep, voffA); PG8_STAGE(PG8_SB(1, 1), cB + hstep + kstep, voffB);
        PG8_WAIT_V(6); PG8_BAR;
    } else {
        PG8_STAGE(PG8_SB(0, 0), cB, voffB); PG8_STAGE(PG8_SA(0, 0), cA, voffA); PG8_STAGE(PG8_SB(0, 1), cB + hstep, voffB); PG8_STAGE(PG8_SA(0, 1), cA + hstep, voffA);
        if (wr == 1) PG8_BAR;
        PG8_WAIT_V(4); PG8_BAR;
        PG8_STAGE(PG8_SB(1, 0), cB + kstep, voffB); PG8_STAGE(PG8_SA(1, 0), cA + kstep, voffA); PG8_STAGE(PG8_SB(1, 1), cB + hstep + kstep, voffB);
        PG8_WAIT_V(6); PG8_BAR;
    }
    for (;;) {
        const bool has_next = S.next(ui + 1, nxt);
        const char* nA = has_next ? (const char*)(nxt.alt ? g.A2 : g.A) + (size_t)nxt.pm * tstep : cA; const char* nB = has_next ? (const char*)(nxt.alt ? g.Bt2 : g.Bt) + (size_t)nxt.pn * tstep : cB;
        for (int t = 0; t < nt; t += 2) {
            const bool last = (t == nt - 2);
            const char* a1 = cA + (size_t)(t + 1) * kstep;
            const char* a2 = last ? nA : cA + (size_t)(t + 2) * kstep; const char* b2 = last ? nB : cB + (size_t)(t + 2) * kstep;
            const char* a3 = a2 + kstep; const char* b3 = b2 + kstep;
            if (last && has_next) S.a_ready(nxt);
            if constexpr (SP2) {
            PG8_LDB(B0, 0, 0); PG8_LDB(B1, 0, 1); PG8_SCHED; PG8_LDA(At, 0, 0); PG8_STAGE(PG8_SA(1, 1), a1 + hstep, voffA);
            PG8_WAIT_V(8); PG8_WAIT_L(0); PG8_BAR; PG8_MMA(0, 0, At, B0); PG8_MMA(0, 1, At, B1); PG8_BAR; PG8_SCHED;
            PG8_LDA(At, 0, 1); PG8_STAGE(PG8_SB(0, 0), b2, voffB); PG8_STAGE(PG8_SB(0, 1), b2 + hstep, voffB); PG8_STAGE(PG8_SA(0, 0), a2, voffA);
            PG8_WAIT_V(8); PG8_WAIT_L(0); PG8_BAR; PG8_MMA(1, 0, At, B0); PG8_MMA(1, 1, At, B1); PG8_BAR; PG8_SCHED;
            PG8_LDB(B0, 1, 0); PG8_LDB(B1, 1, 1); PG8_SCHED; PG8_LDA(At, 1, 0); PG8_STAGE(PG8_SA(0, 1), a2 + hstep, voffA);
            PG8_WAIT_V(8); PG8_WAIT_L(0); PG8_BAR; PG8_MMA(0, 0, At, B0); PG8_MMA(0, 1, At, B1); PG8_BAR; PG8_SCHED;
            PG8_LDA(At, 1, 1); PG8_STAGE(PG8_SB(1, 0), b3, voffB); PG8_STAGE(PG8_SB(1, 1), b3 + hstep, voffB); PG8_STAGE(PG8_SA(1, 0), a3, voffA);
            PG8_WAIT_V(8); PG8_WAIT_L(0); PG8_BAR; PG8_MMA(1, 0, At, B0); PG8_MMA(1, 1, At, B1); PG8_BAR; PG8_SCHED;
            } else {
            PG8_LDB(B0, 0, 0); PG8_SCHED; PG8_LDA(At, 0, 0); PG8_STAGE(PG8_SA(1, 1), a1 + hstep, voffA);
            PG8_WAIT_L(8); PG8_BAR; PG8_WAIT_L(0); PG8_MMA(0, 0, At, B0); PG8_BAR; PG8_SCHED;
            PG8_LDB(B1, 0, 1); PG8_STAGE(PG8_SB(0, 0), b2, voffB);
            PG8_BAR; PG8_WAIT_L(0); PG8_MMA(0, 1, At, B1); PG8_BAR;
            PG8_LDA(At, 0, 1); PG8_STAGE(PG8_SA(0, 0), a2, voffA);
            PG8_BAR; PG8_WAIT_L(0); PG8_MMA(1, 0, At, B0); PG8_BAR; PG8_SCHED;
            PG8_STAGE(PG8_SB(0, 1), b2 + hstep, voffB);
            PG8_WAIT_V(6); PG8_BAR; PG8_MMA(1, 1, At, B1); PG8_BAR;
            PG8_LDB(B0, 1, 0); PG8_SCHED; PG8_LDA(At, 1, 0); PG8_STAGE(PG8_SA(0, 1), a2 + hstep, voffA);
            PG8_WAIT_L(8); PG8_BAR; PG8_WAIT_L(0); PG8_MMA(0, 0, At, B0); PG8_BAR; PG8_SCHED;
            PG8_LDB(B1, 1, 1); PG8_STAGE(PG8_SB(1, 0), b3, voffB);
            PG8_BAR; PG8_WAIT_L(0); PG8_MMA(0, 1, At, B1); PG8_BAR;
            PG8_LDA(At, 1, 1); PG8_STAGE(PG8_SA(1, 0), a3, voffA);
            PG8_BAR; PG8_WAIT_L(0); PG8_MMA(1, 0, At, B0); PG8_BAR; PG8_SCHED;
            PG8_STAGE(PG8_SB(1, 1), b3 + hstep, voffB);
            PG8_WAIT_V(6); PG8_BAR; PG8_MMA(1, 1, At, B1); PG8_BAR;
            }
        }
        if constexpr (ALIGN_EPI) { if (wr == 0) PG8_BAR; }
        if constexpr (!Epi::AFTER_DRAIN) { E(acc, cur, wr, wc, fr, fq); S.done(cur); }
        if (!has_next) break;
#pragma unroll
        for (int a = 0; a < 2; ++a)
#pragma unroll
            for (int b = 0; b < 2; ++b)
#pragma unroll
                for (int m = 0; m < 4; ++m)
#pragma unroll
                    for (int n = 0; n < 2; ++n) acc[a][b][m][n] = (f32x4){0.f, 0.f, 0.f, 0.f};
        cur = nxt; cA = nA; cB = nB; ++ui;
        if constexpr (ALIGN_EPI) { if (wr == 1) PG8_BAR; }
    }
    PG8_WAIT_V(0);
    if constexpr (!ALIGN_EPI) { if (wr == 0) PG8_BAR; }
    PG8_BAR;
    if constexpr (Epi::AFTER_DRAIN) { E.fused(acc, cur, wr, wc, fr, fq, lds, wid, lane); S.done(cur); }
#undef PG8_SA
#undef PG8_SB
#undef PG8_STAGE
#undef PG8_LDA
#undef PG8_LDB
#undef PG8_MMA
#undef PG8_WAIT_V
#undef PG8_WAIT_L
#undef PG8_BAR
#undef PG8_SCHED
}
}
namespace fa {
typedef short bf16x8 __attribute__((ext_vector_type(8)));
typedef short s16x4 __attribute__((ext_vector_type(4)));
typedef float f32x16 __attribute__((ext_vector_type(16)));
typedef float f32x4 __attribute__((ext_vector_type(4)));
typedef unsigned u32x4 __attribute__((ext_vector_type(4)));
constexpr int NW = 8, QBLK = 32, KVBLK = 64;
constexpr float THR = 8.f;
#define FA_SBAR() __builtin_amdgcn_sched_barrier(0)
#define FA_VMW() asm volatile("s_waitcnt vmcnt(0)" ::: "memory")
__device__ __forceinline__ int crow(int r, int hi) { return (r & 3) + 8 * (r >> 2) + 4 * hi; }
__device__ __forceinline__ unsigned cvtpk(float lo, float hi) { unsigned r; asm volatile("v_cvt_pk_bf16_f32 %0, %1, %2" : "=v"(r) : "v"(lo), "v"(hi)); return r; }

template <int NDQ> __device__ __forceinline__ int kswz(int row, int c) {
    if (NDQ == 4) return row * 128 + ((c ^ ((row >> 1) & 7)) << 4);
    else return row * (NDQ * 32) + ((c ^ (row & 15)) << 4);
}
template <int NDVT> __device__ __forceinline__ int v_st(int k, int c) { const int kk = (k & ~0xC) | ((k & 4) << 1) | ((k & 8) >> 1); return ((kk >> 3) * NDVT + (c >> 5)) * 512 + ((kk & 7) * 32 + (c & 31)) * 2; }
__device__ __forceinline__ int v_rd_base(int lane) { return ((lane & 3) << 3) | (((lane >> 2) & 3) << 6) | (((lane >> 4) & 1) << 5) | (((lane >> 5) & 1) << 8); }

__device__ __forceinline__ void mask_tile(f32x16& p0, f32x16& p1, int dq, unsigned W) {
    const float NEG = -__builtin_inff();
#pragma unroll
    for (int r = 0; r < 16; ++r) { const int c = (r & 3) + 8 * (r >> 2);
        if ((unsigned)(dq - c) >= W) p0[r] = NEG;
        if ((unsigned)(dq - c - 32) >= W) p1[r] = NEG; }
}
__device__ __forceinline__ void partialSM(f32x16& p0, f32x16& p1, float& m_reg, float& alpha) {
    float pmax = p0[0];
#pragma unroll
    for (int r = 1; r < 16; ++r) pmax = fmaxf(pmax, p0[r]);
#pragma unroll
    for (int r = 0; r < 16; ++r) pmax = fmaxf(pmax, p1[r]);
    { auto rr = __builtin_amdgcn_permlane32_swap(__float_as_uint(pmax), __float_as_uint(pmax), false, false); pmax = fmaxf(__uint_as_float(rr[0]), __uint_as_float(rr[1])); }
    float mn;
    if (__builtin_expect(__all((pmax - m_reg) <= THR), 1)) { mn = m_reg; alpha = 1.f; }
    else { mn = fmaxf(m_reg, pmax); alpha = __builtin_amdgcn_exp2f(m_reg - mn); m_reg = mn; }
#pragma unroll
    for (int r = 0; r < 16; ++r) p0[r] = p0[r] - mn;
#pragma unroll
    for (int r = 0; r < 16; ++r) p1[r] = p1[r] - mn;
#pragma unroll
    for (int r = 0; r < 16; ++r) p0[r] = __builtin_amdgcn_exp2f(p0[r]);
}
__device__ __forceinline__ void finishSM(f32x16& p0, f32x16& p1, float alpha, float& l_reg, bf16x8& pa0, bf16x8& pa1, bf16x8& pa2, bf16x8& pa3) {
#pragma unroll
    for (int r = 0; r < 16; ++r) p1[r] = __builtin_amdgcn_exp2f(p1[r]);
    float ps = 0.f;
#pragma unroll
    for (int r = 0; r < 16; ++r) ps += p0[r];
#pragma unroll
    for (int r = 0; r < 16; ++r) ps += p1[r];
    { auto rr = __builtin_amdgcn_permlane32_swap(__float_as_uint(ps), __float_as_uint(ps), false, false); ps = __uint_as_float(rr[0]) + __uint_as_float(rr[1]); }
    l_reg = l_reg * alpha + ps;
#define FA_PK4(P, B_, OUT) do { unsigned a0 = cvtpk(P[B_ + 0], P[B_ + 1]), a1 = cvtpk(P[B_ + 2], P[B_ + 3]); unsigned b0 = cvtpk(P[B_ + 4], P[B_ + 5]), b1 = cvtpk(P[B_ + 6], P[B_ + 7]); \
        auto r0 = __builtin_amdgcn_permlane32_swap(a0, b0, false, false); auto r1 = __builtin_amdgcn_permlane32_swap(a1, b1, false, false); \
        u32x4 w = {r0[0], r1[0], r0[1], r1[1]}; OUT = *reinterpret_cast<bf16x8*>(&w); } while (0)
    FA_PK4(p0, 0, pa0); FA_PK4(p0, 8, pa1); FA_PK4(p1, 0, pa2); FA_PK4(p1, 8, pa3);
#undef FA_PK4
}
template <int NDQ>
__device__ __forceinline__ void qkt(f32x16& p0, f32x16& p1, const char* Kb, int r32, int hi, const bf16x8* qr) {
    p0 = f32x16{}; p1 = f32x16{};
    constexpr int NA = NDQ < 8 ? NDQ : 8;
    const char* kb[NA];
#pragma unroll
    for (int dd = 0; dd < NA; ++dd) kb[dd] = Kb + kswz<NDQ>(r32, 2 * dd + hi);
#pragma unroll
    for (int d0 = 0; d0 < NDQ; ++d0) { const char* a = kb[d0 & (NA - 1)] + (d0 >> 3) * 256;
        const bf16x8 b0 = *reinterpret_cast<const bf16x8*>(a);
        const bf16x8 b1 = *reinterpret_cast<const bf16x8*>(a + 32 * NDQ * 32);
        p0 = __builtin_amdgcn_mfma_f32_32x32x16_bf16(b0, qr[d0], p0, 0, 0, 0);
        p1 = __builtin_amdgcn_mfma_f32_32x32x16_bf16(b1, qr[d0], p1, 0, 0, 0); }
}
template <int NDVT, int NDV>
__device__ __forceinline__ void pv_tile(f32x16* o, int vb, bf16x8 pa0, bf16x8 pa1, bf16x8 pa2, bf16x8 pa3) {
#define FA_TRRD(dst, off) asm volatile("ds_read_b64_tr_b16 %0, %1 offset:%2" : "=&v"(dst) : "v"(vb), "i"(off) : "memory")
#define FA_PV_D0(d0) do { s16x4 l0, l1, l2, l3, h0, h1, h2, h3; constexpr int b_ = (d0) * 512, ks_ = 2 * NDVT * 512, hf_ = NDVT * 512; \
        FA_TRRD(l0, b_); FA_TRRD(h0, b_ + hf_); FA_TRRD(l1, b_ + ks_); FA_TRRD(h1, b_ + ks_ + hf_); FA_TRRD(l2, b_ + 2 * ks_); FA_TRRD(h2, b_ + 2 * ks_ + hf_); FA_TRRD(l3, b_ + 3 * ks_); FA_TRRD(h3, b_ + 3 * ks_ + hf_); \
        asm volatile("s_waitcnt lgkmcnt(0)" ::: "memory"); FA_SBAR(); \
        o[d0] = __builtin_amdgcn_mfma_f32_32x32x16_bf16(pa0, (bf16x8){l0[0], l0[1], l0[2], l0[3], h0[0], h0[1], h0[2], h0[3]}, o[d0], 0, 0, 0); \
        o[d0] = __builtin_amdgcn_mfma_f32_32x32x16_bf16(pa1, (bf16x8){l1[0], l1[1], l1[2], l1[3], h1[0], h1[1], h1[2], h1[3]}, o[d0], 0, 0, 0); \
        o[d0] = __builtin_amdgcn_mfma_f32_32x32x16_bf16(pa2, (bf16x8){l2[0], l2[1], l2[2], l2[3], h2[0], h2[1], h2[2], h2[3]}, o[d0], 0, 0, 0); \
        o[d0] = __builtin_amdgcn_mfma_f32_32x32x16_bf16(pa3, (bf16x8){l3[0], l3[1], l3[2], l3[3], h3[0], h3[1], h3[2], h3[3]}, o[d0], 0, 0, 0); } while (0)
    FA_PV_D0(0); if constexpr (NDV > 1) FA_PV_D0(1); if constexpr (NDV > 2) FA_PV_D0(2); if constexpr (NDV > 3) FA_PV_D0(3);
#undef FA_PV_D0
#undef FA_TRRD
}

template <int NDQ, int NDVT, int NDV>
struct Core {
    static constexpr int KROW = NDQ * 32, SHM_K = 64 * KROW, SHM_V = 64 * NDVT * 64, NKL = NDQ / 4, NVL = NDVT / 2, LDS_NEED = 2 * SHM_V + 2 * SHM_K + NW * 256;
    static_assert(NKL >= 1 && NVL >= 1, "tile too small for 512 staging threads");
    __device__ __forceinline__ static void run(f32x16 (&o)[NDV], float& m_reg, float& l_reg, const bf16* Qw, int ldq, const bf16* Kg, const bf16* Vg, int ldk,
                                               int j_lo, int j_hi, int qlo, int W, char* lds, int vdoff) {
        int tid = threadIdx.x; asm volatile("" : "+v"(tid));
        const int wid = __builtin_amdgcn_readfirstlane(tid >> 6), lane = tid & 63, r32 = lane & 31, hi = lane >> 5;
        const int NT = j_hi - j_lo, qm = qlo + r32 - 4 * hi;
        char* V_lds = lds; char* K_lds = lds + 2 * SHM_V;
        float* wsf = (float*)(lds + 2 * SHM_V + 2 * SHM_K) + wid * 64; float* al_l = wsf + 32;
        m_reg = -1e30f; l_reg = 0.f;
#pragma unroll
        for (int d = 0; d < NDV; ++d) o[d] = f32x16{};
        constexpr int KCH = 2 * NDQ, KRS = 512 / KCH, VCH = 4 * NDVT, VRS = 512 / VCH;
        const int krow0 = tid / KCH, kch = tid % KCH, vrow0 = tid / VCH, vcol = (tid % VCH) * 8;
        int kws[NKL], vws[NVL];
#pragma unroll
        for (int i = 0; i < NKL; ++i) kws[i] = kswz<NDQ>(krow0 + i * KRS, kch);
#pragma unroll
        for (int i = 0; i < NVL; ++i) vws[i] = v_st<NDVT>(vrow0 + i * VRS, vcol);
        const bf16* kgp = Kg + (size_t)krow0 * ldk + kch * 8; const bf16* vgp = Vg + (size_t)vrow0 * ldk + vcol;
        bf16x8 sk[NKL], sv[NVL];
        const int vb0 = (int)(uintptr_t)V_lds + v_rd_base(lane) + vdoff * 512;
#define FA_SLOAD(t) do { const size_t ro_ = (size_t)((j_lo + (t)) * KVBLK) * ldk; \
        _Pragma("unroll") for (int i_ = 0; i_ < NVL; ++i_) sv[i_] = *reinterpret_cast<const bf16x8*>(vgp + ro_ + (size_t)(i_ * VRS) * ldk); \
        _Pragma("unroll") for (int i_ = 0; i_ < NKL; ++i_) sk[i_] = *reinterpret_cast<const bf16x8*>(kgp + ro_ + (size_t)(i_ * KRS) * ldk); } while (0)
#define FA_SWRITE(bf) do { _Pragma("unroll") for (int i_ = 0; i_ < NVL; ++i_) *reinterpret_cast<bf16x8*>(V_lds + (bf) * SHM_V + vws[i_]) = sv[i_]; \
        _Pragma("unroll") for (int i_ = 0; i_ < NKL; ++i_) *reinterpret_cast<bf16x8*>(K_lds + (bf) * SHM_K + kws[i_]) = sk[i_]; } while (0)
#define FA_RESC(a) do { if (__any((a) < 1.f)) { if (hi == 0) al_l[r32] = (a); asm volatile("s_waitcnt lgkmcnt(0)" ::: "memory"); \
        _Pragma("unroll") for (int d_ = 0; d_ < NDV; ++d_) _Pragma("unroll") for (int r = 0; r < 16; ++r) o[d_][r] *= al_l[crow(r, hi)]; } } while (0)
#define FA_KBASE(t) ((j_lo + (t)) * KVBLK)
#define FA_MASKT(P0_, P1_, t) do { const int kb_ = FA_KBASE(t); if (kb_ + KVBLK - 1 > qlo || kb_ <= qlo + QBLK - 1 - W) mask_tile(P0_, P1_, qm - kb_, (unsigned)W); } while (0)
        bf16x8 qr[NDQ];
#pragma unroll
        for (int d0 = 0; d0 < NDQ; ++d0) qr[d0] = *reinterpret_cast<const bf16x8*>(Qw + (size_t)r32 * ldq + d0 * 16 + hi * 8);
        FA_SLOAD(0); FA_VMW(); FA_SWRITE(0); FA_SBAR();
        if (NT > 1) FA_SLOAD(1);
        __syncthreads();
        f32x16 pA0, pA1, pB0, pB1; float alA, alB; bf16x8 pa0, pa1, pa2, pa3;
        FA_SBAR(); qkt<NDQ>(pA0, pA1, K_lds, r32, hi, qr);
        FA_MASKT(pA0, pA1, 0); partialSM(pA0, pA1, m_reg, alA);
        if (NT > 1) { FA_VMW(); FA_SWRITE(1); }
        __syncthreads();
#define FA_HALF_STEP(PX0, PX1, alX, PY0, PY1, alY, t, KB, VB, SB) do { \
        FA_SBAR(); qkt<NDQ>(PX0, PX1, K_lds + (KB) * SHM_K, r32, hi, qr); \
        finishSM(PY0, PY1, alY, l_reg, pa0, pa1, pa2, pa3); FA_SBAR(); \
        if ((t) + 1 < NT) { FA_SLOAD((t) + 1); FA_SBAR(); } \
        pv_tile<NDVT, NDV>(o, vb0 + (VB) * SHM_V, pa0, pa1, pa2, pa3); FA_MASKT(PX0, PX1, (t)); partialSM(PX0, PX1, m_reg, alX); \
        __syncthreads(); \
        if ((t) + 1 < NT) { FA_VMW(); FA_SWRITE(SB); } \
        FA_RESC(alX); __syncthreads(); } while (0)
        for (int t = 1; t + 1 < NT; t += 2) {
            FA_HALF_STEP(pB0, pB1, alB, pA0, pA1, alA, t, 1, 0, 0);
            FA_HALF_STEP(pA0, pA1, alA, pB0, pB1, alB, t + 1, 0, 1, 1);
        }
        const bool even = (NT & 1) == 0;
        if (even) { FA_SBAR(); qkt<NDQ>(pB0, pB1, K_lds + SHM_K, r32, hi, qr); FA_SBAR(); }
        finishSM(pA0, pA1, alA, l_reg, pa0, pa1, pa2, pa3); FA_SBAR();
        pv_tile<NDVT, NDV>(o, vb0, pa0, pa1, pa2, pa3);
        if (even) { FA_MASKT(pB0, pB1, NT - 1); partialSM(pB0, pB1, m_reg, alB); FA_RESC(alB);
            finishSM(pB0, pB1, alB, l_reg, pa0, pa1, pa2, pa3); FA_SBAR(); pv_tile<NDVT, NDV>(o, vb0 + SHM_V, pa0, pa1, pa2, pa3); }
        __syncthreads();
#undef FA_SLOAD
#undef FA_SWRITE
#undef FA_RESC
#undef FA_KBASE
#undef FA_MASKT
#undef FA_HALF_STEP
    }
};

#define FA_PIN(x) asm volatile("" : "+v"(x))
#define FA_PK4V(P, B_, OUT) do { unsigned a0_ = cvtpk(P[B_ + 0], P[B_ + 1]), a1_ = cvtpk(P[B_ + 2], P[B_ + 3]); unsigned b0_ = cvtpk(P[B_ + 4], P[B_ + 5]), b1_ = cvtpk(P[B_ + 6], P[B_ + 7]); \
        auto r0_ = __builtin_amdgcn_permlane32_swap(a0_, b0_, false, false); auto r1_ = __builtin_amdgcn_permlane32_swap(a1_, b1_, false, false); \
        u32x4 w_ = {r0_[0], r1_[0], r0_[1], r1_[1]}; OUT = *reinterpret_cast<bf16x8*>(&w_); } while (0)
__device__ __forceinline__ void step_qk_fin(f32x16& X0, f32x16& X1, const char* Kb, int r32, int hi, const bf16x8* qr,
                                            f32x16& Y0, f32x16& Y1, float alY, float& l_reg, bf16x8& pa0, bf16x8& pa1, bf16x8& pa2, bf16x8& pa3) {
    const char* k0 = Kb + kswz<4>(r32, hi); const char* k1 = Kb + kswz<4>(r32, 2 + hi); const char* k2 = Kb + kswz<4>(r32, 4 + hi); const char* k3 = Kb + kswz<4>(r32, 6 + hi);
    bf16x8 fa = *reinterpret_cast<const bf16x8*>(k0), fb = *reinterpret_cast<const bf16x8*>(k0 + 4096);
    float ps;
    X0 = __builtin_amdgcn_mfma_f32_32x32x16_bf16(fa, qr[0], f32x16{}, 0, 0, 0); X1 = __builtin_amdgcn_mfma_f32_32x32x16_bf16(fb, qr[0], f32x16{}, 0, 0, 0);
    fa = *reinterpret_cast<const bf16x8*>(k1); fb = *reinterpret_cast<const bf16x8*>(k1 + 4096);
#pragma unroll
    for (int r = 0; r < 4; ++r) Y1[r] = __builtin_amdgcn_exp2f(Y1[r]);
    ps = (Y0[0] + Y0[1]) + (Y0[2] + Y0[3]);
    FA_PK4V(Y0, 0, pa0); FA_PIN(ps); FA_PIN(pa0); FA_PIN(Y1); FA_SBAR();
    X0 = __builtin_amdgcn_mfma_f32_32x32x16_bf16(fa, qr[1], X0, 0, 0, 0); X1 = __builtin_amdgcn_mfma_f32_32x32x16_bf16(fb, qr[1], X1, 0, 0, 0);
    fa = *reinterpret_cast<const bf16x8*>(k2); fb = *reinterpret_cast<const bf16x8*>(k2 + 4096);
#pragma unroll
    for (int r = 4; r < 8; ++r) Y1[r] = __builtin_amdgcn_exp2f(Y1[r]);
    ps += (Y0[4] + Y0[5]) + (Y0[6] + Y0[7]); ps += (Y1[0] + Y1[1]) + (Y1[2] + Y1[3]);
    FA_PK4V(Y0, 8, pa1); FA_PIN(ps); FA_PIN(pa1); FA_PIN(Y1); FA_SBAR();
    X0 = __builtin_amdgcn_mfma_f32_32x32x16_bf16(fa, qr[2], X0, 0, 0, 0); X1 = __builtin_amdgcn_mfma_f32_32x32x16_bf16(fb, qr[2], X1, 0, 0, 0);
    fa = *reinterpret_cast<const bf16x8*>(k3); fb = *reinterpret_cast<const bf16x8*>(k3 + 4096);
#pragma unroll
    for (int r = 8; r < 12; ++r) Y1[r] = __builtin_amdgcn_exp2f(Y1[r]);
    ps += (Y0[8] + Y0[9]) + (Y0[10] + Y0[11]); ps += (Y1[4] + Y1[5]) + (Y1[6] + Y1[7]);
    FA_PK4V(Y1, 0, pa2); FA_PIN(ps); FA_PIN(pa2); FA_PIN(Y1); FA_SBAR();
    X0 = __builtin_amdgcn_mfma_f32_32x32x16_bf16(fa, qr[3], X0, 0, 0, 0); X1 = __builtin_amdgcn_mfma_f32_32x32x16_bf16(fb, qr[3], X1, 0, 0, 0);
#pragma unroll
    for (int r = 12; r < 16; ++r) Y1[r] = __builtin_amdgcn_exp2f(Y1[r]);
    ps += (Y0[12] + Y0[13]) + (Y0[14] + Y0[15]); ps += (Y1[8] + Y1[9]) + (Y1[10] + Y1[11]); ps += (Y1[12] + Y1[13]) + (Y1[14] + Y1[15]);
    { auto rr = __builtin_amdgcn_permlane32_swap(__float_as_uint(ps), __float_as_uint(ps), false, false); ps = __uint_as_float(rr[0]) + __uint_as_float(rr[1]); }
    l_reg = l_reg * alY + ps;
    FA_PK4V(Y1, 8, pa3); FA_PIN(l_reg); FA_PIN(pa3); FA_PIN(X0); FA_PIN(X1); FA_SBAR();
}
__device__ __forceinline__ void step_pv_max(f32x16* o, int vb, bf16x8 pa0, bf16x8 pa1, bf16x8 pa2, bf16x8 pa3, f32x16& X0, f32x16& X1, float& m_reg, float& alpha, bool MASK, int dq, unsigned W) {
#define FA_TRRD(dst, off) asm volatile("ds_read_b64_tr_b16 %0, %1 offset:%2" : "=&v"(dst) : "v"(vb), "i"(off) : "memory")
#define FA_RD2(l, h, d0, ks) do { FA_TRRD(l, (d0) * 512 + (ks) * 4096); FA_TRRD(h, (d0) * 512 + (ks) * 4096 + 2048); } while (0)
#define FA_FRAG(l, h) (bf16x8){l[0], l[1], l[2], l[3], h[0], h[1], h[2], h[3]}
    s16x4 l0, h0, l1, h1, l2, h2, l3, h3;
    FA_RD2(l0, h0, 0, 0); FA_RD2(l1, h1, 0, 1); FA_RD2(l2, h2, 0, 2); FA_RD2(l3, h3, 0, 3);
    if (MASK) mask_tile(X0, X1, dq, W);
    float pmax = fmaxf(fmaxf(X0[0], X0[1]), X1[0]);
#pragma unroll
    for (int r = 2; r < 16; r += 2) pmax = fmaxf(fmaxf(pmax, X0[r]), X0[r + 1]);
#pragma unroll
    for (int r = 1; r < 16; r += 2) pmax = fmaxf(fmaxf(pmax, X1[r]), X1[(r + 1) & 15]);
    { auto rr = __builtin_amdgcn_permlane32_swap(__float_as_uint(pmax), __float_as_uint(pmax), false, false); pmax = fmaxf(__uint_as_float(rr[0]), __uint_as_float(rr[1])); }
    float mn;
    if (__builtin_expect(__all((pmax - m_reg) <= THR), 1)) { mn = m_reg; alpha = 1.f; }
    else { mn = fmaxf(m_reg, pmax); alpha = __builtin_amdgcn_exp2f(m_reg - mn); m_reg = mn; }
    FA_PIN(mn);
#define FA_BLK(d0, NXT, FILL) do { asm volatile("s_waitcnt lgkmcnt(0)" ::: "memory"); FA_SBAR(); \
        o[d0] = __builtin_amdgcn_mfma_f32_32x32x16_bf16(pa0, FA_FRAG(l0, h0), o[d0], 0, 0, 0); if (NXT) FA_RD2(l0, h0, (d0) + 1, 0); \
        o[d0] = __builtin_amdgcn_mfma_f32_32x32x16_bf16(pa1, FA_FRAG(l1, h1), o[d0], 0, 0, 0); if (NXT) FA_RD2(l1, h1, (d0) + 1, 1); \
        o[d0] = __builtin_amdgcn_mfma_f32_32x32x16_bf16(pa2, FA_FRAG(l2, h2), o[d0], 0, 0, 0); if (NXT) FA_RD2(l2, h2, (d0) + 1, 2); \
        o[d0] = __builtin_amdgcn_mfma_f32_32x32x16_bf16(pa3, FA_FRAG(l3, h3), o[d0], 0, 0, 0); if (NXT) FA_RD2(l3, h3, (d0) + 1, 3); \
        FILL; } while (0)
    FA_BLK(0, true,  { _Pragma("unroll") for (int r = 0; r < 16; ++r) X0[r] = X0[r] - mn; FA_PIN(X0); });
    FA_BLK(1, true,  { _Pragma("unroll") for (int r = 0; r < 16; ++r) X1[r] = X1[r] - mn; FA_PIN(X1); });
    FA_BLK(2, true,  { _Pragma("unroll") for (int r = 0; r < 8; ++r) X0[r] = __builtin_amdgcn_exp2f(X0[r]); FA_PIN(X0); });
    FA_BLK(3, false, { _Pragma("unroll") for (int r = 8; r < 16; ++r) X0[r] = __builtin_amdgcn_exp2f(X0[r]); FA_PIN(X0); });
    FA_SBAR();
#undef FA_BLK
#undef FA_RD2
#undef FA_FRAG
#undef FA_TRRD
}

template <int NDQ, int NDVT, int NDV>
struct CoreStag {
    static_assert(NDQ == 4 && NDVT == 4 && NDV == 4, "the interleaved interval bodies are written for d_qk = 64, d_v = 128");
    static constexpr int KROW = NDQ * 32, SHM_K = 64 * KROW, SHM_V = 64 * NDVT * 64, NKL = NDQ / 4, NVL = NDVT / 2, LDS_NEED = 2 * SHM_V + 2 * SHM_K + NW * 256;
    __device__ __forceinline__ static void run(f32x16 (&o)[NDV], float& m_reg, float& l_reg, const bf16* Qw, int ldq, const bf16* Kg, const bf16* Vg, int ldk,
                                               int j_lo, int j_hi, int qlo, int W, char* lds, int vdoff) {
        const int tid = threadIdx.x, wid = __builtin_amdgcn_readfirstlane(tid >> 6), lane = tid & 63, r32 = lane & 31, hi = lane >> 5;
        const bool half1 = wid >= 4;
        const int NT = j_hi - j_lo, qm = qlo + r32 - 4 * hi;
        char* V_lds = lds; char* K_lds = lds + 2 * SHM_V;
        float* al_l = (float*)(lds + 2 * SHM_V + 2 * SHM_K) + wid * 64 + 32;
        m_reg = -1e30f; l_reg = 0.f;
#pragma unroll
        for (int d = 0; d < NDV; ++d) o[d] = f32x16{};
        constexpr int KCH = 2 * NDQ, KRS = 512 / KCH, VCH = 4 * NDVT, VRS = 512 / VCH;
        const int krow0 = tid / KCH, kch = tid % KCH, vrow0 = tid / VCH, vcol = (tid % VCH) * 8;
        int kws[NKL], vws[NVL];
#pragma unroll
        for (int i = 0; i < NKL; ++i) kws[i] = kswz<NDQ>(krow0 + i * KRS, kch);
#pragma unroll
        for (int i = 0; i < NVL; ++i) vws[i] = v_st<NDVT>(vrow0 + i * VRS, vcol);
        const bf16* kgp = Kg + (size_t)(j_lo * KVBLK + krow0) * ldk + kch * 8; const bf16* vgp = Vg + (size_t)(j_lo * KVBLK + vrow0) * ldk + vcol;
        bf16x8 sk[NKL], sv[NVL];
        const int vb0 = (int)(uintptr_t)V_lds + v_rd_base(lane) + vdoff * 512;
#define FS_BAR() do { FA_SBAR(); __syncthreads(); FA_SBAR(); } while (0)
#define FS_LOADK(t) do { if ((t) < NT) { const size_t ro_ = (size_t)((t) * KVBLK) * ldk; _Pragma("unroll") for (int i_ = 0; i_ < NKL; ++i_) sk[i_] = *reinterpret_cast<const bf16x8*>(kgp + ro_ + (size_t)(i_ * KRS) * ldk); } } while (0)
#define FS_LOADV(t) do { if ((t) < NT) { const size_t ro_ = (size_t)((t) * KVBLK) * ldk; _Pragma("unroll") for (int i_ = 0; i_ < NVL; ++i_) sv[i_] = *reinterpret_cast<const bf16x8*>(vgp + ro_ + (size_t)(i_ * VRS) * ldk); } } while (0)
#define FS_WRITEK(t, bf) do { if ((t) < NT) { _Pragma("unroll") for (int i_ = 0; i_ < NKL; ++i_) *reinterpret_cast<bf16x8*>(K_lds + (bf) * SHM_K + kws[i_]) = sk[i_]; } } while (0)
#define FS_WRITEV(t, bf) do { if ((t) < NT) { _Pragma("unroll") for (int i_ = 0; i_ < NVL; ++i_) *reinterpret_cast<bf16x8*>(V_lds + (bf) * SHM_V + vws[i_]) = sv[i_]; } } while (0)
#define FS_RESC(a) do { if (__any((a) < 1.f)) { if (hi == 0) al_l[r32] = (a); asm volatile("s_waitcnt lgkmcnt(0)" ::: "memory"); \
        _Pragma("unroll") for (int d_ = 0; d_ < NDV; ++d_) _Pragma("unroll") for (int r = 0; r < 16; ++r) o[d_][r] *= al_l[crow(r, hi)]; } } while (0)
#define FS_MASKT(P0_, P1_, t) do { const int kb_ = (j_lo + (t)) * KVBLK; if (kb_ + KVBLK - 1 > qlo || kb_ <= qlo + QBLK - 1 - W) mask_tile(P0_, P1_, qm - kb_, (unsigned)W); } while (0)
        bf16x8 qr[NDQ];
#pragma unroll
        for (int d0 = 0; d0 < NDQ; ++d0) qr[d0] = *reinterpret_cast<const bf16x8*>(Qw + (size_t)r32 * ldq + d0 * 16 + hi * 8);
        FS_LOADK(0); FS_WRITEK(0, 0); FA_SBAR(); FS_LOADK(1); FS_LOADV(0);
        FS_BAR();
        if (half1) { FS_BAR(); }
        f32x16 pA0, pA1, pB0, pB1; float alA = 1.f, alB = 1.f; bf16x8 pa0, pa1, pa2, pa3;
        FS_WRITEK(1, 1); FA_SBAR(); FS_LOADK(2); FA_SBAR();
        qkt<NDQ>(pA0, pA1, K_lds, r32, hi, qr); asm volatile("" : "+v"(pA0), "+v"(pA1));
        FS_BAR();
        FS_WRITEV(0, 0); FA_SBAR(); FS_LOADV(1); FA_SBAR();
        FS_MASKT(pA0, pA1, 0); partialSM(pA0, pA1, m_reg, alA);
        FS_BAR();
#define FS_STEP(PX0, PX1, alX, PY0, PY1, alY, t, KB) do { \
        finishSM(PY0, PY1, alY, l_reg, pa0, pa1, pa2, pa3); FA_SBAR(); \
        FS_WRITEK((t) + 1, (KB) ^ 1); FA_SBAR(); FS_LOADK((t) + 2); FA_SBAR(); \
        qkt<NDQ>(PX0, PX1, K_lds + (KB) * SHM_K, r32, hi, qr); asm volatile("" : "+v"(PX0), "+v"(PX1)); \
        FS_BAR(); \
        pv_tile<NDVT, NDV>(o, vb0 + ((KB) ^ 1) * SHM_V, pa0, pa1, pa2, pa3); \
        FS_WRITEV((t), (KB)); FA_SBAR(); FS_LOADV((t) + 1); FA_SBAR(); \
        FS_MASKT(PX0, PX1, (t)); partialSM(PX0, PX1, m_reg, alX); FS_RESC(alX); \
        FS_BAR(); } while (0)
        int t = 1;
        for (; t + 1 < NT; t += 2) {
            FS_STEP(pB0, pB1, alB, pA0, pA1, alA, t, 1);
            FS_STEP(pA0, pA1, alA, pB0, pB1, alB, t + 1, 0);
        }
        FS_STEP(pB0, pB1, alB, pA0, pA1, alA, t, 1);
        finishSM(pB0, pB1, alB, l_reg, pa0, pa1, pa2, pa3); FA_SBAR();
        FS_BAR();
        pv_tile<NDVT, NDV>(o, vb0 + SHM_V, pa0, pa1, pa2, pa3);
        FS_BAR();
        if (!half1) { FS_BAR(); }
#undef FS_BAR
#undef FS_LOADK
#undef FS_LOADV
#undef FS_WRITEK
#undef FS_WRITEV
#undef FS_RESC
#undef FS_MASKT
#undef FS_STEP
    }
};
}

constexpr size_t WS_STASH = 128 * MiB;
typedef unsigned v4u32 __attribute__((__vector_size__(16)));
__device__ __forceinline__ __amdgpu_buffer_rsrc_t mk_rsrc(const void* ptr) {
    const unsigned long long v = (unsigned long long)ptr; const unsigned lo = __builtin_amdgcn_readfirstlane((unsigned)v), hi = __builtin_amdgcn_readfirstlane((unsigned)(v >> 32));
    return __builtin_amdgcn_make_buffer_rsrc((void*)(((unsigned long long)hi << 32) | lo), 0, 0x40000000, 0x00020000);
}
__device__ __forceinline__ void attn_phase(const Params& p, char* lds, int vcu0, int nwg) {
    using namespace fa;
    const int tid = threadIdx.x, wid = __builtin_amdgcn_readfirstlane(tid >> 6), lane = tid & 63, r32 = lane & 31, hi = lane >> 5;
    const bf16* proj = (const bf16*)(p.ws + WS_PROJ); bf16* att = (bf16*)(p.ws + WS_ATT);
    typedef CoreStag<4, 4, 4> CD; typedef Core<4, 2, 2> CS;
    float* wsf = (float*)(lds + CD::LDS_NEED) + wid * 64;
    const float lam = calc_lambda(p);
    const int ovoff = (4 * hi * DM + r32) * 2;
#pragma nounroll
    for (int vcu = vcu0; vcu < 256; vcu += nwg) {
        const int bh = vcu >> 3, b = bh >> 2, h = bh & 3, s = vcu & 7;
        u32x4* stash = (u32x4*)(lds + CD::LDS_NEED + NW * 256) + tid;
#pragma nounroll
        for (int pass = 0; pass < 2; ++pass) {
            const int qb = pass ? 15 - s : s;
            const size_t row0 = (size_t)b * SEQ + qb * 256 + wid * 32;
#pragma nounroll
            for (int c = 0; c < 2; ++c) {
                f32x16 o[4]; float m_reg, l_reg;
                CD::run(o, m_reg, l_reg, proj + row0 * NP + C_QD + (2 * h + c) * 64, NP, proj + (size_t)b * SEQ * NP + C_KD + (2 * h + c) * 64, proj + (size_t)b * SEQ * NP + C_VD + h * 128, NP,
                        0, 4 * (qb + 1), qb * 256 + wid * 32, 1 << 30, lds, 0);
                if (hi == 0) wsf[r32] = l_reg;
                asm volatile("s_waitcnt lgkmcnt(0)" ::: "memory");
                if (c == 0) {
#pragma unroll
                    for (int j = 0; j < 2; ++j) { float ri[8];
#pragma unroll
                        for (int e = 0; e < 8; ++e) ri[e] = 1.0f / wsf[crow(8 * j + e, hi)];
#pragma unroll
                        for (int d0 = 0; d0 < 4; ++d0) { u32x4 w; w.x = cvtpk(o[d0][8 * j] * ri[0], o[d0][8 * j + 1] * ri[1]); w.y = cvtpk(o[d0][8 * j + 2] * ri[2], o[d0][8 * j + 3] * ri[3]);
                            w.z = cvtpk(o[d0][8 * j + 4] * ri[4], o[d0][8 * j + 5] * ri[5]); w.w = cvtpk(o[d0][8 * j + 6] * ri[6], o[d0][8 * j + 7] * ri[7]); stash[(d0 * 2 + j) * NTHR] = w; } }
                } else {
                    const __amdgpu_buffer_rsrc_t rso = mk_rsrc(att + row0 * DM + 512 + h * 128);
                    float ssq[16];
#pragma unroll
                    for (int r = 0; r < 16; ++r) ssq[r] = -lam / wsf[crow(r, hi)];
#pragma unroll
                    for (int d0 = 0; d0 < 4; ++d0)
#pragma unroll
                        for (int j = 0; j < 2; ++j) { const u32x4 w = stash[(d0 * 2 + j) * NTHR]; const unsigned ww[4] = {w.x, w.y, w.z, w.w};
#pragma unroll
                            for (int e = 0; e < 8; ++e) { const int r = 8 * j + e; const float a0 = (e & 1) ? __uint_as_float(ww[e >> 1] & 0xffff0000u) : __uint_as_float(ww[e >> 1] << 16);
                                o[d0][r] = a0 + ssq[r] * o[d0][r]; } }
#pragma unroll
                    for (int r = 0; r < 16; ++r) { float q = (o[0][r] * o[0][r] + o[1][r] * o[1][r]) + (o[2][r] * o[2][r] + o[3][r] * o[3][r]);
                        q += __shfl_xor(q, 1); q += __shfl_xor(q, 2); q += __shfl_xor(q, 4); q += __shfl_xor(q, 8); q += __shfl_xor(q, 16);
                        ssq[r] = 0.8f / sqrtf(q * (1.f / 128.f) + EPS); }
#pragma unroll
                    for (int d0 = 0; d0 < 4; ++d0) { const float g = p.g_diff[d0 * 32 + r32];
#pragma unroll
                        for (int r = 0; r < 16; ++r) { const float y = o[d0][r] * ssq[r] * g; const float yn = __shfl_xor(y, 1);
                            if ((r32 & 1) == 0) __builtin_amdgcn_raw_buffer_store_b32(cvtpk(y, yn), rso, ovoff, (((r & 3) + 8 * (r >> 2)) * DM + d0 * 32) * 2, 0); } }
                }
                asm volatile("s_waitcnt lgkmcnt(0)" ::: "memory");
            }
        }
    }
    int tid_s = threadIdx.x; asm volatile("" : "+v"(tid_s));
    const int wid_s = __builtin_amdgcn_readfirstlane(tid_s >> 6), r32_s = tid_s & 31, hi_s = (tid_s >> 5) & 1;
    float* wsf_s = (float*)(lds + CD::LDS_NEED) + wid_s * 64; const int ovoff_s = (4 * hi_s * DM + r32_s) * 2;
#pragma nounroll
    for (int u = vcu0; u < 1024; u += nwg) {
        const int wid = wid_s, r32 = r32_s, hi = hi_s, ovoff = ovoff_s; float* wsf = wsf_s;
        const int bk = u >> 6, g64 = u & 63, b = bk >> 1, kvh = bk & 1, hq = kvh * 4 + (wid >> 1), sub = wid & 1;
        const size_t row0 = (size_t)b * SEQ + g64 * 64 + sub * 32;
        const __amdgpu_buffer_rsrc_t rso = mk_rsrc(att + row0 * DM + hq * 64);
        f32x16 o[2]; float m_reg, l_reg;
        const bf16* Qw = proj + row0 * NP + C_QA + hq * 64;
        const bf16* Kg = proj + (size_t)b * SEQ * NP + C_KA + kvh * 64;
        const bf16* Vg = proj + (size_t)b * SEQ * NP + C_VA + kvh * 64;
        CS::run(o, m_reg, l_reg, Qw, NP, Kg, Vg, NP, g64 >= 2 ? g64 - 2 : 0, g64 + 1, g64 * 64 + sub * 32, 128, lds, 0);
        const float lt = l_reg + __builtin_amdgcn_exp2f(p.sinks[hq] * LOG2E - m_reg);
        if (hi == 0) wsf[r32] = lt;
        asm volatile("s_waitcnt lgkmcnt(0)" ::: "memory");
#pragma unroll
        for (int r = 0; r < 16; ++r) { const float rl = 1.0f / wsf[crow(r, hi)];
#pragma unroll
            for (int d0 = 0; d0 < 2; ++d0) { const float y = o[d0][r] * rl; const float yn = __shfl_xor(y, 1);
                if ((r32 & 1) == 0) __builtin_amdgcn_raw_buffer_store_b32(cvtpk(y, yn), rso, ovoff, (((r & 3) + 8 * (r >> 2)) * DM + d0 * 32) * 2, 0); } }
        __syncthreads();
    }
}

namespace fa {
template <int NDQ, int NDVT, int NDV>
struct CoreSeqG {
    static constexpr int KROW = NDQ * 32, SHM_K = 64 * KROW, SHM_V = 64 * NDVT * 64, KPW = SHM_K / 8192, VPW = SHM_V / 8192;
    static_assert(NDQ == 16 && NDVT == 8, "piece maps below are written for 512-byte K rows and 8 V column blocks");
    typedef __attribute__((address_space(3))) unsigned char* lptr;
    __device__ __forceinline__ static void run(f32x16 (&o)[NDV], float& m_reg, float& l_reg, const bf16* Qw, int ldq, const bf16* Kg, const bf16* Vg, int ldk, int NT, char* lds, lptr ldsL, int scr_off, int vdoff) {
        const int tid = threadIdx.x, wid = __builtin_amdgcn_readfirstlane(tid >> 6), lane = tid & 63, r32 = lane & 31, hi = lane >> 5;
        char* V_lds = lds; char* K_lds = lds + 2 * SHM_V;
        float* al_l = (float*)(lds + scr_off) + wid * 64 + 32;
        m_reg = -1e30f; l_reg = 0.f;
#pragma unroll
        for (int d = 0; d < NDV; ++d) o[d] = f32x16{};
        int ksrc[KPW], vsrc[VPW];
#pragma unroll
        for (int i = 0; i < KPW; ++i) { const int row = 2 * (wid * KPW + i) + (lane >> 5); ksrc[i] = row * ldk + (((lane & 31) ^ (row & 15)) << 3); }
#pragma unroll
        for (int i = 0; i < VPW; ++i) { const int kk = wid * 8 + ((lane & 31) >> 2), k = (kk & ~0xC) | ((kk & 4) << 1) | ((kk & 8) >> 1); vsrc[i] = k * ldk + (2 * i + (lane >> 5)) * 32 + (lane & 3) * 8; }
#define FG_DMA(t, bf) do { const size_t ro_ = (size_t)((t) * KVBLK) * ldk; \
        _Pragma("unroll") for (int i_ = 0; i_ < VPW; ++i_) __builtin_amdgcn_global_load_lds((const unsigned*)(Vg + ro_ + vsrc[i_]), (__attribute__((address_space(3))) unsigned*)(ldsL + (bf) * SHM_V + (wid * VPW + i_) * 1024), 16, 0, 0); \
        _Pragma("unroll") for (int i_ = 0; i_ < KPW; ++i_) __builtin_amdgcn_global_load_lds((const unsigned*)(Kg + ro_ + ksrc[i_]), (__attribute__((address_space(3))) unsigned*)(ldsL + 2 * SHM_V + (bf) * SHM_K + (wid * KPW + i_) * 1024), 16, 0, 0); } while (0)
        const int vb0 = (int)(uintptr_t)V_lds + v_rd_base(lane) + vdoff * 512;
        FG_DMA(0, 0);
        bf16x8 qr[NDQ];
#pragma unroll
        for (int d0 = 0; d0 < NDQ; ++d0) qr[d0] = *reinterpret_cast<const bf16x8*>(Qw + (size_t)r32 * ldq + d0 * 16 + hi * 8);
        __syncthreads();
        for (int t = 0; t < NT; ++t) {
            const int bf = t & 1;
            if (t + 1 < NT) FG_DMA(t + 1, bf ^ 1);
            f32x16 p0, p1; float al; bf16x8 pa0, pa1, pa2, pa3;
            FA_SBAR(); qkt<NDQ>(p0, p1, K_lds + bf * SHM_K, r32, hi, qr);
            partialSM(p0, p1, m_reg, al);
            if (__any(al < 1.f)) { if (hi == 0) al_l[r32] = al; asm volatile("s_waitcnt lgkmcnt(0)" ::: "memory");
#pragma unroll
                for (int d_ = 0; d_ < NDV; ++d_)
#pragma unroll
                    for (int r = 0; r < 16; ++r) o[d_][r] *= al_l[crow(r, hi)]; }
            finishSM(p0, p1, al, l_reg, pa0, pa1, pa2, pa3); FA_SBAR();
            pv_tile<NDVT, NDV>(o, vb0 + bf * SHM_V, pa0, pa1, pa2, pa3);
            __syncthreads();
        }
#undef FG_DMA
    }
};
}
__device__ __forceinline__ void cross_block(const Params& p, char* lds, LAS unsigned char* ldsL, int b, int head, int rb) {
    using namespace fa;
    int tid = threadIdx.x; asm volatile("" : "+v"(tid));
    const int wid = __builtin_amdgcn_readfirstlane(tid >> 6), lane = tid & 63, r32 = lane & 31, hi = lane >> 5, dh = wid >> 2;
    const bf16* qc = (const bf16*)(p.ws + WS_QC); const bf16* kvm = (const bf16*)(p.ws + WS_KVM); bf16* oc = (bf16*)(p.ws + WS_OC);
    typedef CoreSeqG<16, 8, 4> CC;
    constexpr int SCR = 131072 + 8192;
    float* wsf = (float*)(lds + SCR + 2048) + wid * 64;
    const int ovoff = (4 * hi * DM + r32) * 2;
    const size_t row0 = (size_t)b * SEQ + rb * 128 + (wid & 3) * 32;
    const __amdgpu_buffer_rsrc_t rso = mk_rsrc(oc + row0 * DM + head * 256 + dh * 128);
    f32x16 o[4]; float m_reg, l_reg;
    CC::run(o, m_reg, l_reg, qc + row0 * DM + head * 256, DM, kvm + (size_t)b * MEML * 2048 + head * 256, kvm + (size_t)b * MEML * 2048 + 1024 + head * 256, 2048, MEML / 64, lds, (CC::lptr)ldsL, SCR, dh * 4);
    if (hi == 0) wsf[r32] = l_reg;
    asm volatile("s_waitcnt lgkmcnt(0)" ::: "memory");
#pragma unroll
    for (int r = 0; r < 16; ++r) { const float rl = 1.0f / wsf[crow(r, hi)];
#pragma unroll
        for (int d0 = 0; d0 < 4; ++d0) { const float y = o[d0][r] * rl; const float yn = __shfl_xor(y, 1);
            if ((r32 & 1) == 0) __builtin_amdgcn_raw_buffer_store_b32(cvtpk(y, yn), rso, ovoff, (((r & 3) + 8 * (r >> 2)) * DM + d0 * 32) * 2, 0); } }
    asm volatile("s_waitcnt lgkmcnt(0)" ::: "memory");
}
#define GAS __attribute__((address_space(1)))
typedef GAS unsigned gu32;
constexpr int CW_BAR = 4096;
constexpr size_t CTL_ZERO_BYTES = 65536;
constexpr int MISC_OFF = 131072 + 320, TAB_OFF = 131072 + 1024;
constexpr int CW_PANEL = 8192;
constexpr size_t WS_XCH = 60 * MiB;
#define XB_TMO      128
#define XB_XCNT(j)  (256  + 64 * (j))
#define XB_XSUB(j)  (1280 + 64 * (j))
#define XB_XGEN(j)  (2304 + 64 * (j))
#define XB_TOP      3328
#define XB_TOPGEN   3392
#define XCD_BAR_WORDS 3456
#define XB_SPIN_CAP (1u << 18)

__device__ __forceinline__ unsigned xb_ld(unsigned* p)              { return __hip_atomic_load(p, __ATOMIC_RELAXED, __HIP_MEMORY_SCOPE_AGENT); }
__device__ __forceinline__ unsigned xb_add(unsigned* p, unsigned v) { return __hip_atomic_fetch_add(p, v, __ATOMIC_RELAXED, __HIP_MEMORY_SCOPE_AGENT); }
__device__ __forceinline__ unsigned xb_xcc_id() { return (unsigned)__builtin_amdgcn_s_getreg((3 << 11) | 20) & 0xFu; }
#define XB_SPIN(cond, bar) do { unsigned _sp = 0; while (cond) { __builtin_amdgcn_s_sleep(1); \
    if ((++_sp & 255u) == 0u) { if (xb_ld(&(bar)[XB_TMO])) break; if (_sp > XB_SPIN_CAP) { atomicAdd(&(bar)[XB_TMO], 1u); break; } } } } while (0)

struct XcdBarrier {
    unsigned* bar; unsigned x;
    volatile LAS unsigned* st;
};

__device__ __forceinline__ XcdBarrier xcd_barrier_post(unsigned* bar, volatile LAS unsigned* st) {
    XcdBarrier b; b.bar = bar; b.x = xb_xcc_id(); b.st = st;
    if (threadIdx.x == 0) (void)xb_add(&bar[XB_XCNT(b.x)], 1u);
    return b;
}
__device__ __forceinline__ void xcd_barrier_complete(unsigned* bar, unsigned x, unsigned& nloc, unsigned& nx) {
    const unsigned G = gridDim.x * gridDim.y * gridDim.z;
    unsigned sum, cnt, mine, sp = 0u;
    for (;;) {
        sum = 0u; cnt = 0u; mine = 0u;
#pragma unroll
        for (unsigned j = 0; j < 16; ++j) { const unsigned c = xb_ld(&bar[XB_XCNT(j)]); sum += c; cnt += (c > 0u) ? 1u : 0u; mine = (j == x) ? c : mine; }
        if (sum == G) break;
        __builtin_amdgcn_s_sleep(1);
        if ((++sp & 255u) == 0u) { if (xb_ld(&bar[XB_TMO])) break; if (sp > XB_SPIN_CAP) { atomicAdd(&bar[XB_TMO], 1u); break; } }
    }
    nloc = mine > 0u ? mine : 1u; nx = cnt > 0u ? cnt : 1u;
}

__device__ __forceinline__ void xcd_barrier(const XcdBarrier& b) {
    asm volatile("s_waitcnt vmcnt(0)" ::: "memory");
    __syncthreads();
    if (threadIdx.x == 0) {
        unsigned* bar = b.bar;
        __builtin_amdgcn_s_waitcnt(0);
        unsigned nloc = b.st[0], nx = b.st[1];
        if (nloc == 0u) { xcd_barrier_complete(bar, b.x, nloc, nx); b.st[0] = nloc; b.st[1] = nx; }
        const unsigned old = xb_add(&bar[XB_XSUB(b.x)], 1u);
        const unsigned gen = old / nloc;
        if (old + 1u == (gen + 1u) * nloc) {
            __builtin_amdgcn_fence(__ATOMIC_RELEASE, "agent");
            asm volatile("s_waitcnt vmcnt(0)" ::: "memory");
            const unsigned og = xb_add(&bar[XB_TOP], 1u);
            const unsigned tg = og / nx;
            if (og + 1u == (tg + 1u) * nx) xb_add(&bar[XB_TOPGEN], 1u);
            else XB_SPIN(xb_ld(&bar[XB_TOPGEN]) == tg, bar);
            __builtin_amdgcn_fence(__ATOMIC_ACQUIRE, "agent");
            xb_add(&bar[XB_XGEN(b.x)], 1u);
            asm volatile("s_waitcnt vmcnt(0)" ::: "memory");
        } else {
            XB_SPIN(xb_ld(&bar[XB_XGEN(b.x)]) == gen, bar);
            __builtin_amdgcn_fence(__ATOMIC_ACQUIRE, "agent");
            asm volatile("s_waitcnt vmcnt(0)" ::: "memory");
        }
    }
    __syncthreads();
}

constexpr int LDS_BYTES = 147456;
constexpr size_t WS_SS3 = 58 * MiB;
__device__ __forceinline__ void final_norm_ss(float* X, const float* ss, const float* g, int gw, int ngw, int lane) {
    for (int m = gw; m < M; m += ngw) {
        const float rstd = pg8::rstd_ss(ss, m);
        f32x4* xr = (f32x4*)(X + (size_t)m * DM) + lane;
#pragma unroll
        for (int j = 0; j < 4; ++j) { const f32x4 gg = ((const f32x4*)g)[lane + 64 * j]; xr[64 * j] = xr[64 * j] * rstd * gg; }
    }
}
constexpr int N_PHASES = 10;
__global__ void __launch_bounds__(NTHR, 2) fwd_kernel(Params p) {
    extern __shared__ __attribute__((aligned(16))) unsigned char lds_raw[];
    LAS unsigned char* lds = (LAS unsigned char*)lds_raw;
    for (int u = threadIdx.x; u < 64; u += NTHR) ((LAS unsigned*)(lds + MISC_OFF))[u] = 0u;
    __syncthreads();
    XcdBarrier bar = xcd_barrier_post((unsigned*)(p.ws + WS_CTL) + CW_BAR, (volatile LAS unsigned*)(lds + MISC_OFF) + 8);
    const int tid = threadIdx.x, wave = __builtin_amdgcn_readfirstlane(tid >> 6), lane = tid & 63, bid = blockIdx.x, nblk = gridDim.x;
    const int gw = bid * NWAVES + wave, ngw = nblk * NWAVES;
    const int vcu = (nblk % 8 == 0) ? (bid % 8) * (nblk / 8) + bid / 8 : bid;
    unsigned char* ws = p.ws;
    const int lo = p.ph_lo, hi = p.ph_hi;
    typedef pg8::bf16_t b16;
#define IN(k) (lo <= (k) && (k) < hi)
#define SEAM(k) do { if (IN(k) && IN((k) + 1) && !((k) == 8 && nblk == 256)) xcd_barrier(bar); } while (0)
    if (IN(0)) { p0_prologue(p, lds, bid, nblk, tid); } SEAM(0);
    if (IN(1)) {
        pg8::Gemm g{(const b16*)(ws + WS_XN), (const b16*)(ws + WS_WIN), (const b16*)(ws + WS_MEMN), (const b16*)(ws + WS_WCKV), DM};
        pg8::TwoOrder S; S.init(M, NP, nblk, bid); S.n2M = MM / 256; S.n2N = 2048 / 256;
        pg8::EpiProj E{(b16*)(ws + WS_PROJ), (b16*)(ws + WS_KVM), (const float*)(ws + WS_ROPE)};
        pg8::gemm_phase<pg8::EpiProj, pg8::TwoOrder, true, true>(lds, g, S, E);
    } SEAM(1);
    if (IN(2)) { attn_phase(p, (char*)lds_raw, vcu, nblk);
    } SEAM(2);
    if (IN(3)) {
        pg8::Gemm g{(const b16*)(ws + WS_ATT), (const b16*)(ws + WS_WOUT), nullptr, nullptr, DM};
        pg8::StaticOrder S; S.init(M, DM, nblk, bid);
        pg8::EpiResB<true> E{p.x, nullptr, (b16*)(ws + WS_XN), (float*)(ws + WS_SS1)};
        pg8::gemm_phase<pg8::EpiResB<true>, pg8::StaticOrder, true, true>(lds, g, S, E);
    } SEAM(3);
    if (IN(4)) {
        pg8::Gemm g{(const b16*)(ws + WS_XN), (const b16*)(ws + WS_WCQ), nullptr, nullptr, DM};
        pg8::StaticOrder S; S.init(M, DM, nblk, bid);
        pg8::EpiScaleBf16<0> E{(b16*)(ws + WS_QC), DM, (const float*)(ws + WS_SS1), CQ, lds + TAB_OFF};
        pg8::gemm_phase<pg8::EpiScaleBf16<0>, pg8::StaticOrder, true, true>(lds, g, S, E);
        asm volatile("s_waitcnt vmcnt(0)" ::: "memory");
        __syncthreads();
        if (tid == 0) { __builtin_amdgcn_fence(__ATOMIC_ACQUIRE, "agent"); asm volatile("s_waitcnt vmcnt(0)" ::: "memory"); }
        __syncthreads();
#pragma nounroll
        for (int i = 0; ; ++i) {
            pg8::Unit u; if (!S.next(i, u)) break;
#pragma nounroll
            for (int hb = 0; hb < 2; ++hb) cross_block(p, (char*)lds_raw, lds, u.pm >> 4, u.pn, (u.pm & 15) * 2 + hb);
        }
    } SEAM(4);
    if (IN(6)) {
        pg8::Gemm g{(const b16*)(ws + WS_OC), (const b16*)(ws + WS_WCO), nullptr, nullptr, DM};
        pg8::StaticOrder S; S.init(M, DM, nblk, bid);
        pg8::EpiResB<false> E{nullptr, (const b16*)(ws + WS_XN), (b16*)(ws + WS_XN), (float*)(ws + WS_SS2)};
        pg8::gemm_phase<pg8::EpiResB<false>, pg8::StaticOrder, true, true>(lds, g, S, E);
    } SEAM(6);
    if (IN(7)) {
        pg8::Gemm g{(const b16*)(ws + WS_XN), (const b16*)(ws + WS_WUP), nullptr, nullptr, DM};
        pg8::StaticOrder S; S.init(M, FF, nblk, bid);
        pg8::EpiScaleBf16<1> E{(b16*)(ws + WS_ACT), FF, (const float*)(ws + WS_SS2), 1.f, lds + TAB_OFF};
        pg8::gemm_phase<pg8::EpiScaleBf16<1>, pg8::StaticOrder, true, true>(lds, g, S, E);
    } SEAM(7);
    if (IN(8)) {
        pg8::Gemm g{(const b16*)(ws + WS_ACT), (const b16*)(ws + WS_WDOWN), nullptr, nullptr, FF};
        pg8::StaticOrder S; S.init(M, DM, nblk, bid);
        if (nblk == 256) {
            pg8::EpiFinal E{(const b16*)(ws + WS_XN), p.out, p.g_final, (unsigned*)(ws + WS_XCH), (unsigned*)(ws + WS_CTL) + CW_PANEL, lds + TAB_OFF};
            pg8::gemm_phase<pg8::EpiFinal, pg8::StaticOrder, true, true>(lds, g, S, E);
        } else {
            pg8::EpiResF E{(const b16*)(ws + WS_XN), p.out, (float*)(ws + WS_SS3)};
            pg8::gemm_phase<pg8::EpiResF, pg8::StaticOrder, true, true>(lds, g, S, E);
        }
    } SEAM(8);
    if (IN(9) && nblk != 256) { final_norm_ss(p.out, (const float*)(ws + WS_SS3), p.g_final, gw, ngw, lane); }
#undef IN
#undef SEAM
}

extern "C" void kernel_launch(void* const* d_in, const int* in_sizes, int n_in, void* d_out, int out_size, void* d_ws, size_t ws_size, hipStream_t stream) {
    static int grid = 0;
    if (grid == 0) {
        if (n_in != 21 || out_size != M * DM || ws_size < WS_END) { fprintf(stderr, "kernel_launch: unexpected shapes (n_in %d out %d ws %zu)\n", n_in, out_size, ws_size); grid = -1; return; }
        int dev = 0, cus = 0, per_cu = 0;
        (void)hipGetDevice(&dev); (void)hipDeviceGetAttribute(&cus, hipDeviceAttributeMultiprocessorCount, dev);
        if (hipFuncSetAttribute((const void*)fwd_kernel, hipFuncAttributeMaxDynamicSharedMemorySize, LDS_BYTES) != hipSuccess) { fprintf(stderr, "kernel_launch: hipFuncSetAttribute failed\n"); grid = -1; return; }
        (void)hipOccupancyMaxActiveBlocksPerMultiprocessor(&per_cu, (const void*)fwd_kernel, NTHR, LDS_BYTES);
        if (per_cu < 1) { fprintf(stderr, "kernel_launch: occupancy query says %d blocks per CU\n", per_cu); per_cu = 1; }
        grid = cus;
    }
    if (grid < 0) return;
    Params p{};
    p.x = (const float*)d_in[0]; p.mem = (const float*)d_in[1]; p.pos = (const int*)d_in[2]; p.g_mix = (const float*)d_in[3]; p.w_in = (const float*)d_in[4];
    p.sinks = (const float*)d_in[5]; p.lq1 = (const float*)d_in[6]; p.lk1 = (const float*)d_in[7]; p.lq2 = (const float*)d_in[8]; p.lk2 = (const float*)d_in[9];
    p.g_diff = (const float*)d_in[10]; p.w_out = (const float*)d_in[11]; p.g_cross = (const float*)d_in[12]; p.g_mem = (const float*)d_in[13]; p.w_cq = (const float*)d_in[14];
    p.w_ckv = (const float*)d_in[15]; p.w_co = (const float*)d_in[16]; p.g_mlp = (const float*)d_in[17]; p.w_up = (const float*)d_in[18]; p.w_down = (const float*)d_in[19]; p.g_final = (const float*)d_in[20];
    p.out = (float*)d_out; p.ws = (unsigned char*)d_ws;
    if (hipMemsetAsync((char*)d_ws + WS_CTL, 0, CTL_ZERO_BYTES, stream) != hipSuccess) { fprintf(stderr, "kernel_launch: hipMemsetAsync of the control words failed\n"); return; }
    p.ph_lo = 0; p.ph_hi = N_PHASES;
    hipLaunchKernelGGL(fwd_kernel, dim3(grid), dim3(NTHR), LDS_BYTES, stream, p);
}
```

```cpp
#define WT_ATT 16
#include <hip/hip_runtime.h>
#include <cstdio>
#include <cstdint>


#define LAS __attribute__((address_space(3)))
typedef unsigned short bf16;
typedef short bf16x8 __attribute__((ext_vector_type(8)));
typedef float f32x4 __attribute__((ext_vector_type(4)));
typedef unsigned u32x4 __attribute__((ext_vector_type(4)));
typedef unsigned u32x2 __attribute__((ext_vector_type(2)));

constexpr int BATCH = 8, SEQ = 4096, M = BATCH * SEQ, DM = 1024, NP = 2304, MEML = 256, MM = BATCH * MEML, FF = 4096;
constexpr int NWAVES = 8, NTHR = NWAVES * 64;
constexpr float EPS = 1e-5f;
constexpr float LOG2E = 1.4426950408889634f;
constexpr float C2 = 0.125f * LOG2E;
constexpr float CQ = 0.0625f * LOG2E;
constexpr int C_QA = 0, C_KA = 512, C_VA = 640, C_QD = 768, C_KD = 1280, C_VD = 1792;

constexpr size_t MiB = 1u << 20;
constexpr size_t WS_CTL = 0;
constexpr size_t WS_WIN = 2 * MiB;
constexpr size_t WS_WOUT = WS_WIN + (size_t)NP * DM * 2;
constexpr size_t WS_WCQ = WS_WOUT + 2 * MiB;
constexpr size_t WS_WCKV = WS_WCQ + 2 * MiB;
constexpr size_t WS_WCO = WS_WCKV + 4 * MiB;
constexpr size_t WS_WUP = WS_WCO + 2 * MiB;
constexpr size_t WS_WDOWN = WS_WUP + 8 * MiB;
constexpr size_t WS_ROPE = 34 * MiB;
constexpr size_t WS_KVM = 42 * MiB;
constexpr size_t WS_MEMN = 50 * MiB;
constexpr size_t WS_SS1 = 54 * MiB, WS_SS2 = 56 * MiB;
constexpr size_t WS_XN = 64 * MiB;
constexpr size_t WS_PROJ = 256 * MiB;
constexpr size_t WS_ATT = 400 * MiB;
constexpr size_t WS_QC = 256 * MiB;
constexpr size_t WS_OC = 320 * MiB;
constexpr size_t WS_ACT = 256 * MiB;
constexpr size_t WS_END = 512 * MiB;
static_assert(WS_WDOWN + 8 * MiB <= WS_ROPE, "weights fit");

struct Params {
    const float *x, *mem; const int* pos;
    const float *g_mix, *w_in, *sinks, *lq1, *lk1, *lq2, *lk2, *g_diff, *w_out, *g_cross, *g_mem, *w_cq, *w_ckv, *w_co, *g_mlp, *w_up, *w_down, *g_final;
    float* out; unsigned char* ws; int ph_lo, ph_hi;
};

__device__ __forceinline__ unsigned f2bf(float f) { unsigned u = __builtin_bit_cast(unsigned, f); return (u + 0x7fffu + ((u >> 16) & 1u)) >> 16; }
__device__ __forceinline__ unsigned pk2(float lo, float hi) { return f2bf(lo) | (f2bf(hi) << 16); }
__device__ __forceinline__ float bf2f(unsigned h) { return __builtin_bit_cast(float, h << 16); }
__device__ __forceinline__ float bflo(unsigned w) { return __builtin_bit_cast(float, w << 16); }
__device__ __forceinline__ float bfhi(unsigned w) { return __builtin_bit_cast(float, w & 0xffff0000u); }
__device__ __forceinline__ float wave_sum(float v) {
#pragma unroll
    for (int o = 1; o < 64; o <<= 1) v += __shfl_xor(v, o);
    return v;
}
__device__ __forceinline__ float wave_max(float v) {
#pragma unroll
    for (int o = 1; o < 64; o <<= 1) v = fmaxf(v, __shfl_xor(v, o));
    return v;
}
__host__ __device__ __forceinline__ bool col_roped(int n) { return n < C_VA || (n >= C_QD && n < C_VD); }
__host__ __device__ __forceinline__ int phys_of_logical(int nl) {
    if (!col_roped(nl)) return nl;
    const int g = nl & ~63, j = nl & 63; return g + ((j & 31) << 1) + (j >> 5);
}
__device__ __forceinline__ float calc_lambda(const Params& p) {
    float a = 0.f, b = 0.f;
    for (int i = 0; i < 64; ++i) { a += p.lq1[i] * p.lk1[i]; b += p.lq2[i] * p.lk2[i]; }
    return __expf(a) - __expf(b) + 0.2f;
}

__device__ const double INV_FREQ[32] = {
    1.0, 0.7498942093324559, 0.5623413251903491, 0.4216965034285822,
    0.31622776601683794, 0.23713737056616552, 0.1778279410038923, 0.1333521432163324,
    0.1, 0.07498942093324558, 0.05623413251903491, 0.042169650342858224,
    0.03162277660168379, 0.023713737056616554, 0.01778279410038923, 0.01333521432163324,
    0.01, 0.007498942093324558, 0.005623413251903491, 0.004216965034285823,
    0.0031622776601683794, 0.0023713737056616554, 0.0017782794100389228, 0.001333521432163324,
    0.001, 0.0007498942093324559, 0.0005623413251903491, 0.00042169650342858224,
    0.00031622776601683794, 0.00023713737056616554, 0.00017782794100389227, 0.0001333521432163324};

__device__ __forceinline__ void sincos_d(double a, float& c, float& s) {
    const double kd = rint(a * 0.63661977236758134308);
    const int k = (int)kd;
    double r = fma(-kd, 1.57079632679489655800e+00, a); r = fma(-kd, 6.12323399573676603587e-17, r);
    const double r2 = r * r;
    const double sp = r * (1.0 + r2 * (-1.0 / 6.0 + r2 * (1.0 / 120.0 + r2 * (-1.0 / 5040.0 + r2 * (1.0 / 362880.0 + r2 * (-1.0 / 39916800.0 + r2 * (1.0 / 6227020800.0)))))));
    const double cp = 1.0 + r2 * (-0.5 + r2 * (1.0 / 24.0 + r2 * (-1.0 / 720.0 + r2 * (1.0 / 40320.0 + r2 * (-1.0 / 3628800.0 + r2 * (1.0 / 479001600.0 + r2 * (-1.0 / 87178291200.0)))))));
    const int q = k & 3;
    const double ss = (q == 0) ? sp : (q == 1) ? cp : (q == 2) ? -sp : -cp;
    const double cc = (q == 0) ? cp : (q == 1) ? -sp : (q == 2) ? -cp : sp;
    c = (float)cc; s = (float)ss;
}

template <bool HASG, bool PERMC>
__device__ __forceinline__ void transpose_item(const float* W, int K, int N, const float* g, bf16* WT, LAS float* scr, int item, int lane) {
    const int nblk = N / 32, kb = item / nblk, nb = item % nblk, k0 = 64 * kb, n0 = 32 * nb;
#pragma unroll 16
    for (int i = 0; i < 32; ++i) { const int kk = 2 * i + (lane >> 5); float v = W[(size_t)(k0 + kk) * N + n0 + (lane & 31)]; if (HASG) v *= g[k0 + kk]; scr[kk * 33 + (lane & 31)] = v; }
    asm volatile("s_waitcnt lgkmcnt(0)" ::: "memory");
    const int c = lane & 7;
#pragma unroll
    for (int j = 0; j < 4; ++j) { const int n = (lane >> 3) + 8 * j; const LAS float* s = scr + (8 * c) * 33 + n;
        u32x4 o; o.x = pk2(s[0 * 33], s[1 * 33]); o.y = pk2(s[2 * 33], s[3 * 33]); o.z = pk2(s[4 * 33], s[5 * 33]); o.w = pk2(s[6 * 33], s[7 * 33]);
        const int nl = n0 + n, np = PERMC ? phys_of_logical(nl) : nl;
        *(u32x4*)(WT + (size_t)np * K + k0 + 8 * c) = o; }
    asm volatile("s_waitcnt lgkmcnt(0)" ::: "memory");
}
__device__ __forceinline__ void rms_row_to_bf16(const float* xrow, const float* g, bf16* orow, int lane) {
    const f32x4* xr = (const f32x4*)xrow + lane;
    f32x4 v[4]; float s = 0.f;
#pragma unroll
    for (int j = 0; j < 4; ++j) { v[j] = xr[64 * j]; s += (v[j].x * v[j].x + v[j].y * v[j].y) + (v[j].z * v[j].z + v[j].w * v[j].w); }
    const float rstd = 1.0f / sqrtf(wave_sum(s) * (1.f / DM) + EPS);
    u32x2* o8 = (u32x2*)orow + lane;
#pragma unroll
    for (int j = 0; j < 4; ++j) {
        f32x4 gg = (f32x4){1.f, 1.f, 1.f, 1.f}; if (g) gg = ((const f32x4*)g)[lane + 64 * j];
        u32x2 w; w.x = pk2(v[j].x * rstd * gg.x, v[j].y * rstd * gg.y); w.y = pk2(v[j].z * rstd * gg.z, v[j].w * rstd * gg.w); o8[64 * j] = w; }
}
__device__ __forceinline__ void p0_prologue(const Params& p, LAS unsigned char* lds, int bid, int nblk, int tid) {
    const int wave = tid >> 6, lane = tid & 63;
    LAS float* scr = (LAS float*)(lds + wave * 8704);
    const int gw = bid * NWAVES + wave, NGW = nblk * NWAVES;
    unsigned char* ws = p.ws;
    constexpr int I_IN = (DM / 64) * (NP / 32), I_SQ = (DM / 64) * (DM / 32), I_KV = (DM / 64) * (2048 / 32), I_UP = (DM / 64) * (FF / 32), I_DN = (FF / 64) * (DM / 32);
    constexpr int NITEMS = I_IN + 3 * I_SQ + I_KV + I_UP + I_DN;
    for (int it = gw; it < NITEMS; it += NGW) {
        int r = it;
        if (r < I_IN) { transpose_item<true, true>(p.w_in, DM, NP, p.g_mix, (bf16*)(ws + WS_WIN), scr, r, lane); continue; } r -= I_IN;
        if (r < I_SQ) { transpose_item<false, false>(p.w_out, DM, DM, nullptr, (bf16*)(ws + WS_WOUT), scr, r, lane); continue; } r -= I_SQ;
        if (r < I_SQ) { transpose_item<true, false>(p.w_cq, DM, DM, p.g_cross, (bf16*)(ws + WS_WCQ), scr, r, lane); continue; } r -= I_SQ;
        if (r < I_KV) { transpose_item<false, false>(p.w_ckv, DM, 2048, nullptr, (bf16*)(ws + WS_WCKV), scr, r, lane); continue; } r -= I_KV;
        if (r < I_SQ) { transpose_item<false, false>(p.w_co, DM, DM, nullptr, (bf16*)(ws + WS_WCO), scr, r, lane); continue; } r -= I_SQ;
        if (r < I_UP) { transpose_item<true, false>(p.w_up, DM, FF, p.g_mlp, (bf16*)(ws + WS_WUP), scr, r, lane); continue; } r -= I_UP;
        transpose_item<false, false>(p.w_down, FF, DM, nullptr, (bf16*)(ws + WS_WDOWN), scr, r, lane);
    }
    for (int m = gw * 2; m < M; m += NGW * 2) {
        const f32x4* x0 = (const f32x4*)(p.x + (size_t)m * DM) + lane; const f32x4* x1 = x0 + DM / 4;
        f32x4 v0[4], v1[4]; float s0 = 0.f, s1 = 0.f;
#pragma unroll
        for (int j = 0; j < 4; ++j) { v0[j] = x0[64 * j]; v1[j] = x1[64 * j]; }
#pragma unroll
        for (int j = 0; j < 4; ++j) { s0 += (v0[j].x * v0[j].x + v0[j].y * v0[j].y) + (v0[j].z * v0[j].z + v0[j].w * v0[j].w); s1 += (v1[j].x * v1[j].x + v1[j].y * v1[j].y) + (v1[j].z * v1[j].z + v1[j].w * v1[j].w); }
#pragma unroll
        for (int o = 1; o < 64; o <<= 1) { s0 += __shfl_xor(s0, o); s1 += __shfl_xor(s1, o); }
        const float r0 = 1.0f / sqrtf(s0 * (1.f / DM) + EPS), r1 = 1.0f / sqrtf(s1 * (1.f / DM) + EPS);
        u32x2* o0 = (u32x2*)((bf16*)(ws + WS_XN) + (size_t)m * DM) + lane; u32x2* o1 = o0 + DM / 4;
#pragma unroll
        for (int j = 0; j < 4; ++j) { u32x2 w; w.x = pk2(v0[j].x * r0, v0[j].y * r0); w.y = pk2(v0[j].z * r0, v0[j].w * r0); o0[64 * j] = w;
            u32x2 z; z.x = pk2(v1[j].x * r1, v1[j].y * r1); z.y = pk2(v1[j].z * r1, v1[j].w * r1); o1[64 * j] = z; }
    }
    for (int m = gw; m < MM; m += NGW) rms_row_to_bf16(p.mem + (size_t)m * DM, p.g_mem, (bf16*)(ws + WS_MEMN) + (size_t)m * DM, lane);
    float2* rope = (float2*)(ws + WS_ROPE);
    for (int i = bid * NTHR + tid; i < M * 32; i += nblk * NTHR) {
        const int row = i >> 5, d = i & 31; float c, s; sincos_d((double)p.pos[row] * INV_FREQ[d], c, s); rope[i] = make_float2(c, s); }
}

namespace pg8 {
#define PG8_LAS __attribute__((address_space(3)))
typedef unsigned short bf16_t;
typedef short bf16x8 __attribute__((ext_vector_type(8)));
typedef float f32x4 __attribute__((ext_vector_type(4)));
typedef unsigned u32x4 __attribute__((ext_vector_type(4)));
typedef unsigned u32x2 __attribute__((ext_vector_type(2)));
constexpr int BM = 256, BK = 64, HALF = 128, HTB = HALF * BK * 2  , STAGE_BYTES = 8 * HTB, NXCD = 8, WGM = 8;

__host__ __device__ __forceinline__ int lds_byte(int r, int c) { const int st = (r >> 4) * 2 + (c >> 5), rr = r & 15, cc = c & 31, ob = rr * 64 + cc * 2; return st * 1024 + (ob ^ (((ob >> 9) & 1) << 5)); }
__host__ __device__ __forceinline__ void stage_rc(int b, int& R, int& C) { const int st = b / 1024, sb = b % 1024, swz = sb ^ (((sb >> 9) & 1) << 5); R = (st >> 1) * 16 + swz / 64; C = (st & 1) * 32 + (swz % 64) / 2; }
__host__ __device__ __forceinline__ int perm32(int rho) { const int n = rho >> 4, i = rho & 15; return 8 * (i >> 2) + 4 * n + (i & 3); }

struct Unit { int pm, pn, alt; };
struct Gemm { const bf16_t* A; const bf16_t* Bt; const bf16_t* A2; const bf16_t* Bt2; int K; };

struct StaticOrder {
    int nM, nN, nwg, G, c;
    __host__ __device__ void init(int M_, int N_, int G_, int c_) { nM = M_ / BM; nN = N_ / BM; nwg = nM * nN; G = G_; c = c_; }
    __host__ __device__ bool map(long L, Unit& u) const {
        if (L >= nwg) return false;
        int wgid = (int)L; { const int q = nwg / NXCD, r = nwg % NXCD, xcd = wgid % NXCD, off = wgid / NXCD; wgid = (xcd < r ? xcd * (q + 1) : r * (q + 1) + (xcd - r) * q) + off; }
        const int nig = WGM * nN, gid = wgid / nig, fm = gid * WGM, gsz = (nM - fm) < WGM ? (nM - fm) : WGM;
        u.pm = fm + ((wgid % nig) % gsz); u.pn = (wgid % nig) / gsz; u.alt = 0; return true;
    }
    __host__ __device__ bool next(int i, Unit& u) const { return map((long)i * G + c, u); }
    __device__ __forceinline__ void a_ready(const Unit&) const {}
    __device__ __forceinline__ void done(const Unit&) const {}
};
struct OneUnit {
    Unit u;
    __device__ __forceinline__ bool next(int i, Unit& o) const { if (i) return false; o = u; return true; }
    __device__ __forceinline__ void a_ready(const Unit&) const {}
    __device__ __forceinline__ void done(const Unit&) const {}
};
struct TwoOrder : StaticOrder {
    int n2M, n2N;
    __host__ __device__ bool next(int i, Unit& u) const {
        const long L = (long)i * G + c;
        if (L < nwg) return map(L, u);
        const int r = (int)(L - nwg); if (r >= n2M * n2N) return false;
        u.pm = r % n2M; u.pn = r / n2M; u.alt = 1; return true;
    }
};
typedef __bf16 cvt_bf2 __attribute__((ext_vector_type(2))); typedef float cvt_f2 __attribute__((ext_vector_type(2)));
__device__ __forceinline__ unsigned cvt_pk_bf16(float lo, float hi) { const cvt_f2 v = {lo, hi}; return __builtin_bit_cast(unsigned, __builtin_convertvector(v, cvt_bf2)); }

__device__ __forceinline__ float rstd_ss(const float* ss, int row) {
    const f32x4* s4 = (const f32x4*)(ss + (size_t)row * 16); float t = 0.f;
#pragma unroll
    for (int i = 0; i < 4; ++i) { const f32x4 v = s4[i]; t += (v.x + v.y) + (v.z + v.w); }
    return 1.0f / sqrtf(t * (1.f / DM) + EPS);
}
struct EpiProj {
    static constexpr bool PERM = true, AFTER_DRAIN = false;
    bf16_t* proj; bf16_t* kvm; const float* rope;
    __device__ __forceinline__ void operator()(const f32x4 (&acc)[2][2][4][2], const Unit& u, int wr, int wc, int fr, int fq) const {
        const int row0 = u.pm * BM + wr * 64 + fr, col0 = u.pn * BM + wc * 32 + 8 * fq;
        if (u.alt) {
#pragma unroll
            for (int ai = 0; ai < 2; ++ai)
#pragma unroll
                for (int m = 0; m < 4; ++m) { bf16_t* rowp = kvm + (size_t)(row0 + ai * HALF + m * 16) * 2048 + col0;
#pragma unroll
                    for (int bj = 0; bj < 2; ++bj) { const f32x4 v0 = acc[ai][bj][m][0], v1 = acc[ai][bj][m][1];
                        u32x4 w; w.x = cvt_pk_bf16(v0[0], v0[1]); w.y = cvt_pk_bf16(v0[2], v0[3]); w.z = cvt_pk_bf16(v1[0], v1[1]); w.w = cvt_pk_bf16(v1[2], v1[3]);
                        *(u32x4*)(rowp + bj * HALF) = w; } }
            return;
        }
        const int d0 = ((wc & 1) * 32 + 8 * fq) >> 1;
#pragma unroll
        for (int ai = 0; ai < 2; ++ai) {
            f32x4 csa[4], csb[4];
#pragma unroll
            for (int m = 0; m < 4; ++m) { const size_t ro = (size_t)(row0 + ai * HALF + m * 16) * 64 + 2 * d0; csa[m] = *(const f32x4*)(rope + ro); csb[m] = *(const f32x4*)(rope + ro + 4); }
#pragma unroll
            for (int m = 0; m < 4; ++m) { const int row = row0 + ai * HALF + m * 16;
                const f32x4 cs0 = csa[m], cs1 = csb[m];
#pragma unroll
                for (int bj = 0; bj < 2; ++bj) { const int cb = u.pn * BM + bj * HALF;
                    const bool roped = col_roped(cb); const float sc = (cb < C_KA || (cb >= C_QD && cb < C_KD)) ? C2 : 1.f;
                    f32x4 v0 = acc[ai][bj][m][0], v1 = acc[ai][bj][m][1];
                    if (roped) {
                        const f32x4 a = v0, b = v1;
                        v0[0] = a[0] * cs0[0] - a[1] * cs0[1]; v0[1] = a[1] * cs0[0] + a[0] * cs0[1];
                        v0[2] = a[2] * cs0[2] - a[3] * cs0[3]; v0[3] = a[3] * cs0[2] + a[2] * cs0[3];
                        v1[0] = b[0] * cs1[0] - b[1] * cs1[1]; v1[1] = b[1] * cs1[0] + b[0] * cs1[1];
                        v1[2] = b[2] * cs1[2] - b[3] * cs1[3]; v1[3] = b[3] * cs1[2] + b[2] * cs1[3];
                    }
                    v0 = v0 * sc; v1 = v1 * sc;
                    u32x4 w; w.x = cvt_pk_bf16(v0[0], v0[1]); w.y = cvt_pk_bf16(v0[2], v0[3]); w.z = cvt_pk_bf16(v1[0], v1[1]); w.w = cvt_pk_bf16(v1[2], v1[3]);
                    *(u32x4*)(proj + (size_t)row * NP + col0 + bj * HALF) = w; } }
        }
    }
};
struct EpiRes {
    static constexpr bool PERM = false, AFTER_DRAIN = false;
    const float* xi; float* xo; bf16_t* xb; float* ss;
    __device__ __forceinline__ void operator()(const f32x4 (&acc)[2][2][4][2], const Unit& u, int wr, int wc, int fr, int fq) const {
        const int row0 = u.pm * BM + wr * 64 + fr, col0 = u.pn * BM + wc * 32 + 4 * fq;
#pragma unroll
        for (int ai = 0; ai < 2; ++ai)
#pragma unroll
            for (int m = 0; m < 4; ++m) { const int row = row0 + ai * HALF + m * 16; const size_t off = (size_t)row * DM + col0; float q = 0.f;
#pragma unroll
                for (int bj = 0; bj < 2; ++bj)
#pragma unroll
                    for (int n = 0; n < 2; ++n) { const size_t c = off + bj * HALF + n * 16; const f32x4 r = *(const f32x4*)(xi + c) + acc[ai][bj][m][n];
                        *(f32x4*)(xo + c) = r; q += (r[0] * r[0] + r[1] * r[1]) + (r[2] * r[2] + r[3] * r[3]);
                        if (xb) { u32x2 w; w.x = cvt_pk_bf16(r[0], r[1]); w.y = cvt_pk_bf16(r[2], r[3]); *(u32x2*)(xb + c) = w; } }
                q += __shfl_xor(q, 16); q += __shfl_xor(q, 32);
                if (fq == 0) ss[(size_t)row * 16 + u.pn * 4 + wc] = q;
                if (m & 1) asm volatile("" ::: "memory"); }
    }
};
template <bool XF> struct EpiResB {
    static constexpr bool PERM = true, AFTER_DRAIN = false;
    const float* xf; const bf16_t* xb_in; bf16_t* xb_out; float* ss;
    __device__ __forceinline__ void operator()(const f32x4 (&acc)[2][2][4][2], const Unit& u, int wr, int wc, int fr, int fq) const {
        const int row0 = u.pm * BM + wr * 64 + fr, col0 = u.pn * BM + wc * 32 + 8 * fq;
#pragma unroll
        for (int ai = 0; ai < 2; ++ai) {
            u32x4 pre[4][2];
            if (!XF) {
#pragma unroll
                for (int m = 0; m < 4; ++m)
#pragma unroll
                    for (int bj = 0; bj < 2; ++bj) pre[m][bj] = *(const u32x4*)(xb_in + (size_t)(row0 + ai * HALF + m * 16) * DM + col0 + bj * HALF); }
#pragma unroll
            for (int m = 0; m < 4; ++m) { const int row = row0 + ai * HALF + m * 16; const size_t off = (size_t)row * DM + col0; float q = 0.f;
#pragma unroll
                for (int bj = 0; bj < 2; ++bj) { f32x4 r0, r1;
                    if (XF) { r0 = *(const f32x4*)(xf + off + bj * HALF); r1 = *(const f32x4*)(xf + off + bj * HALF + 4); }
                    else { const u32x4 w = pre[m][bj];
                        r0 = (f32x4){__uint_as_float(w.x << 16), __uint_as_float(w.x & 0xffff0000u), __uint_as_float(w.y << 16), __uint_as_float(w.y & 0xffff0000u)};
                        r1 = (f32x4){__uint_as_float(w.z << 16), __uint_as_float(w.z & 0xffff0000u), __uint_as_float(w.w << 16), __uint_as_float(w.w & 0xffff0000u)}; }
                    r0 = r0 + acc[ai][bj][m][0]; r1 = r1 + acc[ai][bj][m][1];
                    q += ((r0[0] * r0[0] + r0[1] * r0[1]) + (r0[2] * r0[2] + r0[3] * r0[3])) + ((r1[0] * r1[0] + r1[1] * r1[1]) + (r1[2] * r1[2] + r1[3] * r1[3]));
                    u32x4 w; w.x = cvt_pk_bf16(r0[0], r0[1]); w.y = cvt_pk_bf16(r0[2], r0[3]); w.z = cvt_pk_bf16(r1[0], r1[1]); w.w = cvt_pk_bf16(r1[2], r1[3]);
                    *(u32x4*)(xb_out + off + bj * HALF) = w; }
                q += __shfl_xor(q, 16); q += __shfl_xor(q, 32);
                if (fq == 0) ss[(size_t)row * 16 + u.pn * 4 + wc] = q; }
            asm volatile("" ::: "memory");
        }
    }
};
struct EpiResF {
    static constexpr bool PERM = false, AFTER_DRAIN = false;
    const bf16_t* xb; float* xo; float* ss;
    __device__ __forceinline__ void operator()(const f32x4 (&acc)[2][2][4][2], const Unit& u, int wr, int wc, int fr, int fq) const {
        const int row0 = u.pm * BM + wr * 64 + fr, col0 = u.pn * BM + wc * 32 + 4 * fq;
#pragma unroll
        for (int ai = 0; ai < 2; ++ai)
#pragma unroll
            for (int m = 0; m < 4; ++m) { const int row = row0 + ai * HALF + m * 16; const size_t off = (size_t)row * DM + col0; float q = 0.f;
#pragma unroll
                for (int bj = 0; bj < 2; ++bj)
#pragma unroll
                    for (int n = 0; n < 2; ++n) { const size_t c = off + bj * HALF + n * 16; const u32x2 w = *(const u32x2*)(xb + c);
                        const f32x4 r = (f32x4){__uint_as_float(w.x << 16), __uint_as_float(w.x & 0xffff0000u), __uint_as_float(w.y << 16), __uint_as_float(w.y & 0xffff0000u)} + acc[ai][bj][m][n];
                        *(f32x4*)(xo + c) = r; q += (r[0] * r[0] + r[1] * r[1]) + (r[2] * r[2] + r[3] * r[3]); }
                q += __shfl_xor(q, 16); q += __shfl_xor(q, 32);
                if (fq == 0) ss[(size_t)row * 16 + u.pn * 4 + wc] = q;
                if (m & 1) asm volatile("" ::: "memory"); }
    }
};
struct EpiFinal {
    static constexpr bool PERM = false, AFTER_DRAIN = false;
    const bf16_t* xb; float* out; const float* g; unsigned* xbuf; unsigned* cnt; PG8_LAS unsigned char* tab;
    __device__ __forceinline__ void operator()(f32x4 (&acc)[2][2][4][2], const Unit& u, int wr, int wc, int fr, int fq) const {
        const int tid = threadIdx.x, lane = tid & 63, wid = __builtin_amdgcn_readfirstlane(tid >> 6);
        PG8_LAS float* P = (PG8_LAS float*)tab; PG8_LAS float* S = (PG8_LAS float*)(tab + 4096);
        const int col0 = u.pn * BM + wc * 32 + 4 * fq;
#pragma unroll
        for (int ai = 0; ai < 2; ++ai)
#pragma unroll
            for (int m = 0; m < 4; ++m) { const int rl = ai * HALF + wr * 64 + m * 16 + fr; const size_t off = (size_t)(u.pm * BM + rl) * DM + col0; float q = 0.f;
#pragma unroll
                for (int bj = 0; bj < 2; ++bj)
#pragma unroll
                    for (int n = 0; n < 2; ++n) { const u32x2 w = *(const u32x2*)(xb + off + bj * HALF + n * 16);
                        const f32x4 r = (f32x4){__uint_as_float(w.x << 16), __uint_as_float(w.x & 0xffff0000u), __uint_as_float(w.y << 16), __uint_as_float(w.y & 0xffff0000u)} + acc[ai][bj][m][n];
                        acc[ai][bj][m][n] = r; q += (r[0] * r[0] + r[1] * r[1]) + (r[2] * r[2] + r[3] * r[3]); }
                q += __shfl_xor(q, 16); q += __shfl_xor(q, 32);
                if (fq == 0) P[rl * 4 + wc] = q;
                if (m & 1) asm volatile("" ::: "memory"); }
        asm volatile("s_waitcnt lgkmcnt(0)" ::: "memory"); __builtin_amdgcn_s_barrier(); asm volatile("" ::: "memory");
        unsigned* slot = xbuf + ((size_t)(u.pm * BM + (tid & 255)) * 4);
        if (tid < 256) { const f32x4 a = *(const PG8_LAS f32x4*)(P + tid * 4);
            __hip_atomic_store(slot + u.pn, __float_as_uint((a[0] + a[1]) + (a[2] + a[3])), __ATOMIC_RELAXED, __HIP_MEMORY_SCOPE_AGENT); }
        asm volatile("s_waitcnt vmcnt(0)" ::: "memory");
        if (tid < 256 && lane == 0) __hip_atomic_fetch_add(cnt + 64 * u.pm, 1u, __ATOMIC_RELAXED, __HIP_MEMORY_SCOPE_AGENT);
        if (wid == 0) {
            unsigned sp = 0;
            while ((unsigned)__builtin_amdgcn_readfirstlane(__hip_atomic_load(cnt + 64 * u.pm, __ATOMIC_RELAXED, __HIP_MEMORY_SCOPE_AGENT)) < 16u) { __builtin_amdgcn_s_sleep(2); if (++sp > (1u << 22)) break; }
            __builtin_amdgcn_fence(__ATOMIC_ACQUIRE, "agent");
        }
        asm volatile("s_waitcnt vmcnt(0) lgkmcnt(0)" ::: "memory"); __builtin_amdgcn_s_barrier(); asm volatile("" ::: "memory");
        if (tid < 256) { float t = 0.f;
#pragma unroll
            for (int k = 0; k < 4; ++k) t += __uint_as_float(__hip_atomic_load(slot + k, __ATOMIC_RELAXED, __HIP_MEMORY_SCOPE_AGENT));
            S[tid] = 1.0f / sqrtf(t * (1.f / DM) + EPS); }
        asm volatile("s_waitcnt lgkmcnt(0)" ::: "memory"); __builtin_amdgcn_s_barrier(); asm volatile("" ::: "memory");
        f32x4 gg[2][2];
#pragma unroll
        for (int bj = 0; bj < 2; ++bj)
#pragma unroll
            for (int n = 0; n < 2; ++n) gg[bj][n] = *(const f32x4*)(g + col0 + bj * HALF + n * 16);
#pragma unroll
        for (int ai = 0; ai < 2; ++ai)
#pragma unroll
            for (int m = 0; m < 4; ++m) { const int rl = ai * HALF + wr * 64 + m * 16 + fr; const size_t off = (size_t)(u.pm * BM + rl) * DM + col0; const float rs = S[rl];
#pragma unroll
                for (int bj = 0; bj < 2; ++bj)
#pragma unroll
                    for (int n = 0; n < 2; ++n) *(f32x4*)(out + off + bj * HALF + n * 16) = acc[ai][bj][m][n] * rs * gg[bj][n]; }
    }
};
template <int ACT> struct EpiScaleBf16 {
    static constexpr bool PERM = true, AFTER_DRAIN = false;
    bf16_t* O; int ldc; const float* ss; float mul; PG8_LAS unsigned char* tab;
    __device__ __forceinline__ void operator()(const f32x4 (&acc)[2][2][4][2], const Unit& u, int wr, int wc, int fr, int fq) const {
        const int tid = threadIdx.x; PG8_LAS float* S = (PG8_LAS float*)tab;
        if (tid < 256) S[tid] = rstd_ss(ss, u.pm * BM + tid) * mul;
        asm volatile("s_waitcnt lgkmcnt(0)" ::: "memory"); __builtin_amdgcn_s_barrier(); asm volatile("" ::: "memory");
        const int rl0 = wr * 64 + fr, col0 = u.pn * BM + wc * 32 + 8 * fq;
#pragma unroll
        for (int ai = 0; ai < 2; ++ai)
#pragma unroll
            for (int m = 0; m < 4; ++m) { const int rl = rl0 + ai * HALF + m * 16; const float rs = S[rl]; bf16_t* rowp = O + (size_t)(u.pm * BM + rl) * ldc + col0;
#pragma unroll
                for (int bj = 0; bj < 2; ++bj) { f32x4 v0 = acc[ai][bj][m][0] * rs, v1 = acc[ai][bj][m][1] * rs;
                    if (ACT == 1) {
#pragma unroll
                        for (int e = 0; e < 4; ++e) { const float a = fmaxf(v0[e], 0.f), b = fmaxf(v1[e], 0.f); v0[e] = a * a; v1[e] = b * b; } }
                    u32x4 w; w.x = cvt_pk_bf16(v0[0], v0[1]); w.y = cvt_pk_bf16(v0[2], v0[3]); w.z = cvt_pk_bf16(v1[0], v1[1]); w.w = cvt_pk_bf16(v1[2], v1[3]);
                    *(u32x4*)(rowp + bj * HALF) = w; } }
        __builtin_amdgcn_s_barrier();
    }
};

template <class Epi, class Sched, bool ALIGN_EPI = false, bool SP2 = false>
__device__ __forceinline__ void gemm_phase(PG8_LAS unsigned char* lds, const Gemm g, const Sched& S, const Epi& E) {
    const int tid = threadIdx.x, wid = __builtin_amdgcn_readfirstlane(tid >> 6), lane = tid & 63, wr = wid >> 2, wc = wid & 3, fr = lane & 15, fq = lane >> 4;
    const int K = g.K, nt = K / BK;
    unsigned voffA[2], voffB[2];
#pragma unroll
    for (int i = 0; i < 2; ++i) { int R, C; stage_rc(tid * 16 + i * 8192, R, C); const int Rb = Epi::PERM ? ((R & ~31) + perm32(R & 31)) : R;
        voffA[i] = (unsigned)(R * K + C) * 2u; voffB[i] = (unsigned)(Rb * K + C) * 2u; }
    const size_t kstep = (size_t)(BK * 2);
    const size_t hstep = (size_t)HALF * K * 2;
    const size_t tstep = 2 * hstep;
    const unsigned ldsw = (unsigned)wid * 1024u;
    const int aoff = lds_byte(wr * 64 + fr, fq * 8), boff = lds_byte(wc * 32 + fr, fq * 8);
#define PG8_SA(b, h) (((b) * 2 + (h)) * HTB)
#define PG8_SB(b, h) ((4 + (b) * 2 + (h)) * HTB)
#define PG8_STAGE(bufoff, gbase, voff) do { _Pragma("unroll") for (int _i = 0; _i < 2; ++_i) \
        __builtin_amdgcn_global_load_lds((const unsigned*)((const char*)(gbase) + (voff)[_i]), (PG8_LAS unsigned*)(lds + (bufoff) + ldsw + _i * 8192), 16, 0, 0); } while (0)
#define PG8_LDA(dst, b, h) do { _Pragma("unroll") for (int m = 0; m < 4; ++m) _Pragma("unroll") for (int k = 0; k < 2; ++k) dst[m][k] = *(const PG8_LAS bf16x8*)(lds + PG8_SA(b, h) + aoff + m * 2048 + k * 1024); } while (0)
#define PG8_LDB(dst, b, h) do { _Pragma("unroll") for (int n = 0; n < 2; ++n) _Pragma("unroll") for (int k = 0; k < 2; ++k) dst[n][k] = *(const PG8_LAS bf16x8*)(lds + PG8_SB(b, h) + boff + n * 2048 + k * 1024); } while (0)
#define PG8_MMA(ai, bj, At, Bt) do { __builtin_amdgcn_s_setprio(1); _Pragma("unroll") for (int m = 0; m < 4; ++m) _Pragma("unroll") for (int n = 0; n < 2; ++n) _Pragma("unroll") for (int k = 0; k < 2; ++k) \
        acc[ai][bj][m][n] = __builtin_amdgcn_mfma_f32_16x16x32_bf16(Bt[n][k], At[m][k], acc[ai][bj][m][n], 0, 0, 0); __builtin_amdgcn_s_setprio(0); } while (0)
#define PG8_WAIT_V(n) asm volatile("s_waitcnt vmcnt(" #n ")" ::: "memory")
#define PG8_WAIT_L(n) asm volatile("s_waitcnt lgkmcnt(" #n ")" ::: "memory")
#define PG8_BAR __builtin_amdgcn_s_barrier()
#define PG8_SCHED __builtin_amdgcn_sched_barrier(0)
    Unit cur, nxt; int ui = 0;
    if (!S.next(0, cur)) return;
    f32x4 acc[2][2][4][2];
#pragma unroll
    for (int a = 0; a < 2; ++a)
#pragma unroll
        for (int b = 0; b < 2; ++b)
#pragma unroll
            for (int m = 0; m < 4; ++m)
#pragma unroll
                for (int n = 0; n < 2; ++n) acc[a][b][m][n] = (f32x4){0.f, 0.f, 0.f, 0.f};
    bf16x8 At[4][2], B0[2][2], B1[2][2];
    const char* cA = (const char*)(cur.alt ? g.A2 : g.A) + (size_t)cur.pm * tstep; const char* cB = (const char*)(cur.alt ? g.Bt2 : g.Bt) + (size_t)cur.pn * tstep;
    S.a_ready(cur);
    if constexpr (SP2) {
        PG8_STAGE(PG8_SB(0, 0), cB, voffB); PG8_STAGE(PG8_SB(0, 1), cB + hstep, voffB); PG8_STAGE(PG8_SA(0, 0), cA, voffA); PG8_STAGE(PG8_SA(0, 1), cA + hstep, voffA);
        if (wr == 1) PG8_BAR;
        PG8_WAIT_V(2); PG8_BAR;
        PG8_STAGE(PG8_SB(1, 0), cB + kstep, voffB); PG8_STAGE(PG8_SA(1, 0), cA + kstep, voffA); PG8_STAGE(PG8_SB(1, 1), cB + hstep + kstep, voffB);
        PG8_WAIT_V(6); PG8_BAR;
    } else {
        PG8_STAGE(PG8_SB(0, 0), cB, voffB); PG8_STAGE(PG8_SA(0, 0), cA, voffA); PG8_STAGE(PG8_SB(0, 1), cB + hstep, voffB); PG8_STAGE(PG8_SA(0, 1), cA + hstep, voffA);
        if (wr == 1) PG8_BAR;
        PG8_WAIT_V(4); PG8_BAR;
        PG8_STAGE(PG8_SB(1, 0), cB + kstep, voffB); PG8_STAGE(PG8_SA(1, 0), cA + kstep, voffA); PG8_STAGE(PG8_SB(1, 1), cB + hstep + kstep, voffB);
        PG8_WAIT_V(6); PG8_BAR;
    }
    for (;;) {
        const bool has_next = S.next(ui + 1, nxt);
        const char* nA = has_next ? (const char*)(nxt.alt ? g.A2 : g.A) + (size_t)nxt.pm * tstep : cA; const char* nB = has_next ? (const char*)(nxt.alt ? g.Bt2 : g.Bt) + (size_t)nxt.pn * tstep : cB;
        for (int t = 0; t < nt; t += 2) {
            const bool last = (t == nt - 2);
            const char* a1 = cA + (size_t)(t + 1) * kstep;
            const char* a2 = last ? nA : cA + (size_t)(t + 2) * kstep; const char* b2 = last ? nB : cB + (size_t)(t + 2) * kstep;
            const char* a3 = a2 + kstep; const char* b3 = b2 + kstep;
            if (last && has_next) S.a_ready(nxt);
            if constexpr (SP2) {
            PG8_LDB(B0, 0, 0); PG8_LDB(B1, 0, 1); PG8_SCHED; PG8_LDA(At, 0, 0); PG8_STAGE(PG8_SA(1, 1), a1 + hstep, voffA);
            PG8_WAIT_V(8); PG8_WAIT_L(0); PG8_BAR; PG8_MMA(0, 0, At, B0); PG8_MMA(0, 1, At, B1); PG8_BAR; PG8_SCHED;
            PG8_LDA(At, 0, 1); PG8_STAGE(PG8_SB(0, 0), b2, voffB); PG8_STAGE(PG8_SB(0, 1), b2 + hstep, voffB); PG8_STAGE(PG8_SA(0, 0), a2, voffA);
            PG8_WAIT_V(8); PG8_WAIT_L(0); PG8_BAR; PG8_MMA(1, 0, At, B0); PG8_MMA(1, 1, At, B1); PG8_BAR; PG8_SCHED;
            PG8_LDB(B0, 1, 0); PG8_LDB(B1, 1, 1); PG8_SCHED; PG8_LDA(At, 1, 0); PG8_STAGE(PG8_SA(0, 1), a2 + hstep, voffA);
            PG8_WAIT_V(8); PG8_WAIT_L(0); PG8_BAR; PG8_MMA(0, 0, At, B0); PG8_MMA(0, 1, At, B1); PG8_BAR; PG8_SCHED;
            PG8_LDA(At, 1, 1); PG8_STAGE(PG8_SB(1, 0), b3, voffB); PG8_STAGE(PG8_SB(1, 1), b3 + hstep, voffB); PG8_STAGE(PG8_SA(1, 0), a3, voffA);
            PG8_WAIT_V(8); PG8_WAIT_L(0); PG8_BAR; PG8_MMA(1, 0, At, B0); PG8_MMA(1, 1, At, B1); PG8_BAR; PG8_SCHED;
            } else {
            PG8_LDB(B0, 0, 0); PG8_SCHED; PG8_LDA(At, 0, 0); PG8_STAGE(PG8_SA(1, 1), a1 + hstep, voffA);
            PG8_WAIT_L(8); PG8_BAR; PG8_WAIT_L(0); PG8_MMA(0, 0, At, B0); PG8_BAR; PG8_SCHED;
            PG8_LDB(B1, 0, 1); PG8_STAGE(PG8_SB(0, 0), b2, voffB);
            PG8_BAR; PG8_WAIT_L(0); PG8_MMA(0, 1, At, B1); PG8_BAR;
            PG8_LDA(At, 0, 1); PG8_STAGE(PG8_SA(0, 0), a2, voffA);
            PG8_BAR; PG8_WAIT_L(0); PG8_MMA(1, 0, At, B0); PG8_BAR; PG8_SCHED;
            PG8_STAGE(PG8_SB(0, 1), b2 + hstep, voffB);
            PG8_WAIT_V(6); PG8_BAR; PG8_MMA(1, 1, At, B1); PG8_BAR;
            PG8_LDB(B0, 1, 0); PG8_SCHED; PG8_LDA(At, 1, 0); PG8_STAGE(PG8_SA(0, 1), a2 + hstep, voffA);
            PG8_WAIT_L(8); PG8_BAR; PG8_WAIT_L(0); PG8_MMA(0, 0, At, B0); PG8_BAR; PG8_SCHED;
            PG8_LDB(B1, 1, 1); PG8_STAGE(PG8_SB(1, 0), b3, voffB);
            PG8_BAR; PG8_WAIT_L(0); PG8_MMA(0, 1, At, B1); PG8_BAR;
            PG8_LDA(At, 1, 1); PG8_STAGE(PG8_SA(1, 0), a3, voffA);
            PG8_BAR; PG8_WAIT_L(0); PG8_MMA(1, 0, At, B0); PG8_BAR; PG8_SCHED;
            PG8_STAGE(PG8_SB(1, 1), b3 + hstep, voffB);
            PG8_WAIT_V(6); PG8_BAR; PG8_MMA(1, 1, At, B1); PG8_BAR;
            }
        }
        if constexpr (ALIGN_EPI) { if (wr == 0) PG8_BAR; }
        if constexpr (!Epi::AFTER_DRAIN) { E(acc, cur, wr, wc, fr, fq); S.done(cur); }
        if (!has_next) break;
#pragma unroll
        for (int a = 0; a < 2; ++a)
#pragma unroll
            for (int b = 0; b < 2; ++b)
#pragma unroll
                for (int m = 0; m < 4; ++m)
#pragma unroll
                    for (int n = 0; n < 2; ++n) acc[a][b][m][n] = (f32x4){0.f, 0.f, 0.f, 0.f};
        cur = nxt; cA = nA; cB = nB; ++ui;
        if constexpr (ALIGN_EPI) { if (wr == 1) PG8_BAR; }
    }
    PG8_WAIT_V(0);
    if constexpr (!ALIGN_EPI) { if (wr == 0) PG8_BAR; }
    PG8_BAR;
    if constexpr (Epi::AFTER_DRAIN) { E.fused(acc, cur, wr, wc, fr, fq, lds, wid, lane); S.done(cur); }
#undef PG8_SA
#undef PG8_SB
#undef PG8_STAGE
#undef PG8_LDA
#undef PG8_LDB
#undef PG8_MMA
#undef PG8_WAIT_V
#undef PG8_WAIT_L
#undef PG8_BAR
#undef PG8_SCHED
}
}
namespace fa {
typedef short bf16x8 __attribute__((ext_vector_type(8)));
typedef short s16x4 __attribute__((ext_vector_type(4)));
typedef float f32x16 __attribute__((ext_vector_type(16)));
typedef float f32x4 __attribute__((ext_vector_type(4)));
typedef unsigned u32x4 __attribute__((ext_vector_type(4)));
constexpr int NW = 8, QBLK = 32, KVBLK = 64;
constexpr float THR = 8.f;
#define FA_SBAR() __builtin_amdgcn_sched_barrier(0)
#define FA_VMW() asm volatile("s_waitcnt vmcnt(0)" ::: "memory")
__device__ __forceinline__ int crow(int r, int hi) { return (r & 3) + 8 * (r >> 2) + 4 * hi; }
typedef __bf16 cvt_bf2a __attribute__((ext_vector_type(2))); typedef float cvt_f2a __attribute__((ext_vector_type(2)));
__device__ __forceinline__ unsigned cvtpk(float lo, float hi) { const cvt_f2a v = {lo, hi}; return __builtin_bit_cast(unsigned, __builtin_convertvector(v, cvt_bf2a)); }

template <int NDQ> __device__ __forceinline__ int kswz(int row, int c) {
    if (NDQ == 4) return row * 128 + ((c ^ ((row >> 1) & 7)) << 4);
    else return row * (NDQ * 32) + ((c ^ (row & 15)) << 4);
}
template <int NDVT> __device__ __forceinline__ int v_st(int k, int c) { const int kk = (k & ~0xC) | ((k & 4) << 1) | ((k & 8) >> 1); return ((kk >> 3) * NDVT + (c >> 5)) * 512 + ((kk & 7) * 32 + (c & 31)) * 2; }
__device__ __forceinline__ int v_rd_base(int lane) { return ((lane & 3) << 3) | (((lane >> 2) & 3) << 6) | (((lane >> 4) & 1) << 5) | (((lane >> 5) & 1) << 8); }

__device__ __forceinline__ void mask_tile(f32x16& p0, f32x16& p1, int dq, unsigned W) {
    const float NEG = -__builtin_inff();
#pragma unroll
    for (int r = 0; r < 16; ++r) { const int c = (r & 3) + 8 * (r >> 2);
        if ((unsigned)(dq - c) >= W) p0[r] = NEG;
        if ((unsigned)(dq - c - 32) >= W) p1[r] = NEG; }
}
__device__ __forceinline__ void partialSM(f32x16& p0, f32x16& p1, float& m_reg, float& alpha) {
    float pmax = p0[0];
#pragma unroll
    for (int r = 1; r < 16; ++r) pmax = fmaxf(pmax, p0[r]);
#pragma unroll
    for (int r = 0; r < 16; ++r) pmax = fmaxf(pmax, p1[r]);
    { auto rr = __builtin_amdgcn_permlane32_swap(__float_as_uint(pmax), __float_as_uint(pmax), false, false); pmax = fmaxf(__uint_as_float(rr[0]), __uint_as_float(rr[1])); }
    float mn;
    if (__builtin_expect(__all((pmax - m_reg) <= THR), 1)) { mn = m_reg; alpha = 1.f; }
    else { mn = fmaxf(m_reg, pmax); alpha = __builtin_amdgcn_exp2f(m_reg - mn); m_reg = mn; }
#pragma unroll
    for (int r = 0; r < 16; ++r) p0[r] = p0[r] - mn;
#pragma unroll
    for (int r = 0; r < 16; ++r) p1[r] = p1[r] - mn;
#pragma unroll
    for (int r = 0; r < 16; ++r) p0[r] = __builtin_amdgcn_exp2f(p0[r]);
}
__device__ __forceinline__ void finishSM(f32x16& p0, f32x16& p1, float alpha, float& l_reg, bf16x8& pa0, bf16x8& pa1, bf16x8& pa2, bf16x8& pa3) {
#pragma unroll
    for (int r = 0; r < 16; ++r) p1[r] = __builtin_amdgcn_exp2f(p1[r]);
    float ps = 0.f;
#pragma unroll
    for (int r = 0; r < 16; ++r) ps += p0[r];
#pragma unroll
    for (int r = 0; r < 16; ++r) ps += p1[r];
    { auto rr = __builtin_amdgcn_permlane32_swap(__float_as_uint(ps), __float_as_uint(ps), false, false); ps = __uint_as_float(rr[0]) + __uint_as_float(rr[1]); }
    l_reg = l_reg * alpha + ps;
#define FA_PK4(P, B_, OUT) do { unsigned a0 = cvtpk(P[B_ + 0], P[B_ + 1]), a1 = cvtpk(P[B_ + 2], P[B_ + 3]); unsigned b0 = cvtpk(P[B_ + 4], P[B_ + 5]), b1 = cvtpk(P[B_ + 6], P[B_ + 7]); \
        auto r0 = __builtin_amdgcn_permlane32_swap(a0, b0, false, false); auto r1 = __builtin_amdgcn_permlane32_swap(a1, b1, false, false); \
        u32x4 w = {r0[0], r1[0], r0[1], r1[1]}; OUT = *reinterpret_cast<bf16x8*>(&w); } while (0)
    FA_PK4(p0, 0, pa0); FA_PK4(p0, 8, pa1); FA_PK4(p1, 0, pa2); FA_PK4(p1, 8, pa3);
#undef FA_PK4
}
template <int NDQ>
__device__ __forceinline__ void qkt(f32x16& p0, f32x16& p1, const char* Kb, int r32, int hi, const bf16x8* qr) {
    p0 = f32x16{}; p1 = f32x16{};
    constexpr int NA = NDQ < 8 ? NDQ : 8;
    const char* kb[NA];
#pragma unroll
    for (int dd = 0; dd < NA; ++dd) kb[dd] = Kb + kswz<NDQ>(r32, 2 * dd + hi);
#pragma unroll
    for (int d0 = 0; d0 < NDQ; ++d0) { const char* a = kb[d0 & (NA - 1)] + (d0 >> 3) * 256;
        const bf16x8 b0 = *reinterpret_cast<const bf16x8*>(a);
        const bf16x8 b1 = *reinterpret_cast<const bf16x8*>(a + 32 * NDQ * 32);
        p0 = __builtin_amdgcn_mfma_f32_32x32x16_bf16(b0, qr[d0], p0, 0, 0, 0);
        p1 = __builtin_amdgcn_mfma_f32_32x32x16_bf16(b1, qr[d0], p1, 0, 0, 0); }
}
template <int NDVT, int NDV>
__device__ __forceinline__ void pv_tile(f32x16* o, int vb, bf16x8 pa0, bf16x8 pa1, bf16x8 pa2, bf16x8 pa3) {
#define FA_TRRD(dst, off) asm volatile("ds_read_b64_tr_b16 %0, %1 offset:%2" : "=&v"(dst) : "v"(vb), "i"(off) : "memory")
#define FA_PV_D0(d0) do { s16x4 l0, l1, l2, l3, h0, h1, h2, h3; constexpr int b_ = (d0) * 512, ks_ = 2 * NDVT * 512, hf_ = NDVT * 512; \
        FA_TRRD(l0, b_); FA_TRRD(h0, b_ + hf_); FA_TRRD(l1, b_ + ks_); FA_TRRD(h1, b_ + ks_ + hf_); FA_TRRD(l2, b_ + 2 * ks_); FA_TRRD(h2, b_ + 2 * ks_ + hf_); FA_TRRD(l3, b_ + 3 * ks_); FA_TRRD(h3, b_ + 3 * ks_ + hf_); \
        asm volatile("s_waitcnt lgkmcnt(0)" ::: "memory"); FA_SBAR(); \
        o[d0] = __builtin_amdgcn_mfma_f32_32x32x16_bf16(pa0, (bf16x8){l0[0], l0[1], l0[2], l0[3], h0[0], h0[1], h0[2], h0[3]}, o[d0], 0, 0, 0); \
        o[d0] = __builtin_amdgcn_mfma_f32_32x32x16_bf16(pa1, (bf16x8){l1[0], l1[1], l1[2], l1[3], h1[0], h1[1], h1[2], h1[3]}, o[d0], 0, 0, 0); \
        o[d0] = __builtin_amdgcn_mfma_f32_32x32x16_bf16(pa2, (bf16x8){l2[0], l2[1], l2[2], l2[3], h2[0], h2[1], h2[2], h2[3]}, o[d0], 0, 0, 0); \
        o[d0] = __builtin_amdgcn_mfma_f32_32x32x16_bf16(pa3, (bf16x8){l3[0], l3[1], l3[2], l3[3], h3[0], h3[1], h3[2], h3[3]}, o[d0], 0, 0, 0); } while (0)
    FA_PV_D0(0); if constexpr (NDV > 1) FA_PV_D0(1); if constexpr (NDV > 2) FA_PV_D0(2); if constexpr (NDV > 3) FA_PV_D0(3);
#undef FA_PV_D0
#undef FA_TRRD
}

template <int NDQ, int NDVT, int NDV>
struct Core {
    static constexpr int KROW = NDQ * 32, SHM_K = 64 * KROW, SHM_V = 64 * NDVT * 64, NKL = NDQ / 4, NVL = NDVT / 2, LDS_NEED = 2 * SHM_V + 2 * SHM_K + NW * 256;
    static_assert(NKL >= 1 && NVL >= 1, "tile too small for 512 staging threads");
    __device__ __forceinline__ static void run(f32x16 (&o)[NDV], float& m_reg, float& l_reg, const bf16* Qw, int ldq, const bf16* Kg, const bf16* Vg, int ldk,
                                               int j_lo, int j_hi, int qlo, int W, char* lds, int vdoff) {
        int tid = threadIdx.x; asm volatile("" : "+v"(tid));
        const int wid = __builtin_amdgcn_readfirstlane(tid >> 6), lane = tid & 63, r32 = lane & 31, hi = lane >> 5;
        const int NT = j_hi - j_lo, qm = qlo + r32 - 4 * hi;
        char* V_lds = lds; char* K_lds = lds + 2 * SHM_V;
        float* wsf = (float*)(lds + 2 * SHM_V + 2 * SHM_K) + wid * 64; float* al_l = wsf + 32;
        m_reg = -1e30f; l_reg = 0.f;
#pragma unroll
        for (int d = 0; d < NDV; ++d) o[d] = f32x16{};
        constexpr int KCH = 2 * NDQ, KRS = 512 / KCH, VCH = 4 * NDVT, VRS = 512 / VCH;
        const int krow0 = tid / KCH, kch = tid % KCH, vrow0 = tid / VCH, vcol = (tid % VCH) * 8;
        int kws[NKL], vws[NVL];
#pragma unroll
        for (int i = 0; i < NKL; ++i) kws[i] = kswz<NDQ>(krow0 + i * KRS, kch);
#pragma unroll
        for (int i = 0; i < NVL; ++i) vws[i] = v_st<NDVT>(vrow0 + i * VRS, vcol);
        const bf16* kgp = Kg + (size_t)krow0 * ldk + kch * 8; const bf16* vgp = Vg + (size_t)vrow0 * ldk + vcol;
        bf16x8 sk[NKL], sv[NVL];
        const int vb0 = (int)(uintptr_t)V_lds + v_rd_base(lane) + vdoff * 512;
#define FA_SLOAD(t) do { const size_t ro_ = (size_t)((j_lo + (t)) * KVBLK) * ldk; \
        _Pragma("unroll") for (int i_ = 0; i_ < NVL; ++i_) sv[i_] = *reinterpret_cast<const bf16x8*>(vgp + ro_ + (size_t)(i_ * VRS) * ldk); \
        _Pragma("unroll") for (int i_ = 0; i_ < NKL; ++i_) sk[i_] = *reinterpret_cast<const bf16x8*>(kgp + ro_ + (size_t)(i_ * KRS) * ldk); } while (0)
#define FA_SWRITE(bf) do { _Pragma("unroll") for (int i_ = 0; i_ < NVL; ++i_) *reinterpret_cast<bf16x8*>(V_lds + (bf) * SHM_V + vws[i_]) = sv[i_]; \
        _Pragma("unroll") for (int i_ = 0; i_ < NKL; ++i_) *reinterpret_cast<bf16x8*>(K_lds + (bf) * SHM_K + kws[i_]) = sk[i_]; } while (0)
#define FA_RESC(a) do { if (__any((a) < 1.f)) { if (hi == 0) al_l[r32] = (a); asm volatile("s_waitcnt lgkmcnt(0)" ::: "memory"); \
        _Pragma("unroll") for (int d_ = 0; d_ < NDV; ++d_) _Pragma("unroll") for (int r = 0; r < 16; ++r) o[d_][r] *= al_l[crow(r, hi)]; } } while (0)
#define FA_KBASE(t) ((j_lo + (t)) * KVBLK)
#define FA_MASKT(P0_, P1_, t) do { const int kb_ = FA_KBASE(t); if (kb_ + KVBLK - 1 > qlo || kb_ <= qlo + QBLK - 1 - W) mask_tile(P0_, P1_, qm - kb_, (unsigned)W); } while (0)
        bf16x8 qr[NDQ];
#pragma unroll
        for (int d0 = 0; d0 < NDQ; ++d0) qr[d0] = *reinterpret_cast<const bf16x8*>(Qw + (size_t)r32 * ldq + d0 * 16 + hi * 8);
        FA_SLOAD(0); FA_VMW(); FA_SWRITE(0); FA_SBAR();
        if (NT > 1) FA_SLOAD(1);
        __syncthreads();
        f32x16 pA0, pA1, pB0, pB1; float alA, alB; bf16x8 pa0, pa1, pa2, pa3;
        FA_SBAR(); qkt<NDQ>(pA0, pA1, K_lds, r32, hi, qr);
        FA_MASKT(pA0, pA1, 0); partialSM(pA0, pA1, m_reg, alA);
        if (NT > 1) { FA_VMW(); FA_SWRITE(1); }
        __syncthreads();
#define FA_HALF_STEP(PX0, PX1, alX, PY0, PY1, alY, t, KB, VB, SB) do { \
        FA_SBAR(); qkt<NDQ>(PX0, PX1, K_lds + (KB) * SHM_K, r32, hi, qr); \
        finishSM(PY0, PY1, alY, l_reg, pa0, pa1, pa2, pa3); FA_SBAR(); \
        if ((t) + 1 < NT) { FA_SLOAD((t) + 1); FA_SBAR(); } \
        pv_tile<NDVT, NDV>(o, vb0 + (VB) * SHM_V, pa0, pa1, pa2, pa3); FA_MASKT(PX0, PX1, (t)); partialSM(PX0, PX1, m_reg, alX); \
        __syncthreads(); \
        if ((t) + 1 < NT) { FA_VMW(); FA_SWRITE(SB); } \
        FA_RESC(alX); __syncthreads(); } while (0)
        for (int t = 1; t + 1 < NT; t += 2) {
            FA_HALF_STEP(pB0, pB1, alB, pA0, pA1, alA, t, 1, 0, 0);
            FA_HALF_STEP(pA0, pA1, alA, pB0, pB1, alB, t + 1, 0, 1, 1);
        }
        const bool even = (NT & 1) == 0;
        if (even) { FA_SBAR(); qkt<NDQ>(pB0, pB1, K_lds + SHM_K, r32, hi, qr); FA_SBAR(); }
        finishSM(pA0, pA1, alA, l_reg, pa0, pa1, pa2, pa3); FA_SBAR();
        pv_tile<NDVT, NDV>(o, vb0, pa0, pa1, pa2, pa3);
        if (even) { FA_MASKT(pB0, pB1, NT - 1); partialSM(pB0, pB1, m_reg, alB); FA_RESC(alB);
            finishSM(pB0, pB1, alB, l_reg, pa0, pa1, pa2, pa3); FA_SBAR(); pv_tile<NDVT, NDV>(o, vb0 + SHM_V, pa0, pa1, pa2, pa3); }
        __syncthreads();
#undef FA_SLOAD
#undef FA_SWRITE
#undef FA_RESC
#undef FA_KBASE
#undef FA_MASKT
#undef FA_HALF_STEP
    }
};

#define FA_PIN(x) asm volatile("" : "+v"(x))
#define FA_PK4V(P, B_, OUT) do { unsigned a0_ = cvtpk(P[B_ + 0], P[B_ + 1]), a1_ = cvtpk(P[B_ + 2], P[B_ + 3]); unsigned b0_ = cvtpk(P[B_ + 4], P[B_ + 5]), b1_ = cvtpk(P[B_ + 6], P[B_ + 7]); \
        auto r0_ = __builtin_amdgcn_permlane32_swap(a0_, b0_, false, false); auto r1_ = __builtin_amdgcn_permlane32_swap(a1_, b1_, false, false); \
        u32x4 w_ = {r0_[0], r1_[0], r0_[1], r1_[1]}; OUT = *reinterpret_cast<bf16x8*>(&w_); } while (0)
__device__ __forceinline__ void step_qk_fin(f32x16& X0, f32x16& X1, const char* Kb, int r32, int hi, const bf16x8* qr,
                                            f32x16& Y0, f32x16& Y1, float alY, float& l_reg, bf16x8& pa0, bf16x8& pa1, bf16x8& pa2, bf16x8& pa3) {
    const char* k0 = Kb + kswz<4>(r32, hi); const char* k1 = Kb + kswz<4>(r32, 2 + hi); const char* k2 = Kb + kswz<4>(r32, 4 + hi); const char* k3 = Kb + kswz<4>(r32, 6 + hi);
    bf16x8 fa = *reinterpret_cast<const bf16x8*>(k0), fb = *reinterpret_cast<const bf16x8*>(k0 + 4096);
    float ps;
    X0 = __builtin_amdgcn_mfma_f32_32x32x16_bf16(fa, qr[0], f32x16{}, 0, 0, 0); X1 = __builtin_amdgcn_mfma_f32_32x32x16_bf16(fb, qr[0], f32x16{}, 0, 0, 0);
    fa = *reinterpret_cast<const bf16x8*>(k1); fb = *reinterpret_cast<const bf16x8*>(k1 + 4096);
#pragma unroll
    for (int r = 0; r < 4; ++r) Y1[r] = __builtin_amdgcn_exp2f(Y1[r]);
    ps = (Y0[0] + Y0[1]) + (Y0[2] + Y0[3]);
    FA_PK4V(Y0, 0, pa0); FA_PIN(ps); FA_PIN(pa0); FA_PIN(Y1); FA_SBAR();
    X0 = __builtin_amdgcn_mfma_f32_32x32x16_bf16(fa, qr[1], X0, 0, 0, 0); X1 = __builtin_amdgcn_mfma_f32_32x32x16_bf16(fb, qr[1], X1, 0, 0, 0);
    fa = *reinterpret_cast<const bf16x8*>(k2); fb = *reinterpret_cast<const bf16x8*>(k2 + 4096);
#pragma unroll
    for (int r = 4; r < 8; ++r) Y1[r] = __builtin_amdgcn_exp2f(Y1[r]);
    ps += (Y0[4] + Y0[5]) + (Y0[6] + Y0[7]); ps += (Y1[0] + Y1[1]) + (Y1[2] + Y1[3]);
    FA_PK4V(Y0, 8, pa1); FA_PIN(ps); FA_PIN(pa1); FA_PIN(Y1); FA_SBAR();
    X0 = __builtin_amdgcn_mfma_f32_32x32x16_bf16(fa, qr[2], X0, 0, 0, 0); X1 = __builtin_amdgcn_mfma_f32_32x32x16_bf16(fb, qr[2], X1, 0, 0, 0);
    fa = *reinterpret_cast<const bf16x8*>(k3); fb = *reinterpret_cast<const bf16x8*>(k3 + 4096);
#pragma unroll
    for (int r = 8; r < 12; ++r) Y1[r] = __builtin_amdgcn_exp2f(Y1[r]);
    ps += (Y0[8] + Y0[9]) + (Y0[10] + Y0[11]); ps += (Y1[4] + Y1[5]) + (Y1[6] + Y1[7]);
    FA_PK4V(Y1, 0, pa2); FA_PIN(ps); FA_PIN(pa2); FA_PIN(Y1); FA_SBAR();
    X0 = __builtin_amdgcn_mfma_f32_32x32x16_bf16(fa, qr[3], X0, 0, 0, 0); X1 = __builtin_amdgcn_mfma_f32_32x32x16_bf16(fb, qr[3], X1, 0, 0, 0);
#pragma unroll
    for (int r = 12; r < 16; ++r) Y1[r] = __builtin_amdgcn_exp2f(Y1[r]);
    ps += (Y0[12] + Y0[13]) + (Y0[14] + Y0[15]); ps += (Y1[8] + Y1[9]) + (Y1[10] + Y1[11]); ps += (Y1[12] + Y1[13]) + (Y1[14] + Y1[15]);
    { auto rr = __builtin_amdgcn_permlane32_swap(__float_as_uint(ps), __float_as_uint(ps), false, false); ps = __uint_as_float(rr[0]) + __uint_as_float(rr[1]); }
    l_reg = l_reg * alY + ps;
    FA_PK4V(Y1, 8, pa3); FA_PIN(l_reg); FA_PIN(pa3); FA_PIN(X0); FA_PIN(X1); FA_SBAR();
}
__device__ __forceinline__ void step_pv_max(f32x16* o, int vb, bf16x8 pa0, bf16x8 pa1, bf16x8 pa2, bf16x8 pa3, f32x16& X0, f32x16& X1, float& m_reg, float& alpha, bool MASK, int dq, unsigned W) {
#define FA_TRRD(dst, off) asm volatile("ds_read_b64_tr_b16 %0, %1 offset:%2" : "=&v"(dst) : "v"(vb), "i"(off) : "memory")
#define FA_RD2(l, h, d0, ks) do { FA_TRRD(l, (d0) * 512 + (ks) * 4096); FA_TRRD(h, (d0) * 512 + (ks) * 4096 + 2048); } while (0)
#define FA_FRAG(l, h) (bf16x8){l[0], l[1], l[2], l[3], h[0], h[1], h[2], h[3]}
    s16x4 l0, h0, l1, h1, l2, h2, l3, h3;
    FA_RD2(l0, h0, 0, 0); FA_RD2(l1, h1, 0, 1); FA_RD2(l2, h2, 0, 2); FA_RD2(l3, h3, 0, 3);
    if (MASK) mask_tile(X0, X1, dq, W);
    float pmax = fmaxf(fmaxf(X0[0], X0[1]), X1[0]);
#pragma unroll
    for (int r = 2; r < 16; r += 2) pmax = fmaxf(fmaxf(pmax, X0[r]), X0[r + 1]);
#pragma unroll
    for (int r = 1; r < 16; r += 2) pmax = fmaxf(fmaxf(pmax, X1[r]), X1[(r + 1) & 15]);
    { auto rr = __builtin_amdgcn_permlane32_swap(__float_as_uint(pmax), __float_as_uint(pmax), false, false); pmax = fmaxf(__uint_as_float(rr[0]), __uint_as_float(rr[1])); }
    float mn;
    if (__builtin_expect(__all((pmax - m_reg) <= THR), 1)) { mn = m_reg; alpha = 1.f; }
    else { mn = fmaxf(m_reg, pmax); alpha = __builtin_amdgcn_exp2f(m_reg - mn); m_reg = mn; }
    FA_PIN(mn);
#define FA_BLK(d0, NXT, FILL) do { asm volatile("s_waitcnt lgkmcnt(0)" ::: "memory"); FA_SBAR(); \
        o[d0] = __builtin_amdgcn_mfma_f32_32x32x16_bf16(pa0, FA_FRAG(l0, h0), o[d0], 0, 0, 0); if (NXT) FA_RD2(l0, h0, (d0) + 1, 0); \
        o[d0] = __builtin_amdgcn_mfma_f32_32x32x16_bf16(pa1, FA_FRAG(l1, h1), o[d0], 0, 0, 0); if (NXT) FA_RD2(l1, h1, (d0) + 1, 1); \
        o[d0] = __builtin_amdgcn_mfma_f32_32x32x16_bf16(pa2, FA_FRAG(l2, h2), o[d0], 0, 0, 0); if (NXT) FA_RD2(l2, h2, (d0) + 1, 2); \
        o[d0] = __builtin_amdgcn_mfma_f32_32x32x16_bf16(pa3, FA_FRAG(l3, h3), o[d0], 0, 0, 0); if (NXT) FA_RD2(l3, h3, (d0) + 1, 3); \
        FILL; } while (0)
    FA_BLK(0, true,  { _Pragma("unroll") for (int r = 0; r < 16; ++r) X0[r] = X0[r] - mn; FA_PIN(X0); });
    FA_BLK(1, true,  { _Pragma("unroll") for (int r = 0; r < 16; ++r) X1[r] = X1[r] - mn; FA_PIN(X1); });
    FA_BLK(2, true,  { _Pragma("unroll") for (int r = 0; r < 8; ++r) X0[r] = __builtin_amdgcn_exp2f(X0[r]); FA_PIN(X0); });
    FA_BLK(3, false, { _Pragma("unroll") for (int r = 8; r < 16; ++r) X0[r] = __builtin_amdgcn_exp2f(X0[r]); FA_PIN(X0); });
    FA_SBAR();
#undef FA_BLK
#undef FA_RD2
#undef FA_FRAG
#undef FA_TRRD
}

template <int NDQ, int NDVT, int NDV>
struct CoreStag {
    static_assert(NDQ == 4 && NDVT == 4 && NDV == 4, "the interleaved interval bodies are written for d_qk = 64, d_v = 128");
    static constexpr int KROW = NDQ * 32, SHM_K = 64 * KROW, SHM_V = 64 * NDVT * 64, NKL = NDQ / 4, NVL = NDVT / 2, LDS_NEED = 2 * SHM_V + 2 * SHM_K + NW * 256;
    __device__ __forceinline__ static void run(f32x16 (&o)[NDV], float& m_reg, float& l_reg, const bf16* Qw, int ldq, const bf16* Kg, const bf16* Vg, int ldk,
                                               int j_lo, int j_hi, int qlo, int W, char* lds, int vdoff) {
        const int tid = threadIdx.x, wid = __builtin_amdgcn_readfirstlane(tid >> 6), lane = tid & 63, r32 = lane & 31, hi = lane >> 5;
        const bool half1 = wid >= 4;
        const int NT = j_hi - j_lo, qm = qlo + r32 - 4 * hi;
        char* V_lds = lds; char* K_lds = lds + 2 * SHM_V;
        float* al_l = (float*)(lds + 2 * SHM_V + 2 * SHM_K) + wid * 64 + 32;
        m_reg = -1e30f; l_reg = 0.f;
#pragma unroll
        for (int d = 0; d < NDV; ++d) o[d] = f32x16{};
        constexpr int KCH = 2 * NDQ, KRS = 512 / KCH, VCH = 4 * NDVT, VRS = 512 / VCH;
        const int krow0 = tid / KCH, kch = tid % KCH, vrow0 = tid / VCH, vcol = (tid % VCH) * 8;
        int kws[NKL], vws[NVL];
#pragma unroll
        for (int i = 0; i < NKL; ++i) kws[i] = kswz<NDQ>(krow0 + i * KRS, kch);
#pragma unroll
        for (int i = 0; i < NVL; ++i) vws[i] = v_st<NDVT>(vrow0 + i * VRS, vcol);
        const bf16* kgp = Kg + (size_t)(j_lo * KVBLK + krow0) * ldk + kch * 8; const bf16* vgp = Vg + (size_t)(j_lo * KVBLK + vrow0) * ldk + vcol;
        bf16x8 sk[NKL], sv[NVL];
        const int vb0 = (int)(uintptr_t)V_lds + v_rd_base(lane) + vdoff * 512;
#define FS_BAR() do { FA_SBAR(); __syncthreads(); FA_SBAR(); } while (0)
#define FS_LOADK(t) do { if ((t) < NT) { const size_t ro_ = (size_t)((t) * KVBLK) * ldk; _Pragma("unroll") for (int i_ = 0; i_ < NKL; ++i_) sk[i_] = *reinterpret_cast<const bf16x8*>(kgp + ro_ + (size_t)(i_ * KRS) * ldk); } } while (0)
#define FS_LOADV(t) do { if ((t) < NT) { const size_t ro_ = (size_t)((t) * KVBLK) * ldk; _Pragma("unroll") for (int i_ = 0; i_ < NVL; ++i_) sv[i_] = *reinterpret_cast<const bf16x8*>(vgp + ro_ + (size_t)(i_ * VRS) * ldk); } } while (0)
#define FS_WRITEK(t, bf) do { if ((t) < NT) { _Pragma("unroll") for (int i_ = 0; i_ < NKL; ++i_) *reinterpret_cast<bf16x8*>(K_lds + (bf) * SHM_K + kws[i_]) = sk[i_]; } } while (0)
#define FS_WRITEV(t, bf) do { if ((t) < NT) { _Pragma("unroll") for (int i_ = 0; i_ < NVL; ++i_) *reinterpret_cast<bf16x8*>(V_lds + (bf) * SHM_V + vws[i_]) = sv[i_]; } } while (0)
#define FS_RESC(a) do { if (__any((a) < 1.f)) { if (hi == 0) al_l[r32] = (a); asm volatile("s_waitcnt lgkmcnt(0)" ::: "memory"); \
        _Pragma("unroll") for (int d_ = 0; d_ < NDV; ++d_) _Pragma("unroll") for (int r = 0; r < 16; ++r) o[d_][r] *= al_l[crow(r, hi)]; } } while (0)
#define FS_MASKT(P0_, P1_, t) do { const int kb_ = (j_lo + (t)) * KVBLK; if (kb_ + KVBLK - 1 > qlo || kb_ <= qlo + QBLK - 1 - W) mask_tile(P0_, P1_, qm - kb_, (unsigned)W); } while (0)
        bf16x8 qr[NDQ];
#pragma unroll
        for (int d0 = 0; d0 < NDQ; ++d0) qr[d0] = *reinterpret_cast<const bf16x8*>(Qw + (size_t)r32 * ldq + d0 * 16 + hi * 8);
        FS_LOADK(0); FS_WRITEK(0, 0); FA_SBAR(); FS_LOADK(1); FS_LOADV(0);
        FS_BAR();
        if (half1) { FS_BAR(); }
        f32x16 pA0, pA1, pB0, pB1; float alA = 1.f, alB = 1.f; bf16x8 pa0, pa1, pa2, pa3;
        FS_WRITEK(1, 1); FA_SBAR(); FS_LOADK(2); FA_SBAR();
        qkt<NDQ>(pA0, pA1, K_lds, r32, hi, qr); asm volatile("" : "+v"(pA0), "+v"(pA1));
        FS_BAR();
        FS_WRITEV(0, 0); FA_SBAR(); FS_LOADV(1); FA_SBAR();
        FS_MASKT(pA0, pA1, 0); partialSM(pA0, pA1, m_reg, alA);
        FS_BAR();
#define FS_STEP(PX0, PX1, alX, PY0, PY1, alY, t, KB) do { \
        finishSM(PY0, PY1, alY, l_reg, pa0, pa1, pa2, pa3); FA_SBAR(); \
        FS_WRITEK((t) + 1, (KB) ^ 1); FA_SBAR(); FS_LOADK((t) + 2); FA_SBAR(); \
        qkt<NDQ>(PX0, PX1, K_lds + (KB) * SHM_K, r32, hi, qr); asm volatile("" : "+v"(PX0), "+v"(PX1)); \
        FS_BAR(); \
        pv_tile<NDVT, NDV>(o, vb0 + ((KB) ^ 1) * SHM_V, pa0, pa1, pa2, pa3); \
        FS_WRITEV((t), (KB)); FA_SBAR(); FS_LOADV((t) + 1); FA_SBAR(); \
        FS_MASKT(PX0, PX1, (t)); partialSM(PX0, PX1, m_reg, alX); FS_RESC(alX); \
        FS_BAR(); } while (0)
        int t = 1;
        for (; t + 1 < NT; t += 2) {
            FS_STEP(pB0, pB1, alB, pA0, pA1, alA, t, 1);
            FS_STEP(pA0, pA1, alA, pB0, pB1, alB, t + 1, 0);
        }
        FS_STEP(pB0, pB1, alB, pA0, pA1, alA, t, 1);
        finishSM(pB0, pB1, alB, l_reg, pa0, pa1, pa2, pa3); FA_SBAR();
        FS_BAR();
        pv_tile<NDVT, NDV>(o, vb0 + SHM_V, pa0, pa1, pa2, pa3);
        FS_BAR();
        if (!half1) { FS_BAR(); }
#undef FS_BAR
#undef FS_LOADK
#undef FS_LOADV
#undef FS_WRITEK
#undef FS_WRITEV
#undef FS_RESC
#undef FS_MASKT
#undef FS_STEP
    }
};
}

constexpr size_t WS_STASH = 128 * MiB;
typedef unsigned v4u32 __attribute__((__vector_size__(16)));
__device__ __forceinline__ __amdgpu_buffer_rsrc_t mk_rsrc(const void* ptr) {
    const unsigned long long v = (unsigned long long)ptr; const unsigned lo = __builtin_amdgcn_readfirstlane((unsigned)v), hi = __builtin_amdgcn_readfirstlane((unsigned)(v >> 32));
    return __builtin_amdgcn_make_buffer_rsrc((void*)(((unsigned long long)hi << 32) | lo), 0, 0x40000000, 0x00020000);
}
__device__ __forceinline__ void attn_phase(const Params& p, char* lds, int vcu0, int nwg) {
    using namespace fa;
    const int tid = threadIdx.x, wid = __builtin_amdgcn_readfirstlane(tid >> 6), lane = tid & 63, r32 = lane & 31, hi = lane >> 5;
    const bf16* proj = (const bf16*)(p.ws + WS_PROJ); bf16* att = (bf16*)(p.ws + WS_ATT);
    typedef CoreStag<4, 4, 4> CD; typedef Core<4, 2, 2> CS;
    float* wsf = (float*)(lds + CD::LDS_NEED) + wid * 64;
    const float lam = calc_lambda(p);
    const int ovoff = (4 * hi * DM + r32) * 2;
#pragma nounroll
    for (int vcu = vcu0; vcu < 256; vcu += nwg) {
        const int bh = vcu >> 3, b = bh >> 2, h = bh & 3, s = vcu & 7;
        u32x4* stash = (u32x4*)(lds + CD::LDS_NEED + NW * 256) + tid;
#pragma nounroll
        for (int pass = 0; pass < 2; ++pass) {
            const int qb = pass ? 15 - s : s;
            const size_t row0 = (size_t)b * SEQ + qb * 256 + wid * 32;
#pragma nounroll
            for (int c = 0; c < 2; ++c) {
                f32x16 o[4]; float m_reg, l_reg;
                CD::run(o, m_reg, l_reg, proj + row0 * NP + C_QD + (2 * h + c) * 64, NP, proj + (size_t)b * SEQ * NP + C_KD + (2 * h + c) * 64, proj + (size_t)b * SEQ * NP + C_VD + h * 128, NP,
                        0, 4 * (qb + 1), qb * 256 + wid * 32, 1 << 30, lds, 0);
                if (hi == 0) wsf[r32] = l_reg;
                asm volatile("s_waitcnt lgkmcnt(0)" ::: "memory");
                if (c == 0) {
#pragma unroll
                    for (int j = 0; j < 2; ++j) { float ri[8];
#pragma unroll
                        for (int e = 0; e < 8; ++e) ri[e] = 1.0f / wsf[crow(8 * j + e, hi)];
#pragma unroll
                        for (int d0 = 0; d0 < 4; ++d0) { u32x4 w; w.x = cvtpk(o[d0][8 * j] * ri[0], o[d0][8 * j + 1] * ri[1]); w.y = cvtpk(o[d0][8 * j + 2] * ri[2], o[d0][8 * j + 3] * ri[3]);
                            w.z = cvtpk(o[d0][8 * j + 4] * ri[4], o[d0][8 * j + 5] * ri[5]); w.w = cvtpk(o[d0][8 * j + 6] * ri[6], o[d0][8 * j + 7] * ri[7]); stash[(d0 * 2 + j) * NTHR] = w; } }
                } else {
                    const __amdgpu_buffer_rsrc_t rso = mk_rsrc(att + row0 * DM + 512 + h * 128);
                    float ssq[16];
#pragma unroll
                    for (int r = 0; r < 16; ++r) ssq[r] = -lam / wsf[crow(r, hi)];
#pragma unroll
                    for (int d0 = 0; d0 < 4; ++d0)
#pragma unroll
                        for (int j = 0; j < 2; ++j) { const u32x4 w = stash[(d0 * 2 + j) * NTHR]; const unsigned ww[4] = {w.x, w.y, w.z, w.w};
#pragma unroll
                            for (int e = 0; e < 8; ++e) { const int r = 8 * j + e; const float a0 = (e & 1) ? __uint_as_float(ww[e >> 1] & 0xffff0000u) : __uint_as_float(ww[e >> 1] << 16);
                                o[d0][r] = a0 + ssq[r] * o[d0][r]; } }
#pragma unroll
                    for (int r = 0; r < 16; ++r) { float q = (o[0][r] * o[0][r] + o[1][r] * o[1][r]) + (o[2][r] * o[2][r] + o[3][r] * o[3][r]);
                        q += __shfl_xor(q, 1); q += __shfl_xor(q, 2); q += __shfl_xor(q, 4); q += __shfl_xor(q, 8); q += __shfl_xor(q, 16);
                        ssq[r] = 0.8f / sqrtf(q * (1.f / 128.f) + EPS); }
#pragma unroll
                    for (int d0 = 0; d0 < 4; ++d0) { const float g = p.g_diff[d0 * 32 + r32];
#pragma unroll
                        for (int r = 0; r < 16; ++r) { const float y = o[d0][r] * ssq[r] * g; const float yn = __shfl_xor(y, 1);
                            if ((r32 & 1) == 0) __builtin_amdgcn_raw_buffer_store_b32(cvtpk(y, yn), rso, ovoff, (((r & 3) + 8 * (r >> 2)) * DM + d0 * 32) * 2, WT_ATT); } }
                }
                asm volatile("s_waitcnt lgkmcnt(0)" ::: "memory");
            }
        }
    }
    int tid_s = threadIdx.x; asm volatile("" : "+v"(tid_s));
    const int wid_s = __builtin_amdgcn_readfirstlane(tid_s >> 6), r32_s = tid_s & 31, hi_s = (tid_s >> 5) & 1;
    float* wsf_s = (float*)(lds + CD::LDS_NEED) + wid_s * 64; const int ovoff_s = (4 * hi_s * DM + r32_s) * 2;
#pragma nounroll
    for (int u = vcu0; u < 1024; u += nwg) {
        const int wid = wid_s, r32 = r32_s, hi = hi_s, ovoff = ovoff_s; float* wsf = wsf_s;
        const int bk = u >> 6, g64 = u & 63, b = bk >> 1, kvh = bk & 1, hq = kvh * 4 + (wid >> 1), sub = wid & 1;
        const size_t row0 = (size_t)b * SEQ + g64 * 64 + sub * 32;
        const __amdgpu_buffer_rsrc_t rso = mk_rsrc(att + row0 * DM + hq * 64);
        f32x16 o[2]; float m_reg, l_reg;
        const bf16* Qw = proj + row0 * NP + C_QA + hq * 64;
        const bf16* Kg = proj + (size_t)b * SEQ * NP + C_KA + kvh * 64;
        const bf16* Vg = proj + (size_t)b * SEQ * NP + C_VA + kvh * 64;
        CS::run(o, m_reg, l_reg, Qw, NP, Kg, Vg, NP, g64 >= 2 ? g64 - 2 : 0, g64 + 1, g64 * 64 + sub * 32, 128, lds, 0);
        const float lt = l_reg + __builtin_amdgcn_exp2f(p.sinks[hq] * LOG2E - m_reg);
        if (hi == 0) wsf[r32] = lt;
        asm volatile("s_waitcnt lgkmcnt(0)" ::: "memory");
#pragma unroll
        for (int r = 0; r < 16; ++r) { const float rl = 1.0f / wsf[crow(r, hi)];
#pragma unroll
            for (int d0 = 0; d0 < 2; ++d0) { const float y = o[d0][r] * rl; const float yn = __shfl_xor(y, 1);
                if ((r32 & 1) == 0) __builtin_amdgcn_raw_buffer_store_b32(cvtpk(y, yn), rso, ovoff, (((r & 3) + 8 * (r >> 2)) * DM + d0 * 32) * 2, WT_ATT); } }
        __syncthreads();
    }
}

namespace fa {
template <int NDQ, int NDVT, int NDV>
struct CoreSeqG {
    static constexpr int KROW = NDQ * 32, SHM_K = 64 * KROW, SHM_V = 64 * NDVT * 64, KPW = SHM_K / 8192, VPW = SHM_V / 8192;
    static_assert(NDQ == 16 && NDVT == 8, "piece maps below are written for 512-byte K rows and 8 V column blocks");
    typedef __attribute__((address_space(3))) unsigned char* lptr;
    __device__ __forceinline__ static void run(f32x16 (&o)[NDV], float& m_reg, float& l_reg, const bf16* Qw, int ldq, const bf16* Kg, const bf16* Vg, int ldk, int NT, char* lds, lptr ldsL, int scr_off, int vdoff) {
        const int tid = threadIdx.x, wid = __builtin_amdgcn_readfirstlane(tid >> 6), lane = tid & 63, r32 = lane & 31, hi = lane >> 5;
        char* V_lds = lds; char* K_lds = lds + 2 * SHM_V;
        float* al_l = (float*)(lds + scr_off) + wid * 64 + 32;
        m_reg = -1e30f; l_reg = 0.f;
#pragma unroll
        for (int d = 0; d < NDV; ++d) o[d] = f32x16{};
        int ksrc[KPW], vsrc[VPW];
#pragma unroll
        for (int i = 0; i < KPW; ++i) { const int row = 2 * (wid * KPW + i) + (lane >> 5); ksrc[i] = row * ldk + (((lane & 31) ^ (row & 15)) << 3); }
#pragma unroll
        for (int i = 0; i < VPW; ++i) { const int kk = wid * 8 + ((lane & 31) >> 2), k = (kk & ~0xC) | ((kk & 4) << 1) | ((kk & 8) >> 1); vsrc[i] = k * ldk + (2 * i + (lane >> 5)) * 32 + (lane & 3) * 8; }
#define FG_DMA(t, bf) do { const size_t ro_ = (size_t)((t) * KVBLK) * ldk; \
        _Pragma("unroll") for (int i_ = 0; i_ < VPW; ++i_) __builtin_amdgcn_global_load_lds((const unsigned*)(Vg + ro_ + vsrc[i_]), (__attribute__((address_space(3))) unsigned*)(ldsL + (bf) * SHM_V + (wid * VPW + i_) * 1024), 16, 0, 0); \
        _Pragma("unroll") for (int i_ = 0; i_ < KPW; ++i_) __builtin_amdgcn_global_load_lds((const unsigned*)(Kg + ro_ + ksrc[i_]), (__attribute__((address_space(3))) unsigned*)(ldsL + 2 * SHM_V + (bf) * SHM_K + (wid * KPW + i_) * 1024), 16, 0, 0); } while (0)
        const int vb0 = (int)(uintptr_t)V_lds + v_rd_base(lane) + vdoff * 512;
        FG_DMA(0, 0);
        bf16x8 qr[NDQ];
#pragma unroll
        for (int d0 = 0; d0 < NDQ; ++d0) qr[d0] = *reinterpret_cast<const bf16x8*>(Qw + (size_t)r32 * ldq + d0 * 16 + hi * 8);
        __syncthreads();
        for (int t = 0; t < NT; ++t) {
            const int bf = t & 1;
            if (t + 1 < NT) FG_DMA(t + 1, bf ^ 1);
            f32x16 p0, p1; float al; bf16x8 pa0, pa1, pa2, pa3;
            FA_SBAR(); qkt<NDQ>(p0, p1, K_lds + bf * SHM_K, r32, hi, qr);
            partialSM(p0, p1, m_reg, al);
            if (__any(al < 1.f)) { if (hi == 0) al_l[r32] = al; asm volatile("s_waitcnt lgkmcnt(0)" ::: "memory");
#pragma unroll
                for (int d_ = 0; d_ < NDV; ++d_)
#pragma unroll
                    for (int r = 0; r < 16; ++r) o[d_][r] *= al_l[crow(r, hi)]; }
            finishSM(p0, p1, al, l_reg, pa0, pa1, pa2, pa3); FA_SBAR();
            pv_tile<NDVT, NDV>(o, vb0 + bf * SHM_V, pa0, pa1, pa2, pa3);
            __syncthreads();
        }
#undef FG_DMA
    }
};
}
__device__ __forceinline__ void cross_block(const Params& p, char* lds, LAS unsigned char* ldsL, int b, int head, int rb) {
    using namespace fa;
    int tid = threadIdx.x; asm volatile("" : "+v"(tid));
    const int wid = __builtin_amdgcn_readfirstlane(tid >> 6), lane = tid & 63, r32 = lane & 31, hi = lane >> 5, dh = wid >> 2;
    const bf16* qc = (const bf16*)(p.ws + WS_QC); const bf16* kvm = (const bf16*)(p.ws + WS_KVM); bf16* oc = (bf16*)(p.ws + WS_OC);
    typedef CoreSeqG<16, 8, 4> CC;
    constexpr int SCR = 131072 + 8192;
    float* wsf = (float*)(lds + SCR + 2048) + wid * 64;
    const int ovoff = (4 * hi * DM + r32) * 2;
    const size_t row0 = (size_t)b * SEQ + rb * 128 + (wid & 3) * 32;
    const __amdgpu_buffer_rsrc_t rso = mk_rsrc(oc + row0 * DM + head * 256 + dh * 128);
    f32x16 o[4]; float m_reg, l_reg;
    CC::run(o, m_reg, l_reg, qc + row0 * DM + head * 256, DM, kvm + (size_t)b * MEML * 2048 + head * 256, kvm + (size_t)b * MEML * 2048 + 1024 + head * 256, 2048, MEML / 64, lds, (CC::lptr)ldsL, SCR, dh * 4);
    if (hi == 0) wsf[r32] = l_reg;
    asm volatile("s_waitcnt lgkmcnt(0)" ::: "memory");
#pragma unroll
    for (int r = 0; r < 16; ++r) { const float rl = 1.0f / wsf[crow(r, hi)];
#pragma unroll
        for (int d0 = 0; d0 < 4; ++d0) { const float y = o[d0][r] * rl; const float yn = __shfl_xor(y, 1);
            if ((r32 & 1) == 0) __builtin_amdgcn_raw_buffer_store_b32(cvtpk(y, yn), rso, ovoff, (((r & 3) + 8 * (r >> 2)) * DM + d0 * 32) * 2, WT_ATT); } }
    asm volatile("s_waitcnt lgkmcnt(0)" ::: "memory");
}
#define GAS __attribute__((address_space(1)))
typedef GAS unsigned gu32;
constexpr int CW_BAR = 4096;
constexpr size_t CTL_ZERO_BYTES = 65536;
constexpr int MISC_OFF = 131072 + 320, TAB_OFF = 131072 + 1024;
constexpr int CW_PANEL = 8192;
constexpr size_t WS_XCH = 60 * MiB;
#define XB_TMO      128
#define XB_XCNT(j)  (256  + 64 * (j))
#define XB_XSUB(j)  (1280 + 64 * (j))
#define XB_XGEN(j)  (2304 + 64 * (j))
#define XB_TOP      3328
#define XB_TOPGEN   3392
#define XCD_BAR_WORDS 3456
#define XB_SPIN_CAP (1u << 18)

__device__ __forceinline__ unsigned xb_ld(unsigned* p)              { return __hip_atomic_load(p, __ATOMIC_RELAXED, __HIP_MEMORY_SCOPE_AGENT); }
__device__ __forceinline__ unsigned xb_add(unsigned* p, unsigned v) { return __hip_atomic_fetch_add(p, v, __ATOMIC_RELAXED, __HIP_MEMORY_SCOPE_AGENT); }
__device__ __forceinline__ unsigned xb_xcc_id() { return (unsigned)__builtin_amdgcn_s_getreg((3 << 11) | 20) & 0xFu; }
#define XB_SPIN(cond, bar) do { unsigned _sp = 0; while (cond) { __builtin_amdgcn_s_sleep(1); \
    if ((++_sp & 255u) == 0u) { if (xb_ld(&(bar)[XB_TMO])) break; if (_sp > XB_SPIN_CAP) { atomicAdd(&(bar)[XB_TMO], 1u); break; } } } } while (0)

struct XcdBarrier {
    unsigned* bar; unsigned x;
    volatile LAS unsigned* st;
};

__device__ __forceinline__ XcdBarrier xcd_barrier_post(unsigned* bar, volatile LAS unsigned* st) {
    XcdBarrier b; b.bar = bar; b.x = xb_xcc_id(); b.st = st;
    if (threadIdx.x == 0) (void)xb_add(&bar[XB_XCNT(b.x)], 1u);
    return b;
}
__device__ __forceinline__ void xcd_barrier_complete(unsigned* bar, unsigned x, unsigned& nloc, unsigned& nx) {
    const unsigned G = gridDim.x * gridDim.y * gridDim.z;
    unsigned sum, cnt, mine, sp = 0u;
    for (;;) {
        sum = 0u; cnt = 0u; mine = 0u;
#pragma unroll
        for (unsigned j = 0; j < 16; ++j) { const unsigned c = xb_ld(&bar[XB_XCNT(j)]); sum += c; cnt += (c > 0u) ? 1u : 0u; mine = (j == x) ? c : mine; }
        if (sum == G) break;
        __builtin_amdgcn_s_sleep(1);
        if ((++sp & 255u) == 0u) { if (xb_ld(&bar[XB_TMO])) break; if (sp > XB_SPIN_CAP) { atomicAdd(&bar[XB_TMO], 1u); break; } }
    }
    nloc = mine > 0u ? mine : 1u; nx = cnt > 0u ? cnt : 1u;
}

__device__ __forceinline__ void xcd_barrier(const XcdBarrier& b) {
    asm volatile("s_waitcnt vmcnt(0)" ::: "memory");
    __syncthreads();
    if (threadIdx.x == 0) {
        unsigned* bar = b.bar;
        __builtin_amdgcn_s_waitcnt(0);
        unsigned nloc = b.st[0], nx = b.st[1];
        if (nloc == 0u) { xcd_barrier_complete(bar, b.x, nloc, nx); b.st[0] = nloc; b.st[1] = nx; }
        const unsigned old = xb_add(&bar[XB_XSUB(b.x)], 1u);
        const unsigned gen = old / nloc;
        if (old + 1u == (gen + 1u) * nloc) {
            __builtin_amdgcn_fence(__ATOMIC_RELEASE, "agent");
            asm volatile("s_waitcnt vmcnt(0)" ::: "memory");
            const unsigned og = xb_add(&bar[XB_TOP], 1u);
            const unsigned tg = og / nx;
            if (og + 1u == (tg + 1u) * nx) xb_add(&bar[XB_TOPGEN], 1u);
            else XB_SPIN(xb_ld(&bar[XB_TOPGEN]) == tg, bar);
            __builtin_amdgcn_fence(__ATOMIC_ACQUIRE, "agent");
            xb_add(&bar[XB_XGEN(b.x)], 1u);
            asm volatile("s_waitcnt vmcnt(0)" ::: "memory");
        } else {
            XB_SPIN(xb_ld(&bar[XB_XGEN(b.x)]) == gen, bar);
            __builtin_amdgcn_fence(__ATOMIC_ACQUIRE, "agent");
            asm volatile("s_waitcnt vmcnt(0)" ::: "memory");
        }
    }
    __syncthreads();
}

constexpr int LDS_BYTES = 147456;
constexpr size_t WS_SS3 = 58 * MiB;
__device__ __forceinline__ void final_norm_ss(float* X, const float* ss, const float* g, int gw, int ngw, int lane) {
    for (int m = gw; m < M; m += ngw) {
        const float rstd = pg8::rstd_ss(ss, m);
        f32x4* xr = (f32x4*)(X + (size_t)m * DM) + lane;
#pragma unroll
        for (int j = 0; j < 4; ++j) { const f32x4 gg = ((const f32x4*)g)[lane + 64 * j]; xr[64 * j] = xr[64 * j] * rstd * gg; }
    }
}
constexpr int N_PHASES = 10;
__global__ void __launch_bounds__(NTHR, 2) fwd_kernel(Params p) {
    extern __shared__ __attribute__((aligned(16))) unsigned char lds_raw[];
    LAS unsigned char* lds = (LAS unsigned char*)lds_raw;
    for (int u = threadIdx.x; u < 64; u += NTHR) ((LAS unsigned*)(lds + MISC_OFF))[u] = 0u;
    __syncthreads();
    XcdBarrier bar = xcd_barrier_post((unsigned*)(p.ws + WS_CTL) + CW_BAR, (volatile LAS unsigned*)(lds + MISC_OFF) + 8);
    const int tid = threadIdx.x, wave = __builtin_amdgcn_readfirstlane(tid >> 6), lane = tid & 63, bid = blockIdx.x, nblk = gridDim.x;
    const int gw = bid * NWAVES + wave, ngw = nblk * NWAVES;
    const int vcu = (nblk % 8 == 0) ? (bid % 8) * (nblk / 8) + bid / 8 : bid;
    unsigned char* ws = p.ws;
    const int lo = p.ph_lo, hi = p.ph_hi;
    typedef pg8::bf16_t b16;
#define IN(k) (lo <= (k) && (k) < hi)
#define SEAM(k) do { if (IN(k) && IN((k) + 1) && !((k) == 8 && nblk == 256)) xcd_barrier(bar); } while (0)
    if (IN(0)) { p0_prologue(p, lds, bid, nblk, tid); } SEAM(0);
    if (IN(1)) {
        pg8::Gemm g{(const b16*)(ws + WS_XN), (const b16*)(ws + WS_WIN), (const b16*)(ws + WS_MEMN), (const b16*)(ws + WS_WCKV), DM};
        pg8::TwoOrder S; S.init(M, NP, nblk, bid); S.n2M = MM / 256; S.n2N = 2048 / 256;
        pg8::EpiProj E{(b16*)(ws + WS_PROJ), (b16*)(ws + WS_KVM), (const float*)(ws + WS_ROPE)};
        pg8::gemm_phase<pg8::EpiProj, pg8::TwoOrder, true, true>(lds, g, S, E);
    } SEAM(1);
    if (IN(2)) { attn_phase(p, (char*)lds_raw, vcu, nblk);
    } SEAM(2);
    if (IN(3)) {
        pg8::Gemm g{(const b16*)(ws + WS_ATT), (const b16*)(ws + WS_WOUT), nullptr, nullptr, DM};
        pg8::StaticOrder S; S.init(M, DM, nblk, bid);
        pg8::EpiResB<true> E{p.x, nullptr, (b16*)(ws + WS_XN), (float*)(ws + WS_SS1)};
        pg8::gemm_phase<pg8::EpiResB<true>, pg8::StaticOrder, true, true>(lds, g, S, E);
    } SEAM(3);
    if (IN(4)) {
        pg8::Gemm g{(const b16*)(ws + WS_XN), (const b16*)(ws + WS_WCQ), nullptr, nullptr, DM};
        pg8::StaticOrder S; S.init(M, DM, nblk, bid);
        pg8::EpiScaleBf16<0> E{(b16*)(ws + WS_QC), DM, (const float*)(ws + WS_SS1), CQ, lds + TAB_OFF};
        pg8::gemm_phase<pg8::EpiScaleBf16<0>, pg8::StaticOrder, true, true>(lds, g, S, E);
        asm volatile("s_waitcnt vmcnt(0)" ::: "memory");
        __syncthreads();
        if (tid == 0) { __builtin_amdgcn_fence(__ATOMIC_ACQUIRE, "agent"); asm volatile("s_waitcnt vmcnt(0)" ::: "memory"); }
        __syncthreads();
#pragma nounroll
        for (int i = 0; ; ++i) {
            pg8::Unit u; if (!S.next(i, u)) break;
#pragma nounroll
            for (int hb = 0; hb < 2; ++hb) cross_block(p, (char*)lds_raw, lds, u.pm >> 4, u.pn, (u.pm & 15) * 2 + hb);
        }
    } SEAM(4);
    if (IN(6)) {
        pg8::Gemm g{(const b16*)(ws + WS_OC), (const b16*)(ws + WS_WCO), nullptr, nullptr, DM};
        pg8::StaticOrder S; S.init(M, DM, nblk, bid);
        pg8::EpiResB<false> E{nullptr, (const b16*)(ws + WS_XN), (b16*)(ws + WS_XN), (float*)(ws + WS_SS2)};
        pg8::gemm_phase<pg8::EpiResB<false>, pg8::StaticOrder, true, true>(lds, g, S, E);
    } SEAM(6);
    if (IN(7)) {
        pg8::Gemm g{(const b16*)(ws + WS_XN), (const b16*)(ws + WS_WUP), nullptr, nullptr, DM};
        pg8::StaticOrder S; S.init(M, FF, nblk, bid);
        pg8::EpiScaleBf16<1> E{(b16*)(ws + WS_ACT), FF, (const float*)(ws + WS_SS2), 1.f, lds + TAB_OFF};
        pg8::gemm_phase<pg8::EpiScaleBf16<1>, pg8::StaticOrder, true, true>(lds, g, S, E);
    } SEAM(7);
    if (IN(8)) {
        pg8::Gemm g{(const b16*)(ws + WS_ACT), (const b16*)(ws + WS_WDOWN), nullptr, nullptr, FF};
        pg8::StaticOrder S; S.init(M, DM, nblk, bid);
        if (nblk == 256) {
            pg8::EpiFinal E{(const b16*)(ws + WS_XN), p.out, p.g_final, (unsigned*)(ws + WS_XCH), (unsigned*)(ws + WS_CTL) + CW_PANEL, lds + TAB_OFF};
            pg8::gemm_phase<pg8::EpiFinal, pg8::StaticOrder, true, true>(lds, g, S, E);
        } else {
            pg8::EpiResF E{(const b16*)(ws + WS_XN), p.out, (float*)(ws + WS_SS3)};
            pg8::gemm_phase<pg8::EpiResF, pg8::StaticOrder, true, true>(lds, g, S, E);
        }
    } SEAM(8);
    if (IN(9) && nblk != 256) { final_norm_ss(p.out, (const float*)(ws + WS_SS3), p.g_final, gw, ngw, lane); }
#undef IN
#undef SEAM
}

extern "C" void kernel_launch(void* const* d_in, const int* in_sizes, int n_in, void* d_out, int out_size, void* d_ws, size_t ws_size, hipStream_t stream) {
    static int grid = 0;
    if (grid == 0) {
        if (n_in != 21 || out_size != M * DM || ws_size < WS_END) { fprintf(stderr, "kernel_launch: unexpected shapes (n_in %d out %d ws %zu)\n", n_in, out_size, ws_size); grid = -1; return; }
        int dev = 0, cus = 0, per_cu = 0;
        (void)hipGetDevice(&dev); (void)hipDeviceGetAttribute(&cus, hipDeviceAttributeMultiprocessorCount, dev);
        if (hipFuncSetAttribute((const void*)fwd_kernel, hipFuncAttributeMaxDynamicSharedMemorySize, LDS_BYTES) != hipSuccess) { fprintf(stderr, "kernel_launch: hipFuncSetAttribute failed\n"); grid = -1; return; }
        (void)hipOccupancyMaxActiveBlocksPerMultiprocessor(&per_cu, (const void*)fwd_kernel, NTHR, LDS_BYTES);
        if (per_cu < 1) { fprintf(stderr, "kernel_launch: occupancy query says %d blocks per CU\n", per_cu); per_cu = 1; }
        grid = cus;
    }
    if (grid < 0) return;
    Params p{};
    p.x = (const float*)d_in[0]; p.mem = (const float*)d_in[1]; p.pos = (const int*)d_in[2]; p.g_mix = (const float*)d_in[3]; p.w_in = (const float*)d_in[4];
    p.sinks = (const float*)d_in[5]; p.lq1 = (const float*)d_in[6]; p.lk1 = (const float*)d_in[7]; p.lq2 = (const float*)d_in[8]; p.lk2 = (const float*)d_in[9];
    p.g_diff = (const float*)d_in[10]; p.w_out = (const float*)d_in[11]; p.g_cross = (const float*)d_in[12]; p.g_mem = (const float*)d_in[13]; p.w_cq = (const float*)d_in[14];
    p.w_ckv = (const float*)d_in[15]; p.w_co = (const float*)d_in[16]; p.g_mlp = (const float*)d_in[17]; p.w_up = (const float*)d_in[18]; p.w_down = (const float*)d_in[19]; p.g_final = (const float*)d_in[20];
    p.out = (float*)d_out; p.ws = (unsigned char*)d_ws;
    if (hipMemsetAsync((char*)d_ws + WS_CTL, 0, CTL_ZERO_BYTES, stream) != hipSuccess) { fprintf(stderr, "kernel_launch: hipMemsetAsync of the control words failed\n"); return; }
    p.ph_lo = 0; p.ph_hi = N_PHASES;
    hipLaunchKernelGGL(fwd_kernel, dim3(grid), dim3(NTHR), LDS_BYTES, stream, p);
}
```

```cpp
#define WT_ATT 16
#include <hip/hip_runtime.h>
#include <cstdio>
#include <cstdint>


#define LAS __attribute__((address_space(3)))
typedef unsigned short bf16;
typedef short bf16x8 __attribute__((ext_vector_type(8)));
typedef float f32x4 __attribute__((ext_vector_type(4)));
typedef unsigned u32x4 __attribute__((ext_vector_type(4)));
typedef unsigned u32x2 __attribute__((ext_vector_type(2)));

constexpr int BATCH = 8, SEQ = 4096, M = BATCH * SEQ, DM = 1024, NP = 2304, MEML = 256, MM = BATCH * MEML, FF = 4096;
constexpr int NWAVES = 8, NTHR = NWAVES * 64;
constexpr float EPS = 1e-5f;
constexpr float LOG2E = 1.4426950408889634f;
constexpr float C2 = 0.125f * LOG2E;
constexpr float CQ = 0.0625f * LOG2E;
constexpr int C_QA = 0, C_KA = 512, C_VA = 640, C_QD = 768, C_KD = 1280, C_VD = 1792;

constexpr size_t MiB = 1u << 20;
constexpr size_t WS_CTL = 0;
constexpr size_t WS_WIN = 2 * MiB;
constexpr size_t WS_WOUT = WS_WIN + (size_t)NP * DM * 2;
constexpr size_t WS_WCQ = WS_WOUT + 2 * MiB;
constexpr size_t WS_WCKV = WS_WCQ + 2 * MiB;
constexpr size_t WS_WCO = WS_WCKV + 4 * MiB;
constexpr size_t WS_WUP = WS_WCO + 2 * MiB;
constexpr size_t WS_WDOWN = WS_WUP + 8 * MiB;
constexpr size_t WS_ROPE = 34 * MiB;
constexpr size_t WS_KVM = 42 * MiB;
constexpr size_t WS_MEMN = 50 * MiB;
constexpr size_t WS_SS1 = 54 * MiB, WS_SS2 = 56 * MiB;
constexpr size_t WS_XN = 64 * MiB;
constexpr size_t WS_PROJ = 256 * MiB;
constexpr size_t WS_ATT = 400 * MiB;
constexpr size_t WS_QC = 256 * MiB;
constexpr size_t WS_OC = 320 * MiB;
constexpr size_t WS_ACT = 256 * MiB;
constexpr size_t WS_END = 512 * MiB;
static_assert(WS_WDOWN + 8 * MiB <= WS_ROPE, "weights fit");

struct Params {
    const float *x, *mem; const int* pos;
    const float *g_mix, *w_in, *sinks, *lq1, *lk1, *lq2, *lk2, *g_diff, *w_out, *g_cross, *g_mem, *w_cq, *w_ckv, *w_co, *g_mlp, *w_up, *w_down, *g_final;
    float* out; unsigned char* ws; int ph_lo, ph_hi;
};

__device__ __forceinline__ unsigned f2bf(float f) { unsigned u = __builtin_bit_cast(unsigned, f); return (u + 0x7fffu + ((u >> 16) & 1u)) >> 16; }
__device__ __forceinline__ unsigned pk2(float lo, float hi) { return f2bf(lo) | (f2bf(hi) << 16); }
__device__ __forceinline__ float bf2f(unsigned h) { return __builtin_bit_cast(float, h << 16); }
__device__ __forceinline__ float bflo(unsigned w) { return __builtin_bit_cast(float, w << 16); }
__device__ __forceinline__ float bfhi(unsigned w) { return __builtin_bit_cast(float, w & 0xffff0000u); }
__device__ __forceinline__ float wave_sum(float v) {
#pragma unroll
    for (int o = 1; o < 64; o <<= 1) v += __shfl_xor(v, o);
    return v;
}
__device__ __forceinline__ float wave_max(float v) {
#pragma unroll
    for (int o = 1; o < 64; o <<= 1) v = fmaxf(v, __shfl_xor(v, o));
    return v;
}
__host__ __device__ __forceinline__ bool col_roped(int n) { return n < C_VA || (n >= C_QD && n < C_VD); }
__host__ __device__ __forceinline__ int phys_of_logical(int nl) {
    if (!col_roped(nl)) return nl;
    const int g = nl & ~63, j = nl & 63; return g + ((j & 31) << 1) + (j >> 5);
}
__device__ __forceinline__ float calc_lambda(const Params& p) {
    float a = 0.f, b = 0.f;
    for (int i = 0; i < 64; ++i) { a += p.lq1[i] * p.lk1[i]; b += p.lq2[i] * p.lk2[i]; }
    return __expf(a) - __expf(b) + 0.2f;
}

__device__ const double INV_FREQ[32] = {
    1.0, 0.7498942093324559, 0.5623413251903491, 0.4216965034285822,
    0.31622776601683794, 0.23713737056616552, 0.1778279410038923, 0.1333521432163324,
    0.1, 0.07498942093324558, 0.05623413251903491, 0.042169650342858224,
    0.03162277660168379, 0.023713737056616554, 0.01778279410038923, 0.01333521432163324,
    0.01, 0.007498942093324558, 0.005623413251903491, 0.004216965034285823,
    0.0031622776601683794, 0.0023713737056616554, 0.0017782794100389228, 0.001333521432163324,
    0.001, 0.0007498942093324559, 0.0005623413251903491, 0.00042169650342858224,
    0.00031622776601683794, 0.00023713737056616554, 0.00017782794100389227, 0.0001333521432163324};

__device__ __forceinline__ void sincos_d(double a, float& c, float& s) {
    const double kd = rint(a * 0.63661977236758134308);
    const int k = (int)kd;
    double r = fma(-kd, 1.57079632679489655800e+00, a); r = fma(-kd, 6.12323399573676603587e-17, r);
    const double r2 = r * r;
    const double sp = r * (1.0 + r2 * (-1.0 / 6.0 + r2 * (1.0 / 120.0 + r2 * (-1.0 / 5040.0 + r2 * (1.0 / 362880.0 + r2 * (-1.0 / 39916800.0 + r2 * (1.0 / 6227020800.0)))))));
    const double cp = 1.0 + r2 * (-0.5 + r2 * (1.0 / 24.0 + r2 * (-1.0 / 720.0 + r2 * (1.0 / 40320.0 + r2 * (-1.0 / 3628800.0 + r2 * (1.0 / 479001600.0 + r2 * (-1.0 / 87178291200.0)))))));
    const int q = k & 3;
    const double ss = (q == 0) ? sp : (q == 1) ? cp : (q == 2) ? -sp : -cp;
    const double cc = (q == 0) ? cp : (q == 1) ? -sp : (q == 2) ? -cp : sp;
    c = (float)cc; s = (float)ss;
}

template <bool HASG, bool PERMC>
__device__ __forceinline__ void transpose_item(const float* W, int K, int N, const float* g, bf16* WT, LAS float* scr, int item, int lane) {
    const int nblk = N / 32, kb = item / nblk, nb = item % nblk, k0 = 64 * kb, n0 = 32 * nb;
#pragma unroll 16
    for (int i = 0; i < 32; ++i) { const int kk = 2 * i + (lane >> 5); float v = W[(size_t)(k0 + kk) * N + n0 + (lane & 31)]; if (HASG) v *= g[k0 + kk]; scr[kk * 33 + (lane & 31)] = v; }
    asm volatile("s_waitcnt lgkmcnt(0)" ::: "memory");
    const int c = lane & 7;
#pragma unroll
    for (int j = 0; j < 4; ++j) { const int n = (lane >> 3) + 8 * j; const LAS float* s = scr + (8 * c) * 33 + n;
        u32x4 o; o.x = pk2(s[0 * 33], s[1 * 33]); o.y = pk2(s[2 * 33], s[3 * 33]); o.z = pk2(s[4 * 33], s[5 * 33]); o.w = pk2(s[6 * 33], s[7 * 33]);
        const int nl = n0 + n, np = PERMC ? phys_of_logical(nl) : nl;
        *(u32x4*)(WT + (size_t)np * K + k0 + 8 * c) = o; }
    asm volatile("s_waitcnt lgkmcnt(0)" ::: "memory");
}
__device__ __forceinline__ void rms_row_to_bf16(const float* xrow, const float* g, bf16* orow, int lane) {
    const f32x4* xr = (const f32x4*)xrow + lane;
    f32x4 v[4]; float s = 0.f;
#pragma unroll
    for (int j = 0; j < 4; ++j) { v[j] = xr[64 * j]; s += (v[j].x * v[j].x + v[j].y * v[j].y) + (v[j].z * v[j].z + v[j].w * v[j].w); }
    const float rstd = 1.0f / sqrtf(wave_sum(s) * (1.f / DM) + EPS);
    u32x2* o8 = (u32x2*)orow + lane;
#pragma unroll
    for (int j = 0; j < 4; ++j) {
        f32x4 gg = (f32x4){1.f, 1.f, 1.f, 1.f}; if (g) gg = ((const f32x4*)g)[lane + 64 * j];
        u32x2 w; w.x = pk2(v[j].x * rstd * gg.x, v[j].y * rstd * gg.y); w.y = pk2(v[j].z * rstd * gg.z, v[j].w * rstd * gg.w); o8[64 * j] = w; }
}
__device__ __forceinline__ void p0_prologue(const Params& p, LAS unsigned char* lds, int bid, int nblk, int tid) {
    const int wave = tid >> 6, lane = tid & 63;
    LAS float* scr = (LAS float*)(lds + wave * 8704);
    const int gw = bid * NWAVES + wave, NGW = nblk * NWAVES;
    unsigned char* ws = p.ws;
    constexpr int I_IN = (DM / 64) * (NP / 32), I_SQ = (DM / 64) * (DM / 32), I_KV = (DM / 64) * (2048 / 32), I_UP = (DM / 64) * (FF / 32), I_DN = (FF / 64) * (DM / 32);
    constexpr int NITEMS = I_IN + 3 * I_SQ + I_KV + I_UP + I_DN;
    for (int it = gw; it < NITEMS; it += NGW) {
        int r = it;
        if (r < I_IN) { transpose_item<true, true>(p.w_in, DM, NP, p.g_mix, (bf16*)(ws + WS_WIN), scr, r, lane); continue; } r -= I_IN;
        if (r < I_SQ) { transpose_item<false, false>(p.w_out, DM, DM, nullptr, (bf16*)(ws + WS_WOUT), scr, r, lane); continue; } r -= I_SQ;
        if (r < I_SQ) { transpose_item<true, false>(p.w_cq, DM, DM, p.g_cross, (bf16*)(ws + WS_WCQ), scr, r, lane); continue; } r -= I_SQ;
        if (r < I_KV) { transpose_item<false, false>(p.w_ckv, DM, 2048, nullptr, (bf16*)(ws + WS_WCKV), scr, r, lane); continue; } r -= I_KV;
        if (r < I_SQ) { transpose_item<false, false>(p.w_co, DM, DM, nullptr, (bf16*)(ws + WS_WCO), scr, r, lane); continue; } r -= I_SQ;
        if (r < I_UP) { transpose_item<true, false>(p.w_up, DM, FF, p.g_mlp, (bf16*)(ws + WS_WUP), scr, r, lane); continue; } r -= I_UP;
        transpose_item<false, false>(p.w_down, FF, DM, nullptr, (bf16*)(ws + WS_WDOWN), scr, r, lane);
    }
    for (int m = gw * 2; m < M; m += NGW * 2) {
        const f32x4* x0 = (const f32x4*)(p.x + (size_t)m * DM) + lane; const f32x4* x1 = x0 + DM / 4;
        f32x4 v0[4], v1[4]; float s0 = 0.f, s1 = 0.f;
#pragma unroll
        for (int j = 0; j < 4; ++j) { v0[j] = x0[64 * j]; v1[j] = x1[64 * j]; }
#pragma unroll
        for (int j = 0; j < 4; ++j) { s0 += (v0[j].x * v0[j].x + v0[j].y * v0[j].y) + (v0[j].z * v0[j].z + v0[j].w * v0[j].w); s1 += (v1[j].x * v1[j].x + v1[j].y * v1[j].y) + (v1[j].z * v1[j].z + v1[j].w * v1[j].w); }
#pragma unroll
        for (int o = 1; o < 64; o <<= 1) { s0 += __shfl_xor(s0, o); s1 += __shfl_xor(s1, o); }
        const float r0 = 1.0f / sqrtf(s0 * (1.f / DM) + EPS), r1 = 1.0f / sqrtf(s1 * (1.f / DM) + EPS);
        u32x2* o0 = (u32x2*)((bf16*)(ws + WS_XN) + (size_t)m * DM) + lane; u32x2* o1 = o0 + DM / 4;
#pragma unroll
        for (int j = 0; j < 4; ++j) { u32x2 w; w.x = pk2(v0[j].x * r0, v0[j].y * r0); w.y = pk2(v0[j].z * r0, v0[j].w * r0); o0[64 * j] = w;
            u32x2 z; z.x = pk2(v1[j].x * r1, v1[j].y * r1); z.y = pk2(v1[j].z * r1, v1[j].w * r1); o1[64 * j] = z; }
    }
    for (int m = gw; m < MM; m += NGW) rms_row_to_bf16(p.mem + (size_t)m * DM, p.g_mem, (bf16*)(ws + WS_MEMN) + (size_t)m * DM, lane);
    float2* rope = (float2*)(ws + WS_ROPE);
    for (int i = bid * NTHR + tid; i < M * 32; i += nblk * NTHR) {
        const int row = i >> 5, d = i & 31; float c, s; sincos_d((double)p.pos[row] * INV_FREQ[d], c, s); rope[i] = make_float2(c, s); }
}

namespace pg8 {
#define PG8_LAS __attribute__((address_space(3)))
typedef unsigned short bf16_t;
typedef short bf16x8 __attribute__((ext_vector_type(8)));
typedef float f32x4 __attribute__((ext_vector_type(4)));
typedef unsigned u32x4 __attribute__((ext_vector_type(4)));
typedef unsigned u32x2 __attribute__((ext_vector_type(2)));
constexpr int BM = 256, BK = 64, HALF = 128, HTB = HALF * BK * 2  , STAGE_BYTES = 8 * HTB, NXCD = 8, WGM = 8;

__host__ __device__ __forceinline__ int lds_byte(int r, int c) { const int st = (r >> 4) * 2 + (c >> 5), rr = r & 15, cc = c & 31, ob = rr * 64 + cc * 2; return st * 1024 + (ob ^ (((ob >> 9) & 1) << 5)); }
__host__ __device__ __forceinline__ void stage_rc(int b, int& R, int& C) { const int st = b / 1024, sb = b % 1024, swz = sb ^ (((sb >> 9) & 1) << 5); R = (st >> 1) * 16 + swz / 64; C = (st & 1) * 32 + (swz % 64) / 2; }
__host__ __device__ __forceinline__ int perm32(int rho) { const int n = rho >> 4, i = rho & 15; return 8 * (i >> 2) + 4 * n + (i & 3); }

struct Unit { int pm, pn, alt; };
struct Gemm { const bf16_t* A; const bf16_t* Bt; const bf16_t* A2; const bf16_t* Bt2; int K; };

struct StaticOrder {
    int nM, nN, nwg, G, c;
    __host__ __device__ void init(int M_, int N_, int G_, int c_) { nM = M_ / BM; nN = N_ / BM; nwg = nM * nN; G = G_; c = c_; }
    __host__ __device__ bool map(long L, Unit& u) const {
        if (L >= nwg) return false;
        int wgid = (int)L; { const int q = nwg / NXCD, r = nwg % NXCD, xcd = wgid % NXCD, off = wgid / NXCD; wgid = (xcd < r ? xcd * (q + 1) : r * (q + 1) + (xcd - r) * q) + off; }
        const int nig = WGM * nN, gid = wgid / nig, fm = gid * WGM, gsz = (nM - fm) < WGM ? (nM - fm) : WGM;
        u.pm = fm + ((wgid % nig) % gsz); u.pn = (wgid % nig) / gsz; u.alt = 0; return true;
    }
    __host__ __device__ bool next(int i, Unit& u) const { return map((long)i * G + c, u); }
    __device__ __forceinline__ void a_ready(const Unit&) const {}
    __device__ __forceinline__ void done(const Unit&) const {}
};
struct OneUnit {
    Unit u;
    __device__ __forceinline__ bool next(int i, Unit& o) const { if (i) return false; o = u; return true; }
    __device__ __forceinline__ void a_ready(const Unit&) const {}
    __device__ __forceinline__ void done(const Unit&) const {}
};
struct TwoOrder : StaticOrder {
    int n2M, n2N;
    __host__ __device__ bool next(int i, Unit& u) const {
        const long L = (long)i * G + c;
        if (L < nwg) return map(L, u);
        const int r = (int)(L - nwg); if (r >= n2M * n2N) return false;
        u.pm = r % n2M; u.pn = r / n2M; u.alt = 1; return true;
    }
};
typedef __bf16 cvt_bf2 __attribute__((ext_vector_type(2))); typedef float cvt_f2 __attribute__((ext_vector_type(2)));
__device__ __forceinline__ unsigned cvt_pk_bf16(float lo, float hi) { const cvt_f2 v = {lo, hi}; return __builtin_bit_cast(unsigned, __builtin_convertvector(v, cvt_bf2)); }

__device__ __forceinline__ float rstd_ss(const float* ss, int row) {
    const f32x4* s4 = (const f32x4*)(ss + (size_t)row * 16); float t = 0.f;
#pragma unroll
    for (int i = 0; i < 4; ++i) { const f32x4 v = s4[i]; t += (v.x + v.y) + (v.z + v.w); }
    return 1.0f / sqrtf(t * (1.f / DM) + EPS);
}
struct EpiProj {
    static constexpr bool PERM = true, AFTER_DRAIN = false;
    bf16_t* proj; bf16_t* kvm; const float* rope;
    __device__ __forceinline__ void operator()(const f32x4 (&acc)[2][2][4][2], const Unit& u, int wr, int wc, int fr, int fq) const {
        const int row0 = u.pm * BM + wr * 64 + fr, col0 = u.pn * BM + wc * 32 + 8 * fq;
        if (u.alt) {
#pragma unroll
            for (int ai = 0; ai < 2; ++ai)
#pragma unroll
                for (int m = 0; m < 4; ++m) { bf16_t* rowp = kvm + (size_t)(row0 + ai * HALF + m * 16) * 2048 + col0;
#pragma unroll
                    for (int bj = 0; bj < 2; ++bj) { const f32x4 v0 = acc[ai][bj][m][0], v1 = acc[ai][bj][m][1];
                        u32x4 w; w.x = cvt_pk_bf16(v0[0], v0[1]); w.y = cvt_pk_bf16(v0[2], v0[3]); w.z = cvt_pk_bf16(v1[0], v1[1]); w.w = cvt_pk_bf16(v1[2], v1[3]);
                        *(u32x4*)(rowp + bj * HALF) = w; } }
            return;
        }
        const int d0 = ((wc & 1) * 32 + 8 * fq) >> 1;
#pragma unroll
        for (int ai = 0; ai < 2; ++ai) {
            f32x4 csa[4], csb[4];
#pragma unroll
            for (int m = 0; m < 4; ++m) { const size_t ro = (size_t)(row0 + ai * HALF + m * 16) * 64 + 2 * d0; csa[m] = *(const f32x4*)(rope + ro); csb[m] = *(const f32x4*)(rope + ro + 4); }
#pragma unroll
            for (int m = 0; m < 4; ++m) { const int row = row0 + ai * HALF + m * 16;
                const f32x4 cs0 = csa[m], cs1 = csb[m];
#pragma unroll
                for (int bj = 0; bj < 2; ++bj) { const int cb = u.pn * BM + bj * HALF;
                    const bool roped = col_roped(cb); const float sc = (cb < C_KA || (cb >= C_QD && cb < C_KD)) ? C2 : 1.f;
                    f32x4 v0 = acc[ai][bj][m][0], v1 = acc[ai][bj][m][1];
                    if (roped) {
                        const f32x4 a = v0, b = v1;
                        v0[0] = a[0] * cs0[0] - a[1] * cs0[1]; v0[1] = a[1] * cs0[0] + a[0] * cs0[1];
                        v0[2] = a[2] * cs0[2] - a[3] * cs0[3]; v0[3] = a[3] * cs0[2] + a[2] * cs0[3];
                        v1[0] = b[0] * cs1[0] - b[1] * cs1[1]; v1[1] = b[1] * cs1[0] + b[0] * cs1[1];
                        v1[2] = b[2] * cs1[2] - b[3] * cs1[3]; v1[3] = b[3] * cs1[2] + b[2] * cs1[3];
                    }
                    v0 = v0 * sc; v1 = v1 * sc;
                    u32x4 w; w.x = cvt_pk_bf16(v0[0], v0[1]); w.y = cvt_pk_bf16(v0[2], v0[3]); w.z = cvt_pk_bf16(v1[0], v1[1]); w.w = cvt_pk_bf16(v1[2], v1[3]);
                    *(u32x4*)(proj + (size_t)row * NP + col0 + bj * HALF) = w; } }
        }
    }
};
struct EpiRes {
    static constexpr bool PERM = false, AFTER_DRAIN = false;
    const float* xi; float* xo; bf16_t* xb; float* ss;
    __device__ __forceinline__ void operator()(const f32x4 (&acc)[2][2][4][2], const Unit& u, int wr, int wc, int fr, int fq) const {
        const int row0 = u.pm * BM + wr * 64 + fr, col0 = u.pn * BM + wc * 32 + 4 * fq;
#pragma unroll
        for (int ai = 0; ai < 2; ++ai)
#pragma unroll
            for (int m = 0; m < 4; ++m) { const int row = row0 + ai * HALF + m * 16; const size_t off = (size_t)row * DM + col0; float q = 0.f;
#pragma unroll
                for (int bj = 0; bj < 2; ++bj)
#pragma unroll
                    for (int n = 0; n < 2; ++n) { const size_t c = off + bj * HALF + n * 16; const f32x4 r = *(const f32x4*)(xi + c) + acc[ai][bj][m][n];
                        *(f32x4*)(xo + c) = r; q += (r[0] * r[0] + r[1] * r[1]) + (r[2] * r[2] + r[3] * r[3]);
                        if (xb) { u32x2 w; w.x = cvt_pk_bf16(r[0], r[1]); w.y = cvt_pk_bf16(r[2], r[3]); *(u32x2*)(xb + c) = w; } }
                q += __shfl_xor(q, 16); q += __shfl_xor(q, 32);
                if (fq == 0) ss[(size_t)row * 16 + u.pn * 4 + wc] = q;
                if (m & 1) asm volatile("" ::: "memory"); }
    }
};
template <bool XF> struct EpiResB {
    static constexpr bool PERM = true, AFTER_DRAIN = false;
    const float* xf; const bf16_t* xb_in; bf16_t* xb_out; float* ss;
    __device__ __forceinline__ void operator()(const f32x4 (&acc)[2][2][4][2], const Unit& u, int wr, int wc, int fr, int fq) const {
        const int row0 = u.pm * BM + wr * 64 + fr, col0 = u.pn * BM + wc * 32 + 8 * fq;
#pragma unroll
        for (int ai = 0; ai < 2; ++ai) {
            u32x4 pre[4][2];
            if (!XF) {
#pragma unroll
                for (int m = 0; m < 4; ++m)
#pragma unroll
                    for (int bj = 0; bj < 2; ++bj) pre[m][bj] = *(const u32x4*)(xb_in + (size_t)(row0 + ai * HALF + m * 16) * DM + col0 + bj * HALF); }
#pragma unroll
            for (int m = 0; m < 4; ++m) { const int row = row0 + ai * HALF + m * 16; const size_t off = (size_t)row * DM + col0; float q = 0.f;
#pragma unroll
                for (int bj = 0; bj < 2; ++bj) { f32x4 r0, r1;
                    if (XF) { r0 = *(const f32x4*)(xf + off + bj * HALF); r1 = *(const f32x4*)(xf + off + bj * HALF + 4); }
                    else { const u32x4 w = pre[m][bj];
                        r0 = (f32x4){__uint_as_float(w.x << 16), __uint_as_float(w.x & 0xffff0000u), __uint_as_float(w.y << 16), __uint_as_float(w.y & 0xffff0000u)};
                        r1 = (f32x4){__uint_as_float(w.z << 16), __uint_as_float(w.z & 0xffff0000u), __uint_as_float(w.w << 16), __uint_as_float(w.w & 0xffff0000u)}; }
                    r0 = r0 + acc[ai][bj][m][0]; r1 = r1 + acc[ai][bj][m][1];
                    q += ((r0[0] * r0[0] + r0[1] * r0[1]) + (r0[2] * r0[2] + r0[3] * r0[3])) + ((r1[0] * r1[0] + r1[1] * r1[1]) + (r1[2] * r1[2] + r1[3] * r1[3]));
                    u32x4 w; w.x = cvt_pk_bf16(r0[0], r0[1]); w.y = cvt_pk_bf16(r0[2], r0[3]); w.z = cvt_pk_bf16(r1[0], r1[1]); w.w = cvt_pk_bf16(r1[2], r1[3]);
                    *(u32x4*)(xb_out + off + bj * HALF) = w; }
                q += __shfl_xor(q, 16); q += __shfl_xor(q, 32);
                if (fq == 0) ss[(size_t)row * 16 + u.pn * 4 + wc] = q; }
            asm volatile("" ::: "memory");
        }
    }
};
struct EpiResF {
    static constexpr bool PERM = false, AFTER_DRAIN = false;
    const bf16_t* xb; float* xo; float* ss;
    __device__ __forceinline__ void operator()(const f32x4 (&acc)[2][2][4][2], const Unit& u, int wr, int wc, int fr, int fq) const {
        const int row0 = u.pm * BM + wr * 64 + fr, col0 = u.pn * BM + wc * 32 + 4 * fq;
#pragma unroll
        for (int ai = 0; ai < 2; ++ai)
#pragma unroll
            for (int m = 0; m < 4; ++m) { const int row = row0 + ai * HALF + m * 16; const size_t off = (size_t)row * DM + col0; float q = 0.f;
#pragma unroll
                for (int bj = 0; bj < 2; ++bj)
#pragma unroll
                    for (int n = 0; n < 2; ++n) { const size_t c = off + bj * HALF + n * 16; const u32x2 w = *(const u32x2*)(xb + c);
                        const f32x4 r = (f32x4){__uint_as_float(w.x << 16), __uint_as_float(w.x & 0xffff0000u), __uint_as_float(w.y << 16), __uint_as_float(w.y & 0xffff0000u)} + acc[ai][bj][m][n];
                        *(f32x4*)(xo + c) = r; q += (r[0] * r[0] + r[1] * r[1]) + (r[2] * r[2] + r[3] * r[3]); }
                q += __shfl_xor(q, 16); q += __shfl_xor(q, 32);
                if (fq == 0) ss[(size_t)row * 16 + u.pn * 4 + wc] = q;
                if (m & 1) asm volatile("" ::: "memory"); }
    }
};
struct EpiFinal {
    static constexpr bool PERM = false, AFTER_DRAIN = false;
    const bf16_t* xb; float* out; const float* g; unsigned* xbuf; unsigned* cnt; PG8_LAS unsigned char* tab;
    __device__ __forceinline__ void operator()(f32x4 (&acc)[2][2][4][2], const Unit& u, int wr, int wc, int fr, int fq) const {
        const int tid = threadIdx.x, lane = tid & 63, wid = __builtin_amdgcn_readfirstlane(tid >> 6);
        PG8_LAS float* P = (PG8_LAS float*)tab; PG8_LAS float* S = (PG8_LAS float*)(tab + 4096);
        const int col0 = u.pn * BM + wc * 32 + 4 * fq;
#pragma unroll
        for (int ai = 0; ai < 2; ++ai)
#pragma unroll
            for (int m = 0; m < 4; ++m) { const int rl = ai * HALF + wr * 64 + m * 16 + fr; const size_t off = (size_t)(u.pm * BM + rl) * DM + col0; float q = 0.f;
#pragma unroll
                for (int bj = 0; bj < 2; ++bj)
#pragma unroll
                    for (int n = 0; n < 2; ++n) { const u32x2 w = *(const u32x2*)(xb + off + bj * HALF + n * 16);
                        const f32x4 r = (f32x4){__uint_as_float(w.x << 16), __uint_as_float(w.x & 0xffff0000u), __uint_as_float(w.y << 16), __uint_as_float(w.y & 0xffff0000u)} + acc[ai][bj][m][n];
                        acc[ai][bj][m][n] = r; q += (r[0] * r[0] + r[1] * r[1]) + (r[2] * r[2] + r[3] * r[3]); }
                q += __shfl_xor(q, 16); q += __shfl_xor(q, 32);
                if (fq == 0) P[rl * 4 + wc] = q;
                if (m & 1) asm volatile("" ::: "memory"); }
        asm volatile("s_waitcnt lgkmcnt(0)" ::: "memory"); __builtin_amdgcn_s_barrier(); asm volatile("" ::: "memory");
        unsigned* slot = xbuf + ((size_t)(u.pm * BM + (tid & 255)) * 4);
        if (tid < 256) { const f32x4 a = *(const PG8_LAS f32x4*)(P + tid * 4);
            __hip_atomic_store(slot + u.pn, __float_as_uint((a[0] + a[1]) + (a[2] + a[3])), __ATOMIC_RELAXED, __HIP_MEMORY_SCOPE_AGENT); }
        asm volatile("s_waitcnt vmcnt(0)" ::: "memory");
        if (tid < 256 && lane == 0) __hip_atomic_fetch_add(cnt + 64 * u.pm, 1u, __ATOMIC_RELAXED, __HIP_MEMORY_SCOPE_AGENT);
        if (wid == 0) {
            unsigned sp = 0;
            while ((unsigned)__builtin_amdgcn_readfirstlane(__hip_atomic_load(cnt + 64 * u.pm, __ATOMIC_RELAXED, __HIP_MEMORY_SCOPE_AGENT)) < 16u) { __builtin_amdgcn_s_sleep(2); if (++sp > (1u << 22)) break; }
            __builtin_amdgcn_fence(__ATOMIC_ACQUIRE, "agent");
        }
        asm volatile("s_waitcnt vmcnt(0) lgkmcnt(0)" ::: "memory"); __builtin_amdgcn_s_barrier(); asm volatile("" ::: "memory");
        if (tid < 256) { float t = 0.f;
#pragma unroll
            for (int k = 0; k < 4; ++k) t += __uint_as_float(__hip_atomic_load(slot + k, __ATOMIC_RELAXED, __HIP_MEMORY_SCOPE_AGENT));
            S[tid] = 1.0f / sqrtf(t * (1.f / DM) + EPS); }
        asm volatile("s_waitcnt lgkmcnt(0)" ::: "memory"); __builtin_amdgcn_s_barrier(); asm volatile("" ::: "memory");
        f32x4 gg[2][2];
#pragma unroll
        for (int bj = 0; bj < 2; ++bj)
#pragma unroll
            for (int n = 0; n < 2; ++n) gg[bj][n] = *(const f32x4*)(g + col0 + bj * HALF + n * 16);
#pragma unroll
        for (int ai = 0; ai < 2; ++ai)
#pragma unroll
            for (int m = 0; m < 4; ++m) { const int rl = ai * HALF + wr * 64 + m * 16 + fr; const size_t off = (size_t)(u.pm * BM + rl) * DM + col0; const float rs = S[rl];
#pragma unroll
                for (int bj = 0; bj < 2; ++bj)
#pragma unroll
                    for (int n = 0; n < 2; ++n) *(f32x4*)(out + off + bj * HALF + n * 16) = acc[ai][bj][m][n] * rs * gg[bj][n]; }
    }
};
template <int ACT> struct EpiScaleBf16 {
    static constexpr bool PERM = true, AFTER_DRAIN = false;
    bf16_t* O; int ldc; const float* ss; float mul; PG8_LAS unsigned char* tab;
    __device__ __forceinline__ void operator()(const f32x4 (&acc)[2][2][4][2], const Unit& u, int wr, int wc, int fr, int fq) const {
        const int tid = threadIdx.x; PG8_LAS float* S = (PG8_LAS float*)tab;
        if (tid < 256) S[tid] = rstd_ss(ss, u.pm * BM + tid) * mul;
        asm volatile("s_waitcnt lgkmcnt(0)" ::: "memory"); __builtin_amdgcn_s_barrier(); asm volatile("" ::: "memory");
        const int rl0 = wr * 64 + fr, col0 = u.pn * BM + wc * 32 + 8 * fq;
#pragma unroll
        for (int ai = 0; ai < 2; ++ai)
#pragma unroll
            for (int m = 0; m < 4; ++m) { const int rl = rl0 + ai * HALF + m * 16; const float rs = S[rl]; bf16_t* rowp = O + (size_t)(u.pm * BM + rl) * ldc + col0;
#pragma unroll
                for (int bj = 0; bj < 2; ++bj) { f32x4 v0 = acc[ai][bj][m][0] * rs, v1 = acc[ai][bj][m][1] * rs;
                    if (ACT == 1) {
#pragma unroll
                        for (int e = 0; e < 4; ++e) { const float a = fmaxf(v0[e], 0.f), b = fmaxf(v1[e], 0.f); v0[e] = a * a; v1[e] = b * b; } }
                    u32x4 w; w.x = cvt_pk_bf16(v0[0], v0[1]); w.y = cvt_pk_bf16(v0[2], v0[3]); w.z = cvt_pk_bf16(v1[0], v1[1]); w.w = cvt_pk_bf16(v1[2], v1[3]);
                    *(u32x4*)(rowp + bj * HALF) = w; } }
        __builtin_amdgcn_s_barrier();
    }
};

template <class Epi, class Sched, bool ALIGN_EPI = false, bool SP2 = false>
__device__ __forceinline__ void gemm_phase(PG8_LAS unsigned char* lds, const Gemm g, const Sched& S, const Epi& E) {
    const int tid = threadIdx.x, wid = __builtin_amdgcn_readfirstlane(tid >> 6), lane = tid & 63, wr = wid >> 2, wc = wid & 3, fr = lane & 15, fq = lane >> 4;
    const int K = g.K, nt = K / BK;
    unsigned voffA[2], voffB[2];
#pragma unroll
    for (int i = 0; i < 2; ++i) { int R, C; stage_rc(tid * 16 + i * 8192, R, C); const int Rb = Epi::PERM ? ((R & ~31) + perm32(R & 31)) : R;
        voffA[i] = (unsigned)(R * K + C) * 2u; voffB[i] = (unsigned)(Rb * K + C) * 2u; }
    const size_t kstep = (size_t)(BK * 2);
    const size_t hstep = (size_t)HALF * K * 2;
    const size_t tstep = 2 * hstep;
    const unsigned ldsw = (unsigned)wid * 1024u;
    const int aoff = lds_byte(wr * 64 + fr, fq * 8), boff = lds_byte(wc * 32 + fr, fq * 8);
#define PG8_SA(b, h) (((b) * 2 + (h)) * HTB)
#define PG8_SB(b, h) ((4 + (b) * 2 + (h)) * HTB)
#define PG8_STAGE(bufoff, gbase, voff) do { _Pragma("unroll") for (int _i = 0; _i < 2; ++_i) \
        __builtin_amdgcn_global_load_lds((const unsigned*)((const char*)(gbase) + (voff)[_i]), (PG8_LAS unsigned*)(lds + (bufoff) + ldsw + _i * 8192), 16, 0, 0); } while (0)
#define PG8_LDA(dst, b, h) do { _Pragma("unroll") for (int m = 0; m < 4; ++m) _Pragma("unroll") for (int k = 0; k < 2; ++k) dst[m][k] = *(const PG8_LAS bf16x8*)(lds + PG8_SA(b, h) + aoff + m * 2048 + k * 1024); } while (0)
#define PG8_LDB(dst, b, h) do { _Pragma("unroll") for (int n = 0; n < 2; ++n) _Pragma("unroll") for (int k = 0; k < 2; ++k) dst[n][k] = *(const PG8_LAS bf16x8*)(lds + PG8_SB(b, h) + boff + n * 2048 + k * 1024); } while (0)
#define PG8_MMA(ai, bj, At, Bt) do { __builtin_amdgcn_s_setprio(1); _Pragma("unroll") for (int m = 0; m < 4; ++m) _Pragma("unroll") for (int n = 0; n < 2; ++n) _Pragma("unroll") for (int k = 0; k < 2; ++k) \
        acc[ai][bj][m][n] = __builtin_amdgcn_mfma_f32_16x16x32_bf16(Bt[n][k], At[m][k], acc[ai][bj][m][n], 0, 0, 0); __builtin_amdgcn_s_setprio(0); } while (0)
#define PG8_WAIT_V(n) asm volatile("s_waitcnt vmcnt(" #n ")" ::: "memory")
#define PG8_WAIT_L(n) asm volatile("s_waitcnt lgkmcnt(" #n ")" ::: "memory")
#define PG8_BAR __builtin_amdgcn_s_barrier()
#define PG8_SCHED __builtin_amdgcn_sched_barrier(0)
    Unit cur, nxt; int ui = 0;
    if (!S.next(0, cur)) return;
    f32x4 acc[2][2][4][2];
#pragma unroll
    for (int a = 0; a < 2; ++a)
#pragma unroll
        for (int b = 0; b < 2; ++b)
#pragma unroll
            for (int m = 0; m < 4; ++m)
#pragma unroll
                for (int n = 0; n < 2; ++n) acc[a][b][m][n] = (f32x4){0.f, 0.f, 0.f, 0.f};
    bf16x8 At[4][2], B0[2][2], B1[2][2];
    const char* cA = (const char*)(cur.alt ? g.A2 : g.A) + (size_t)cur.pm * tstep; const char* cB = (const char*)(cur.alt ? g.Bt2 : g.Bt) + (size_t)cur.pn * tstep;
    S.a_ready(cur);
    if constexpr (SP2) {
        PG8_STAGE(PG8_SB(0, 0), cB, voffB); PG8_STAGE(PG8_SB(0, 1), cB + hstep, voffB); PG8_STAGE(PG8_SA(0, 0), cA, voffA); PG8_STAGE(PG8_SA(0, 1), cA + hstep, voffA);
        if (wr == 1) PG8_BAR;
        PG8_WAIT_V(2); PG8_BAR;
        PG8_STAGE(PG8_SB(1, 0), cB + kstep, voffB); PG8_STAGE(PG8_SA(1, 0), cA + kstep, voffA); PG8_STAGE(PG8_SB(1, 1), cB + hstep + kstep, voffB);
        PG8_WAIT_V(6); PG8_BAR;
    } else {
        PG8_STAGE(PG8_SB(0, 0), cB, voffB); PG8_STAGE(PG8_SA(0, 0), cA, voffA); PG8_STAGE(PG8_SB(0, 1), cB + hstep, voffB); PG8_STAGE(PG8_SA(0, 1), cA + hstep, voffA);
        if (wr == 1) PG8_BAR;
        PG8_WAIT_V(4); PG8_BAR;
        PG8_STAGE(PG8_SB(1, 0), cB + kstep, voffB); PG8_STAGE(PG8_SA(1, 0), cA + kstep, voffA); PG8_STAGE(PG8_SB(1, 1), cB + hstep + kstep, voffB);
        PG8_WAIT_V(6); PG8_BAR;
    }
    for (;;) {
        const bool has_next = S.next(ui + 1, nxt);
        const char* nA = has_next ? (const char*)(nxt.alt ? g.A2 : g.A) + (size_t)nxt.pm * tstep : cA; const char* nB = has_next ? (const char*)(nxt.alt ? g.Bt2 : g.Bt) + (size_t)nxt.pn * tstep : cB;
        for (int t = 0; t < nt; t += 2) {
            const bool last = (t == nt - 2);
            const char* a1 = cA + (size_t)(t + 1) * kstep;
            const char* a2 = last ? nA : cA + (size_t)(t + 2) * kstep; const char* b2 = last ? nB : cB + (size_t)(t + 2) * kstep;
            const char* a3 = a2 + kstep; const char* b3 = b2 + kstep;
            if (last && has_next) S.a_ready(nxt);
            if constexpr (SP2) {
            PG8_LDB(B0, 0, 0); PG8_LDB(B1, 0, 1); PG8_SCHED; PG8_LDA(At, 0, 0); PG8_STAGE(PG8_SA(1, 1), a1 + hstep, voffA);
            PG8_WAIT_V(8); PG8_WAIT_L(0); PG8_BAR; PG8_MMA(0, 0, At, B0); PG8_MMA(0, 1, At, B1); PG8_BAR; PG8_SCHED;
            PG8_LDA(At, 0, 1); PG8_STAGE(PG8_SB(0, 0), b2, voffB); PG8_STAGE(PG8_SB(0, 1), b2 + hstep, voffB); PG8_STAGE(PG8_SA(0, 0), a2, voffA);
            PG8_WAIT_V(8); PG8_WAIT_L(0); PG8_BAR; PG8_MMA(1, 0, At, B0); PG8_MMA(1, 1, At, B1); PG8_BAR; PG8_SCHED;
            PG8_LDB(B0, 1, 0); PG8_LDB(B1, 1, 1); PG8_SCHED; PG8_LDA(At, 1, 0); PG8_STAGE(PG8_SA(0, 1), a2 + hstep, voffA);
            PG8_WAIT_V(8); PG8_WAIT_L(0); PG8_BAR; PG8_MMA(0, 0, At, B0); PG8_MMA(0, 1, At, B1); PG8_BAR; PG8_SCHED;
            PG8_LDA(At, 1, 1); PG8_STAGE(PG8_SB(1, 0), b3, voffB); PG8_STAGE(PG8_SB(1, 1), b3 + hstep, voffB); PG8_STAGE(PG8_SA(1, 0), a3, voffA);
            PG8_WAIT_V(8); PG8_WAIT_L(0); PG8_BAR; PG8_MMA(1, 0, At, B0); PG8_MMA(1, 1, At, B1); PG8_BAR; PG8_SCHED;
            } else {
            PG8_LDB(B0, 0, 0); PG8_SCHED; PG8_LDA(At, 0, 0); PG8_STAGE(PG8_SA(1, 1), a1 + hstep, voffA);
            PG8_WAIT_L(8); PG8_BAR; PG8_WAIT_L(0); PG8_MMA(0, 0, At, B0); PG8_BAR; PG8_SCHED;
            PG8_LDB(B1, 0, 1); PG8_STAGE(PG8_SB(0, 0), b2, voffB);
            PG8_BAR; PG8_WAIT_L(0); PG8_MMA(0, 1, At, B1); PG8_BAR;
            PG8_LDA(At, 0, 1); PG8_STAGE(PG8_SA(0, 0), a2, voffA);
            PG8_BAR; PG8_WAIT_L(0); PG8_MMA(1, 0, At, B0); PG8_BAR; PG8_SCHED;
            PG8_STAGE(PG8_SB(0, 1), b2 + hstep, voffB);
            PG8_WAIT_V(6); PG8_BAR; PG8_MMA(1, 1, At, B1); PG8_BAR;
            PG8_LDB(B0, 1, 0); PG8_SCHED; PG8_LDA(At, 1, 0); PG8_STAGE(PG8_SA(0, 1), a2 + hstep, voffA);
            PG8_WAIT_L(8); PG8_BAR; PG8_WAIT_L(0); PG8_MMA(0, 0, At, B0); PG8_BAR; PG8_SCHED;
            PG8_LDB(B1, 1, 1); PG8_STAGE(PG8_SB(1, 0), b3, voffB);
            PG8_BAR; PG8_WAIT_L(0); PG8_MMA(0, 1, At, B1); PG8_BAR;
            PG8_LDA(At, 1, 1); PG8_STAGE(PG8_SA(1, 0), a3, voffA);
            PG8_BAR; PG8_WAIT_L(0); PG8_MMA(1, 0, At, B0); PG8_BAR; PG8_SCHED;
            PG8_STAGE(PG8_SB(1, 1), b3 + hstep, voffB);
            PG8_WAIT_V(6); PG8_BAR; PG8_MMA(1, 1, At, B1); PG8_BAR;
            }
        }
        if constexpr (ALIGN_EPI) { if (wr == 0) PG8_BAR; }
        if constexpr (!Epi::AFTER_DRAIN) { E(acc, cur, wr, wc, fr, fq); S.done(cur); }
        if (!has_next) break;
#pragma unroll
        for (int a = 0; a < 2; ++a)
#pragma unroll
            for (int b = 0; b < 2; ++b)
#pragma unroll
                for (int m = 0; m < 4; ++m)
#pragma unroll
                    for (int n = 0; n < 2; ++n) acc[a][b][m][n] = (f32x4){0.f, 0.f, 0.f, 0.f};
        cur = nxt; cA = nA; cB = nB; ++ui;
        if constexpr (ALIGN_EPI) { if (wr == 1) PG8_BAR; }
    }
    PG8_WAIT_V(0);
    if constexpr (!ALIGN_EPI) { if (wr == 0) PG8_BAR; }
    PG8_BAR;
    if constexpr (Epi::AFTER_DRAIN) { E.fused(acc, cur, wr, wc, fr, fq, lds, wid, lane); S.done(cur); }
#undef PG8_SA
#undef PG8_SB
#undef PG8_STAGE
#undef PG8_LDA
#undef PG8_LDB
#undef PG8_MMA
#undef PG8_WAIT_V
#undef PG8_WAIT_L
#undef PG8_BAR
#undef PG8_SCHED
}
}
namespace fa {
typedef short bf16x8 __attribute__((ext_vector_type(8)));
typedef short s16x4 __attribute__((ext_vector_type(4)));
typedef float f32x16 __attribute__((ext_vector_type(16)));
typedef float f32x4 __attribute__((ext_vector_type(4)));
typedef unsigned u32x4 __attribute__((ext_vector_type(4)));
constexpr int NW = 8, QBLK = 32, KVBLK = 64;
constexpr float THR = 8.f;
#define FA_SBAR() __builtin_amdgcn_sched_barrier(0)
#define FA_VMW() asm volatile("s_waitcnt vmcnt(0)" ::: "memory")
__device__ __forceinline__ int crow(int r, int hi) { return (r & 3) + 8 * (r >> 2) + 4 * hi; }
typedef __bf16 cvt_bf2a __attribute__((ext_vector_type(2))); typedef float cvt_f2a __attribute__((ext_vector_type(2)));
__device__ __forceinline__ unsigned cvtpk(float lo, float hi) { const cvt_f2a v = {lo, hi}; return __builtin_bit_cast(unsigned, __builtin_convertvector(v, cvt_bf2a)); }

template <int NDQ> __device__ __forceinline__ int kswz(int row, int c) {
    if (NDQ == 4) return row * 128 + ((c ^ ((row >> 1) & 7)) << 4);
    else return row * (NDQ * 32) + ((c ^ (row & 15)) << 4);
}
template <int NDVT> __device__ __forceinline__ int v_st(int k, int c) { const int kk = (k & ~0xC) | ((k & 4) << 1) | ((k & 8) >> 1); return ((kk >> 3) * NDVT + (c >> 5)) * 512 + ((kk & 7) * 32 + (c & 31)) * 2; }
__device__ __forceinline__ int v_rd_base(int lane) { return ((lane & 3) << 3) | (((lane >> 2) & 3) << 6) | (((lane >> 4) & 1) << 5) | (((lane >> 5) & 1) << 8); }

__device__ __forceinline__ void mask_tile(f32x16& p0, f32x16& p1, int dq, unsigned W) {
    const float NEG = -__builtin_inff();
#pragma unroll
    for (int r = 0; r < 16; ++r) { const int c = (r & 3) + 8 * (r >> 2);
        if ((unsigned)(dq - c) >= W) p0[r] = NEG;
        if ((unsigned)(dq - c - 32) >= W) p1[r] = NEG; }
}
__device__ __forceinline__ void partialSM(f32x16& p0, f32x16& p1, float& m_reg, float& alpha) {
    float pmax = p0[0];
#pragma unroll
    for (int r = 1; r < 16; ++r) pmax = fmaxf(pmax, p0[r]);
#pragma unroll
    for (int r = 0; r < 16; ++r) pmax = fmaxf(pmax, p1[r]);
    { auto rr = __builtin_amdgcn_permlane32_swap(__float_as_uint(pmax), __float_as_uint(pmax), false, false); pmax = fmaxf(__uint_as_float(rr[0]), __uint_as_float(rr[1])); }
    float mn;
    if (__builtin_expect(__all((pmax - m_reg) <= THR), 1)) { mn = m_reg; alpha = 1.f; }
    else { mn = fmaxf(m_reg, pmax); alpha = __builtin_amdgcn_exp2f(m_reg - mn); m_reg = mn; }
#pragma unroll
    for (int r = 0; r < 16; ++r) p0[r] = p0[r] - mn;
#pragma unroll
    for (int r = 0; r < 16; ++r) p1[r] = p1[r] - mn;
#pragma unroll
    for (int r = 0; r < 16; ++r) p0[r] = __builtin_amdgcn_exp2f(p0[r]);
}
__device__ __forceinline__ void finishSM(f32x16& p0, f32x16& p1, float alpha, float& l_reg, bf16x8& pa0, bf16x8& pa1, bf16x8& pa2, bf16x8& pa3) {
#pragma unroll
    for (int r = 0; r < 16; ++r) p1[r] = __builtin_amdgcn_exp2f(p1[r]);
    float ps = 0.f;
#pragma unroll
    for (int r = 0; r < 16; ++r) ps += p0[r];
#pragma unroll
    for (int r = 0; r < 16; ++r) ps += p1[r];
    { auto rr = __builtin_amdgcn_permlane32_swap(__float_as_uint(ps), __float_as_uint(ps), false, false); ps = __uint_as_float(rr[0]) + __uint_as_float(rr[1]); }
    l_reg = l_reg * alpha + ps;
#define FA_PK4(P, B_, OUT) do { unsigned a0 = cvtpk(P[B_ + 0], P[B_ + 1]), a1 = cvtpk(P[B_ + 2], P[B_ + 3]); unsigned b0 = cvtpk(P[B_ + 4], P[B_ + 5]), b1 = cvtpk(P[B_ + 6], P[B_ + 7]); \
        auto r0 = __builtin_amdgcn_permlane32_swap(a0, b0, false, false); auto r1 = __builtin_amdgcn_permlane32_swap(a1, b1, false, false); \
        u32x4 w = {r0[0], r1[0], r0[1], r1[1]}; OUT = *reinterpret_cast<bf16x8*>(&w); } while (0)
    FA_PK4(p0, 0, pa0); FA_PK4(p0, 8, pa1); FA_PK4(p1, 0, pa2); FA_PK4(p1, 8, pa3);
#undef FA_PK4
}
template <int NDQ>
__device__ __forceinline__ void qkt(f32x16& p0, f32x16& p1, const char* Kb, int r32, int hi, const bf16x8* qr) {
    p0 = f32x16{}; p1 = f32x16{};
    constexpr int NA = NDQ < 8 ? NDQ : 8;
    const char* kb[NA];
#pragma unroll
    for (int dd = 0; dd < NA; ++dd) kb[dd] = Kb + kswz<NDQ>(r32, 2 * dd + hi);
#pragma unroll
    for (int d0 = 0; d0 < NDQ; ++d0) { const char* a = kb[d0 & (NA - 1)] + (d0 >> 3) * 256;
        const bf16x8 b0 = *reinterpret_cast<const bf16x8*>(a);
        const bf16x8 b1 = *reinterpret_cast<const bf16x8*>(a + 32 * NDQ * 32);
        p0 = __builtin_amdgcn_mfma_f32_32x32x16_bf16(b0, qr[d0], p0, 0, 0, 0);
        p1 = __builtin_amdgcn_mfma_f32_32x32x16_bf16(b1, qr[d0], p1, 0, 0, 0); }
}
template <int NDVT, int NDV>
__device__ __forceinline__ void pv_tile(f32x16* o, int vb, bf16x8 pa0, bf16x8 pa1, bf16x8 pa2, bf16x8 pa3) {
#define FA_TRRD(dst, off) asm volatile("ds_read_b64_tr_b16 %0, %1 offset:%2" : "=&v"(dst) : "v"(vb), "i"(off) : "memory")
#define FA_PV_D0(d0) do { s16x4 l0, l1, l2, l3, h0, h1, h2, h3; constexpr int b_ = (d0) * 512, ks_ = 2 * NDVT * 512, hf_ = NDVT * 512; \
        FA_TRRD(l0, b_); FA_TRRD(h0, b_ + hf_); FA_TRRD(l1, b_ + ks_); FA_TRRD(h1, b_ + ks_ + hf_); FA_TRRD(l2, b_ + 2 * ks_); FA_TRRD(h2, b_ + 2 * ks_ + hf_); FA_TRRD(l3, b_ + 3 * ks_); FA_TRRD(h3, b_ + 3 * ks_ + hf_); \
        asm volatile("s_waitcnt lgkmcnt(0)" ::: "memory"); FA_SBAR(); \
        o[d0] = __builtin_amdgcn_mfma_f32_32x32x16_bf16(pa0, (bf16x8){l0[0], l0[1], l0[2], l0[3], h0[0], h0[1], h0[2], h0[3]}, o[d0], 0, 0, 0); \
        o[d0] = __builtin_amdgcn_mfma_f32_32x32x16_bf16(pa1, (bf16x8){l1[0], l1[1], l1[2], l1[3], h1[0], h1[1], h1[2], h1[3]}, o[d0], 0, 0, 0); \
        o[d0] = __builtin_amdgcn_mfma_f32_32x32x16_bf16(pa2, (bf16x8){l2[0], l2[1], l2[2], l2[3], h2[0], h2[1], h2[2], h2[3]}, o[d0], 0, 0, 0); \
        o[d0] = __builtin_amdgcn_mfma_f32_32x32x16_bf16(pa3, (bf16x8){l3[0], l3[1], l3[2], l3[3], h3[0], h3[1], h3[2], h3[3]}, o[d0], 0, 0, 0); } while (0)
    FA_PV_D0(0); if constexpr (NDV > 1) FA_PV_D0(1); if constexpr (NDV > 2) FA_PV_D0(2); if constexpr (NDV > 3) FA_PV_D0(3);
#undef FA_PV_D0
#undef FA_TRRD
}

template <int NDQ, int NDVT, int NDV>
struct Core {
    static constexpr int KROW = NDQ * 32, SHM_K = 64 * KROW, SHM_V = 64 * NDVT * 64, NKL = NDQ / 4, NVL = NDVT / 2, LDS_NEED = 2 * SHM_V + 2 * SHM_K + NW * 256;
    static_assert(NKL >= 1 && NVL >= 1, "tile too small for 512 staging threads");
    __device__ __forceinline__ static void run(f32x16 (&o)[NDV], float& m_reg, float& l_reg, const bf16* Qw, int ldq, const bf16* Kg, const bf16* Vg, int ldk,
                                               int j_lo, int j_hi, int qlo, int W, char* lds, int vdoff) {
        int tid = threadIdx.x; asm volatile("" : "+v"(tid));
        const int wid = __builtin_amdgcn_readfirstlane(tid >> 6), lane = tid & 63, r32 = lane & 31, hi = lane >> 5;
        const int NT = j_hi - j_lo, qm = qlo + r32 - 4 * hi;
        char* V_lds = lds; char* K_lds = lds + 2 * SHM_V;
        float* wsf = (float*)(lds + 2 * SHM_V + 2 * SHM_K) + wid * 64; float* al_l = wsf + 32;
        m_reg = -1e30f; l_reg = 0.f;
#pragma unroll
        for (int d = 0; d < NDV; ++d) o[d] = f32x16{};
        constexpr int KCH = 2 * NDQ, KRS = 512 / KCH, VCH = 4 * NDVT, VRS = 512 / VCH;
        const int krow0 = tid / KCH, kch = tid % KCH, vrow0 = tid / VCH, vcol = (tid % VCH) * 8;
        int kws[NKL], vws[NVL];
#pragma unroll
        for (int i = 0; i < NKL; ++i) kws[i] = kswz<NDQ>(krow0 + i * KRS, kch);
#pragma unroll
        for (int i = 0; i < NVL; ++i) vws[i] = v_st<NDVT>(vrow0 + i * VRS, vcol);
        const bf16* kgp = Kg + (size_t)krow0 * ldk + kch * 8; const bf16* vgp = Vg + (size_t)vrow0 * ldk + vcol;
        bf16x8 sk[NKL], sv[NVL];
        const int vb0 = (int)(uintptr_t)V_lds + v_rd_base(lane) + vdoff * 512;
#define FA_SLOAD(t) do { const size_t ro_ = (size_t)((j_lo + (t)) * KVBLK) * ldk; \
        _Pragma("unroll") for (int i_ = 0; i_ < NVL; ++i_) sv[i_] = *reinterpret_cast<const bf16x8*>(vgp + ro_ + (size_t)(i_ * VRS) * ldk); \
        _Pragma("unroll") for (int i_ = 0; i_ < NKL; ++i_) sk[i_] = *reinterpret_cast<const bf16x8*>(kgp + ro_ + (size_t)(i_ * KRS) * ldk); } while (0)
#define FA_SWRITE(bf) do { _Pragma("unroll") for (int i_ = 0; i_ < NVL; ++i_) *reinterpret_cast<bf16x8*>(V_lds + (bf) * SHM_V + vws[i_]) = sv[i_]; \
        _Pragma("unroll") for (int i_ = 0; i_ < NKL; ++i_) *reinterpret_cast<bf16x8*>(K_lds + (bf) * SHM_K + kws[i_]) = sk[i_]; } while (0)
#define FA_RESC(a) do { if (__any((a) < 1.f)) { if (hi == 0) al_l[r32] = (a); asm volatile("s_waitcnt lgkmcnt(0)" ::: "memory"); \
        _Pragma("unroll") for (int d_ = 0; d_ < NDV; ++d_) _Pragma("unroll") for (int r = 0; r < 16; ++r) o[d_][r] *= al_l[crow(r, hi)]; } } while (0)
#define FA_KBASE(t) ((j_lo + (t)) * KVBLK)
#define FA_MASKT(P0_, P1_, t) do { const int kb_ = FA_KBASE(t); if (kb_ + KVBLK - 1 > qlo || kb_ <= qlo + QBLK - 1 - W) mask_tile(P0_, P1_, qm - kb_, (unsigned)W); } while (0)
        bf16x8 qr[NDQ];
#pragma unroll
        for (int d0 = 0; d0 < NDQ; ++d0) qr[d0] = *reinterpret_cast<const bf16x8*>(Qw + (size_t)r32 * ldq + d0 * 16 + hi * 8);
        FA_SLOAD(0); FA_VMW(); FA_SWRITE(0); FA_SBAR();
        if (NT > 1) FA_SLOAD(1);
        __syncthreads();
        f32x16 pA0, pA1, pB0, pB1; float alA, alB; bf16x8 pa0, pa1, pa2, pa3;
        FA_SBAR(); qkt<NDQ>(pA0, pA1, K_lds, r32, hi, qr);
        FA_MASKT(pA0, pA1, 0); partialSM(pA0, pA1, m_reg, alA);
        if (NT > 1) { FA_VMW(); FA_SWRITE(1); }
        __syncthreads();
#define FA_HALF_STEP(PX0, PX1, alX, PY0, PY1, alY, t, KB, VB, SB) do { \
        FA_SBAR(); qkt<NDQ>(PX0, PX1, K_lds + (KB) * SHM_K, r32, hi, qr); \
        finishSM(PY0, PY1, alY, l_reg, pa0, pa1, pa2, pa3); FA_SBAR(); \
        if ((t) + 1 < NT) { FA_SLOAD((t) + 1); FA_SBAR(); } \
        pv_tile<NDVT, NDV>(o, vb0 + (VB) * SHM_V, pa0, pa1, pa2, pa3); FA_MASKT(PX0, PX1, (t)); partialSM(PX0, PX1, m_reg, alX); \
        __syncthreads(); \
        if ((t) + 1 < NT) { FA_VMW(); FA_SWRITE(SB); } \
        FA_RESC(alX); __syncthreads(); } while (0)
        for (int t = 1; t + 1 < NT; t += 2) {
            FA_HALF_STEP(pB0, pB1, alB, pA0, pA1, alA, t, 1, 0, 0);
            FA_HALF_STEP(pA0, pA1, alA, pB0, pB1, alB, t + 1, 0, 1, 1);
        }
        const bool even = (NT & 1) == 0;
        if (even) { FA_SBAR(); qkt<NDQ>(pB0, pB1, K_lds + SHM_K, r32, hi, qr); FA_SBAR(); }
        finishSM(pA0, pA1, alA, l_reg, pa0, pa1, pa2, pa3); FA_SBAR();
        pv_tile<NDVT, NDV>(o, vb0, pa0, pa1, pa2, pa3);
        if (even) { FA_MASKT(pB0, pB1, NT - 1); partialSM(pB0, pB1, m_reg, alB); FA_RESC(alB);
            finishSM(pB0, pB1, alB, l_reg, pa0, pa1, pa2, pa3); FA_SBAR(); pv_tile<NDVT, NDV>(o, vb0 + SHM_V, pa0, pa1, pa2, pa3); }
        __syncthreads();
#undef FA_SLOAD
#undef FA_SWRITE
#undef FA_RESC
#undef FA_KBASE
#undef FA_MASKT
#undef FA_HALF_STEP
    }
};

#define FA_PIN(x) asm volatile("" : "+v"(x))
#define FA_PK4V(P, B_, OUT) do { unsigned a0_ = cvtpk(P[B_ + 0], P[B_ + 1]), a1_ = cvtpk(P[B_ + 2], P[B_ + 3]); unsigned b0_ = cvtpk(P[B_ + 4], P[B_ + 5]), b1_ = cvtpk(P[B_ + 6], P[B_ + 7]); \
        auto r0_ = __builtin_amdgcn_permlane32_swap(a0_, b0_, false, false); auto r1_ = __builtin_amdgcn_permlane32_swap(a1_, b1_, false, false); \
        u32x4 w_ = {r0_[0], r1_[0], r0_[1], r1_[1]}; OUT = *reinterpret_cast<bf16x8*>(&w_); } while (0)
__device__ __forceinline__ void step_qk_fin(f32x16& X0, f32x16& X1, const char* Kb, int r32, int hi, const bf16x8* qr,
                                            f32x16& Y0, f32x16& Y1, float alY, float& l_reg, bf16x8& pa0, bf16x8& pa1, bf16x8& pa2, bf16x8& pa3) {
    const char* k0 = Kb + kswz<4>(r32, hi); const char* k1 = Kb + kswz<4>(r32, 2 + hi); const char* k2 = Kb + kswz<4>(r32, 4 + hi); const char* k3 = Kb + kswz<4>(r32, 6 + hi);
    bf16x8 fa = *reinterpret_cast<const bf16x8*>(k0), fb = *reinterpret_cast<const bf16x8*>(k0 + 4096);
    float ps;
    X0 = __builtin_amdgcn_mfma_f32_32x32x16_bf16(fa, qr[0], f32x16{}, 0, 0, 0); X1 = __builtin_amdgcn_mfma_f32_32x32x16_bf16(fb, qr[0], f32x16{}, 0, 0, 0);
    fa = *reinterpret_cast<const bf16x8*>(k1); fb = *reinterpret_cast<const bf16x8*>(k1 + 4096);
#pragma unroll
    for (int r = 0; r < 4; ++r) Y1[r] = __builtin_amdgcn_exp2f(Y1[r]);
    ps = (Y0[0] + Y0[1]) + (Y0[2] + Y0[3]);
    FA_PK4V(Y0, 0, pa0); FA_PIN(ps); FA_PIN(pa0); FA_PIN(Y1); FA_SBAR();
    X0 = __builtin_amdgcn_mfma_f32_32x32x16_bf16(fa, qr[1], X0, 0, 0, 0); X1 = __builtin_amdgcn_mfma_f32_32x32x16_bf16(fb, qr[1], X1, 0, 0, 0);
    fa = *reinterpret_cast<const bf16x8*>(k2); fb = *reinterpret_cast<const bf16x8*>(k2 + 4096);
#pragma unroll
    for (int r = 4; r < 8; ++r) Y1[r] = __builtin_amdgcn_exp2f(Y1[r]);
    ps += (Y0[4] + Y0[5]) + (Y0[6] + Y0[7]); ps += (Y1[0] + Y1[1]) + (Y1[2] + Y1[3]);
    FA_PK4V(Y0, 8, pa1); FA_PIN(ps); FA_PIN(pa1); FA_PIN(Y1); FA_SBAR();
    X0 = __builtin_amdgcn_mfma_f32_32x32x16_bf16(fa, qr[2], X0, 0, 0, 0); X1 = __builtin_amdgcn_mfma_f32_32x32x16_bf16(fb, qr[2], X1, 0, 0, 0);
    fa = *reinterpret_cast<const bf16x8*>(k3); fb = *reinterpret_cast<const bf16x8*>(k3 + 4096);
#pragma unroll
    for (int r = 8; r < 12; ++r) Y1[r] = __builtin_amdgcn_exp2f(Y1[r]);
    ps += (Y0[8] + Y0[9]) + (Y0[10] + Y0[11]); ps += (Y1[4] + Y1[5]) + (Y1[6] + Y1[7]);
    FA_PK4V(Y1, 0, pa2); FA_PIN(ps); FA_PIN(pa2); FA_PIN(Y1); FA_SBAR();
    X0 = __builtin_amdgcn_mfma_f32_32x32x16_bf16(fa, qr[3], X0, 0, 0, 0); X1 = __builtin_amdgcn_mfma_f32_32x32x16_bf16(fb, qr[3], X1, 0, 0, 0);
#pragma unroll
    for (int r = 12; r < 16; ++r) Y1[r] = __builtin_amdgcn_exp2f(Y1[r]);
    ps += (Y0[12] + Y0[13]) + (Y0[14] + Y0[15]); ps += (Y1[8] + Y1[9]) + (Y1[10] + Y1[11]); ps += (Y1[12] + Y1[13]) + (Y1[14] + Y1[15]);
    { auto rr = __builtin_amdgcn_permlane32_swap(__float_as_uint(ps), __float_as_uint(ps), false, false); ps = __uint_as_float(rr[0]) + __uint_as_float(rr[1]); }
    l_reg = l_reg * alY + ps;
    FA_PK4V(Y1, 8, pa3); FA_PIN(l_reg); FA_PIN(pa3); FA_PIN(X0); FA_PIN(X1); FA_SBAR();
}
__device__ __forceinline__ void step_pv_max(f32x16* o, int vb, bf16x8 pa0, bf16x8 pa1, bf16x8 pa2, bf16x8 pa3, f32x16& X0, f32x16& X1, float& m_reg, float& alpha, bool MASK, int dq, unsigned W) {
#define FA_TRRD(dst, off) asm volatile("ds_read_b64_tr_b16 %0, %1 offset:%2" : "=&v"(dst) : "v"(vb), "i"(off) : "memory")
#define FA_RD2(l, h, d0, ks) do { FA_TRRD(l, (d0) * 512 + (ks) * 4096); FA_TRRD(h, (d0) * 512 + (ks) * 4096 + 2048); } while (0)
#define FA_FRAG(l, h) (bf16x8){l[0], l[1], l[2], l[3], h[0], h[1], h[2], h[3]}
    s16x4 l0, h0, l1, h1, l2, h2, l3, h3;
    FA_RD2(l0, h0, 0, 0); FA_RD2(l1, h1, 0, 1); FA_RD2(l2, h2, 0, 2); FA_RD2(l3, h3, 0, 3);
    if (MASK) mask_tile(X0, X1, dq, W);
    float pmax = fmaxf(fmaxf(X0[0], X0[1]), X1[0]);
#pragma unroll
    for (int r = 2; r < 16; r += 2) pmax = fmaxf(fmaxf(pmax, X0[r]), X0[r + 1]);
#pragma unroll
    for (int r = 1; r < 16; r += 2) pmax = fmaxf(fmaxf(pmax, X1[r]), X1[(r + 1) & 15]);
    { auto rr = __builtin_amdgcn_permlane32_swap(__float_as_uint(pmax), __float_as_uint(pmax), false, false); pmax = fmaxf(__uint_as_float(rr[0]), __uint_as_float(rr[1])); }
    float mn;
    if (__builtin_expect(__all((pmax - m_reg) <= THR), 1)) { mn = m_reg; alpha = 1.f; }
    else { mn = fmaxf(m_reg, pmax); alpha = __builtin_amdgcn_exp2f(m_reg - mn); m_reg = mn; }
    FA_PIN(mn);
#define FA_BLK(d0, NXT, FILL) do { asm volatile("s_waitcnt lgkmcnt(0)" ::: "memory"); FA_SBAR(); \
        o[d0] = __builtin_amdgcn_mfma_f32_32x32x16_bf16(pa0, FA_FRAG(l0, h0), o[d0], 0, 0, 0); if (NXT) FA_RD2(l0, h0, (d0) + 1, 0); \
        o[d0] = __builtin_amdgcn_mfma_f32_32x32x16_bf16(pa1, FA_FRAG(l1, h1), o[d0], 0, 0, 0); if (NXT) FA_RD2(l1, h1, (d0) + 1, 1); \
        o[d0] = __builtin_amdgcn_mfma_f32_32x32x16_bf16(pa2, FA_FRAG(l2, h2), o[d0], 0, 0, 0); if (NXT) FA_RD2(l2, h2, (d0) + 1, 2); \
        o[d0] = __builtin_amdgcn_mfma_f32_32x32x16_bf16(pa3, FA_FRAG(l3, h3), o[d0], 0, 0, 0); if (NXT) FA_RD2(l3, h3, (d0) + 1, 3); \
        FILL; } while (0)
    FA_BLK(0, true,  { _Pragma("unroll") for (int r = 0; r < 16; ++r) X0[r] = X0[r] - mn; FA_PIN(X0); });
    FA_BLK(1, true,  { _Pragma("unroll") for (int r = 0; r < 16; ++r) X1[r] = X1[r] - mn; FA_PIN(X1); });
    FA_BLK(2, true,  { _Pragma("unroll") for (int r = 0; r < 8; ++r) X0[r] = __builtin_amdgcn_exp2f(X0[r]); FA_PIN(X0); });
    FA_BLK(3, false, { _Pragma("unroll") for (int r = 8; r < 16; ++r) X0[r] = __builtin_amdgcn_exp2f(X0[r]); FA_PIN(X0); });
    FA_SBAR();
#undef FA_BLK
#undef FA_RD2
#undef FA_FRAG
#undef FA_TRRD
}

template <int NDQ, int NDVT, int NDV>
struct CoreStag {
    static_assert(NDQ == 4 && NDVT == 4 && NDV == 4, "the interleaved interval bodies are written for d_qk = 64, d_v = 128");
    static constexpr int KROW = NDQ * 32, SHM_K = 64 * KROW, SHM_V = 64 * NDVT * 64, NKL = NDQ / 4, NVL = NDVT / 2, LDS_NEED = 2 * SHM_V + 2 * SHM_K + NW * 256;
    __device__ __forceinline__ static void run(f32x16 (&o)[NDV], float& m_reg, float& l_reg, const bf16* Qw, int ldq, const bf16* Kg, const bf16* Vg, int ldk,
                                               int j_lo, int j_hi, int qlo, int W, char* lds, int vdoff) {
        const int tid = threadIdx.x, wid = __builtin_amdgcn_readfirstlane(tid >> 6), lane = tid & 63, r32 = lane & 31, hi = lane >> 5;
        const bool half1 = wid >= 4;
        const int NT = j_hi - j_lo, qm = qlo + r32 - 4 * hi;
        char* V_lds = lds; char* K_lds = lds + 2 * SHM_V;
        float* al_l = (float*)(lds + 2 * SHM_V + 2 * SHM_K) + wid * 64 + 32;
        m_reg = -1e30f; l_reg = 0.f;
#pragma unroll
        for (int d = 0; d < NDV; ++d) o[d] = f32x16{};
        constexpr int KCH = 2 * NDQ, KRS = 512 / KCH, VCH = 4 * NDVT, VRS = 512 / VCH;
        const int krow0 = tid / KCH, kch = tid % KCH, vrow0 = tid / VCH, vcol = (tid % VCH) * 8;
        int kws[NKL], vws[NVL];
#pragma unroll
        for (int i = 0; i < NKL; ++i) kws[i] = kswz<NDQ>(krow0 + i * KRS, kch);
#pragma unroll
        for (int i = 0; i < NVL; ++i) vws[i] = v_st<NDVT>(vrow0 + i * VRS, vcol);
        const bf16* kgp = Kg + (size_t)(j_lo * KVBLK + krow0) * ldk + kch * 8; const bf16* vgp = Vg + (size_t)(j_lo * KVBLK + vrow0) * ldk + vcol;
        bf16x8 sk[NKL], sv[NVL];
        const int vb0 = (int)(uintptr_t)V_lds + v_rd_base(lane) + vdoff * 512;
#define FS_BAR() do { FA_SBAR(); __syncthreads(); FA_SBAR(); } while (0)
#define FS_LOADK(t) do { if ((t) < NT) { const size_t ro_ = (size_t)((t) * KVBLK) * ldk; _Pragma("unroll") for (int i_ = 0; i_ < NKL; ++i_) sk[i_] = *reinterpret_cast<const bf16x8*>(kgp + ro_ + (size_t)(i_ * KRS) * ldk); } } while (0)
#define FS_LOADV(t) do { if ((t) < NT) { const size_t ro_ = (size_t)((t) * KVBLK) * ldk; _Pragma("unroll") for (int i_ = 0; i_ < NVL; ++i_) sv[i_] = *reinterpret_cast<const bf16x8*>(vgp + ro_ + (size_t)(i_ * VRS) * ldk); } } while (0)
#define FS_WRITEK(t, bf) do { if ((t) < NT) { _Pragma("unroll") for (int i_ = 0; i_ < NKL; ++i_) *reinterpret_cast<bf16x8*>(K_lds + (bf) * SHM_K + kws[i_]) = sk[i_]; } } while (0)
#define FS_WRITEV(t, bf) do { if ((t) < NT) { _Pragma("unroll") for (int i_ = 0; i_ < NVL; ++i_) *reinterpret_cast<bf16x8*>(V_lds + (bf) * SHM_V + vws[i_]) = sv[i_]; } } while (0)
#define FS_RESC(a) do { if (__any((a) < 1.f)) { if (hi == 0) al_l[r32] = (a); asm volatile("s_waitcnt lgkmcnt(0)" ::: "memory"); \
        _Pragma("unroll") for (int d_ = 0; d_ < NDV; ++d_) _Pragma("unroll") for (int r = 0; r < 16; ++r) o[d_][r] *= al_l[crow(r, hi)]; } } while (0)
#define FS_MASKT(P0_, P1_, t) do { const int kb_ = (j_lo + (t)) * KVBLK; if (kb_ + KVBLK - 1 > qlo || kb_ <= qlo + QBLK - 1 - W) mask_tile(P0_, P1_, qm - kb_, (unsigned)W); } while (0)
        bf16x8 qr[NDQ];
#pragma unroll
        for (int d0 = 0; d0 < NDQ; ++d0) qr[d0] = *reinterpret_cast<const bf16x8*>(Qw + (size_t)r32 * ldq + d0 * 16 + hi * 8);
        FS_LOADK(0); FS_WRITEK(0, 0); FA_SBAR(); FS_LOADK(1); FS_LOADV(0);
        FS_BAR();
        if (half1) { FS_BAR(); }
        f32x16 pA0, pA1, pB0, pB1; float alA = 1.f, alB = 1.f; bf16x8 pa0, pa1, pa2, pa3;
        FS_WRITEK(1, 1); FA_SBAR(); FS_LOADK(2); FA_SBAR();
        qkt<NDQ>(pA0, pA1, K_lds, r32, hi, qr); asm volatile("" : "+v"(pA0), "+v"(pA1));
        FS_BAR();
        FS_WRITEV(0, 0); FA_SBAR(); FS_LOADV(1); FA_SBAR();
        FS_MASKT(pA0, pA1, 0); partialSM(pA0, pA1, m_reg, alA);
        FS_BAR();
#define FS_STEP(PX0, PX1, alX, PY0, PY1, alY, t, KB) do { \
        finishSM(PY0, PY1, alY, l_reg, pa0, pa1, pa2, pa3); FA_SBAR(); \
        FS_WRITEK((t) + 1, (KB) ^ 1); FA_SBAR(); FS_LOADK((t) + 2); FA_SBAR(); \
        qkt<NDQ>(PX0, PX1, K_lds + (KB) * SHM_K, r32, hi, qr); asm volatile("" : "+v"(PX0), "+v"(PX1)); \
        FS_BAR(); \
        pv_tile<NDVT, NDV>(o, vb0 + ((KB) ^ 1) * SHM_V, pa0, pa1, pa2, pa3); \
        FS_WRITEV((t), (KB)); FA_SBAR(); FS_LOADV((t) + 1); FA_SBAR(); \
        FS_MASKT(PX0, PX1, (t)); partialSM(PX0, PX1, m_reg, alX); FS_RESC(alX); \
        FS_BAR(); } while (0)
        int t = 1;
        for (; t + 1 < NT; t += 2) {
            FS_STEP(pB0, pB1, alB, pA0, pA1, alA, t, 1);
            FS_STEP(pA0, pA1, alA, pB0, pB1, alB, t + 1, 0);
        }
        FS_STEP(pB0, pB1, alB, pA0, pA1, alA, t, 1);
        finishSM(pB0, pB1, alB, l_reg, pa0, pa1, pa2, pa3); FA_SBAR();
        FS_BAR();
        pv_tile<NDVT, NDV>(o, vb0 + SHM_V, pa0, pa1, pa2, pa3);
        FS_BAR();
        if (!half1) { FS_BAR(); }
#undef FS_BAR
#undef FS_LOADK
#undef FS_LOADV
#undef FS_WRITEK
#undef FS_WRITEV
#undef FS_RESC
#undef FS_MASKT
#undef FS_STEP
    }
};
}

constexpr size_t WS_STASH = 128 * MiB;
typedef unsigned v4u32 __attribute__((__vector_size__(16)));
__device__ __forceinline__ __amdgpu_buffer_rsrc_t mk_rsrc(const void* ptr) {
    const unsigned long long v = (unsigned long long)ptr; const unsigned lo = __builtin_amdgcn_readfirstlane((unsigned)v), hi = __builtin_amdgcn_readfirstlane((unsigned)(v >> 32));
    return __builtin_amdgcn_make_buffer_rsrc((void*)(((unsigned long long)hi << 32) | lo), 0, 0x40000000, 0x00020000);
}
__device__ __forceinline__ void attn_phase(const Params& p, char* lds, int vcu0, int nwg) {
    using namespace fa;
    const int tid = threadIdx.x, wid = __builtin_amdgcn_readfirstlane(tid >> 6), lane = tid & 63, r32 = lane & 31, hi = lane >> 5;
    const bf16* proj = (const bf16*)(p.ws + WS_PROJ); bf16* att = (bf16*)(p.ws + WS_ATT);
    typedef CoreStag<4, 4, 4> CD; typedef Core<4, 2, 2> CS;
    float* wsf = (float*)(lds + CD::LDS_NEED) + wid * 64;
    const float lam = calc_lambda(p);
    const int ovoff = (4 * hi * DM + r32) * 2;
#pragma nounroll
    for (int vcu = vcu0; vcu < 256; vcu += nwg) {
        const int bh = vcu >> 3, b = bh >> 2, h = bh & 3, s = vcu & 7;
        u32x4* stash = (u32x4*)(lds + CD::LDS_NEED + NW * 256) + tid;
#pragma nounroll
        for (int pass = 0; pass < 2; ++pass) {
            const int qb = pass ? 15 - s : s;
            const size_t row0 = (size_t)b * SEQ + qb * 256 + wid * 32;
#pragma nounroll
            for (int c = 0; c < 2; ++c) {
                f32x16 o[4]; float m_reg, l_reg;
                CD::run(o, m_reg, l_reg, proj + row0 * NP + C_QD + (2 * h + c) * 64, NP, proj + (size_t)b * SEQ * NP + C_KD + (2 * h + c) * 64, proj + (size_t)b * SEQ * NP + C_VD + h * 128, NP,
                        0, 4 * (qb + 1), qb * 256 + wid * 32, 1 << 30, lds, 0);
                if (hi == 0) wsf[r32] = l_reg;
                asm volatile("s_waitcnt lgkmcnt(0)" ::: "memory");
                if (c == 0) {
#pragma unroll
                    for (int j = 0; j < 2; ++j) { float ri[8];
#pragma unroll
                        for (int e = 0; e < 8; ++e) ri[e] = 1.0f / wsf[crow(8 * j + e, hi)];
#pragma unroll
                        for (int d0 = 0; d0 < 4; ++d0) { u32x4 w; w.x = cvtpk(o[d0][8 * j] * ri[0], o[d0][8 * j + 1] * ri[1]); w.y = cvtpk(o[d0][8 * j + 2] * ri[2], o[d0][8 * j + 3] * ri[3]);
                            w.z = cvtpk(o[d0][8 * j + 4] * ri[4], o[d0][8 * j + 5] * ri[5]); w.w = cvtpk(o[d0][8 * j + 6] * ri[6], o[d0][8 * j + 7] * ri[7]); stash[(d0 * 2 + j) * NTHR] = w; } }
                } else {
                    const __amdgpu_buffer_rsrc_t rso = mk_rsrc(att + row0 * DM + 512 + h * 128);
                    float ssq[16];
#pragma unroll
                    for (int r = 0; r < 16; ++r) ssq[r] = -lam / wsf[crow(r, hi)];
#pragma unroll
                    for (int d0 = 0; d0 < 4; ++d0)
#pragma unroll
                        for (int j = 0; j < 2; ++j) { const u32x4 w = stash[(d0 * 2 + j) * NTHR]; const unsigned ww[4] = {w.x, w.y, w.z, w.w};
#pragma unroll
                            for (int e = 0; e < 8; ++e) { const int r = 8 * j + e; const float a0 = (e & 1) ? __uint_as_float(ww[e >> 1] & 0xffff0000u) : __uint_as_float(ww[e >> 1] << 16);
                                o[d0][r] = a0 + ssq[r] * o[d0][r]; } }
#pragma unroll
                    for (int r = 0; r < 16; ++r) { float q = (o[0][r] * o[0][r] + o[1][r] * o[1][r]) + (o[2][r] * o[2][r] + o[3][r] * o[3][r]);
                        q += __shfl_xor(q, 1); q += __shfl_xor(q, 2); q += __shfl_xor(q, 4); q += __shfl_xor(q, 8); q += __shfl_xor(q, 16);
                        ssq[r] = 0.8f / sqrtf(q * (1.f / 128.f) + EPS); }
#pragma unroll
                    for (int d0 = 0; d0 < 4; ++d0) { const float g = p.g_diff[d0 * 32 + r32];
#pragma unroll
                        for (int r = 0; r < 16; ++r) { const float y = o[d0][r] * ssq[r] * g; const float yn = __shfl_xor(y, 1);
                            if ((r32 & 1) == 0) __builtin_amdgcn_raw_buffer_store_b32(cvtpk(y, yn), rso, ovoff, (((r & 3) + 8 * (r >> 2)) * DM + d0 * 32) * 2, WT_ATT); } }
                }
                asm volatile("s_waitcnt lgkmcnt(0)" ::: "memory");
            }
        }
    }
    int tid_s = threadIdx.x; asm volatile("" : "+v"(tid_s));
    const int wid_s = __builtin_amdgcn_readfirstlane(tid_s >> 6), r32_s = tid_s & 31, hi_s = (tid_s >> 5) & 1;
    float* wsf_s = (float*)(lds + CD::LDS_NEED) + wid_s * 64; const int ovoff_s = (4 * hi_s * DM + r32_s) * 2;
#pragma nounroll
    for (int u = vcu0; u < 1024; u += nwg) {
        const int wid = wid_s, r32 = r32_s, hi = hi_s, ovoff = ovoff_s; float* wsf = wsf_s;
        const int bk = u >> 6, g64 = u & 63, b = bk >> 1, kvh = bk & 1, hq = kvh * 4 + (wid >> 1), sub = wid & 1;
        const size_t row0 = (size_t)b * SEQ + g64 * 64 + sub * 32;
        const __amdgpu_buffer_rsrc_t rso = mk_rsrc(att + row0 * DM + hq * 64);
        f32x16 o[2]; float m_reg, l_reg;
        const bf16* Qw = proj + row0 * NP + C_QA + hq * 64;
        const bf16* Kg = proj + (size_t)b * SEQ * NP + C_KA + kvh * 64;
        const bf16* Vg = proj + (size_t)b * SEQ * NP + C_VA + kvh * 64;
        CS::run(o, m_reg, l_reg, Qw, NP, Kg, Vg, NP, g64 >= 2 ? g64 - 2 : 0, g64 + 1, g64 * 64 + sub * 32, 128, lds, 0);
        const float lt = l_reg + __builtin_amdgcn_exp2f(p.sinks[hq] * LOG2E - m_reg);
        if (hi == 0) wsf[r32] = lt;
        asm volatile("s_waitcnt lgkmcnt(0)" ::: "memory");
#pragma unroll
        for (int r = 0; r < 16; ++r) { const float rl = 1.0f / wsf[crow(r, hi)];
#pragma unroll
            for (int d0 = 0; d0 < 2; ++d0) { const float y = o[d0][r] * rl; const float yn = __shfl_xor(y, 1);
                if ((r32 & 1) == 0) __builtin_amdgcn_raw_buffer_store_b32(cvtpk(y, yn), rso, ovoff, (((r & 3) + 8 * (r >> 2)) * DM + d0 * 32) * 2, WT_ATT); } }
        __syncthreads();
    }
}

namespace fa {
template <int NDQ, int NDVT, int NDV>
struct CoreSeqG {
    static constexpr int KROW = NDQ * 32, SHM_K = 64 * KROW, SHM_V = 64 * NDVT * 64, KPW = SHM_K / 8192, VPW = SHM_V / 8192;
    static_assert(NDQ == 16 && NDVT == 8, "piece maps below are written for 512-byte K rows and 8 V column blocks");
    typedef __attribute__((address_space(3))) unsigned char* lptr;
    __device__ __forceinline__ static void run(f32x16 (&o)[NDV], float& m_reg, float& l_reg, const bf16* Qw, int ldq, const bf16* Kg, const bf16* Vg, int ldk, int NT, char* lds, lptr ldsL, int scr_off, int vdoff) {
        const int tid = threadIdx.x, wid = __builtin_amdgcn_readfirstlane(tid >> 6), lane = tid & 63, r32 = lane & 31, hi = lane >> 5;
        char* V_lds = lds; char* K_lds = lds + 2 * SHM_V;
        float* al_l = (float*)(lds + scr_off) + wid * 64 + 32;
        m_reg = -1e30f; l_reg = 0.f;
#pragma unroll
        for (int d = 0; d < NDV; ++d) o[d] = f32x16{};
        int ksrc[KPW], vsrc[VPW];
#pragma unroll
        for (int i = 0; i < KPW; ++i) { const int row = 2 * (wid * KPW + i) + (lane >> 5); ksrc[i] = row * ldk + (((lane & 31) ^ (row & 15)) << 3); }
#pragma unroll
        for (int i = 0; i < VPW; ++i) { const int kk = wid * 8 + ((lane & 31) >> 2), k = (kk & ~0xC) | ((kk & 4) << 1) | ((kk & 8) >> 1); vsrc[i] = k * ldk + (2 * i + (lane >> 5)) * 32 + (lane & 3) * 8; }
#define FG_DMA(t, bf) do { const size_t ro_ = (size_t)((t) * KVBLK) * ldk; \
        _Pragma("unroll") for (int i_ = 0; i_ < VPW; ++i_) __builtin_amdgcn_global_load_lds((const unsigned*)(Vg + ro_ + vsrc[i_]), (__attribute__((address_space(3))) unsigned*)(ldsL + (bf) * SHM_V + (wid * VPW + i_) * 1024), 16, 0, 0); \
        _Pragma("unroll") for (int i_ = 0; i_ < KPW; ++i_) __builtin_amdgcn_global_load_lds((const unsigned*)(Kg + ro_ + ksrc[i_]), (__attribute__((address_space(3))) unsigned*)(ldsL + 2 * SHM_V + (bf) * SHM_K + (wid * KPW + i_) * 1024), 16, 0, 0); } while (0)
        const int vb0 = (int)(uintptr_t)V_lds + v_rd_base(lane) + vdoff * 512;
        FG_DMA(0, 0);
        bf16x8 qr[NDQ];
#pragma unroll
        for (int d0 = 0; d0 < NDQ; ++d0) qr[d0] = *reinterpret_cast<const bf16x8*>(Qw + (size_t)r32 * ldq + d0 * 16 + hi * 8);
        __syncthreads();
        for (int t = 0; t < NT; ++t) {
            const int bf = t & 1;
            if (t + 1 < NT) FG_DMA(t + 1, bf ^ 1);
            f32x16 p0, p1; float al; bf16x8 pa0, pa1, pa2, pa3;
            FA_SBAR(); qkt<NDQ>(p0, p1, K_lds + bf * SHM_K, r32, hi, qr);
            partialSM(p0, p1, m_reg, al);
            if (__any(al < 1.f)) { if (hi == 0) al_l[r32] = al; asm volatile("s_waitcnt lgkmcnt(0)" ::: "memory");
#pragma unroll
                for (int d_ = 0; d_ < NDV; ++d_)
#pragma unroll
                    for (int r = 0; r < 16; ++r) o[d_][r] *= al_l[crow(r, hi)]; }
            finishSM(p0, p1, al, l_reg, pa0, pa1, pa2, pa3); FA_SBAR();
            pv_tile<NDVT, NDV>(o, vb0 + bf * SHM_V, pa0, pa1, pa2, pa3);
            __syncthreads();
        }
#undef FG_DMA
    }
};
}
__device__ __forceinline__ void cross_block(const Params& p, char* lds, LAS unsigned char* ldsL, int b, int head, int rb) {
    using namespace fa;
    int tid = threadIdx.x; asm volatile("" : "+v"(tid));
    const int wid = __builtin_amdgcn_readfirstlane(tid >> 6), lane = tid & 63, r32 = lane & 31, hi = lane >> 5, dh = wid >> 2;
    const bf16* qc = (const bf16*)(p.ws + WS_QC); const bf16* kvm = (const bf16*)(p.ws + WS_KVM); bf16* oc = (bf16*)(p.ws + WS_OC);
    typedef CoreSeqG<16, 8, 4> CC;
    constexpr int SCR = 131072 + 8192;
    float* wsf = (float*)(lds + SCR + 2048) + wid * 64;
    const int ovoff = (4 * hi * DM + r32) * 2;
    const size_t row0 = (size_t)b * SEQ + rb * 128 + (wid & 3) * 32;
    const __amdgpu_buffer_rsrc_t rso = mk_rsrc(oc + row0 * DM + head * 256 + dh * 128);
    f32x16 o[4]; float m_reg, l_reg;
    CC::run(o, m_reg, l_reg, qc + row0 * DM + head * 256, DM, kvm + (size_t)b * MEML * 2048 + head * 256, kvm + (size_t)b * MEML * 2048 + 1024 + head * 256, 2048, MEML / 64, lds, (CC::lptr)ldsL, SCR, dh * 4);
    if (hi == 0) wsf[r32] = l_reg;
    asm volatile("s_waitcnt lgkmcnt(0)" ::: "memory");
#pragma unroll
    for (int r = 0; r < 16; ++r) { const float rl = 1.0f / wsf[crow(r, hi)];
#pragma unroll
        for (int d0 = 0; d0 < 4; ++d0) { const float y = o[d0][r] * rl; const float yn = __shfl_xor(y, 1);
            if ((r32 & 1) == 0) __builtin_amdgcn_raw_buffer_store_b32(cvtpk(y, yn), rso, ovoff, (((r & 3) + 8 * (r >> 2)) * DM + d0 * 32) * 2, WT_ATT); } }
    asm volatile("s_waitcnt lgkmcnt(0)" ::: "memory");
}
#define GAS __attribute__((address_space(1)))
typedef GAS unsigned gu32;
constexpr int CW_BAR = 4096;
constexpr size_t CTL_ZERO_BYTES = 65536;
constexpr int MISC_OFF = 131072 + 320, TAB_OFF = 131072 + 1024;
constexpr int CW_PANEL = 8192;
constexpr size_t WS_XCH = 60 * MiB;
#define XB_TMO      128
#define XB_XCNT(j)  (256  + 64 * (j))
#define XB_XSUB(j)  (1280 + 64 * (j))
#define XB_XGEN(j)  (2304 + 64 * (j))
#define XB_TOP      3328
#define XB_TOPGEN   3392
#define XCD_BAR_WORDS 3456
#define XB_SPIN_CAP (1u << 18)

__device__ __forceinline__ unsigned xb_ld(unsigned* p)              { return __hip_atomic_load(p, __ATOMIC_RELAXED, __HIP_MEMORY_SCOPE_AGENT); }
__device__ __forceinline__ unsigned xb_add(unsigned* p, unsigned v) { return __hip_atomic_fetch_add(p, v, __ATOMIC_RELAXED, __HIP_MEMORY_SCOPE_AGENT); }
__device__ __forceinline__ unsigned xb_xcc_id() { return (unsigned)__builtin_amdgcn_s_getreg((3 << 11) | 20) & 0xFu; }
#define XB_SPIN(cond, bar) do { unsigned _sp = 0; while (cond) { __builtin_amdgcn_s_sleep(1); \
    if ((++_sp & 255u) == 0u) { if (xb_ld(&(bar)[XB_TMO])) break; if (_sp > XB_SPIN_CAP) { atomicAdd(&(bar)[XB_TMO], 1u); break; } } } } while (0)

struct XcdBarrier {
    unsigned* bar; unsigned x;
    volatile LAS unsigned* st;
};

__device__ __forceinline__ XcdBarrier xcd_barrier_post(unsigned* bar, volatile LAS unsigned* st) {
    XcdBarrier b; b.bar = bar; b.x = xb_xcc_id(); b.st = st;
    if (threadIdx.x == 0) (void)xb_add(&bar[XB_XCNT(b.x)], 1u);
    return b;
}
__device__ __forceinline__ void xcd_barrier_complete(unsigned* bar, unsigned x, unsigned& nloc, unsigned& nx) {
    const unsigned G = gridDim.x * gridDim.y * gridDim.z;
    unsigned sum, cnt, mine, sp = 0u;
    for (;;) {
        sum = 0u; cnt = 0u; mine = 0u;
#pragma unroll
        for (unsigned j = 0; j < 16; ++j) { const unsigned c = xb_ld(&bar[XB_XCNT(j)]); sum += c; cnt += (c > 0u) ? 1u : 0u; mine = (j == x) ? c : mine; }
        if (sum == G) break;
        __builtin_amdgcn_s_sleep(1);
        if ((++sp & 255u) == 0u) { if (xb_ld(&bar[XB_TMO])) break; if (sp > XB_SPIN_CAP) { atomicAdd(&bar[XB_TMO], 1u); break; } }
    }
    nloc = mine > 0u ? mine : 1u; nx = cnt > 0u ? cnt : 1u;
}

__device__ __forceinline__ void xcd_barrier(const XcdBarrier& b) {
    asm volatile("s_waitcnt vmcnt(0)" ::: "memory");
    __syncthreads();
    if (threadIdx.x == 0) {
        unsigned* bar = b.bar;
        __builtin_amdgcn_s_waitcnt(0);
        unsigned nloc = b.st[0], nx = b.st[1];
        if (nloc == 0u) { xcd_barrier_complete(bar, b.x, nloc, nx); b.st[0] = nloc; b.st[1] = nx; }
        const unsigned old = xb_add(&bar[XB_XSUB(b.x)], 1u);
        const unsigned gen = old / nloc;
        if (old + 1u == (gen + 1u) * nloc) {
            __builtin_amdgcn_fence(__ATOMIC_RELEASE, "agent");
            asm volatile("s_waitcnt vmcnt(0)" ::: "memory");
            const unsigned og = xb_add(&bar[XB_TOP], 1u);
            const unsigned tg = og / nx;
            if (og + 1u == (tg + 1u) * nx) xb_add(&bar[XB_TOPGEN], 1u);
            else XB_SPIN(xb_ld(&bar[XB_TOPGEN]) == tg, bar);
            __builtin_amdgcn_fence(__ATOMIC_ACQUIRE, "agent");
            asm volatile("s_waitcnt vmcnt(0)" ::: "memory");
        } else {
            XB_SPIN(xb_ld(&bar[XB_TOPGEN]) == gen, bar);
            __builtin_amdgcn_fence(__ATOMIC_ACQUIRE, "agent");
            asm volatile("s_waitcnt vmcnt(0)" ::: "memory");
        }
    }
    __syncthreads();
}

constexpr int LDS_BYTES = 147456;
constexpr size_t WS_SS3 = 58 * MiB;
__device__ __forceinline__ void final_norm_ss(float* X, const float* ss, const float* g, int gw, int ngw, int lane) {
    for (int m = gw; m < M; m += ngw) {
        const float rstd = pg8::rstd_ss(ss, m);
        f32x4* xr = (f32x4*)(X + (size_t)m * DM) + lane;
#pragma unroll
        for (int j = 0; j < 4; ++j) { const f32x4 gg = ((const f32x4*)g)[lane + 64 * j]; xr[64 * j] = xr[64 * j] * rstd * gg; }
    }
}
constexpr int N_PHASES = 10;
__global__ void __launch_bounds__(NTHR, 2) fwd_kernel(Params p) {
    extern __shared__ __attribute__((aligned(16))) unsigned char lds_raw[];
    LAS unsigned char* lds = (LAS unsigned char*)lds_raw;
    for (int u = threadIdx.x; u < 64; u += NTHR) ((LAS unsigned*)(lds + MISC_OFF))[u] = 0u;
    __syncthreads();
    XcdBarrier bar = xcd_barrier_post((unsigned*)(p.ws + WS_CTL) + CW_BAR, (volatile LAS unsigned*)(lds + MISC_OFF) + 8);
    const int tid = threadIdx.x, wave = __builtin_amdgcn_readfirstlane(tid >> 6), lane = tid & 63, bid = blockIdx.x, nblk = gridDim.x;
    const int gw = bid * NWAVES + wave, ngw = nblk * NWAVES;
    const int vcu = (nblk % 8 == 0) ? (bid % 8) * (nblk / 8) + bid / 8 : bid;
    unsigned char* ws = p.ws;
    const int lo = p.ph_lo, hi = p.ph_hi;
    typedef pg8::bf16_t b16;
#define IN(k) (lo <= (k) && (k) < hi)
#define SEAM(k) do { if (IN(k) && IN((k) + 1) && !((k) == 8 && nblk == 256)) xcd_barrier(bar); } while (0)
    if (IN(0)) { p0_prologue(p, lds, bid, nblk, tid); } SEAM(0);
    if (IN(1)) {
        pg8::Gemm g{(const b16*)(ws + WS_XN), (const b16*)(ws + WS_WIN), (const b16*)(ws + WS_MEMN), (const b16*)(ws + WS_WCKV), DM};
        pg8::TwoOrder S; S.init(M, NP, nblk, bid); S.n2M = MM / 256; S.n2N = 2048 / 256;
        pg8::EpiProj E{(b16*)(ws + WS_PROJ), (b16*)(ws + WS_KVM), (const float*)(ws + WS_ROPE)};
        pg8::gemm_phase<pg8::EpiProj, pg8::TwoOrder, true, true>(lds, g, S, E);
    } SEAM(1);
    if (IN(2)) { attn_phase(p, (char*)lds_raw, vcu, nblk);
    } SEAM(2);
    if (IN(3)) {
        pg8::Gemm g{(const b16*)(ws + WS_ATT), (const b16*)(ws + WS_WOUT), nullptr, nullptr, DM};
        pg8::StaticOrder S; S.init(M, DM, nblk, bid);
        pg8::EpiResB<true> E{p.x, nullptr, (b16*)(ws + WS_XN), (float*)(ws + WS_SS1)};
        pg8::gemm_phase<pg8::EpiResB<true>, pg8::StaticOrder, true, true>(lds, g, S, E);
    } SEAM(3);
    if (IN(4)) {
        pg8::Gemm g{(const b16*)(ws + WS_XN), (const b16*)(ws + WS_WCQ), nullptr, nullptr, DM};
        pg8::StaticOrder S; S.init(M, DM, nblk, bid);
        pg8::EpiScaleBf16<0> E{(b16*)(ws + WS_QC), DM, (const float*)(ws + WS_SS1), CQ, lds + TAB_OFF};
        pg8::gemm_phase<pg8::EpiScaleBf16<0>, pg8::StaticOrder, true, true>(lds, g, S, E);
        asm volatile("s_waitcnt vmcnt(0)" ::: "memory");
        __syncthreads();
        if (tid == 0) { __builtin_amdgcn_fence(__ATOMIC_ACQUIRE, "agent"); asm volatile("s_waitcnt vmcnt(0)" ::: "memory"); }
        __syncthreads();
#pragma nounroll
        for (int i = 0; ; ++i) {
            pg8::Unit u; if (!S.next(i, u)) break;
#pragma nounroll
            for (int hb = 0; hb < 2; ++hb) cross_block(p, (char*)lds_raw, lds, u.pm >> 4, u.pn, (u.pm & 15) * 2 + hb);
        }
    } SEAM(4);
    if (IN(6)) {
        pg8::Gemm g{(const b16*)(ws + WS_OC), (const b16*)(ws + WS_WCO), nullptr, nullptr, DM};
        pg8::StaticOrder S; S.init(M, DM, nblk, bid);
        pg8::EpiResB<false> E{nullptr, (const b16*)(ws + WS_XN), (b16*)(ws + WS_XN), (float*)(ws + WS_SS2)};
        pg8::gemm_phase<pg8::EpiResB<false>, pg8::StaticOrder, true, true>(lds, g, S, E);
    } SEAM(6);
    if (IN(7)) {
        pg8::Gemm g{(const b16*)(ws + WS_XN), (const b16*)(ws + WS_WUP), nullptr, nullptr, DM};
        pg8::StaticOrder S; S.init(M, FF, nblk, bid);
        pg8::EpiScaleBf16<1> E{(b16*)(ws + WS_ACT), FF, (const float*)(ws + WS_SS2), 1.f, lds + TAB_OFF};
        pg8::gemm_phase<pg8::EpiScaleBf16<1>, pg8::StaticOrder, true, true>(lds, g, S, E);
    } SEAM(7);
    if (IN(8)) {
        pg8::Gemm g{(const b16*)(ws + WS_ACT), (const b16*)(ws + WS_WDOWN), nullptr, nullptr, FF};
        pg8::StaticOrder S; S.init(M, DM, nblk, bid);
        if (nblk == 256) {
            pg8::EpiFinal E{(const b16*)(ws + WS_XN), p.out, p.g_final, (unsigned*)(ws + WS_XCH), (unsigned*)(ws + WS_CTL) + CW_PANEL, lds + TAB_OFF};
            pg8::gemm_phase<pg8::EpiFinal, pg8::StaticOrder, true, true>(lds, g, S, E);
        } else {
            pg8::EpiResF E{(const b16*)(ws + WS_XN), p.out, (float*)(ws + WS_SS3)};
            pg8::gemm_phase<pg8::EpiResF, pg8::StaticOrder, true, true>(lds, g, S, E);
        }
    } SEAM(8);
    if (IN(9) && nblk != 256) { final_norm_ss(p.out, (const float*)(ws + WS_SS3), p.g_final, gw, ngw, lane); }
#undef IN
#undef SEAM
}

extern "C" void kernel_launch(void* const* d_in, const int* in_sizes, int n_in, void* d_out, int out_size, void* d_ws, size_t ws_size, hipStream_t stream) {
    static int grid = 0;
    if (grid == 0) {
        if (n_in != 21 || out_size != M * DM || ws_size < WS_END) { fprintf(stderr, "kernel_launch: unexpected shapes (n_in %d out %d ws %zu)\n", n_in, out_size, ws_size); grid = -1; return; }
        int dev = 0, cus = 0, per_cu = 0;
        (void)hipGetDevice(&dev); (void)hipDeviceGetAttribute(&cus, hipDeviceAttributeMultiprocessorCount, dev);
        if (hipFuncSetAttribute((const void*)fwd_kernel, hipFuncAttributeMaxDynamicSharedMemorySize, LDS_BYTES) != hipSuccess) { fprintf(stderr, "kernel_launch: hipFuncSetAttribute failed\n"); grid = -1; return; }
        (void)hipOccupancyMaxActiveBlocksPerMultiprocessor(&per_cu, (const void*)fwd_kernel, NTHR, LDS_BYTES);
        if (per_cu < 1) { fprintf(stderr, "kernel_launch: occupancy query says %d blocks per CU\n", per_cu); per_cu = 1; }
        grid = cus;
    }
    if (grid < 0) return;
    Params p{};
    p.x = (const float*)d_in[0]; p.mem = (const float*)d_in[1]; p.pos = (const int*)d_in[2]; p.g_mix = (const float*)d_in[3]; p.w_in = (const float*)d_in[4];
    p.sinks = (const float*)d_in[5]; p.lq1 = (const float*)d_in[6]; p.lk1 = (const float*)d_in[7]; p.lq2 = (const float*)d_in[8]; p.lk2 = (const float*)d_in[9];
    p.g_diff = (const float*)d_in[10]; p.w_out = (const float*)d_in[11]; p.g_cross = (const float*)d_in[12]; p.g_mem = (const float*)d_in[13]; p.w_cq = (const float*)d_in[14];
    p.w_ckv = (const float*)d_in[15]; p.w_co = (const float*)d_in[16]; p.g_mlp = (const float*)d_in[17]; p.w_up = (const float*)d_in[18]; p.w_down = (const float*)d_in[19]; p.g_final = (const float*)d_in[20];
    p.out = (float*)d_out; p.ws = (unsigned char*)d_ws;
    if (hipMemsetAsync((char*)d_ws + WS_CTL, 0, CTL_ZERO_BYTES, stream) != hipSuccess) { fprintf(stderr, "kernel_launch: hipMemsetAsync of the control words failed\n"); return; }
    p.ph_lo = 0; p.ph_hi = N_PHASES;
    hipLaunchKernelGGL(fwd_kernel, dim3(grid), dim3(NTHR), LDS_BYTES, stream, p);
}
```

```cpp
#define WT_ATT 16
#include <hip/hip_runtime.h>
#include <cstdio>
#include <cstdint>


#define LAS __attribute__((address_space(3)))
typedef unsigned short bf16;
typedef short bf16x8 __attribute__((ext_vector_type(8)));
typedef float f32x4 __attribute__((ext_vector_type(4)));
typedef unsigned u32x4 __attribute__((ext_vector_type(4)));
typedef unsigned u32x2 __attribute__((ext_vector_type(2)));

constexpr int BATCH = 8, SEQ = 4096, M = BATCH * SEQ, DM = 1024, NP = 2304, MEML = 256, MM = BATCH * MEML, FF = 4096;
constexpr int NWAVES = 8, NTHR = NWAVES * 64;
constexpr float EPS = 1e-5f;
constexpr float LOG2E = 1.4426950408889634f;
constexpr float C2 = 0.125f * LOG2E;
constexpr float CQ = 0.0625f * LOG2E;
constexpr int C_QA = 0, C_KA = 512, C_VA = 640, C_QD = 768, C_KD = 1280, C_VD = 1792;

constexpr size_t MiB = 1u << 20;
constexpr size_t WS_CTL = 0;
constexpr size_t WS_WIN = 2 * MiB;
constexpr size_t WS_WOUT = WS_WIN + (size_t)NP * DM * 2;
constexpr size_t WS_WCQ = WS_WOUT + 2 * MiB;
constexpr size_t WS_WCKV = WS_WCQ + 2 * MiB;
constexpr size_t WS_WCO = WS_WCKV + 4 * MiB;
constexpr size_t WS_WUP = WS_WCO + 2 * MiB;
constexpr size_t WS_WDOWN = WS_WUP + 8 * MiB;
constexpr size_t WS_ROPE = 34 * MiB;
constexpr size_t WS_KVM = 42 * MiB;
constexpr size_t WS_MEMN = 50 * MiB;
constexpr size_t WS_SS1 = 54 * MiB, WS_SS2 = 56 * MiB;
constexpr size_t WS_XN = 64 * MiB;
constexpr size_t WS_PROJ = 256 * MiB;
constexpr size_t WS_ATT = 400 * MiB;
constexpr size_t WS_QC = 256 * MiB;
constexpr size_t WS_OC = 320 * MiB;
constexpr size_t WS_ACT = 256 * MiB;
constexpr size_t WS_END = 512 * MiB;
static_assert(WS_WDOWN + 8 * MiB <= WS_ROPE, "weights fit");

struct Params {
    const float *x, *mem; const int* pos;
    const float *g_mix, *w_in, *sinks, *lq1, *lk1, *lq2, *lk2, *g_diff, *w_out, *g_cross, *g_mem, *w_cq, *w_ckv, *w_co, *g_mlp, *w_up, *w_down, *g_final;
    float* out; unsigned char* ws; int ph_lo, ph_hi;
};

__device__ __forceinline__ unsigned f2bf(float f) { unsigned u = __builtin_bit_cast(unsigned, f); return (u + 0x7fffu + ((u >> 16) & 1u)) >> 16; }
__device__ __forceinline__ unsigned pk2(float lo, float hi) { return f2bf(lo) | (f2bf(hi) << 16); }
__device__ __forceinline__ float bf2f(unsigned h) { return __builtin_bit_cast(float, h << 16); }
__device__ __forceinline__ float bflo(unsigned w) { return __builtin_bit_cast(float, w << 16); }
__device__ __forceinline__ float bfhi(unsigned w) { return __builtin_bit_cast(float, w & 0xffff0000u); }
__device__ __forceinline__ float wave_sum(float v) {
#pragma unroll
    for (int o = 1; o < 64; o <<= 1) v += __shfl_xor(v, o);
    return v;
}
__device__ __forceinline__ float wave_max(float v) {
#pragma unroll
    for (int o = 1; o < 64; o <<= 1) v = fmaxf(v, __shfl_xor(v, o));
    return v;
}
__host__ __device__ __forceinline__ bool col_roped(int n) { return n < C_VA || (n >= C_QD && n < C_VD); }
__host__ __device__ __forceinline__ int phys_of_logical(int nl) {
    if (!col_roped(nl)) return nl;
    const int g = nl & ~63, j = nl & 63; return g + ((j & 31) << 1) + (j >> 5);
}
__device__ __forceinline__ float calc_lambda(const Params& p) {
    float a = 0.f, b = 0.f;
    for (int i = 0; i < 64; ++i) { a += p.lq1[i] * p.lk1[i]; b += p.lq2[i] * p.lk2[i]; }
    return __expf(a) - __expf(b) + 0.2f;
}

__device__ const double INV_FREQ[32] = {
    1.0, 0.7498942093324559, 0.5623413251903491, 0.4216965034285822,
    0.31622776601683794, 0.23713737056616552, 0.1778279410038923, 0.1333521432163324,
    0.1, 0.07498942093324558, 0.05623413251903491, 0.042169650342858224,
    0.03162277660168379, 0.023713737056616554, 0.01778279410038923, 0.01333521432163324,
    0.01, 0.007498942093324558, 0.005623413251903491, 0.004216965034285823,
    0.0031622776601683794, 0.0023713737056616554, 0.0017782794100389228, 0.001333521432163324,
    0.001, 0.0007498942093324559, 0.0005623413251903491, 0.00042169650342858224,
    0.00031622776601683794, 0.00023713737056616554, 0.00017782794100389227, 0.0001333521432163324};

__device__ __forceinline__ void sincos_d(double a, float& c, float& s) {
    const double kd = rint(a * 0.63661977236758134308);
    const int k = (int)kd;
    double r = fma(-kd, 1.57079632679489655800e+00, a); r = fma(-kd, 6.12323399573676603587e-17, r);
    const double r2 = r * r;
    const double sp = r * (1.0 + r2 * (-1.0 / 6.0 + r2 * (1.0 / 120.0 + r2 * (-1.0 / 5040.0 + r2 * (1.0 / 362880.0 + r2 * (-1.0 / 39916800.0 + r2 * (1.0 / 6227020800.0)))))));
    const double cp = 1.0 + r2 * (-0.5 + r2 * (1.0 / 24.0 + r2 * (-1.0 / 720.0 + r2 * (1.0 / 40320.0 + r2 * (-1.0 / 3628800.0 + r2 * (1.0 / 479001600.0 + r2 * (-1.0 / 87178291200.0)))))));
    const int q = k & 3;
    const double ss = (q == 0) ? sp : (q == 1) ? cp : (q == 2) ? -sp : -cp;
    const double cc = (q == 0) ? cp : (q == 1) ? -sp : (q == 2) ? -cp : sp;
    c = (float)cc; s = (float)ss;
}

template <bool HASG, bool PERMC>
__device__ __forceinline__ void transpose_item(const float* W, int K, int N, const float* g, bf16* WT, LAS float* scr, int item, int lane) {
    const int nblk = N / 32, kb = item / nblk, nb = item % nblk, k0 = 64 * kb, n0 = 32 * nb;
#pragma unroll 16
    for (int i = 0; i < 32; ++i) { const int kk = 2 * i + (lane >> 5); float v = W[(size_t)(k0 + kk) * N + n0 + (lane & 31)]; if (HASG) v *= g[k0 + kk]; scr[kk * 33 + (lane & 31)] = v; }
    asm volatile("s_waitcnt lgkmcnt(0)" ::: "memory");
    const int c = lane & 7;
#pragma unroll
    for (int j = 0; j < 4; ++j) { const int n = (lane >> 3) + 8 * j; const LAS float* s = scr + (8 * c) * 33 + n;
        u32x4 o; o.x = pk2(s[0 * 33], s[1 * 33]); o.y = pk2(s[2 * 33], s[3 * 33]); o.z = pk2(s[4 * 33], s[5 * 33]); o.w = pk2(s[6 * 33], s[7 * 33]);
        const int nl = n0 + n, np = PERMC ? phys_of_logical(nl) : nl;
        *(u32x4*)(WT + (size_t)np * K + k0 + 8 * c) = o; }
    asm volatile("s_waitcnt lgkmcnt(0)" ::: "memory");
}
__device__ __forceinline__ void rms_row_to_bf16(const float* xrow, const float* g, bf16* orow, int lane) {
    const f32x4* xr = (const f32x4*)xrow + lane;
    f32x4 v[4]; float s = 0.f;
#pragma unroll
    for (int j = 0; j < 4; ++j) { v[j] = xr[64 * j]; s += (v[j].x * v[j].x + v[j].y * v[j].y) + (v[j].z * v[j].z + v[j].w * v[j].w); }
    const float rstd = 1.0f / sqrtf(wave_sum(s) * (1.f / DM) + EPS);
    u32x2* o8 = (u32x2*)orow + lane;
#pragma unroll
    for (int j = 0; j < 4; ++j) {
        f32x4 gg = (f32x4){1.f, 1.f, 1.f, 1.f}; if (g) gg = ((const f32x4*)g)[lane + 64 * j];
        u32x2 w; w.x = pk2(v[j].x * rstd * gg.x, v[j].y * rstd * gg.y); w.y = pk2(v[j].z * rstd * gg.z, v[j].w * rstd * gg.w); o8[64 * j] = w; }
}
__device__ __forceinline__ void p0_prologue(const Params& p, LAS unsigned char* lds, int bid, int nblk, int tid) {
    const int wave = tid >> 6, lane = tid & 63;
    LAS float* scr = (LAS float*)(lds + wave * 8704);
    const int gw = bid * NWAVES + wave, NGW = nblk * NWAVES;
    unsigned char* ws = p.ws;
    constexpr int I_IN = (DM / 64) * (NP / 32), I_SQ = (DM / 64) * (DM / 32), I_KV = (DM / 64) * (2048 / 32), I_UP = (DM / 64) * (FF / 32), I_DN = (FF / 64) * (DM / 32);
    constexpr int NITEMS = I_IN + 3 * I_SQ + I_KV + I_UP + I_DN;
    for (int it = gw; it < NITEMS; it += NGW) {
        int r = it;
        if (r < I_IN) { transpose_item<true, true>(p.w_in, DM, NP, p.g_mix, (bf16*)(ws + WS_WIN), scr, r, lane); continue; } r -= I_IN;
        if (r < I_SQ) { transpose_item<false, false>(p.w_out, DM, DM, nullptr, (bf16*)(ws + WS_WOUT), scr, r, lane); continue; } r -= I_SQ;
        if (r < I_SQ) { transpose_item<true, false>(p.w_cq, DM, DM, p.g_cross, (bf16*)(ws + WS_WCQ), scr, r, lane); continue; } r -= I_SQ;
        if (r < I_KV) { transpose_item<false, false>(p.w_ckv, DM, 2048, nullptr, (bf16*)(ws + WS_WCKV), scr, r, lane); continue; } r -= I_KV;
        if (r < I_SQ) { transpose_item<false, false>(p.w_co, DM, DM, nullptr, (bf16*)(ws + WS_WCO), scr, r, lane); continue; } r -= I_SQ;
        if (r < I_UP) { transpose_item<true, false>(p.w_up, DM, FF, p.g_mlp, (bf16*)(ws + WS_WUP), scr, r, lane); continue; } r -= I_UP;
        transpose_item<false, false>(p.w_down, FF, DM, nullptr, (bf16*)(ws + WS_WDOWN), scr, r, lane);
    }
    for (int m = gw * 2; m < M; m += NGW * 2) {
        const f32x4* x0 = (const f32x4*)(p.x + (size_t)m * DM) + lane; const f32x4* x1 = x0 + DM / 4;
        f32x4 v0[4], v1[4]; float s0 = 0.f, s1 = 0.f;
#pragma unroll
        for (int j = 0; j < 4; ++j) { v0[j] = x0[64 * j]; v1[j] = x1[64 * j]; }
#pragma unroll
        for (int j = 0; j < 4; ++j) { s0 += (v0[j].x * v0[j].x + v0[j].y * v0[j].y) + (v0[j].z * v0[j].z + v0[j].w * v0[j].w); s1 += (v1[j].x * v1[j].x + v1[j].y * v1[j].y) + (v1[j].z * v1[j].z + v1[j].w * v1[j].w); }
#pragma unroll
        for (int o = 1; o < 64; o <<= 1) { s0 += __shfl_xor(s0, o); s1 += __shfl_xor(s1, o); }
        const float r0 = 1.0f / sqrtf(s0 * (1.f / DM) + EPS), r1 = 1.0f / sqrtf(s1 * (1.f / DM) + EPS);
        u32x2* o0 = (u32x2*)((bf16*)(ws + WS_XN) + (size_t)m * DM) + lane; u32x2* o1 = o0 + DM / 4;
#pragma unroll
        for (int j = 0; j < 4; ++j) { u32x2 w; w.x = pk2(v0[j].x * r0, v0[j].y * r0); w.y = pk2(v0[j].z * r0, v0[j].w * r0); o0[64 * j] = w;
            u32x2 z; z.x = pk2(v1[j].x * r1, v1[j].y * r1); z.y = pk2(v1[j].z * r1, v1[j].w * r1); o1[64 * j] = z; }
    }
    for (int m = gw; m < MM; m += NGW) rms_row_to_bf16(p.mem + (size_t)m * DM, p.g_mem, (bf16*)(ws + WS_MEMN) + (size_t)m * DM, lane);
    float2* rope = (float2*)(ws + WS_ROPE);
    for (int i = bid * NTHR + tid; i < M * 32; i += nblk * NTHR) {
        const int row = i >> 5, d = i & 31; float c, s; sincos_d((double)p.pos[row] * INV_FREQ[d], c, s); rope[i] = make_float2(c, s); }
}

namespace pg8 {
#define PG8_LAS __attribute__((address_space(3)))
typedef unsigned short bf16_t;
typedef short bf16x8 __attribute__((ext_vector_type(8)));
typedef float f32x4 __attribute__((ext_vector_type(4)));
typedef unsigned u32x4 __attribute__((ext_vector_type(4)));
typedef unsigned u32x2 __attribute__((ext_vector_type(2)));
constexpr int BM = 256, BK = 64, HALF = 128, HTB = HALF * BK * 2  , STAGE_BYTES = 8 * HTB, NXCD = 8, WGM = 8;

__host__ __device__ __forceinline__ int lds_byte(int r, int c) { const int st = (r >> 4) * 2 + (c >> 5), rr = r & 15, cc = c & 31, ob = rr * 64 + cc * 2; return st * 1024 + (ob ^ (((ob >> 9) & 1) << 5)); }
__host__ __device__ __forceinline__ void stage_rc(int b, int& R, int& C) { const int st = b / 1024, sb = b % 1024, swz = sb ^ (((sb >> 9) & 1) << 5); R = (st >> 1) * 16 + swz / 64; C = (st & 1) * 32 + (swz % 64) / 2; }
__host__ __device__ __forceinline__ int perm32(int rho) { const int n = rho >> 4, i = rho & 15; return 8 * (i >> 2) + 4 * n + (i & 3); }

struct Unit { int pm, pn, alt; };
struct Gemm { const bf16_t* A; const bf16_t* Bt; const bf16_t* A2; const bf16_t* Bt2; int K; int ablk; };

struct StaticOrder {
    int nM, nN, nwg, G, c;
    __host__ __device__ void init(int M_, int N_, int G_, int c_) { nM = M_ / BM; nN = N_ / BM; nwg = nM * nN; G = G_; c = c_; }
    __host__ __device__ bool map(long L, Unit& u) const {
        if (L >= nwg) return false;
        int wgid = (int)L; { const int q = nwg / NXCD, r = nwg % NXCD, xcd = wgid % NXCD, off = wgid / NXCD; wgid = (xcd < r ? xcd * (q + 1) : r * (q + 1) + (xcd - r) * q) + off; }
        const int nig = WGM * nN, gid = wgid / nig, fm = gid * WGM, gsz = (nM - fm) < WGM ? (nM - fm) : WGM;
        u.pm = fm + ((wgid % nig) % gsz); u.pn = (wgid % nig) / gsz; u.alt = 0; return true;
    }
    __host__ __device__ bool next(int i, Unit& u) const { return map((long)i * G + c, u); }
    __device__ __forceinline__ void a_ready(const Unit&) const {}
    __device__ __forceinline__ void done(const Unit&) const {}
};
struct OneUnit {
    Unit u;
    __device__ __forceinline__ bool next(int i, Unit& o) const { if (i) return false; o = u; return true; }
    __device__ __forceinline__ void a_ready(const Unit&) const {}
    __device__ __forceinline__ void done(const Unit&) const {}
};
struct TwoOrder : StaticOrder {
    int n2M, n2N;
    __host__ __device__ bool next(int i, Unit& u) const {
        const long L = (long)i * G + c;
        if (L < nwg) return map(L, u);
        const int r = (int)(L - nwg); if (r >= n2M * n2N) return false;
        u.pm = r % n2M; u.pn = r / n2M; u.alt = 1; return true;
    }
};
typedef __bf16 cvt_bf2 __attribute__((ext_vector_type(2))); typedef float cvt_f2 __attribute__((ext_vector_type(2)));
__device__ __forceinline__ unsigned cvt_pk_bf16(float lo, float hi) { const cvt_f2 v = {lo, hi}; return __builtin_bit_cast(unsigned, __builtin_convertvector(v, cvt_bf2)); }

__device__ __forceinline__ float rstd_ss(const float* ss, int row) {
    const f32x4* s4 = (const f32x4*)(ss + (size_t)row * 16); float t = 0.f;
#pragma unroll
    for (int i = 0; i < 4; ++i) { const f32x4 v = s4[i]; t += (v.x + v.y) + (v.z + v.w); }
    return 1.0f / sqrtf(t * (1.f / DM) + EPS);
}
struct EpiProj {
    static constexpr bool PERM = true, AFTER_DRAIN = false;
    bf16_t* proj; bf16_t* kvm; const float* rope;
    __device__ __forceinline__ void operator()(const f32x4 (&acc)[2][2][4][2], const Unit& u, int wr, int wc, int fr, int fq) const {
        const int row0 = u.pm * BM + wr * 64 + fr, col0 = u.pn * BM + wc * 32 + 8 * fq;
        if (u.alt) {
#pragma unroll
            for (int ai = 0; ai < 2; ++ai)
#pragma unroll
                for (int m = 0; m < 4; ++m) { bf16_t* rowp = kvm + (size_t)(row0 + ai * HALF + m * 16) * 2048 + col0;
#pragma unroll
                    for (int bj = 0; bj < 2; ++bj) { const f32x4 v0 = acc[ai][bj][m][0], v1 = acc[ai][bj][m][1];
                        u32x4 w; w.x = cvt_pk_bf16(v0[0], v0[1]); w.y = cvt_pk_bf16(v0[2], v0[3]); w.z = cvt_pk_bf16(v1[0], v1[1]); w.w = cvt_pk_bf16(v1[2], v1[3]);
                        *(u32x4*)(rowp + bj * HALF) = w; } }
            return;
        }
        const int d0 = ((wc & 1) * 32 + 8 * fq) >> 1;
#pragma unroll
        for (int ai = 0; ai < 2; ++ai) {
            f32x4 csa[4], csb[4];
#pragma unroll
            for (int m = 0; m < 4; ++m) { const size_t ro = (size_t)(row0 + ai * HALF + m * 16) * 64 + 2 * d0; csa[m] = *(const f32x4*)(rope + ro); csb[m] = *(const f32x4*)(rope + ro + 4); }
#pragma unroll
            for (int m = 0; m < 4; ++m) { const int row = row0 + ai * HALF + m * 16;
                const f32x4 cs0 = csa[m], cs1 = csb[m];
#pragma unroll
                for (int bj = 0; bj < 2; ++bj) { const int cb = u.pn * BM + bj * HALF;
                    const bool roped = col_roped(cb); const float sc = (cb < C_KA || (cb >= C_QD && cb < C_KD)) ? C2 : 1.f;
                    f32x4 v0 = acc[ai][bj][m][0], v1 = acc[ai][bj][m][1];
                    if (roped) {
                        const f32x4 a = v0, b = v1;
                        v0[0] = a[0] * cs0[0] - a[1] * cs0[1]; v0[1] = a[1] * cs0[0] + a[0] * cs0[1];
                        v0[2] = a[2] * cs0[2] - a[3] * cs0[3]; v0[3] = a[3] * cs0[2] + a[2] * cs0[3];
                        v1[0] = b[0] * cs1[0] - b[1] * cs1[1]; v1[1] = b[1] * cs1[0] + b[0] * cs1[1];
                        v1[2] = b[2] * cs1[2] - b[3] * cs1[3]; v1[3] = b[3] * cs1[2] + b[2] * cs1[3];
                    }
                    v0 = v0 * sc; v1 = v1 * sc;
                    u32x4 w; w.x = cvt_pk_bf16(v0[0], v0[1]); w.y = cvt_pk_bf16(v0[2], v0[3]); w.z = cvt_pk_bf16(v1[0], v1[1]); w.w = cvt_pk_bf16(v1[2], v1[3]);
                    *(u32x4*)(proj + (size_t)row * NP + col0 + bj * HALF) = w; } }
        }
    }
};
struct EpiRes {
    static constexpr bool PERM = false, AFTER_DRAIN = false;
    const float* xi; float* xo; bf16_t* xb; float* ss;
    __device__ __forceinline__ void operator()(const f32x4 (&acc)[2][2][4][2], const Unit& u, int wr, int wc, int fr, int fq) const {
        const int row0 = u.pm * BM + wr * 64 + fr, col0 = u.pn * BM + wc * 32 + 4 * fq;
#pragma unroll
        for (int ai = 0; ai < 2; ++ai)
#pragma unroll
            for (int m = 0; m < 4; ++m) { const int row = row0 + ai * HALF + m * 16; const size_t off = (size_t)row * DM + col0; float q = 0.f;
#pragma unroll
                for (int bj = 0; bj < 2; ++bj)
#pragma unroll
                    for (int n = 0; n < 2; ++n) { const size_t c = off + bj * HALF + n * 16; const f32x4 r = *(const f32x4*)(xi + c) + acc[ai][bj][m][n];
                        *(f32x4*)(xo + c) = r; q += (r[0] * r[0] + r[1] * r[1]) + (r[2] * r[2] + r[3] * r[3]);
                        if (xb) { u32x2 w; w.x = cvt_pk_bf16(r[0], r[1]); w.y = cvt_pk_bf16(r[2], r[3]); *(u32x2*)(xb + c) = w; } }
                q += __shfl_xor(q, 16); q += __shfl_xor(q, 32);
                if (fq == 0) ss[(size_t)row * 16 + u.pn * 4 + wc] = q;
                if (m & 1) asm volatile("" ::: "memory"); }
    }
};
template <bool XF> struct EpiResB {
    static constexpr bool PERM = true, AFTER_DRAIN = false;
    const float* xf; const bf16_t* xb_in; bf16_t* xb_out; float* ss;
    __device__ __forceinline__ void operator()(const f32x4 (&acc)[2][2][4][2], const Unit& u, int wr, int wc, int fr, int fq) const {
        const int row0 = u.pm * BM + wr * 64 + fr, col0 = u.pn * BM + wc * 32 + 8 * fq;
        const size_t xblk0 = (size_t)((u.pm * 16 + wr * 4) * 32 + u.pn * 8 + wc) * 512 + fr * 32 + fq * 8;
#define XBLK(ai, m, bj) (xblk0 + (size_t)((((ai) * 8 + (m)) * 32 + (bj) * 4) * 512))
#pragma unroll
        for (int ai = 0; ai < 2; ++ai) {
            u32x4 pre[4][2];
            if (!XF) {
#pragma unroll
                for (int m = 0; m < 4; ++m)
#pragma unroll
                    for (int bj = 0; bj < 2; ++bj) pre[m][bj] = *(const u32x4*)(xb_in + XBLK(ai, m, bj)); }
#pragma unroll
            for (int m = 0; m < 4; ++m) { const int row = row0 + ai * HALF + m * 16; const size_t off = (size_t)row * DM + col0; float q = 0.f;
#pragma unroll
                for (int bj = 0; bj < 2; ++bj) { f32x4 r0, r1;
                    if (XF) { r0 = *(const f32x4*)(xf + off + bj * HALF); r1 = *(const f32x4*)(xf + off + bj * HALF + 4); }
                    else { const u32x4 w = pre[m][bj];
                        r0 = (f32x4){__uint_as_float(w.x << 16), __uint_as_float(w.x & 0xffff0000u), __uint_as_float(w.y << 16), __uint_as_float(w.y & 0xffff0000u)};
                        r1 = (f32x4){__uint_as_float(w.z << 16), __uint_as_float(w.z & 0xffff0000u), __uint_as_float(w.w << 16), __uint_as_float(w.w & 0xffff0000u)}; }
                    r0 = r0 + acc[ai][bj][m][0]; r1 = r1 + acc[ai][bj][m][1];
                    q += ((r0[0] * r0[0] + r0[1] * r0[1]) + (r0[2] * r0[2] + r0[3] * r0[3])) + ((r1[0] * r1[0] + r1[1] * r1[1]) + (r1[2] * r1[2] + r1[3] * r1[3]));
                    u32x4 w; w.x = cvt_pk_bf16(r0[0], r0[1]); w.y = cvt_pk_bf16(r0[2], r0[3]); w.z = cvt_pk_bf16(r1[0], r1[1]); w.w = cvt_pk_bf16(r1[2], r1[3]);
                    *(u32x4*)(xb_out + XBLK(ai, m, bj)) = w; }
                q += __shfl_xor(q, 16); q += __shfl_xor(q, 32);
                if (fq == 0) ss[(size_t)row * 16 + u.pn * 4 + wc] = q; }
            asm volatile("" ::: "memory");
        }
    }
};
#undef XBLK
struct EpiResF {
    static constexpr bool PERM = false, AFTER_DRAIN = false;
    const bf16_t* xb; float* xo; float* ss;
    __device__ __forceinline__ void operator()(const f32x4 (&acc)[2][2][4][2], const Unit& u, int wr, int wc, int fr, int fq) const {
        const int row0 = u.pm * BM + wr * 64 + fr, col0 = u.pn * BM + wc * 32 + 4 * fq;
#pragma unroll
        for (int ai = 0; ai < 2; ++ai)
#pragma unroll
            for (int m = 0; m < 4; ++m) { const int row = row0 + ai * HALF + m * 16; const size_t off = (size_t)row * DM + col0; float q = 0.f;
#pragma unroll
                for (int bj = 0; bj < 2; ++bj)
#pragma unroll
                    for (int n = 0; n < 2; ++n) { const size_t c = off + bj * HALF + n * 16; const u32x2 w = *(const u32x2*)(xb + ((size_t)(((row >> 4) * 32) + u.pn * 8 + wc + bj * 4) * 512 + (row & 15) * 32 + 4 * fq + n * 16));
                        const f32x4 r = (f32x4){__uint_as_float(w.x << 16), __uint_as_float(w.x & 0xffff0000u), __uint_as_float(w.y << 16), __uint_as_float(w.y & 0xffff0000u)} + acc[ai][bj][m][n];
                        *(f32x4*)(xo + c) = r; q += (r[0] * r[0] + r[1] * r[1]) + (r[2] * r[2] + r[3] * r[3]); }
                q += __shfl_xor(q, 16); q += __shfl_xor(q, 32);
                if (fq == 0) ss[(size_t)row * 16 + u.pn * 4 + wc] = q;
                if (m & 1) asm volatile("" ::: "memory"); }
    }
};
struct EpiFinal {
    static constexpr bool PERM = false, AFTER_DRAIN = false;
    const bf16_t* xb; float* out; const float* g; unsigned* xbuf; unsigned* cnt; PG8_LAS unsigned char* tab;
    __device__ __forceinline__ void operator()(f32x4 (&acc)[2][2][4][2], const Unit& u, int wr, int wc, int fr, int fq) const {
        const int tid = threadIdx.x, lane = tid & 63, wid = __builtin_amdgcn_readfirstlane(tid >> 6);
        PG8_LAS float* P = (PG8_LAS float*)tab; PG8_LAS float* S = (PG8_LAS float*)(tab + 4096);
        const int col0 = u.pn * BM + wc * 32 + 4 * fq;
#pragma unroll
        for (int ai = 0; ai < 2; ++ai)
#pragma unroll
            for (int m = 0; m < 4; ++m) { const int rl = ai * HALF + wr * 64 + m * 16 + fr; const size_t off = (size_t)(u.pm * BM + rl) * DM + col0; float q = 0.f;
#pragma unroll
                for (int bj = 0; bj < 2; ++bj)
#pragma unroll
                    for (int n = 0; n < 2; ++n) { const u32x2 w = *(const u32x2*)(xb + ((size_t)((u.pm * 16 + ai * 8 + wr * 4 + m) * 32 + u.pn * 8 + wc + bj * 4) * 512 + fr * 32 + 4 * fq + n * 16));
                        const f32x4 r = (f32x4){__uint_as_float(w.x << 16), __uint_as_float(w.x & 0xffff0000u), __uint_as_float(w.y << 16), __uint_as_float(w.y & 0xffff0000u)} + acc[ai][bj][m][n];
                        acc[ai][bj][m][n] = r; q += (r[0] * r[0] + r[1] * r[1]) + (r[2] * r[2] + r[3] * r[3]); }
                q += __shfl_xor(q, 16); q += __shfl_xor(q, 32);
                if (fq == 0) P[rl * 4 + wc] = q;
                if (m & 1) asm volatile("" ::: "memory"); }
        asm volatile("s_waitcnt lgkmcnt(0)" ::: "memory"); __builtin_amdgcn_s_barrier(); asm volatile("" ::: "memory");
        unsigned* slot = xbuf + ((size_t)(u.pm * BM + (tid & 255)) * 4);
        if (tid < 256) { const f32x4 a = *(const PG8_LAS f32x4*)(P + tid * 4);
            __hip_atomic_store(slot + u.pn, __float_as_uint((a[0] + a[1]) + (a[2] + a[3])), __ATOMIC_RELAXED, __HIP_MEMORY_SCOPE_AGENT); }
        asm volatile("s_waitcnt vmcnt(0)" ::: "memory");
        if (tid < 256 && lane == 0) __hip_atomic_fetch_add(cnt + 64 * u.pm, 1u, __ATOMIC_RELAXED, __HIP_MEMORY_SCOPE_AGENT);
        if (wid == 0) {
            unsigned sp = 0;
            while ((unsigned)__builtin_amdgcn_readfirstlane(__hip_atomic_load(cnt + 64 * u.pm, __ATOMIC_RELAXED, __HIP_MEMORY_SCOPE_AGENT)) < 16u) { __builtin_amdgcn_s_sleep(2); if (++sp > (1u << 22)) break; }
            __builtin_amdgcn_fence(__ATOMIC_ACQUIRE, "agent");
        }
        asm volatile("s_waitcnt vmcnt(0) lgkmcnt(0)" ::: "memory"); __builtin_amdgcn_s_barrier(); asm volatile("" ::: "memory");
        if (tid < 256) { float t = 0.f;
#pragma unroll
            for (int k = 0; k < 4; ++k) t += __uint_as_float(__hip_atomic_load(slot + k, __ATOMIC_RELAXED, __HIP_MEMORY_SCOPE_AGENT));
            S[tid] = 1.0f / sqrtf(t * (1.f / DM) + EPS); }
        asm volatile("s_waitcnt lgkmcnt(0)" ::: "memory"); __builtin_amdgcn_s_barrier(); asm volatile("" ::: "memory");
        f32x4 gg[2][2];
#pragma unroll
        for (int bj = 0; bj < 2; ++bj)
#pragma unroll
            for (int n = 0; n < 2; ++n) gg[bj][n] = *(const f32x4*)(g + col0 + bj * HALF + n * 16);
#pragma unroll
        for (int ai = 0; ai < 2; ++ai)
#pragma unroll
            for (int m = 0; m < 4; ++m) { const int rl = ai * HALF + wr * 64 + m * 16 + fr; const size_t off = (size_t)(u.pm * BM + rl) * DM + col0; const float rs = S[rl];
#pragma unroll
                for (int bj = 0; bj < 2; ++bj)
#pragma unroll
                    for (int n = 0; n < 2; ++n) *(f32x4*)(out + off + bj * HALF + n * 16) = acc[ai][bj][m][n] * rs * gg[bj][n]; }
    }
};
template <int ACT> struct EpiScaleBf16 {
    static constexpr bool PERM = true, AFTER_DRAIN = false;
    bf16_t* O; int ldc; const float* ss; float mul; PG8_LAS unsigned char* tab;
    __device__ __forceinline__ void operator()(const f32x4 (&acc)[2][2][4][2], const Unit& u, int wr, int wc, int fr, int fq) const {
        const int tid = threadIdx.x; PG8_LAS float* S = (PG8_LAS float*)tab;
        if (tid < 256) S[tid] = rstd_ss(ss, u.pm * BM + tid) * mul;
        asm volatile("s_waitcnt lgkmcnt(0)" ::: "memory"); __builtin_amdgcn_s_barrier(); asm volatile("" ::: "memory");
        const int rl0 = wr * 64 + fr, col0 = u.pn * BM + wc * 32 + 8 * fq;
#pragma unroll
        for (int ai = 0; ai < 2; ++ai)
#pragma unroll
            for (int m = 0; m < 4; ++m) { const int rl = rl0 + ai * HALF + m * 16; const float rs = S[rl];
                bf16_t* rowp = ACT == 1 ? O + ((size_t)((u.pm * 16 + wr * 4 + ai * 8 + m) * (ldc >> 5) + u.pn * 8 + wc) * 512 + fr * 32 + fq * 8) : O + (size_t)(u.pm * BM + rl) * ldc + col0;
#pragma unroll
                for (int bj = 0; bj < 2; ++bj) { f32x4 v0 = acc[ai][bj][m][0] * rs, v1 = acc[ai][bj][m][1] * rs;
                    if (ACT == 1) {
#pragma unroll
                        for (int e = 0; e < 4; ++e) { const float a = fmaxf(v0[e], 0.f), b = fmaxf(v1[e], 0.f); v0[e] = a * a; v1[e] = b * b; } }
                    u32x4 w; w.x = cvt_pk_bf16(v0[0], v0[1]); w.y = cvt_pk_bf16(v0[2], v0[3]); w.z = cvt_pk_bf16(v1[0], v1[1]); w.w = cvt_pk_bf16(v1[2], v1[3]);
                    *(u32x4*)(rowp + (ACT == 1 ? bj * 4 * 512 : bj * HALF)) = w; } }
        __builtin_amdgcn_s_barrier();
    }
};

template <class Epi, class Sched, bool ALIGN_EPI = false, bool SP2 = false>
__device__ __forceinline__ void gemm_phase(PG8_LAS unsigned char* lds, const Gemm g, const Sched& S, const Epi& E) {
    const int tid = threadIdx.x, wid = __builtin_amdgcn_readfirstlane(tid >> 6), lane = tid & 63, wr = wid >> 2, wc = wid & 3, fr = lane & 15, fq = lane >> 4;
    const int K = g.K, nt = K / BK;
    unsigned voffA[2], voffB[2];
#pragma unroll
    for (int i = 0; i < 2; ++i) { int R, C; stage_rc(tid * 16 + i * 8192, R, C); const int Rb = Epi::PERM ? ((R & ~31) + perm32(R & 31)) : R;
        voffA[i] = g.ablk ? (unsigned)(((R >> 4) * (K >> 5) + (C >> 5)) * 1024 + (R & 15) * 64 + (C & 31) * 2) : (unsigned)(R * K + C) * 2u; voffB[i] = (unsigned)(Rb * K + C) * 2u; }
    const size_t kstep = (size_t)(BK * 2);
    const size_t hstep = (size_t)HALF * K * 2;
    const size_t kstepA = g.ablk ? (size_t)2048 : kstep, hstepA = g.ablk ? (size_t)8 * (K >> 5) * 1024 : hstep, tstepA = 2 * hstepA;
    const size_t tstep = 2 * hstep;
    const unsigned ldsw = (unsigned)wid * 1024u;
    const int aoff = lds_byte(wr * 64 + fr, fq * 8), boff = lds_byte(wc * 32 + fr, fq * 8);
#define PG8_SA(b, h) (((b) * 2 + (h)) * HTB)
#define PG8_SB(b, h) ((4 + (b) * 2 + (h)) * HTB)
#define PG8_STAGE(bufoff, gbase, voff) do { _Pragma("unroll") for (int _i = 0; _i < 2; ++_i) \
        __builtin_amdgcn_global_load_lds((const unsigned*)((const char*)(gbase) + (voff)[_i]), (PG8_LAS unsigned*)(lds + (bufoff) + ldsw + _i * 8192), 16, 0, 0); } while (0)
#define PG8_LDA(dst, b, h) do { _Pragma("unroll") for (int m = 0; m < 4; ++m) _Pragma("unroll") for (int k = 0; k < 2; ++k) dst[m][k] = *(const PG8_LAS bf16x8*)(lds + PG8_SA(b, h) + aoff + m * 2048 + k * 1024); } while (0)
#define PG8_LDB(dst, b, h) do { _Pragma("unroll") for (int n = 0; n < 2; ++n) _Pragma("unroll") for (int k = 0; k < 2; ++k) dst[n][k] = *(const PG8_LAS bf16x8*)(lds + PG8_SB(b, h) + boff + n * 2048 + k * 1024); } while (0)
#define PG8_MMA(ai, bj, At, Bt) do { __builtin_amdgcn_s_setprio(1); _Pragma("unroll") for (int m = 0; m < 4; ++m) _Pragma("unroll") for (int n = 0; n < 2; ++n) _Pragma("unroll") for (int k = 0; k < 2; ++k) \
        acc[ai][bj][m][n] = __builtin_amdgcn_mfma_f32_16x16x32_bf16(Bt[n][k], At[m][k], acc[ai][bj][m][n], 0, 0, 0); __builtin_amdgcn_s_setprio(0); } while (0)
#define PG8_WAIT_V(n) asm volatile("s_waitcnt vmcnt(" #n ")" ::: "memory")
#define PG8_WAIT_L(n) asm volatile("s_waitcnt lgkmcnt(" #n ")" ::: "memory")
#define PG8_BAR __builtin_amdgcn_s_barrier()
#define PG8_SCHED __builtin_amdgcn_sched_barrier(0)
    Unit cur, nxt; int ui = 0;
    if (!S.next(0, cur)) return;
    f32x4 acc[2][2][4][2];
#pragma unroll
    for (int a = 0; a < 2; ++a)
#pragma unroll
        for (int b = 0; b < 2; ++b)
#pragma unroll
            for (int m = 0; m < 4; ++m)
#pragma unroll
                for (int n = 0; n < 2; ++n) acc[a][b][m][n] = (f32x4){0.f, 0.f, 0.f, 0.f};
    bf16x8 At[4][2], B0[2][2], B1[2][2];
    const char* cA = (const char*)(cur.alt ? g.A2 : g.A) + (size_t)cur.pm * tstepA; const char* cB = (const char*)(cur.alt ? g.Bt2 : g.Bt) + (size_t)cur.pn * tstep;
    S.a_ready(cur);
    if constexpr (SP2) {
        PG8_STAGE(PG8_SB(0, 0), cB, voffB); PG8_STAGE(PG8_SB(0, 1), cB + hstep, voffB); PG8_STAGE(PG8_SA(0, 0), cA, voffA); PG8_STAGE(PG8_SA(0, 1), cA + hstepA, voffA);
        if (wr == 1) PG8_BAR;
        PG8_WAIT_V(2); PG8_BAR;
        PG8_STAGE(PG8_SB(1, 0), cB + kstep, voffB); PG8_STAGE(PG8_SA(1, 0), cA + kstepA, voffA); PG8_STAGE(PG8_SB(1, 1), cB + hstep + kstep, voffB);
        PG8_WAIT_V(6); PG8_BAR;
    } else {
        PG8_STAGE(PG8_SB(0, 0), cB, voffB); PG8_STAGE(PG8_SA(0, 0), cA, voffA); PG8_STAGE(PG8_SB(0, 1), cB + hstep, voffB); PG8_STAGE(PG8_SA(0, 1), cA + hstepA, voffA);
        if (wr == 1) PG8_BAR;
        PG8_WAIT_V(4); PG8_BAR;
        PG8_STAGE(PG8_SB(1, 0), cB + kstep, voffB); PG8_STAGE(PG8_SA(1, 0), cA + kstepA, voffA); PG8_STAGE(PG8_SB(1, 1), cB + hstep + kstep, voffB);
        PG8_WAIT_V(6); PG8_BAR;
    }
    for (;;) {
        const bool has_next = S.next(ui + 1, nxt);
        const char* nA = has_next ? (const char*)(nxt.alt ? g.A2 : g.A) + (size_t)nxt.pm * tstepA : cA; const char* nB = has_next ? (const char*)(nxt.alt ? g.Bt2 : g.Bt) + (size_t)nxt.pn * tstep : cB;
        for (int t = 0; t < nt; t += 2) {
            const bool last = (t == nt - 2);
            const char* a1 = cA + (size_t)(t + 1) * kstepA;
            const char* a2 = last ? nA : cA + (size_t)(t + 2) * kstepA; const char* b2 = last ? nB : cB + (size_t)(t + 2) * kstep;
            const char* a3 = a2 + kstepA; const char* b3 = b2 + kstep;
            if (last && has_next) S.a_ready(nxt);
            if constexpr (SP2) {
            PG8_LDB(B0, 0, 0); PG8_LDB(B1, 0, 1); PG8_SCHED; PG8_LDA(At, 0, 0); PG8_STAGE(PG8_SA(1, 1), a1 + hstepA, voffA);
            PG8_WAIT_V(8); PG8_WAIT_L(0); PG8_BAR; PG8_MMA(0, 0, At, B0); PG8_MMA(0, 1, At, B1); PG8_BAR; PG8_SCHED;
            PG8_LDA(At, 0, 1); PG8_STAGE(PG8_SB(0, 0), b2, voffB); PG8_STAGE(PG8_SB(0, 1), b2 + hstep, voffB); PG8_STAGE(PG8_SA(0, 0), a2, voffA);
            PG8_WAIT_V(8); PG8_WAIT_L(0); PG8_BAR; PG8_MMA(1, 0, At, B0); PG8_MMA(1, 1, At, B1); PG8_BAR; PG8_SCHED;
            PG8_LDB(B0, 1, 0); PG8_LDB(B1, 1, 1); PG8_SCHED; PG8_LDA(At, 1, 0); PG8_STAGE(PG8_SA(0, 1), a2 + hstepA, voffA);
            PG8_WAIT_V(8); PG8_WAIT_L(0); PG8_BAR; PG8_MMA(0, 0, At, B0); PG8_MMA(0, 1, At, B1); PG8_BAR; PG8_SCHED;
            PG8_LDA(At, 1, 1); PG8_STAGE(PG8_SB(1, 0), b3, voffB); PG8_STAGE(PG8_SB(1, 1), b3 + hstep, voffB); PG8_STAGE(PG8_SA(1, 0), a3, voffA);
            PG8_WAIT_V(8); PG8_WAIT_L(0); PG8_BAR; PG8_MMA(1, 0, At, B0); PG8_MMA(1, 1, At, B1); PG8_BAR; PG8_SCHED;
            } else {
            PG8_LDB(B0, 0, 0); PG8_SCHED; PG8_LDA(At, 0, 0); PG8_STAGE(PG8_SA(1, 1), a1 + hstepA, voffA);
            PG8_WAIT_L(8); PG8_BAR; PG8_WAIT_L(0); PG8_MMA(0, 0, At, B0); PG8_BAR; PG8_SCHED;
            PG8_LDB(B1, 0, 1); PG8_STAGE(PG8_SB(0, 0), b2, voffB);
            PG8_BAR; PG8_WAIT_L(0); PG8_MMA(0, 1, At, B1); PG8_BAR;
            PG8_LDA(At, 0, 1); PG8_STAGE(PG8_SA(0, 0), a2, voffA);
            PG8_BAR; PG8_WAIT_L(0); PG8_MMA(1, 0, At, B0); PG8_BAR; PG8_SCHED;
            PG8_STAGE(PG8_SB(0, 1), b2 + hstep, voffB);
            PG8_WAIT_V(6); PG8_BAR; PG8_MMA(1, 1, At, B1); PG8_BAR;
            PG8_LDB(B0, 1, 0); PG8_SCHED; PG8_LDA(At, 1, 0); PG8_STAGE(PG8_SA(0, 1), a2 + hstepA, voffA);
            PG8_WAIT_L(8); PG8_BAR; PG8_WAIT_L(0); PG8_MMA(0, 0, At, B0); PG8_BAR; PG8_SCHED;
            PG8_LDB(B1, 1, 1); PG8_STAGE(PG8_SB(1, 0), b3, voffB);
            PG8_BAR; PG8_WAIT_L(0); PG8_MMA(0, 1, At, B1); PG8_BAR;
            PG8_LDA(At, 1, 1); PG8_STAGE(PG8_SA(1, 0), a3, voffA);
            PG8_BAR; PG8_WAIT_L(0); PG8_MMA(1, 0, At, B0); PG8_BAR; PG8_SCHED;
            PG8_STAGE(PG8_SB(1, 1), b3 + hstep, voffB);
            PG8_WAIT_V(6); PG8_BAR; PG8_MMA(1, 1, At, B1); PG8_BAR;
            }
        }
        if constexpr (ALIGN_EPI) { if (wr == 0) PG8_BAR; }
        if constexpr (!Epi::AFTER_DRAIN) { E(acc, cur, wr, wc, fr, fq); S.done(cur); }
        if (!has_next) break;
#pragma unroll
        for (int a = 0; a < 2; ++a)
#pragma unroll
            for (int b = 0; b < 2; ++b)
#pragma unroll
                for (int m = 0; m < 4; ++m)
#pragma unroll
                    for (int n = 0; n < 2; ++n) acc[a][b][m][n] = (f32x4){0.f, 0.f, 0.f, 0.f};
        cur = nxt; cA = nA; cB = nB; ++ui;
        if constexpr (ALIGN_EPI) { if (wr == 1) PG8_BAR; }
    }
    PG8_WAIT_V(0);
    if constexpr (!ALIGN_EPI) { if (wr == 0) PG8_BAR; }
    PG8_BAR;
    if constexpr (Epi::AFTER_DRAIN) { E.fused(acc, cur, wr, wc, fr, fq, lds, wid, lane); S.done(cur); }
#undef PG8_SA
#undef PG8_SB
#undef PG8_STAGE
#undef PG8_LDA
#undef PG8_LDB
#undef PG8_MMA
#undef PG8_WAIT_V
#undef PG8_WAIT_L
#undef PG8_BAR
#undef PG8_SCHED
}
}
namespace fa {
typedef short bf16x8 __attribute__((ext_vector_type(8)));
typedef short s16x4 __attribute__((ext_vector_type(4)));
typedef float f32x16 __attribute__((ext_vector_type(16)));
typedef float f32x4 __attribute__((ext_vector_type(4)));
typedef unsigned u32x4 __attribute__((ext_vector_type(4)));
constexpr int NW = 8, QBLK = 32, KVBLK = 64;
constexpr float THR = 8.f;
#define FA_SBAR() __builtin_amdgcn_sched_barrier(0)
#define FA_VMW() asm volatile("s_waitcnt vmcnt(0)" ::: "memory")
__device__ __forceinline__ int crow(int r, int hi) { return (r & 3) + 8 * (r >> 2) + 4 * hi; }
typedef __bf16 cvt_bf2a __attribute__((ext_vector_type(2))); typedef float cvt_f2a __attribute__((ext_vector_type(2)));
__device__ __forceinline__ unsigned cvtpk(float lo, float hi) { const cvt_f2a v = {lo, hi}; return __builtin_bit_cast(unsigned, __builtin_convertvector(v, cvt_bf2a)); }

template <int NDQ> __device__ __forceinline__ int kswz(int row, int c) {
    if (NDQ == 4) return row * 128 + ((c ^ ((row >> 1) & 7)) << 4);
    else return row * (NDQ * 32) + ((c ^ (row & 15)) << 4);
}
template <int NDVT> __device__ __forceinline__ int v_st(int k, int c) { const int kk = (k & ~0xC) | ((k & 4) << 1) | ((k & 8) >> 1); return ((kk >> 3) * NDVT + (c >> 5)) * 512 + ((kk & 7) * 32 + (c & 31)) * 2; }
__device__ __forceinline__ int v_rd_base(int lane) { return ((lane & 3) << 3) | (((lane >> 2) & 3) << 6) | (((lane >> 4) & 1) << 5) | (((lane >> 5) & 1) << 8); }

__device__ __forceinline__ void mask_tile(f32x16& p0, f32x16& p1, int dq, unsigned W) {
    const float NEG = -__builtin_inff();
#pragma unroll
    for (int r = 0; r < 16; ++r) { const int c = (r & 3) + 8 * (r >> 2);
        if ((unsigned)(dq - c) >= W) p0[r] = NEG;
        if ((unsigned)(dq - c - 32) >= W) p1[r] = NEG; }
}
__device__ __forceinline__ void partialSM(f32x16& p0, f32x16& p1, float& m_reg, float& alpha) {
    float pmax = p0[0];
#pragma unroll
    for (int r = 1; r < 16; ++r) pmax = fmaxf(pmax, p0[r]);
#pragma unroll
    for (int r = 0; r < 16; ++r) pmax = fmaxf(pmax, p1[r]);
    { auto rr = __builtin_amdgcn_permlane32_swap(__float_as_uint(pmax), __float_as_uint(pmax), false, false); pmax = fmaxf(__uint_as_float(rr[0]), __uint_as_float(rr[1])); }
    float mn;
    if (__builtin_expect(__all((pmax - m_reg) <= THR), 1)) { mn = m_reg; alpha = 1.f; }
    else { mn = fmaxf(m_reg, pmax); alpha = __builtin_amdgcn_exp2f(m_reg - mn); m_reg = mn; }
#pragma unroll
    for (int r = 0; r < 16; ++r) p0[r] = p0[r] - mn;
#pragma unroll
    for (int r = 0; r < 16; ++r) p1[r] = p1[r] - mn;
#pragma unroll
    for (int r = 0; r < 16; ++r) p0[r] = __builtin_amdgcn_exp2f(p0[r]);
}
__device__ __forceinline__ void finishSM(f32x16& p0, f32x16& p1, float alpha, float& l_reg, bf16x8& pa0, bf16x8& pa1, bf16x8& pa2, bf16x8& pa3) {
#pragma unroll
    for (int r = 0; r < 16; ++r) p1[r] = __builtin_amdgcn_exp2f(p1[r]);
    float ps = 0.f;
#pragma unroll
    for (int r = 0; r < 16; ++r) ps += p0[r];
#pragma unroll
    for (int r = 0; r < 16; ++r) ps += p1[r];
    { auto rr = __builtin_amdgcn_permlane32_swap(__float_as_uint(ps), __float_as_uint(ps), false, false); ps = __uint_as_float(rr[0]) + __uint_as_float(rr[1]); }
    l_reg = l_reg * alpha + ps;
#define FA_PK4(P, B_, OUT) do { unsigned a0 = cvtpk(P[B_ + 0], P[B_ + 1]), a1 = cvtpk(P[B_ + 2], P[B_ + 3]); unsigned b0 = cvtpk(P[B_ + 4], P[B_ + 5]), b1 = cvtpk(P[B_ + 6], P[B_ + 7]); \
        auto r0 = __builtin_amdgcn_permlane32_swap(a0, b0, false, false); auto r1 = __builtin_amdgcn_permlane32_swap(a1, b1, false, false); \
        u32x4 w = {r0[0], r1[0], r0[1], r1[1]}; OUT = *reinterpret_cast<bf16x8*>(&w); } while (0)
    FA_PK4(p0, 0, pa0); FA_PK4(p0, 8, pa1); FA_PK4(p1, 0, pa2); FA_PK4(p1, 8, pa3);
#undef FA_PK4
}
template <int NDQ>
__device__ __forceinline__ void qkt(f32x16& p0, f32x16& p1, const char* Kb, int r32, int hi, const bf16x8* qr) {
    p0 = f32x16{}; p1 = f32x16{};
    constexpr int NA = NDQ < 8 ? NDQ : 8;
    const char* kb[NA];
#pragma unroll
    for (int dd = 0; dd < NA; ++dd) kb[dd] = Kb + kswz<NDQ>(r32, 2 * dd + hi);
#pragma unroll
    for (int d0 = 0; d0 < NDQ; ++d0) { const char* a = kb[d0 & (NA - 1)] + (d0 >> 3) * 256;
        const bf16x8 b0 = *reinterpret_cast<const bf16x8*>(a);
        const bf16x8 b1 = *reinterpret_cast<const bf16x8*>(a + 32 * NDQ * 32);
        p0 = __builtin_amdgcn_mfma_f32_32x32x16_bf16(b0, qr[d0], p0, 0, 0, 0);
        p1 = __builtin_amdgcn_mfma_f32_32x32x16_bf16(b1, qr[d0], p1, 0, 0, 0); }
}
template <int NDVT, int NDV>
__device__ __forceinline__ void pv_tile(f32x16* o, int vb, bf16x8 pa0, bf16x8 pa1, bf16x8 pa2, bf16x8 pa3) {
#define FA_TRRD(dst, off) asm volatile("ds_read_b64_tr_b16 %0, %1 offset:%2" : "=&v"(dst) : "v"(vb), "i"(off) : "memory")
#define FA_PV_D0(d0) do { s16x4 l0, l1, l2, l3, h0, h1, h2, h3; constexpr int b_ = (d0) * 512, ks_ = 2 * NDVT * 512, hf_ = NDVT * 512; \
        FA_TRRD(l0, b_); FA_TRRD(h0, b_ + hf_); FA_TRRD(l1, b_ + ks_); FA_TRRD(h1, b_ + ks_ + hf_); FA_TRRD(l2, b_ + 2 * ks_); FA_TRRD(h2, b_ + 2 * ks_ + hf_); FA_TRRD(l3, b_ + 3 * ks_); FA_TRRD(h3, b_ + 3 * ks_ + hf_); \
        asm volatile("s_waitcnt lgkmcnt(0)" ::: "memory"); FA_SBAR(); \
        o[d0] = __builtin_amdgcn_mfma_f32_32x32x16_bf16(pa0, (bf16x8){l0[0], l0[1], l0[2], l0[3], h0[0], h0[1], h0[2], h0[3]}, o[d0], 0, 0, 0); \
        o[d0] = __builtin_amdgcn_mfma_f32_32x32x16_bf16(pa1, (bf16x8){l1[0], l1[1], l1[2], l1[3], h1[0], h1[1], h1[2], h1[3]}, o[d0], 0, 0, 0); \
        o[d0] = __builtin_amdgcn_mfma_f32_32x32x16_bf16(pa2, (bf16x8){l2[0], l2[1], l2[2], l2[3], h2[0], h2[1], h2[2], h2[3]}, o[d0], 0, 0, 0); \
        o[d0] = __builtin_amdgcn_mfma_f32_32x32x16_bf16(pa3, (bf16x8){l3[0], l3[1], l3[2], l3[3], h3[0], h3[1], h3[2], h3[3]}, o[d0], 0, 0, 0); } while (0)
    FA_PV_D0(0); if constexpr (NDV > 1) FA_PV_D0(1); if constexpr (NDV > 2) FA_PV_D0(2); if constexpr (NDV > 3) FA_PV_D0(3);
#undef FA_PV_D0
#undef FA_TRRD
}

template <int NDQ, int NDVT, int NDV>
struct Core {
    static constexpr int KROW = NDQ * 32, SHM_K = 64 * KROW, SHM_V = 64 * NDVT * 64, NKL = NDQ / 4, NVL = NDVT / 2, LDS_NEED = 2 * SHM_V + 2 * SHM_K + NW * 256;
    static_assert(NKL >= 1 && NVL >= 1, "tile too small for 512 staging threads");
    __device__ __forceinline__ static void run(f32x16 (&o)[NDV], float& m_reg, float& l_reg, const bf16* Qw, int ldq, const bf16* Kg, const bf16* Vg, int ldk,
                                               int j_lo, int j_hi, int qlo, int W, char* lds, int vdoff) {
        int tid = threadIdx.x; asm volatile("" : "+v"(tid));
        const int wid = __builtin_amdgcn_readfirstlane(tid >> 6), lane = tid & 63, r32 = lane & 31, hi = lane >> 5;
        const int NT = j_hi - j_lo, qm = qlo + r32 - 4 * hi;
        char* V_lds = lds; char* K_lds = lds + 2 * SHM_V;
        float* wsf = (float*)(lds + 2 * SHM_V + 2 * SHM_K) + wid * 64; float* al_l = wsf + 32;
        m_reg = -1e30f; l_reg = 0.f;
#pragma unroll
        for (int d = 0; d < NDV; ++d) o[d] = f32x16{};
        constexpr int KCH = 2 * NDQ, KRS = 512 / KCH, VCH = 4 * NDVT, VRS = 512 / VCH;
        const int krow0 = tid / KCH, kch = tid % KCH, vrow0 = tid / VCH, vcol = (tid % VCH) * 8;
        int kws[NKL], vws[NVL];
#pragma unroll
        for (int i = 0; i < NKL; ++i) kws[i] = kswz<NDQ>(krow0 + i * KRS, kch);
#pragma unroll
        for (int i = 0; i < NVL; ++i) vws[i] = v_st<NDVT>(vrow0 + i * VRS, vcol);
        const bf16* kgp = Kg + (size_t)krow0 * ldk + kch * 8; const bf16* vgp = Vg + (size_t)vrow0 * ldk + vcol;
        bf16x8 sk[NKL], sv[NVL];
        const int vb0 = (int)(uintptr_t)V_lds + v_rd_base(lane) + vdoff * 512;
#define FA_SLOAD(t) do { const size_t ro_ = (size_t)((j_lo + (t)) * KVBLK) * ldk; \
        _Pragma("unroll") for (int i_ = 0; i_ < NVL; ++i_) sv[i_] = *reinterpret_cast<const bf16x8*>(vgp + ro_ + (size_t)(i_ * VRS) * ldk); \
        _Pragma("unroll") for (int i_ = 0; i_ < NKL; ++i_) sk[i_] = *reinterpret_cast<const bf16x8*>(kgp + ro_ + (size_t)(i_ * KRS) * ldk); } while (0)
#define FA_SWRITE(bf) do { _Pragma("unroll") for (int i_ = 0; i_ < NVL; ++i_) *reinterpret_cast<bf16x8*>(V_lds + (bf) * SHM_V + vws[i_]) = sv[i_]; \
        _Pragma("unroll") for (int i_ = 0; i_ < NKL; ++i_) *reinterpret_cast<bf16x8*>(K_lds + (bf) * SHM_K + kws[i_]) = sk[i_]; } while (0)
#define FA_RESC(a) do { if (__any((a) < 1.f)) { if (hi == 0) al_l[r32] = (a); asm volatile("s_waitcnt lgkmcnt(0)" ::: "memory"); \
        _Pragma("unroll") for (int d_ = 0; d_ < NDV; ++d_) _Pragma("unroll") for (int r = 0; r < 16; ++r) o[d_][r] *= al_l[crow(r, hi)]; } } while (0)
#define FA_KBASE(t) ((j_lo + (t)) * KVBLK)
#define FA_MASKT(P0_, P1_, t) do { const int kb_ = FA_KBASE(t); if (kb_ + KVBLK - 1 > qlo || kb_ <= qlo + QBLK - 1 - W) mask_tile(P0_, P1_, qm - kb_, (unsigned)W); } while (0)
        bf16x8 qr[NDQ];
#pragma unroll
        for (int d0 = 0; d0 < NDQ; ++d0) qr[d0] = *reinterpret_cast<const bf16x8*>(Qw + (size_t)r32 * ldq + d0 * 16 + hi * 8);
        FA_SLOAD(0); FA_VMW(); FA_SWRITE(0); FA_SBAR();
        if (NT > 1) FA_SLOAD(1);
        __syncthreads();
        f32x16 pA0, pA1, pB0, pB1; float alA, alB; bf16x8 pa0, pa1, pa2, pa3;
        FA_SBAR(); qkt<NDQ>(pA0, pA1, K_lds, r32, hi, qr);
        FA_MASKT(pA0, pA1, 0); partialSM(pA0, pA1, m_reg, alA);
        if (NT > 1) { FA_VMW(); FA_SWRITE(1); }
        __syncthreads();
#define FA_HALF_STEP(PX0, PX1, alX, PY0, PY1, alY, t, KB, VB, SB) do { \
        FA_SBAR(); qkt<NDQ>(PX0, PX1, K_lds + (KB) * SHM_K, r32, hi, qr); \
        finishSM(PY0, PY1, alY, l_reg, pa0, pa1, pa2, pa3); FA_SBAR(); \
        if ((t) + 1 < NT) { FA_SLOAD((t) + 1); FA_SBAR(); } \
        pv_tile<NDVT, NDV>(o, vb0 + (VB) * SHM_V, pa0, pa1, pa2, pa3); FA_MASKT(PX0, PX1, (t)); partialSM(PX0, PX1, m_reg, alX); \
        __syncthreads(); \
        if ((t) + 1 < NT) { FA_VMW(); FA_SWRITE(SB); } \
        FA_RESC(alX); __syncthreads(); } while (0)
        for (int t = 1; t + 1 < NT; t += 2) {
            FA_HALF_STEP(pB0, pB1, alB, pA0, pA1, alA, t, 1, 0, 0);
            FA_HALF_STEP(pA0, pA1, alA, pB0, pB1, alB, t + 1, 0, 1, 1);
        }
        const bool even = (NT & 1) == 0;
        if (even) { FA_SBAR(); qkt<NDQ>(pB0, pB1, K_lds + SHM_K, r32, hi, qr); FA_SBAR(); }
        finishSM(pA0, pA1, alA, l_reg, pa0, pa1, pa2, pa3); FA_SBAR();
        pv_tile<NDVT, NDV>(o, vb0, pa0, pa1, pa2, pa3);
        if (even) { FA_MASKT(pB0, pB1, NT - 1); partialSM(pB0, pB1, m_reg, alB); FA_RESC(alB);
            finishSM(pB0, pB1, alB, l_reg, pa0, pa1, pa2, pa3); FA_SBAR(); pv_tile<NDVT, NDV>(o, vb0 + SHM_V, pa0, pa1, pa2, pa3); }
        __syncthreads();
#undef FA_SLOAD
#undef FA_SWRITE
#undef FA_RESC
#undef FA_KBASE
#undef FA_MASKT
#undef FA_HALF_STEP
    }
};

#define FA_PIN(x) asm volatile("" : "+v"(x))
#define FA_PK4V(P, B_, OUT) do { unsigned a0_ = cvtpk(P[B_ + 0], P[B_ + 1]), a1_ = cvtpk(P[B_ + 2], P[B_ + 3]); unsigned b0_ = cvtpk(P[B_ + 4], P[B_ + 5]), b1_ = cvtpk(P[B_ + 6], P[B_ + 7]); \
        auto r0_ = __builtin_amdgcn_permlane32_swap(a0_, b0_, false, false); auto r1_ = __builtin_amdgcn_permlane32_swap(a1_, b1_, false, false); \
        u32x4 w_ = {r0_[0], r1_[0], r0_[1], r1_[1]}; OUT = *reinterpret_cast<bf16x8*>(&w_); } while (0)
__device__ __forceinline__ void step_qk_fin(f32x16& X0, f32x16& X1, const char* Kb, int r32, int hi, const bf16x8* qr,
                                            f32x16& Y0, f32x16& Y1, float alY, float& l_reg, bf16x8& pa0, bf16x8& pa1, bf16x8& pa2, bf16x8& pa3) {
    const char* k0 = Kb + kswz<4>(r32, hi); const char* k1 = Kb + kswz<4>(r32, 2 + hi); const char* k2 = Kb + kswz<4>(r32, 4 + hi); const char* k3 = Kb + kswz<4>(r32, 6 + hi);
    bf16x8 fa = *reinterpret_cast<const bf16x8*>(k0), fb = *reinterpret_cast<const bf16x8*>(k0 + 4096);
    float ps;
    X0 = __builtin_amdgcn_mfma_f32_32x32x16_bf16(fa, qr[0], f32x16{}, 0, 0, 0); X1 = __builtin_amdgcn_mfma_f32_32x32x16_bf16(fb, qr[0], f32x16{}, 0, 0, 0);
    fa = *reinterpret_cast<const bf16x8*>(k1); fb = *reinterpret_cast<const bf16x8*>(k1 + 4096);
#pragma unroll
    for (int r = 0; r < 4; ++r) Y1[r] = __builtin_amdgcn_exp2f(Y1[r]);
    ps = (Y0[0] + Y0[1]) + (Y0[2] + Y0[3]);
    FA_PK4V(Y0, 0, pa0); FA_PIN(ps); FA_PIN(pa0); FA_PIN(Y1); FA_SBAR();
    X0 = __builtin_amdgcn_mfma_f32_32x32x16_bf16(fa, qr[1], X0, 0, 0, 0); X1 = __builtin_amdgcn_mfma_f32_32x32x16_bf16(fb, qr[1], X1, 0, 0, 0);
    fa = *reinterpret_cast<const bf16x8*>(k2); fb = *reinterpret_cast<const bf16x8*>(k2 + 4096);
#pragma unroll
    for (int r = 4; r < 8; ++r) Y1[r] = __builtin_amdgcn_exp2f(Y1[r]);
    ps += (Y0[4] + Y0[5]) + (Y0[6] + Y0[7]); ps += (Y1[0] + Y1[1]) + (Y1[2] + Y1[3]);
    FA_PK4V(Y0, 8, pa1); FA_PIN(ps); FA_PIN(pa1); FA_PIN(Y1); FA_SBAR();
    X0 = __builtin_amdgcn_mfma_f32_32x32x16_bf16(fa, qr[2], X0, 0, 0, 0); X1 = __builtin_amdgcn_mfma_f32_32x32x16_bf16(fb, qr[2], X1, 0, 0, 0);
    fa = *reinterpret_cast<const bf16x8*>(k3); fb = *reinterpret_cast<const bf16x8*>(k3 + 4096);
#pragma unroll
    for (int r = 8; r < 12; ++r) Y1[r] = __builtin_amdgcn_exp2f(Y1[r]);
    ps += (Y0[8] + Y0[9]) + (Y0[10] + Y0[11]); ps += (Y1[4] + Y1[5]) + (Y1[6] + Y1[7]);
    FA_PK4V(Y1, 0, pa2); FA_PIN(ps); FA_PIN(pa2); FA_PIN(Y1); FA_SBAR();
    X0 = __builtin_amdgcn_mfma_f32_32x32x16_bf16(fa, qr[3], X0, 0, 0, 0); X1 = __builtin_amdgcn_mfma_f32_32x32x16_bf16(fb, qr[3], X1, 0, 0, 0);
#pragma unroll
    for (int r = 12; r < 16; ++r) Y1[r] = __builtin_amdgcn_exp2f(Y1[r]);
    ps += (Y0[12] + Y0[13]) + (Y0[14] + Y0[15]); ps += (Y1[8] + Y1[9]) + (Y1[10] + Y1[11]); ps += (Y1[12] + Y1[13]) + (Y1[14] + Y1[15]);
    { auto rr = __builtin_amdgcn_permlane32_swap(__float_as_uint(ps), __float_as_uint(ps), false, false); ps = __uint_as_float(rr[0]) + __uint_as_float(rr[1]); }
    l_reg = l_reg * alY + ps;
    FA_PK4V(Y1, 8, pa3); FA_PIN(l_reg); FA_PIN(pa3); FA_PIN(X0); FA_PIN(X1); FA_SBAR();
}
__device__ __forceinline__ void step_pv_max(f32x16* o, int vb, bf16x8 pa0, bf16x8 pa1, bf16x8 pa2, bf16x8 pa3, f32x16& X0, f32x16& X1, float& m_reg, float& alpha, bool MASK, int dq, unsigned W) {
#define FA_TRRD(dst, off) asm volatile("ds_read_b64_tr_b16 %0, %1 offset:%2" : "=&v"(dst) : "v"(vb), "i"(off) : "memory")
#define FA_RD2(l, h, d0, ks) do { FA_TRRD(l, (d0) * 512 + (ks) * 4096); FA_TRRD(h, (d0) * 512 + (ks) * 4096 + 2048); } while (0)
#define FA_FRAG(l, h) (bf16x8){l[0], l[1], l[2], l[3], h[0], h[1], h[2], h[3]}
    s16x4 l0, h0, l1, h1, l2, h2, l3, h3;
    FA_RD2(l0, h0, 0, 0); FA_RD2(l1, h1, 0, 1); FA_RD2(l2, h2, 0, 2); FA_RD2(l3, h3, 0, 3);
    if (MASK) mask_tile(X0, X1, dq, W);
    float pmax = fmaxf(fmaxf(X0[0], X0[1]), X1[0]);
#pragma unroll
    for (int r = 2; r < 16; r += 2) pmax = fmaxf(fmaxf(pmax, X0[r]), X0[r + 1]);
#pragma unroll
    for (int r = 1; r < 16; r += 2) pmax = fmaxf(fmaxf(pmax, X1[r]), X1[(r + 1) & 15]);
    { auto rr = __builtin_amdgcn_permlane32_swap(__float_as_uint(pmax), __float_as_uint(pmax), false, false); pmax = fmaxf(__uint_as_float(rr[0]), __uint_as_float(rr[1])); }
    float mn;
    if (__builtin_expect(__all((pmax - m_reg) <= THR), 1)) { mn = m_reg; alpha = 1.f; }
    else { mn = fmaxf(m_reg, pmax); alpha = __builtin_amdgcn_exp2f(m_reg - mn); m_reg = mn; }
    FA_PIN(mn);
#define FA_BLK(d0, NXT, FILL) do { asm volatile("s_waitcnt lgkmcnt(0)" ::: "memory"); FA_SBAR(); \
        o[d0] = __builtin_amdgcn_mfma_f32_32x32x16_bf16(pa0, FA_FRAG(l0, h0), o[d0], 0, 0, 0); if (NXT) FA_RD2(l0, h0, (d0) + 1, 0); \
        o[d0] = __builtin_amdgcn_mfma_f32_32x32x16_bf16(pa1, FA_FRAG(l1, h1), o[d0], 0, 0, 0); if (NXT) FA_RD2(l1, h1, (d0) + 1, 1); \
        o[d0] = __builtin_amdgcn_mfma_f32_32x32x16_bf16(pa2, FA_FRAG(l2, h2), o[d0], 0, 0, 0); if (NXT) FA_RD2(l2, h2, (d0) + 1, 2); \
        o[d0] = __builtin_amdgcn_mfma_f32_32x32x16_bf16(pa3, FA_FRAG(l3, h3), o[d0], 0, 0, 0); if (NXT) FA_RD2(l3, h3, (d0) + 1, 3); \
        FILL; } while (0)
    FA_BLK(0, true,  { _Pragma("unroll") for (int r = 0; r < 16; ++r) X0[r] = X0[r] - mn; FA_PIN(X0); });
    FA_BLK(1, true,  { _Pragma("unroll") for (int r = 0; r < 16; ++r) X1[r] = X1[r] - mn; FA_PIN(X1); });
    FA_BLK(2, true,  { _Pragma("unroll") for (int r = 0; r < 8; ++r) X0[r] = __builtin_amdgcn_exp2f(X0[r]); FA_PIN(X0); });
    FA_BLK(3, false, { _Pragma("unroll") for (int r = 8; r < 16; ++r) X0[r] = __builtin_amdgcn_exp2f(X0[r]); FA_PIN(X0); });
    FA_SBAR();
#undef FA_BLK
#undef FA_RD2
#undef FA_FRAG
#undef FA_TRRD
}

template <int NDQ, int NDVT, int NDV>
struct CoreStag {
    static_assert(NDQ == 4 && NDVT == 4 && NDV == 4, "the interleaved interval bodies are written for d_qk = 64, d_v = 128");
    static constexpr int KROW = NDQ * 32, SHM_K = 64 * KROW, SHM_V = 64 * NDVT * 64, NKL = NDQ / 4, NVL = NDVT / 2, LDS_NEED = 2 * SHM_V + 2 * SHM_K + NW * 256;
    __device__ __forceinline__ static void run(f32x16 (&o)[NDV], float& m_reg, float& l_reg, const bf16* Qw, int ldq, const bf16* Kg, const bf16* Vg, int ldk,
                                               int j_lo, int j_hi, int qlo, int W, char* lds, int vdoff) {
        const int tid = threadIdx.x, wid = __builtin_amdgcn_readfirstlane(tid >> 6), lane = tid & 63, r32 = lane & 31, hi = lane >> 5;
        const bool half1 = wid >= 4;
        const int NT = j_hi - j_lo, qm = qlo + r32 - 4 * hi;
        char* V_lds = lds; char* K_lds = lds + 2 * SHM_V;
        float* al_l = (float*)(lds + 2 * SHM_V + 2 * SHM_K) + wid * 64 + 32;
        m_reg = -1e30f; l_reg = 0.f;
#pragma unroll
        for (int d = 0; d < NDV; ++d) o[d] = f32x16{};
        constexpr int KCH = 2 * NDQ, KRS = 512 / KCH, VCH = 4 * NDVT, VRS = 512 / VCH;
        const int krow0 = tid / KCH, kch = tid % KCH, vrow0 = tid / VCH, vcol = (tid % VCH) * 8;
        int kws[NKL], vws[NVL];
#pragma unroll
        for (int i = 0; i < NKL; ++i) kws[i] = kswz<NDQ>(krow0 + i * KRS, kch);
#pragma unroll
        for (int i = 0; i < NVL; ++i) vws[i] = v_st<NDVT>(vrow0 + i * VRS, vcol);
        const bf16* kgp = Kg + (size_t)(j_lo * KVBLK + krow0) * ldk + kch * 8; const bf16* vgp = Vg + (size_t)(j_lo * KVBLK + vrow0) * ldk + vcol;
        bf16x8 sk[NKL], sv[NVL];
        const int vb0 = (int)(uintptr_t)V_lds + v_rd_base(lane) + vdoff * 512;
#define FS_BAR() do { FA_SBAR(); __syncthreads(); FA_SBAR(); } while (0)
#define FS_LOADK(t) do { if ((t) < NT) { const size_t ro_ = (size_t)((t) * KVBLK) * ldk; _Pragma("unroll") for (int i_ = 0; i_ < NKL; ++i_) sk[i_] = *reinterpret_cast<const bf16x8*>(kgp + ro_ + (size_t)(i_ * KRS) * ldk); } } while (0)
#define FS_LOADV(t) do { if ((t) < NT) { const size_t ro_ = (size_t)((t) * KVBLK) * ldk; _Pragma("unroll") for (int i_ = 0; i_ < NVL; ++i_) sv[i_] = *reinterpret_cast<const bf16x8*>(vgp + ro_ + (size_t)(i_ * VRS) * ldk); } } while (0)
#define FS_WRITEK(t, bf) do { if ((t) < NT) { _Pragma("unroll") for (int i_ = 0; i_ < NKL; ++i_) *reinterpret_cast<bf16x8*>(K_lds + (bf) * SHM_K + kws[i_]) = sk[i_]; } } while (0)
#define FS_WRITEV(t, bf) do { if ((t) < NT) { _Pragma("unroll") for (int i_ = 0; i_ < NVL; ++i_) *reinterpret_cast<bf16x8*>(V_lds + (bf) * SHM_V + vws[i_]) = sv[i_]; } } while (0)
#define FS_RESC(a) do { if (__any((a) < 1.f)) { if (hi == 0) al_l[r32] = (a); asm volatile("s_waitcnt lgkmcnt(0)" ::: "memory"); \
        _Pragma("unroll") for (int d_ = 0; d_ < NDV; ++d_) _Pragma("unroll") for (int r = 0; r < 16; ++r) o[d_][r] *= al_l[crow(r, hi)]; } } while (0)
#define FS_MASKT(P0_, P1_, t) do { const int kb_ = (j_lo + (t)) * KVBLK; if (kb_ + KVBLK - 1 > qlo || kb_ <= qlo + QBLK - 1 - W) mask_tile(P0_, P1_, qm - kb_, (unsigned)W); } while (0)
        bf16x8 qr[NDQ];
#pragma unroll
        for (int d0 = 0; d0 < NDQ; ++d0) qr[d0] = *reinterpret_cast<const bf16x8*>(Qw + (size_t)r32 * ldq + d0 * 16 + hi * 8);
        FS_LOADK(0); FS_WRITEK(0, 0); FA_SBAR(); FS_LOADK(1); FS_LOADV(0);
        FS_BAR();
        if (half1) { FS_BAR(); }
        f32x16 pA0, pA1, pB0, pB1; float alA = 1.f, alB = 1.f; bf16x8 pa0, pa1, pa2, pa3;
        FS_WRITEK(1, 1); FA_SBAR(); FS_LOADK(2); FA_SBAR();
        qkt<NDQ>(pA0, pA1, K_lds, r32, hi, qr); asm volatile("" : "+v"(pA0), "+v"(pA1));
        FS_BAR();
        FS_WRITEV(0, 0); FA_SBAR(); FS_LOADV(1); FA_SBAR();
        FS_MASKT(pA0, pA1, 0); partialSM(pA0, pA1, m_reg, alA);
        FS_BAR();
#define FS_STEP(PX0, PX1, alX, PY0, PY1, alY, t, KB) do { \
        finishSM(PY0, PY1, alY, l_reg, pa0, pa1, pa2, pa3); FA_SBAR(); \
        FS_WRITEK((t) + 1, (KB) ^ 1); FA_SBAR(); FS_LOADK((t) + 2); FA_SBAR(); \
        qkt<NDQ>(PX0, PX1, K_lds + (KB) * SHM_K, r32, hi, qr); asm volatile("" : "+v"(PX0), "+v"(PX1)); \
        FS_BAR(); \
        pv_tile<NDVT, NDV>(o, vb0 + ((KB) ^ 1) * SHM_V, pa0, pa1, pa2, pa3); \
        FS_WRITEV((t), (KB)); FA_SBAR(); FS_LOADV((t) + 1); FA_SBAR(); \
        FS_MASKT(PX0, PX1, (t)); partialSM(PX0, PX1, m_reg, alX); FS_RESC(alX); \
        FS_BAR(); } while (0)
        int t = 1;
        for (; t + 1 < NT; t += 2) {
            FS_STEP(pB0, pB1, alB, pA0, pA1, alA, t, 1);
            FS_STEP(pA0, pA1, alA, pB0, pB1, alB, t + 1, 0);
        }
        FS_STEP(pB0, pB1, alB, pA0, pA1, alA, t, 1);
        finishSM(pB0, pB1, alB, l_reg, pa0, pa1, pa2, pa3); FA_SBAR();
        FS_BAR();
        pv_tile<NDVT, NDV>(o, vb0 + SHM_V, pa0, pa1, pa2, pa3);
        FS_BAR();
        if (!half1) { FS_BAR(); }
#undef FS_BAR
#undef FS_LOADK
#undef FS_LOADV
#undef FS_WRITEK
#undef FS_WRITEV
#undef FS_RESC
#undef FS_MASKT
#undef FS_STEP
    }
};
}

constexpr size_t WS_STASH = 128 * MiB;
typedef unsigned v4u32 __attribute__((__vector_size__(16)));
__device__ __forceinline__ __amdgpu_buffer_rsrc_t mk_rsrc(const void* ptr) {
    const unsigned long long v = (unsigned long long)ptr; const unsigned lo = __builtin_amdgcn_readfirstlane((unsigned)v), hi = __builtin_amdgcn_readfirstlane((unsigned)(v >> 32));
    return __builtin_amdgcn_make_buffer_rsrc((void*)(((unsigned long long)hi << 32) | lo), 0, 0x40000000, 0x00020000);
}
__device__ __forceinline__ void attn_phase(const Params& p, char* lds, int vcu0, int nwg) {
    using namespace fa;
    const int tid = threadIdx.x, wid = __builtin_amdgcn_readfirstlane(tid >> 6), lane = tid & 63, r32 = lane & 31, hi = lane >> 5;
    const bf16* proj = (const bf16*)(p.ws + WS_PROJ); bf16* att = (bf16*)(p.ws + WS_ATT);
    typedef CoreStag<4, 4, 4> CD; typedef Core<4, 2, 2> CS;
    float* wsf = (float*)(lds + CD::LDS_NEED) + wid * 64;
    const float lam = calc_lambda(p);
    const int ovoff = (4 * hi * DM + r32) * 2;
#pragma nounroll
    for (int vcu = vcu0; vcu < 256; vcu += nwg) {
        const int bh = vcu >> 3, b = bh >> 2, h = bh & 3, s = vcu & 7;
        u32x4* stash = (u32x4*)(lds + CD::LDS_NEED + NW * 256) + tid;
#pragma nounroll
        for (int pass = 0; pass < 2; ++pass) {
            const int qb = pass ? 15 - s : s;
            const size_t row0 = (size_t)b * SEQ + qb * 256 + wid * 32;
#pragma nounroll
            for (int c = 0; c < 2; ++c) {
                f32x16 o[4]; float m_reg, l_reg;
                CD::run(o, m_reg, l_reg, proj + row0 * NP + C_QD + (2 * h + c) * 64, NP, proj + (size_t)b * SEQ * NP + C_KD + (2 * h + c) * 64, proj + (size_t)b * SEQ * NP + C_VD + h * 128, NP,
                        0, 4 * (qb + 1), qb * 256 + wid * 32, 1 << 30, lds, 0);
                if (hi == 0) wsf[r32] = l_reg;
                asm volatile("s_waitcnt lgkmcnt(0)" ::: "memory");
                if (c == 0) {
#pragma unroll
                    for (int j = 0; j < 2; ++j) { float ri[8];
#pragma unroll
                        for (int e = 0; e < 8; ++e) ri[e] = 1.0f / wsf[crow(8 * j + e, hi)];
#pragma unroll
                        for (int d0 = 0; d0 < 4; ++d0) { u32x4 w; w.x = cvtpk(o[d0][8 * j] * ri[0], o[d0][8 * j + 1] * ri[1]); w.y = cvtpk(o[d0][8 * j + 2] * ri[2], o[d0][8 * j + 3] * ri[3]);
                            w.z = cvtpk(o[d0][8 * j + 4] * ri[4], o[d0][8 * j + 5] * ri[5]); w.w = cvtpk(o[d0][8 * j + 6] * ri[6], o[d0][8 * j + 7] * ri[7]); stash[(d0 * 2 + j) * NTHR] = w; } }
                } else {
                    const __amdgpu_buffer_rsrc_t rso = mk_rsrc(att + row0 * DM + 512 + h * 128);
                    float ssq[16];
#pragma unroll
                    for (int r = 0; r < 16; ++r) ssq[r] = -lam / wsf[crow(r, hi)];
#pragma unroll
                    for (int d0 = 0; d0 < 4; ++d0)
#pragma unroll
                        for (int j = 0; j < 2; ++j) { const u32x4 w = stash[(d0 * 2 + j) * NTHR]; const unsigned ww[4] = {w.x, w.y, w.z, w.w};
#pragma unroll
                            for (int e = 0; e < 8; ++e) { const int r = 8 * j + e; const float a0 = (e & 1) ? __uint_as_float(ww[e >> 1] & 0xffff0000u) : __uint_as_float(ww[e >> 1] << 16);
                                o[d0][r] = a0 + ssq[r] * o[d0][r]; } }
#pragma unroll
                    for (int r = 0; r < 16; ++r) { float q = (o[0][r] * o[0][r] + o[1][r] * o[1][r]) + (o[2][r] * o[2][r] + o[3][r] * o[3][r]);
                        q += __shfl_xor(q, 1); q += __shfl_xor(q, 2); q += __shfl_xor(q, 4); q += __shfl_xor(q, 8); q += __shfl_xor(q, 16);
                        ssq[r] = 0.8f / sqrtf(q * (1.f / 128.f) + EPS); }
#pragma unroll
                    for (int d0 = 0; d0 < 4; ++d0) { const float g = p.g_diff[d0 * 32 + r32];
#pragma unroll
                        for (int r = 0; r < 16; ++r) { const float y = o[d0][r] * ssq[r] * g; const float yn = __shfl_xor(y, 1);
                            if ((r32 & 1) == 0) __builtin_amdgcn_raw_buffer_store_b32(cvtpk(y, yn), rso, ovoff, (((r & 3) + 8 * (r >> 2)) * DM + d0 * 32) * 2, WT_ATT); } }
                }
                asm volatile("s_waitcnt lgkmcnt(0)" ::: "memory");
            }
        }
    }
    int tid_s = threadIdx.x; asm volatile("" : "+v"(tid_s));
    const int wid_s = __builtin_amdgcn_readfirstlane(tid_s >> 6), r32_s = tid_s & 31, hi_s = (tid_s >> 5) & 1;
    float* wsf_s = (float*)(lds + CD::LDS_NEED) + wid_s * 64; const int ovoff_s = (4 * hi_s * DM + r32_s) * 2;
#pragma nounroll
    for (int u = vcu0; u < 1024; u += nwg) {
        const int wid = wid_s, r32 = r32_s, hi = hi_s, ovoff = ovoff_s; float* wsf = wsf_s;
        const int bk = u >> 6, g64 = u & 63, b = bk >> 1, kvh = bk & 1, hq = kvh * 4 + (wid >> 1), sub = wid & 1;
        const size_t row0 = (size_t)b * SEQ + g64 * 64 + sub * 32;
        const __amdgpu_buffer_rsrc_t rso = mk_rsrc(att + row0 * DM + hq * 64);
        f32x16 o[2]; float m_reg, l_reg;
        const bf16* Qw = proj + row0 * NP + C_QA + hq * 64;
        const bf16* Kg = proj + (size_t)b * SEQ * NP + C_KA + kvh * 64;
        const bf16* Vg = proj + (size_t)b * SEQ * NP + C_VA + kvh * 64;
        CS::run(o, m_reg, l_reg, Qw, NP, Kg, Vg, NP, g64 >= 2 ? g64 - 2 : 0, g64 + 1, g64 * 64 + sub * 32, 128, lds, 0);
        const float lt = l_reg + __builtin_amdgcn_exp2f(p.sinks[hq] * LOG2E - m_reg);
        if (hi == 0) wsf[r32] = lt;
        asm volatile("s_waitcnt lgkmcnt(0)" ::: "memory");
#pragma unroll
        for (int r = 0; r < 16; ++r) { const float rl = 1.0f / wsf[crow(r, hi)];
#pragma unroll
            for (int d0 = 0; d0 < 2; ++d0) { const float y = o[d0][r] * rl; const float yn = __shfl_xor(y, 1);
                if ((r32 & 1) == 0) __builtin_amdgcn_raw_buffer_store_b32(cvtpk(y, yn), rso, ovoff, (((r & 3) + 8 * (r >> 2)) * DM + d0 * 32) * 2, WT_ATT); } }
        __syncthreads();
    }
}

namespace fa {
template <int NDQ, int NDVT, int NDV>
struct CoreSeqG {
    static constexpr int KROW = NDQ * 32, SHM_K = 64 * KROW, SHM_V = 64 * NDVT * 64, KPW = SHM_K / 8192, VPW = SHM_V / 8192;
    static_assert(NDQ == 16 && NDVT == 8, "piece maps below are written for 512-byte K rows and 8 V column blocks");
    typedef __attribute__((address_space(3))) unsigned char* lptr;
    __device__ __forceinline__ static void run(f32x16 (&o)[NDV], float& m_reg, float& l_reg, const bf16* Qw, int ldq, const bf16* Kg, const bf16* Vg, int ldk, int NT, char* lds, lptr ldsL, int scr_off, int vdoff) {
        const int tid = threadIdx.x, wid = __builtin_amdgcn_readfirstlane(tid >> 6), lane = tid & 63, r32 = lane & 31, hi = lane >> 5;
        char* V_lds = lds; char* K_lds = lds + 2 * SHM_V;
        float* al_l = (float*)(lds + scr_off) + wid * 64 + 32;
        m_reg = -1e30f; l_reg = 0.f;
#pragma unroll
        for (int d = 0; d < NDV; ++d) o[d] = f32x16{};
        int ksrc[KPW], vsrc[VPW];
#pragma unroll
        for (int i = 0; i < KPW; ++i) { const int row = 2 * (wid * KPW + i) + (lane >> 5); ksrc[i] = row * ldk + (((lane & 31) ^ (row & 15)) << 3); }
#pragma unroll
        for (int i = 0; i < VPW; ++i) { const int kk = wid * 8 + ((lane & 31) >> 2), k = (kk & ~0xC) | ((kk & 4) << 1) | ((kk & 8) >> 1); vsrc[i] = k * ldk + (2 * i + (lane >> 5)) * 32 + (lane & 3) * 8; }
#define FG_DMA(t, bf) do { const size_t ro_ = (size_t)((t) * KVBLK) * ldk; \
        _Pragma("unroll") for (int i_ = 0; i_ < VPW; ++i_) __builtin_amdgcn_global_load_lds((const unsigned*)(Vg + ro_ + vsrc[i_]), (__attribute__((address_space(3))) unsigned*)(ldsL + (bf) * SHM_V + (wid * VPW + i_) * 1024), 16, 0, 0); \
        _Pragma("unroll") for (int i_ = 0; i_ < KPW; ++i_) __builtin_amdgcn_global_load_lds((const unsigned*)(Kg + ro_ + ksrc[i_]), (__attribute__((address_space(3))) unsigned*)(ldsL + 2 * SHM_V + (bf) * SHM_K + (wid * KPW + i_) * 1024), 16, 0, 0); } while (0)
        const int vb0 = (int)(uintptr_t)V_lds + v_rd_base(lane) + vdoff * 512;
        FG_DMA(0, 0);
        bf16x8 qr[NDQ];
#pragma unroll
        for (int d0 = 0; d0 < NDQ; ++d0) qr[d0] = *reinterpret_cast<const bf16x8*>(Qw + (size_t)r32 * ldq + d0 * 16 + hi * 8);
        __syncthreads();
        for (int t = 0; t < NT; ++t) {
            const int bf = t & 1;
            if (t + 1 < NT) FG_DMA(t + 1, bf ^ 1);
            f32x16 p0, p1; float al; bf16x8 pa0, pa1, pa2, pa3;
            FA_SBAR(); qkt<NDQ>(p0, p1, K_lds + bf * SHM_K, r32, hi, qr);
            partialSM(p0, p1, m_reg, al);
            if (__any(al < 1.f)) { if (hi == 0) al_l[r32] = al; asm volatile("s_waitcnt lgkmcnt(0)" ::: "memory");
#pragma unroll
                for (int d_ = 0; d_ < NDV; ++d_)
#pragma unroll
                    for (int r = 0; r < 16; ++r) o[d_][r] *= al_l[crow(r, hi)]; }
            finishSM(p0, p1, al, l_reg, pa0, pa1, pa2, pa3); FA_SBAR();
            pv_tile<NDVT, NDV>(o, vb0 + bf * SHM_V, pa0, pa1, pa2, pa3);
            __syncthreads();
        }
#undef FG_DMA
    }
};
}
__device__ __forceinline__ void cross_block(const Params& p, char* lds, LAS unsigned char* ldsL, int b, int head, int rb) {
    using namespace fa;
    int tid = threadIdx.x; asm volatile("" : "+v"(tid));
    const int wid = __builtin_amdgcn_readfirstlane(tid >> 6), lane = tid & 63, r32 = lane & 31, hi = lane >> 5, dh = wid >> 2;
    const bf16* qc = (const bf16*)(p.ws + WS_QC); const bf16* kvm = (const bf16*)(p.ws + WS_KVM); bf16* oc = (bf16*)(p.ws + WS_OC);
    typedef CoreSeqG<16, 8, 4> CC;
    constexpr int SCR = 131072 + 8192;
    float* wsf = (float*)(lds + SCR + 2048) + wid * 64;
    const int ovoff = (4 * hi * DM + r32) * 2;
    const size_t row0 = (size_t)b * SEQ + rb * 128 + (wid & 3) * 32;
    const __amdgpu_buffer_rsrc_t rso = mk_rsrc(oc + row0 * DM + head * 256 + dh * 128);
    f32x16 o[4]; float m_reg, l_reg;
    CC::run(o, m_reg, l_reg, qc + row0 * DM + head * 256, DM, kvm + (size_t)b * MEML * 2048 + head * 256, kvm + (size_t)b * MEML * 2048 + 1024 + head * 256, 2048, MEML / 64, lds, (CC::lptr)ldsL, SCR, dh * 4);
    if (hi == 0) wsf[r32] = l_reg;
    asm volatile("s_waitcnt lgkmcnt(0)" ::: "memory");
#pragma unroll
    for (int r = 0; r < 16; ++r) { const float rl = 1.0f / wsf[crow(r, hi)];
#pragma unroll
        for (int d0 = 0; d0 < 4; ++d0) { const float y = o[d0][r] * rl; const float yn = __shfl_xor(y, 1);
            if ((r32 & 1) == 0) __builtin_amdgcn_raw_buffer_store_b32(cvtpk(y, yn), rso, ovoff, (((r & 3) + 8 * (r >> 2)) * DM + d0 * 32) * 2, WT_ATT); } }
    asm volatile("s_waitcnt lgkmcnt(0)" ::: "memory");
}
#define GAS __attribute__((address_space(1)))
typedef GAS unsigned gu32;
constexpr int CW_BAR = 4096;
constexpr size_t CTL_ZERO_BYTES = 65536;
constexpr int MISC_OFF = 131072 + 320, TAB_OFF = 131072 + 1024;
constexpr int CW_PANEL = 8192;
constexpr size_t WS_XCH = 60 * MiB;
#define XB_TMO      128
#define XB_XCNT(j)  (256  + 64 * (j))
#define XB_XSUB(j)  (1280 + 64 * (j))
#define XB_XGEN(j)  (2304 + 64 * (j))
#define XB_TOP      3328
#define XB_TOPGEN   3392
#define XCD_BAR_WORDS 3456
#define XB_SPIN_CAP (1u << 18)

__device__ __forceinline__ unsigned xb_ld(unsigned* p)              { return __hip_atomic_load(p, __ATOMIC_RELAXED, __HIP_MEMORY_SCOPE_AGENT); }
__device__ __forceinline__ unsigned xb_add(unsigned* p, unsigned v) { return __hip_atomic_fetch_add(p, v, __ATOMIC_RELAXED, __HIP_MEMORY_SCOPE_AGENT); }
__device__ __forceinline__ unsigned xb_xcc_id() { return (unsigned)__builtin_amdgcn_s_getreg((3 << 11) | 20) & 0xFu; }
#define XB_SPIN(cond, bar) do { unsigned _sp = 0; while (cond) { __builtin_amdgcn_s_sleep(1); \
    if ((++_sp & 255u) == 0u) { if (xb_ld(&(bar)[XB_TMO])) break; if (_sp > XB_SPIN_CAP) { atomicAdd(&(bar)[XB_TMO], 1u); break; } } } } while (0)

struct XcdBarrier {
    unsigned* bar; unsigned x;
    volatile LAS unsigned* st;
};

__device__ __forceinline__ XcdBarrier xcd_barrier_post(unsigned* bar, volatile LAS unsigned* st) {
    XcdBarrier b; b.bar = bar; b.x = xb_xcc_id(); b.st = st;
    if (threadIdx.x == 0) (void)xb_add(&bar[XB_XCNT(b.x)], 1u);
    return b;
}
__device__ __forceinline__ void xcd_barrier_complete(unsigned* bar, unsigned x, unsigned& nloc, unsigned& nx) {
    const unsigned G = gridDim.x * gridDim.y * gridDim.z;
    unsigned sum, cnt, mine, sp = 0u;
    for (;;) {
        sum = 0u; cnt = 0u; mine = 0u;
#pragma unroll
        for (unsigned j = 0; j < 16; ++j) { const unsigned c = xb_ld(&bar[XB_XCNT(j)]); sum += c; cnt += (c > 0u) ? 1u : 0u; mine = (j == x) ? c : mine; }
        if (sum == G) break;
        __builtin_amdgcn_s_sleep(1);
        if ((++sp & 255u) == 0u) { if (xb_ld(&bar[XB_TMO])) break; if (sp > XB_SPIN_CAP) { atomicAdd(&bar[XB_TMO], 1u); break; } }
    }
    nloc = mine > 0u ? mine : 1u; nx = cnt > 0u ? cnt : 1u;
}

__device__ __forceinline__ void xcd_barrier(const XcdBarrier& b) {
    asm volatile("s_waitcnt vmcnt(0)" ::: "memory");
    __syncthreads();
    if (threadIdx.x == 0) {
        unsigned* bar = b.bar;
        __builtin_amdgcn_s_waitcnt(0);
        unsigned nloc = b.st[0], nx = b.st[1];
        if (nloc == 0u) { xcd_barrier_complete(bar, b.x, nloc, nx); b.st[0] = nloc; b.st[1] = nx; }
        const unsigned old = xb_add(&bar[XB_XSUB(b.x)], 1u);
        const unsigned gen = old / nloc;
        if (old + 1u == (gen + 1u) * nloc) {
            __builtin_amdgcn_fence(__ATOMIC_RELEASE, "agent");
            asm volatile("s_waitcnt vmcnt(0)" ::: "memory");
            const unsigned og = xb_add(&bar[XB_TOP], 1u);
            const unsigned tg = og / nx;
            if (og + 1u == (tg + 1u) * nx) xb_add(&bar[XB_TOPGEN], 1u);
            else XB_SPIN(xb_ld(&bar[XB_TOPGEN]) == tg, bar);
            __builtin_amdgcn_fence(__ATOMIC_ACQUIRE, "agent");
            asm volatile("s_waitcnt vmcnt(0)" ::: "memory");
        } else {
            XB_SPIN(xb_ld(&bar[XB_TOPGEN]) == gen, bar);
            __builtin_amdgcn_fence(__ATOMIC_ACQUIRE, "agent");
            asm volatile("s_waitcnt vmcnt(0)" ::: "memory");
        }
    }
    __syncthreads();
}

constexpr int LDS_BYTES = 147456;
constexpr size_t WS_SS3 = 58 * MiB;
__device__ __forceinline__ void final_norm_ss(float* X, const float* ss, const float* g, int gw, int ngw, int lane) {
    for (int m = gw; m < M; m += ngw) {
        const float rstd = pg8::rstd_ss(ss, m);
        f32x4* xr = (f32x4*)(X + (size_t)m * DM) + lane;
#pragma unroll
        for (int j = 0; j < 4; ++j) { const f32x4 gg = ((const f32x4*)g)[lane + 64 * j]; xr[64 * j] = xr[64 * j] * rstd * gg; }
    }
}
constexpr int N_PHASES = 10;
__global__ void __launch_bounds__(NTHR, 2) fwd_kernel(Params p) {
    extern __shared__ __attribute__((aligned(16))) unsigned char lds_raw[];
    LAS unsigned char* lds = (LAS unsigned char*)lds_raw;
    for (int u = threadIdx.x; u < 64; u += NTHR) ((LAS unsigned*)(lds + MISC_OFF))[u] = 0u;
    __syncthreads();
    XcdBarrier bar = xcd_barrier_post((unsigned*)(p.ws + WS_CTL) + CW_BAR, (volatile LAS unsigned*)(lds + MISC_OFF) + 8);
    const int tid = threadIdx.x, wave = __builtin_amdgcn_readfirstlane(tid >> 6), lane = tid & 63, bid = blockIdx.x, nblk = gridDim.x;
    const int gw = bid * NWAVES + wave, ngw = nblk * NWAVES;
    const int vcu = (nblk % 8 == 0) ? (bid % 8) * (nblk / 8) + bid / 8 : bid;
    unsigned char* ws = p.ws;
    const int lo = p.ph_lo, hi = p.ph_hi;
    typedef pg8::bf16_t b16;
#define IN(k) (lo <= (k) && (k) < hi)
#define SEAM(k) do { if (IN(k) && IN((k) + 1) && !((k) == 8 && nblk == 256)) xcd_barrier(bar); } while (0)
    if (IN(0)) { p0_prologue(p, lds, bid, nblk, tid); } SEAM(0);
    if (IN(1)) {
        pg8::Gemm g{(const b16*)(ws + WS_XN), (const b16*)(ws + WS_WIN), (const b16*)(ws + WS_MEMN), (const b16*)(ws + WS_WCKV), DM};
        pg8::TwoOrder S; S.init(M, NP, nblk, bid); S.n2M = MM / 256; S.n2N = 2048 / 256;
        pg8::EpiProj E{(b16*)(ws + WS_PROJ), (b16*)(ws + WS_KVM), (const float*)(ws + WS_ROPE)};
        pg8::gemm_phase<pg8::EpiProj, pg8::TwoOrder, true, true>(lds, g, S, E);
    } SEAM(1);
    if (IN(2)) { attn_phase(p, (char*)lds_raw, vcu, nblk);
    } SEAM(2);
    if (IN(3)) {
        pg8::Gemm g{(const b16*)(ws + WS_ATT), (const b16*)(ws + WS_WOUT), nullptr, nullptr, DM};
        pg8::StaticOrder S; S.init(M, DM, nblk, bid);
        pg8::EpiResB<true> E{p.x, nullptr, (b16*)(ws + WS_XN), (float*)(ws + WS_SS1)};
        pg8::gemm_phase<pg8::EpiResB<true>, pg8::StaticOrder, true, true>(lds, g, S, E);
    } SEAM(3);
    if (IN(4)) {
        pg8::Gemm g{(const b16*)(ws + WS_XN), (const b16*)(ws + WS_WCQ), nullptr, nullptr, DM, 1};
        pg8::StaticOrder S; S.init(M, DM, nblk, bid);
        pg8::EpiScaleBf16<0> E{(b16*)(ws + WS_QC), DM, (const float*)(ws + WS_SS1), CQ, lds + TAB_OFF};
        pg8::gemm_phase<pg8::EpiScaleBf16<0>, pg8::StaticOrder, true, true>(lds, g, S, E);
        asm volatile("s_waitcnt vmcnt(0)" ::: "memory");
        __syncthreads();
        if (tid == 0) { __builtin_amdgcn_fence(__ATOMIC_ACQUIRE, "agent"); asm volatile("s_waitcnt vmcnt(0)" ::: "memory"); }
        __syncthreads();
#pragma nounroll
        for (int i = 0; ; ++i) {
            pg8::Unit u; if (!S.next(i, u)) break;
#pragma nounroll
            for (int hb = 0; hb < 2; ++hb) cross_block(p, (char*)lds_raw, lds, u.pm >> 4, u.pn, (u.pm & 15) * 2 + hb);
        }
    } SEAM(4);
    if (IN(6)) {
        pg8::Gemm g{(const b16*)(ws + WS_OC), (const b16*)(ws + WS_WCO), nullptr, nullptr, DM};
        pg8::StaticOrder S; S.init(M, DM, nblk, bid);
        pg8::EpiResB<false> E{nullptr, (const b16*)(ws + WS_XN), (b16*)(ws + WS_XN), (float*)(ws + WS_SS2)};
        pg8::gemm_phase<pg8::EpiResB<false>, pg8::StaticOrder, true, true>(lds, g, S, E);
    } SEAM(6);
    if (IN(7)) {
        pg8::Gemm g{(const b16*)(ws + WS_XN), (const b16*)(ws + WS_WUP), nullptr, nullptr, DM, 1};
        pg8::StaticOrder S; S.init(M, FF, nblk, bid);
        pg8::EpiScaleBf16<1> E{(b16*)(ws + WS_ACT), FF, (const float*)(ws + WS_SS2), 1.f, lds + TAB_OFF};
        pg8::gemm_phase<pg8::EpiScaleBf16<1>, pg8::StaticOrder, true, true>(lds, g, S, E);
    } SEAM(7);
    if (IN(8)) {
        pg8::Gemm g{(const b16*)(ws + WS_ACT), (const b16*)(ws + WS_WDOWN), nullptr, nullptr, FF, 1};
        pg8::StaticOrder S; S.init(M, DM, nblk, bid);
        if (nblk == 256) {
            pg8::EpiFinal E{(const b16*)(ws + WS_XN), p.out, p.g_final, (unsigned*)(ws + WS_XCH), (unsigned*)(ws + WS_CTL) + CW_PANEL, lds + TAB_OFF};
            pg8::gemm_phase<pg8::EpiFinal, pg8::StaticOrder, true, true>(lds, g, S, E);
        } else {
            pg8::EpiResF E{(const b16*)(ws + WS_XN), p.out, (float*)(ws + WS_SS3)};
            pg8::gemm_phase<pg8::EpiResF, pg8::StaticOrder, true, true>(lds, g, S, E);
        }
    } SEAM(8);
    if (IN(9) && nblk != 256) { final_norm_ss(p.out, (const float*)(ws + WS_SS3), p.g_final, gw, ngw, lane); }
#undef IN
#undef SEAM
}

extern "C" void kernel_launch(void* const* d_in, const int* in_sizes, int n_in, void* d_out, int out_size, void* d_ws, size_t ws_size, hipStream_t stream) {
    static int grid = 0;
    if (grid == 0) {
        if (n_in != 21 || out_size != M * DM || ws_size < WS_END) { fprintf(stderr, "kernel_launch: unexpected shapes (n_in %d out %d ws %zu)\n", n_in, out_size, ws_size); grid = -1; return; }
        int dev = 0, cus = 0, per_cu = 0;
        (void)hipGetDevice(&dev); (void)hipDeviceGetAttribute(&cus, hipDeviceAttributeMultiprocessorCount, dev);
        if (hipFuncSetAttribute((const void*)fwd_kernel, hipFuncAttributeMaxDynamicSharedMemorySize, LDS_BYTES) != hipSuccess) { fprintf(stderr, "kernel_launch: hipFuncSetAttribute failed\n"); grid = -1; return; }
        (void)hipOccupancyMaxActiveBlocksPerMultiprocessor(&per_cu, (const void*)fwd_kernel, NTHR, LDS_BYTES);
        if (per_cu < 1) { fprintf(stderr, "kernel_launch: occupancy query says %d blocks per CU\n", per_cu); per_cu = 1; }
        grid = cus;
    }
    if (grid < 0) return;
    Params p{};
    p.x = (const float*)d_in[0]; p.mem = (const float*)d_in[1]; p.pos = (const int*)d_in[2]; p.g_mix = (const float*)d_in[3]; p.w_in = (const float*)d_in[4];
    p.sinks = (const float*)d_in[5]; p.lq1 = (const float*)d_in[6]; p.lk1 = (const float*)d_in[7]; p.lq2 = (const float*)d_in[8]; p.lk2 = (const float*)d_in[9];
    p.g_diff = (const float*)d_in[10]; p.w_out = (const float*)d_in[11]; p.g_cross = (const float*)d_in[12]; p.g_mem = (const float*)d_in[13]; p.w_cq = (const float*)d_in[14];
    p.w_ckv = (const float*)d_in[15]; p.w_co = (const float*)d_in[16]; p.g_mlp = (const float*)d_in[17]; p.w_up = (const float*)d_in[18]; p.w_down = (const float*)d_in[19]; p.g_final = (const float*)d_in[20];
    p.out = (float*)d_out; p.ws = (unsigned char*)d_ws;
    if (hipMemsetAsync((char*)d_ws + WS_CTL, 0, CTL_ZERO_BYTES, stream) != hipSuccess) { fprintf(stderr, "kernel_launch: hipMemsetAsync of the control words failed\n"); return; }
    p.ph_lo = 0; p.ph_hi = N_PHASES;
    hipLaunchKernelGGL(fwd_kernel, dim3(grid), dim3(NTHR), LDS_BYTES, stream, p);
}
```

```cpp
#define WT_ATT 16
#include <hip/hip_runtime.h>
#include <cstdio>
#include <cstdint>


#define LAS __attribute__((address_space(3)))
typedef unsigned short bf16;
typedef short bf16x8 __attribute__((ext_vector_type(8)));
typedef float f32x4 __attribute__((ext_vector_type(4)));
typedef unsigned u32x4 __attribute__((ext_vector_type(4)));
typedef unsigned u32x2 __attribute__((ext_vector_type(2)));

constexpr int BATCH = 8, SEQ = 4096, M = BATCH * SEQ, DM = 1024, NP = 2304, MEML = 256, MM = BATCH * MEML, FF = 4096;
constexpr int NWAVES = 8, NTHR = NWAVES * 64;
constexpr float EPS = 1e-5f;
constexpr float LOG2E = 1.4426950408889634f;
constexpr float C2 = 0.125f * LOG2E;
constexpr float CQ = 0.0625f * LOG2E;
constexpr int C_QA = 0, C_KA = 512, C_VA = 640, C_QD = 768, C_KD = 1280, C_VD = 1792;

constexpr size_t MiB = 1u << 20;
constexpr size_t WS_CTL = 0;
constexpr size_t WS_WIN = 2 * MiB;
constexpr size_t WS_WOUT = WS_WIN + (size_t)NP * DM * 2;
constexpr size_t WS_WCQ = WS_WOUT + 2 * MiB;
constexpr size_t WS_WCKV = WS_WCQ + 2 * MiB;
constexpr size_t WS_WCO = WS_WCKV + 4 * MiB;
constexpr size_t WS_WUP = WS_WCO + 2 * MiB;
constexpr size_t WS_WDOWN = WS_WUP + 8 * MiB;
constexpr size_t WS_ROPE = 34 * MiB;
constexpr size_t WS_KVM = 42 * MiB;
constexpr size_t WS_MEMN = 50 * MiB;
constexpr size_t WS_SS1 = 54 * MiB, WS_SS2 = 56 * MiB;
constexpr size_t WS_XN = 64 * MiB;
constexpr size_t WS_PROJ = 256 * MiB;
constexpr size_t WS_ATT = 400 * MiB;
constexpr size_t WS_QC = 256 * MiB;
constexpr size_t WS_OC = 320 * MiB;
constexpr size_t WS_ACT = 256 * MiB;
constexpr size_t WS_END = 512 * MiB;
static_assert(WS_WDOWN + 8 * MiB <= WS_ROPE, "weights fit");

struct Params {
    const float *x, *mem; const int* pos;
    const float *g_mix, *w_in, *sinks, *lq1, *lk1, *lq2, *lk2, *g_diff, *w_out, *g_cross, *g_mem, *w_cq, *w_ckv, *w_co, *g_mlp, *w_up, *w_down, *g_final;
    float* out; unsigned char* ws; int ph_lo, ph_hi;
};

__device__ __forceinline__ unsigned f2bf(float f) { unsigned u = __builtin_bit_cast(unsigned, f); return (u + 0x7fffu + ((u >> 16) & 1u)) >> 16; }
__device__ __forceinline__ unsigned pk2(float lo, float hi) { return f2bf(lo) | (f2bf(hi) << 16); }
__device__ __forceinline__ float bf2f(unsigned h) { return __builtin_bit_cast(float, h << 16); }
__device__ __forceinline__ float bflo(unsigned w) { return __builtin_bit_cast(float, w << 16); }
__device__ __forceinline__ float bfhi(unsigned w) { return __builtin_bit_cast(float, w & 0xffff0000u); }
__device__ __forceinline__ float wave_sum(float v) {
#pragma unroll
    for (int o = 1; o < 64; o <<= 1) v += __shfl_xor(v, o);
    return v;
}
__device__ __forceinline__ float wave_max(float v) {
#pragma unroll
    for (int o = 1; o < 64; o <<= 1) v = fmaxf(v, __shfl_xor(v, o));
    return v;
}
__host__ __device__ __forceinline__ bool col_roped(int n) { return n < C_VA || (n >= C_QD && n < C_VD); }
__host__ __device__ __forceinline__ int phys_of_logical(int nl) {
    if (!col_roped(nl)) return nl;
    const int g = nl & ~63, j = nl & 63; return g + ((j & 31) << 1) + (j >> 5);
}
__device__ __forceinline__ float calc_lambda(const Params& p) {
    float a = 0.f, b = 0.f;
    for (int i = 0; i < 64; ++i) { a += p.lq1[i] * p.lk1[i]; b += p.lq2[i] * p.lk2[i]; }
    return __expf(a) - __expf(b) + 0.2f;
}

__device__ const double INV_FREQ[32] = {
    1.0, 0.7498942093324559, 0.5623413251903491, 0.4216965034285822,
    0.31622776601683794, 0.23713737056616552, 0.1778279410038923, 0.1333521432163324,
    0.1, 0.07498942093324558, 0.05623413251903491, 0.042169650342858224,
    0.03162277660168379, 0.023713737056616554, 0.01778279410038923, 0.01333521432163324,
    0.01, 0.007498942093324558, 0.005623413251903491, 0.004216965034285823,
    0.0031622776601683794, 0.0023713737056616554, 0.0017782794100389228, 0.001333521432163324,
    0.001, 0.0007498942093324559, 0.0005623413251903491, 0.00042169650342858224,
    0.00031622776601683794, 0.00023713737056616554, 0.00017782794100389227, 0.0001333521432163324};

__device__ __forceinline__ void sincos_d(double a, float& c, float& s) {
    const double kd = rint(a * 0.63661977236758134308);
    const int k = (int)kd;
    double r = fma(-kd, 1.57079632679489655800e+00, a); r = fma(-kd, 6.12323399573676603587e-17, r);
    const double r2 = r * r;
    const double sp = r * (1.0 + r2 * (-1.0 / 6.0 + r2 * (1.0 / 120.0 + r2 * (-1.0 / 5040.0 + r2 * (1.0 / 362880.0 + r2 * (-1.0 / 39916800.0 + r2 * (1.0 / 6227020800.0)))))));
    const double cp = 1.0 + r2 * (-0.5 + r2 * (1.0 / 24.0 + r2 * (-1.0 / 720.0 + r2 * (1.0 / 40320.0 + r2 * (-1.0 / 3628800.0 + r2 * (1.0 / 479001600.0 + r2 * (-1.0 / 87178291200.0)))))));
    const int q = k & 3;
    const double ss = (q == 0) ? sp : (q == 1) ? cp : (q == 2) ? -sp : -cp;
    const double cc = (q == 0) ? cp : (q == 1) ? -sp : (q == 2) ? -cp : sp;
    c = (float)cc; s = (float)ss;
}

template <bool HASG, bool PERMC>
__device__ __forceinline__ void transpose_item(const float* W, int K, int N, const float* g, bf16* WT, LAS float* scr, int item, int lane) {
    const int nblk = N / 32, kb = item / nblk, nb = item % nblk, k0 = 64 * kb, n0 = 32 * nb;
#pragma unroll 16
    for (int i = 0; i < 32; ++i) { const int kk = 2 * i + (lane >> 5); float v = W[(size_t)(k0 + kk) * N + n0 + (lane & 31)]; if (HASG) v *= g[k0 + kk]; scr[kk * 33 + (lane & 31)] = v; }
    asm volatile("s_waitcnt lgkmcnt(0)" ::: "memory");
    const int c = lane & 7;
#pragma unroll
    for (int j = 0; j < 4; ++j) { const int n = (lane >> 3) + 8 * j; const LAS float* s = scr + (8 * c) * 33 + n;
        u32x4 o; o.x = pk2(s[0 * 33], s[1 * 33]); o.y = pk2(s[2 * 33], s[3 * 33]); o.z = pk2(s[4 * 33], s[5 * 33]); o.w = pk2(s[6 * 33], s[7 * 33]);
        const int nl = n0 + n, np = PERMC ? phys_of_logical(nl) : nl;
        *(u32x4*)(WT + (size_t)np * K + k0 + 8 * c) = o; }
    asm volatile("s_waitcnt lgkmcnt(0)" ::: "memory");
}
__device__ __forceinline__ void rms_row_to_bf16(const float* xrow, const float* g, bf16* orow, int lane) {
    const f32x4* xr = (const f32x4*)xrow + lane;
    f32x4 v[4]; float s = 0.f;
#pragma unroll
    for (int j = 0; j < 4; ++j) { v[j] = xr[64 * j]; s += (v[j].x * v[j].x + v[j].y * v[j].y) + (v[j].z * v[j].z + v[j].w * v[j].w); }
    const float rstd = 1.0f / sqrtf(wave_sum(s) * (1.f / DM) + EPS);
    u32x2* o8 = (u32x2*)orow + lane;
#pragma unroll
    for (int j = 0; j < 4; ++j) {
        f32x4 gg = (f32x4){1.f, 1.f, 1.f, 1.f}; if (g) gg = ((const f32x4*)g)[lane + 64 * j];
        u32x2 w; w.x = pk2(v[j].x * rstd * gg.x, v[j].y * rstd * gg.y); w.y = pk2(v[j].z * rstd * gg.z, v[j].w * rstd * gg.w); o8[64 * j] = w; }
}
__device__ __forceinline__ void p0_prologue(const Params& p, LAS unsigned char* lds, int bid, int nblk, int tid) {
    const int wave = tid >> 6, lane = tid & 63;
    LAS float* scr = (LAS float*)(lds + wave * 8704);
    const int gw = bid * NWAVES + wave, NGW = nblk * NWAVES;
    unsigned char* ws = p.ws;
    constexpr int I_IN = (DM / 64) * (NP / 32), I_SQ = (DM / 64) * (DM / 32), I_KV = (DM / 64) * (2048 / 32), I_UP = (DM / 64) * (FF / 32), I_DN = (FF / 64) * (DM / 32);
    constexpr int NITEMS = I_IN + 3 * I_SQ + I_KV + I_UP + I_DN;
    for (int it = gw; it < NITEMS; it += NGW) {
        int r = it;
        if (r < I_IN) { transpose_item<true, true>(p.w_in, DM, NP, p.g_mix, (bf16*)(ws + WS_WIN), scr, r, lane); continue; } r -= I_IN;
        if (r < I_SQ) { transpose_item<false, false>(p.w_out, DM, DM, nullptr, (bf16*)(ws + WS_WOUT), scr, r, lane); continue; } r -= I_SQ;
        if (r < I_SQ) { transpose_item<true, false>(p.w_cq, DM, DM, p.g_cross, (bf16*)(ws + WS_WCQ), scr, r, lane); continue; } r -= I_SQ;
        if (r < I_KV) { transpose_item<false, false>(p.w_ckv, DM, 2048, nullptr, (bf16*)(ws + WS_WCKV), scr, r, lane); continue; } r -= I_KV;
        if (r < I_SQ) { transpose_item<false, false>(p.w_co, DM, DM, nullptr, (bf16*)(ws + WS_WCO), scr, r, lane); continue; } r -= I_SQ;
        if (r < I_UP) { transpose_item<true, false>(p.w_up, DM, FF, p.g_mlp, (bf16*)(ws + WS_WUP), scr, r, lane); continue; } r -= I_UP;
        transpose_item<false, false>(p.w_down, FF, DM, nullptr, (bf16*)(ws + WS_WDOWN), scr, r, lane);
    }
    for (int m = gw * 2; m < M; m += NGW * 2) {
        const f32x4* x0 = (const f32x4*)(p.x + (size_t)m * DM) + lane; const f32x4* x1 = x0 + DM / 4;
        f32x4 v0[4], v1[4]; float s0 = 0.f, s1 = 0.f;
#pragma unroll
        for (int j = 0; j < 4; ++j) { v0[j] = x0[64 * j]; v1[j] = x1[64 * j]; }
#pragma unroll
        for (int j = 0; j < 4; ++j) { s0 += (v0[j].x * v0[j].x + v0[j].y * v0[j].y) + (v0[j].z * v0[j].z + v0[j].w * v0[j].w); s1 += (v1[j].x * v1[j].x + v1[j].y * v1[j].y) + (v1[j].z * v1[j].z + v1[j].w * v1[j].w); }
#pragma unroll
        for (int o = 1; o < 64; o <<= 1) { s0 += __shfl_xor(s0, o); s1 += __shfl_xor(s1, o); }
        const float r0 = 1.0f / sqrtf(s0 * (1.f / DM) + EPS), r1 = 1.0f / sqrtf(s1 * (1.f / DM) + EPS);
        u32x2* o0 = (u32x2*)((bf16*)(ws + WS_XN) + (size_t)m * DM) + lane; u32x2* o1 = o0 + DM / 4;
#pragma unroll
        for (int j = 0; j < 4; ++j) { u32x2 w; w.x = pk2(v0[j].x * r0, v0[j].y * r0); w.y = pk2(v0[j].z * r0, v0[j].w * r0); o0[64 * j] = w;
            u32x2 z; z.x = pk2(v1[j].x * r1, v1[j].y * r1); z.y = pk2(v1[j].z * r1, v1[j].w * r1); o1[64 * j] = z; }
    }
    for (int m = gw; m < MM; m += NGW) rms_row_to_bf16(p.mem + (size_t)m * DM, p.g_mem, (bf16*)(ws + WS_MEMN) + (size_t)m * DM, lane);
    float2* rope = (float2*)(ws + WS_ROPE);
    for (int i = bid * NTHR + tid; i < M * 32; i += nblk * NTHR) {
        const int row = i >> 5, d = i & 31; float c, s; sincos_d((double)p.pos[row] * INV_FREQ[d], c, s); rope[i] = make_float2(c, s); }
}

namespace pg8 {
#define PG8_LAS __attribute__((address_space(3)))
typedef unsigned short bf16_t;
typedef short bf16x8 __attribute__((ext_vector_type(8)));
typedef float f32x4 __attribute__((ext_vector_type(4)));
typedef unsigned u32x4 __attribute__((ext_vector_type(4)));
typedef unsigned u32x2 __attribute__((ext_vector_type(2)));
constexpr int BM = 256, BK = 64, HALF = 128, HTB = HALF * BK * 2  , STAGE_BYTES = 8 * HTB, NXCD = 8, WGM = 8;

__host__ __device__ __forceinline__ int lds_byte(int r, int c) { const int st = (r >> 4) * 2 + (c >> 5), rr = r & 15, cc = c & 31, ob = rr * 64 + cc * 2; return st * 1024 + (ob ^ (((ob >> 9) & 1) << 5)); }
__host__ __device__ __forceinline__ void stage_rc(int b, int& R, int& C) { const int st = b / 1024, sb = b % 1024, swz = sb ^ (((sb >> 9) & 1) << 5); R = (st >> 1) * 16 + swz / 64; C = (st & 1) * 32 + (swz % 64) / 2; }
__host__ __device__ __forceinline__ int perm32(int rho) { const int n = rho >> 4, i = rho & 15; return 8 * (i >> 2) + 4 * n + (i & 3); }

struct Unit { int pm, pn, alt; };
struct Gemm { const bf16_t* A; const bf16_t* Bt; const bf16_t* A2; const bf16_t* Bt2; int K; int ablk; };

struct StaticOrder {
    int nM, nN, nwg, G, c;
    __host__ __device__ void init(int M_, int N_, int G_, int c_) { nM = M_ / BM; nN = N_ / BM; nwg = nM * nN; G = G_; c = c_; }
    __host__ __device__ bool map(long L, Unit& u) const {
        if (L >= nwg) return false;
        int wgid = (int)L; { const int q = nwg / NXCD, r = nwg % NXCD, xcd = wgid % NXCD, off = wgid / NXCD; wgid = (xcd < r ? xcd * (q + 1) : r * (q + 1) + (xcd - r) * q) + off; }
        const int nig = WGM * nN, gid = wgid / nig, fm = gid * WGM, gsz = (nM - fm) < WGM ? (nM - fm) : WGM;
        u.pm = fm + ((wgid % nig) % gsz); u.pn = (wgid % nig) / gsz; u.alt = 0; return true;
    }
    __host__ __device__ bool next(int i, Unit& u) const { return map((long)i * G + c, u); }
    __device__ __forceinline__ void a_ready(const Unit&) const {}
    __device__ __forceinline__ void done(const Unit&) const {}
};
struct OneUnit {
    Unit u;
    __device__ __forceinline__ bool next(int i, Unit& o) const { if (i) return false; o = u; return true; }
    __device__ __forceinline__ void a_ready(const Unit&) const {}
    __device__ __forceinline__ void done(const Unit&) const {}
};
struct TwoOrder : StaticOrder {
    int n2M, n2N;
    __host__ __device__ bool next(int i, Unit& u) const {
        const long L = (long)i * G + c;
        if (L < nwg) return map(L, u);
        const int r = (int)(L - nwg); if (r >= n2M * n2N) return false;
        u.pm = r % n2M; u.pn = r / n2M; u.alt = 1; return true;
    }
};
typedef __bf16 cvt_bf2 __attribute__((ext_vector_type(2))); typedef float cvt_f2 __attribute__((ext_vector_type(2)));
__device__ __forceinline__ unsigned cvt_pk_bf16(float lo, float hi) { const cvt_f2 v = {lo, hi}; return __builtin_bit_cast(unsigned, __builtin_convertvector(v, cvt_bf2)); }

__device__ __forceinline__ float rstd_ss(const float* ss, int row) {
    const f32x4* s4 = (const f32x4*)(ss + (size_t)row * 16); float t = 0.f;
#pragma unroll
    for (int i = 0; i < 4; ++i) { const f32x4 v = s4[i]; t += (v.x + v.y) + (v.z + v.w); }
    return 1.0f / sqrtf(t * (1.f / DM) + EPS);
}
struct EpiProj {
    static constexpr bool PERM = true, AFTER_DRAIN = false;
    bf16_t* proj; bf16_t* kvm; const float* rope;
    __device__ __forceinline__ void operator()(const f32x4 (&acc)[2][2][4][2], const Unit& u, int wr, int wc, int fr, int fq) const {
        const int row0 = u.pm * BM + wr * 64 + fr, col0 = u.pn * BM + wc * 32 + 8 * fq;
        if (u.alt) {
#pragma unroll
            for (int ai = 0; ai < 2; ++ai)
#pragma unroll
                for (int m = 0; m < 4; ++m) { bf16_t* rowp = kvm + (size_t)(row0 + ai * HALF + m * 16) * 2048 + col0;
#pragma unroll
                    for (int bj = 0; bj < 2; ++bj) { const f32x4 v0 = acc[ai][bj][m][0], v1 = acc[ai][bj][m][1];
                        u32x4 w; w.x = cvt_pk_bf16(v0[0], v0[1]); w.y = cvt_pk_bf16(v0[2], v0[3]); w.z = cvt_pk_bf16(v1[0], v1[1]); w.w = cvt_pk_bf16(v1[2], v1[3]);
                        *(u32x4*)(rowp + bj * HALF) = w; } }
            return;
        }
        const int d0 = ((wc & 1) * 32 + 8 * fq) >> 1;
#pragma unroll
        for (int ai = 0; ai < 2; ++ai) {
            f32x4 csa[4], csb[4];
#pragma unroll
            for (int m = 0; m < 4; ++m) { const size_t ro = (size_t)(row0 + ai * HALF + m * 16) * 64 + 2 * d0; csa[m] = *(const f32x4*)(rope + ro); csb[m] = *(const f32x4*)(rope + ro + 4); }
#pragma unroll
            for (int m = 0; m < 4; ++m) { const int row = row0 + ai * HALF + m * 16;
                const f32x4 cs0 = csa[m], cs1 = csb[m];
#pragma unroll
                for (int bj = 0; bj < 2; ++bj) { const int cb = u.pn * BM + bj * HALF;
                    const bool roped = col_roped(cb); const float sc = (cb < C_KA || (cb >= C_QD && cb < C_KD)) ? C2 : 1.f;
                    f32x4 v0 = acc[ai][bj][m][0], v1 = acc[ai][bj][m][1];
                    if (roped) {
                        const f32x4 a = v0, b = v1;
                        v0[0] = a[0] * cs0[0] - a[1] * cs0[1]; v0[1] = a[1] * cs0[0] + a[0] * cs0[1];
                        v0[2] = a[2] * cs0[2] - a[3] * cs0[3]; v0[3] = a[3] * cs0[2] + a[2] * cs0[3];
                        v1[0] = b[0] * cs1[0] - b[1] * cs1[1]; v1[1] = b[1] * cs1[0] + b[0] * cs1[1];
                        v1[2] = b[2] * cs1[2] - b[3] * cs1[3]; v1[3] = b[3] * cs1[2] + b[2] * cs1[3];
                    }
                    v0 = v0 * sc; v1 = v1 * sc;
                    u32x4 w; w.x = cvt_pk_bf16(v0[0], v0[1]); w.y = cvt_pk_bf16(v0[2], v0[3]); w.z = cvt_pk_bf16(v1[0], v1[1]); w.w = cvt_pk_bf16(v1[2], v1[3]);
                    *(u32x4*)(proj + (size_t)row * NP + col0 + bj * HALF) = w; } }
        }
    }
};
struct EpiRes {
    static constexpr bool PERM = false, AFTER_DRAIN = false;
    const float* xi; float* xo; bf16_t* xb; float* ss;
    __device__ __forceinline__ void operator()(const f32x4 (&acc)[2][2][4][2], const Unit& u, int wr, int wc, int fr, int fq) const {
        const int row0 = u.pm * BM + wr * 64 + fr, col0 = u.pn * BM + wc * 32 + 4 * fq;
#pragma unroll
        for (int ai = 0; ai < 2; ++ai)
#pragma unroll
            for (int m = 0; m < 4; ++m) { const int row = row0 + ai * HALF + m * 16; const size_t off = (size_t)row * DM + col0; float q = 0.f;
#pragma unroll
                for (int bj = 0; bj < 2; ++bj)
#pragma unroll
                    for (int n = 0; n < 2; ++n) { const size_t c = off + bj * HALF + n * 16; const f32x4 r = *(const f32x4*)(xi + c) + acc[ai][bj][m][n];
                        *(f32x4*)(xo + c) = r; q += (r[0] * r[0] + r[1] * r[1]) + (r[2] * r[2] + r[3] * r[3]);
                        if (xb) { u32x2 w; w.x = cvt_pk_bf16(r[0], r[1]); w.y = cvt_pk_bf16(r[2], r[3]); *(u32x2*)(xb + c) = w; } }
                q += __shfl_xor(q, 16); q += __shfl_xor(q, 32);
                if (fq == 0) ss[(size_t)row * 16 + u.pn * 4 + wc] = q;
                if (m & 1) asm volatile("" ::: "memory"); }
    }
};
template <bool XF> struct EpiResB {
    static constexpr bool PERM = true, AFTER_DRAIN = false;
    const float* xf; const bf16_t* xb_in; bf16_t* xb_out; float* ss;
    __device__ __forceinline__ void operator()(const f32x4 (&acc)[2][2][4][2], const Unit& u, int wr, int wc, int fr, int fq) const {
        const int row0 = u.pm * BM + wr * 64 + fr, col0 = u.pn * BM + wc * 32 + 8 * fq;
        const size_t xblk0 = (size_t)((u.pm * 16 + wr * 4) * 32 + u.pn * 8 + wc) * 512 + fr * 32 + fq * 8;
#define XBLK(ai, m, bj) (xblk0 + (size_t)((((ai) * 8 + (m)) * 32 + (bj) * 4) * 512))
#pragma unroll
        for (int ai = 0; ai < 2; ++ai) {
            u32x4 pre[4][2];
            if (!XF) {
#pragma unroll
                for (int m = 0; m < 4; ++m)
#pragma unroll
                    for (int bj = 0; bj < 2; ++bj) pre[m][bj] = *(const u32x4*)(xb_in + XBLK(ai, m, bj)); }
#pragma unroll
            for (int m = 0; m < 4; ++m) { const int row = row0 + ai * HALF + m * 16; const size_t off = (size_t)row * DM + col0; float q = 0.f;
#pragma unroll
                for (int bj = 0; bj < 2; ++bj) { f32x4 r0, r1;
                    if (XF) { r0 = *(const f32x4*)(xf + off + bj * HALF); r1 = *(const f32x4*)(xf + off + bj * HALF + 4); }
                    else { const u32x4 w = pre[m][bj];
                        r0 = (f32x4){__uint_as_float(w.x << 16), __uint_as_float(w.x & 0xffff0000u), __uint_as_float(w.y << 16), __uint_as_float(w.y & 0xffff0000u)};
                        r1 = (f32x4){__uint_as_float(w.z << 16), __uint_as_float(w.z & 0xffff0000u), __uint_as_float(w.w << 16), __uint_as_float(w.w & 0xffff0000u)}; }
                    r0 = r0 + acc[ai][bj][m][0]; r1 = r1 + acc[ai][bj][m][1];
                    q += ((r0[0] * r0[0] + r0[1] * r0[1]) + (r0[2] * r0[2] + r0[3] * r0[3])) + ((r1[0] * r1[0] + r1[1] * r1[1]) + (r1[2] * r1[2] + r1[3] * r1[3]));
                    u32x4 w; w.x = cvt_pk_bf16(r0[0], r0[1]); w.y = cvt_pk_bf16(r0[2], r0[3]); w.z = cvt_pk_bf16(r1[0], r1[1]); w.w = cvt_pk_bf16(r1[2], r1[3]);
                    *(u32x4*)(xb_out + XBLK(ai, m, bj)) = w; }
                q += __shfl_xor(q, 16); q += __shfl_xor(q, 32);
                if (fq == 0) ss[(size_t)row * 16 + u.pn * 4 + wc] = q; }
            asm volatile("" ::: "memory");
        }
    }
};
#undef XBLK
struct EpiResF {
    static constexpr bool PERM = false, AFTER_DRAIN = false;
    const bf16_t* xb; float* xo; float* ss;
    __device__ __forceinline__ void operator()(const f32x4 (&acc)[2][2][4][2], const Unit& u, int wr, int wc, int fr, int fq) const {
        const int row0 = u.pm * BM + wr * 64 + fr, col0 = u.pn * BM + wc * 32 + 4 * fq;
#pragma unroll
        for (int ai = 0; ai < 2; ++ai)
#pragma unroll
            for (int m = 0; m < 4; ++m) { const int row = row0 + ai * HALF + m * 16; const size_t off = (size_t)row * DM + col0; float q = 0.f;
#pragma unroll
                for (int bj = 0; bj < 2; ++bj)
#pragma unroll
                    for (int n = 0; n < 2; ++n) { const size_t c = off + bj * HALF + n * 16; const u32x2 w = *(const u32x2*)(xb + ((size_t)(((row >> 4) * 32) + u.pn * 8 + wc + bj * 4) * 512 + (row & 15) * 32 + 4 * fq + n * 16));
                        const f32x4 r = (f32x4){__uint_as_float(w.x << 16), __uint_as_float(w.x & 0xffff0000u), __uint_as_float(w.y << 16), __uint_as_float(w.y & 0xffff0000u)} + acc[ai][bj][m][n];
                        *(f32x4*)(xo + c) = r; q += (r[0] * r[0] + r[1] * r[1]) + (r[2] * r[2] + r[3] * r[3]); }
                q += __shfl_xor(q, 16); q += __shfl_xor(q, 32);
                if (fq == 0) ss[(size_t)row * 16 + u.pn * 4 + wc] = q;
                if (m & 1) asm volatile("" ::: "memory"); }
    }
};
struct EpiFinal {
    static constexpr bool PERM = false, AFTER_DRAIN = false;
    const bf16_t* xb; float* out; const float* g; unsigned* xbuf; unsigned* cnt; PG8_LAS unsigned char* tab;
    __device__ __forceinline__ void operator()(f32x4 (&acc)[2][2][4][2], const Unit& u, int wr, int wc, int fr, int fq) const {
        const int tid = threadIdx.x, lane = tid & 63, wid = __builtin_amdgcn_readfirstlane(tid >> 6);
        PG8_LAS float* P = (PG8_LAS float*)tab; PG8_LAS float* S = (PG8_LAS float*)(tab + 4096);
        const int col0 = u.pn * BM + wc * 32 + 4 * fq;
#pragma unroll
        for (int ai = 0; ai < 2; ++ai)
#pragma unroll
            for (int m = 0; m < 4; ++m) { const int rl = ai * HALF + wr * 64 + m * 16 + fr; const size_t off = (size_t)(u.pm * BM + rl) * DM + col0; float q = 0.f;
#pragma unroll
                for (int bj = 0; bj < 2; ++bj)
#pragma unroll
                    for (int n = 0; n < 2; ++n) { const u32x2 w = *(const u32x2*)(xb + ((size_t)((u.pm * 16 + ai * 8 + wr * 4 + m) * 32 + u.pn * 8 + wc + bj * 4) * 512 + fr * 32 + 4 * fq + n * 16));
                        const f32x4 r = (f32x4){__uint_as_float(w.x << 16), __uint_as_float(w.x & 0xffff0000u), __uint_as_float(w.y << 16), __uint_as_float(w.y & 0xffff0000u)} + acc[ai][bj][m][n];
                        acc[ai][bj][m][n] = r; q += (r[0] * r[0] + r[1] * r[1]) + (r[2] * r[2] + r[3] * r[3]); }
                q += __shfl_xor(q, 16); q += __shfl_xor(q, 32);
                if (fq == 0) P[rl * 4 + wc] = q;
                if (m & 1) asm volatile("" ::: "memory"); }
        asm volatile("s_waitcnt lgkmcnt(0)" ::: "memory"); __builtin_amdgcn_s_barrier(); asm volatile("" ::: "memory");
        unsigned* slot = xbuf + ((size_t)(u.pm * BM + (tid & 255)) * 4);
        if (tid < 256) { const f32x4 a = *(const PG8_LAS f32x4*)(P + tid * 4);
            __hip_atomic_store(slot + u.pn, __float_as_uint((a[0] + a[1]) + (a[2] + a[3])), __ATOMIC_RELAXED, __HIP_MEMORY_SCOPE_AGENT); }
        asm volatile("s_waitcnt vmcnt(0)" ::: "memory");
        if (tid < 256 && lane == 0) __hip_atomic_fetch_add(cnt + 64 * u.pm, 1u, __ATOMIC_RELAXED, __HIP_MEMORY_SCOPE_AGENT);
        if (wid == 0) {
            unsigned sp = 0;
            while ((unsigned)__builtin_amdgcn_readfirstlane(__hip_atomic_load(cnt + 64 * u.pm, __ATOMIC_RELAXED, __HIP_MEMORY_SCOPE_AGENT)) < 16u) { __builtin_amdgcn_s_sleep(2); if (++sp > (1u << 22)) break; }
            __builtin_amdgcn_fence(__ATOMIC_ACQUIRE, "agent");
        }
        asm volatile("s_waitcnt vmcnt(0) lgkmcnt(0)" ::: "memory"); __builtin_amdgcn_s_barrier(); asm volatile("" ::: "memory");
        if (tid < 256) { float t = 0.f;
#pragma unroll
            for (int k = 0; k < 4; ++k) t += __uint_as_float(__hip_atomic_load(slot + k, __ATOMIC_RELAXED, __HIP_MEMORY_SCOPE_AGENT));
            S[tid] = 1.0f / sqrtf(t * (1.f / DM) + EPS); }
        asm volatile("s_waitcnt lgkmcnt(0)" ::: "memory"); __builtin_amdgcn_s_barrier(); asm volatile("" ::: "memory");
        f32x4 gg[2][2];
#pragma unroll
        for (int bj = 0; bj < 2; ++bj)
#pragma unroll
            for (int n = 0; n < 2; ++n) gg[bj][n] = *(const f32x4*)(g + col0 + bj * HALF + n * 16);
#pragma unroll
        for (int ai = 0; ai < 2; ++ai)
#pragma unroll
            for (int m = 0; m < 4; ++m) { const int rl = ai * HALF + wr * 64 + m * 16 + fr; const size_t off = (size_t)(u.pm * BM + rl) * DM + col0; const float rs = S[rl];
#pragma unroll
                for (int bj = 0; bj < 2; ++bj)
#pragma unroll
                    for (int n = 0; n < 2; ++n) *(f32x4*)(out + off + bj * HALF + n * 16) = acc[ai][bj][m][n] * rs * gg[bj][n]; }
    }
};
template <int ACT> struct EpiScaleBf16 {
    static constexpr bool PERM = true, AFTER_DRAIN = false;
    bf16_t* O; int ldc; const float* ss; float mul; PG8_LAS unsigned char* tab;
    __device__ __forceinline__ void operator()(const f32x4 (&acc)[2][2][4][2], const Unit& u, int wr, int wc, int fr, int fq) const {
        const int tid = threadIdx.x; PG8_LAS float* S = (PG8_LAS float*)tab;
        if (tid < 256) S[tid] = rstd_ss(ss, u.pm * BM + tid) * mul;
        asm volatile("s_waitcnt lgkmcnt(0)" ::: "memory"); __builtin_amdgcn_s_barrier(); asm volatile("" ::: "memory");
        const int rl0 = wr * 64 + fr, col0 = u.pn * BM + wc * 32 + 8 * fq;
#pragma unroll
        for (int ai = 0; ai < 2; ++ai)
#pragma unroll
            for (int m = 0; m < 4; ++m) { const int rl = rl0 + ai * HALF + m * 16; const float rs = S[rl];
                bf16_t* rowp = O + ((size_t)((u.pm * 16 + wr * 4 + ai * 8 + m) * (ldc >> 5) + u.pn * 8 + wc) * 512 + fr * 32 + fq * 8);
#pragma unroll
                for (int bj = 0; bj < 2; ++bj) { f32x4 v0 = acc[ai][bj][m][0] * rs, v1 = acc[ai][bj][m][1] * rs;
                    if (ACT == 1) {
#pragma unroll
                        for (int e = 0; e < 4; ++e) { const float a = fmaxf(v0[e], 0.f), b = fmaxf(v1[e], 0.f); v0[e] = a * a; v1[e] = b * b; } }
                    u32x4 w; w.x = cvt_pk_bf16(v0[0], v0[1]); w.y = cvt_pk_bf16(v0[2], v0[3]); w.z = cvt_pk_bf16(v1[0], v1[1]); w.w = cvt_pk_bf16(v1[2], v1[3]);
                    *(u32x4*)(rowp + bj * 4 * 512) = w; } }
        __builtin_amdgcn_s_barrier();
    }
};

template <class Epi, class Sched, bool ALIGN_EPI = false, bool SP2 = false>
__device__ __forceinline__ void gemm_phase(PG8_LAS unsigned char* lds, const Gemm g, const Sched& S, const Epi& E) {
    const int tid = threadIdx.x, wid = __builtin_amdgcn_readfirstlane(tid >> 6), lane = tid & 63, wr = wid >> 2, wc = wid & 3, fr = lane & 15, fq = lane >> 4;
    const int K = g.K, nt = K / BK;
    unsigned voffA[2], voffB[2];
#pragma unroll
    for (int i = 0; i < 2; ++i) { int R, C; stage_rc(tid * 16 + i * 8192, R, C); const int Rb = Epi::PERM ? ((R & ~31) + perm32(R & 31)) : R;
        voffA[i] = g.ablk ? (unsigned)(((R >> 4) * (K >> 5) + (C >> 5)) * 1024 + (R & 15) * 64 + (C & 31) * 2) : (unsigned)(R * K + C) * 2u; voffB[i] = (unsigned)(Rb * K + C) * 2u; }
    const size_t kstep = (size_t)(BK * 2);
    const size_t hstep = (size_t)HALF * K * 2;
    const size_t kstepA = g.ablk ? (size_t)2048 : kstep, hstepA = g.ablk ? (size_t)8 * (K >> 5) * 1024 : hstep, tstepA = 2 * hstepA;
    const size_t tstep = 2 * hstep;
    const unsigned ldsw = (unsigned)wid * 1024u;
    const int aoff = lds_byte(wr * 64 + fr, fq * 8), boff = lds_byte(wc * 32 + fr, fq * 8);
#define PG8_SA(b, h) (((b) * 2 + (h)) * HTB)
#define PG8_SB(b, h) ((4 + (b) * 2 + (h)) * HTB)
#define PG8_STAGE(bufoff, gbase, voff) do { _Pragma("unroll") for (int _i = 0; _i < 2; ++_i) \
        __builtin_amdgcn_global_load_lds((const unsigned*)((const char*)(gbase) + (voff)[_i]), (PG8_LAS unsigned*)(lds + (bufoff) + ldsw + _i * 8192), 16, 0, 0); } while (0)
#define PG8_LDA(dst, b, h) do { _Pragma("unroll") for (int m = 0; m < 4; ++m) _Pragma("unroll") for (int k = 0; k < 2; ++k) dst[m][k] = *(const PG8_LAS bf16x8*)(lds + PG8_SA(b, h) + aoff + m * 2048 + k * 1024); } while (0)
#define PG8_LDB(dst, b, h) do { _Pragma("unroll") for (int n = 0; n < 2; ++n) _Pragma("unroll") for (int k = 0; k < 2; ++k) dst[n][k] = *(const PG8_LAS bf16x8*)(lds + PG8_SB(b, h) + boff + n * 2048 + k * 1024); } while (0)
#define PG8_MMA(ai, bj, At, Bt) do { __builtin_amdgcn_s_setprio(1); _Pragma("unroll") for (int m = 0; m < 4; ++m) _Pragma("unroll") for (int n = 0; n < 2; ++n) _Pragma("unroll") for (int k = 0; k < 2; ++k) \
        acc[ai][bj][m][n] = __builtin_amdgcn_mfma_f32_16x16x32_bf16(Bt[n][k], At[m][k], acc[ai][bj][m][n], 0, 0, 0); __builtin_amdgcn_s_setprio(0); } while (0)
#define PG8_WAIT_V(n) asm volatile("s_waitcnt vmcnt(" #n ")" ::: "memory")
#define PG8_WAIT_L(n) asm volatile("s_waitcnt lgkmcnt(" #n ")" ::: "memory")
#define PG8_BAR __builtin_amdgcn_s_barrier()
#define PG8_SCHED __builtin_amdgcn_sched_barrier(0)
    Unit cur, nxt; int ui = 0;
    if (!S.next(0, cur)) return;
    f32x4 acc[2][2][4][2];
#pragma unroll
    for (int a = 0; a < 2; ++a)
#pragma unroll
        for (int b = 0; b < 2; ++b)
#pragma unroll
            for (int m = 0; m < 4; ++m)
#pragma unroll
                for (int n = 0; n < 2; ++n) acc[a][b][m][n] = (f32x4){0.f, 0.f, 0.f, 0.f};
    bf16x8 At[4][2], B0[2][2], B1[2][2];
    const char* cA = (const char*)(cur.alt ? g.A2 : g.A) + (size_t)cur.pm * tstepA; const char* cB = (const char*)(cur.alt ? g.Bt2 : g.Bt) + (size_t)cur.pn * tstep;
    S.a_ready(cur);
    if constexpr (SP2) {
        PG8_STAGE(PG8_SB(0, 0), cB, voffB); PG8_STAGE(PG8_SB(0, 1), cB + hstep, voffB); PG8_STAGE(PG8_SA(0, 0), cA, voffA); PG8_STAGE(PG8_SA(0, 1), cA + hstepA, voffA);
        if (wr == 1) PG8_BAR;
        PG8_WAIT_V(2); PG8_BAR;
        PG8_STAGE(PG8_SB(1, 0), cB + kstep, voffB); PG8_STAGE(PG8_SA(1, 0), cA + kstepA, voffA); PG8_STAGE(PG8_SB(1, 1), cB + hstep + kstep, voffB);
        PG8_WAIT_V(6); PG8_BAR;
    } else {
        PG8_STAGE(PG8_SB(0, 0), cB, voffB); PG8_STAGE(PG8_SA(0, 0), cA, voffA); PG8_STAGE(PG8_SB(0, 1), cB + hstep, voffB); PG8_STAGE(PG8_SA(0, 1), cA + hstepA, voffA);
        if (wr == 1) PG8_BAR;
        PG8_WAIT_V(4); PG8_BAR;
        PG8_STAGE(PG8_SB(1, 0), cB + kstep, voffB); PG8_STAGE(PG8_SA(1, 0), cA + kstepA, voffA); PG8_STAGE(PG8_SB(1, 1), cB + hstep + kstep, voffB);
        PG8_WAIT_V(6); PG8_BAR;
    }
    for (;;) {
        const bool has_next = S.next(ui + 1, nxt);
        const char* nA = has_next ? (const char*)(nxt.alt ? g.A2 : g.A) + (size_t)nxt.pm * tstepA : cA; const char* nB = has_next ? (const char*)(nxt.alt ? g.Bt2 : g.Bt) + (size_t)nxt.pn * tstep : cB;
        for (int t = 0; t < nt; t += 2) {
            const bool last = (t == nt - 2);
            const char* a1 = cA + (size_t)(t + 1) * kstepA;
            const char* a2 = last ? nA : cA + (size_t)(t + 2) * kstepA; const char* b2 = last ? nB : cB + (size_t)(t + 2) * kstep;
            const char* a3 = a2 + kstepA; const char* b3 = b2 + kstep;
            if (last && has_next) S.a_ready(nxt);
            if constexpr (SP2) {
            PG8_LDB(B0, 0, 0); PG8_LDB(B1, 0, 1); PG8_SCHED; PG8_LDA(At, 0, 0); PG8_STAGE(PG8_SA(1, 1), a1 + hstepA, voffA);
            PG8_WAIT_V(8); PG8_WAIT_L(0); PG8_BAR; PG8_MMA(0, 0, At, B0); PG8_MMA(0, 1, At, B1); PG8_BAR; PG8_SCHED;
            PG8_LDA(At, 0, 1); PG8_STAGE(PG8_SB(0, 0), b2, voffB); PG8_STAGE(PG8_SB(0, 1), b2 + hstep, voffB); PG8_STAGE(PG8_SA(0, 0), a2, voffA);
            PG8_WAIT_V(8); PG8_WAIT_L(0); PG8_BAR; PG8_MMA(1, 0, At, B0); PG8_MMA(1, 1, At, B1); PG8_BAR; PG8_SCHED;
            PG8_LDB(B0, 1, 0); PG8_LDB(B1, 1, 1); PG8_SCHED; PG8_LDA(At, 1, 0); PG8_STAGE(PG8_SA(0, 1), a2 + hstepA, voffA);
            PG8_WAIT_V(8); PG8_WAIT_L(0); PG8_BAR; PG8_MMA(0, 0, At, B0); PG8_MMA(0, 1, At, B1); PG8_BAR; PG8_SCHED;
            PG8_LDA(At, 1, 1); PG8_STAGE(PG8_SB(1, 0), b3, voffB); PG8_STAGE(PG8_SB(1, 1), b3 + hstep, voffB); PG8_STAGE(PG8_SA(1, 0), a3, voffA);
            PG8_WAIT_V(8); PG8_WAIT_L(0); PG8_BAR; PG8_MMA(1, 0, At, B0); PG8_MMA(1, 1, At, B1); PG8_BAR; PG8_SCHED;
            } else {
            PG8_LDB(B0, 0, 0); PG8_SCHED; PG8_LDA(At, 0, 0); PG8_STAGE(PG8_SA(1, 1), a1 + hstepA, voffA);
            PG8_WAIT_L(8); PG8_BAR; PG8_WAIT_L(0); PG8_MMA(0, 0, At, B0); PG8_BAR; PG8_SCHED;
            PG8_LDB(B1, 0, 1); PG8_STAGE(PG8_SB(0, 0), b2, voffB);
            PG8_BAR; PG8_WAIT_L(0); PG8_MMA(0, 1, At, B1); PG8_BAR;
            PG8_LDA(At, 0, 1); PG8_STAGE(PG8_SA(0, 0), a2, voffA);
            PG8_BAR; PG8_WAIT_L(0); PG8_MMA(1, 0, At, B0); PG8_BAR; PG8_SCHED;
            PG8_STAGE(PG8_SB(0, 1), b2 + hstep, voffB);
            PG8_WAIT_V(6); PG8_BAR; PG8_MMA(1, 1, At, B1); PG8_BAR;
            PG8_LDB(B0, 1, 0); PG8_SCHED; PG8_LDA(At, 1, 0); PG8_STAGE(PG8_SA(0, 1), a2 + hstepA, voffA);
            PG8_WAIT_L(8); PG8_BAR; PG8_WAIT_L(0); PG8_MMA(0, 0, At, B0); PG8_BAR; PG8_SCHED;
            PG8_LDB(B1, 1, 1); PG8_STAGE(PG8_SB(1, 0), b3, voffB);
            PG8_BAR; PG8_WAIT_L(0); PG8_MMA(0, 1, At, B1); PG8_BAR;
            PG8_LDA(At, 1, 1); PG8_STAGE(PG8_SA(1, 0), a3, voffA);
            PG8_BAR; PG8_WAIT_L(0); PG8_MMA(1, 0, At, B0); PG8_BAR; PG8_SCHED;
            PG8_STAGE(PG8_SB(1, 1), b3 + hstep, voffB);
            PG8_WAIT_V(6); PG8_BAR; PG8_MMA(1, 1, At, B1); PG8_BAR;
            }
        }
        if constexpr (ALIGN_EPI) { if (wr == 0) PG8_BAR; }
        if constexpr (!Epi::AFTER_DRAIN) { E(acc, cur, wr, wc, fr, fq); S.done(cur); }
        if (!has_next) break;
#pragma unroll
        for (int a = 0; a < 2; ++a)
#pragma unroll
            for (int b = 0; b < 2; ++b)
#pragma unroll
                for (int m = 0; m < 4; ++m)
#pragma unroll
                    for (int n = 0; n < 2; ++n) acc[a][b][m][n] = (f32x4){0.f, 0.f, 0.f, 0.f};
        cur = nxt; cA = nA; cB = nB; ++ui;
        if constexpr (ALIGN_EPI) { if (wr == 1) PG8_BAR; }
    }
    PG8_WAIT_V(0);
    if constexpr (!ALIGN_EPI) { if (wr == 0) PG8_BAR; }
    PG8_BAR;
    if constexpr (Epi::AFTER_DRAIN) { E.fused(acc, cur, wr, wc, fr, fq, lds, wid, lane); S.done(cur); }
#undef PG8_SA
#undef PG8_SB
#undef PG8_STAGE
#undef PG8_LDA
#undef PG8_LDB
#undef PG8_MMA
#undef PG8_WAIT_V
#undef PG8_WAIT_L
#undef PG8_BAR
#undef PG8_SCHED
}
}
namespace fa {
typedef short bf16x8 __attribute__((ext_vector_type(8)));
typedef short s16x4 __attribute__((ext_vector_type(4)));
typedef float f32x16 __attribute__((ext_vector_type(16)));
typedef float f32x4 __attribute__((ext_vector_type(4)));
typedef unsigned u32x4 __attribute__((ext_vector_type(4)));
constexpr int NW = 8, QBLK = 32, KVBLK = 64;
constexpr float THR = 8.f;
#define FA_SBAR() __builtin_amdgcn_sched_barrier(0)
#define FA_VMW() asm volatile("s_waitcnt vmcnt(0)" ::: "memory")
__device__ __forceinline__ int crow(int r, int hi) { return (r & 3) + 8 * (r >> 2) + 4 * hi; }
typedef __bf16 cvt_bf2a __attribute__((ext_vector_type(2))); typedef float cvt_f2a __attribute__((ext_vector_type(2)));
__device__ __forceinline__ unsigned cvtpk(float lo, float hi) { const cvt_f2a v = {lo, hi}; return __builtin_bit_cast(unsigned, __builtin_convertvector(v, cvt_bf2a)); }

template <int NDQ> __device__ __forceinline__ int kswz(int row, int c) {
    if (NDQ == 4) return row * 128 + ((c ^ ((row >> 1) & 7)) << 4);
    else return row * (NDQ * 32) + ((c ^ (row & 15)) << 4);
}
template <int NDVT> __device__ __forceinline__ int v_st(int k, int c) { const int kk = (k & ~0xC) | ((k & 4) << 1) | ((k & 8) >> 1); return ((kk >> 3) * NDVT + (c >> 5)) * 512 + ((kk & 7) * 32 + (c & 31)) * 2; }
__device__ __forceinline__ int v_rd_base(int lane) { return ((lane & 3) << 3) | (((lane >> 2) & 3) << 6) | (((lane >> 4) & 1) << 5) | (((lane >> 5) & 1) << 8); }

__device__ __forceinline__ void mask_tile(f32x16& p0, f32x16& p1, int dq, unsigned W) {
    const float NEG = -__builtin_inff();
#pragma unroll
    for (int r = 0; r < 16; ++r) { const int c = (r & 3) + 8 * (r >> 2);
        if ((unsigned)(dq - c) >= W) p0[r] = NEG;
        if ((unsigned)(dq - c - 32) >= W) p1[r] = NEG; }
}
__device__ __forceinline__ void partialSM(f32x16& p0, f32x16& p1, float& m_reg, float& alpha) {
    float pmax = p0[0];
#pragma unroll
    for (int r = 1; r < 16; ++r) pmax = fmaxf(pmax, p0[r]);
#pragma unroll
    for (int r = 0; r < 16; ++r) pmax = fmaxf(pmax, p1[r]);
    { auto rr = __builtin_amdgcn_permlane32_swap(__float_as_uint(pmax), __float_as_uint(pmax), false, false); pmax = fmaxf(__uint_as_float(rr[0]), __uint_as_float(rr[1])); }
    float mn;
    if (__builtin_expect(__all((pmax - m_reg) <= THR), 1)) { mn = m_reg; alpha = 1.f; }
    else { mn = fmaxf(m_reg, pmax); alpha = __builtin_amdgcn_exp2f(m_reg - mn); m_reg = mn; }
#pragma unroll
    for (int r = 0; r < 16; ++r) p0[r] = p0[r] - mn;
#pragma unroll
    for (int r = 0; r < 16; ++r) p1[r] = p1[r] - mn;
#pragma unroll
    for (int r = 0; r < 16; ++r) p0[r] = __builtin_amdgcn_exp2f(p0[r]);
}
__device__ __forceinline__ void finishSM(f32x16& p0, f32x16& p1, float alpha, float& l_reg, bf16x8& pa0, bf16x8& pa1, bf16x8& pa2, bf16x8& pa3) {
#pragma unroll
    for (int r = 0; r < 16; ++r) p1[r] = __builtin_amdgcn_exp2f(p1[r]);
    float ps = 0.f;
#pragma unroll
    for (int r = 0; r < 16; ++r) ps += p0[r];
#pragma unroll
    for (int r = 0; r < 16; ++r) ps += p1[r];
    { auto rr = __builtin_amdgcn_permlane32_swap(__float_as_uint(ps), __float_as_uint(ps), false, false); ps = __uint_as_float(rr[0]) + __uint_as_float(rr[1]); }
    l_reg = l_reg * alpha + ps;
#define FA_PK4(P, B_, OUT) do { unsigned a0 = cvtpk(P[B_ + 0], P[B_ + 1]), a1 = cvtpk(P[B_ + 2], P[B_ + 3]); unsigned b0 = cvtpk(P[B_ + 4], P[B_ + 5]), b1 = cvtpk(P[B_ + 6], P[B_ + 7]); \
        auto r0 = __builtin_amdgcn_permlane32_swap(a0, b0, false, false); auto r1 = __builtin_amdgcn_permlane32_swap(a1, b1, false, false); \
        u32x4 w = {r0[0], r1[0], r0[1], r1[1]}; OUT = *reinterpret_cast<bf16x8*>(&w); } while (0)
    FA_PK4(p0, 0, pa0); FA_PK4(p0, 8, pa1); FA_PK4(p1, 0, pa2); FA_PK4(p1, 8, pa3);
#undef FA_PK4
}
template <int NDQ>
__device__ __forceinline__ void qkt(f32x16& p0, f32x16& p1, const char* Kb, int r32, int hi, const bf16x8* qr) {
    p0 = f32x16{}; p1 = f32x16{};
    constexpr int NA = NDQ < 8 ? NDQ : 8;
    const char* kb[NA];
#pragma unroll
    for (int dd = 0; dd < NA; ++dd) kb[dd] = Kb + kswz<NDQ>(r32, 2 * dd + hi);
#pragma unroll
    for (int d0 = 0; d0 < NDQ; ++d0) { const char* a = kb[d0 & (NA - 1)] + (d0 >> 3) * 256;
        const bf16x8 b0 = *reinterpret_cast<const bf16x8*>(a);
        const bf16x8 b1 = *reinterpret_cast<const bf16x8*>(a + 32 * NDQ * 32);
        p0 = __builtin_amdgcn_mfma_f32_32x32x16_bf16(b0, qr[d0], p0, 0, 0, 0);
        p1 = __builtin_amdgcn_mfma_f32_32x32x16_bf16(b1, qr[d0], p1, 0, 0, 0); }
}
template <int NDVT, int NDV>
__device__ __forceinline__ void pv_tile(f32x16* o, int vb, bf16x8 pa0, bf16x8 pa1, bf16x8 pa2, bf16x8 pa3) {
#define FA_TRRD(dst, off) asm volatile("ds_read_b64_tr_b16 %0, %1 offset:%2" : "=&v"(dst) : "v"(vb), "i"(off) : "memory")
#define FA_PV_D0(d0) do { s16x4 l0, l1, l2, l3, h0, h1, h2, h3; constexpr int b_ = (d0) * 512, ks_ = 2 * NDVT * 512, hf_ = NDVT * 512; \
        FA_TRRD(l0, b_); FA_TRRD(h0, b_ + hf_); FA_TRRD(l1, b_ + ks_); FA_TRRD(h1, b_ + ks_ + hf_); FA_TRRD(l2, b_ + 2 * ks_); FA_TRRD(h2, b_ + 2 * ks_ + hf_); FA_TRRD(l3, b_ + 3 * ks_); FA_TRRD(h3, b_ + 3 * ks_ + hf_); \
        asm volatile("s_waitcnt lgkmcnt(0)" ::: "memory"); FA_SBAR(); \
        o[d0] = __builtin_amdgcn_mfma_f32_32x32x16_bf16(pa0, (bf16x8){l0[0], l0[1], l0[2], l0[3], h0[0], h0[1], h0[2], h0[3]}, o[d0], 0, 0, 0); \
        o[d0] = __builtin_amdgcn_mfma_f32_32x32x16_bf16(pa1, (bf16x8){l1[0], l1[1], l1[2], l1[3], h1[0], h1[1], h1[2], h1[3]}, o[d0], 0, 0, 0); \
        o[d0] = __builtin_amdgcn_mfma_f32_32x32x16_bf16(pa2, (bf16x8){l2[0], l2[1], l2[2], l2[3], h2[0], h2[1], h2[2], h2[3]}, o[d0], 0, 0, 0); \
        o[d0] = __builtin_amdgcn_mfma_f32_32x32x16_bf16(pa3, (bf16x8){l3[0], l3[1], l3[2], l3[3], h3[0], h3[1], h3[2], h3[3]}, o[d0], 0, 0, 0); } while (0)
    FA_PV_D0(0); if constexpr (NDV > 1) FA_PV_D0(1); if constexpr (NDV > 2) FA_PV_D0(2); if constexpr (NDV > 3) FA_PV_D0(3);
#undef FA_PV_D0
#undef FA_TRRD
}

template <int NDQ, int NDVT, int NDV>
struct Core {
    static constexpr int KROW = NDQ * 32, SHM_K = 64 * KROW, SHM_V = 64 * NDVT * 64, NKL = NDQ / 4, NVL = NDVT / 2, LDS_NEED = 2 * SHM_V + 2 * SHM_K + NW * 256;
    static_assert(NKL >= 1 && NVL >= 1, "tile too small for 512 staging threads");
    __device__ __forceinline__ static void run(f32x16 (&o)[NDV], float& m_reg, float& l_reg, const bf16* Qw, int ldq, const bf16* Kg, const bf16* Vg, int ldk,
                                               int j_lo, int j_hi, int qlo, int W, char* lds, int vdoff) {
        int tid = threadIdx.x; asm volatile("" : "+v"(tid));
        const int wid = __builtin_amdgcn_readfirstlane(tid >> 6), lane = tid & 63, r32 = lane & 31, hi = lane >> 5;
        const int NT = j_hi - j_lo, qm = qlo + r32 - 4 * hi;
        char* V_lds = lds; char* K_lds = lds + 2 * SHM_V;
        float* wsf = (float*)(lds + 2 * SHM_V + 2 * SHM_K) + wid * 64; float* al_l = wsf + 32;
        m_reg = -1e30f; l_reg = 0.f;
#pragma unroll
        for (int d = 0; d < NDV; ++d) o[d] = f32x16{};
        constexpr int KCH = 2 * NDQ, KRS = 512 / KCH, VCH = 4 * NDVT, VRS = 512 / VCH;
        const int krow0 = tid / KCH, kch = tid % KCH, vrow0 = tid / VCH, vcol = (tid % VCH) * 8;
        int kws[NKL], vws[NVL];
#pragma unroll
        for (int i = 0; i < NKL; ++i) kws[i] = kswz<NDQ>(krow0 + i * KRS, kch);
#pragma unroll
        for (int i = 0; i < NVL; ++i) vws[i] = v_st<NDVT>(vrow0 + i * VRS, vcol);
        const bf16* kgp = Kg + (size_t)krow0 * ldk + kch * 8; const bf16* vgp = Vg + (size_t)vrow0 * ldk + vcol;
        bf16x8 sk[NKL], sv[NVL];
        const int vb0 = (int)(uintptr_t)V_lds + v_rd_base(lane) + vdoff * 512;
#define FA_SLOAD(t) do { const size_t ro_ = (size_t)((j_lo + (t)) * KVBLK) * ldk; \
        _Pragma("unroll") for (int i_ = 0; i_ < NVL; ++i_) sv[i_] = *reinterpret_cast<const bf16x8*>(vgp + ro_ + (size_t)(i_ * VRS) * ldk); \
        _Pragma("unroll") for (int i_ = 0; i_ < NKL; ++i_) sk[i_] = *reinterpret_cast<const bf16x8*>(kgp + ro_ + (size_t)(i_ * KRS) * ldk); } while (0)
#define FA_SWRITE(bf) do { _Pragma("unroll") for (int i_ = 0; i_ < NVL; ++i_) *reinterpret_cast<bf16x8*>(V_lds + (bf) * SHM_V + vws[i_]) = sv[i_]; \
        _Pragma("unroll") for (int i_ = 0; i_ < NKL; ++i_) *reinterpret_cast<bf16x8*>(K_lds + (bf) * SHM_K + kws[i_]) = sk[i_]; } while (0)
#define FA_RESC(a) do { if (__any((a) < 1.f)) { if (hi == 0) al_l[r32] = (a); asm volatile("s_waitcnt lgkmcnt(0)" ::: "memory"); \
        _Pragma("unroll") for (int d_ = 0; d_ < NDV; ++d_) _Pragma("unroll") for (int r = 0; r < 16; ++r) o[d_][r] *= al_l[crow(r, hi)]; } } while (0)
#define FA_KBASE(t) ((j_lo + (t)) * KVBLK)
#define FA_MASKT(P0_, P1_, t) do { const int kb_ = FA_KBASE(t); if (kb_ + KVBLK - 1 > qlo || kb_ <= qlo + QBLK - 1 - W) mask_tile(P0_, P1_, qm - kb_, (unsigned)W); } while (0)
        bf16x8 qr[NDQ];
#pragma unroll
        for (int d0 = 0; d0 < NDQ; ++d0) qr[d0] = *reinterpret_cast<const bf16x8*>(Qw + (size_t)r32 * ldq + d0 * 16 + hi * 8);
        FA_SLOAD(0); FA_VMW(); FA_SWRITE(0); FA_SBAR();
        if (NT > 1) FA_SLOAD(1);
        __syncthreads();
        f32x16 pA0, pA1, pB0, pB1; float alA, alB; bf16x8 pa0, pa1, pa2, pa3;
        FA_SBAR(); qkt<NDQ>(pA0, pA1, K_lds, r32, hi, qr);
        FA_MASKT(pA0, pA1, 0); partialSM(pA0, pA1, m_reg, alA);
        if (NT > 1) { FA_VMW(); FA_SWRITE(1); }
        __syncthreads();
#define FA_HALF_STEP(PX0, PX1, alX, PY0, PY1, alY, t, KB, VB, SB) do { \
        FA_SBAR(); qkt<NDQ>(PX0, PX1, K_lds + (KB) * SHM_K, r32, hi, qr); \
        finishSM(PY0, PY1, alY, l_reg, pa0, pa1, pa2, pa3); FA_SBAR(); \
        if ((t) + 1 < NT) { FA_SLOAD((t) + 1); FA_SBAR(); } \
        pv_tile<NDVT, NDV>(o, vb0 + (VB) * SHM_V, pa0, pa1, pa2, pa3); FA_MASKT(PX0, PX1, (t)); partialSM(PX0, PX1, m_reg, alX); \
        __syncthreads(); \
        if ((t) + 1 < NT) { FA_VMW(); FA_SWRITE(SB); } \
        FA_RESC(alX); __syncthreads(); } while (0)
        for (int t = 1; t + 1 < NT; t += 2) {
            FA_HALF_STEP(pB0, pB1, alB, pA0, pA1, alA, t, 1, 0, 0);
            FA_HALF_STEP(pA0, pA1, alA, pB0, pB1, alB, t + 1, 0, 1, 1);
        }
        const bool even = (NT & 1) == 0;
        if (even) { FA_SBAR(); qkt<NDQ>(pB0, pB1, K_lds + SHM_K, r32, hi, qr); FA_SBAR(); }
        finishSM(pA0, pA1, alA, l_reg, pa0, pa1, pa2, pa3); FA_SBAR();
        pv_tile<NDVT, NDV>(o, vb0, pa0, pa1, pa2, pa3);
        if (even) { FA_MASKT(pB0, pB1, NT - 1); partialSM(pB0, pB1, m_reg, alB); FA_RESC(alB);
            finishSM(pB0, pB1, alB, l_reg, pa0, pa1, pa2, pa3); FA_SBAR(); pv_tile<NDVT, NDV>(o, vb0 + SHM_V, pa0, pa1, pa2, pa3); }
        __syncthreads();
#undef FA_SLOAD
#undef FA_SWRITE
#undef FA_RESC
#undef FA_KBASE
#undef FA_MASKT
#undef FA_HALF_STEP
    }
};

#define FA_PIN(x) asm volatile("" : "+v"(x))
#define FA_PK4V(P, B_, OUT) do { unsigned a0_ = cvtpk(P[B_ + 0], P[B_ + 1]), a1_ = cvtpk(P[B_ + 2], P[B_ + 3]); unsigned b0_ = cvtpk(P[B_ + 4], P[B_ + 5]), b1_ = cvtpk(P[B_ + 6], P[B_ + 7]); \
        auto r0_ = __builtin_amdgcn_permlane32_swap(a0_, b0_, false, false); auto r1_ = __builtin_amdgcn_permlane32_swap(a1_, b1_, false, false); \
        u32x4 w_ = {r0_[0], r1_[0], r0_[1], r1_[1]}; OUT = *reinterpret_cast<bf16x8*>(&w_); } while (0)
__device__ __forceinline__ void step_qk_fin(f32x16& X0, f32x16& X1, const char* Kb, int r32, int hi, const bf16x8* qr,
                                            f32x16& Y0, f32x16& Y1, float alY, float& l_reg, bf16x8& pa0, bf16x8& pa1, bf16x8& pa2, bf16x8& pa3) {
    const char* k0 = Kb + kswz<4>(r32, hi); const char* k1 = Kb + kswz<4>(r32, 2 + hi); const char* k2 = Kb + kswz<4>(r32, 4 + hi); const char* k3 = Kb + kswz<4>(r32, 6 + hi);
    bf16x8 fa = *reinterpret_cast<const bf16x8*>(k0), fb = *reinterpret_cast<const bf16x8*>(k0 + 4096);
    float ps;
    X0 = __builtin_amdgcn_mfma_f32_32x32x16_bf16(fa, qr[0], f32x16{}, 0, 0, 0); X1 = __builtin_amdgcn_mfma_f32_32x32x16_bf16(fb, qr[0], f32x16{}, 0, 0, 0);
    fa = *reinterpret_cast<const bf16x8*>(k1); fb = *reinterpret_cast<const bf16x8*>(k1 + 4096);
#pragma unroll
    for (int r = 0; r < 4; ++r) Y1[r] = __builtin_amdgcn_exp2f(Y1[r]);
    ps = (Y0[0] + Y0[1]) + (Y0[2] + Y0[3]);
    FA_PK4V(Y0, 0, pa0); FA_PIN(ps); FA_PIN(pa0); FA_PIN(Y1); FA_SBAR();
    X0 = __builtin_amdgcn_mfma_f32_32x32x16_bf16(fa, qr[1], X0, 0, 0, 0); X1 = __builtin_amdgcn_mfma_f32_32x32x16_bf16(fb, qr[1], X1, 0, 0, 0);
    fa = *reinterpret_cast<const bf16x8*>(k2); fb = *reinterpret_cast<const bf16x8*>(k2 + 4096);
#pragma unroll
    for (int r = 4; r < 8; ++r) Y1[r] = __builtin_amdgcn_exp2f(Y1[r]);
    ps += (Y0[4] + Y0[5]) + (Y0[6] + Y0[7]); ps += (Y1[0] + Y1[1]) + (Y1[2] + Y1[3]);
    FA_PK4V(Y0, 8, pa1); FA_PIN(ps); FA_PIN(pa1); FA_PIN(Y1); FA_SBAR();
    X0 = __builtin_amdgcn_mfma_f32_32x32x16_bf16(fa, qr[2], X0, 0, 0, 0); X1 = __builtin_amdgcn_mfma_f32_32x32x16_bf16(fb, qr[2], X1, 0, 0, 0);
    fa = *reinterpret_cast<const bf16x8*>(k3); fb = *reinterpret_cast<const bf16x8*>(k3 + 4096);
#pragma unroll
    for (int r = 8; r < 12; ++r) Y1[r] = __builtin_amdgcn_exp2f(Y1[r]);
    ps += (Y0[8] + Y0[9]) + (Y0[10] + Y0[11]); ps += (Y1[4] + Y1[5]) + (Y1[6] + Y1[7]);
    FA_PK4V(Y1, 0, pa2); FA_PIN(ps); FA_PIN(pa2); FA_PIN(Y1); FA_SBAR();
    X0 = __builtin_amdgcn_mfma_f32_32x32x16_bf16(fa, qr[3], X0, 0, 0, 0); X1 = __builtin_amdgcn_mfma_f32_32x32x16_bf16(fb, qr[3], X1, 0, 0, 0);
#pragma unroll
    for (int r = 12; r < 16; ++r) Y1[r] = __builtin_amdgcn_exp2f(Y1[r]);
    ps += (Y0[12] + Y0[13]) + (Y0[14] + Y0[15]); ps += (Y1[8] + Y1[9]) + (Y1[10] + Y1[11]); ps += (Y1[12] + Y1[13]) + (Y1[14] + Y1[15]);
    { auto rr = __builtin_amdgcn_permlane32_swap(__float_as_uint(ps), __float_as_uint(ps), false, false); ps = __uint_as_float(rr[0]) + __uint_as_float(rr[1]); }
    l_reg = l_reg * alY + ps;
    FA_PK4V(Y1, 8, pa3); FA_PIN(l_reg); FA_PIN(pa3); FA_PIN(X0); FA_PIN(X1); FA_SBAR();
}
__device__ __forceinline__ void step_pv_max(f32x16* o, int vb, bf16x8 pa0, bf16x8 pa1, bf16x8 pa2, bf16x8 pa3, f32x16& X0, f32x16& X1, float& m_reg, float& alpha, bool MASK, int dq, unsigned W) {
#define FA_TRRD(dst, off) asm volatile("ds_read_b64_tr_b16 %0, %1 offset:%2" : "=&v"(dst) : "v"(vb), "i"(off) : "memory")
#define FA_RD2(l, h, d0, ks) do { FA_TRRD(l, (d0) * 512 + (ks) * 4096); FA_TRRD(h, (d0) * 512 + (ks) * 4096 + 2048); } while (0)
#define FA_FRAG(l, h) (bf16x8){l[0], l[1], l[2], l[3], h[0], h[1], h[2], h[3]}
    s16x4 l0, h0, l1, h1, l2, h2, l3, h3;
    FA_RD2(l0, h0, 0, 0); FA_RD2(l1, h1, 0, 1); FA_RD2(l2, h2, 0, 2); FA_RD2(l3, h3, 0, 3);
    if (MASK) mask_tile(X0, X1, dq, W);
    float pmax = fmaxf(fmaxf(X0[0], X0[1]), X1[0]);
#pragma unroll
    for (int r = 2; r < 16; r += 2) pmax = fmaxf(fmaxf(pmax, X0[r]), X0[r + 1]);
#pragma unroll
    for (int r = 1; r < 16; r += 2) pmax = fmaxf(fmaxf(pmax, X1[r]), X1[(r + 1) & 15]);
    { auto rr = __builtin_amdgcn_permlane32_swap(__float_as_uint(pmax), __float_as_uint(pmax), false, false); pmax = fmaxf(__uint_as_float(rr[0]), __uint_as_float(rr[1])); }
    float mn;
    if (__builtin_expect(__all((pmax - m_reg) <= THR), 1)) { mn = m_reg; alpha = 1.f; }
    else { mn = fmaxf(m_reg, pmax); alpha = __builtin_amdgcn_exp2f(m_reg - mn); m_reg = mn; }
    FA_PIN(mn);
#define FA_BLK(d0, NXT, FILL) do { asm volatile("s_waitcnt lgkmcnt(0)" ::: "memory"); FA_SBAR(); \
        o[d0] = __builtin_amdgcn_mfma_f32_32x32x16_bf16(pa0, FA_FRAG(l0, h0), o[d0], 0, 0, 0); if (NXT) FA_RD2(l0, h0, (d0) + 1, 0); \
        o[d0] = __builtin_amdgcn_mfma_f32_32x32x16_bf16(pa1, FA_FRAG(l1, h1), o[d0], 0, 0, 0); if (NXT) FA_RD2(l1, h1, (d0) + 1, 1); \
        o[d0] = __builtin_amdgcn_mfma_f32_32x32x16_bf16(pa2, FA_FRAG(l2, h2), o[d0], 0, 0, 0); if (NXT) FA_RD2(l2, h2, (d0) + 1, 2); \
        o[d0] = __builtin_amdgcn_mfma_f32_32x32x16_bf16(pa3, FA_FRAG(l3, h3), o[d0], 0, 0, 0); if (NXT) FA_RD2(l3, h3, (d0) + 1, 3); \
        FILL; } while (0)
    FA_BLK(0, true,  { _Pragma("unroll") for (int r = 0; r < 16; ++r) X0[r] = X0[r] - mn; FA_PIN(X0); });
    FA_BLK(1, true,  { _Pragma("unroll") for (int r = 0; r < 16; ++r) X1[r] = X1[r] - mn; FA_PIN(X1); });
    FA_BLK(2, true,  { _Pragma("unroll") for (int r = 0; r < 8; ++r) X0[r] = __builtin_amdgcn_exp2f(X0[r]); FA_PIN(X0); });
    FA_BLK(3, false, { _Pragma("unroll") for (int r = 8; r < 16; ++r) X0[r] = __builtin_amdgcn_exp2f(X0[r]); FA_PIN(X0); });
    FA_SBAR();
#undef FA_BLK
#undef FA_RD2
#undef FA_FRAG
#undef FA_TRRD
}

template <int NDQ, int NDVT, int NDV>
struct CoreStag {
    static_assert(NDQ == 4 && NDVT == 4 && NDV == 4, "the interleaved interval bodies are written for d_qk = 64, d_v = 128");
    static constexpr int KROW = NDQ * 32, SHM_K = 64 * KROW, SHM_V = 64 * NDVT * 64, NKL = NDQ / 4, NVL = NDVT / 2, LDS_NEED = 2 * SHM_V + 2 * SHM_K + NW * 256;
    __device__ __forceinline__ static void run(f32x16 (&o)[NDV], float& m_reg, float& l_reg, const bf16* Qw, int ldq, const bf16* Kg, const bf16* Vg, int ldk,
                                               int j_lo, int j_hi, int qlo, int W, char* lds, int vdoff) {
        const int tid = threadIdx.x, wid = __builtin_amdgcn_readfirstlane(tid >> 6), lane = tid & 63, r32 = lane & 31, hi = lane >> 5;
        const bool half1 = wid >= 4;
        const int NT = j_hi - j_lo, qm = qlo + r32 - 4 * hi;
        char* V_lds = lds; char* K_lds = lds + 2 * SHM_V;
        float* al_l = (float*)(lds + 2 * SHM_V + 2 * SHM_K) + wid * 64 + 32;
        m_reg = -1e30f; l_reg = 0.f;
#pragma unroll
        for (int d = 0; d < NDV; ++d) o[d] = f32x16{};
        constexpr int KCH = 2 * NDQ, KRS = 512 / KCH, VCH = 4 * NDVT, VRS = 512 / VCH;
        const int krow0 = tid / KCH, kch = tid % KCH, vrow0 = tid / VCH, vcol = (tid % VCH) * 8;
        int kws[NKL], vws[NVL];
#pragma unroll
        for (int i = 0; i < NKL; ++i) kws[i] = kswz<NDQ>(krow0 + i * KRS, kch);
#pragma unroll
        for (int i = 0; i < NVL; ++i) vws[i] = v_st<NDVT>(vrow0 + i * VRS, vcol);
        const bf16* kgp = Kg + (size_t)(j_lo * KVBLK + krow0) * ldk + kch * 8; const bf16* vgp = Vg + (size_t)(j_lo * KVBLK + vrow0) * ldk + vcol;
        bf16x8 sk[NKL], sv[NVL];
        const int vb0 = (int)(uintptr_t)V_lds + v_rd_base(lane) + vdoff * 512;
#define FS_BAR() do { FA_SBAR(); __syncthreads(); FA_SBAR(); } while (0)
#define FS_LOADK(t) do { if ((t) < NT) { const size_t ro_ = (size_t)((t) * KVBLK) * ldk; _Pragma("unroll") for (int i_ = 0; i_ < NKL; ++i_) sk[i_] = *reinterpret_cast<const bf16x8*>(kgp + ro_ + (size_t)(i_ * KRS) * ldk); } } while (0)
#define FS_LOADV(t) do { if ((t) < NT) { const size_t ro_ = (size_t)((t) * KVBLK) * ldk; _Pragma("unroll") for (int i_ = 0; i_ < NVL; ++i_) sv[i_] = *reinterpret_cast<const bf16x8*>(vgp + ro_ + (size_t)(i_ * VRS) * ldk); } } while (0)
#define FS_WRITEK(t, bf) do { if ((t) < NT) { _Pragma("unroll") for (int i_ = 0; i_ < NKL; ++i_) *reinterpret_cast<bf16x8*>(K_lds + (bf) * SHM_K + kws[i_]) = sk[i_]; } } while (0)
#define FS_WRITEV(t, bf) do { if ((t) < NT) { _Pragma("unroll") for (int i_ = 0; i_ < NVL; ++i_) *reinterpret_cast<bf16x8*>(V_lds + (bf) * SHM_V + vws[i_]) = sv[i_]; } } while (0)
#define FS_RESC(a) do { if (__any((a) < 1.f)) { if (hi == 0) al_l[r32] = (a); asm volatile("s_waitcnt lgkmcnt(0)" ::: "memory"); \
        _Pragma("unroll") for (int d_ = 0; d_ < NDV; ++d_) _Pragma("unroll") for (int r = 0; r < 16; ++r) o[d_][r] *= al_l[crow(r, hi)]; } } while (0)
#define FS_MASKT(P0_, P1_, t) do { const int kb_ = (j_lo + (t)) * KVBLK; if (kb_ + KVBLK - 1 > qlo || kb_ <= qlo + QBLK - 1 - W) mask_tile(P0_, P1_, qm - kb_, (unsigned)W); } while (0)
        bf16x8 qr[NDQ];
#pragma unroll
        for (int d0 = 0; d0 < NDQ; ++d0) qr[d0] = *reinterpret_cast<const bf16x8*>(Qw + (size_t)r32 * ldq + d0 * 16 + hi * 8);
        FS_LOADK(0); FS_WRITEK(0, 0); FA_SBAR(); FS_LOADK(1); FS_LOADV(0);
        FS_BAR();
        if (half1) { FS_BAR(); }
        f32x16 pA0, pA1, pB0, pB1; float alA = 1.f, alB = 1.f; bf16x8 pa0, pa1, pa2, pa3;
        FS_WRITEK(1, 1); FA_SBAR(); FS_LOADK(2); FA_SBAR();
        qkt<NDQ>(pA0, pA1, K_lds, r32, hi, qr); asm volatile("" : "+v"(pA0), "+v"(pA1));
        FS_BAR();
        FS_WRITEV(0, 0); FA_SBAR(); FS_LOADV(1); FA_SBAR();
        FS_MASKT(pA0, pA1, 0); partialSM(pA0, pA1, m_reg, alA);
        FS_BAR();
#define FS_STEP(PX0, PX1, alX, PY0, PY1, alY, t, KB) do { \
        finishSM(PY0, PY1, alY, l_reg, pa0, pa1, pa2, pa3); FA_SBAR(); \
        FS_WRITEK((t) + 1, (KB) ^ 1); FA_SBAR(); FS_LOADK((t) + 2); FA_SBAR(); \
        qkt<NDQ>(PX0, PX1, K_lds + (KB) * SHM_K, r32, hi, qr); asm volatile("" : "+v"(PX0), "+v"(PX1)); \
        FS_BAR(); \
        pv_tile<NDVT, NDV>(o, vb0 + ((KB) ^ 1) * SHM_V, pa0, pa1, pa2, pa3); \
        FS_WRITEV((t), (KB)); FA_SBAR(); FS_LOADV((t) + 1); FA_SBAR(); \
        FS_MASKT(PX0, PX1, (t)); partialSM(PX0, PX1, m_reg, alX); FS_RESC(alX); \
        FS_BAR(); } while (0)
        int t = 1;
        for (; t + 1 < NT; t += 2) {
            FS_STEP(pB0, pB1, alB, pA0, pA1, alA, t, 1);
            FS_STEP(pA0, pA1, alA, pB0, pB1, alB, t + 1, 0);
        }
        FS_STEP(pB0, pB1, alB, pA0, pA1, alA, t, 1);
        finishSM(pB0, pB1, alB, l_reg, pa0, pa1, pa2, pa3); FA_SBAR();
        FS_BAR();
        pv_tile<NDVT, NDV>(o, vb0 + SHM_V, pa0, pa1, pa2, pa3);
        FS_BAR();
        if (!half1) { FS_BAR(); }
#undef FS_BAR
#undef FS_LOADK
#undef FS_LOADV
#undef FS_WRITEK
#undef FS_WRITEV
#undef FS_RESC
#undef FS_MASKT
#undef FS_STEP
    }
};
}

constexpr size_t WS_STASH = 128 * MiB;
typedef unsigned v4u32 __attribute__((__vector_size__(16)));
__device__ __forceinline__ __amdgpu_buffer_rsrc_t mk_rsrc(const void* ptr) {
    const unsigned long long v = (unsigned long long)ptr; const unsigned lo = __builtin_amdgcn_readfirstlane((unsigned)v), hi = __builtin_amdgcn_readfirstlane((unsigned)(v >> 32));
    return __builtin_amdgcn_make_buffer_rsrc((void*)(((unsigned long long)hi << 32) | lo), 0, 0x40000000, 0x00020000);
}
__device__ __forceinline__ void attn_phase(const Params& p, char* lds, int vcu0, int nwg) {
    using namespace fa;
    const int tid = threadIdx.x, wid = __builtin_amdgcn_readfirstlane(tid >> 6), lane = tid & 63, r32 = lane & 31, hi = lane >> 5;
    const bf16* proj = (const bf16*)(p.ws + WS_PROJ); bf16* att = (bf16*)(p.ws + WS_ATT);
    typedef CoreStag<4, 4, 4> CD; typedef Core<4, 2, 2> CS;
    float* wsf = (float*)(lds + CD::LDS_NEED) + wid * 64;
    const float lam = calc_lambda(p);
    const int ovoff = (4 * hi * DM + r32) * 2;
#pragma nounroll
    for (int vcu = vcu0; vcu < 256; vcu += nwg) {
        const int bh = vcu >> 3, b = bh >> 2, h = bh & 3, s = vcu & 7;
        u32x4* stash = (u32x4*)(lds + CD::LDS_NEED + NW * 256) + tid;
#pragma nounroll
        for (int pass = 0; pass < 2; ++pass) {
            const int qb = pass ? 15 - s : s;
            const size_t row0 = (size_t)b * SEQ + qb * 256 + wid * 32;
#pragma nounroll
            for (int c = 0; c < 2; ++c) {
                f32x16 o[4]; float m_reg, l_reg;
                CD::run(o, m_reg, l_reg, proj + row0 * NP + C_QD + (2 * h + c) * 64, NP, proj + (size_t)b * SEQ * NP + C_KD + (2 * h + c) * 64, proj + (size_t)b * SEQ * NP + C_VD + h * 128, NP,
                        0, 4 * (qb + 1), qb * 256 + wid * 32, 1 << 30, lds, 0);
                if (hi == 0) wsf[r32] = l_reg;
                asm volatile("s_waitcnt lgkmcnt(0)" ::: "memory");
                if (c == 0) {
#pragma unroll
                    for (int j = 0; j < 2; ++j) { float ri[8];
#pragma unroll
                        for (int e = 0; e < 8; ++e) ri[e] = 1.0f / wsf[crow(8 * j + e, hi)];
#pragma unroll
                        for (int d0 = 0; d0 < 4; ++d0) { u32x4 w; w.x = cvtpk(o[d0][8 * j] * ri[0], o[d0][8 * j + 1] * ri[1]); w.y = cvtpk(o[d0][8 * j + 2] * ri[2], o[d0][8 * j + 3] * ri[3]);
                            w.z = cvtpk(o[d0][8 * j + 4] * ri[4], o[d0][8 * j + 5] * ri[5]); w.w = cvtpk(o[d0][8 * j + 6] * ri[6], o[d0][8 * j + 7] * ri[7]); stash[(d0 * 2 + j) * NTHR] = w; } }
                } else {
                    const __amdgpu_buffer_rsrc_t rso = mk_rsrc(att + row0 * DM + 512 + h * 128);
                    float ssq[16];
#pragma unroll
                    for (int r = 0; r < 16; ++r) ssq[r] = -lam / wsf[crow(r, hi)];
#pragma unroll
                    for (int d0 = 0; d0 < 4; ++d0)
#pragma unroll
                        for (int j = 0; j < 2; ++j) { const u32x4 w = stash[(d0 * 2 + j) * NTHR]; const unsigned ww[4] = {w.x, w.y, w.z, w.w};
#pragma unroll
                            for (int e = 0; e < 8; ++e) { const int r = 8 * j + e; const float a0 = (e & 1) ? __uint_as_float(ww[e >> 1] & 0xffff0000u) : __uint_as_float(ww[e >> 1] << 16);
                                o[d0][r] = a0 + ssq[r] * o[d0][r]; } }
#pragma unroll
                    for (int r = 0; r < 16; ++r) { float q = (o[0][r] * o[0][r] + o[1][r] * o[1][r]) + (o[2][r] * o[2][r] + o[3][r] * o[3][r]);
                        q += __shfl_xor(q, 1); q += __shfl_xor(q, 2); q += __shfl_xor(q, 4); q += __shfl_xor(q, 8); q += __shfl_xor(q, 16);
                        ssq[r] = 0.8f / sqrtf(q * (1.f / 128.f) + EPS); }
#pragma unroll
                    for (int d0 = 0; d0 < 4; ++d0) { const float g = p.g_diff[d0 * 32 + r32];
#pragma unroll
                        for (int r = 0; r < 16; ++r) { const float y = o[d0][r] * ssq[r] * g; const float yn = __shfl_xor(y, 1);
                            if ((r32 & 1) == 0) __builtin_amdgcn_raw_buffer_store_b32(cvtpk(y, yn), rso, ovoff, (((r & 3) + 8 * (r >> 2)) * DM + d0 * 32) * 2, WT_ATT); } }
                }
                asm volatile("s_waitcnt lgkmcnt(0)" ::: "memory");
            }
        }
    }
    int tid_s = threadIdx.x; asm volatile("" : "+v"(tid_s));
    const int wid_s = __builtin_amdgcn_readfirstlane(tid_s >> 6), r32_s = tid_s & 31, hi_s = (tid_s >> 5) & 1;
    float* wsf_s = (float*)(lds + CD::LDS_NEED) + wid_s * 64; const int ovoff_s = (4 * hi_s * DM + r32_s) * 2;
#pragma nounroll
    for (int u = vcu0; u < 1024; u += nwg) {
        const int wid = wid_s, r32 = r32_s, hi = hi_s, ovoff = ovoff_s; float* wsf = wsf_s;
        const int bk = u >> 6, g64 = u & 63, b = bk >> 1, kvh = bk & 1, hq = kvh * 4 + (wid >> 1), sub = wid & 1;
        const size_t row0 = (size_t)b * SEQ + g64 * 64 + sub * 32;
        const __amdgpu_buffer_rsrc_t rso = mk_rsrc(att + row0 * DM + hq * 64);
        f32x16 o[2]; float m_reg, l_reg;
        const bf16* Qw = proj + row0 * NP + C_QA + hq * 64;
        const bf16* Kg = proj + (size_t)b * SEQ * NP + C_KA + kvh * 64;
        const bf16* Vg = proj + (size_t)b * SEQ * NP + C_VA + kvh * 64;
        CS::run(o, m_reg, l_reg, Qw, NP, Kg, Vg, NP, g64 >= 2 ? g64 - 2 : 0, g64 + 1, g64 * 64 + sub * 32, 128, lds, 0);
        const float lt = l_reg + __builtin_amdgcn_exp2f(p.sinks[hq] * LOG2E - m_reg);
        if (hi == 0) wsf[r32] = lt;
        asm volatile("s_waitcnt lgkmcnt(0)" ::: "memory");
#pragma unroll
        for (int r = 0; r < 16; ++r) { const float rl = 1.0f / wsf[crow(r, hi)];
#pragma unroll
            for (int d0 = 0; d0 < 2; ++d0) { const float y = o[d0][r] * rl; const float yn = __shfl_xor(y, 1);
                if ((r32 & 1) == 0) __builtin_amdgcn_raw_buffer_store_b32(cvtpk(y, yn), rso, ovoff, (((r & 3) + 8 * (r >> 2)) * DM + d0 * 32) * 2, WT_ATT); } }
        __syncthreads();
    }
}

namespace fa {
template <int NDQ, int NDVT, int NDV>
struct CoreSeqG {
    static constexpr int KROW = NDQ * 32, SHM_K = 64 * KROW, SHM_V = 64 * NDVT * 64, KPW = SHM_K / 8192, VPW = SHM_V / 8192;
    static_assert(NDQ == 16 && NDVT == 8, "piece maps below are written for 512-byte K rows and 8 V column blocks");
    typedef __attribute__((address_space(3))) unsigned char* lptr;
    __device__ __forceinline__ static void run(f32x16 (&o)[NDV], float& m_reg, float& l_reg, const bf16* Qw, int ldq, const bf16* Kg, const bf16* Vg, int ldk, int NT, char* lds, lptr ldsL, int scr_off, int vdoff) {
        const int tid = threadIdx.x, wid = __builtin_amdgcn_readfirstlane(tid >> 6), lane = tid & 63, r32 = lane & 31, hi = lane >> 5;
        char* V_lds = lds; char* K_lds = lds + 2 * SHM_V;
        float* al_l = (float*)(lds + scr_off) + wid * 64 + 32;
        m_reg = -1e30f; l_reg = 0.f;
#pragma unroll
        for (int d = 0; d < NDV; ++d) o[d] = f32x16{};
        int ksrc[KPW], vsrc[VPW];
#pragma unroll
        for (int i = 0; i < KPW; ++i) { const int row = 2 * (wid * KPW + i) + (lane >> 5); ksrc[i] = row * ldk + (((lane & 31) ^ (row & 15)) << 3); }
#pragma unroll
        for (int i = 0; i < VPW; ++i) { const int kk = wid * 8 + ((lane & 31) >> 2), k = (kk & ~0xC) | ((kk & 4) << 1) | ((kk & 8) >> 1); vsrc[i] = k * ldk + (2 * i + (lane >> 5)) * 32 + (lane & 3) * 8; }
#define FG_DMA(t, bf) do { const size_t ro_ = (size_t)((t) * KVBLK) * ldk; \
        _Pragma("unroll") for (int i_ = 0; i_ < VPW; ++i_) __builtin_amdgcn_global_load_lds((const unsigned*)(Vg + ro_ + vsrc[i_]), (__attribute__((address_space(3))) unsigned*)(ldsL + (bf) * SHM_V + (wid * VPW + i_) * 1024), 16, 0, 0); \
        _Pragma("unroll") for (int i_ = 0; i_ < KPW; ++i_) __builtin_amdgcn_global_load_lds((const unsigned*)(Kg + ro_ + ksrc[i_]), (__attribute__((address_space(3))) unsigned*)(ldsL + 2 * SHM_V + (bf) * SHM_K + (wid * KPW + i_) * 1024), 16, 0, 0); } while (0)
        const int vb0 = (int)(uintptr_t)V_lds + v_rd_base(lane) + vdoff * 512;
        FG_DMA(0, 0);
        bf16x8 qr[NDQ];
#pragma unroll
        for (int d0 = 0; d0 < NDQ; ++d0) qr[d0] = *reinterpret_cast<const bf16x8*>(Qw + (size_t)(r32 >> 4) * (ldq * 16) + (r32 & 15) * 32 + hi * 8 + (d0 >> 1) * 512 + (d0 & 1) * 16);
        __syncthreads();
        for (int t = 0; t < NT; ++t) {
            const int bf = t & 1;
            if (t + 1 < NT) FG_DMA(t + 1, bf ^ 1);
            f32x16 p0, p1; float al; bf16x8 pa0, pa1, pa2, pa3;
            FA_SBAR(); qkt<NDQ>(p0, p1, K_lds + bf * SHM_K, r32, hi, qr);
            partialSM(p0, p1, m_reg, al);
            if (__any(al < 1.f)) { if (hi == 0) al_l[r32] = al; asm volatile("s_waitcnt lgkmcnt(0)" ::: "memory");
#pragma unroll
                for (int d_ = 0; d_ < NDV; ++d_)
#pragma unroll
                    for (int r = 0; r < 16; ++r) o[d_][r] *= al_l[crow(r, hi)]; }
            finishSM(p0, p1, al, l_reg, pa0, pa1, pa2, pa3); FA_SBAR();
            pv_tile<NDVT, NDV>(o, vb0 + bf * SHM_V, pa0, pa1, pa2, pa3);
            __syncthreads();
        }
#undef FG_DMA
    }
};
}
__device__ __forceinline__ void cross_block(const Params& p, char* lds, LAS unsigned char* ldsL, int b, int head, int rb) {
    using namespace fa;
    int tid = threadIdx.x; asm volatile("" : "+v"(tid));
    const int wid = __builtin_amdgcn_readfirstlane(tid >> 6), lane = tid & 63, r32 = lane & 31, hi = lane >> 5, dh = wid >> 2;
    const bf16* qc = (const bf16*)(p.ws + WS_QC); const bf16* kvm = (const bf16*)(p.ws + WS_KVM); bf16* oc = (bf16*)(p.ws + WS_OC);
    typedef CoreSeqG<16, 8, 4> CC;
    constexpr int SCR = 131072 + 8192;
    float* wsf = (float*)(lds + SCR + 2048) + wid * 64;
    const int ovoff = (4 * hi * DM + r32) * 2;
    const size_t row0 = (size_t)b * SEQ + rb * 128 + (wid & 3) * 32;
    const __amdgpu_buffer_rsrc_t rso = mk_rsrc(oc + row0 * DM + head * 256 + dh * 128);
    f32x16 o[4]; float m_reg, l_reg;
    CC::run(o, m_reg, l_reg, qc + (row0 >> 4) * (size_t)(DM * 16) + head * 8 * 512, DM, kvm + (size_t)b * MEML * 2048 + head * 256, kvm + (size_t)b * MEML * 2048 + 1024 + head * 256, 2048, MEML / 64, lds, (CC::lptr)ldsL, SCR, dh * 4);
    if (hi == 0) wsf[r32] = l_reg;
    asm volatile("s_waitcnt lgkmcnt(0)" ::: "memory");
#pragma unroll
    for (int r = 0; r < 16; ++r) { const float rl = 1.0f / wsf[crow(r, hi)];
#pragma unroll
        for (int d0 = 0; d0 < 4; ++d0) { const float y = o[d0][r] * rl; const float yn = __shfl_xor(y, 1);
            if ((r32 & 1) == 0) __builtin_amdgcn_raw_buffer_store_b32(cvtpk(y, yn), rso, ovoff, (((r & 3) + 8 * (r >> 2)) * DM + d0 * 32) * 2, WT_ATT); } }
    asm volatile("s_waitcnt lgkmcnt(0)" ::: "memory");
}
#define GAS __attribute__((address_space(1)))
typedef GAS unsigned gu32;
constexpr int CW_BAR = 4096;
constexpr size_t CTL_ZERO_BYTES = 65536;
constexpr int MISC_OFF = 131072 + 320, TAB_OFF = 131072 + 1024;
constexpr int CW_PANEL = 8192;
constexpr size_t WS_XCH = 60 * MiB;
#define XB_TMO      128
#define XB_XCNT(j)  (256  + 64 * (j))
#define XB_XSUB(j)  (1280 + 64 * (j))
#define XB_XGEN(j)  (2304 + 64 * (j))
#define XB_TOP      3328
#define XB_TOPGEN   3392
#define XCD_BAR_WORDS 3456
#define XB_SPIN_CAP (1u << 18)

__device__ __forceinline__ unsigned xb_ld(unsigned* p)              { return __hip_atomic_load(p, __ATOMIC_RELAXED, __HIP_MEMORY_SCOPE_AGENT); }
__device__ __forceinline__ unsigned xb_add(unsigned* p, unsigned v) { return __hip_atomic_fetch_add(p, v, __ATOMIC_RELAXED, __HIP_MEMORY_SCOPE_AGENT); }
__device__ __forceinline__ unsigned xb_xcc_id() { return (unsigned)__builtin_amdgcn_s_getreg((3 << 11) | 20) & 0xFu; }
#define XB_SPIN(cond, bar) do { unsigned _sp = 0; while (cond) { __builtin_amdgcn_s_sleep(1); \
    if ((++_sp & 255u) == 0u) { if (xb_ld(&(bar)[XB_TMO])) break; if (_sp > XB_SPIN_CAP) { atomicAdd(&(bar)[XB_TMO], 1u); break; } } } } while (0)

struct XcdBarrier {
    unsigned* bar; unsigned x;
    volatile LAS unsigned* st;
};

__device__ __forceinline__ XcdBarrier xcd_barrier_post(unsigned* bar, volatile LAS unsigned* st) {
    XcdBarrier b; b.bar = bar; b.x = xb_xcc_id(); b.st = st;
    if (threadIdx.x == 0) (void)xb_add(&bar[XB_XCNT(b.x)], 1u);
    return b;
}
__device__ __forceinline__ void xcd_barrier_complete(unsigned* bar, unsigned x, unsigned& nloc, unsigned& nx) {
    const unsigned G = gridDim.x * gridDim.y * gridDim.z;
    unsigned sum, cnt, mine, sp = 0u;
    for (;;) {
        sum = 0u; cnt = 0u; mine = 0u;
#pragma unroll
        for (unsigned j = 0; j < 16; ++j) { const unsigned c = xb_ld(&bar[XB_XCNT(j)]); sum += c; cnt += (c > 0u) ? 1u : 0u; mine = (j == x) ? c : mine; }
        if (sum == G) break;
        __builtin_amdgcn_s_sleep(1);
        if ((++sp & 255u) == 0u) { if (xb_ld(&bar[XB_TMO])) break; if (sp > XB_SPIN_CAP) { atomicAdd(&bar[XB_TMO], 1u); break; } }
    }
    nloc = mine > 0u ? mine : 1u; nx = cnt > 0u ? cnt : 1u;
}

__device__ __forceinline__ void xcd_barrier(const XcdBarrier& b) {
    asm volatile("s_waitcnt vmcnt(0)" ::: "memory");
    __syncthreads();
    if (threadIdx.x == 0) {
        unsigned* bar = b.bar;
        __builtin_amdgcn_s_waitcnt(0);
        unsigned nloc = b.st[0], nx = b.st[1];
        if (nloc == 0u) { xcd_barrier_complete(bar, b.x, nloc, nx); b.st[0] = nloc; b.st[1] = nx; }
        const unsigned old = xb_add(&bar[XB_XSUB(b.x)], 1u);
        const unsigned gen = old / nloc;
        if (old + 1u == (gen + 1u) * nloc) {
            __builtin_amdgcn_fence(__ATOMIC_RELEASE, "agent");
            asm volatile("s_waitcnt vmcnt(0)" ::: "memory");
            const unsigned og = xb_add(&bar[XB_TOP], 1u);
            const unsigned tg = og / nx;
            if (og + 1u == (tg + 1u) * nx) xb_add(&bar[XB_TOPGEN], 1u);
            else XB_SPIN(xb_ld(&bar[XB_TOPGEN]) == tg, bar);
            __builtin_amdgcn_fence(__ATOMIC_ACQUIRE, "agent");
            asm volatile("s_waitcnt vmcnt(0)" ::: "memory");
        } else {
            XB_SPIN(xb_ld(&bar[XB_TOPGEN]) == gen, bar);
            __builtin_amdgcn_fence(__ATOMIC_ACQUIRE, "agent");
            asm volatile("s_waitcnt vmcnt(0)" ::: "memory");
        }
    }
    __syncthreads();
}

constexpr int LDS_BYTES = 147456;
constexpr size_t WS_SS3 = 58 * MiB;
__device__ __forceinline__ void final_norm_ss(float* X, const float* ss, const float* g, int gw, int ngw, int lane) {
    for (int m = gw; m < M; m += ngw) {
        const float rstd = pg8::rstd_ss(ss, m);
        f32x4* xr = (f32x4*)(X + (size_t)m * DM) + lane;
#pragma unroll
        for (int j = 0; j < 4; ++j) { const f32x4 gg = ((const f32x4*)g)[lane + 64 * j]; xr[64 * j] = xr[64 * j] * rstd * gg; }
    }
}
constexpr int N_PHASES = 10;
__global__ void __launch_bounds__(NTHR, 2) fwd_kernel(Params p) {
    extern __shared__ __attribute__((aligned(16))) unsigned char lds_raw[];
    LAS unsigned char* lds = (LAS unsigned char*)lds_raw;
    for (int u = threadIdx.x; u < 64; u += NTHR) ((LAS unsigned*)(lds + MISC_OFF))[u] = 0u;
    __syncthreads();
    XcdBarrier bar = xcd_barrier_post((unsigned*)(p.ws + WS_CTL) + CW_BAR, (volatile LAS unsigned*)(lds + MISC_OFF) + 8);
    const int tid = threadIdx.x, wave = __builtin_amdgcn_readfirstlane(tid >> 6), lane = tid & 63, bid = blockIdx.x, nblk = gridDim.x;
    const int gw = bid * NWAVES + wave, ngw = nblk * NWAVES;
    const int vcu = (nblk % 8 == 0) ? (bid % 8) * (nblk / 8) + bid / 8 : bid;
    unsigned char* ws = p.ws;
    const int lo = p.ph_lo, hi = p.ph_hi;
    typedef pg8::bf16_t b16;
#define IN(k) (lo <= (k) && (k) < hi)
#define SEAM(k) do { if (IN(k) && IN((k) + 1) && !((k) == 8 && nblk == 256)) xcd_barrier(bar); } while (0)
    if (IN(0)) { p0_prologue(p, lds, bid, nblk, tid); } SEAM(0);
    if (IN(1)) {
        pg8::Gemm g{(const b16*)(ws + WS_XN), (const b16*)(ws + WS_WIN), (const b16*)(ws + WS_MEMN), (const b16*)(ws + WS_WCKV), DM};
        pg8::TwoOrder S; S.init(M, NP, nblk, bid); S.n2M = MM / 256; S.n2N = 2048 / 256;
        pg8::EpiProj E{(b16*)(ws + WS_PROJ), (b16*)(ws + WS_KVM), (const float*)(ws + WS_ROPE)};
        pg8::gemm_phase<pg8::EpiProj, pg8::TwoOrder, true, true>(lds, g, S, E);
    } SEAM(1);
    if (IN(2)) { attn_phase(p, (char*)lds_raw, vcu, nblk);
    } SEAM(2);
    if (IN(3)) {
        pg8::Gemm g{(const b16*)(ws + WS_ATT), (const b16*)(ws + WS_WOUT), nullptr, nullptr, DM};
        pg8::StaticOrder S; S.init(M, DM, nblk, bid);
        pg8::EpiResB<true> E{p.x, nullptr, (b16*)(ws + WS_XN), (float*)(ws + WS_SS1)};
        pg8::gemm_phase<pg8::EpiResB<true>, pg8::StaticOrder, true, true>(lds, g, S, E);
    } SEAM(3);
    if (IN(4)) {
        pg8::Gemm g{(const b16*)(ws + WS_XN), (const b16*)(ws + WS_WCQ), nullptr, nullptr, DM, 1};
        pg8::StaticOrder S; S.init(M, DM, nblk, bid);
        pg8::EpiScaleBf16<0> E{(b16*)(ws + WS_QC), DM, (const float*)(ws + WS_SS1), CQ, lds + TAB_OFF};
        pg8::gemm_phase<pg8::EpiScaleBf16<0>, pg8::StaticOrder, true, true>(lds, g, S, E);
        asm volatile("s_waitcnt vmcnt(0)" ::: "memory");
        __syncthreads();
        if (tid == 0) { __builtin_amdgcn_fence(__ATOMIC_ACQUIRE, "agent"); asm volatile("s_waitcnt vmcnt(0)" ::: "memory"); }
        __syncthreads();
#pragma nounroll
        for (int i = 0; ; ++i) {
            pg8::Unit u; if (!S.next(i, u)) break;
#pragma nounroll
            for (int hb = 0; hb < 2; ++hb) cross_block(p, (char*)lds_raw, lds, u.pm >> 4, u.pn, (u.pm & 15) * 2 + hb);
        }
    } SEAM(4);
    if (IN(6)) {
        pg8::Gemm g{(const b16*)(ws + WS_OC), (const b16*)(ws + WS_WCO), nullptr, nullptr, DM};
        pg8::StaticOrder S; S.init(M, DM, nblk, bid);
        pg8::EpiResB<false> E{nullptr, (const b16*)(ws + WS_XN), (b16*)(ws + WS_XN), (float*)(ws + WS_SS2)};
        pg8::gemm_phase<pg8::EpiResB<false>, pg8::StaticOrder, true, true>(lds, g, S, E);
    } SEAM(6);
    if (IN(7)) {
        pg8::Gemm g{(const b16*)(ws + WS_XN), (const b16*)(ws + WS_WUP), nullptr, nullptr, DM, 1};
        pg8::StaticOrder S; S.init(M, FF, nblk, bid);
        pg8::EpiScaleBf16<1> E{(b16*)(ws + WS_ACT), FF, (const float*)(ws + WS_SS2), 1.f, lds + TAB_OFF};
        pg8::gemm_phase<pg8::EpiScaleBf16<1>, pg8::StaticOrder, true, true>(lds, g, S, E);
    } SEAM(7);
    if (IN(8)) {
        pg8::Gemm g{(const b16*)(ws + WS_ACT), (const b16*)(ws + WS_WDOWN), nullptr, nullptr, FF, 1};
        pg8::StaticOrder S; S.init(M, DM, nblk, bid);
        if (nblk == 256) {
            pg8::EpiFinal E{(const b16*)(ws + WS_XN), p.out, p.g_final, (unsigned*)(ws + WS_XCH), (unsigned*)(ws + WS_CTL) + CW_PANEL, lds + TAB_OFF};
            pg8::gemm_phase<pg8::EpiFinal, pg8::StaticOrder, true, true>(lds, g, S, E);
        } else {
            pg8::EpiResF E{(const b16*)(ws + WS_XN), p.out, (float*)(ws + WS_SS3)};
            pg8::gemm_phase<pg8::EpiResF, pg8::StaticOrder, true, true>(lds, g, S, E);
        }
    } SEAM(8);
    if (IN(9) && nblk != 256) { final_norm_ss(p.out, (const float*)(ws + WS_SS3), p.g_final, gw, ngw, lane); }
#undef IN
#undef SEAM
}

extern "C" void kernel_launch(void* const* d_in, const int* in_sizes, int n_in, void* d_out, int out_size, void* d_ws, size_t ws_size, hipStream_t stream) {
    static int grid = 0;
    if (grid == 0) {
        if (n_in != 21 || out_size != M * DM || ws_size < WS_END) { fprintf(stderr, "kernel_launch: unexpected shapes (n_in %d out %d ws %zu)\n", n_in, out_size, ws_size); grid = -1; return; }
        int dev = 0, cus = 0, per_cu = 0;
        (void)hipGetDevice(&dev); (void)hipDeviceGetAttribute(&cus, hipDeviceAttributeMultiprocessorCount, dev);
        if (hipFuncSetAttribute((const void*)fwd_kernel, hipFuncAttributeMaxDynamicSharedMemorySize, LDS_BYTES) != hipSuccess) { fprintf(stderr, "kernel_launch: hipFuncSetAttribute failed\n"); grid = -1; return; }
        (void)hipOccupancyMaxActiveBlocksPerMultiprocessor(&per_cu, (const void*)fwd_kernel, NTHR, LDS_BYTES);
        if (per_cu < 1) { fprintf(stderr, "kernel_launch: occupancy query says %d blocks per CU\n", per_cu); per_cu = 1; }
        grid = cus;
    }
    if (grid < 0) return;
    Params p{};
    p.x = (const float*)d_in[0]; p.mem = (const float*)d_in[1]; p.pos = (const int*)d_in[2]; p.g_mix = (const float*)d_in[3]; p.w_in = (const float*)d_in[4];
    p.sinks = (const float*)d_in[5]; p.lq1 = (const float*)d_in[6]; p.lk1 = (const float*)d_in[7]; p.lq2 = (const float*)d_in[8]; p.lk2 = (const float*)d_in[9];
    p.g_diff = (const float*)d_in[10]; p.w_out = (const float*)d_in[11]; p.g_cross = (const float*)d_in[12]; p.g_mem = (const float*)d_in[13]; p.w_cq = (const float*)d_in[14];
    p.w_ckv = (const float*)d_in[15]; p.w_co = (const float*)d_in[16]; p.g_mlp = (const float*)d_in[17]; p.w_up = (const float*)d_in[18]; p.w_down = (const float*)d_in[19]; p.g_final = (const float*)d_in[20];
    p.out = (float*)d_out; p.ws = (unsigned char*)d_ws;
    if (hipMemsetAsync((char*)d_ws + WS_CTL, 0, CTL_ZERO_BYTES, stream) != hipSuccess) { fprintf(stderr, "kernel_launch: hipMemsetAsync of the control words failed\n"); return; }
    p.ph_lo = 0; p.ph_hi = N_PHASES;
    hipLaunchKernelGGL(fwd_kernel, dim3(grid), dim3(NTHR), LDS_BYTES, stream, p);
}
```

```cpp
#define WT_ATT 0
#include <hip/hip_runtime.h>
#include <cstdio>
#include <cstdint>


#define LAS __attribute__((address_space(3)))
typedef unsigned short bf16;
typedef short bf16x8 __attribute__((ext_vector_type(8)));
typedef float f32x4 __attribute__((ext_vector_type(4)));
typedef unsigned u32x4 __attribute__((ext_vector_type(4)));
typedef unsigned u32x2 __attribute__((ext_vector_type(2)));

constexpr int BATCH = 8, SEQ = 4096, M = BATCH * SEQ, DM = 1024, NP = 2304, MEML = 256, MM = BATCH * MEML, FF = 4096;
constexpr int NWAVES = 8, NTHR = NWAVES * 64;
constexpr float EPS = 1e-5f;
constexpr float LOG2E = 1.4426950408889634f;
constexpr float C2 = 0.125f * LOG2E;
constexpr float CQ = 0.0625f * LOG2E;
constexpr int C_QA = 0, C_KA = 512, C_VA = 640, C_QD = 768, C_KD = 1280, C_VD = 1792;

constexpr size_t MiB = 1u << 20;
constexpr size_t WS_CTL = 0;
constexpr size_t WS_WIN = 2 * MiB;
constexpr size_t WS_WOUT = WS_WIN + (size_t)NP * DM * 2;
constexpr size_t WS_WCQ = WS_WOUT + 2 * MiB;
constexpr size_t WS_WCKV = WS_WCQ + 2 * MiB;
constexpr size_t WS_WCO = WS_WCKV + 4 * MiB;
constexpr size_t WS_WUP = WS_WCO + 2 * MiB;
constexpr size_t WS_WDOWN = WS_WUP + 8 * MiB;
constexpr size_t WS_ROPE = 34 * MiB;
constexpr size_t WS_KVM = 42 * MiB;
constexpr size_t WS_MEMN = 50 * MiB;
constexpr size_t WS_SS1 = 54 * MiB, WS_SS2 = 56 * MiB;
constexpr size_t WS_XN = 64 * MiB;
constexpr size_t WS_PROJ = 256 * MiB;
constexpr size_t WS_ATT = 400 * MiB;
constexpr size_t WS_QC = 256 * MiB;
constexpr size_t WS_OC = 320 * MiB;
constexpr size_t WS_ACT = 256 * MiB;
constexpr size_t WS_QB = 128 * MiB;
constexpr size_t WS_IRS = 62 * MiB;
constexpr size_t WS_XB8 = 192 * MiB;
constexpr size_t WS_END = 512 * MiB;
static_assert(WS_WDOWN + 8 * MiB <= WS_ROPE, "weights fit");

struct Params {
    const float *x, *mem; const int* pos;
    const float *g_mix, *w_in, *sinks, *lq1, *lk1, *lq2, *lk2, *g_diff, *w_out, *g_cross, *g_mem, *w_cq, *w_ckv, *w_co, *g_mlp, *w_up, *w_down, *g_final;
    float* out; unsigned char* ws; int ph_lo, ph_hi;
};

__device__ __forceinline__ unsigned f2bf(float f) { unsigned u = __builtin_bit_cast(unsigned, f); return (u + 0x7fffu + ((u >> 16) & 1u)) >> 16; }
__device__ __forceinline__ unsigned pk2(float lo, float hi) { return f2bf(lo) | (f2bf(hi) << 16); }
__device__ __forceinline__ float bf2f(unsigned h) { return __builtin_bit_cast(float, h << 16); }
__device__ __forceinline__ float bflo(unsigned w) { return __builtin_bit_cast(float, w << 16); }
__device__ __forceinline__ float bfhi(unsigned w) { return __builtin_bit_cast(float, w & 0xffff0000u); }
__device__ __forceinline__ float wave_sum(float v) {
#pragma unroll
    for (int o = 1; o < 64; o <<= 1) v += __shfl_xor(v, o);
    return v;
}
__device__ __forceinline__ float wave_max(float v) {
#pragma unroll
    for (int o = 1; o < 64; o <<= 1) v = fmaxf(v, __shfl_xor(v, o));
    return v;
}
__host__ __device__ __forceinline__ bool col_roped(int n) { return n < C_VA || (n >= C_QD && n < C_VD); }
__host__ __device__ __forceinline__ int phys_of_logical(int nl) {
    if (!col_roped(nl)) return nl;
    const int g = nl & ~63, j = nl & 63; return g + ((j & 31) << 1) + (j >> 5);
}
__device__ __forceinline__ float calc_lambda(const Params& p) {
    float a = 0.f, b = 0.f;
    for (int i = 0; i < 64; ++i) { a += p.lq1[i] * p.lk1[i]; b += p.lq2[i] * p.lk2[i]; }
    return __expf(a) - __expf(b) + 0.2f;
}

__device__ const double INV_FREQ[32] = {
    1.0, 0.7498942093324559, 0.5623413251903491, 0.4216965034285822,
    0.31622776601683794, 0.23713737056616552, 0.1778279410038923, 0.1333521432163324,
    0.1, 0.07498942093324558, 0.05623413251903491, 0.042169650342858224,
    0.03162277660168379, 0.023713737056616554, 0.01778279410038923, 0.01333521432163324,
    0.01, 0.007498942093324558, 0.005623413251903491, 0.004216965034285823,
    0.0031622776601683794, 0.0023713737056616554, 0.0017782794100389228, 0.001333521432163324,
    0.001, 0.0007498942093324559, 0.0005623413251903491, 0.00042169650342858224,
    0.00031622776601683794, 0.00023713737056616554, 0.00017782794100389227, 0.0001333521432163324};

__device__ __forceinline__ void sincos_d(double a, float& c, float& s) {
    const double kd = rint(a * 0.63661977236758134308);
    const int k = (int)kd;
    double r = fma(-kd, 1.57079632679489655800e+00, a); r = fma(-kd, 6.12323399573676603587e-17, r);
    const double r2 = r * r;
    const double sp = r * (1.0 + r2 * (-1.0 / 6.0 + r2 * (1.0 / 120.0 + r2 * (-1.0 / 5040.0 + r2 * (1.0 / 362880.0 + r2 * (-1.0 / 39916800.0 + r2 * (1.0 / 6227020800.0)))))));
    const double cp = 1.0 + r2 * (-0.5 + r2 * (1.0 / 24.0 + r2 * (-1.0 / 720.0 + r2 * (1.0 / 40320.0 + r2 * (-1.0 / 3628800.0 + r2 * (1.0 / 479001600.0 + r2 * (-1.0 / 87178291200.0)))))));
    const int q = k & 3;
    const double ss = (q == 0) ? sp : (q == 1) ? cp : (q == 2) ? -sp : -cp;
    const double cc = (q == 0) ? cp : (q == 1) ? -sp : (q == 2) ? -cp : sp;
    c = (float)cc; s = (float)ss;
}

template <bool HASG, bool PERMC>
__device__ __forceinline__ void transpose_item(const float* W, int K, int N, const float* g, bf16* WT, LAS float* scr, int item, int lane) {
    const int nblk = N / 32, kb = item / nblk, nb = item % nblk, k0 = 64 * kb, n0 = 32 * nb;
#pragma unroll 16
    for (int i = 0; i < 32; ++i) { const int kk = 2 * i + (lane >> 5); float v = W[(size_t)(k0 + kk) * N + n0 + (lane & 31)]; if (HASG) v *= g[k0 + kk]; scr[kk * 33 + (lane & 31)] = v; }
    asm volatile("s_waitcnt lgkmcnt(0)" ::: "memory");
    const int c = lane & 7;
#pragma unroll
    for (int j = 0; j < 4; ++j) { const int n = (lane >> 3) + 8 * j; const LAS float* s = scr + (8 * c) * 33 + n;
        u32x4 o; o.x = pk2(s[0 * 33], s[1 * 33]); o.y = pk2(s[2 * 33], s[3 * 33]); o.z = pk2(s[4 * 33], s[5 * 33]); o.w = pk2(s[6 * 33], s[7 * 33]);
        const int nl = n0 + n, np = PERMC ? phys_of_logical(nl) : nl;
        *(u32x4*)(WT + (size_t)np * K + k0 + 8 * c) = o; }
    asm volatile("s_waitcnt lgkmcnt(0)" ::: "memory");
}
template <bool HASG>
__device__ __forceinline__ void transpose_item8(const float* W, int K, int N, const float* g, unsigned char* WT, LAS float* scr, int item, int lane) {
    const int nblk = N / 32, kb = item / nblk, nb = item % nblk, k0 = 64 * kb, n0 = 32 * nb;
#pragma unroll 16
    for (int i = 0; i < 32; ++i) { const int kk = 2 * i + (lane >> 5); float v = W[(size_t)(k0 + kk) * N + n0 + (lane & 31)] * 32.f; if (HASG) v *= g[k0 + kk]; scr[kk * 33 + (lane & 31)] = v; }
    asm volatile("s_waitcnt lgkmcnt(0)" ::: "memory");
    const int c = lane & 7;
#pragma unroll
    for (int j = 0; j < 4; ++j) { const int n = (lane >> 3) + 8 * j; const LAS float* s = scr + (8 * c) * 33 + n;
        int d0 = __builtin_amdgcn_cvt_pk_fp8_f32(s[0 * 33], s[1 * 33], 0, false); d0 = __builtin_amdgcn_cvt_pk_fp8_f32(s[2 * 33], s[3 * 33], d0, true);
        int d1 = __builtin_amdgcn_cvt_pk_fp8_f32(s[4 * 33], s[5 * 33], 0, false); d1 = __builtin_amdgcn_cvt_pk_fp8_f32(s[6 * 33], s[7 * 33], d1, true);
        u32x2 o; o.x = (unsigned)d0; o.y = (unsigned)d1;
        *(u32x2*)(WT + (size_t)(n0 + n) * K + k0 + 8 * c) = o; }
    asm volatile("s_waitcnt lgkmcnt(0)" ::: "memory");
}
__device__ __forceinline__ void rms_row_to_bf16(const float* xrow, const float* g, bf16* orow, int lane) {
    const f32x4* xr = (const f32x4*)xrow + lane;
    f32x4 v[4]; float s = 0.f;
#pragma unroll
    for (int j = 0; j < 4; ++j) { v[j] = xr[64 * j]; s += (v[j].x * v[j].x + v[j].y * v[j].y) + (v[j].z * v[j].z + v[j].w * v[j].w); }
    const float rstd = 1.0f / sqrtf(wave_sum(s) * (1.f / DM) + EPS);
#pragma unroll
    for (int j = 0; j < 4; ++j) {
        f32x4 gg = (f32x4){1.f, 1.f, 1.f, 1.f}; if (g) gg = ((const f32x4*)g)[lane + 64 * j];
        u32x2 w; w.x = pk2(v[j].x * rstd * gg.x, v[j].y * rstd * gg.y); w.y = pk2(v[j].z * rstd * gg.z, v[j].w * rstd * gg.w); *(u32x2*)(orow + (size_t)(8 * j + (lane >> 3)) * 512 + 4 * (lane & 7)) = w; }
}
constexpr int FQ_SQ = (DM / 64) * (DM / 32), FQ_UP = (DM / 64) * (FF / 32), FQ_DN = (FF / 64) * (DM / 32);
constexpr int FQ_L_OUT = FQ_SQ, FQ_L_CQ = 2 * FQ_SQ, FQ_L_CO = 3 * FQ_SQ, FQ_ITEMS = 3 * FQ_SQ + FQ_UP + FQ_DN;
__device__ __forceinline__ void fill_chunk(const Params& p, LAS unsigned char* lds, int base, int tid) {
    const int wave = __builtin_amdgcn_readfirstlane(tid >> 6), lane = tid & 63; int it = base + wave;
    LAS float* scr = (LAS float*)(lds + wave * 8704);
    if (it < FQ_SQ) {
        const int k0 = 64 * (it / (DM / 32));
        if (k0 >= 512) transpose_item<true, false>(p.w_out, DM, DM, p.g_diff + (((k0 - 512) & 127) - k0), (bf16*)(p.ws + WS_WOUT), scr, it, lane);
        else transpose_item8<false>(p.w_out, 2 * DM, DM, nullptr, p.ws + WS_WOUT + 512, scr, it, lane);
        return; } it -= FQ_SQ;
    if (it < FQ_SQ) { transpose_item8<true>(p.w_cq, DM, DM, p.g_cross, p.ws + WS_WCQ, scr, it, lane); return; } it -= FQ_SQ;
    if (it < FQ_SQ) { transpose_item8<false>(p.w_co, DM, DM, nullptr, p.ws + WS_WCO, scr, it, lane); return; } it -= FQ_SQ;
    if (it < FQ_UP) { transpose_item<true, false>(p.w_up, DM, FF, p.g_mlp, (bf16*)(p.ws + WS_WUP), scr, it, lane); return; } it -= FQ_UP;
    if (it < FQ_DN) transpose_item<false, false>(p.w_down, FF, DM, nullptr, (bf16*)(p.ws + WS_WDOWN), scr, it, lane);
}
__device__ __forceinline__ void p0_prologue(const Params& p, LAS unsigned char* lds, int bid, int nblk, int tid) {
    const int wave = tid >> 6, lane = tid & 63;
    LAS float* scr = (LAS float*)(lds + wave * 8704);
    const int gw = bid * NWAVES + wave, NGW = nblk * NWAVES;
    unsigned char* ws = p.ws;
    constexpr int I_IN = (DM / 64) * (NP / 32), I_SQ = (DM / 64) * (DM / 32), I_KV = (DM / 64) * (2048 / 32), I_UP = (DM / 64) * (FF / 32), I_DN = (FF / 64) * (DM / 32);
    constexpr int NITEMS = I_IN + I_KV;
    for (int it = gw; it < NITEMS; it += NGW) {
        int r = it;
        if (r < I_IN) { transpose_item<true, true>(p.w_in, DM, NP, p.g_mix, (bf16*)(ws + WS_WIN), scr, r, lane); continue; } r -= I_IN;
        transpose_item<false, false>(p.w_ckv, DM, 2048, nullptr, (bf16*)(ws + WS_WCKV), scr, r, lane);
    }
    {
        const int hl = lane >> 5, l32 = lane & 31;
        typedef unsigned p0_v4u __attribute__((__vector_size__(16)));
        const __amdgpu_buffer_rsrc_t rs_xn = __builtin_amdgcn_make_buffer_rsrc((void*)(ws + WS_XN), 0, 0x7fffffff, 0x00020000);
        f32x4 v[4][2], vn[4][2];
        int m = gw * 2;
        if (m < M) { const f32x4* xr = (const f32x4*)(p.x + (size_t)(m + hl) * DM) + 2 * l32;
#pragma unroll
            for (int j = 0; j < 4; ++j) { v[j][0] = __builtin_nontemporal_load(xr + 64 * j); v[j][1] = __builtin_nontemporal_load(xr + 64 * j + 1); } }
#pragma nounroll
        for (; m < M; m += NGW * 2) {
            const int row = m + hl, mn = m + NGW * 2;
            if (mn < M) { const f32x4* xr = (const f32x4*)(p.x + (size_t)(mn + hl) * DM) + 2 * l32;
#pragma unroll
                for (int j = 0; j < 4; ++j) { vn[j][0] = __builtin_nontemporal_load(xr + 64 * j); vn[j][1] = __builtin_nontemporal_load(xr + 64 * j + 1); } }
            float s = 0.f;
#pragma unroll
            for (int j = 0; j < 4; ++j)
#pragma unroll
                for (int q = 0; q < 2; ++q) s += (v[j][q].x * v[j][q].x + v[j][q].y * v[j][q].y) + (v[j][q].z * v[j][q].z + v[j][q].w * v[j][q].w);
#pragma unroll
            for (int o = 1; o < 32; o <<= 1) s += __shfl_xor(s, o);
            const float ms = s * (1.f / DM) + EPS, r = 1.0f / sqrtf(ms);
            if (l32 == 0) ((float*)(ws + WS_IRS))[row] = sqrtf(ms);
            bf16* ob = (bf16*)(ws + WS_XN) + ((size_t)(row >> 4) * 32 + (l32 >> 2)) * 512 + (row & 15) * 32 + (l32 & 3) * 8;
#pragma unroll
            for (int j = 0; j < 4; ++j) { u32x4 w; w.x = pk2(v[j][0].x * r, v[j][0].y * r); w.y = pk2(v[j][0].z * r, v[j][0].w * r); w.z = pk2(v[j][1].x * r, v[j][1].y * r); w.w = pk2(v[j][1].z * r, v[j][1].w * r);
                __builtin_amdgcn_raw_buffer_store_b128(__builtin_bit_cast(p0_v4u, w), rs_xn, (unsigned)((size_t)(ob - (bf16*)(ws + WS_XN)) * 2 + (size_t)j * 8 * 1024), 0,   16); }
#pragma unroll
            for (int j = 0; j < 4; ++j) { v[j][0] = vn[j][0]; v[j][1] = vn[j][1]; }
        }
    }
    for (int m = gw; m < MM; m += NGW) rms_row_to_bf16(p.mem + (size_t)m * DM, p.g_mem, (bf16*)(ws + WS_MEMN) + (size_t)(m >> 4) * (32 * 512) + (m & 15) * 32, lane);
    unsigned* rope = (unsigned*)(ws + WS_ROPE);
    typedef _Float16 p0_h2 __attribute__((ext_vector_type(2)));
    for (int i = bid * NTHR + tid; i < M * 32; i += nblk * NTHR) {
        const int row = i >> 5, d = i & 31; float c, s; sincos_d((double)p.pos[row] * INV_FREQ[d], c, s); const p0_h2 h = {(_Float16)c, (_Float16)s}; rope[i] = __builtin_bit_cast(unsigned, h); }
}

namespace pg8 {
#define PG8_LAS __attribute__((address_space(3)))
typedef unsigned short bf16_t;
typedef short bf16x8 __attribute__((ext_vector_type(8)));
typedef float f32x4 __attribute__((ext_vector_type(4)));
typedef unsigned u32x4 __attribute__((ext_vector_type(4)));
typedef unsigned u32x2 __attribute__((ext_vector_type(2)));
constexpr int BM = 256, BK = 64, HALF = 128, HTB = HALF * BK * 2  , STAGE_BYTES = 8 * HTB, NXCD = 8, WGM = 8;

__host__ __device__ __forceinline__ int lds_byte(int r, int c) { const int st = (r >> 4) * 2 + (c >> 5), rr = r & 15, cc = c & 31, ob = rr * 64 + cc * 2; return st * 1024 + (ob ^ (((ob >> 9) & 1) << 5)); }
__host__ __device__ __forceinline__ void stage_rc(int b, int& R, int& C) { const int st = b / 1024, sb = b % 1024, swz = sb ^ (((sb >> 9) & 1) << 5); R = (st >> 1) * 16 + swz / 64; C = (st & 1) * 32 + (swz % 64) / 2; }
__host__ __device__ __forceinline__ int perm32(int rho) { const int n = rho >> 4, i = rho & 15; return 8 * (i >> 2) + 4 * n + (i & 3); }

typedef int pg8_v8i __attribute__((ext_vector_type(8)));
typedef int pg8_v4i __attribute__((ext_vector_type(4)));
struct Unit { int pm, pn, alt; };
struct Gemm { const bf16_t* A; const bf16_t* Bt; const bf16_t* A2; const bf16_t* Bt2; int K; int ablk; };

struct StaticOrder {
    int nM, nN, nwg, G, c;
    __host__ __device__ void init(int M_, int N_, int G_, int c_) { nM = M_ / BM; nN = N_ / BM; nwg = nM * nN; G = G_; c = c_; }
    __host__ __device__ bool map(long L, Unit& u) const {
        if (L >= nwg) return false;
        int wgid = (int)L; { const int q = nwg / NXCD, r = nwg % NXCD, xcd = wgid % NXCD, off = wgid / NXCD; wgid = (xcd < r ? xcd * (q + 1) : r * (q + 1) + (xcd - r) * q) + off; }
        const int nig = WGM * nN, gid = wgid / nig, fm = gid * WGM, gsz = (nM - fm) < WGM ? (nM - fm) : WGM;
        u.pm = fm + ((wgid % nig) % gsz); u.pn = (wgid % nig) / gsz; u.alt = 0; return true;
    }
    __host__ __device__ bool next(int i, Unit& u) const { return map((long)i * G + c, u); }
    __device__ __forceinline__ void a_ready(const Unit&) const {}
    __device__ __forceinline__ void done(const Unit&) const {}
};
struct OneUnit {
    Unit u;
    __device__ __forceinline__ bool next(int i, Unit& o) const { if (i) return false; o = u; return true; }
    __device__ __forceinline__ void a_ready(const Unit&) const {}
    __device__ __forceinline__ void done(const Unit&) const {}
};
struct TwoOrder : StaticOrder {
    int n2M, n2N;
    __host__ __device__ bool next(int i, Unit& u) const {
        const long L = (long)i * G + c;
        if (L < nwg) return map(L, u);
        const int r = (int)(L - nwg); if (r >= n2M * n2N) return false;
        u.pm = r % n2M; u.pn = r / n2M; u.alt = 1; return true;
    }
};
typedef __bf16 cvt_bf2 __attribute__((ext_vector_type(2))); typedef float cvt_f2 __attribute__((ext_vector_type(2)));
__device__ __forceinline__ unsigned cvt_pk_bf16(float lo, float hi) { const cvt_f2 v = {lo, hi}; return __builtin_bit_cast(unsigned, __builtin_convertvector(v, cvt_bf2)); }

__device__ __forceinline__ float rstd_ss(const float* ss, int row) {
    const f32x4* s4 = (const f32x4*)(ss + (size_t)row * 16); float t = 0.f;
#pragma unroll
    for (int i = 0; i < 4; ++i) { const f32x4 v = s4[i]; t += (v.x + v.y) + (v.z + v.w); }
    return 1.0f / sqrtf(t * (1.f / DM) + EPS);
}
struct EpiProj {
    static constexpr bool PERM = true, AFTER_DRAIN = false, A_NT = false, FP8 = false; static constexpr int KT0 = 0, NT8 = 0; static constexpr bool PREF = false; static constexpr int NST = 0; static constexpr float MIXSCALE = 1.f;
    bf16_t* proj; bf16_t* kvm; const float* rope; bf16_t* qblk;
    __device__ __forceinline__ void operator()(const f32x4 (&acc)[2][2][4][2], const Unit& u, int wr, int wc, int fr, int fq) const {
        const int row0 = u.pm * BM + wr * 64 + fr, col0 = u.pn * BM + wc * 32 + 8 * fq;
        if (u.alt) {
#pragma unroll
            for (int ai = 0; ai < 2; ++ai)
#pragma unroll
                for (int m = 0; m < 4; ++m) { bf16_t* rowp = kvm + (size_t)(row0 + ai * HALF + m * 16) * 2048 + col0;
#pragma unroll
                    for (int bj = 0; bj < 2; ++bj) { const f32x4 v0 = acc[ai][bj][m][0], v1 = acc[ai][bj][m][1];
                        u32x4 w; w.x = cvt_pk_bf16(v0[0], v0[1]); w.y = cvt_pk_bf16(v0[2], v0[3]); w.z = cvt_pk_bf16(v1[0], v1[1]); w.w = cvt_pk_bf16(v1[2], v1[3]);
                        *(u32x4*)(rowp + bj * HALF) = w; } }
            return;
        }
        const bool qt = u.pn < 2 || u.pn == 3 || u.pn == 4; const int qtile = u.pn < 2 ? u.pn : u.pn - 1;
        const int d0 = ((wc & 1) * 32 + 8 * fq) >> 1;
        u32x4 csh[2][4];
#pragma unroll
        for (int ai = 0; ai < 2; ++ai)
#pragma unroll
            for (int m = 0; m < 4; ++m) csh[ai][m] = *(const u32x4*)((const unsigned*)rope + (size_t)(row0 + ai * HALF + m * 16) * 32 + d0);
#pragma unroll
        for (int ai = 0; ai < 2; ++ai) {
#pragma unroll
            for (int m = 0; m < 4; ++m) { const int row = row0 + ai * HALF + m * 16;
                const u32x4 cw = csh[ai][m];
#define EP_LO(w) ((float)__builtin_bit_cast(_Float16, (unsigned short)((w) & 0xffffu)))
#define EP_HI(w) ((float)__builtin_bit_cast(_Float16, (unsigned short)((w) >> 16)))
                const f32x4 cs0 = {EP_LO(cw.x), EP_HI(cw.x), EP_LO(cw.y), EP_HI(cw.y)}, cs1 = {EP_LO(cw.z), EP_HI(cw.z), EP_LO(cw.w), EP_HI(cw.w)};
#undef EP_LO
#undef EP_HI
#pragma unroll
                for (int bj = 0; bj < 2; ++bj) { const int cb = u.pn * BM + bj * HALF;
                    const bool roped = col_roped(cb); const float sc = (cb < C_KA || (cb >= C_QD && cb < C_KD)) ? C2 : 1.f;
                    f32x4 v0 = acc[ai][bj][m][0], v1 = acc[ai][bj][m][1];
                    if (roped) {
                        const f32x4 a = v0, b = v1;
                        v0[0] = a[0] * cs0[0] - a[1] * cs0[1]; v0[1] = a[1] * cs0[0] + a[0] * cs0[1];
                        v0[2] = a[2] * cs0[2] - a[3] * cs0[3]; v0[3] = a[3] * cs0[2] + a[2] * cs0[3];
                        v1[0] = b[0] * cs1[0] - b[1] * cs1[1]; v1[1] = b[1] * cs1[0] + b[0] * cs1[1];
                        v1[2] = b[2] * cs1[2] - b[3] * cs1[3]; v1[3] = b[3] * cs1[2] + b[2] * cs1[3];
                    }
                    v0 = v0 * sc; v1 = v1 * sc;
                    u32x4 w; w.x = cvt_pk_bf16(v0[0], v0[1]); w.y = cvt_pk_bf16(v0[2], v0[3]); w.z = cvt_pk_bf16(v1[0], v1[1]); w.w = cvt_pk_bf16(v1[2], v1[3]);
                    bf16_t* dst = qt ? qblk + ((size_t)((u.pm * 16 + wr * 4 + ai * 8 + m) * 32 + qtile * 8 + wc + bj * 4) * 512 + fr * 32 + fq * 8) : proj + (size_t)row * NP + col0 + bj * HALF;
                    *(u32x4*)dst = w; } }
        }
    }
};
struct EpiRes {
    static constexpr bool PERM = false, AFTER_DRAIN = false, A_NT = false, FP8 = false; static constexpr int KT0 = 0, NT8 = 0; static constexpr bool PREF = false; static constexpr int NST = 0; static constexpr float MIXSCALE = 1.f;
    const float* xi; float* xo; bf16_t* xb; float* ss;
    __device__ __forceinline__ void operator()(const f32x4 (&acc)[2][2][4][2], const Unit& u, int wr, int wc, int fr, int fq) const {
        const int row0 = u.pm * BM + wr * 64 + fr, col0 = u.pn * BM + wc * 32 + 4 * fq;
#pragma unroll
        for (int ai = 0; ai < 2; ++ai)
#pragma unroll
            for (int m = 0; m < 4; ++m) { const int row = row0 + ai * HALF + m * 16; const size_t off = (size_t)row * DM + col0; float q = 0.f;
#pragma unroll
                for (int bj = 0; bj < 2; ++bj)
#pragma unroll
                    for (int n = 0; n < 2; ++n) { const size_t c = off + bj * HALF + n * 16; const f32x4 r = *(const f32x4*)(xi + c) + acc[ai][bj][m][n];
                        *(f32x4*)(xo + c) = r; q += (r[0] * r[0] + r[1] * r[1]) + (r[2] * r[2] + r[3] * r[3]);
                        if (xb) { u32x2 w; w.x = cvt_pk_bf16(r[0], r[1]); w.y = cvt_pk_bf16(r[2], r[3]); *(u32x2*)(xb + c) = w; } }
                q += __shfl_xor(q, 16); q += __shfl_xor(q, 32);
                if (fq == 0) ss[(size_t)row * 16 + u.pn * 4 + wc] = q;
                if (m & 1) asm volatile("" ::: "memory"); }
    }
};
template <bool XF> struct EpiResB {
    static constexpr bool PERM = true, AFTER_DRAIN = false, A_NT = false, FP8 = !XF; static constexpr int KT0 = XF ? 4 : 0, NT8 = XF ? 4 : 0; static constexpr bool PREF = false; static constexpr int NST = 0; static constexpr float MIXSCALE = 1.f / 512.f;
    const float* xf; const bf16_t* xb_in; bf16_t* xb_out; float* ss; unsigned char* xb8; float asc;
    __device__ __forceinline__ void operator()(const f32x4 (&acc)[2][2][4][2], const Unit& u, int wr, int wc, int fr, int fq) const {
        if constexpr (FP8 || NT8 > 0) { asm volatile("" : "+v"(fr), "+v"(fq)); }
        const int row0 = u.pm * BM + wr * 64 + fr, col0 = u.pn * BM + wc * 32 + 8 * fq;
        const size_t xblk0 = (size_t)((u.pm * 16 + wr * 4) * 32 + u.pn * 8 + wc) * 512 + fr * 32 + fq * 8;
#define XBLK(ai, m, bj) (xblk0 + (size_t)((((ai) * 8 + (m)) * 32 + (bj) * 4) * 512))
        typedef unsigned erb_v4u __attribute__((__vector_size__(16)));
        const __amdgpu_buffer_rsrc_t rs_xb = __builtin_amdgcn_make_buffer_rsrc((void*)xb_out, 0, 0x7fffffff, 0x00020000);
        float irsv[2][4];
        if (XF) {
#pragma unroll
            for (int ai = 0; ai < 2; ++ai)
#pragma unroll
                for (int m = 0; m < 4; ++m) irsv[ai][m] = xf[row0 + ai * HALF + m * 16]; }
#pragma unroll
        for (int ai = 0; ai < 2; ++ai) {
            u32x4 pre[4][2];
            {
#pragma unroll
                for (int m = 0; m < 4; ++m)
#pragma unroll
                    for (int bj = 0; bj < 2; ++bj) pre[m][bj] = *(const u32x4*)(xb_in + XBLK(ai, m, bj)); }
#pragma unroll
            for (int m = 0; m < 4; ++m) { const int row = row0 + ai * HALF + m * 16; const size_t off = (size_t)row * DM + col0; float q = 0.f; const float irs = XF ? irsv[ai][m] : 1.f;
#pragma unroll
                for (int bj = 0; bj < 2; ++bj) { f32x4 r0, r1;
                    { const u32x4 w = pre[m][bj];
                        r0 = (f32x4){__uint_as_float(w.x << 16), __uint_as_float(w.x & 0xffff0000u), __uint_as_float(w.y << 16), __uint_as_float(w.y & 0xffff0000u)};
                        r1 = (f32x4){__uint_as_float(w.z << 16), __uint_as_float(w.z & 0xffff0000u), __uint_as_float(w.w << 16), __uint_as_float(w.w & 0xffff0000u)}; }
                    if (XF) { r0 = r0 * irs; r1 = r1 * irs; }
                    r0 = r0 + acc[ai][bj][m][0] * asc; r1 = r1 + acc[ai][bj][m][1] * asc;
                    q += ((r0[0] * r0[0] + r0[1] * r0[1]) + (r0[2] * r0[2] + r0[3] * r0[3])) + ((r1[0] * r1[0] + r1[1] * r1[1]) + (r1[2] * r1[2] + r1[3] * r1[3]));
                    u32x4 w; w.x = cvt_pk_bf16(r0[0], r0[1]); w.y = cvt_pk_bf16(r0[2], r0[3]); w.z = cvt_pk_bf16(r1[0], r1[1]); w.w = cvt_pk_bf16(r1[2], r1[3]);
                    __builtin_amdgcn_raw_buffer_store_b128(__builtin_bit_cast(erb_v4u, w), rs_xb, (unsigned)(XBLK(ai, m, bj) * 2), 0,   16);
                    if (XF) {
                        int d0 = __builtin_amdgcn_cvt_pk_fp8_f32(r0[0], r0[1], 0, false); d0 = __builtin_amdgcn_cvt_pk_fp8_f32(r0[2], r0[3], d0, true);
                        int d1 = __builtin_amdgcn_cvt_pk_fp8_f32(r1[0], r1[1], 0, false); d1 = __builtin_amdgcn_cvt_pk_fp8_f32(r1[2], r1[3], d1, true);
                        u32x2 w8; w8.x = (unsigned)d0; w8.y = (unsigned)d1;
                        *(u32x2*)(xb8 + ((size_t)((u.pm * 16 + wr * 4 + ai * 8 + m) * 16 + u.pn * 4 + bj * 2 + (wc >> 1)) * 1024 + fr * 64 + (wc & 1) * 32 + fq * 8)) = w8; } }
                q += __shfl_xor(q, 16); q += __shfl_xor(q, 32);
                if (fq == 0) ss[(size_t)row * 16 + u.pn * 4 + wc] = q; }
            asm volatile("" ::: "memory");
        }
    }
};
#undef XBLK
struct EpiResF {
    static constexpr bool PERM = false, AFTER_DRAIN = false, A_NT = false, FP8 = false; static constexpr int KT0 = 0, NT8 = 0; static constexpr bool PREF = false; static constexpr int NST = 0; static constexpr float MIXSCALE = 1.f;
    const bf16_t* xb; float* xo; float* ss;
    __device__ __forceinline__ void operator()(const f32x4 (&acc)[2][2][4][2], const Unit& u, int wr, int wc, int fr, int fq) const {
        const int row0 = u.pm * BM + wr * 64 + fr, col0 = u.pn * BM + wc * 32 + 4 * fq;
#pragma unroll
        for (int ai = 0; ai < 2; ++ai)
#pragma unroll
            for (int m = 0; m < 4; ++m) { const int row = row0 + ai * HALF + m * 16; const size_t off = (size_t)row * DM + col0; float q = 0.f;
#pragma unroll
                for (int bj = 0; bj < 2; ++bj)
#pragma unroll
                    for (int n = 0; n < 2; ++n) { const size_t c = off + bj * HALF + n * 16; const u32x2 w = *(const u32x2*)(xb + ((size_t)(((row >> 4) * 32) + u.pn * 8 + wc + bj * 4) * 512 + (row & 15) * 32 + 4 * fq + n * 16));
                        const f32x4 r = (f32x4){__uint_as_float(w.x << 16), __uint_as_float(w.x & 0xffff0000u), __uint_as_float(w.y << 16), __uint_as_float(w.y & 0xffff0000u)} + acc[ai][bj][m][n];
                        *(f32x4*)(xo + c) = r; q += (r[0] * r[0] + r[1] * r[1]) + (r[2] * r[2] + r[3] * r[3]); }
                q += __shfl_xor(q, 16); q += __shfl_xor(q, 32);
                if (fq == 0) ss[(size_t)row * 16 + u.pn * 4 + wc] = q;
                if (m & 1) asm volatile("" ::: "memory"); }
    }
};
struct EpiFinal {
    static constexpr bool PERM = false, AFTER_DRAIN = false, A_NT = true, FP8 = false; static constexpr int KT0 = 0, NT8 = 0; static constexpr bool PREF = false; static constexpr int NST = 0; static constexpr float MIXSCALE = 1.f;
    const bf16_t* xb; float* out; const float* g; unsigned* xbuf; unsigned* cnt; PG8_LAS unsigned char* tab;
    __device__ __forceinline__ void operator()(f32x4 (&acc)[2][2][4][2], const Unit& u, int wr, int wc, int fr, int fq) const {
        const int tid = threadIdx.x, lane = tid & 63, wid = __builtin_amdgcn_readfirstlane(tid >> 6);
        PG8_LAS float* P = (PG8_LAS float*)tab; PG8_LAS float* S = (PG8_LAS float*)(tab + 4096);
        const int col0 = u.pn * BM + wc * 32 + 4 * fq;
        f32x4 gg[2][2];
#pragma unroll
        for (int bj = 0; bj < 2; ++bj)
#pragma unroll
            for (int n = 0; n < 2; ++n) gg[bj][n] = *(const f32x4*)(g + col0 + bj * HALF + n * 16);
#pragma unroll
        for (int ai = 0; ai < 2; ++ai)
#pragma unroll
            for (int m = 0; m < 4; ++m) { const int rl = ai * HALF + wr * 64 + m * 16 + fr; const size_t off = (size_t)(u.pm * BM + rl) * DM + col0; float q = 0.f;
#pragma unroll
                for (int bj = 0; bj < 2; ++bj)
#pragma unroll
                    for (int n = 0; n < 2; ++n) { const u32x2 w = *(const u32x2*)(xb + ((size_t)((u.pm * 16 + ai * 8 + wr * 4 + m) * 32 + u.pn * 8 + wc + bj * 4) * 512 + fr * 32 + 4 * fq + n * 16));
                        const f32x4 r = (f32x4){__uint_as_float(w.x << 16), __uint_as_float(w.x & 0xffff0000u), __uint_as_float(w.y << 16), __uint_as_float(w.y & 0xffff0000u)} + acc[ai][bj][m][n];
                        acc[ai][bj][m][n] = r; q += (r[0] * r[0] + r[1] * r[1]) + (r[2] * r[2] + r[3] * r[3]); }
                q += __shfl_xor(q, 16); q += __shfl_xor(q, 32);
                if (fq == 0) P[rl * 4 + wc] = q;
                if (m == 3) asm volatile("" ::: "memory"); }
        asm volatile("s_waitcnt lgkmcnt(0)" ::: "memory"); __builtin_amdgcn_s_barrier(); asm volatile("" ::: "memory");
        unsigned* slot = xbuf + ((size_t)(u.pm * BM + (tid & 255)) * 4);
        if (tid < 256) { const f32x4 a = *(const PG8_LAS f32x4*)(P + tid * 4);
            __hip_atomic_store(slot + u.pn, __float_as_uint((a[0] + a[1]) + (a[2] + a[3])), __ATOMIC_RELAXED, __HIP_MEMORY_SCOPE_AGENT); }
        asm volatile("s_waitcnt vmcnt(0)" ::: "memory");
        if (tid < 256 && lane == 0) __hip_atomic_fetch_add(cnt + 64 * u.pm, 1u, __ATOMIC_RELAXED, __HIP_MEMORY_SCOPE_AGENT);
        if (wid == 0) {
            unsigned sp = 0;
            while ((unsigned)__builtin_amdgcn_readfirstlane(__hip_atomic_load(cnt + 64 * u.pm, __ATOMIC_RELAXED, __HIP_MEMORY_SCOPE_AGENT)) < 16u) { __builtin_amdgcn_s_sleep(2); if (++sp > (1u << 22)) break; }
            __builtin_amdgcn_fence(__ATOMIC_ACQUIRE, "agent");
        }
        asm volatile("s_waitcnt vmcnt(0) lgkmcnt(0)" ::: "memory"); __builtin_amdgcn_s_barrier(); asm volatile("" ::: "memory");
        if (tid < 256) { float t = 0.f;
#pragma unroll
            for (int k = 0; k < 4; ++k) t += __uint_as_float(__hip_atomic_load(slot + k, __ATOMIC_RELAXED, __HIP_MEMORY_SCOPE_AGENT));
            S[tid] = 1.0f / sqrtf(t * (1.f / DM) + EPS); }
        asm volatile("s_waitcnt lgkmcnt(0)" ::: "memory"); __builtin_amdgcn_s_barrier(); asm volatile("" ::: "memory");
        typedef unsigned epf_v4u __attribute__((__vector_size__(16)));
        const __amdgpu_buffer_rsrc_t rs_out = __builtin_amdgcn_make_buffer_rsrc((void*)out, 0, 0x7fffffff, 0x00020000);
#pragma unroll
        for (int ai = 0; ai < 2; ++ai)
#pragma unroll
            for (int m = 0; m < 4; ++m) { const int rl = ai * HALF + wr * 64 + m * 16 + fr; const size_t off = (size_t)(u.pm * BM + rl) * DM + col0; const float rs = S[rl];
#pragma unroll
                for (int bj = 0; bj < 2; ++bj)
#pragma unroll
                    for (int n = 0; n < 2; ++n) { const f32x4 ov = acc[ai][bj][m][n] * rs * gg[bj][n]; __builtin_amdgcn_raw_buffer_store_b128(__builtin_bit_cast(epf_v4u, ov), rs_out, (unsigned)((off + bj * HALF + n * 16) * 4), 0,   18); } }
    }
};
template <int ACT> struct EpiScaleBf16 {
    static constexpr bool PERM = true, AFTER_DRAIN = false, A_NT = false, FP8 = (ACT == 0); static constexpr int KT0 = 0, NT8 = 0; static constexpr bool PREF = true; static constexpr int NST = 0; static constexpr float MIXSCALE = 1.f;
    static constexpr int RAW_REL = 147456 - (131072 + 1024);
    bf16_t* O; int ldc; const float* ss; float mul; PG8_LAS unsigned char* tab;
    __device__ __forceinline__ void operator()(const f32x4 (&acc)[2][2][4][2], const Unit& u, int wr, int wc, int fr, int fq) const {
        int tid = threadIdx.x; PG8_LAS float* S = (PG8_LAS float*)tab;
        if constexpr (FP8) { asm volatile("" : "+v"(fr), "+v"(fq), "+v"(tid)); }
        if constexpr (!PREF) { if (tid < 256) S[tid] = rstd_ss(ss, u.pm * BM + tid) * mul; }
        else { if (tid < 256) { const PG8_LAS f32x4* r4 = (const PG8_LAS f32x4*)(tab + RAW_REL + tid * 64); float t = 0.f;
#pragma unroll
                for (int i = 0; i < 4; ++i) { const f32x4 v = r4[i]; t += (v.x + v.y) + (v.z + v.w); }
                S[tid] = (1.0f / sqrtf(t * (1.f / DM) + EPS)) * mul; } }
        asm volatile("s_waitcnt lgkmcnt(0)" ::: "memory"); __builtin_amdgcn_s_barrier(); asm volatile("" ::: "memory");
        const int rl0 = wr * 64 + fr, col0 = u.pn * BM + wc * 32 + 8 * fq;
#pragma unroll
        for (int ai = 0; ai < 2; ++ai)
#pragma unroll
            for (int m = 0; m < 4; ++m) { const int rl = rl0 + ai * HALF + m * 16; const float rs = S[rl];
                bf16_t* rowp = O + ((size_t)((u.pm * 16 + wr * 4 + ai * 8 + m) * (ldc >> 5) + u.pn * 8 + wc) * 512 + fr * 32 + fq * 8);
#pragma unroll
                for (int bj = 0; bj < 2; ++bj) { f32x4 v0 = acc[ai][bj][m][0] * rs, v1 = acc[ai][bj][m][1] * rs;
                    if (ACT == 1) {
#pragma unroll
                        for (int e = 0; e < 4; ++e) { const float a = fmaxf(v0[e], 0.f), b = fmaxf(v1[e], 0.f); v0[e] = a * a; v1[e] = b * b; } }
                    u32x4 w; w.x = cvt_pk_bf16(v0[0], v0[1]); w.y = cvt_pk_bf16(v0[2], v0[3]); w.z = cvt_pk_bf16(v1[0], v1[1]); w.w = cvt_pk_bf16(v1[2], v1[3]);
                    if (ACT == 1) __builtin_nontemporal_store(w, (u32x4*)(rowp + bj * 4 * 512));   else *(u32x4*)(rowp + bj * 4 * 512) = w; } }
        if constexpr (!PREF) __builtin_amdgcn_s_barrier();
    }
    __device__ __forceinline__ void pref_issue(const Unit& u) const {
        const int tid = threadIdx.x, w = __builtin_amdgcn_readfirstlane(tid >> 6), lane = tid & 63;
        const float* src = ss + (size_t)(u.pm * BM + w * 32) * 16 + lane * 4;
#pragma unroll
        for (int i = 0; i < 2; ++i) __builtin_amdgcn_global_load_lds((const unsigned*)(src + i * 256), (PG8_LAS unsigned*)(tab + RAW_REL + w * 2048 + i * 1024), 16, 0, 0);
    }
};

template <class Epi, class Sched, bool ALIGN_EPI = false, bool SP2 = false>
__device__ __forceinline__ void gemm_phase(PG8_LAS unsigned char* lds, const Gemm g, const Sched& S, const Epi& E) {
    const int tid = threadIdx.x, wid = __builtin_amdgcn_readfirstlane(tid >> 6), lane = tid & 63, wr = wid >> 2, wc = wid & 3, fr = lane & 15, fq = lane >> 4;
    const int K = g.K, Kb = K * (Epi::FP8 ? 1 : 2), nt = Kb / (BK * 2) - Epi::KT0;
    (void)K;
    unsigned voffA[2], voffB[2];
#pragma unroll
    for (int i = 0; i < 2; ++i) { int R, C; stage_rc(tid * 16 + i * 8192, R, C); const int Rb = Epi::PERM ? ((R & ~31) + perm32(R & 31)) : R;
        voffA[i] = g.ablk ? (unsigned)(((R >> 4) * (Kb >> 6) + (C >> 5)) * 1024 + (R & 15) * 64 + (C & 31) * 2) : (unsigned)(R * Kb + C * 2); voffB[i] = (unsigned)(Rb * Kb + C * 2); }
    const size_t kstep = (size_t)(BK * 2);
    const size_t hstep = (size_t)HALF * Kb;
    const size_t kstepA = g.ablk ? (size_t)2048 : kstep, hstepA = g.ablk ? (size_t)8 * (Kb >> 6) * 1024 : hstep, tstepA = 2 * hstepA;
    const size_t tstep = 2 * hstep;
    const unsigned ldsw = (unsigned)wid * 1024u;
    const int aoff = lds_byte(wr * 64 + fr, fq * 8), boff = lds_byte(wc * 32 + fr, fq * 8);
#define PG8_SA(b, h) (((b) * 2 + (h)) * HTB)
#define PG8_SB(b, h) ((4 + (b) * 2 + (h)) * HTB)
#define PG8_UNI(p_) ((const char*)((((unsigned long long)(unsigned)__builtin_amdgcn_readfirstlane((int)((unsigned long long)(p_) >> 32))) << 32) | (unsigned long long)(unsigned)__builtin_amdgcn_readfirstlane((int)(unsigned)(unsigned long long)(p_))))
#define PG8_STAGE(bufoff, gbase, voff) do { _Pragma("unroll") for (int _i = 0; _i < 2; ++_i) { asm volatile("" : "+v"((voff)[_i]));     \
        __builtin_amdgcn_global_load_lds((const unsigned*)(PG8_UNI(gbase) + (voff)[_i]), (PG8_LAS unsigned*)(lds + (bufoff) + ldsw + _i * 8192), 16, 0, 0); } } while (0)
#define PG8_STAGE_A(bufoff, gbase, voff) do { _Pragma("unroll") for (int _i = 0; _i < 2; ++_i) { asm volatile("" : "+v"((voff)[_i])); \
        __builtin_amdgcn_global_load_lds((const unsigned*)(PG8_UNI(gbase) + (voff)[_i]), (PG8_LAS unsigned*)(lds + (bufoff) + ldsw + _i * 8192), 16, 0, Epi::A_NT ? 2 : 0); } } while (0)
#define PG8_LDAF(F8_, dst, b, h) do { if constexpr (F8_) { _Pragma("unroll") for (int m = 0; m < 4; ++m) dst##8[m] = __builtin_shufflevector(*(const PG8_LAS pg8_v4i*)(lds + PG8_SA(b, h) + aoff + m * 2048), *(const PG8_LAS pg8_v4i*)(lds + PG8_SA(b, h) + aoff + m * 2048 + 1024), 0, 1, 2, 3, 4, 5, 6, 7); } \
        else { _Pragma("unroll") for (int m = 0; m < 4; ++m) _Pragma("unroll") for (int k = 0; k < 2; ++k) dst[m][k] = *(const PG8_LAS bf16x8*)(lds + PG8_SA(b, h) + aoff + m * 2048 + k * 1024); } } while (0)
#define PG8_LDBF(F8_, dst, b, h) do { if constexpr (F8_) { _Pragma("unroll") for (int n = 0; n < 2; ++n) dst##8[n] = __builtin_shufflevector(*(const PG8_LAS pg8_v4i*)(lds + PG8_SB(b, h) + boff + n * 2048), *(const PG8_LAS pg8_v4i*)(lds + PG8_SB(b, h) + boff + n * 2048 + 1024), 0, 1, 2, 3, 4, 5, 6, 7); } \
        else { _Pragma("unroll") for (int n = 0; n < 2; ++n) _Pragma("unroll") for (int k = 0; k < 2; ++k) dst[n][k] = *(const PG8_LAS bf16x8*)(lds + PG8_SB(b, h) + boff + n * 2048 + k * 1024); } } while (0)
#define PG8_MMAF(F8_, ai, bj, At, Bt) do { __builtin_amdgcn_s_setprio(1); \
        if constexpr (F8_) { _Pragma("unroll") for (int m = 0; m < 4; ++m) _Pragma("unroll") for (int n = 0; n < 2; ++n)     \
            acc[ai][bj][m][n] = __builtin_amdgcn_mfma_scale_f32_16x16x128_f8f6f4(Bt##8[n], At##8[m], acc[ai][bj][m][n], 0, 0, 0, 0, 0, 0); } \
        else { _Pragma("unroll") for (int m = 0; m < 4; ++m) _Pragma("unroll") for (int n = 0; n < 2; ++n) _Pragma("unroll") for (int k = 0; k < 2; ++k) \
            acc[ai][bj][m][n] = __builtin_amdgcn_mfma_f32_16x16x32_bf16(Bt[n][k], At[m][k], acc[ai][bj][m][n], 0, 0, 0); } \
        __builtin_amdgcn_s_setprio(0); } while (0)
#define PG8_LDA(dst, b, h) PG8_LDAF(Epi::FP8, dst, b, h)
#define PG8_LDB(dst, b, h) PG8_LDBF(Epi::FP8, dst, b, h)
#define PG8_MMA(ai, bj, At, Bt) PG8_MMAF(Epi::FP8, ai, bj, At, Bt)
#define PG8_WAIT_V(n) asm volatile("s_waitcnt vmcnt(" #n ")" ::: "memory")
#define PG8_WAIT_L(n) asm volatile("s_waitcnt lgkmcnt(" #n ")" ::: "memory")
#define PG8_BAR __builtin_amdgcn_s_barrier()
#define PG8_SCHED __builtin_amdgcn_sched_barrier(0)
    Unit cur, nxt; int ui = 0;
    if (!S.next(0, cur)) return;
    f32x4 acc[2][2][4][2];
#pragma unroll
    for (int a = 0; a < 2; ++a)
#pragma unroll
        for (int b = 0; b < 2; ++b)
#pragma unroll
            for (int m = 0; m < 4; ++m)
#pragma unroll
                for (int n = 0; n < 2; ++n) acc[a][b][m][n] = (f32x4){0.f, 0.f, 0.f, 0.f};
    bf16x8 At[4][2], B0[2][2], B1[2][2];
    pg8_v8i At8[4], B08[2], B18[2];
    const size_t koffA = (size_t)Epi::KT0 * kstepA, koffB = (size_t)Epi::KT0 * kstep;
    const char* cA = (const char*)(cur.alt ? g.A2 : g.A) + (size_t)cur.pm * tstepA + koffA; const char* cB = (const char*)(cur.alt ? g.Bt2 : g.Bt) + (size_t)cur.pn * tstep + koffB;
    S.a_ready(cur);
    if constexpr (Epi::PREF) E.pref_issue(cur);
    if constexpr (SP2) {
        PG8_STAGE(PG8_SB(0, 0), cB, voffB); PG8_STAGE(PG8_SB(0, 1), cB + hstep, voffB); PG8_STAGE_A(PG8_SA(0, 0), cA, voffA); PG8_STAGE_A(PG8_SA(0, 1), cA + hstepA, voffA);
        if (wr == 1) PG8_BAR;
        PG8_WAIT_V(2); PG8_BAR;
        PG8_STAGE(PG8_SB(1, 0), cB + kstep, voffB); PG8_STAGE_A(PG8_SA(1, 0), cA + kstepA, voffA); PG8_STAGE(PG8_SB(1, 1), cB + hstep + kstep, voffB);
        PG8_WAIT_V(6); PG8_BAR;
    } else {
        PG8_STAGE(PG8_SB(0, 0), cB, voffB); PG8_STAGE_A(PG8_SA(0, 0), cA, voffA); PG8_STAGE(PG8_SB(0, 1), cB + hstep, voffB); PG8_STAGE_A(PG8_SA(0, 1), cA + hstepA, voffA);
        if (wr == 1) PG8_BAR;
        PG8_WAIT_V(4); PG8_BAR;
        PG8_STAGE(PG8_SB(1, 0), cB + kstep, voffB); PG8_STAGE_A(PG8_SA(1, 0), cA + kstepA, voffA); PG8_STAGE(PG8_SB(1, 1), cB + hstep + kstep, voffB);
        PG8_WAIT_V(6); PG8_BAR;
    }
    for (;;) {
        const bool has_next = S.next(ui + 1, nxt);
        const char* nA = has_next ? (const char*)(nxt.alt ? g.A2 : g.A) + (size_t)nxt.pm * tstepA + koffA : cA; const char* nB = has_next ? (const char*)(nxt.alt ? g.Bt2 : g.Bt) + (size_t)nxt.pn * tstep + koffB : cB;
#define PG8_ITERW(F8_, W_) do { \
            const bool last = (t == nt - 2); \
            const char* a1 = cA + (size_t)(t + 1) * kstepA; \
            const char* a2 = last ? nA : cA + (size_t)(t + 2) * kstepA; const char* b2 = last ? nB : cB + (size_t)(t + 2) * kstep; \
            const char* a3 = a2 + kstepA; const char* b3 = b2 + kstep; \
            if (last && has_next) S.a_ready(nxt); \
            PG8_LDBF(F8_, B0, 0, 0); PG8_LDBF(F8_, B1, 0, 1); PG8_SCHED; PG8_LDAF(F8_, At, 0, 0); PG8_STAGE_A(PG8_SA(1, 1), a1 + hstepA, voffA); \
            PG8_WAIT_V(W_); PG8_WAIT_L(0); PG8_BAR; PG8_MMAF(F8_, 0, 0, At, B0); PG8_MMAF(F8_, 0, 1, At, B1); PG8_BAR; PG8_SCHED; \
            PG8_LDAF(F8_, At, 0, 1); PG8_STAGE(PG8_SB(0, 0), b2, voffB); PG8_STAGE(PG8_SB(0, 1), b2 + hstep, voffB); PG8_STAGE_A(PG8_SA(0, 0), a2, voffA); \
            PG8_WAIT_V(W_); PG8_WAIT_L(0); PG8_BAR; PG8_MMAF(F8_, 1, 0, At, B0); PG8_MMAF(F8_, 1, 1, At, B1); PG8_BAR; PG8_SCHED; \
            PG8_LDBF(F8_, B0, 1, 0); PG8_LDBF(F8_, B1, 1, 1); PG8_SCHED; PG8_LDAF(F8_, At, 1, 0); PG8_STAGE_A(PG8_SA(0, 1), a2 + hstepA, voffA); \
            PG8_WAIT_V(8); PG8_WAIT_L(0); PG8_BAR; PG8_MMAF(F8_, 0, 0, At, B0); PG8_MMAF(F8_, 0, 1, At, B1); PG8_BAR; PG8_SCHED; \
            PG8_LDAF(F8_, At, 1, 1); PG8_STAGE(PG8_SB(1, 0), b3, voffB); PG8_STAGE(PG8_SB(1, 1), b3 + hstep, voffB); PG8_STAGE_A(PG8_SA(1, 0), a3, voffA); \
            PG8_WAIT_V(8); PG8_WAIT_L(0); PG8_BAR; PG8_MMAF(F8_, 1, 0, At, B0); PG8_MMAF(F8_, 1, 1, At, B1); PG8_BAR; PG8_SCHED; \
        } while (0)
        static_assert(SP2, "only the merged-phase schedule is kept");
        if constexpr (Epi::NT8 > 0) {
#pragma nounroll
            for (int t = 0; t < Epi::NT8; t += 2) PG8_ITERW(true, 8);
#pragma unroll
            for (int a_ = 0; a_ < 2; ++a_)
#pragma unroll
                for (int b_ = 0; b_ < 2; ++b_)
#pragma unroll
                    for (int m_ = 0; m_ < 4; ++m_)
#pragma unroll
                        for (int n_ = 0; n_ < 2; ++n_) acc[a_][b_][m_][n_] = acc[a_][b_][m_][n_] * Epi::MIXSCALE;
#pragma nounroll
            for (int t = Epi::NT8; t < nt; t += 2) PG8_ITERW(false, 8);
        } else {
            if constexpr (Epi::NST == 16) {
                { const int t = 0; PG8_ITERW(Epi::FP8, 24); }
#pragma nounroll
                for (int t = 2; t < nt; t += 2) PG8_ITERW(Epi::FP8, 8);
            } else {
#pragma nounroll
                for (int t = 0; t < nt; t += 2) PG8_ITERW(Epi::FP8, 8);
            }
        }
#undef PG8_ITERW
        if constexpr (ALIGN_EPI) { if (wr == 0) PG8_BAR; }
        if constexpr (!Epi::AFTER_DRAIN) { E(acc, cur, wr, wc, fr, fq); S.done(cur); }
        if (!has_next) break;
        if constexpr (Epi::PREF) E.pref_issue(nxt);
#pragma unroll
        for (int a = 0; a < 2; ++a)
#pragma unroll
            for (int b = 0; b < 2; ++b)
#pragma unroll
                for (int m = 0; m < 4; ++m)
#pragma unroll
                    for (int n = 0; n < 2; ++n) acc[a][b][m][n] = (f32x4){0.f, 0.f, 0.f, 0.f};
        cur = nxt; cA = nA; cB = nB; ++ui;
        if constexpr (ALIGN_EPI) { if (wr == 1) PG8_BAR; }
    }
    PG8_WAIT_V(0);
    if constexpr (!ALIGN_EPI) { if (wr == 0) PG8_BAR; }
    PG8_BAR;
    if constexpr (Epi::AFTER_DRAIN) { E.fused(acc, cur, wr, wc, fr, fq, lds, wid, lane); S.done(cur); }
#undef PG8_SA
#undef PG8_SB
#undef PG8_STAGE
#undef PG8_UNI
#undef PG8_STAGE_A
#undef PG8_LDA
#undef PG8_LDB
#undef PG8_MMA
#undef PG8_LDAF
#undef PG8_LDBF
#undef PG8_MMAF
#undef PG8_WAIT_V
#undef PG8_WAIT_L
#undef PG8_BAR
#undef PG8_SCHED
}
}
namespace fa {
typedef short bf16x8 __attribute__((ext_vector_type(8)));
typedef short s16x4 __attribute__((ext_vector_type(4)));
typedef float f32x16 __attribute__((ext_vector_type(16)));
typedef float f32x4 __attribute__((ext_vector_type(4)));
typedef unsigned u32x4 __attribute__((ext_vector_type(4)));
constexpr int NW = 8, QBLK = 32, KVBLK = 64;
constexpr float THR = 8.f;
#define FA_SBAR() __builtin_amdgcn_sched_barrier(0)
#define FA_VMW() asm volatile("s_waitcnt vmcnt(0)" ::: "memory")
__device__ __forceinline__ int crow(int r, int hi) { return (r & 3) + 8 * (r >> 2) + 4 * hi; }
typedef __bf16 cvt_bf2a __attribute__((ext_vector_type(2))); typedef float cvt_f2a __attribute__((ext_vector_type(2)));
__device__ __forceinline__ unsigned cvtpk(float lo, float hi) { const cvt_f2a v = {lo, hi}; return __builtin_bit_cast(unsigned, __builtin_convertvector(v, cvt_bf2a)); }

template <int NDQ> __device__ __forceinline__ int kswz(int row, int c) {
    if (NDQ == 4) return row * 128 + ((c ^ ((row >> 1) & 7)) << 4);
    else return row * (NDQ * 32) + ((c ^ (row & 15)) << 4);
}
template <int NDVT> __device__ __forceinline__ int v_st(int k, int c) { const int kk = (k & ~0xC) | ((k & 4) << 1) | ((k & 8) >> 1); return ((kk >> 3) * NDVT + (c >> 5)) * 512 + ((kk & 7) * 32 + (c & 31)) * 2; }
__device__ __forceinline__ int v_rd_base(int lane) { return ((lane & 3) << 3) | (((lane >> 2) & 3) << 6) | (((lane >> 4) & 1) << 5) | (((lane >> 5) & 1) << 8); }

__device__ __forceinline__ void mask_tile(f32x16& p0, f32x16& p1, int dq, unsigned W) {
    const float NEG = -__builtin_inff();
#pragma unroll
    for (int r = 0; r < 16; ++r) { const int c = (r & 3) + 8 * (r >> 2);
        if ((unsigned)(dq - c) >= W) p0[r] = NEG;
        if ((unsigned)(dq - c - 32) >= W) p1[r] = NEG; }
}
__device__ __forceinline__ void partialSM(f32x16& p0, f32x16& p1, float& m_reg, float& alpha) {
    float pmax = p0[0];
#pragma unroll
    for (int r = 1; r < 16; ++r) pmax = fmaxf(pmax, p0[r]);
#pragma unroll
    for (int r = 0; r < 16; ++r) pmax = fmaxf(pmax, p1[r]);
    { auto rr = __builtin_amdgcn_permlane32_swap(__float_as_uint(pmax), __float_as_uint(pmax), false, false); pmax = fmaxf(__uint_as_float(rr[0]), __uint_as_float(rr[1])); }
    float mn;
    if (__builtin_expect(__all((pmax - m_reg) <= THR), 1)) { mn = m_reg; alpha = 1.f; }
    else { mn = fmaxf(m_reg, pmax); alpha = __builtin_amdgcn_exp2f(m_reg - mn); m_reg = mn; }
#pragma unroll
    for (int r = 0; r < 16; ++r) p0[r] = p0[r] - mn;
#pragma unroll
    for (int r = 0; r < 16; ++r) p1[r] = p1[r] - mn;
#pragma unroll
    for (int r = 0; r < 16; ++r) p0[r] = __builtin_amdgcn_exp2f(p0[r]);
}
__device__ __forceinline__ void finishSM(f32x16& p0, f32x16& p1, float alpha, float& l_reg, bf16x8& pa0, bf16x8& pa1, bf16x8& pa2, bf16x8& pa3) {
#pragma unroll
    for (int r = 0; r < 16; ++r) p1[r] = __builtin_amdgcn_exp2f(p1[r]);
    float ps = 0.f;
#pragma unroll
    for (int r = 0; r < 16; ++r) ps += p0[r];
#pragma unroll
    for (int r = 0; r < 16; ++r) ps += p1[r];
    { auto rr = __builtin_amdgcn_permlane32_swap(__float_as_uint(ps), __float_as_uint(ps), false, false); ps = __uint_as_float(rr[0]) + __uint_as_float(rr[1]); }
    l_reg = l_reg * alpha + ps;
#define FA_PK4(P, B_, OUT) do { unsigned a0 = cvtpk(P[B_ + 0], P[B_ + 1]), a1 = cvtpk(P[B_ + 2], P[B_ + 3]); unsigned b0 = cvtpk(P[B_ + 4], P[B_ + 5]), b1 = cvtpk(P[B_ + 6], P[B_ + 7]); \
        auto r0 = __builtin_amdgcn_permlane32_swap(a0, b0, false, false); auto r1 = __builtin_amdgcn_permlane32_swap(a1, b1, false, false); \
        u32x4 w = {r0[0], r1[0], r0[1], r1[1]}; OUT = *reinterpret_cast<bf16x8*>(&w); } while (0)
    FA_PK4(p0, 0, pa0); FA_PK4(p0, 8, pa1); FA_PK4(p1, 0, pa2); FA_PK4(p1, 8, pa3);
#undef FA_PK4
}
template <int NDQ>
__device__ __forceinline__ void qkt(f32x16& p0, f32x16& p1, const char* Kb, int r32, int hi, const bf16x8* qr) {
    p0 = f32x16{}; p1 = f32x16{};
    constexpr int NA = NDQ < 8 ? NDQ : 8;
    const char* kb[NA];
#pragma unroll
    for (int dd = 0; dd < NA; ++dd) kb[dd] = Kb + kswz<NDQ>(r32, 2 * dd + hi);
#pragma unroll
    for (int d0 = 0; d0 < NDQ; ++d0) { const char* a = kb[d0 & (NA - 1)] + (d0 >> 3) * 256;
        const bf16x8 b0 = *reinterpret_cast<const bf16x8*>(a);
        const bf16x8 b1 = *reinterpret_cast<const bf16x8*>(a + 32 * NDQ * 32);
        p0 = __builtin_amdgcn_mfma_f32_32x32x16_bf16(b0, qr[d0], p0, 0, 0, 0);
        p1 = __builtin_amdgcn_mfma_f32_32x32x16_bf16(b1, qr[d0], p1, 0, 0, 0); }
}
template <int NDVT, int NDV>
__device__ __forceinline__ void pv_tile(f32x16* o, int vb, bf16x8 pa0, bf16x8 pa1, bf16x8 pa2, bf16x8 pa3) {
#define FA_TRRD(dst, off) asm volatile("ds_read_b64_tr_b16 %0, %1 offset:%2" : "=&v"(dst) : "v"(vb), "i"(off) : "memory")
#define FA_PV_D0(d0) do { s16x4 l0, l1, l2, l3, h0, h1, h2, h3; constexpr int b_ = (d0) * 512, ks_ = 2 * NDVT * 512, hf_ = NDVT * 512; \
        FA_TRRD(l0, b_); FA_TRRD(h0, b_ + hf_); FA_TRRD(l1, b_ + ks_); FA_TRRD(h1, b_ + ks_ + hf_); FA_TRRD(l2, b_ + 2 * ks_); FA_TRRD(h2, b_ + 2 * ks_ + hf_); FA_TRRD(l3, b_ + 3 * ks_); FA_TRRD(h3, b_ + 3 * ks_ + hf_); \
        asm volatile("s_waitcnt lgkmcnt(0)" ::: "memory"); FA_SBAR(); \
        o[d0] = __builtin_amdgcn_mfma_f32_32x32x16_bf16((bf16x8){l0[0], l0[1], l0[2], l0[3], h0[0], h0[1], h0[2], h0[3]}, pa0, o[d0], 0, 0, 0); \
        o[d0] = __builtin_amdgcn_mfma_f32_32x32x16_bf16((bf16x8){l1[0], l1[1], l1[2], l1[3], h1[0], h1[1], h1[2], h1[3]}, pa1, o[d0], 0, 0, 0); \
        o[d0] = __builtin_amdgcn_mfma_f32_32x32x16_bf16((bf16x8){l2[0], l2[1], l2[2], l2[3], h2[0], h2[1], h2[2], h2[3]}, pa2, o[d0], 0, 0, 0); \
        o[d0] = __builtin_amdgcn_mfma_f32_32x32x16_bf16((bf16x8){l3[0], l3[1], l3[2], l3[3], h3[0], h3[1], h3[2], h3[3]}, pa3, o[d0], 0, 0, 0); } while (0)
    FA_PV_D0(0); if constexpr (NDV > 1) FA_PV_D0(1); if constexpr (NDV > 2) FA_PV_D0(2); if constexpr (NDV > 3) FA_PV_D0(3);
#undef FA_PV_D0
#undef FA_TRRD
}

template <int NDQ, int NDVT, int NDV>
struct Core {
    static constexpr int KROW = NDQ * 32, SHM_K = 64 * KROW, SHM_V = 64 * NDVT * 64, NKL = NDQ / 4, NVL = NDVT / 2, LDS_NEED = 2 * SHM_V + 2 * SHM_K + NW * 256;
    static_assert(NKL >= 1 && NVL >= 1, "tile too small for 512 staging threads");
    __device__ __forceinline__ static void run(f32x16 (&o)[NDV], float& m_reg, float& l_reg, const bf16* Qw, int ldq, const bf16* Kg, const bf16* Vg, int ldk,
                                               int j_lo, int j_hi, int qlo, int W, char* lds, int vdoff) {
        int tid = threadIdx.x; asm volatile("" : "+v"(tid));
        const int wid = __builtin_amdgcn_readfirstlane(tid >> 6), lane = tid & 63, r32 = lane & 31, hi = lane >> 5;
        const int NT = j_hi - j_lo, qm = qlo + r32 - 4 * hi;
        char* V_lds = lds; char* K_lds = lds + 2 * SHM_V;
        float* wsf = (float*)(lds + 2 * SHM_V + 2 * SHM_K) + wid * 64; float* al_l = wsf + 32;
        m_reg = -1e30f; l_reg = 0.f;
#pragma unroll
        for (int d = 0; d < NDV; ++d) o[d] = f32x16{};
        constexpr int KCH = 2 * NDQ, KRS = 512 / KCH, VCH = 4 * NDVT, VRS = 512 / VCH;
        const int krow0 = tid / KCH, kch = tid % KCH, vrow0 = tid / VCH, vcol = (tid % VCH) * 8;
        int kws[NKL], vws[NVL];
#pragma unroll
        for (int i = 0; i < NKL; ++i) kws[i] = kswz<NDQ>(krow0 + i * KRS, kch);
#pragma unroll
        for (int i = 0; i < NVL; ++i) vws[i] = v_st<NDVT>(vrow0 + i * VRS, vcol);
        const bf16* kgp = Kg + (size_t)krow0 * ldk + kch * 8; const bf16* vgp = Vg + (size_t)vrow0 * ldk + vcol;
        bf16x8 sk[NKL], sv[NVL];
        const int vb0 = (int)(uintptr_t)V_lds + v_rd_base(lane) + vdoff * 512;
#define FA_SLOAD(t) do { const size_t ro_ = (size_t)((j_lo + (t)) * KVBLK) * ldk; \
        _Pragma("unroll") for (int i_ = 0; i_ < NVL; ++i_) sv[i_] = *reinterpret_cast<const bf16x8*>(vgp + ro_ + (size_t)(i_ * VRS) * ldk); \
        _Pragma("unroll") for (int i_ = 0; i_ < NKL; ++i_) sk[i_] = *reinterpret_cast<const bf16x8*>(kgp + ro_ + (size_t)(i_ * KRS) * ldk); } while (0)
#define FA_SWRITE(bf) do { _Pragma("unroll") for (int i_ = 0; i_ < NVL; ++i_) *reinterpret_cast<bf16x8*>(V_lds + (bf) * SHM_V + vws[i_]) = sv[i_]; \
        _Pragma("unroll") for (int i_ = 0; i_ < NKL; ++i_) *reinterpret_cast<bf16x8*>(K_lds + (bf) * SHM_K + kws[i_]) = sk[i_]; } while (0)
#define FA_RESC(a) do { if (__any((a) < 1.f)) { \
        _Pragma("unroll") for (int d_ = 0; d_ < NDV; ++d_) _Pragma("unroll") for (int r = 0; r < 16; ++r) o[d_][r] *= (a); } } while (0)
#define FA_KBASE(t) ((j_lo + (t)) * KVBLK)
#define FA_MASKT(P0_, P1_, t) do { const int kb_ = FA_KBASE(t); if (kb_ + KVBLK - 1 > qlo || kb_ <= qlo + QBLK - 1 - W) mask_tile(P0_, P1_, qm - kb_, (unsigned)W); } while (0)
        bf16x8 qr[NDQ];
#pragma unroll
        for (int d0 = 0; d0 < NDQ; ++d0) qr[d0] = *reinterpret_cast<const bf16x8*>(Qw + (size_t)(r32 >> 4) * (32 * 512) + (r32 & 15) * 32 + hi * 8 + (d0 >> 1) * 512 + (d0 & 1) * 16);
        FA_SLOAD(0); FA_VMW(); FA_SWRITE(0); FA_SBAR();
        if (NT > 1) FA_SLOAD(1);
        __syncthreads();
        f32x16 pA0, pA1, pB0, pB1; float alA, alB; bf16x8 pa0, pa1, pa2, pa3;
        FA_SBAR(); qkt<NDQ>(pA0, pA1, K_lds, r32, hi, qr);
        FA_MASKT(pA0, pA1, 0); partialSM(pA0, pA1, m_reg, alA);
        if (NT > 1) { FA_VMW(); FA_SWRITE(1); }
        __syncthreads();
#define FA_HALF_STEP(PX0, PX1, alX, PY0, PY1, alY, t, KB, VB, SB) do { \
        FA_SBAR(); qkt<NDQ>(PX0, PX1, K_lds + (KB) * SHM_K, r32, hi, qr); \
        finishSM(PY0, PY1, alY, l_reg, pa0, pa1, pa2, pa3); FA_SBAR(); \
        if ((t) + 1 < NT) { FA_SLOAD((t) + 1); FA_SBAR(); } \
        pv_tile<NDVT, NDV>(o, vb0 + (VB) * SHM_V, pa0, pa1, pa2, pa3); FA_MASKT(PX0, PX1, (t)); partialSM(PX0, PX1, m_reg, alX); \
        __syncthreads(); \
        if ((t) + 1 < NT) { FA_VMW(); FA_SWRITE(SB); } \
        FA_RESC(alX); __syncthreads(); } while (0)
        for (int t = 1; t + 1 < NT; t += 2) {
            FA_HALF_STEP(pB0, pB1, alB, pA0, pA1, alA, t, 1, 0, 0);
            FA_HALF_STEP(pA0, pA1, alA, pB0, pB1, alB, t + 1, 0, 1, 1);
        }
        const bool even = (NT & 1) == 0;
        if (even) { FA_SBAR(); qkt<NDQ>(pB0, pB1, K_lds + SHM_K, r32, hi, qr); FA_SBAR(); }
        finishSM(pA0, pA1, alA, l_reg, pa0, pa1, pa2, pa3); FA_SBAR();
        pv_tile<NDVT, NDV>(o, vb0, pa0, pa1, pa2, pa3);
        if (even) { FA_MASKT(pB0, pB1, NT - 1); partialSM(pB0, pB1, m_reg, alB); FA_RESC(alB);
            finishSM(pB0, pB1, alB, l_reg, pa0, pa1, pa2, pa3); FA_SBAR(); pv_tile<NDVT, NDV>(o, vb0 + SHM_V, pa0, pa1, pa2, pa3); }
        __syncthreads();
#undef FA_SLOAD
#undef FA_SWRITE
#undef FA_RESC
#undef FA_KBASE
#undef FA_MASKT
#undef FA_HALF_STEP
    }
};

#define FA_PIN(x) asm volatile("" : "+v"(x))
#define FA_PK4V(P, B_, OUT) do { unsigned a0_ = cvtpk(P[B_ + 0], P[B_ + 1]), a1_ = cvtpk(P[B_ + 2], P[B_ + 3]); unsigned b0_ = cvtpk(P[B_ + 4], P[B_ + 5]), b1_ = cvtpk(P[B_ + 6], P[B_ + 7]); \
        auto r0_ = __builtin_amdgcn_permlane32_swap(a0_, b0_, false, false); auto r1_ = __builtin_amdgcn_permlane32_swap(a1_, b1_, false, false); \
        u32x4 w_ = {r0_[0], r1_[0], r0_[1], r1_[1]}; OUT = *reinterpret_cast<bf16x8*>(&w_); } while (0)
__device__ __forceinline__ void step_qk_fin(f32x16& X0, f32x16& X1, const char* Kb, int r32, int hi, const bf16x8* qr,
                                            f32x16& Y0, f32x16& Y1, float alY, float& l_reg, bf16x8& pa0, bf16x8& pa1, bf16x8& pa2, bf16x8& pa3) {
    const char* k0 = Kb + kswz<4>(r32, hi); const char* k1 = Kb + kswz<4>(r32, 2 + hi); const char* k2 = Kb + kswz<4>(r32, 4 + hi); const char* k3 = Kb + kswz<4>(r32, 6 + hi);
    bf16x8 fa = *reinterpret_cast<const bf16x8*>(k0), fb = *reinterpret_cast<const bf16x8*>(k0 + 4096);
    float ps;
    X0 = __builtin_amdgcn_mfma_f32_32x32x16_bf16(fa, qr[0], f32x16{}, 0, 0, 0); X1 = __builtin_amdgcn_mfma_f32_32x32x16_bf16(fb, qr[0], f32x16{}, 0, 0, 0);
    fa = *reinterpret_cast<const bf16x8*>(k1); fb = *reinterpret_cast<const bf16x8*>(k1 + 4096);
#pragma unroll
    for (int r = 0; r < 4; ++r) Y1[r] = __builtin_amdgcn_exp2f(Y1[r]);
    ps = (Y0[0] + Y0[1]) + (Y0[2] + Y0[3]);
    FA_PK4V(Y0, 0, pa0); FA_PIN(ps); FA_PIN(pa0); FA_PIN(Y1); FA_SBAR();
    X0 = __builtin_amdgcn_mfma_f32_32x32x16_bf16(fa, qr[1], X0, 0, 0, 0); X1 = __builtin_amdgcn_mfma_f32_32x32x16_bf16(fb, qr[1], X1, 0, 0, 0);
    fa = *reinterpret_cast<const bf16x8*>(k2); fb = *reinterpret_cast<const bf16x8*>(k2 + 4096);
#pragma unroll
    for (int r = 4; r < 8; ++r) Y1[r] = __builtin_amdgcn_exp2f(Y1[r]);
    ps += (Y0[4] + Y0[5]) + (Y0[6] + Y0[7]); ps += (Y1[0] + Y1[1]) + (Y1[2] + Y1[3]);
    FA_PK4V(Y0, 8, pa1); FA_PIN(ps); FA_PIN(pa1); FA_PIN(Y1); FA_SBAR();
    X0 = __builtin_amdgcn_mfma_f32_32x32x16_bf16(fa, qr[2], X0, 0, 0, 0); X1 = __builtin_amdgcn_mfma_f32_32x32x16_bf16(fb, qr[2], X1, 0, 0, 0);
    fa = *reinterpret_cast<const bf16x8*>(k3); fb = *reinterpret_cast<const bf16x8*>(k3 + 4096);
#pragma unroll
    for (int r = 8; r < 12; ++r) Y1[r] = __builtin_amdgcn_exp2f(Y1[r]);
    ps += (Y0[8] + Y0[9]) + (Y0[10] + Y0[11]); ps += (Y1[4] + Y1[5]) + (Y1[6] + Y1[7]);
    FA_PK4V(Y1, 0, pa2); FA_PIN(ps); FA_PIN(pa2); FA_PIN(Y1); FA_SBAR();
    X0 = __builtin_amdgcn_mfma_f32_32x32x16_bf16(fa, qr[3], X0, 0, 0, 0); X1 = __builtin_amdgcn_mfma_f32_32x32x16_bf16(fb, qr[3], X1, 0, 0, 0);
#pragma unroll
    for (int r = 12; r < 16; ++r) Y1[r] = __builtin_amdgcn_exp2f(Y1[r]);
    ps += (Y0[12] + Y0[13]) + (Y0[14] + Y0[15]); ps += (Y1[8] + Y1[9]) + (Y1[10] + Y1[11]); ps += (Y1[12] + Y1[13]) + (Y1[14] + Y1[15]);
    { auto rr = __builtin_amdgcn_permlane32_swap(__float_as_uint(ps), __float_as_uint(ps), false, false); ps = __uint_as_float(rr[0]) + __uint_as_float(rr[1]); }
    l_reg = l_reg * alY + ps;
    FA_PK4V(Y1, 8, pa3); FA_PIN(l_reg); FA_PIN(pa3); FA_PIN(X0); FA_PIN(X1); FA_SBAR();
}
__device__ __forceinline__ void step_pv_max(f32x16* o, int vb, bf16x8 pa0, bf16x8 pa1, bf16x8 pa2, bf16x8 pa3, f32x16& X0, f32x16& X1, float& m_reg, float& alpha, bool MASK, int dq, unsigned W) {
#define FA_TRRD(dst, off) asm volatile("ds_read_b64_tr_b16 %0, %1 offset:%2" : "=&v"(dst) : "v"(vb), "i"(off) : "memory")
#define FA_RD2(l, h, d0, ks) do { FA_TRRD(l, (d0) * 512 + (ks) * 4096); FA_TRRD(h, (d0) * 512 + (ks) * 4096 + 2048); } while (0)
#define FA_FRAG(l, h) (bf16x8){l[0], l[1], l[2], l[3], h[0], h[1], h[2], h[3]}
    s16x4 l0, h0, l1, h1, l2, h2, l3, h3;
    FA_RD2(l0, h0, 0, 0); FA_RD2(l1, h1, 0, 1); FA_RD2(l2, h2, 0, 2); FA_RD2(l3, h3, 0, 3);
    if (MASK) mask_tile(X0, X1, dq, W);
    float pmax = fmaxf(fmaxf(X0[0], X0[1]), X1[0]);
#pragma unroll
    for (int r = 2; r < 16; r += 2) pmax = fmaxf(fmaxf(pmax, X0[r]), X0[r + 1]);
#pragma unroll
    for (int r = 1; r < 16; r += 2) pmax = fmaxf(fmaxf(pmax, X1[r]), X1[(r + 1) & 15]);
    { auto rr = __builtin_amdgcn_permlane32_swap(__float_as_uint(pmax), __float_as_uint(pmax), false, false); pmax = fmaxf(__uint_as_float(rr[0]), __uint_as_float(rr[1])); }
    float mn;
    if (__builtin_expect(__all((pmax - m_reg) <= THR), 1)) { mn = m_reg; alpha = 1.f; }
    else { mn = fmaxf(m_reg, pmax); alpha = __builtin_amdgcn_exp2f(m_reg - mn); m_reg = mn; }
    FA_PIN(mn);
#define FA_BLK(d0, NXT, FILL) do { asm volatile("s_waitcnt lgkmcnt(0)" ::: "memory"); FA_SBAR(); \
        o[d0] = __builtin_amdgcn_mfma_f32_32x32x16_bf16(pa0, FA_FRAG(l0, h0), o[d0], 0, 0, 0); if (NXT) FA_RD2(l0, h0, (d0) + 1, 0); \
        o[d0] = __builtin_amdgcn_mfma_f32_32x32x16_bf16(pa1, FA_FRAG(l1, h1), o[d0], 0, 0, 0); if (NXT) FA_RD2(l1, h1, (d0) + 1, 1); \
        o[d0] = __builtin_amdgcn_mfma_f32_32x32x16_bf16(pa2, FA_FRAG(l2, h2), o[d0], 0, 0, 0); if (NXT) FA_RD2(l2, h2, (d0) + 1, 2); \
        o[d0] = __builtin_amdgcn_mfma_f32_32x32x16_bf16(pa3, FA_FRAG(l3, h3), o[d0], 0, 0, 0); if (NXT) FA_RD2(l3, h3, (d0) + 1, 3); \
        FILL; } while (0)
    FA_BLK(0, true,  { _Pragma("unroll") for (int r = 0; r < 16; ++r) X0[r] = X0[r] - mn; FA_PIN(X0); });
    FA_BLK(1, true,  { _Pragma("unroll") for (int r = 0; r < 16; ++r) X1[r] = X1[r] - mn; FA_PIN(X1); });
    FA_BLK(2, true,  { _Pragma("unroll") for (int r = 0; r < 8; ++r) X0[r] = __builtin_amdgcn_exp2f(X0[r]); FA_PIN(X0); });
    FA_BLK(3, false, { _Pragma("unroll") for (int r = 8; r < 16; ++r) X0[r] = __builtin_amdgcn_exp2f(X0[r]); FA_PIN(X0); });
    FA_SBAR();
#undef FA_BLK
#undef FA_RD2
#undef FA_FRAG
#undef FA_TRRD
}

template <int NDQ, int NDVT, int NDV>
struct CoreStag {
    static_assert(NDQ == 4 && NDVT == 4 && NDV == 4, "the interleaved interval bodies are written for d_qk = 64, d_v = 128");
    static constexpr int KROW = NDQ * 32, SHM_K = 64 * KROW, SHM_V = 64 * NDVT * 64, NKL = NDQ / 4, NVL = NDVT / 2, LDS_NEED = 2 * SHM_V + 2 * SHM_K + NW * 256;
    __device__ __forceinline__ static void run(f32x16 (&o)[NDV], float& m_reg, float& l_reg, const bf16* Qw, int ldq, const bf16* Kg, const bf16* Vg, int ldk,
                                               int j_lo, int j_hi, int qlo, int W, char* lds, int vdoff) {
        const int tid = threadIdx.x, wid = __builtin_amdgcn_readfirstlane(tid >> 6), lane = tid & 63, r32 = lane & 31, hi = lane >> 5;
        const bool half1 = wid >= 4;
        const int NT = j_hi - j_lo, qm = qlo + r32 - 4 * hi;
        char* V_lds = lds; char* K_lds = lds + 2 * SHM_V;
        float* al_l = (float*)(lds + 2 * SHM_V + 2 * SHM_K) + wid * 64 + 32;
        m_reg = -1e30f; l_reg = 0.f;
#pragma unroll
        for (int d = 0; d < NDV; ++d) o[d] = f32x16{};
        constexpr int KCH = 2 * NDQ, KRS = 512 / KCH, VCH = 4 * NDVT, VRS = 512 / VCH;
        const int krow0 = tid / KCH, kch = tid % KCH, vrow0 = tid / VCH, vcol = (tid % VCH) * 8;
        int kws[NKL], vws[NVL];
#pragma unroll
        for (int i = 0; i < NKL; ++i) kws[i] = kswz<NDQ>(krow0 + i * KRS, kch);
#pragma unroll
        for (int i = 0; i < NVL; ++i) vws[i] = v_st<NDVT>(vrow0 + i * VRS, vcol);
        const bf16* kgp = Kg + (size_t)(j_lo * KVBLK + krow0) * ldk + kch * 8; const bf16* vgp = Vg + (size_t)(j_lo * KVBLK + vrow0) * ldk + vcol;
        bf16x8 sk[NKL], sv[NVL];
        const int vb0 = (int)(uintptr_t)V_lds + v_rd_base(lane) + vdoff * 512;
#define FS_BAR() do { FA_SBAR(); __syncthreads(); FA_SBAR(); } while (0)
#define FS_LOADK(t) do { if ((t) < NT) { const size_t ro_ = (size_t)((t) * KVBLK) * ldk; _Pragma("unroll") for (int i_ = 0; i_ < NKL; ++i_) sk[i_] = *reinterpret_cast<const bf16x8*>(kgp + ro_ + (size_t)(i_ * KRS) * ldk); } } while (0)
#define FS_LOADV(t) do { if ((t) < NT) { const size_t ro_ = (size_t)((t) * KVBLK) * ldk; _Pragma("unroll") for (int i_ = 0; i_ < NVL; ++i_) sv[i_] = *reinterpret_cast<const bf16x8*>(vgp + ro_ + (size_t)(i_ * VRS) * ldk); } } while (0)
#define FS_WRITEK(t, bf) do { if ((t) < NT) { _Pragma("unroll") for (int i_ = 0; i_ < NKL; ++i_) *reinterpret_cast<bf16x8*>(K_lds + (bf) * SHM_K + kws[i_]) = sk[i_]; } } while (0)
#define FS_WRITEV(t, bf) do { if ((t) < NT) { _Pragma("unroll") for (int i_ = 0; i_ < NVL; ++i_) *reinterpret_cast<bf16x8*>(V_lds + (bf) * SHM_V + vws[i_]) = sv[i_]; } } while (0)
#define FS_RESC(a) do { if (__any((a) < 1.f)) { \
        _Pragma("unroll") for (int d_ = 0; d_ < NDV; ++d_) _Pragma("unroll") for (int r = 0; r < 16; ++r) o[d_][r] *= (a); } } while (0)
#define FS_MASKT(P0_, P1_, t) do { const int kb_ = (j_lo + (t)) * KVBLK; if (kb_ + KVBLK - 1 > qlo || kb_ <= qlo + QBLK - 1 - W) mask_tile(P0_, P1_, qm - kb_, (unsigned)W); } while (0)
        bf16x8 qr[NDQ];
#pragma unroll
        for (int d0 = 0; d0 < NDQ; ++d0) qr[d0] = *reinterpret_cast<const bf16x8*>(Qw + (size_t)(r32 >> 4) * (32 * 512) + (r32 & 15) * 32 + hi * 8 + (d0 >> 1) * 512 + (d0 & 1) * 16);
        FS_LOADK(0); FS_WRITEK(0, 0); FA_SBAR(); FS_LOADK(1); FS_LOADV(0);
        FS_BAR();
        if (half1) { FS_BAR(); }
        f32x16 pA0, pA1, pB0, pB1; float alA = 1.f, alB = 1.f; bf16x8 pa0, pa1, pa2, pa3;
        FS_WRITEK(1, 1); FA_SBAR(); FS_LOADK(2); FA_SBAR();
        qkt<NDQ>(pA0, pA1, K_lds, r32, hi, qr); asm volatile("" : "+v"(pA0), "+v"(pA1));
        FS_BAR();
        FS_WRITEV(0, 0); FA_SBAR(); FS_LOADV(1); FA_SBAR();
        FS_MASKT(pA0, pA1, 0); partialSM(pA0, pA1, m_reg, alA);
        FS_BAR();
#define FS_STEP(PX0, PX1, alX, PY0, PY1, alY, t, KB) do { \
        finishSM(PY0, PY1, alY, l_reg, pa0, pa1, pa2, pa3); FA_SBAR(); \
        FS_WRITEK((t) + 1, (KB) ^ 1); FA_SBAR(); FS_LOADK((t) + 2); FA_SBAR(); \
        qkt<NDQ>(PX0, PX1, K_lds + (KB) * SHM_K, r32, hi, qr); asm volatile("" : "+v"(PX0), "+v"(PX1)); \
        FS_BAR(); \
        pv_tile<NDVT, NDV>(o, vb0 + ((KB) ^ 1) * SHM_V, pa0, pa1, pa2, pa3); \
        FS_WRITEV((t), (KB)); FA_SBAR(); FS_LOADV((t) + 1); FA_SBAR(); \
        FS_MASKT(PX0, PX1, (t)); partialSM(PX0, PX1, m_reg, alX); FS_RESC(alX); \
        FS_BAR(); } while (0)
        int t = 1;
        for (; t + 1 < NT; t += 2) {
            FS_STEP(pB0, pB1, alB, pA0, pA1, alA, t, 1);
            FS_STEP(pA0, pA1, alA, pB0, pB1, alB, t + 1, 0);
        }
        FS_STEP(pB0, pB1, alB, pA0, pA1, alA, t, 1);
        finishSM(pB0, pB1, alB, l_reg, pa0, pa1, pa2, pa3); FA_SBAR();
        FS_BAR();
        pv_tile<NDVT, NDV>(o, vb0 + SHM_V, pa0, pa1, pa2, pa3);
        FS_BAR();
        if (!half1) { FS_BAR(); }
#undef FS_BAR
#undef FS_LOADK
#undef FS_LOADV
#undef FS_WRITEK
#undef FS_WRITEV
#undef FS_RESC
#undef FS_MASKT
#undef FS_STEP
    }
};
}

constexpr size_t WS_STASH = 128 * MiB;
typedef unsigned v4u32 __attribute__((__vector_size__(16)));
__device__ __forceinline__ __amdgpu_buffer_rsrc_t mk_rsrc(const void* ptr) {
    const unsigned long long v = (unsigned long long)ptr; const unsigned lo = __builtin_amdgcn_readfirstlane((unsigned)v), hi = __builtin_amdgcn_readfirstlane((unsigned)(v >> 32));
    return __builtin_amdgcn_make_buffer_rsrc((void*)(((unsigned long long)hi << 32) | lo), 0, 0x40000000, 0x00020000);
}
template <bool GAIN> __device__ __forceinline__ void store_block_rows(const fa::f32x16& o, float sc, __amdgpu_buffer_rsrc_t gcol, __amdgpu_buffer_rsrc_t rso, int voff, int cb, int hi) {
    using namespace fa;
#pragma unroll
    for (int gp = 0; gp < 2; ++gp) {
        float ya[4], yb[4];
#pragma unroll
        for (int e = 0; e < 4; ++e) { ya[e] = o[8 * gp + e] * sc; yb[e] = o[8 * gp + 4 + e] * sc; }
        if (GAIN) { const f32x4 ga = __builtin_bit_cast(f32x4, __builtin_amdgcn_raw_buffer_load_b128(gcol, 16 * hi, (cb + 16 * gp) * 4, 0)), gb = __builtin_bit_cast(f32x4, __builtin_amdgcn_raw_buffer_load_b128(gcol, 16 * hi, (cb + 16 * gp + 8) * 4, 0));
#pragma unroll
            for (int e = 0; e < 4; ++e) { ya[e] *= ga[e]; yb[e] *= gb[e]; } }
        const unsigned a0 = cvtpk(ya[0], ya[1]), a1 = cvtpk(ya[2], ya[3]), b0 = cvtpk(yb[0], yb[1]), b1 = cvtpk(yb[2], yb[3]);
        auto r0 = __builtin_amdgcn_permlane32_swap(a0, b0, false, false); auto r1 = __builtin_amdgcn_permlane32_swap(a1, b1, false, false);
        const v4u32 w = {r0[0], r1[0], r0[1], r1[1]};
        __builtin_amdgcn_raw_buffer_store_b128(w, rso, voff + (cb >> 5) * 1024 + gp * 32, 0, WT_ATT);
    }
}
__device__ __forceinline__ void store_block_rows_fp8(const fa::f32x16& o, float sc, __amdgpu_buffer_rsrc_t rso, int voff, int d0) {
    typedef unsigned v2u32 __attribute__((__vector_size__(8)));
#pragma unroll
    for (int gp = 0; gp < 2; ++gp) {
        int a = __builtin_amdgcn_cvt_pk_fp8_f32(o[8 * gp] * sc, o[8 * gp + 1] * sc, 0, false); a = __builtin_amdgcn_cvt_pk_fp8_f32(o[8 * gp + 2] * sc, o[8 * gp + 3] * sc, a, true);
        int b = __builtin_amdgcn_cvt_pk_fp8_f32(o[8 * gp + 4] * sc, o[8 * gp + 5] * sc, 0, false); b = __builtin_amdgcn_cvt_pk_fp8_f32(o[8 * gp + 6] * sc, o[8 * gp + 7] * sc, b, true);
        auto r = __builtin_amdgcn_permlane32_swap((unsigned)a, (unsigned)b, false, false);
        const v2u32 w = {r[0], r[1]};
        __builtin_amdgcn_raw_buffer_store_b64(w, rso, voff + (d0 >> 1) * 1024 + (d0 & 1) * 32 + gp * 16, 0, WT_ATT);
    }
}
__device__ __forceinline__ void attn_phase(const Params& p, char* lds, int vcu0, int nwg) {
    using namespace fa;
    const int tid = threadIdx.x, wid = __builtin_amdgcn_readfirstlane(tid >> 6), lane = tid & 63, r32 = lane & 31, hi = lane >> 5;
    const bf16* proj = (const bf16*)(p.ws + WS_PROJ); bf16* att = (bf16*)(p.ws + WS_ATT); const bf16* qblk = (const bf16*)(p.ws + WS_QB);
    typedef CoreStag<4, 4, 4> CD; typedef Core<4, 2, 2> CS;
    float* wsf = (float*)(lds + CD::LDS_NEED) + wid * 64;
    const float lam = calc_lambda(p);
    const int ovoff = (r32 >> 4) * 32768 + (r32 & 15) * 64 + 16 * hi;
#pragma nounroll
    for (int vcu = vcu0; vcu < 256; vcu += nwg) {
        const int bh = vcu >> 3, b = bh >> 2, h = bh & 3, s = vcu & 7;
#pragma nounroll
        for (int pass = 0; pass < 2; ++pass) {
            const int qb = pass ? 15 - s : s;
            const size_t row0 = (size_t)b * SEQ + qb * 256 + wid * 32;
#pragma nounroll
            for (int c = 0; c < 2; ++c) {
                f32x16 o[4]; float m_reg, l_reg;
                CD::run(o, m_reg, l_reg, qblk + ((row0 >> 4) * 32 + 16 + (2 * h + c) * 2) * 512, NP, proj + (size_t)b * SEQ * NP + C_KD + (2 * h + c) * 64, proj + (size_t)b * SEQ * NP + C_VD + h * 128, NP,
                        0, 4 * (qb + 1), qb * 256 + wid * 32, 1 << 30, lds, 0);
                const float rinv = 1.0f / l_reg;
                int tid_e = threadIdx.x; asm volatile("" : "+v"(tid_e));
                const int hi = (tid_e >> 5) & 1, ovoff = ((tid_e >> 4) & 1) * 32768 + (tid_e & 15) * 64 + 16 * hi;
                u32x4* stash = (u32x4*)(lds + CD::LDS_NEED + NW * 256) + tid_e;
                if (c == 0) {
#pragma unroll
                    for (int j = 0; j < 2; ++j)
#pragma unroll
                        for (int d0 = 0; d0 < 4; ++d0) { u32x4 w; w.x = cvtpk(o[d0][8 * j] * rinv, o[d0][8 * j + 1] * rinv); w.y = cvtpk(o[d0][8 * j + 2] * rinv, o[d0][8 * j + 3] * rinv);
                            w.z = cvtpk(o[d0][8 * j + 4] * rinv, o[d0][8 * j + 5] * rinv); w.w = cvtpk(o[d0][8 * j + 6] * rinv, o[d0][8 * j + 7] * rinv); stash[(d0 * 2 + j) * NTHR] = w; }
                } else {
                    const __amdgpu_buffer_rsrc_t rso = mk_rsrc(att + ((row0 >> 4) * 32 + 16 + h * 4) * 512);
                    const float s1 = -lam * rinv; float q = 0.f;
#pragma unroll
                    for (int d0 = 0; d0 < 4; ++d0)
#pragma unroll
                        for (int j = 0; j < 2; ++j) { const u32x4 w = stash[(d0 * 2 + j) * NTHR]; const unsigned ww[4] = {w.x, w.y, w.z, w.w};
#pragma unroll
                            for (int e = 0; e < 8; ++e) { const int r = 8 * j + e; const float a0 = (e & 1) ? __uint_as_float(ww[e >> 1] & 0xffff0000u) : __uint_as_float(ww[e >> 1] << 16);
                                const float v = a0 + s1 * o[d0][r]; o[d0][r] = v; q += v * v; } }
                    q += __shfl_xor(q, 32);
                    const float rn = 0.8f / sqrtf(q * (1.f / 128.f) + EPS);
#pragma unroll
                    for (int d0 = 0; d0 < 4; ++d0) store_block_rows<false>(o[d0], rn, rso, rso, ovoff, d0 * 32, hi);
                }
                asm volatile("s_waitcnt lgkmcnt(0)" ::: "memory");
            }
        }
    }
    int tid_s = threadIdx.x; asm volatile("" : "+v"(tid_s));
    const int wid_s = __builtin_amdgcn_readfirstlane(tid_s >> 6), r32_s = tid_s & 31, hi_s = (tid_s >> 5) & 1;
    float* wsf_s = (float*)(lds + CD::LDS_NEED) + wid_s * 64; const int ovoff_s = (r32_s >> 4) * 32768 + (r32_s & 15) * 64 + 16 * hi_s;
#pragma nounroll
    for (int u = vcu0; u < 1024; u += nwg) {
        const int wid = wid_s, r32 = r32_s, hi = hi_s, ovoff = ovoff_s; float* wsf = wsf_s;
        const int bk = u >> 6, g64 = u & 63, b = bk >> 1, kvh = bk & 1, hq = kvh * 4 + (wid >> 1), sub = wid & 1;
        const size_t row0 = (size_t)b * SEQ + g64 * 64 + sub * 32;
        const __amdgpu_buffer_rsrc_t rso = mk_rsrc((unsigned char*)att + ((row0 >> 4) * 32 + 8 + hq) * 1024);
        f32x16 o[2]; float m_reg, l_reg;
        const bf16* Qw = qblk + ((row0 >> 4) * 32 + hq * 2) * 512;
        const bf16* Kg = proj + (size_t)b * SEQ * NP + C_KA + kvh * 64;
        const bf16* Vg = proj + (size_t)b * SEQ * NP + C_VA + kvh * 64;
        CS::run(o, m_reg, l_reg, Qw, NP, Kg, Vg, NP, g64 >= 2 ? g64 - 2 : 0, g64 + 1, g64 * 64 + sub * 32, 128, lds, 0);
        const float lt = l_reg + __builtin_amdgcn_exp2f(p.sinks[hq] * LOG2E - m_reg);
        const float rl = 16.0f / lt;
#pragma unroll
        for (int d0 = 0; d0 < 2; ++d0) store_block_rows_fp8(o[d0], rl, rso, ovoff - 8 * hi, d0);
        __syncthreads();
    }
}

namespace fa {
template <int NDQ, int NDVT, int NDV>
struct CoreSeqG {
    static constexpr int KROW = NDQ * 32, SHM_K = 64 * KROW, SHM_V = 64 * NDVT * 64, KPW = SHM_K / 8192, VPW = SHM_V / 8192;
    static_assert(NDQ == 16 && NDVT == 8, "piece maps below are written for 512-byte K rows and 8 V column blocks");
    typedef __attribute__((address_space(3))) unsigned char* lptr;
    __device__ __forceinline__ static void run(f32x16 (&o)[NDV], float& m_reg, float& l_reg, const bf16* Qw, int ldq, const bf16* Kg, const bf16* Vg, int ldk, int NT, char* lds, lptr ldsL, int scr_off, int vdoff) {
        const int tid = threadIdx.x, wid = __builtin_amdgcn_readfirstlane(tid >> 6), lane = tid & 63, r32 = lane & 31, hi = lane >> 5;
        char* V_lds = lds; char* K_lds = lds + 2 * SHM_V;
        float* al_l = (float*)(lds + scr_off) + wid * 64 + 32;
        m_reg = -1e30f; l_reg = 0.f;
#pragma unroll
        for (int d = 0; d < NDV; ++d) o[d] = f32x16{};
        int ksrc[KPW], vsrc[VPW];
#pragma unroll
        for (int i = 0; i < KPW; ++i) { const int row = 2 * (wid * KPW + i) + (lane >> 5); ksrc[i] = row * ldk + (((lane & 31) ^ (row & 15)) << 3); }
#pragma unroll
        for (int i = 0; i < VPW; ++i) { const int kk = wid * 8 + ((lane & 31) >> 2), k = (kk & ~0xC) | ((kk & 4) << 1) | ((kk & 8) >> 1); vsrc[i] = k * ldk + (2 * i + (lane >> 5)) * 32 + (lane & 3) * 8; }
#define FG_DMA(t, bf) do { const size_t ro_ = (size_t)((t) * KVBLK) * ldk; \
        _Pragma("unroll") for (int i_ = 0; i_ < VPW; ++i_) __builtin_amdgcn_global_load_lds((const unsigned*)(Vg + ro_ + vsrc[i_]), (__attribute__((address_space(3))) unsigned*)(ldsL + (bf) * SHM_V + (wid * VPW + i_) * 1024), 16, 0, 0); \
        _Pragma("unroll") for (int i_ = 0; i_ < KPW; ++i_) __builtin_amdgcn_global_load_lds((const unsigned*)(Kg + ro_ + ksrc[i_]), (__attribute__((address_space(3))) unsigned*)(ldsL + 2 * SHM_V + (bf) * SHM_K + (wid * KPW + i_) * 1024), 16, 0, 0); } while (0)
        const int vb0 = (int)(uintptr_t)V_lds + v_rd_base(lane) + vdoff * 512;
        FG_DMA(0, 0);
        bf16x8 qr[NDQ];
#pragma unroll
        for (int d0 = 0; d0 < NDQ; ++d0) qr[d0] = *reinterpret_cast<const bf16x8*>(Qw + (size_t)(r32 >> 4) * (ldq * 16) + (r32 & 15) * 32 + hi * 8 + (d0 >> 1) * 512 + (d0 & 1) * 16);
        __syncthreads();
        for (int t = 0; t < NT; ++t) {
            const int bf = t & 1;
            if (t + 1 < NT) FG_DMA(t + 1, bf ^ 1);
            f32x16 p0, p1; float al; bf16x8 pa0, pa1, pa2, pa3;
            FA_SBAR(); qkt<NDQ>(p0, p1, K_lds + bf * SHM_K, r32, hi, qr);
            partialSM(p0, p1, m_reg, al);
            if (__any(al < 1.f)) {
#pragma unroll
                for (int d_ = 0; d_ < NDV; ++d_)
#pragma unroll
                    for (int r = 0; r < 16; ++r) o[d_][r] *= al; }
            finishSM(p0, p1, al, l_reg, pa0, pa1, pa2, pa3); FA_SBAR();
            pv_tile<NDVT, NDV>(o, vb0 + bf * SHM_V, pa0, pa1, pa2, pa3);
            __syncthreads();
        }
#undef FG_DMA
    }
};
}
__device__ __forceinline__ void cross_block(const Params& p, char* lds, LAS unsigned char* ldsL, int b, int head, int rb) {
    using namespace fa;
    int tid = threadIdx.x; asm volatile("" : "+v"(tid));
    const int wid = __builtin_amdgcn_readfirstlane(tid >> 6), lane = tid & 63, r32 = lane & 31, hi = lane >> 5, dh = wid >> 2;
    const bf16* qc = (const bf16*)(p.ws + WS_QC); const bf16* kvm = (const bf16*)(p.ws + WS_KVM); bf16* oc = (bf16*)(p.ws + WS_OC);
    typedef CoreSeqG<16, 8, 4> CC;
    constexpr int SCR = 131072 + 8192;
    float* wsf = (float*)(lds + SCR + 2048) + wid * 64;
    const int ovoff = (r32 >> 4) * 16384 + (r32 & 15) * 64 + 8 * hi;
    const size_t row0 = (size_t)b * SEQ + rb * 128 + (wid & 3) * 32;
    const __amdgpu_buffer_rsrc_t rso = mk_rsrc((unsigned char*)oc + ((row0 >> 4) * 16 + head * 4 + dh * 2) * 1024);
    f32x16 o[4]; float m_reg, l_reg;
    CC::run(o, m_reg, l_reg, qc + (row0 >> 4) * (size_t)(DM * 16) + head * 8 * 512, DM, kvm + (size_t)b * MEML * 2048 + head * 256, kvm + (size_t)b * MEML * 2048 + 1024 + head * 256, 2048, MEML / 64, lds, (CC::lptr)ldsL, SCR, dh * 4);
    const float rl = 16.0f / l_reg;
#pragma unroll
    for (int d0 = 0; d0 < 4; ++d0) store_block_rows_fp8(o[d0], rl, rso, ovoff, d0);
}
#define GAS __attribute__((address_space(1)))
typedef GAS unsigned gu32;
constexpr int CW_BAR = 4096;
constexpr size_t CTL_ZERO_BYTES = 65536;
constexpr int MISC_OFF = 131072 + 320, TAB_OFF = 131072 + 1024;
constexpr int CW_PANEL = 8192;
constexpr size_t WS_XCH = 60 * MiB;
#define XB_TMO      128
#define XB_XCNT(j)  (256  + 64 * (j))
#define XB_XSUB(j)  (1280 + 64 * (j))
#define XB_XGEN(j)  (2304 + 64 * (j))
#define XB_TOP      3328
#define XB_TOPGEN   3392
#define XCD_BAR_WORDS 3456
#define XB_SPIN_CAP (1u << 18)

__device__ __forceinline__ unsigned xb_ld(unsigned* p)              { return __hip_atomic_load(p, __ATOMIC_RELAXED, __HIP_MEMORY_SCOPE_AGENT); }
__device__ __forceinline__ unsigned xb_add(unsigned* p, unsigned v) { return __hip_atomic_fetch_add(p, v, __ATOMIC_RELAXED, __HIP_MEMORY_SCOPE_AGENT); }
__device__ __forceinline__ unsigned xb_xcc_id() { return (unsigned)__builtin_amdgcn_s_getreg((3 << 11) | 20) & 0xFu; }
#define XB_SPIN(cond, bar) do { unsigned _sp = 0; while (cond) { __builtin_amdgcn_s_sleep(1); \
    if ((++_sp & 255u) == 0u) { if (xb_ld(&(bar)[XB_TMO])) break; if (_sp > XB_SPIN_CAP) { atomicAdd(&(bar)[XB_TMO], 1u); break; } } } } while (0)

struct XcdBarrier {
    unsigned* bar; unsigned x;
    volatile LAS unsigned* st;
};

__device__ __forceinline__ XcdBarrier xcd_barrier_post(unsigned* bar, volatile LAS unsigned* st) {
    XcdBarrier b; b.bar = bar; b.x = xb_xcc_id(); b.st = st;
    if (threadIdx.x == 0) (void)xb_add(&bar[XB_XCNT(b.x)], 1u);
    return b;
}
__device__ __forceinline__ void xcd_barrier_complete(unsigned* bar, unsigned x, unsigned& nloc, unsigned& nx) {
    const unsigned G = gridDim.x * gridDim.y * gridDim.z;
    unsigned sum, cnt, mine, sp = 0u;
    for (;;) {
        sum = 0u; cnt = 0u; mine = 0u;
#pragma unroll
        for (unsigned j = 0; j < 16; ++j) { const unsigned c = xb_ld(&bar[XB_XCNT(j)]); sum += c; cnt += (c > 0u) ? 1u : 0u; mine = (j == x) ? c : mine; }
        if (sum == G) break;
        __builtin_amdgcn_s_sleep(1);
        if ((++sp & 255u) == 0u) { if (xb_ld(&bar[XB_TMO])) break; if (sp > XB_SPIN_CAP) { atomicAdd(&bar[XB_TMO], 1u); break; } }
    }
    nloc = mine > 0u ? mine : 1u; nx = cnt > 0u ? cnt : 1u;
}

__device__ __forceinline__ void xcd_barrier(const XcdBarrier& b) {
    asm volatile("s_waitcnt vmcnt(0)" ::: "memory");
    __syncthreads();
    if (threadIdx.x == 0) {
        unsigned* bar = b.bar;
        __builtin_amdgcn_s_waitcnt(0);
        unsigned nloc = b.st[0], nx = b.st[1];
        if (nloc == 0u) { xcd_barrier_complete(bar, b.x, nloc, nx); b.st[0] = nloc; b.st[1] = nx; }
        const unsigned old = xb_add(&bar[XB_XSUB(b.x)], 1u);
        const unsigned gen = old / nloc;
        if (old + 1u == (gen + 1u) * nloc) {
            __builtin_amdgcn_fence(__ATOMIC_RELEASE, "agent");
            asm volatile("s_waitcnt vmcnt(0)" ::: "memory");
            const unsigned og = xb_add(&bar[XB_TOP], 1u);
            const unsigned tg = og / nx;
            if (og + 1u == (tg + 1u) * nx) xb_add(&bar[XB_TOPGEN], 1u);
            else XB_SPIN(xb_ld(&bar[XB_TOPGEN]) == tg, bar);
            __builtin_amdgcn_fence(__ATOMIC_ACQUIRE, "agent");
            asm volatile("s_waitcnt vmcnt(0)" ::: "memory");
        } else {
            XB_SPIN(xb_ld(&bar[XB_TOPGEN]) == gen, bar);
            __builtin_amdgcn_fence(__ATOMIC_ACQUIRE, "agent");
            asm volatile("s_waitcnt vmcnt(0)" ::: "memory");
        }
    }
    __syncthreads();
}

constexpr int CW_FQ = 1024;
__device__ __forceinline__ void xcd_barrier_fill(const XcdBarrier& b, const Params& p, LAS unsigned char* lds) {
    asm volatile("s_waitcnt vmcnt(0)" ::: "memory");
    __syncthreads();
    volatile LAS unsigned* mw = (volatile LAS unsigned*)(lds + MISC_OFF);
    unsigned* bar = b.bar; unsigned* fq = (unsigned*)(p.ws + WS_CTL) + CW_FQ;
    if (threadIdx.x == 0) {
        __builtin_amdgcn_s_waitcnt(0);
        unsigned nloc = b.st[0], nx = b.st[1];
        if (nloc == 0u) { xcd_barrier_complete(bar, b.x, nloc, nx); b.st[0] = nloc; b.st[1] = nx; }
        const unsigned old = xb_add(&bar[XB_XSUB(b.x)], 1u);
        const unsigned gen = old / nloc;
        if (old + 1u == (gen + 1u) * nloc) {
            __builtin_amdgcn_fence(__ATOMIC_RELEASE, "agent");
            asm volatile("s_waitcnt vmcnt(0)" ::: "memory");
            const unsigned og = xb_add(&bar[XB_TOP], 1u);
            const unsigned tg = og / nx;
            if (og + 1u == (tg + 1u) * nx) xb_add(&bar[XB_TOPGEN], 1u);
        }
        mw[19] = gen;
    }
    for (;;) {
        if (threadIdx.x == 0) {
            const unsigned gen = mw[19];
            unsigned rel = xb_ld(&bar[XB_TOPGEN]) != gen ? 1u : 0u, base = 0xffffffffu;
            if (!rel) {
                if (mw[20] != 0u) { base = mw[20] - 1u; mw[20] = 0u; }
                else if (!mw[18]) { base = xb_add(fq, 8u); if (base >= (unsigned)FQ_ITEMS) { mw[18] = 1u; base = 0xffffffffu; }
                    else if (xb_ld(&bar[XB_TOPGEN]) != gen) { mw[20] = base + 1u; base = 0xffffffffu; rel = 1u; } }
                if (!rel && base == 0xffffffffu) { XB_SPIN(xb_ld(&bar[XB_TOPGEN]) == gen, bar); rel = 1u; }
            }
            mw[16] = rel; mw[17] = base;
        }
        __syncthreads();
        const unsigned rel = mw[16], base = mw[17];
        if (rel) break;
        fill_chunk(p, lds, (int)base, threadIdx.x);
        __syncthreads();
    }
    if (threadIdx.x == 0) { __builtin_amdgcn_fence(__ATOMIC_ACQUIRE, "agent"); asm volatile("s_waitcnt vmcnt(0)" ::: "memory"); }
    __syncthreads();
}
__device__ __forceinline__ void fill_drain(const Params& p, LAS unsigned char* lds, unsigned limit) {
    volatile LAS unsigned* mw = (volatile LAS unsigned*)(lds + MISC_OFF);
    unsigned* fq = (unsigned*)(p.ws + WS_CTL) + CW_FQ;
    asm volatile("s_waitcnt vmcnt(0)" ::: "memory");
    __syncthreads();
    for (;;) {
        if (threadIdx.x == 0) {
            unsigned base = 0xffffffffu;
            if (mw[20] != 0u) { base = mw[20] - 1u; mw[20] = 0u; }
            else if (!mw[18] && mw[21] < limit) { base = xb_add(fq, 8u); mw[21] = base + 8u; if (base >= (unsigned)FQ_ITEMS) { mw[18] = 1u; base = 0xffffffffu; } }
            mw[17] = base;
        }
        __syncthreads();
        const unsigned base = mw[17];
        if (base == 0xffffffffu) break;
        fill_chunk(p, lds, (int)base, threadIdx.x);
        __syncthreads();
    }
}
constexpr int LDS_BYTES = 163840;
constexpr size_t WS_SS3 = 58 * MiB;
__device__ __forceinline__ void final_norm_ss(float* X, const float* ss, const float* g, int gw, int ngw, int lane) {
    for (int m = gw; m < M; m += ngw) {
        const float rstd = pg8::rstd_ss(ss, m);
        f32x4* xr = (f32x4*)(X + (size_t)m * DM) + lane;
#pragma unroll
        for (int j = 0; j < 4; ++j) { const f32x4 gg = ((const f32x4*)g)[lane + 64 * j]; xr[64 * j] = xr[64 * j] * rstd * gg; }
    }
}
constexpr int N_PHASES = 10;
__global__ void __launch_bounds__(NTHR, 2) fwd_kernel(Params p) {
    extern __shared__ __attribute__((aligned(16))) unsigned char lds_raw[];
    LAS unsigned char* lds = (LAS unsigned char*)lds_raw;
    for (int u = threadIdx.x; u < 64; u += NTHR) ((LAS unsigned*)(lds + MISC_OFF))[u] = 0u;
    __syncthreads();
    XcdBarrier bar = xcd_barrier_post((unsigned*)(p.ws + WS_CTL) + CW_BAR, (volatile LAS unsigned*)(lds + MISC_OFF) + 8);
    const int tid = threadIdx.x, wave = __builtin_amdgcn_readfirstlane(tid >> 6), lane = tid & 63, bid = blockIdx.x, nblk = gridDim.x;
    const int gw = bid * NWAVES + wave, ngw = nblk * NWAVES;
    const int vcu = (nblk % 8 == 0) ? (bid % 8) * (nblk / 8) + bid / 8 : bid;
    unsigned char* ws = p.ws;
    const int lo = p.ph_lo, hi = p.ph_hi;
    typedef pg8::bf16_t b16;
#define IN(k) (lo <= (k) && (k) < hi)
#define FQ_PEEK() do { if (tid == 0) __builtin_amdgcn_global_load_lds((const unsigned*)((unsigned*)(ws + WS_CTL) + CW_FQ), (LAS unsigned*)(lds + MISC_OFF) + 21, 4, 0, 0); } while (0)
#define SEAM(k) do { if (IN(k) && IN((k) + 1) && !((k) == 8 && nblk == 256)) { if ((k) <= 4) xcd_barrier_fill(bar, p, lds); else xcd_barrier(bar); } } while (0)
    if (IN(0)) { p0_prologue(p, lds, bid, nblk, tid); } SEAM(0);
    if (IN(1)) {
        pg8::Gemm g{(const b16*)(ws + WS_XN), (const b16*)(ws + WS_WIN), (const b16*)(ws + WS_MEMN), (const b16*)(ws + WS_WCKV), DM, 1};
        pg8::TwoOrder S; S.init(M, NP, nblk, bid); S.n2M = MM / 256; S.n2N = 2048 / 256;
        pg8::EpiProj E{(b16*)(ws + WS_PROJ), (b16*)(ws + WS_KVM), (const float*)(ws + WS_ROPE), (b16*)(ws + WS_QB)};
        pg8::gemm_phase<pg8::EpiProj, pg8::TwoOrder, true, true>(lds, g, S, E);
    } SEAM(1);
    if (IN(2)) { FQ_PEEK(); attn_phase(p, (char*)lds_raw, vcu, nblk);
        fill_drain(p, lds, (unsigned)FQ_L_OUT);
    } SEAM(2);
    if (IN(3)) {
        pg8::Gemm g{(const b16*)(ws + WS_ATT), (const b16*)(ws + WS_WOUT), nullptr, nullptr, DM, 1};
        pg8::StaticOrder S; S.init(M, DM, nblk, bid);
        pg8::EpiResB<true> E{(const float*)(ws + WS_IRS), (const b16*)(ws + WS_XN), (b16*)(ws + WS_XN), (float*)(ws + WS_SS1), ws + WS_XB8, 1.f};
        FQ_PEEK();
        pg8::gemm_phase<pg8::EpiResB<true>, pg8::StaticOrder, true, true>(lds, g, S, E);
        fill_drain(p, lds, (unsigned)FQ_L_CQ);
    } SEAM(3);
    if (IN(4)) {
        pg8::Gemm g{(const b16*)(ws + WS_XB8), (const b16*)(ws + WS_WCQ), nullptr, nullptr, DM, 1};
        pg8::StaticOrder S; S.init(M, DM, nblk, bid);
        pg8::EpiScaleBf16<0> E{(b16*)(ws + WS_QC), DM, (const float*)(ws + WS_SS1), CQ * (1.f / 32.f), lds + TAB_OFF};
        FQ_PEEK();
        pg8::gemm_phase<pg8::EpiScaleBf16<0>, pg8::StaticOrder, true, true>(lds, g, S, E);
        asm volatile("s_waitcnt vmcnt(0)" ::: "memory");
        __syncthreads();
        if (tid == 0) { __builtin_amdgcn_fence(__ATOMIC_ACQUIRE, "agent"); asm volatile("s_waitcnt vmcnt(0)" ::: "memory"); }
        __syncthreads();
#pragma nounroll
        for (int i = 0; ; ++i) {
            pg8::Unit u; if (!S.next(i, u)) break;
#pragma nounroll
            for (int hb = 0; hb < 2; ++hb) cross_block(p, (char*)lds_raw, lds, u.pm >> 4, u.pn, (u.pm & 15) * 2 + hb);
        }
        fill_drain(p, lds, (unsigned)FQ_L_CO);
    } SEAM(4);
    if (IN(6)) {
        FQ_PEEK();
        pg8::Gemm g{(const b16*)(ws + WS_OC), (const b16*)(ws + WS_WCO), nullptr, nullptr, DM, 1};
        pg8::StaticOrder S; S.init(M, DM, nblk, bid);
        pg8::EpiResB<false> E{nullptr, (const b16*)(ws + WS_XN), (b16*)(ws + WS_XN), (float*)(ws + WS_SS2), nullptr, 1.f / 512.f};
        pg8::gemm_phase<pg8::EpiResB<false>, pg8::StaticOrder, true, true>(lds, g, S, E);
        fill_drain(p, lds, (unsigned)FQ_ITEMS);
    } SEAM(6);
    if (IN(7)) {
        pg8::Gemm g{(const b16*)(ws + WS_XN), (const b16*)(ws + WS_WUP), nullptr, nullptr, DM, 1};
        pg8::StaticOrder S; S.init(M, FF, nblk, bid);
        pg8::EpiScaleBf16<1> E{(b16*)(ws + WS_ACT), FF, (const float*)(ws + WS_SS2), 1.f, lds + TAB_OFF};
        pg8::gemm_phase<pg8::EpiScaleBf16<1>, pg8::StaticOrder, true, true>(lds, g, S, E);
    } SEAM(7);
    if (IN(8)) {
        pg8::Gemm g{(const b16*)(ws + WS_ACT), (const b16*)(ws + WS_WDOWN), nullptr, nullptr, FF, 1};
        pg8::StaticOrder S; S.init(M, DM, nblk, bid);
        if (nblk == 256) {
            pg8::EpiFinal E{(const b16*)(ws + WS_XN), p.out, p.g_final, (unsigned*)(ws + WS_XCH), (unsigned*)(ws + WS_CTL) + CW_PANEL, lds + TAB_OFF};
            pg8::gemm_phase<pg8::EpiFinal, pg8::StaticOrder, true, true>(lds, g, S, E);
        } else {
            pg8::EpiResF E{(const b16*)(ws + WS_XN), p.out, (float*)(ws + WS_SS3)};
            pg8::gemm_phase<pg8::EpiResF, pg8::StaticOrder, true, true>(lds, g, S, E);
        }
    } SEAM(8);
    if (IN(9) && nblk != 256) { final_norm_ss(p.out, (const float*)(ws + WS_SS3), p.g_final, gw, ngw, lane); }
#undef IN
#undef SEAM
}

extern "C" void kernel_launch(void* const* d_in, const int* in_sizes, int n_in, void* d_out, int out_size, void* d_ws, size_t ws_size, hipStream_t stream) {
    static int grid = 0;
    if (grid == 0) {
        if (n_in != 21 || out_size != M * DM || ws_size < WS_END) { fprintf(stderr, "kernel_launch: unexpected shapes (n_in %d out %d ws %zu)\n", n_in, out_size, ws_size); grid = -1; return; }
        int dev = 0, cus = 0, per_cu = 0;
        (void)hipGetDevice(&dev); (void)hipDeviceGetAttribute(&cus, hipDeviceAttributeMultiprocessorCount, dev);
        if (hipFuncSetAttribute((const void*)fwd_kernel, hipFuncAttributeMaxDynamicSharedMemorySize, LDS_BYTES) != hipSuccess) { fprintf(stderr, "kernel_launch: hipFuncSetAttribute failed\n"); grid = -1; return; }
        (void)hipOccupancyMaxActiveBlocksPerMultiprocessor(&per_cu, (const void*)fwd_kernel, NTHR, LDS_BYTES);
        if (per_cu < 1) { fprintf(stderr, "kernel_launch: occupancy query says %d blocks per CU\n", per_cu); per_cu = 1; }
        grid = cus;
    }
    if (grid < 0) return;
    Params p{};
    p.x = (const float*)d_in[0]; p.mem = (const float*)d_in[1]; p.pos = (const int*)d_in[2]; p.g_mix = (const float*)d_in[3]; p.w_in = (const float*)d_in[4];
    p.sinks = (const float*)d_in[5]; p.lq1 = (const float*)d_in[6]; p.lk1 = (const float*)d_in[7]; p.lq2 = (const float*)d_in[8]; p.lk2 = (const float*)d_in[9];
    p.g_diff = (const float*)d_in[10]; p.w_out = (const float*)d_in[11]; p.g_cross = (const float*)d_in[12]; p.g_mem = (const float*)d_in[13]; p.w_cq = (const float*)d_in[14];
    p.w_ckv = (const float*)d_in[15]; p.w_co = (const float*)d_in[16]; p.g_mlp = (const float*)d_in[17]; p.w_up = (const float*)d_in[18]; p.w_down = (const float*)d_in[19]; p.g_final = (const float*)d_in[20];
    p.out = (float*)d_out; p.ws = (unsigned char*)d_ws;
    if (hipMemsetAsync((char*)d_ws + WS_CTL, 0, CTL_ZERO_BYTES, stream) != hipSuccess) { fprintf(stderr, "kernel_launch: hipMemsetAsync of the control words failed\n"); return; }
    p.ph_lo = 0; p.ph_hi = N_PHASES;
    hipLaunchKernelGGL(fwd_kernel, dim3(grid), dim3(NTHR), LDS_BYTES, stream, p);
}
```
